# Optimizing an MI355X kernel written in HIP

```python
import math
import jax, jax.numpy as jnp
from jax import lax
import numpy as np

D_MODEL = 2048
BATCH = 2
SEQ = 8192
DEPTH = 4

HEAD_DIM = 64
BLK = 128
NORM_EPS = 1e-5
N_BRANCH = 3
A_WINDOW = 128
A_HQ = 8
A_HKV = 2
A_G = A_HQ // A_HKV
B_HEADS = 12
B_WIDTH = B_HEADS * HEAD_DIM
LORA_DECAY = 96
LORA_ICLR = 96
LORA_GATE = 256
B_GN_EPS = 64e-5
C_GROUPS = ((128, 1), (512, 4), (2048, 16))
C_HG = 4
C_HEADS = C_HG * len(C_GROUPS)
C_WIDTH = C_HEADS * HEAD_DIM
C_OUT = C_HG * HEAD_DIM
N_BUCKETS = 32
MAX_EXACT = 16
REL_MAX_DIST = 2048
N_BIAS_HEADS = A_HQ + C_HEADS
D_FF = 5504
CONV_W = 3
B_COL_SIZES = (B_WIDTH, B_WIDTH, B_WIDTH, LORA_DECAY, LORA_ICLR, LORA_GATE)
B_COLS = sum(B_COL_SIZES)
IN_COL_SIZES = (A_HQ * HEAD_DIM, A_HKV * HEAD_DIM, A_HKV * HEAD_DIM, B_COLS,
                C_WIDTH, C_WIDTH, C_WIDTH, N_BRANCH * D_MODEL)
D_IN = sum(IN_COL_SIZES)

kernel_name = 'hybrid_swa_rwkv7_dilated_gated_trunk'


def _split(t, sizes):
    return jnp.split(t, [int(c) for c in np.cumsum(sizes)[:-1]], axis=-1)


def _rmsnorm(x, g):
    xf = x.astype(jnp.float32)
    y = xf * lax.rsqrt(jnp.mean(xf * xf, axis=-1, keepdims=True) + NORM_EPS)
    return (y * g.astype(jnp.float32)).astype(x.dtype)


def _shift(t):
    return jnp.pad(t, ((0, 0), (1, 0), (0, 0)))[:, :-1]


def _band_offsets():
    i = jnp.arange(BLK)[:, None]
    j = jnp.arange(2 * BLK)[None, :]
    return i + BLK - j


def _t5_bucket(dist):
    small = dist < MAX_EXACT
    nf = jnp.maximum(dist, 1).astype(jnp.float32)
    large = MAX_EXACT + (jnp.log(nf / MAX_EXACT) / math.log(REL_MAX_DIST / MAX_EXACT)
                         * (N_BUCKETS - MAX_EXACT)).astype(jnp.int32)
    return jnp.where(small, dist, jnp.minimum(large, N_BUCKETS - 1))


def _rel_bias(table, dilation):
    dist = jnp.maximum(_band_offsets(), 0) * dilation
    return jnp.transpose(table[_t5_bucket(dist)], (2, 0, 1))


def _banded_attention(q, k, v, max_steps, bias, sink):
    n, L, hkv, g, hd = q.shape
    nb = -(-L // BLK)
    pad = nb * BLK - L
    q = jnp.pad(q, ((0, 0), (0, pad), (0, 0), (0, 0), (0, 0)))
    k = jnp.pad(k, ((0, 0), (0, pad), (0, 0), (0, 0)))
    v = jnp.pad(v, ((0, 0), (0, pad), (0, 0), (0, 0)))
    qb = q.reshape(n, nb, BLK, hkv, g, hd).astype(jnp.float32)

    def window(t):
        tb = t.reshape(n, nb, BLK, hkv, hd)
        prev = jnp.pad(tb, ((0, 0), (1, 0), (0, 0), (0, 0), (0, 0)))[:, :-1]
        return jnp.concatenate([prev, tb], axis=2).astype(jnp.float32)

    kw, vw = window(k), window(v)
    s = jnp.einsum('nbqhgd,nbkhd->nbhgqk', qb, kw) * (hd ** -0.5) + bias.astype(jnp.float32)
    dist = _band_offsets()
    kpos = jnp.arange(nb)[:, None, None] * BLK - BLK + jnp.arange(2 * BLK)[None, None, :]
    valid = (dist >= 0) & (dist <= max_steps) & (kpos >= 0)
    s = jnp.where(valid[None, :, None, None], s, -jnp.inf)
    m = jnp.max(s, axis=-1)
    if sink is not None:
        sk = sink.astype(jnp.float32)[:, :, None]
        m = jnp.maximum(m, sk)
    p = jnp.exp(s - m[..., None])
    l = jnp.sum(p, axis=-1)
    denom = l + jnp.exp(sk - m) if sink is not None else l
    o = jnp.einsum('nbhgqk,nbkhd->nbqhgd', p, vw) / jnp.moveaxis(denom, -1, 2)[..., None]
    lse = jnp.moveaxis(m + jnp.log(l), -1, 2)
    o = o.reshape(n, nb * BLK, hkv, g, hd)[:, :L].astype(q.dtype)
    lse = lse.reshape(n, nb * BLK, hkv, g)[:, :L]
    return o, lse


def _swa_sink_attention(q, k, v, bias, sink):
    B, S, _ = q.shape
    q = q.reshape(B, S, A_HKV, A_G, HEAD_DIM)
    k = k.reshape(B, S, A_HKV, HEAD_DIM)
    v = v.reshape(B, S, A_HKV, HEAD_DIM)
    o, _ = _banded_attention(q, k, v, A_WINDOW - 1, bias, sink.reshape(A_HKV, A_G))
    return o.reshape(B, S, A_HQ * HEAD_DIM)


def _fold(t, dil):
    B, S = t.shape[:2]
    rest = t.shape[2:]
    return jnp.swapaxes(t.reshape(B, S // dil, dil, *rest), 1, 2).reshape(B * dil, S // dil, *rest)


def _unfold(t, B, dil):
    L = t.shape[1]
    rest = t.shape[2:]
    return jnp.swapaxes(t.reshape(B, dil, L, *rest), 1, 2).reshape(B, L * dil, *rest)


def _dilated_mixture(q, k, v, biases):
    B, S, _ = q.shape
    shp = (B, S, len(C_GROUPS), C_HG, HEAD_DIM)
    q, k, v = q.reshape(shp), k.reshape(shp), v.reshape(shp)
    outs, lses = [], []
    for gi, ((win, dil), bias) in enumerate(zip(C_GROUPS, biases)):
        o, lse = _banded_attention(_fold(q[:, :, gi], dil)[:, :, :, None], _fold(k[:, :, gi], dil),
                                   _fold(v[:, :, gi], dil), win // dil, bias, None)
        outs.append(_unfold(o[:, :, :, 0], B, dil).astype(jnp.float32))
        lses.append(_unfold(lse[..., 0], B, dil))
    wts = jax.nn.softmax(jnp.stack(lses), axis=0)
    y = jnp.sum(wts[..., None] * jnp.stack(outs), axis=0)
    return y.reshape(B, S, C_OUT).astype(q.dtype)


def _wkv7_scan(r, w, k, v, a, b):
    B, S, H, N = r.shape

    def step(state, inp):
        r_t, w_t, k_t, v_t, a_t, b_t = inp
        sa = jnp.einsum('bhvk,bhk->bhv', state, a_t)
        state = state * w_t[:, :, None, :] + sa[..., None] * b_t[:, :, None, :] + v_t[..., None] * k_t[:, :, None, :]
        return state, jnp.einsum('bhvk,bhk->bhv', state, r_t)

    xs = tuple(jnp.swapaxes(t, 0, 1) for t in (r, w, k, v, a, b))
    _, ys = lax.scan(step, jnp.zeros((B, H, N, N), jnp.float32), xs)
    return jnp.swapaxes(ys, 0, 1)


def _rwkv7_time_mix(pb, mu, w0, w_up, a0, a_up, g_up, k_k, k_a, r_k, lnx_g, lnx_b):
    B, S, _ = pb.shape
    pf = pb.astype(jnp.float32)
    pf = pf + (_shift(pf) - pf) * mu
    r, k, v, wd, ad, gd = _split(pf, B_COL_SIZES)
    w = -jax.nn.softplus(-(w0 + jnp.tanh(wd) @ w_up)) - 0.5
    a = jax.nn.sigmoid(a0 + ad @ a_up)
    g = jax.nn.sigmoid(gd) @ g_up
    heads = lambda t: t.reshape(B, S, B_HEADS, HEAD_DIM)
    kk = heads(k * k_k)
    kk = kk / jnp.maximum(jnp.sqrt(jnp.sum(kk * kk, axis=-1, keepdims=True)), 1e-12)
    k = k * (1.0 + (a - 1.0) * k_a)
    r, k, v, a = heads(r), heads(k), heads(v), heads(a)
    y = _wkv7_scan(r, jnp.exp(-jnp.exp(heads(w))), k, v, -kk, kk * a)
    mean = jnp.mean(y, axis=-1, keepdims=True)
    var = jnp.mean(jnp.square(y - mean), axis=-1, keepdims=True)
    y = ((y - mean) * lax.rsqrt(var + B_GN_EPS)).reshape(B, S, B_WIDTH) * lnx_g + lnx_b
    y = y + (jnp.sum(r * k * r_k, axis=-1, keepdims=True) * v).reshape(B, S, B_WIDTH)
    return (y * g).astype(pb.dtype)


def _conv_ffn(h, w_up, conv_w, w_down):
    u = h @ w_up
    gate, val = jnp.split(u, 2, axis=-1)
    gp = jnp.pad(gate, ((0, 0), (CONV_W - 1, 0), (0, 0)))
    S = gate.shape[1]
    gate = conv_w[0] * gp[:, 0:S] + conv_w[1] * gp[:, 1:S + 1] + conv_w[2] * gp[:, 2:S + 2]
    return (jax.nn.silu(gate) * val) @ w_down


def setup_inputs(seed: int = 0) -> dict:
    key = jax.random.key(seed)
    ks = jax.random.split(key, 26)
    nrm = lambda kk, shape, scale: jax.random.normal(kk, shape, jnp.float32) * scale
    L = DEPTH
    return {
        'x': nrm(ks[0], (BATCH, SEQ, D_MODEL), 1.0),
        'rel_bias': nrm(ks[1], (N_BUCKETS, N_BIAS_HEADS), 0.3),
        'norm1_g': 1.0 + nrm(ks[2], (L, D_MODEL), 0.02),
        'w_in': nrm(ks[3], (L, D_MODEL, D_IN), D_MODEL ** -0.5),
        'attn_sinks': nrm(ks[4], (L, A_HQ), 0.5),
        'rwkv_mu': jax.random.uniform(ks[5], (L, B_COLS), jnp.float32),
        'rwkv_w0': -0.5 + nrm(ks[6], (L, B_WIDTH), 0.5),
        'rwkv_w_up': nrm(ks[7], (L, LORA_DECAY, B_WIDTH), 0.5 * LORA_DECAY ** -0.5),
        'rwkv_a0': nrm(ks[8], (L, B_WIDTH), 0.1),
        'rwkv_a_up': nrm(ks[9], (L, LORA_ICLR, B_WIDTH), 0.5 * LORA_ICLR ** -0.5),
        'rwkv_g_up': nrm(ks[10], (L, LORA_GATE, B_WIDTH), 2.0 * LORA_GATE ** -0.5),
        'rwkv_k_k': 0.85 + nrm(ks[11], (L, B_WIDTH), 0.05),
        'rwkv_k_a': 1.0 + nrm(ks[12], (L, B_WIDTH), 0.05),
        'rwkv_r_k': nrm(ks[13], (L, B_HEADS, HEAD_DIM), 0.1),
        'rwkv_lnx_g': 1.0 + nrm(ks[14], (L, B_WIDTH), 0.02),
        'rwkv_lnx_b': nrm(ks[15], (L, B_WIDTH), 0.02),
        'proj_a': nrm(ks[16], (L, A_HQ * HEAD_DIM, D_MODEL), (A_HQ * HEAD_DIM) ** -0.5),
        'proj_b': nrm(ks[17], (L, B_WIDTH, D_MODEL), B_WIDTH ** -0.5),
        'proj_c': nrm(ks[18], (L, C_OUT, D_MODEL), C_OUT ** -0.5),
        'w_out': nrm(ks[19], (L, D_MODEL, D_MODEL), D_MODEL ** -0.5),
        'norm2_g': 1.0 + nrm(ks[20], (L, D_MODEL), 0.02),
        'ffn_up': nrm(ks[21], (L, D_MODEL, 2 * D_FF), D_MODEL ** -0.5),
        'ffn_conv': nrm(ks[22], (L, CONV_W, D_FF), 0.6),
        'ffn_down': nrm(ks[23], (L, D_FF, D_MODEL), D_FF ** -0.5),
        'final_g': 1.0 + nrm(ks[24], (D_MODEL,), 0.02),
    }


def reference(x, rel_bias, norm1_g, w_in, attn_sinks, rwkv_mu, rwkv_w0, rwkv_w_up, rwkv_a0, rwkv_a_up,
              rwkv_g_up, rwkv_k_k, rwkv_k_a, rwkv_r_k, rwkv_lnx_g, rwkv_lnx_b, proj_a, proj_b, proj_c,
              w_out, norm2_g, ffn_up, ffn_conv, ffn_down, final_g):
    bias_a = _rel_bias(rel_bias[:, :A_HQ], 1).reshape(A_HKV, A_G, BLK, 2 * BLK)
    bias_c = [_rel_bias(rel_bias[:, A_HQ + gi * C_HG:A_HQ + (gi + 1) * C_HG], dil)[:, None]
              for gi, (_, dil) in enumerate(C_GROUPS)]
    for l in range(DEPTH):
        h = _rmsnorm(x, norm1_g[l])
        aq, ak, av, pb, cq, ck, cv, gates = _split(h @ w_in[l], IN_COL_SIZES)
        y_a = _swa_sink_attention(aq, ak, av, bias_a, attn_sinks[l])
        y_b = _rwkv7_time_mix(pb, rwkv_mu[l], rwkv_w0[l], rwkv_w_up[l], rwkv_a0[l], rwkv_a_up[l],
                              rwkv_g_up[l], rwkv_k_k[l], rwkv_k_a[l], rwkv_r_k[l], rwkv_lnx_g[l], rwkv_lnx_b[l])
        y_c = _dilated_mixture(cq, ck, cv, bias_c)
        g_a, g_b, g_c = jnp.split(jax.nn.sigmoid(gates.astype(jnp.float32)).astype(h.dtype), N_BRANCH, axis=-1)
        merged = g_a * (y_a @ proj_a[l]) + g_b * (y_b @ proj_b[l]) + g_c * (y_c @ proj_c[l])
        x = x + merged @ w_out[l]
        x = x + _conv_ffn(_rmsnorm(x, norm2_g[l]), ffn_up[l], ffn_conv[l], ffn_down[l])
    return _rmsnorm(x, final_g)
```

```cpp
#include <hip/hip_runtime.h>
#include <cstdio>
#include <cstdint>
#include <cmath>
#define GAS __attribute__((address_space(1)))
#define LAS __attribute__((address_space(3)))
namespace pg8 {
#define PG8_LAS __attribute__((address_space(3)))
typedef unsigned short bf16_t;
typedef short bf16x8 __attribute__((ext_vector_type(8)));
typedef float f32x4 __attribute__((ext_vector_type(4)));
typedef unsigned u32x4 __attribute__((ext_vector_type(4)));
constexpr int BM = 256, BK = 64, HALF = 128, HTB = HALF * BK * 2  , STAGE_BYTES = 8 * HTB, NXCD = 8, WGM = 8;

__host__ __device__ __forceinline__ int lds_byte(int r, int c) { const int st = (r >> 4) * 2 + (c >> 5), rr = r & 15, cc = c & 31, ob = rr * 64 + cc * 2; return st * 1024 + (ob ^ (((ob >> 9) & 1) << 5)); }
__host__ __device__ __forceinline__ void stage_rc(int b, int& R, int& C) { const int st = b / 1024, sb = b % 1024, swz = sb ^ (((sb >> 9) & 1) << 5); R = (st >> 1) * 16 + swz / 64; C = (st & 1) * 32 + (swz % 64) / 2; }
__host__ __device__ __forceinline__ int perm32(int rho) { const int n = rho >> 4, i = rho & 15; return 8 * (i >> 2) + 4 * n + (i & 3); }

struct Unit { int pm, pn; };
struct Gemm { const bf16_t* A; const bf16_t* Bt; int M, N, K; };

struct StaticOrder {
    int nM, nN, nwg, G, c;
    __host__ __device__ void init(int M, int N, int G_, int c_) { nM = M / BM; nN = N / BM; nwg = nM * nN; G = G_; c = c_; }
    __host__ __device__ bool next(int i, Unit& u) const {
        const long L = (long)i * G + c; if (L >= nwg) return false;
        int wgid = (int)L; { const int q = nwg / NXCD, r = nwg % NXCD, xcd = wgid % NXCD, off = wgid / NXCD; wgid = (xcd < r ? xcd * (q + 1) : r * (q + 1) + (xcd - r) * q) + off; }
        const int nig = WGM * nN, gid = wgid / nig, fm = gid * WGM, gsz = (nM - fm) < WGM ? (nM - fm) : WGM;
        u.pm = fm + ((wgid % nig) % gsz); u.pn = (wgid % nig) / gsz; return true;
    }
    __device__ __forceinline__ void a_ready(const Unit&) const {}
    __device__ __forceinline__ void done(const Unit&) const {}
};
__device__ __forceinline__ unsigned cvt_pk_bf16(float lo, float hi) { unsigned r; asm volatile("v_cvt_pk_bf16_f32 %0, %1, %2" : "=v"(r) : "v"(lo), "v"(hi)); return r; }
template <class Epi, class Sched, bool ALIGN_EPI = false, bool SP2 = false>
__device__ __forceinline__ void gemm_phase(PG8_LAS unsigned char* lds, const Gemm g, const Sched& S, const Epi& E) {
    const int tid = threadIdx.x, wid = __builtin_amdgcn_readfirstlane(tid >> 6), lane = tid & 63, wr = wid >> 2, wc = wid & 3, fr = lane & 15, fq = lane >> 4;
    const int K = g.K, nt = K / BK;
    unsigned voffA[2], voffB[2];
#pragma unroll
    for (int i = 0; i < 2; ++i) { int R, C; stage_rc(tid * 16 + i * 8192, R, C); const int Rb = Epi::PERM ? ((R & ~31) + perm32(R & 31)) : R;
        voffA[i] = (unsigned)(R * K + C) * 2u; voffB[i] = (unsigned)(Rb * K + C) * 2u; }
    const size_t kstep = (size_t)(BK * 2);
    const size_t hstep = (size_t)HALF * K * 2;
    const size_t tstep = 2 * hstep;
    const unsigned ldsw = (unsigned)wid * 1024u;
    const int aoff = lds_byte(wr * 64 + fr, fq * 8), boff = lds_byte(wc * 32 + fr, fq * 8);
#define PG8_SA(b, h) (((b) * 2 + (h)) * HTB)
#define PG8_SB(b, h) ((4 + (b) * 2 + (h)) * HTB)
#define PG8_STAGE(bufoff, gbase, voff) do { _Pragma("unroll") for (int _i = 0; _i < 2; ++_i) \
        __builtin_amdgcn_global_load_lds((const unsigned*)((const char*)(gbase) + (voff)[_i]), (PG8_LAS unsigned*)(lds + (bufoff) + ldsw + _i * 8192), 16, 0, 0); } while (0)
#define PG8_LDA(dst, b, h) do { _Pragma("unroll") for (int m = 0; m < 4; ++m) _Pragma("unroll") for (int k = 0; k < 2; ++k) dst[m][k] = *(const PG8_LAS bf16x8*)(lds + PG8_SA(b, h) + aoff + m * 2048 + k * 1024); } while (0)
#define PG8_LDB(dst, b, h) do { _Pragma("unroll") for (int n = 0; n < 2; ++n) _Pragma("unroll") for (int k = 0; k < 2; ++k) dst[n][k] = *(const PG8_LAS bf16x8*)(lds + PG8_SB(b, h) + boff + n * 2048 + k * 1024); } while (0)
#define PG8_MMA(ai, bj, At, Bt) do { __builtin_amdgcn_s_setprio(1); _Pragma("unroll") for (int m = 0; m < 4; ++m) _Pragma("unroll") for (int n = 0; n < 2; ++n) _Pragma("unroll") for (int k = 0; k < 2; ++k) \
        acc[ai][bj][m][n] = __builtin_amdgcn_mfma_f32_16x16x32_bf16(Bt[n][k], At[m][k], acc[ai][bj][m][n], 0, 0, 0); __builtin_amdgcn_s_setprio(0); } while (0)
#define PG8_WAIT_V(n) asm volatile("s_waitcnt vmcnt(" #n ")" ::: "memory")
#define PG8_WAIT_L(n) asm volatile("s_waitcnt lgkmcnt(" #n ")" ::: "memory")
#define PG8_BAR __builtin_amdgcn_s_barrier()
#define PG8_SCHED __builtin_amdgcn_sched_barrier(0)
    Unit cur, nxt; int ui = 0;
    if (!S.next(0, cur)) return;
    f32x4 acc[2][2][4][2];
#pragma unroll
    for (int a = 0; a < 2; ++a)
#pragma unroll
        for (int b = 0; b < 2; ++b)
#pragma unroll
            for (int m = 0; m < 4; ++m)
#pragma unroll
                for (int n = 0; n < 2; ++n) acc[a][b][m][n] = (f32x4){0.f, 0.f, 0.f, 0.f};
    bf16x8 At[4][2], B0[2][2], B1[2][2];
    const char* cA = (const char*)g.A + (size_t)cur.pm * tstep; const char* cB = (const char*)g.Bt + (size_t)cur.pn * tstep;
    S.a_ready(cur);
    if constexpr (SP2) {
        PG8_STAGE(PG8_SB(0, 0), cB, voffB); PG8_STAGE(PG8_SB(0, 1), cB + hstep, voffB); PG8_STAGE(PG8_SA(0, 0), cA, voffA); PG8_STAGE(PG8_SA(0, 1), cA + hstep, voffA);
        if (wr == 1) PG8_BAR;
        PG8_WAIT_V(2); PG8_BAR;
        PG8_STAGE(PG8_SB(1, 0), cB + kstep, voffB); PG8_STAGE(PG8_SA(1, 0), cA + kstep, voffA); PG8_STAGE(PG8_SB(1, 1), cB + hstep + kstep, voffB);
        PG8_WAIT_V(6); PG8_BAR;
    } else {
        PG8_STAGE(PG8_SB(0, 0), cB, voffB); PG8_STAGE(PG8_SA(0, 0), cA, voffA); PG8_STAGE(PG8_SB(0, 1), cB + hstep, voffB); PG8_STAGE(PG8_SA(0, 1), cA + hstep, voffA);
        if (wr == 1) PG8_BAR;
        PG8_WAIT_V(4); PG8_BAR;
        PG8_STAGE(PG8_SB(1, 0), cB + kstep, voffB); PG8_STAGE(PG8_SA(1, 0), cA + kstep, voffA); PG8_STAGE(PG8_SB(1, 1), cB + hstep + kstep, voffB);
        PG8_WAIT_V(6); PG8_BAR;
    }
    for (;;) {
        const bool has_next = S.next(ui + 1, nxt);
        const char* nA = has_next ? (const char*)g.A + (size_t)nxt.pm * tstep : cA; const char* nB = has_next ? (const char*)g.Bt + (size_t)nxt.pn * tstep : cB;
        for (int t = 0; t < nt; t += 2) {
            const bool last = (t == nt - 2);
            const char* a1 = cA + (size_t)(t + 1) * kstep;
            const char* a2 = last ? nA : cA + (size_t)(t + 2) * kstep; const char* b2 = last ? nB : cB + (size_t)(t + 2) * kstep;
            const char* a3 = a2 + kstep; const char* b3 = b2 + kstep;
            if (last && has_next) S.a_ready(nxt);
            if constexpr (SP2) {
            PG8_LDB(B0, 0, 0); PG8_LDB(B1, 0, 1); PG8_SCHED; PG8_LDA(At, 0, 0); PG8_STAGE(PG8_SA(1, 1), a1 + hstep, voffA);
            PG8_WAIT_V(8); PG8_WAIT_L(0); PG8_BAR; PG8_MMA(0, 0, At, B0); PG8_MMA(0, 1, At, B1); PG8_BAR; PG8_SCHED;
            PG8_LDA(At, 0, 1); PG8_STAGE(PG8_SB(0, 0), b2, voffB); PG8_STAGE(PG8_SB(0, 1), b2 + hstep, voffB); PG8_STAGE(PG8_SA(0, 0), a2, voffA);
            PG8_WAIT_V(8); PG8_WAIT_L(0); PG8_BAR; PG8_MMA(1, 0, At, B0); PG8_MMA(1, 1, At, B1); PG8_BAR; PG8_SCHED;
            PG8_LDB(B0, 1, 0); PG8_LDB(B1, 1, 1); PG8_SCHED; PG8_LDA(At, 1, 0); PG8_STAGE(PG8_SA(0, 1), a2 + hstep, voffA);
            PG8_WAIT_V(8); PG8_WAIT_L(0); PG8_BAR; PG8_MMA(0, 0, At, B0); PG8_MMA(0, 1, At, B1); PG8_BAR; PG8_SCHED;
            PG8_LDA(At, 1, 1); PG8_STAGE(PG8_SB(1, 0), b3, voffB); PG8_STAGE(PG8_SB(1, 1), b3 + hstep, voffB); PG8_STAGE(PG8_SA(1, 0), a3, voffA);
            PG8_WAIT_V(8); PG8_WAIT_L(0); PG8_BAR; PG8_MMA(1, 0, At, B0); PG8_MMA(1, 1, At, B1); PG8_BAR; PG8_SCHED;
            } else {
            PG8_LDB(B0, 0, 0); PG8_SCHED; PG8_LDA(At, 0, 0); PG8_STAGE(PG8_SA(1, 1), a1 + hstep, voffA);
            PG8_WAIT_L(8); PG8_BAR; PG8_WAIT_L(0); PG8_MMA(0, 0, At, B0); PG8_BAR; PG8_SCHED;
            PG8_LDB(B1, 0, 1); PG8_STAGE(PG8_SB(0, 0), b2, voffB);
            PG8_BAR; PG8_WAIT_L(0); PG8_MMA(0, 1, At, B1); PG8_BAR;
            PG8_LDA(At, 0, 1); PG8_STAGE(PG8_SA(0, 0), a2, voffA);
            PG8_BAR; PG8_WAIT_L(0); PG8_MMA(1, 0, At, B0); PG8_BAR; PG8_SCHED;
            PG8_STAGE(PG8_SB(0, 1), b2 + hstep, voffB);
            PG8_WAIT_V(6); PG8_BAR; PG8_MMA(1, 1, At, B1); PG8_BAR;
            PG8_LDB(B0, 1, 0); PG8_SCHED; PG8_LDA(At, 1, 0); PG8_STAGE(PG8_SA(0, 1), a2 + hstep, voffA);
            PG8_WAIT_L(8); PG8_BAR; PG8_WAIT_L(0); PG8_MMA(0, 0, At, B0); PG8_BAR; PG8_SCHED;
            PG8_LDB(B1, 1, 1); PG8_STAGE(PG8_SB(1, 0), b3, voffB);
            PG8_BAR; PG8_WAIT_L(0); PG8_MMA(0, 1, At, B1); PG8_BAR;
            PG8_LDA(At, 1, 1); PG8_STAGE(PG8_SA(1, 0), a3, voffA);
            PG8_BAR; PG8_WAIT_L(0); PG8_MMA(1, 0, At, B0); PG8_BAR; PG8_SCHED;
            PG8_STAGE(PG8_SB(1, 1), b3 + hstep, voffB);
            PG8_WAIT_V(6); PG8_BAR; PG8_MMA(1, 1, At, B1); PG8_BAR;
            }
        }
        if constexpr (ALIGN_EPI) { if (wr == 0) PG8_BAR; }
        if constexpr (!Epi::AFTER_DRAIN) { E(acc, cur, wr, wc, fr, fq); S.done(cur); }
        if (!has_next) break;
#pragma unroll
        for (int a = 0; a < 2; ++a)
#pragma unroll
            for (int b = 0; b < 2; ++b)
#pragma unroll
                for (int m = 0; m < 4; ++m)
#pragma unroll
                    for (int n = 0; n < 2; ++n) acc[a][b][m][n] = (f32x4){0.f, 0.f, 0.f, 0.f};
        cur = nxt; cA = nA; cB = nB; ++ui;
        if constexpr (ALIGN_EPI) { if (wr == 1) PG8_BAR; }
    }
    PG8_WAIT_V(0);
    if constexpr (!ALIGN_EPI) { if (wr == 0) PG8_BAR; }
    PG8_BAR;
    if constexpr (Epi::AFTER_DRAIN) { E.fused(acc, cur, wr, wc, fr, fq, lds, wid, lane); S.done(cur); }
#undef PG8_SA
#undef PG8_SB
#undef PG8_STAGE
#undef PG8_LDA
#undef PG8_LDB
#undef PG8_MMA
#undef PG8_WAIT_V
#undef PG8_WAIT_L
#undef PG8_BAR
#undef PG8_SCHED
}
}
#define XB_TMO      128
#define XB_XCNT(j)  (256  + 64 * (j))
#define XB_XSUB(j)  (1280 + 64 * (j))
#define XB_XGEN(j)  (2304 + 64 * (j))
#define XB_TOP      3328
#define XB_TOPGEN   3392
#define XCD_BAR_WORDS 3456
#define XB_SPIN_CAP (1u << 18)

__device__ __forceinline__ unsigned xb_ld(unsigned* p)              { return __hip_atomic_load(p, __ATOMIC_RELAXED, __HIP_MEMORY_SCOPE_AGENT); }
__device__ __forceinline__ unsigned xb_add(unsigned* p, unsigned v) { return __hip_atomic_fetch_add(p, v, __ATOMIC_RELAXED, __HIP_MEMORY_SCOPE_AGENT); }
__device__ __forceinline__ unsigned xb_xcc_id() { return (unsigned)__builtin_amdgcn_s_getreg((3 << 11) | 20) & 0xFu; }
#define XB_SPIN(cond, bar) do { unsigned _sp = 0; while (cond) { __builtin_amdgcn_s_sleep(1); \
    if ((++_sp & 255u) == 0u) { if (xb_ld(&(bar)[XB_TMO])) break; if (_sp > XB_SPIN_CAP) { atomicAdd(&(bar)[XB_TMO], 1u); break; } } } } while (0)

struct XcdBarrier {
    unsigned* bar; unsigned x;
    volatile LAS unsigned* st;
};

__device__ __forceinline__ XcdBarrier xcd_barrier_post(unsigned* bar, volatile LAS unsigned* st) {
    XcdBarrier b; b.bar = bar; b.x = xb_xcc_id(); b.st = st;
    if (threadIdx.x == 0) (void)xb_add(&bar[XB_XCNT(b.x)], 1u);
    return b;
}
__device__ __forceinline__ void xcd_barrier_complete(unsigned* bar, unsigned x, unsigned& nloc, unsigned& nx) {
    const unsigned G = gridDim.x * gridDim.y * gridDim.z;
    unsigned sum, cnt, mine, sp = 0u;
    for (;;) {
        sum = 0u; cnt = 0u; mine = 0u;
#pragma unroll
        for (unsigned j = 0; j < 16; ++j) { const unsigned c = xb_ld(&bar[XB_XCNT(j)]); sum += c; cnt += (c > 0u) ? 1u : 0u; mine = (j == x) ? c : mine; }
        if (sum == G) break;
        __builtin_amdgcn_s_sleep(1);
        if ((++sp & 255u) == 0u) { if (xb_ld(&bar[XB_TMO])) break; if (sp > XB_SPIN_CAP) { atomicAdd(&bar[XB_TMO], 1u); break; } }
    }
    nloc = mine > 0u ? mine : 1u; nx = cnt > 0u ? cnt : 1u;
}

__device__ __forceinline__ void xcd_barrier(const XcdBarrier& b) {
    asm volatile("s_waitcnt vmcnt(0)" ::: "memory");
    __syncthreads();
    if (threadIdx.x == 0) {
        unsigned* bar = b.bar;
        __builtin_amdgcn_s_waitcnt(0);
        unsigned nloc = b.st[0], nx = b.st[1];
        if (nloc == 0u) { xcd_barrier_complete(bar, b.x, nloc, nx); b.st[0] = nloc; b.st[1] = nx; }
        const unsigned old = xb_add(&bar[XB_XSUB(b.x)], 1u);
        const unsigned gen = old / nloc;
        if (old + 1u == (gen + 1u) * nloc) {
            __builtin_amdgcn_fence(__ATOMIC_RELEASE, "agent");
            asm volatile("s_waitcnt vmcnt(0)" ::: "memory");
            const unsigned og = xb_add(&bar[XB_TOP], 1u);
            const unsigned tg = og / nx;
            if (og + 1u == (tg + 1u) * nx) xb_add(&bar[XB_TOPGEN], 1u);
            else XB_SPIN(xb_ld(&bar[XB_TOPGEN]) == tg, bar);
            __builtin_amdgcn_fence(__ATOMIC_ACQUIRE, "agent");
            xb_add(&bar[XB_XGEN(b.x)], 1u);
            asm volatile("s_waitcnt vmcnt(0)" ::: "memory");
        } else {
            XB_SPIN(xb_ld(&bar[XB_XGEN(b.x)]) == gen, bar);
            __builtin_amdgcn_fence(__ATOMIC_ACQUIRE, "agent");
            asm volatile("s_waitcnt vmcnt(0)" ::: "memory");
        }
    }
    __syncthreads();
}

constexpr int BATCH = 2, SEQ = 8192, M = BATCH * SEQ, D = 2048, DEPTH = 4;
constexpr int DIN = 11968, NP1 = 5888, NG = 6144, NWIN = NP1 + NG;
constexpr int BW = 768, BCOLS = 2752;
constexpr int C_AQ = 0, C_AK = 512, C_AV = 640, C_R = 768, C_K = 1536, C_V = 2304, C_WD = 3072, C_CQ = 3520, C_CK = 4288, C_CV = 5056, C_END = 5824;
constexpr int DFF = 5504, NUP = 2 * DFF;
constexpr int NLORA = 2304, KLORA = 512;
constexpr float NORM_EPS = 1e-5f, GN_EPS = 64e-5f;
constexpr int NWAVES = 8, NTHREADS = 512;
constexpr int NPH = 13;
constexpr int NPHASES = DEPTH * NPH + 1;
constexpr int NSCAN = 48;

constexpr size_t MiB = 1u << 20;
constexpr size_t WS_CTL = 0, CTL_ZERO_BYTES = 1 * MiB;
constexpr size_t WS_WIN = 1 * MiB;
constexpr size_t WS_WLORA = 48 * MiB;
constexpr size_t WS_PA = 51 * MiB;
constexpr size_t WS_PB = 53 * MiB;
constexpr size_t WS_PC = 56 * MiB;
constexpr size_t WS_WOUT = 57 * MiB;
constexpr size_t WS_WUP = 65 * MiB;
constexpr size_t WS_WDOWN = 108 * MiB;
constexpr size_t WS_H = 130 * MiB;
constexpr size_t WS_P1 = 194 * MiB;
constexpr size_t WS_G = 378 * MiB;
constexpr size_t WS_U = WS_P1;
constexpr size_t WS_AP = 570 * MiB;
constexpr size_t WS_LO = 586 * MiB;
constexpr size_t WS_ACT = WS_LO;
constexpr size_t WS_SR = 730 * MiB;
constexpr size_t WS_SW = 778 * MiB, WS_SK = 826 * MiB, WS_SKK = 874 * MiB, WS_SB = 922 * MiB, WS_SV = 970 * MiB;
constexpr size_t WS_YRAW = 1018 * MiB;
constexpr size_t WS_YA = 1066 * MiB;
constexpr size_t WS_YB = 1082 * MiB;
constexpr size_t WS_YC = 1106 * MiB;
constexpr size_t WS_OC = 1114 * MiB;
constexpr size_t WS_LSE = 1138 * MiB;
constexpr size_t WS_MG = 1139 * MiB;
constexpr size_t WS_END = 1203 * MiB;
constexpr int CW_BAR = 4096;

constexpr int RING_OFF = 0, RING_BYTES = 131072;
constexpr int LDSCTL_OFF = RING_BYTES, MISC_OFF = LDSCTL_OFF + 320;
constexpr int LDS_BYTES = 147456;

typedef unsigned short bf16;
typedef unsigned v4u __attribute__((ext_vector_type(4)));
typedef unsigned v2u __attribute__((ext_vector_type(2)));
typedef float f32x4 __attribute__((ext_vector_type(4)));
#define LDS_WAIT() asm volatile("s_waitcnt lgkmcnt(0)" ::: "memory")

__device__ __forceinline__ unsigned f2bf(float f) { unsigned u = __builtin_bit_cast(unsigned, f); return (u + 0x7fffu + ((u >> 16) & 1u)) >> 16; }
__device__ __forceinline__ unsigned pk2(float lo, float hi) { return f2bf(lo) | (f2bf(hi) << 16); }
__device__ __forceinline__ float bflo(unsigned w) { return __builtin_bit_cast(float, w << 16); }
__device__ __forceinline__ float bfhi(unsigned w) { return __builtin_bit_cast(float, w & 0xffff0000u); }
__device__ __forceinline__ float bf1(bf16 h) { return __builtin_bit_cast(float, ((unsigned)h) << 16); }
__device__ __forceinline__ float sigmoidf_(float x) { return 1.0f / (1.0f + __expf(-x)); }
__device__ __forceinline__ float wave_sum(float v) {
#pragma unroll
    for (int o = 1; o < 64; o <<= 1) v += __shfl_xor(v, o);
    return v;
}
template <int CTRL> __device__ __forceinline__ float dppf(float x) { return __builtin_bit_cast(float, __builtin_amdgcn_update_dpp(0, __builtin_bit_cast(int, x), CTRL, 0xF, 0xF, true)); }
__device__ __forceinline__ float red4(float x) { x += dppf<0xB1>(x); x += dppf<0x4E>(x); return x; }
__device__ __forceinline__ float red16(float x) { x = red4(x); x += dppf<0x141>(x); x += dppf<0x140>(x); return x; }

__device__ const unsigned char T5B[3][132] = {
 {0,1,2,3,4,5,6,7,8,9,10,11,12,13,14,15,16,16,16,16,16,16,17,17,17,17,17,17,17,17,18,18,18,18,18,18,18,18,18,18,19,19,19,19,19,19,19,19,19,19,19,19,19,19,20,20,20,20,20,20,20,20,20,20,20,20,20,20,20,20,20,20,20,21,21,21,21,21,21,21,21,21,21,21,21,21,21,21,21,21,21,21,21,21,21,21,21,21,21,22,22,22,22,22,22,22,22,22,22,22,22,22,22,22,22,22,22,22,22,22,22,22,22,22,22,22,22,22,22,0,0,0},
 {0,4,8,12,16,16,17,17,18,18,19,19,19,19,20,20,20,20,20,21,21,21,21,21,21,22,22,22,22,22,22,22,22,22,23,23,23,23,23,23,23,23,23,23,23,23,24,24,24,24,24,24,24,24,24,24,24,24,24,24,24,24,25,25,25,25,25,25,25,25,25,25,25,25,25,25,25,25,25,25,25,25,25,26,26,26,26,26,26,26,26,26,26,26,26,26,26,26,26,26,26,26,26,26,26,26,26,26,26,26,26,26,26,27,27,27,27,27,27,27,27,27,27,27,27,27,27,27,27,0,0,0},
 {0,16,18,19,20,21,21,22,22,23,23,23,24,24,24,24,25,25,25,25,25,26,26,26,26,26,26,26,26,27,27,27,27,27,27,27,27,27,27,28,28,28,28,28,28,28,28,28,28,28,28,28,29,29,29,29,29,29,29,29,29,29,29,29,29,29,29,29,29,29,30,30,30,30,30,30,30,30,30,30,30,30,30,30,30,30,30,30,30,30,30,30,30,30,30,31,31,31,31,31,31,31,31,31,31,31,31,31,31,31,31,31,31,31,31,31,31,31,31,31,31,31,31,31,31,31,31,31,31,0,0,0}};

namespace pg8 {
struct EpiWin {
    static constexpr bool PERM = true, AFTER_DRAIN = false;
    bf16_t* P1; bf16_t* G;
    __device__ __forceinline__ void operator()(const f32x4 (&acc)[2][2][4][2], const Unit& u, int wr, int wc, int fr, int fq) const {
        const int row0 = u.pm * BM + wr * 64 + fr; const bool gate = u.pn >= 23;
        bf16_t* base = gate ? G : P1; const int ldc = gate ? 6144 : 5888; const int col0 = (gate ? (u.pn - 23) : u.pn) * BM + wc * 32 + 8 * fq;
#pragma unroll
        for (int ai = 0; ai < 2; ++ai)
#pragma unroll
            for (int m = 0; m < 4; ++m) { bf16_t* rowp = base + (size_t)(row0 + ai * HALF + m * 16) * ldc + col0;
#pragma unroll
                for (int bj = 0; bj < 2; ++bj) { f32x4 v0 = acc[ai][bj][m][0], v1 = acc[ai][bj][m][1];
                    if (gate) {
#pragma unroll
                        for (int j = 0; j < 4; ++j) { v0[j] = __builtin_amdgcn_rcpf(1.0f + __expf(-v0[j])); v1[j] = __builtin_amdgcn_rcpf(1.0f + __expf(-v1[j])); } }
                    u32x4 w; w.x = cvt_pk_bf16(v0[0], v0[1]); w.y = cvt_pk_bf16(v0[2], v0[3]); w.z = cvt_pk_bf16(v1[0], v1[1]); w.w = cvt_pk_bf16(v1[2], v1[3]);
                    *(u32x4*)(rowp + bj * HALF) = w; } }
    }
};
struct EpiBf16P {
    static constexpr bool PERM = true, AFTER_DRAIN = false;
    bf16_t* O; int ldc;
    __device__ __forceinline__ void operator()(const f32x4 (&acc)[2][2][4][2], const Unit& u, int wr, int wc, int fr, int fq) const {
        const int row0 = u.pm * BM + wr * 64 + fr; const int col0 = u.pn * BM + wc * 32 + 8 * fq;
#pragma unroll
        for (int ai = 0; ai < 2; ++ai)
#pragma unroll
            for (int m = 0; m < 4; ++m) { bf16_t* rowp = O + (size_t)(row0 + ai * HALF + m * 16) * ldc + col0;
#pragma unroll
                for (int bj = 0; bj < 2; ++bj) { const f32x4 v0 = acc[ai][bj][m][0], v1 = acc[ai][bj][m][1];
                    u32x4 w; w.x = cvt_pk_bf16(v0[0], v0[1]); w.y = cvt_pk_bf16(v0[2], v0[3]); w.z = cvt_pk_bf16(v1[0], v1[1]); w.w = cvt_pk_bf16(v1[2], v1[3]);
                    *(u32x4*)(rowp + bj * HALF) = w; } }
    }
};
struct EpiF32P {
    static constexpr bool PERM = false, AFTER_DRAIN = false;
    float* C; int ldc;
    __device__ __forceinline__ void operator()(const f32x4 (&acc)[2][2][4][2], const Unit& u, int wr, int wc, int fr, int fq) const {
        const int row0 = u.pm * BM + wr * 64 + fr, col0 = u.pn * BM + wc * 32 + 4 * fq;
#pragma unroll
        for (int ai = 0; ai < 2; ++ai)
#pragma unroll
            for (int m = 0; m < 4; ++m) { float* rowp = C + (size_t)(row0 + ai * HALF + m * 16) * ldc + col0;
#pragma unroll
                for (int bj = 0; bj < 2; ++bj)
#pragma unroll
                    for (int n = 0; n < 2; ++n) *(f32x4*)(rowp + bj * HALF + n * 16) = acc[ai][bj][m][n]; }
    }
};
struct EpiResid {
    static constexpr bool PERM = false, AFTER_DRAIN = false;
    const float* xin; float* out;
    __device__ __forceinline__ void operator()(const f32x4 (&acc)[2][2][4][2], const Unit& u, int wr, int wc, int fr, int fq) const {
        const int row0 = u.pm * BM + wr * 64 + fr, col0 = u.pn * BM + wc * 32 + 4 * fq;
#pragma unroll
        for (int ai = 0; ai < 2; ++ai)
#pragma unroll
            for (int m = 0; m < 4; ++m) { const size_t ro = (size_t)(row0 + ai * HALF + m * 16) * 2048 + col0;
#pragma unroll
                for (int bj = 0; bj < 2; ++bj)
#pragma unroll
                    for (int n = 0; n < 2; ++n) { const f32x4 xv = *(const f32x4*)(xin + ro + bj * HALF + n * 16); *(f32x4*)(out + ro + bj * HALF + n * 16) = xv + acc[ai][bj][m][n]; } }
    }
};
template <bool ACC> struct EpiGate {
    static constexpr bool PERM = true, AFTER_DRAIN = false;
    const bf16_t* G; int gofs; bf16_t* MG;
    __device__ __forceinline__ void operator()(const f32x4 (&acc)[2][2][4][2], const Unit& u, int wr, int wc, int fr, int fq) const {
        const int row0 = u.pm * BM + wr * 64 + fr; const int col0 = u.pn * BM + wc * 32 + 8 * fq;
#pragma unroll
        for (int ai = 0; ai < 2; ++ai)
#pragma unroll
            for (int m = 0; m < 4; ++m) { const int row = row0 + ai * HALF + m * 16;
#pragma unroll
                for (int bj = 0; bj < 2; ++bj) { const int col = col0 + bj * HALF;
                    const u32x4 gv = *(const u32x4*)(G + (size_t)row * 6144 + gofs + col);
                    const f32x4 a0 = acc[ai][bj][m][0], a1 = acc[ai][bj][m][1];
                    float r[8];
                    r[0] = __builtin_bit_cast(float, gv.x << 16) * a0[0]; r[1] = __builtin_bit_cast(float, gv.x & 0xffff0000u) * a0[1];
                    r[2] = __builtin_bit_cast(float, gv.y << 16) * a0[2]; r[3] = __builtin_bit_cast(float, gv.y & 0xffff0000u) * a0[3];
                    r[4] = __builtin_bit_cast(float, gv.z << 16) * a1[0]; r[5] = __builtin_bit_cast(float, gv.z & 0xffff0000u) * a1[1];
                    r[6] = __builtin_bit_cast(float, gv.w << 16) * a1[2]; r[7] = __builtin_bit_cast(float, gv.w & 0xffff0000u) * a1[3];
                    bf16_t* mp = MG + (size_t)row * 2048 + col;
                    if (ACC) { const u32x4 ov = *(const u32x4*)mp;
                        r[0] += __builtin_bit_cast(float, ov.x << 16); r[1] += __builtin_bit_cast(float, ov.x & 0xffff0000u);
                        r[2] += __builtin_bit_cast(float, ov.y << 16); r[3] += __builtin_bit_cast(float, ov.y & 0xffff0000u);
                        r[4] += __builtin_bit_cast(float, ov.z << 16); r[5] += __builtin_bit_cast(float, ov.z & 0xffff0000u);
                        r[6] += __builtin_bit_cast(float, ov.w << 16); r[7] += __builtin_bit_cast(float, ov.w & 0xffff0000u); }
                    u32x4 w; w.x = cvt_pk_bf16(r[0], r[1]); w.y = cvt_pk_bf16(r[2], r[3]); w.z = cvt_pk_bf16(r[4], r[5]); w.w = cvt_pk_bf16(r[6], r[7]);
                    *(u32x4*)mp = w; } }
    }
};
}

struct Args { const float* in[25]; float* out; unsigned char* ws; int ph_lo, ph_hi, li, pad; };

struct Ctx {
    LAS unsigned char* lds;
    int tid, lane, wave, G, bid;
    int gw, ngw;
};

__device__ __forceinline__ void transpose_item(const float* W, int K, int N, bf16* WT, int kb, int nb, int dst_row0, LAS float* scr, int lane) {
    const int k0 = 64 * kb, n0 = 32 * nb;
#pragma unroll 8
    for (int i = 0; i < 32; ++i) { const int kk = 2 * i + (lane >> 5); scr[kk * 33 + (lane & 31)] = W[(size_t)(k0 + kk) * N + n0 + (lane & 31)]; }
    LDS_WAIT(); asm volatile("" ::: "memory");
    const int c = lane & 7;
#pragma unroll
    for (int j = 0; j < 4; ++j) { const int n = (lane >> 3) + 8 * j; const LAS float* s = scr + (8 * c) * 33 + n;
        v4u o; o.x = pk2(s[0 * 33], s[1 * 33]); o.y = pk2(s[2 * 33], s[3 * 33]); o.z = pk2(s[4 * 33], s[5 * 33]); o.w = pk2(s[6 * 33], s[7 * 33]);
        *(v4u*)(WT + (size_t)(dst_row0 + n) * K + k0 + 8 * c) = o; }
    LDS_WAIT(); asm volatile("" ::: "memory");
}
__device__ __forceinline__ int transpose_matrix(const Ctx& C, const float* W, int K, int N, bf16* WT, int gate_split, int base) {
    LAS float* scr = (LAS float*)(C.lds + RING_OFF + C.wave * 16384);
    const int nblk = N / 32, items = (K / 64) * nblk;
    int first = (C.gw - base) % C.ngw; if (first < 0) first += C.ngw;
    for (int it = first; it < items; it += C.ngw) {
        const int kb = it / nblk, nb = it % nblk; int dr = 32 * nb; if (gate_split && dr >= C_END) dr += 64;
        transpose_item(W, K, N, WT, kb, nb, dr, scr, C.lane);
    }
    return base + items;
}

__device__ __forceinline__ void rms_row_bf16(const float* xrow, const float* gam, bf16* orow, int lane) {
    const f32x4* xr = (const f32x4*)xrow + lane; f32x4 v[8]; float s = 0.f;
#pragma unroll
    for (int j = 0; j < 8; ++j) { v[j] = xr[64 * j]; s += (v[j].x * v[j].x + v[j].y * v[j].y) + (v[j].z * v[j].z + v[j].w * v[j].w); }
    const float rs = 1.0f / sqrtf(wave_sum(s) * (1.0f / D) + NORM_EPS);
    const f32x4* gr = (const f32x4*)gam + lane; v2u* o8 = (v2u*)orow + lane;
#pragma unroll
    for (int j = 0; j < 8; ++j) { const f32x4 g = gr[64 * j]; v2u w; w.x = pk2(v[j].x * rs * g.x, v[j].y * rs * g.y); w.y = pk2(v[j].z * rs * g.z, v[j].w * rs * g.w); o8[64 * j] = w; }
}
__device__ __forceinline__ void rms_row_f32(float* xrow, const float* gam, int lane) {
    f32x4* xr = (f32x4*)xrow + lane; f32x4 v[8]; float s = 0.f;
#pragma unroll
    for (int j = 0; j < 8; ++j) { v[j] = xr[64 * j]; s += (v[j].x * v[j].x + v[j].y * v[j].y) + (v[j].z * v[j].z + v[j].w * v[j].w); }
    const float rs = 1.0f / sqrtf(wave_sum(s) * (1.0f / D) + NORM_EPS);
    const f32x4* gr = (const f32x4*)gam + lane;
#pragma unroll
    for (int j = 0; j < 8; ++j) { const f32x4 g = gr[64 * j]; xr[64 * j] = v[j] * rs * g; }
}

__device__ __forceinline__ void phase_prep(const Ctx& C, const Args& a, int l, const float* xsrc, unsigned char* ws) {
    int base = 0;
    base = transpose_matrix(C, a.in[3] + (size_t)l * D * DIN, D, DIN, (bf16*)(ws + WS_WIN), 1, base);
    base = transpose_matrix(C, a.in[21] + (size_t)l * D * NUP, D, NUP, (bf16*)(ws + WS_WUP), 0, base);
    base = transpose_matrix(C, a.in[23] + (size_t)l * DFF * D, DFF, D, (bf16*)(ws + WS_WDOWN), 0, base);
    base = transpose_matrix(C, a.in[19] + (size_t)l * D * D, D, D, (bf16*)(ws + WS_WOUT), 0, base);
    base = transpose_matrix(C, a.in[16] + (size_t)l * 512 * D, 512, D, (bf16*)(ws + WS_PA), 0, base);
    base = transpose_matrix(C, a.in[17] + (size_t)l * 768 * D, 768, D, (bf16*)(ws + WS_PB), 0, base);
    base = transpose_matrix(C, a.in[18] + (size_t)l * 256 * D, 256, D, (bf16*)(ws + WS_PC), 0, base);
    const int gt = C.bid * NTHREADS + C.tid, ngt = C.G * NTHREADS;
    { v4u* z = (v4u*)((bf16*)(ws + WS_WIN) + (size_t)C_END * D); for (int i = gt; i < 64 * D / 8; i += ngt) z[i] = (v4u){0u, 0u, 0u, 0u}; }
    { bf16* wl = (bf16*)(ws + WS_WLORA); const float* wup = a.in[7] + (size_t)l * 96 * BW; const float* aup = a.in[9] + (size_t)l * 96 * BW; const float* gup = a.in[10] + (size_t)l * 256 * BW;
      for (int i = gt; i < NLORA * KLORA; i += ngt) { const int n = i / KLORA, k = i % KLORA; float v = 0.f;
          if (n < 768) { if (k < 96) v = wup[k * BW + n]; }
          else if (n < 1536) { if (k >= 96 && k < 192) v = aup[(k - 96) * BW + (n - 768)]; }
          else { if (k >= 192 && k < 448) v = gup[(k - 192) * BW + (n - 1536)]; }
          wl[i] = (bf16)f2bf(v); } }
    const float* g1 = a.in[2] + (size_t)l * D; bf16* H = (bf16*)(ws + WS_H);
    for (int m = C.gw; m < M; m += C.ngw) rms_row_bf16(xsrc + (size_t)m * D, g1, H + (size_t)m * D, C.lane);
}

__device__ __forceinline__ void phase_aprime(const Ctx& C, const Args& a, int l, unsigned char* ws) {
    const bf16* P1 = (const bf16*)(ws + WS_P1); bf16* AP = (bf16*)(ws + WS_AP); const float* mu = a.in[5] + (size_t)l * BCOLS;
    const int g = C.lane, c0 = 8 * g;
    float muv[8];
#pragma unroll
    for (int j = 0; j < 8; ++j) muv[j] = (g < 56) ? mu[(C_WD - C_R) + c0 + j] : 0.f;
    for (int m = C.gw; m < M; m += C.ngw) {
        v4u o = (v4u){0u, 0u, 0u, 0u};
        if (g < 56) {
            const v4u cur = *(const v4u*)(P1 + (size_t)m * NP1 + C_WD + c0);
            v4u prv = (v4u){0u, 0u, 0u, 0u}; if ((m & (SEQ - 1)) != 0) prv = *(const v4u*)(P1 + (size_t)(m - 1) * NP1 + C_WD + c0);
            float x[8], p[8];
            x[0] = bflo(cur.x); x[1] = bfhi(cur.x); x[2] = bflo(cur.y); x[3] = bfhi(cur.y); x[4] = bflo(cur.z); x[5] = bfhi(cur.z); x[6] = bflo(cur.w); x[7] = bfhi(cur.w);
            p[0] = bflo(prv.x); p[1] = bfhi(prv.x); p[2] = bflo(prv.y); p[3] = bfhi(prv.y); p[4] = bflo(prv.z); p[5] = bfhi(prv.z); p[6] = bflo(prv.w); p[7] = bfhi(prv.w);
#pragma unroll
            for (int j = 0; j < 8; ++j) { float v = x[j] + (p[j] - x[j]) * muv[j];
                if (g < 12) v = tanhf(v); else if (g >= 24) v = sigmoidf_(v);
                x[j] = v; }
            o.x = pk2(x[0], x[1]); o.y = pk2(x[2], x[3]); o.z = pk2(x[4], x[5]); o.w = pk2(x[6], x[7]);
        }
        *(v4u*)(AP + (size_t)m * KLORA + c0) = o;
    }
}

__device__ __forceinline__ void phase_scanprep(const Ctx& C, const Args& a, int l, unsigned char* ws) {
    const bf16* P1 = (const bf16*)(ws + WS_P1); const float* LO = (const float*)(ws + WS_LO);
    float* SR = (float*)(ws + WS_SR); float* SW = (float*)(ws + WS_SW); float* SK = (float*)(ws + WS_SK); float* SKK = (float*)(ws + WS_SKK); float* SB = (float*)(ws + WS_SB); float* SV = (float*)(ws + WS_SV);
    const float* mu = a.in[5] + (size_t)l * BCOLS; const float* w0 = a.in[6] + (size_t)l * BW; const float* a0 = a.in[8] + (size_t)l * BW;
    const float* kkw = a.in[11] + (size_t)l * BW; const float* kaw = a.in[12] + (size_t)l * BW;
    for (int it = C.gw; it < M * 12; it += C.ngw) {
        const int m = it / 12, h = it % 12, hc = h * 64 + C.lane; const bool first = (m & (SEQ - 1)) == 0;
        const bf16* pr = P1 + (size_t)m * NP1; const bf16* pp = pr - NP1;
        float r = bf1(pr[C_R + hc]), k = bf1(pr[C_K + hc]), v = bf1(pr[C_V + hc]);
        const float rp = first ? 0.f : bf1(pp[C_R + hc]), kp = first ? 0.f : bf1(pp[C_K + hc]), vp = first ? 0.f : bf1(pp[C_V + hc]);
        r = r + (rp - r) * mu[hc]; k = k + (kp - k) * mu[BW + hc]; v = v + (vp - v) * mu[2 * BW + hc];
        const float wpre = w0[hc] + LO[(size_t)m * NLORA + hc], apre = a0[hc] + LO[(size_t)m * NLORA + BW + hc];
        const float xx = -wpre; const float sp = fmaxf(xx, 0.f) + log1pf(expf(-fabsf(xx)));
        const float wlog = -sp - 0.5f; const float decay = expf(-expf(wlog));
        const float av = 1.0f / (1.0f + expf(-apre));
        const float kkr = k * kkw[hc]; const float nrm = sqrtf(wave_sum(kkr * kkr)); const float kk = kkr / fmaxf(nrm, 1e-12f);
        const float kt = k * (1.0f + (av - 1.0f) * kaw[hc]);
        const size_t o = (size_t)m * BW + hc;
        SR[o] = r; SW[o] = decay; SK[o] = kt; SKK[o] = kk; SB[o] = kk * av; SV[o] = v;
    }
}

__device__ __forceinline__ void scan_block(const Ctx& C, int sb, unsigned char* ws) {
    const int b = sb / 24, h = (sb % 24) >> 1, half = sb & 1;
    const float* SR = (const float*)(ws + WS_SR); const float* SW = (const float*)(ws + WS_SW); const float* SK = (const float*)(ws + WS_SK); const float* SKK = (const float*)(ws + WS_SKK);
    const float* SB = (const float*)(ws + WS_SB); const float* SV = (const float*)(ws + WS_SV); float* YR = (float*)(ws + WS_YRAW);
    constexpr int T = 64;
    LAS float* Lr = (LAS float*)(C.lds + RING_OFF); LAS float* Lw = Lr + T * 64; LAS float* Lk = Lw + T * 64; LAS float* Lkk = Lk + T * 64; LAS float* Lb = Lkk + T * 64;
    LAS float* Lv = Lb + T * 64; LAS float* Ly = Lv + T * 32;
    const int tid = C.tid, rl = tid >> 4, kq = tid & 15;
    const size_t rowbase = (size_t)b * SEQ; const int colh = h * 64;
    const int lt0 = tid >> 4, lc0 = (tid & 15) * 4, vt = tid >> 3, vc = (tid & 7) * 4;
    f32x4 pr[2], pw[2], pk[2], pkk[2], pb[2], pv;
#define SCAN_LOAD(t0) do { _Pragma("unroll") for (int i = 0; i < 2; ++i) { const size_t o = (rowbase + (t0) + lt0 + 32 * i) * BW + colh + lc0; \
        pr[i] = *(const f32x4*)(SR + o); pw[i] = *(const f32x4*)(SW + o); pk[i] = *(const f32x4*)(SK + o); pkk[i] = *(const f32x4*)(SKK + o); pb[i] = *(const f32x4*)(SB + o); } \
        pv = *(const f32x4*)(SV + (rowbase + (t0) + vt) * BW + colh + 32 * half + vc); } while (0)
    SCAN_LOAD(0);
    float S0 = 0.f, S1 = 0.f, S2 = 0.f, S3 = 0.f;
    for (int ch = 0; ch < SEQ / T; ++ch) {
        const int t0 = ch * T;
#pragma unroll
        for (int i = 0; i < 2; ++i) { const int lo = (lt0 + 32 * i) * 64 + lc0;
            *(LAS f32x4*)(Lr + lo) = pr[i]; *(LAS f32x4*)(Lw + lo) = pw[i]; *(LAS f32x4*)(Lk + lo) = pk[i]; *(LAS f32x4*)(Lkk + lo) = pkk[i]; *(LAS f32x4*)(Lb + lo) = pb[i]; }
        *(LAS f32x4*)(Lv + vt * 32 + vc) = pv;
        __syncthreads();
        if (ch + 1 < SEQ / T) SCAN_LOAD(t0 + T);
#pragma unroll 4
        for (int t = 0; t < T; ++t) {
            const f32x4 kk4 = *(const LAS f32x4*)(Lkk + t * 64 + kq * 4), w4 = *(const LAS f32x4*)(Lw + t * 64 + kq * 4), b4 = *(const LAS f32x4*)(Lb + t * 64 + kq * 4);
            const f32x4 k4 = *(const LAS f32x4*)(Lk + t * 64 + kq * 4), r4 = *(const LAS f32x4*)(Lr + t * 64 + kq * 4); const float v = Lv[t * 32 + rl];
            float d = (S0 * kk4.x + S1 * kk4.y) + (S2 * kk4.z + S3 * kk4.w); d = red16(d); const float sa = -d;
            S0 = S0 * w4.x + (sa * b4.x + v * k4.x); S1 = S1 * w4.y + (sa * b4.y + v * k4.y); S2 = S2 * w4.z + (sa * b4.z + v * k4.z); S3 = S3 * w4.w + (sa * b4.w + v * k4.w);
            float y = (S0 * r4.x + S1 * r4.y) + (S2 * r4.z + S3 * r4.w); y = red16(y);
            if (kq == 0) Ly[t * 32 + rl] = y;
        }
        __syncthreads();
        *(f32x4*)(YR + (rowbase + t0 + vt) * BW + colh + 32 * half + vc) = *(const LAS f32x4*)(Ly + vt * 32 + vc);
    }
#undef SCAN_LOAD
}

struct AttnPass { int qcol; int bias_head; int tbl; float sink; int use_sink; int maxsteps; bf16* out; int out_ld; int out_col; float* lse; };
__device__ __forceinline__ void attn_stage_kv(const Ctx& C, const bf16* P1, int b, int res, int dil, int fblk, int kcol, int vcol) {
    LAS unsigned char* Ks = C.lds + RING_OFF; LAS unsigned char* Vs = Ks + 256 * 144;
#pragma unroll
    for (int i = 0; i < 4; ++i) { const int c = C.tid + 512 * i, row = c >> 3, part = c & 7; const int fp = (fblk - 1) * 128 + row;
        v4u kv = (v4u){0u, 0u, 0u, 0u}, vv = (v4u){0u, 0u, 0u, 0u};
        if (fp >= 0) { const bf16* src = P1 + ((size_t)b * SEQ + (size_t)fp * dil + res) * NP1; kv = *(const v4u*)(src + kcol + part * 8); vv = *(const v4u*)(src + vcol + part * 8); }
        *(LAS v4u*)(Ks + row * 144 + part * 16) = kv; *(LAS v4u*)(Vs + row * 144 + part * 16) = vv; }
}
__device__ __forceinline__ void attn_pass(const Ctx& C, const bf16* P1, const float* relb, int b, int res, int dil, int fblk, const AttnPass& ap) {
    LAS unsigned char* Ks = C.lds + RING_OFF; LAS unsigned char* Vs = Ks + 256 * 144; LAS float* lut = (LAS float*)(Vs + 256 * 144);
    __syncthreads();
    if (C.tid < 132) lut[C.tid] = (C.tid <= 128) ? relb[(int)T5B[ap.tbl][C.tid] * 20 + ap.bias_head] : 0.f;
    __syncthreads();
    const int i = C.tid >> 2, dq = C.tid & 3;
    const size_t tok = (size_t)b * SEQ + (size_t)(fblk * 128 + i) * dil + res;
    float q[16];
    { const bf16* qp = P1 + tok * NP1 + ap.qcol + dq * 16; const v4u a0 = *(const v4u*)qp, a1 = *(const v4u*)(qp + 8);
      q[0] = bflo(a0.x); q[1] = bfhi(a0.x); q[2] = bflo(a0.y); q[3] = bfhi(a0.y); q[4] = bflo(a0.z); q[5] = bfhi(a0.z); q[6] = bflo(a0.w); q[7] = bfhi(a0.w);
      q[8] = bflo(a1.x); q[9] = bfhi(a1.x); q[10] = bflo(a1.y); q[11] = bfhi(a1.y); q[12] = bflo(a1.z); q[13] = bfhi(a1.z); q[14] = bflo(a1.w); q[15] = bfhi(a1.w);
#pragma unroll
      for (int j = 0; j < 16; ++j) q[j] *= 0.125f; }
    float mrun = ap.use_sink ? ap.sink : -INFINITY, lrun = ap.use_sink ? 1.0f : 0.0f;
    float o[16];
#pragma unroll
    for (int j = 0; j < 16; ++j) o[j] = 0.f;
    const int fq0 = fblk * 128 + i;
    for (int dist = 0; dist <= ap.maxsteps; ++dist) {
        const int kr = i + 128 - dist;
        const bool valid = (fq0 - dist) >= 0;
        const v4u k0 = *(const LAS v4u*)(Ks + kr * 144 + dq * 32), k1 = *(const LAS v4u*)(Ks + kr * 144 + dq * 32 + 16);
        float s = q[0] * bflo(k0.x) + q[1] * bfhi(k0.x) + q[2] * bflo(k0.y) + q[3] * bfhi(k0.y) + q[4] * bflo(k0.z) + q[5] * bfhi(k0.z) + q[6] * bflo(k0.w) + q[7] * bfhi(k0.w)
                + q[8] * bflo(k1.x) + q[9] * bfhi(k1.x) + q[10] * bflo(k1.y) + q[11] * bfhi(k1.y) + q[12] * bflo(k1.z) + q[13] * bfhi(k1.z) + q[14] * bflo(k1.w) + q[15] * bfhi(k1.w);
        s = red4(s) + lut[dist];
        if (valid) {
            if (s > mrun) { const float c = __expf(mrun - s); lrun *= c;
#pragma unroll
                for (int j = 0; j < 16; ++j) o[j] *= c;
                mrun = s; }
            const float p = __expf(s - mrun); lrun += p;
            const v4u v0 = *(const LAS v4u*)(Vs + kr * 144 + dq * 32), v1 = *(const LAS v4u*)(Vs + kr * 144 + dq * 32 + 16);
            o[0] += p * bflo(v0.x); o[1] += p * bfhi(v0.x); o[2] += p * bflo(v0.y); o[3] += p * bfhi(v0.y); o[4] += p * bflo(v0.z); o[5] += p * bfhi(v0.z); o[6] += p * bflo(v0.w); o[7] += p * bfhi(v0.w);
            o[8] += p * bflo(v1.x); o[9] += p * bfhi(v1.x); o[10] += p * bflo(v1.y); o[11] += p * bfhi(v1.y); o[12] += p * bflo(v1.z); o[13] += p * bfhi(v1.z); o[14] += p * bflo(v1.w); o[15] += p * bfhi(v1.w);
        }
    }
    const float inv = 1.0f / lrun;
    v4u w0, w1;
    w0.x = pk2(o[0] * inv, o[1] * inv); w0.y = pk2(o[2] * inv, o[3] * inv); w0.z = pk2(o[4] * inv, o[5] * inv); w0.w = pk2(o[6] * inv, o[7] * inv);
    w1.x = pk2(o[8] * inv, o[9] * inv); w1.y = pk2(o[10] * inv, o[11] * inv); w1.z = pk2(o[12] * inv, o[13] * inv); w1.w = pk2(o[14] * inv, o[15] * inv);
    bf16* op = ap.out + tok * ap.out_ld + ap.out_col + dq * 16;
    *(v4u*)op = w0; *(v4u*)(op + 8) = w1;
    if (ap.lse && dq == 0) ap.lse[tok * 4] = mrun + __logf(lrun);
}
__device__ __forceinline__ void phase_attn(const Ctx& C, const Args& a, int l, unsigned char* ws, int ab, int nab) {
    const bf16* P1 = (const bf16*)(ws + WS_P1); const float* relb = a.in[1]; const float* sinks = a.in[4] + l * 8;
    bf16* YA = (bf16*)(ws + WS_YA); bf16* OC = (bf16*)(ws + WS_OC); float* LSE = (float*)(ws + WS_LSE);
    constexpr int NA = 256, NC = 1536;
    for (int it = ab; it < NA + NC; it += nab) {
        __syncthreads();
        if (it < NA) {
            const int b = it >> 7, fblk = (it >> 1) & 63, hkv = it & 1;
            attn_stage_kv(C, P1, b, 0, 1, fblk, C_AK + hkv * 64, C_AV + hkv * 64);
            for (int g = 0; g < 4; ++g) { const int hq = hkv * 4 + g;
                AttnPass ap; ap.qcol = C_AQ + hq * 64; ap.bias_head = hq; ap.tbl = 0; ap.sink = sinks[hq]; ap.use_sink = 1; ap.maxsteps = 127; ap.out = YA; ap.out_ld = 512; ap.out_col = hq * 64; ap.lse = nullptr;
                attn_pass(C, P1, relb, b, 0, 1, fblk, ap); }
        } else {
            const int ci = it - NA; const int gi = ci / 512, j = (ci >> 7) & 3, qb = ci & 127;
            const int dil = (gi == 0) ? 1 : (gi == 1 ? 4 : 16); const int bps = 64 / dil;
            const int n = qb / bps, fblk = qb % bps, b = n / dil, res = n % dil; const int hc = gi * 4 + j;
            attn_stage_kv(C, P1, b, res, dil, fblk, C_CK + hc * 64, C_CV + hc * 64);
            AttnPass ap; ap.qcol = C_CQ + hc * 64; ap.bias_head = 8 + hc; ap.tbl = gi; ap.sink = 0.f; ap.use_sink = 0; ap.maxsteps = 128; ap.out = OC + (size_t)gi * M * 256; ap.out_ld = 256; ap.out_col = j * 64;
            ap.lse = LSE + (size_t)gi * M * 4 + j;
            attn_pass(C, P1, relb, b, res, dil, fblk, ap);
        }
    }
}

__device__ __forceinline__ void phase_post(const Ctx& C, const Args& a, int l, unsigned char* ws) {
    const float* YR = (const float*)(ws + WS_YRAW); const float* SR = (const float*)(ws + WS_SR); const float* SK = (const float*)(ws + WS_SK); const float* SV = (const float*)(ws + WS_SV);
    const float* LO = (const float*)(ws + WS_LO); bf16* YB = (bf16*)(ws + WS_YB);
    const float* rk = a.in[13] + (size_t)l * BW; const float* lg = a.in[14] + (size_t)l * BW; const float* lb = a.in[15] + (size_t)l * BW;
    for (int it = C.gw; it < M * 12; it += C.ngw) {
        const int m = it / 12, h = it % 12, hc = h * 64 + C.lane; const size_t o = (size_t)m * BW + hc;
        const float y = YR[o]; const float mean = wave_sum(y) * (1.0f / 64.0f); const float dv = y - mean; const float var = wave_sum(dv * dv) * (1.0f / 64.0f);
        float yn = dv * (1.0f / sqrtf(var + GN_EPS)) * lg[hc] + lb[hc];
        const float bonus = wave_sum(SR[o] * SK[o] * rk[hc]);
        yn += bonus * SV[o];
        yn *= LO[(size_t)m * NLORA + 2 * BW + hc];
        YB[o] = (bf16)f2bf(yn);
    }
    const bf16* OC = (const bf16*)(ws + WS_OC); const float* LSE = (const float*)(ws + WS_LSE); bf16* YC = (bf16*)(ws + WS_YC);
    for (int m = C.gw; m < M; m += C.ngw) {
        const int j = C.lane >> 4;
        const float l0 = LSE[(size_t)m * 4 + j], l1 = LSE[((size_t)M + m) * 4 + j], l2 = LSE[((size_t)2 * M + m) * 4 + j];
        const float mx = fmaxf(l0, fmaxf(l1, l2)); const float e0 = __expf(l0 - mx), e1 = __expf(l1 - mx), e2 = __expf(l2 - mx); const float inv = 1.0f / (e0 + e1 + e2);
        const v2u a0 = *(const v2u*)(OC + (size_t)m * 256 + 4 * C.lane), a1 = *(const v2u*)(OC + ((size_t)M + m) * 256 + 4 * C.lane), a2 = *(const v2u*)(OC + ((size_t)2 * M + m) * 256 + 4 * C.lane);
        const float w0 = e0 * inv, w1 = e1 * inv, w2 = e2 * inv;
        v2u o; o.x = pk2(w0 * bflo(a0.x) + w1 * bflo(a1.x) + w2 * bflo(a2.x), w0 * bfhi(a0.x) + w1 * bfhi(a1.x) + w2 * bfhi(a2.x));
        o.y = pk2(w0 * bflo(a0.y) + w1 * bflo(a1.y) + w2 * bflo(a2.y), w0 * bfhi(a0.y) + w1 * bfhi(a1.y) + w2 * bfhi(a2.y));
        *(v2u*)(YC + (size_t)m * 256 + 4 * C.lane) = o;
    }
}

__device__ __forceinline__ void phase_conv(const Ctx& C, const Args& a, int l, unsigned char* ws) {
    const bf16* U = (const bf16*)(ws + WS_U); bf16* ACT = (bf16*)(ws + WS_ACT); const float* cw = a.in[22] + (size_t)l * 3 * DFF;
    constexpr int GPR = DFF / 8;
    const int gt = C.bid * NTHREADS + C.tid, ngt = C.G * NTHREADS;
    for (int idx = gt; idx < M * GPR; idx += ngt) {
        const int m = idx / GPR, f0 = (idx % GPR) * 8, t = m & (SEQ - 1);
        const bf16* ur = U + (size_t)m * NUP + f0;
        const v4u g2 = *(const v4u*)ur; const v4u vv = *(const v4u*)(ur + DFF);
        v4u g1 = (v4u){0u, 0u, 0u, 0u}, g0 = (v4u){0u, 0u, 0u, 0u};
        if (t >= 1) g1 = *(const v4u*)(ur - NUP); if (t >= 2) g0 = *(const v4u*)(ur - 2 * NUP);
        float x2[8], x1[8], x0[8], vl[8], r[8];
        x2[0] = bflo(g2.x); x2[1] = bfhi(g2.x); x2[2] = bflo(g2.y); x2[3] = bfhi(g2.y); x2[4] = bflo(g2.z); x2[5] = bfhi(g2.z); x2[6] = bflo(g2.w); x2[7] = bfhi(g2.w);
        x1[0] = bflo(g1.x); x1[1] = bfhi(g1.x); x1[2] = bflo(g1.y); x1[3] = bfhi(g1.y); x1[4] = bflo(g1.z); x1[5] = bfhi(g1.z); x1[6] = bflo(g1.w); x1[7] = bfhi(g1.w);
        x0[0] = bflo(g0.x); x0[1] = bfhi(g0.x); x0[2] = bflo(g0.y); x0[3] = bfhi(g0.y); x0[4] = bflo(g0.z); x0[5] = bfhi(g0.z); x0[6] = bflo(g0.w); x0[7] = bfhi(g0.w);
        vl[0] = bflo(vv.x); vl[1] = bfhi(vv.x); vl[2] = bflo(vv.y); vl[3] = bfhi(vv.y); vl[4] = bflo(vv.z); vl[5] = bfhi(vv.z); vl[6] = bflo(vv.w); vl[7] = bfhi(vv.w);
#pragma unroll
        for (int j = 0; j < 8; ++j) { const float gsum = cw[f0 + j] * x0[j] + cw[DFF + f0 + j] * x1[j] + cw[2 * DFF + f0 + j] * x2[j];
            r[j] = gsum / (1.0f + __expf(-gsum)) * vl[j]; }
        v4u o; o.x = pk2(r[0], r[1]); o.y = pk2(r[2], r[3]); o.z = pk2(r[4], r[5]); o.w = pk2(r[6], r[7]);
        *(v4u*)(ACT + (size_t)m * DFF + f0) = o;
    }
}

__device__ __forceinline__ Ctx make_ctx(unsigned char* lds) {
    Ctx C;
    C.lds = (LAS unsigned char*)lds;
    C.tid = threadIdx.x; C.lane = C.tid & 63; C.wave = __builtin_amdgcn_readfirstlane(C.tid >> 6);
    C.G = gridDim.x; C.bid = blockIdx.x; C.gw = C.bid * NWAVES + C.wave; C.ngw = C.G * NWAVES;
    return C;
}
template <int K> __device__ __forceinline__ void run_phase(const Ctx& C, const Args& args, int l) {
    unsigned char* ws = args.ws; LAS unsigned char* ring = C.lds + RING_OFF; float* out = args.out;
    const float* xsrc = (l == 0) ? args.in[0] : out;
    if constexpr (K == 0) { phase_prep(C, args, l, xsrc, ws); }
    if constexpr (K == 1) { pg8::Gemm g{(const bf16*)(ws + WS_H), (const bf16*)(ws + WS_WIN), M, NWIN, D}; pg8::StaticOrder S; S.init(M, NWIN, C.G, C.bid);
        pg8::EpiWin E{(bf16*)(ws + WS_P1), (bf16*)(ws + WS_G)};
        pg8::gemm_phase<pg8::EpiWin, pg8::StaticOrder, true, true>(ring, g, S, E); }
    if constexpr (K == 2) { phase_aprime(C, args, l, ws); }
    if constexpr (K == 3) { pg8::Gemm g{(const bf16*)(ws + WS_AP), (const bf16*)(ws + WS_WLORA), M, NLORA, KLORA}; pg8::StaticOrder S; S.init(M, NLORA, C.G, C.bid);
        pg8::EpiF32P E{(float*)(ws + WS_LO), NLORA};
        pg8::gemm_phase<pg8::EpiF32P, pg8::StaticOrder, true, true>(ring, g, S, E); }
    if constexpr (K == 4) { phase_scanprep(C, args, l, ws); }
    if constexpr (K == 5) { if (C.bid < NSCAN) scan_block(C, C.bid, ws); else phase_attn(C, args, l, ws, C.bid - NSCAN, C.G - NSCAN); }
    if constexpr (K == 6) { phase_post(C, args, l, ws); }
    if constexpr (K == 7) {
        { pg8::Gemm g{(const bf16*)(ws + WS_YA), (const bf16*)(ws + WS_PA), M, D, 512}; pg8::StaticOrder S; S.init(M, D, C.G, C.bid);
          pg8::EpiGate<false> E{(const bf16*)(ws + WS_G), 0, (bf16*)(ws + WS_MG)};
          pg8::gemm_phase<pg8::EpiGate<false>, pg8::StaticOrder, true, true>(ring, g, S, E); }
        { pg8::Gemm g{(const bf16*)(ws + WS_YB), (const bf16*)(ws + WS_PB), M, D, 768}; pg8::StaticOrder S; S.init(M, D, C.G, C.bid);
          pg8::EpiGate<true> E{(const bf16*)(ws + WS_G), 2048, (bf16*)(ws + WS_MG)};
          pg8::gemm_phase<pg8::EpiGate<true>, pg8::StaticOrder, true, true>(ring, g, S, E); }
        { pg8::Gemm g{(const bf16*)(ws + WS_YC), (const bf16*)(ws + WS_PC), M, D, 256}; pg8::StaticOrder S; S.init(M, D, C.G, C.bid);
          pg8::EpiGate<true> E{(const bf16*)(ws + WS_G), 4096, (bf16*)(ws + WS_MG)};
          pg8::gemm_phase<pg8::EpiGate<true>, pg8::StaticOrder, true, true>(ring, g, S, E); } }
    if constexpr (K == 8) { pg8::Gemm g{(const bf16*)(ws + WS_MG), (const bf16*)(ws + WS_WOUT), M, D, D}; pg8::StaticOrder S; S.init(M, D, C.G, C.bid);
        pg8::EpiResid E{xsrc, out};
        pg8::gemm_phase<pg8::EpiResid, pg8::StaticOrder, true, true>(ring, g, S, E); }
    if constexpr (K == 9) { const float* g2 = args.in[20] + (size_t)l * D; bf16* H = (bf16*)(ws + WS_H);
        for (int m = C.gw; m < M; m += C.ngw) rms_row_bf16(out + (size_t)m * D, g2, H + (size_t)m * D, C.lane); }
    if constexpr (K == 10) { pg8::Gemm g{(const bf16*)(ws + WS_H), (const bf16*)(ws + WS_WUP), M, NUP, D}; pg8::StaticOrder S; S.init(M, NUP, C.G, C.bid);
        pg8::EpiBf16P E{(bf16*)(ws + WS_U), NUP};
        pg8::gemm_phase<pg8::EpiBf16P, pg8::StaticOrder, true, true>(ring, g, S, E); }
    if constexpr (K == 11) { phase_conv(C, args, l, ws); }
    if constexpr (K == 12) { pg8::Gemm g{(const bf16*)(ws + WS_ACT), (const bf16*)(ws + WS_WDOWN), M, D, DFF}; pg8::StaticOrder S; S.init(M, D, C.G, C.bid);
        pg8::EpiResid E{out, out};
        pg8::gemm_phase<pg8::EpiResid, pg8::StaticOrder, true, true>(ring, g, S, E); }
    if constexpr (K == 13) { const float* gf = args.in[24];
        for (int m = C.gw; m < M; m += C.ngw) rms_row_f32(out + (size_t)m * D, gf, C.lane); }
}
template <int K> __global__ void __launch_bounds__(NTHREADS, 2) fwd_phase(Args args) {
    extern __shared__ __attribute__((aligned(16))) unsigned char lds[];
    const Ctx C = make_ctx(lds);
    run_phase<K>(C, args, args.li);
}

template <int K> static void launch_phase(int grid, hipStream_t stream, Args a, int l) {
    static bool attr = false; if (!attr) { (void)hipFuncSetAttribute((const void*)fwd_phase<K>, hipFuncAttributeMaxDynamicSharedMemorySize, LDS_BYTES); attr = true; }
    a.li = l; a.ph_lo = K; a.ph_hi = K + 1;
    hipLaunchKernelGGL(fwd_phase<K>, dim3(grid), dim3(NTHREADS), LDS_BYTES, stream, a);
}
extern "C" void kernel_launch(void* const* d_in, const int* in_sizes, int n_in, void* d_out, int out_size, void* d_ws, size_t ws_size, hipStream_t stream) {
    static int grid = 0;
    if (grid == 0) {
        if (n_in != 25 || in_sizes[0] != M * D || out_size != M * D || ws_size < WS_END) { fprintf(stderr, "kernel_launch: unexpected shapes (n_in %d, in0 %d, out %d, ws %zu < %zu)\n", n_in, n_in > 0 ? in_sizes[0] : -1, out_size, ws_size, (size_t)WS_END); grid = -1; return; }
        int dev = 0, cus = 0;
        if (hipGetDevice(&dev) != hipSuccess || hipDeviceGetAttribute(&cus, hipDeviceAttributeMultiprocessorCount, dev) != hipSuccess) { grid = -1; return; }
        grid = cus;
    }
    if (grid < 0) return;
    (void)hipMemsetAsync((char*)d_ws + WS_CTL, 0, CTL_ZERO_BYTES, stream);
    Args a{};
    for (int i = 0; i < 25; ++i) a.in[i] = (const float*)d_in[i];
    a.out = (float*)d_out; a.ws = (unsigned char*)d_ws; a.pad = 0;
    for (int l = 0; l < DEPTH; ++l) {
        launch_phase<0>(grid, stream, a, l); launch_phase<1>(grid, stream, a, l); launch_phase<2>(grid, stream, a, l); launch_phase<3>(grid, stream, a, l);
        launch_phase<4>(grid, stream, a, l); launch_phase<5>(grid, stream, a, l); launch_phase<6>(grid, stream, a, l); launch_phase<7>(grid, stream, a, l);
        launch_phase<8>(grid, stream, a, l); launch_phase<9>(grid, stream, a, l); launch_phase<10>(grid, stream, a, l); launch_phase<11>(grid, stream, a, l);
        launch_phase<12>(grid, stream, a, l);
    }
    launch_phase<13>(grid, stream, a, 0);
}
```

```cpp
#include <hip/hip_runtime.h>
#include <cstdio>
#include <cstdint>
#include <cmath>
#define GAS __attribute__((address_space(1)))
#define LAS __attribute__((address_space(3)))
namespace pg8 {
#define PG8_LAS __attribute__((address_space(3)))
typedef unsigned short bf16_t;
typedef short bf16x8 __attribute__((ext_vector_type(8)));
typedef float f32x4 __attribute__((ext_vector_type(4)));
typedef unsigned u32x4 __attribute__((ext_vector_type(4)));
constexpr int BM = 256, BK = 64, HALF = 128, HTB = HALF * BK * 2  , STAGE_BYTES = 8 * HTB, NXCD = 8, WGM = 8;

__host__ __device__ __forceinline__ int lds_byte(int r, int c) { const int st = (r >> 4) * 2 + (c >> 5), rr = r & 15, cc = c & 31, ob = rr * 64 + cc * 2; return st * 1024 + (ob ^ (((ob >> 9) & 1) << 5)); }
__host__ __device__ __forceinline__ void stage_rc(int b, int& R, int& C) { const int st = b / 1024, sb = b % 1024, swz = sb ^ (((sb >> 9) & 1) << 5); R = (st >> 1) * 16 + swz / 64; C = (st & 1) * 32 + (swz % 64) / 2; }
__host__ __device__ __forceinline__ int perm32(int rho) { const int n = rho >> 4, i = rho & 15; return 8 * (i >> 2) + 4 * n + (i & 3); }

struct Unit { int pm, pn; };
struct Gemm { const bf16_t* A; const bf16_t* Bt; int M, N, K; };

struct StaticOrder {
    int nM, nN, nwg, G, c;
    __host__ __device__ void init(int M, int N, int G_, int c_) { nM = M / BM; nN = N / BM; nwg = nM * nN; G = G_; c = c_; }
    __host__ __device__ bool next(int i, Unit& u) const {
        const long L = (long)i * G + c; if (L >= nwg) return false;
        int wgid = (int)L; { const int q = nwg / NXCD, r = nwg % NXCD, xcd = wgid % NXCD, off = wgid / NXCD; wgid = (xcd < r ? xcd * (q + 1) : r * (q + 1) + (xcd - r) * q) + off; }
        const int nig = WGM * nN, gid = wgid / nig, fm = gid * WGM, gsz = (nM - fm) < WGM ? (nM - fm) : WGM;
        u.pm = fm + ((wgid % nig) % gsz); u.pn = (wgid % nig) / gsz; return true;
    }
    __device__ __forceinline__ void a_ready(const Unit&) const {}
    __device__ __forceinline__ void done(const Unit&) const {}
};
__device__ __forceinline__ unsigned cvt_pk_bf16(float lo, float hi) { unsigned r; asm volatile("v_cvt_pk_bf16_f32 %0, %1, %2" : "=v"(r) : "v"(lo), "v"(hi)); return r; }
template <class Epi, class Sched, bool ALIGN_EPI = false, bool SP2 = false>
__device__ __forceinline__ void gemm_phase(PG8_LAS unsigned char* lds, const Gemm g, const Sched& S, const Epi& E) {
    int tid_ = threadIdx.x; asm volatile("" : "+v"(tid_));
    const int tid = tid_, wid = __builtin_amdgcn_readfirstlane(tid >> 6), lane = tid & 63, wr = wid >> 2, wc = wid & 3, fr = lane & 15, fq = lane >> 4;
    const int K = g.K, nt = K / BK;
    unsigned voffA[2], voffB[2];
#pragma unroll
    for (int i = 0; i < 2; ++i) { int R, C; stage_rc(tid * 16 + i * 8192, R, C); const int Rb = Epi::PERM ? ((R & ~31) + perm32(R & 31)) : R;
        voffA[i] = (unsigned)(R * K + C) * 2u; voffB[i] = (unsigned)(Rb * K + C) * 2u; }
    const size_t kstep = (size_t)(BK * 2);
    const size_t hstep = (size_t)HALF * K * 2;
    const size_t tstep = 2 * hstep;
    const unsigned ldsw = (unsigned)wid * 1024u;
    const int aoff = lds_byte(wr * 64 + fr, fq * 8), boff = lds_byte(wc * 32 + fr, fq * 8);
#define PG8_SA(b, h) (((b) * 2 + (h)) * HTB)
#define PG8_SB(b, h) ((4 + (b) * 2 + (h)) * HTB)
#define PG8_STAGE(bufoff, gbase, voff) do { _Pragma("unroll") for (int _i = 0; _i < 2; ++_i) \
        __builtin_amdgcn_global_load_lds((const unsigned*)((const char*)(gbase) + (voff)[_i]), (PG8_LAS unsigned*)(lds + (bufoff) + ldsw + _i * 8192), 16, 0, 0); } while (0)
#define PG8_LDA(dst, b, h) do { _Pragma("unroll") for (int m = 0; m < 4; ++m) _Pragma("unroll") for (int k = 0; k < 2; ++k) dst[m][k] = *(const PG8_LAS bf16x8*)(lds + PG8_SA(b, h) + aoff + m * 2048 + k * 1024); } while (0)
#define PG8_LDB(dst, b, h) do { _Pragma("unroll") for (int n = 0; n < 2; ++n) _Pragma("unroll") for (int k = 0; k < 2; ++k) dst[n][k] = *(const PG8_LAS bf16x8*)(lds + PG8_SB(b, h) + boff + n * 2048 + k * 1024); } while (0)
#define PG8_MMA(ai, bj, At, Bt) do { __builtin_amdgcn_s_setprio(1); _Pragma("unroll") for (int m = 0; m < 4; ++m) _Pragma("unroll") for (int n = 0; n < 2; ++n) _Pragma("unroll") for (int k = 0; k < 2; ++k) \
        acc[ai][bj][m][n] = __builtin_amdgcn_mfma_f32_16x16x32_bf16(Bt[n][k], At[m][k], acc[ai][bj][m][n], 0, 0, 0); __builtin_amdgcn_s_setprio(0); } while (0)
#define PG8_WAIT_V(n) asm volatile("s_waitcnt vmcnt(" #n ")" ::: "memory")
#define PG8_WAIT_L(n) asm volatile("s_waitcnt lgkmcnt(" #n ")" ::: "memory")
#define PG8_BAR __builtin_amdgcn_s_barrier()
#define PG8_SCHED __builtin_amdgcn_sched_barrier(0)
    Unit cur, nxt; int ui = 0;
    if (!S.next(0, cur)) return;
    f32x4 acc[2][2][4][2];
#pragma unroll
    for (int a = 0; a < 2; ++a)
#pragma unroll
        for (int b = 0; b < 2; ++b)
#pragma unroll
            for (int m = 0; m < 4; ++m)
#pragma unroll
                for (int n = 0; n < 2; ++n) acc[a][b][m][n] = (f32x4){0.f, 0.f, 0.f, 0.f};
    bf16x8 At[4][2], B0[2][2], B1[2][2];
    const char* cA = (const char*)g.A + (size_t)cur.pm * tstep; const char* cB = (const char*)g.Bt + (size_t)cur.pn * tstep;
    S.a_ready(cur);
    if constexpr (SP2) {
        PG8_STAGE(PG8_SB(0, 0), cB, voffB); PG8_STAGE(PG8_SB(0, 1), cB + hstep, voffB); PG8_STAGE(PG8_SA(0, 0), cA, voffA); PG8_STAGE(PG8_SA(0, 1), cA + hstep, voffA);
        if (wr == 1) PG8_BAR;
        PG8_WAIT_V(2); PG8_BAR;
        PG8_STAGE(PG8_SB(1, 0), cB + kstep, voffB); PG8_STAGE(PG8_SA(1, 0), cA + kstep, voffA); PG8_STAGE(PG8_SB(1, 1), cB + hstep + kstep, voffB);
        PG8_WAIT_V(6); PG8_BAR;
    } else {
        PG8_STAGE(PG8_SB(0, 0), cB, voffB); PG8_STAGE(PG8_SA(0, 0), cA, voffA); PG8_STAGE(PG8_SB(0, 1), cB + hstep, voffB); PG8_STAGE(PG8_SA(0, 1), cA + hstep, voffA);
        if (wr == 1) PG8_BAR;
        PG8_WAIT_V(4); PG8_BAR;
        PG8_STAGE(PG8_SB(1, 0), cB + kstep, voffB); PG8_STAGE(PG8_SA(1, 0), cA + kstep, voffA); PG8_STAGE(PG8_SB(1, 1), cB + hstep + kstep, voffB);
        PG8_WAIT_V(6); PG8_BAR;
    }
    for (;;) {
        const bool has_next = S.next(ui + 1, nxt);
        const char* nA = has_next ? (const char*)g.A + (size_t)nxt.pm * tstep : cA; const char* nB = has_next ? (const char*)g.Bt + (size_t)nxt.pn * tstep : cB;
        for (int t = 0; t < nt; t += 2) {
            const bool last = (t == nt - 2);
            const char* a1 = cA + (size_t)(t + 1) * kstep;
            const char* a2 = last ? nA : cA + (size_t)(t + 2) * kstep; const char* b2 = last ? nB : cB + (size_t)(t + 2) * kstep;
            const char* a3 = a2 + kstep; const char* b3 = b2 + kstep;
            if (last && has_next) S.a_ready(nxt);
            if constexpr (SP2) {
            PG8_LDB(B0, 0, 0); PG8_LDB(B1, 0, 1); PG8_SCHED; PG8_LDA(At, 0, 0); PG8_STAGE(PG8_SA(1, 1), a1 + hstep, voffA);
            PG8_WAIT_V(8); PG8_WAIT_L(0); PG8_BAR; PG8_MMA(0, 0, At, B0); PG8_MMA(0, 1, At, B1); PG8_BAR; PG8_SCHED;
            PG8_LDA(At, 0, 1); PG8_STAGE(PG8_SB(0, 0), b2, voffB); PG8_STAGE(PG8_SB(0, 1), b2 + hstep, voffB); PG8_STAGE(PG8_SA(0, 0), a2, voffA);
            PG8_WAIT_V(8); PG8_WAIT_L(0); PG8_BAR; PG8_MMA(1, 0, At, B0); PG8_MMA(1, 1, At, B1); PG8_BAR; PG8_SCHED;
            PG8_LDB(B0, 1, 0); PG8_LDB(B1, 1, 1); PG8_SCHED; PG8_LDA(At, 1, 0); PG8_STAGE(PG8_SA(0, 1), a2 + hstep, voffA);
            PG8_WAIT_V(8); PG8_WAIT_L(0); PG8_BAR; PG8_MMA(0, 0, At, B0); PG8_MMA(0, 1, At, B1); PG8_BAR; PG8_SCHED;
            PG8_LDA(At, 1, 1); PG8_STAGE(PG8_SB(1, 0), b3, voffB); PG8_STAGE(PG8_SB(1, 1), b3 + hstep, voffB); PG8_STAGE(PG8_SA(1, 0), a3, voffA);
            PG8_WAIT_V(8); PG8_WAIT_L(0); PG8_BAR; PG8_MMA(1, 0, At, B0); PG8_MMA(1, 1, At, B1); PG8_BAR; PG8_SCHED;
            } else {
            PG8_LDB(B0, 0, 0); PG8_SCHED; PG8_LDA(At, 0, 0); PG8_STAGE(PG8_SA(1, 1), a1 + hstep, voffA);
            PG8_WAIT_L(8); PG8_BAR; PG8_WAIT_L(0); PG8_MMA(0, 0, At, B0); PG8_BAR; PG8_SCHED;
            PG8_LDB(B1, 0, 1); PG8_STAGE(PG8_SB(0, 0), b2, voffB);
            PG8_BAR; PG8_WAIT_L(0); PG8_MMA(0, 1, At, B1); PG8_BAR;
            PG8_LDA(At, 0, 1); PG8_STAGE(PG8_SA(0, 0), a2, voffA);
            PG8_BAR; PG8_WAIT_L(0); PG8_MMA(1, 0, At, B0); PG8_BAR; PG8_SCHED;
            PG8_STAGE(PG8_SB(0, 1), b2 + hstep, voffB);
            PG8_WAIT_V(6); PG8_BAR; PG8_MMA(1, 1, At, B1); PG8_BAR;
            PG8_LDB(B0, 1, 0); PG8_SCHED; PG8_LDA(At, 1, 0); PG8_STAGE(PG8_SA(0, 1), a2 + hstep, voffA);
            PG8_WAIT_L(8); PG8_BAR; PG8_WAIT_L(0); PG8_MMA(0, 0, At, B0); PG8_BAR; PG8_SCHED;
            PG8_LDB(B1, 1, 1); PG8_STAGE(PG8_SB(1, 0), b3, voffB);
            PG8_BAR; PG8_WAIT_L(0); PG8_MMA(0, 1, At, B1); PG8_BAR;
            PG8_LDA(At, 1, 1); PG8_STAGE(PG8_SA(1, 0), a3, voffA);
            PG8_BAR; PG8_WAIT_L(0); PG8_MMA(1, 0, At, B0); PG8_BAR; PG8_SCHED;
            PG8_STAGE(PG8_SB(1, 1), b3 + hstep, voffB);
            PG8_WAIT_V(6); PG8_BAR; PG8_MMA(1, 1, At, B1); PG8_BAR;
            }
        }
        if constexpr (ALIGN_EPI) { if (wr == 0) PG8_BAR; }
        if constexpr (!Epi::AFTER_DRAIN) { E(acc, cur, wr, wc, fr, fq); S.done(cur); }
        if (!has_next) break;
#pragma unroll
        for (int a = 0; a < 2; ++a)
#pragma unroll
            for (int b = 0; b < 2; ++b)
#pragma unroll
                for (int m = 0; m < 4; ++m)
#pragma unroll
                    for (int n = 0; n < 2; ++n) acc[a][b][m][n] = (f32x4){0.f, 0.f, 0.f, 0.f};
        cur = nxt; cA = nA; cB = nB; ++ui;
        if constexpr (ALIGN_EPI) { if (wr == 1) PG8_BAR; }
    }
    PG8_WAIT_V(0);
    if constexpr (!ALIGN_EPI) { if (wr == 0) PG8_BAR; }
    PG8_BAR;
    if constexpr (Epi::AFTER_DRAIN) { E.fused(acc, cur, wr, wc, fr, fq, lds, wid, lane); S.done(cur); }
#undef PG8_SA
#undef PG8_SB
#undef PG8_STAGE
#undef PG8_LDA
#undef PG8_LDB
#undef PG8_MMA
#undef PG8_WAIT_V
#undef PG8_WAIT_L
#undef PG8_BAR
#undef PG8_SCHED
}
}
#define XB_TMO      128
#define XB_XCNT(j)  (256  + 64 * (j))
#define XB_XSUB(j)  (1280 + 64 * (j))
#define XB_XGEN(j)  (2304 + 64 * (j))
#define XB_TOP      3328
#define XB_TOPGEN   3392
#define XCD_BAR_WORDS 3456
#define XB_SPIN_CAP (1u << 18)

__device__ __forceinline__ unsigned xb_ld(unsigned* p)              { return __hip_atomic_load(p, __ATOMIC_RELAXED, __HIP_MEMORY_SCOPE_AGENT); }
__device__ __forceinline__ unsigned xb_add(unsigned* p, unsigned v) { return __hip_atomic_fetch_add(p, v, __ATOMIC_RELAXED, __HIP_MEMORY_SCOPE_AGENT); }
__device__ __forceinline__ unsigned xb_xcc_id() { return (unsigned)__builtin_amdgcn_s_getreg((3 << 11) | 20) & 0xFu; }
#define XB_SPIN(cond, bar) do { unsigned _sp = 0; while (cond) { __builtin_amdgcn_s_sleep(1); \
    if ((++_sp & 255u) == 0u) { if (xb_ld(&(bar)[XB_TMO])) break; if (_sp > XB_SPIN_CAP) { atomicAdd(&(bar)[XB_TMO], 1u); break; } } } } while (0)

struct XcdBarrier {
    unsigned* bar; unsigned x;
    volatile LAS unsigned* st;
};

__device__ __forceinline__ XcdBarrier xcd_barrier_post(unsigned* bar, volatile LAS unsigned* st) {
    XcdBarrier b; b.bar = bar; b.x = xb_xcc_id(); b.st = st;
    if (threadIdx.x == 0) (void)xb_add(&bar[XB_XCNT(b.x)], 1u);
    return b;
}
__device__ __forceinline__ void xcd_barrier_complete(unsigned* bar, unsigned x, unsigned& nloc, unsigned& nx) {
    const unsigned G = gridDim.x * gridDim.y * gridDim.z;
    unsigned sum, cnt, mine, sp = 0u;
    for (;;) {
        sum = 0u; cnt = 0u; mine = 0u;
#pragma unroll
        for (unsigned j = 0; j < 16; ++j) { const unsigned c = xb_ld(&bar[XB_XCNT(j)]); sum += c; cnt += (c > 0u) ? 1u : 0u; mine = (j == x) ? c : mine; }
        if (sum == G) break;
        __builtin_amdgcn_s_sleep(1);
        if ((++sp & 255u) == 0u) { if (xb_ld(&bar[XB_TMO])) break; if (sp > XB_SPIN_CAP) { atomicAdd(&bar[XB_TMO], 1u); break; } }
    }
    nloc = mine > 0u ? mine : 1u; nx = cnt > 0u ? cnt : 1u;
}

__device__ __forceinline__ void xcd_barrier(const XcdBarrier& b) {
    asm volatile("s_waitcnt vmcnt(0)" ::: "memory");
    __syncthreads();
    if (threadIdx.x == 0) {
        unsigned* bar = b.bar;
        __builtin_amdgcn_s_waitcnt(0);
        unsigned nloc = b.st[0], nx = b.st[1];
        if (nloc == 0u) { xcd_barrier_complete(bar, b.x, nloc, nx); b.st[0] = nloc; b.st[1] = nx; }
        const unsigned old = xb_add(&bar[XB_XSUB(b.x)], 1u);
        const unsigned gen = old / nloc;
        if (old + 1u == (gen + 1u) * nloc) {
            __builtin_amdgcn_fence(__ATOMIC_RELEASE, "agent");
            asm volatile("s_waitcnt vmcnt(0)" ::: "memory");
            const unsigned og = xb_add(&bar[XB_TOP], 1u);
            const unsigned tg = og / nx;
            if (og + 1u == (tg + 1u) * nx) xb_add(&bar[XB_TOPGEN], 1u);
            else XB_SPIN(xb_ld(&bar[XB_TOPGEN]) == tg, bar);
            __builtin_amdgcn_fence(__ATOMIC_ACQUIRE, "agent");
            xb_add(&bar[XB_XGEN(b.x)], 1u);
            asm volatile("s_waitcnt vmcnt(0)" ::: "memory");
        } else {
            XB_SPIN(xb_ld(&bar[XB_XGEN(b.x)]) == gen, bar);
            __builtin_amdgcn_fence(__ATOMIC_ACQUIRE, "agent");
            asm volatile("s_waitcnt vmcnt(0)" ::: "memory");
        }
    }
    __syncthreads();
}

constexpr int BATCH = 2, SEQ = 8192, M = BATCH * SEQ, D = 2048, DEPTH = 4;
constexpr int DIN = 11968, NP1 = 5888, NG = 6144, NWIN = NP1 + NG;
constexpr int BW = 768, BCOLS = 2752;
constexpr int C_AQ = 0, C_AK = 512, C_AV = 640, C_R = 768, C_K = 1536, C_V = 2304, C_WD = 3072, C_CQ = 3520, C_CK = 4288, C_CV = 5056, C_END = 5824;
constexpr int DFF = 5504, NUP = 2 * DFF;
constexpr int NLORA = 2304, KLORA = 512;
constexpr float NORM_EPS = 1e-5f, GN_EPS = 64e-5f;
constexpr int NWAVES = 8, NTHREADS = 512;
constexpr int NPH = 13;
constexpr int NPHASES = DEPTH * NPH + 1;
constexpr int NSCAN = 48;

constexpr size_t MiB = 1u << 20;
constexpr size_t WS_CTL = 0, CTL_ZERO_BYTES = 1 * MiB;
constexpr size_t WS_WIN = 1 * MiB;
constexpr size_t WS_WLORA = 48 * MiB;
constexpr size_t WS_PA = 51 * MiB;
constexpr size_t WS_PB = 53 * MiB;
constexpr size_t WS_PC = 56 * MiB;
constexpr size_t WS_WOUT = 57 * MiB;
constexpr size_t WS_WUP = 65 * MiB;
constexpr size_t WS_WDOWN = 108 * MiB;
constexpr size_t WS_H = 130 * MiB;
constexpr size_t WS_P1 = 194 * MiB;
constexpr size_t WS_G = 378 * MiB;
constexpr size_t WS_U = WS_P1;
constexpr size_t WS_AP = 570 * MiB;
constexpr size_t WS_LO = 586 * MiB;
constexpr size_t WS_ACT = WS_LO;
constexpr size_t WS_SR = 730 * MiB;
constexpr size_t WS_SW = 778 * MiB, WS_SK = 826 * MiB, WS_SKK = 874 * MiB, WS_SB = 922 * MiB, WS_SV = 970 * MiB;
constexpr size_t WS_YRAW = 1018 * MiB;
constexpr size_t WS_YA = 1066 * MiB;
constexpr size_t WS_YB = 1082 * MiB;
constexpr size_t WS_YC = 1106 * MiB;
constexpr size_t WS_OC = 1114 * MiB;
constexpr size_t WS_LSE = 1138 * MiB;
constexpr size_t WS_MG = 1139 * MiB;
constexpr size_t WS_END = 1203 * MiB;
constexpr int CW_BAR = 4096;

constexpr int RING_OFF = 0, RING_BYTES = 131072;
constexpr int LDSCTL_OFF = RING_BYTES, MISC_OFF = LDSCTL_OFF + 320;
constexpr int LDS_BYTES = 147456;

typedef unsigned short bf16;
typedef unsigned v4u __attribute__((ext_vector_type(4)));
typedef unsigned v2u __attribute__((ext_vector_type(2)));
typedef float f32x4 __attribute__((ext_vector_type(4)));
#define LDS_WAIT() asm volatile("s_waitcnt lgkmcnt(0)" ::: "memory")

__device__ __forceinline__ unsigned f2bf(float f) { unsigned u = __builtin_bit_cast(unsigned, f); return (u + 0x7fffu + ((u >> 16) & 1u)) >> 16; }
__device__ __forceinline__ unsigned pk2(float lo, float hi) { return f2bf(lo) | (f2bf(hi) << 16); }
__device__ __forceinline__ float bflo(unsigned w) { return __builtin_bit_cast(float, w << 16); }
__device__ __forceinline__ float bfhi(unsigned w) { return __builtin_bit_cast(float, w & 0xffff0000u); }
__device__ __forceinline__ float bf1(bf16 h) { return __builtin_bit_cast(float, ((unsigned)h) << 16); }
__device__ __forceinline__ float sigmoidf_(float x) { return 1.0f / (1.0f + __expf(-x)); }
__device__ __forceinline__ float wave_sum(float v) {
#pragma unroll
    for (int o = 1; o < 64; o <<= 1) v += __shfl_xor(v, o);
    return v;
}
template <int CTRL> __device__ __forceinline__ float dppf(float x) { return __builtin_bit_cast(float, __builtin_amdgcn_update_dpp(0, __builtin_bit_cast(int, x), CTRL, 0xF, 0xF, true)); }
__device__ __forceinline__ float red4(float x) { x += dppf<0xB1>(x); x += dppf<0x4E>(x); return x; }
__device__ __forceinline__ float red16(float x) { x = red4(x); x += dppf<0x141>(x); x += dppf<0x140>(x); return x; }

__device__ const unsigned char T5B[3][132] = {
 {0,1,2,3,4,5,6,7,8,9,10,11,12,13,14,15,16,16,16,16,16,16,17,17,17,17,17,17,17,17,18,18,18,18,18,18,18,18,18,18,19,19,19,19,19,19,19,19,19,19,19,19,19,19,20,20,20,20,20,20,20,20,20,20,20,20,20,20,20,20,20,20,20,21,21,21,21,21,21,21,21,21,21,21,21,21,21,21,21,21,21,21,21,21,21,21,21,21,21,22,22,22,22,22,22,22,22,22,22,22,22,22,22,22,22,22,22,22,22,22,22,22,22,22,22,22,22,22,22,0,0,0},
 {0,4,8,12,16,16,17,17,18,18,19,19,19,19,20,20,20,20,20,21,21,21,21,21,21,22,22,22,22,22,22,22,22,22,23,23,23,23,23,23,23,23,23,23,23,23,24,24,24,24,24,24,24,24,24,24,24,24,24,24,24,24,25,25,25,25,25,25,25,25,25,25,25,25,25,25,25,25,25,25,25,25,25,26,26,26,26,26,26,26,26,26,26,26,26,26,26,26,26,26,26,26,26,26,26,26,26,26,26,26,26,26,26,27,27,27,27,27,27,27,27,27,27,27,27,27,27,27,27,0,0,0},
 {0,16,18,19,20,21,21,22,22,23,23,23,24,24,24,24,25,25,25,25,25,26,26,26,26,26,26,26,26,27,27,27,27,27,27,27,27,27,27,28,28,28,28,28,28,28,28,28,28,28,28,28,29,29,29,29,29,29,29,29,29,29,29,29,29,29,29,29,29,29,30,30,30,30,30,30,30,30,30,30,30,30,30,30,30,30,30,30,30,30,30,30,30,30,30,31,31,31,31,31,31,31,31,31,31,31,31,31,31,31,31,31,31,31,31,31,31,31,31,31,31,31,31,31,31,31,31,31,31,0,0,0}};

namespace pg8 {
struct EpiWin {
    static constexpr bool PERM = true, AFTER_DRAIN = false;
    bf16_t* P1; bf16_t* G;
    __device__ __forceinline__ void operator()(const f32x4 (&acc)[2][2][4][2], const Unit& u, int wr, int wc, int fr, int fq) const {
        const int row0 = u.pm * BM + wr * 64 + fr; const bool gate = u.pn >= 23;
        bf16_t* base = gate ? G : P1; const int ldc = gate ? 6144 : 5888; const int col0 = (gate ? (u.pn - 23) : u.pn) * BM + wc * 32 + 8 * fq;
#pragma unroll
        for (int ai = 0; ai < 2; ++ai)
#pragma unroll
            for (int m = 0; m < 4; ++m) { bf16_t* rowp = base + (size_t)(row0 + ai * HALF + m * 16) * ldc + col0;
#pragma unroll
                for (int bj = 0; bj < 2; ++bj) { f32x4 v0 = acc[ai][bj][m][0], v1 = acc[ai][bj][m][1];
                    if (gate) {
#pragma unroll
                        for (int j = 0; j < 4; ++j) { v0[j] = __builtin_amdgcn_rcpf(1.0f + __expf(-v0[j])); v1[j] = __builtin_amdgcn_rcpf(1.0f + __expf(-v1[j])); } }
                    u32x4 w; w.x = cvt_pk_bf16(v0[0], v0[1]); w.y = cvt_pk_bf16(v0[2], v0[3]); w.z = cvt_pk_bf16(v1[0], v1[1]); w.w = cvt_pk_bf16(v1[2], v1[3]);
                    *(u32x4*)(rowp + bj * HALF) = w; } }
    }
};
struct EpiBf16P {
    static constexpr bool PERM = true, AFTER_DRAIN = false;
    bf16_t* O; int ldc;
    __device__ __forceinline__ void operator()(const f32x4 (&acc)[2][2][4][2], const Unit& u, int wr, int wc, int fr, int fq) const {
        const int row0 = u.pm * BM + wr * 64 + fr; const int col0 = u.pn * BM + wc * 32 + 8 * fq;
#pragma unroll
        for (int ai = 0; ai < 2; ++ai)
#pragma unroll
            for (int m = 0; m < 4; ++m) { bf16_t* rowp = O + (size_t)(row0 + ai * HALF + m * 16) * ldc + col0;
#pragma unroll
                for (int bj = 0; bj < 2; ++bj) { const f32x4 v0 = acc[ai][bj][m][0], v1 = acc[ai][bj][m][1];
                    u32x4 w; w.x = cvt_pk_bf16(v0[0], v0[1]); w.y = cvt_pk_bf16(v0[2], v0[3]); w.z = cvt_pk_bf16(v1[0], v1[1]); w.w = cvt_pk_bf16(v1[2], v1[3]);
                    *(u32x4*)(rowp + bj * HALF) = w; } }
    }
};
struct EpiF32P {
    static constexpr bool PERM = false, AFTER_DRAIN = false;
    float* C; int ldc;
    __device__ __forceinline__ void operator()(const f32x4 (&acc)[2][2][4][2], const Unit& u, int wr, int wc, int fr, int fq) const {
        const int row0 = u.pm * BM + wr * 64 + fr, col0 = u.pn * BM + wc * 32 + 4 * fq;
#pragma unroll
        for (int ai = 0; ai < 2; ++ai)
#pragma unroll
            for (int m = 0; m < 4; ++m) { float* rowp = C + (size_t)(row0 + ai * HALF + m * 16) * ldc + col0;
#pragma unroll
                for (int bj = 0; bj < 2; ++bj)
#pragma unroll
                    for (int n = 0; n < 2; ++n) *(f32x4*)(rowp + bj * HALF + n * 16) = acc[ai][bj][m][n]; }
    }
};
struct EpiResid {
    static constexpr bool PERM = false, AFTER_DRAIN = false;
    const float* xin; float* out;
    __device__ __forceinline__ void operator()(const f32x4 (&acc)[2][2][4][2], const Unit& u, int wr, int wc, int fr, int fq) const {
        const int row0 = u.pm * BM + wr * 64 + fr, col0 = u.pn * BM + wc * 32 + 4 * fq;
#pragma unroll
        for (int ai = 0; ai < 2; ++ai)
#pragma unroll
            for (int m = 0; m < 4; ++m) { const size_t ro = (size_t)(row0 + ai * HALF + m * 16) * 2048 + col0;
#pragma unroll
                for (int bj = 0; bj < 2; ++bj)
#pragma unroll
                    for (int n = 0; n < 2; ++n) { const f32x4 xv = *(const f32x4*)(xin + ro + bj * HALF + n * 16); *(f32x4*)(out + ro + bj * HALF + n * 16) = xv + acc[ai][bj][m][n]; } }
    }
};
template <bool ACC> struct EpiGate {
    static constexpr bool PERM = true, AFTER_DRAIN = false;
    const bf16_t* G; int gofs; bf16_t* MG;
    __device__ __forceinline__ void operator()(const f32x4 (&acc)[2][2][4][2], const Unit& u, int wr, int wc, int fr, int fq) const {
        const int row0 = u.pm * BM + wr * 64 + fr; const int col0 = u.pn * BM + wc * 32 + 8 * fq;
#pragma unroll
        for (int ai = 0; ai < 2; ++ai)
#pragma unroll
            for (int m = 0; m < 4; ++m) { const int row = row0 + ai * HALF + m * 16;
#pragma unroll
                for (int bj = 0; bj < 2; ++bj) { const int col = col0 + bj * HALF;
                    const u32x4 gv = *(const u32x4*)(G + (size_t)row * 6144 + gofs + col);
                    const f32x4 a0 = acc[ai][bj][m][0], a1 = acc[ai][bj][m][1];
                    float r[8];
                    r[0] = __builtin_bit_cast(float, gv.x << 16) * a0[0]; r[1] = __builtin_bit_cast(float, gv.x & 0xffff0000u) * a0[1];
                    r[2] = __builtin_bit_cast(float, gv.y << 16) * a0[2]; r[3] = __builtin_bit_cast(float, gv.y & 0xffff0000u) * a0[3];
                    r[4] = __builtin_bit_cast(float, gv.z << 16) * a1[0]; r[5] = __builtin_bit_cast(float, gv.z & 0xffff0000u) * a1[1];
                    r[6] = __builtin_bit_cast(float, gv.w << 16) * a1[2]; r[7] = __builtin_bit_cast(float, gv.w & 0xffff0000u) * a1[3];
                    bf16_t* mp = MG + (size_t)row * 2048 + col;
                    if (ACC) { const u32x4 ov = *(const u32x4*)mp;
                        r[0] += __builtin_bit_cast(float, ov.x << 16); r[1] += __builtin_bit_cast(float, ov.x & 0xffff0000u);
                        r[2] += __builtin_bit_cast(float, ov.y << 16); r[3] += __builtin_bit_cast(float, ov.y & 0xffff0000u);
                        r[4] += __builtin_bit_cast(float, ov.z << 16); r[5] += __builtin_bit_cast(float, ov.z & 0xffff0000u);
                        r[6] += __builtin_bit_cast(float, ov.w << 16); r[7] += __builtin_bit_cast(float, ov.w & 0xffff0000u); }
                    u32x4 w; w.x = cvt_pk_bf16(r[0], r[1]); w.y = cvt_pk_bf16(r[2], r[3]); w.z = cvt_pk_bf16(r[4], r[5]); w.w = cvt_pk_bf16(r[6], r[7]);
                    *(u32x4*)mp = w; } }
    }
};
}

struct Args { const float* in[25]; float* out; unsigned char* ws; int ph_lo, ph_hi, li, pad; };

struct Ctx {
    LAS unsigned char* lds;
    int tid, lane, wave, G, bid;
    int gw, ngw;
};

__device__ __forceinline__ void transpose_item(const float* W, int K, int N, bf16* WT, int kb, int nb, int dst_row0, LAS float* scr, int lane) {
    const int k0 = 64 * kb, n0 = 32 * nb;
#pragma unroll 8
    for (int i = 0; i < 32; ++i) { const int kk = 2 * i + (lane >> 5); scr[kk * 33 + (lane & 31)] = W[(size_t)(k0 + kk) * N + n0 + (lane & 31)]; }
    LDS_WAIT(); asm volatile("" ::: "memory");
    const int c = lane & 7;
#pragma unroll
    for (int j = 0; j < 4; ++j) { const int n = (lane >> 3) + 8 * j; const LAS float* s = scr + (8 * c) * 33 + n;
        v4u o; o.x = pk2(s[0 * 33], s[1 * 33]); o.y = pk2(s[2 * 33], s[3 * 33]); o.z = pk2(s[4 * 33], s[5 * 33]); o.w = pk2(s[6 * 33], s[7 * 33]);
        *(v4u*)(WT + (size_t)(dst_row0 + n) * K + k0 + 8 * c) = o; }
    LDS_WAIT(); asm volatile("" ::: "memory");
}
__device__ __forceinline__ int transpose_matrix(const Ctx& C, const float* W, int K, int N, bf16* WT, int gate_split, int base) {
    LAS float* scr = (LAS float*)(C.lds + RING_OFF + C.wave * 16384);
    const int nblk = N / 32, items = (K / 64) * nblk;
    int first = (C.gw - base) % C.ngw; if (first < 0) first += C.ngw;
    for (int it = first; it < items; it += C.ngw) {
        const int kb = it / nblk, nb = it % nblk; int dr = 32 * nb; if (gate_split && dr >= C_END) dr += 64;
        transpose_item(W, K, N, WT, kb, nb, dr, scr, C.lane);
    }
    return base + items;
}

__device__ __forceinline__ void rms_row_bf16(const float* xrow, const float* gam, bf16* orow, int lane) {
    const f32x4* xr = (const f32x4*)xrow + lane; f32x4 v[8]; float s = 0.f;
#pragma unroll
    for (int j = 0; j < 8; ++j) { v[j] = xr[64 * j]; s += (v[j].x * v[j].x + v[j].y * v[j].y) + (v[j].z * v[j].z + v[j].w * v[j].w); }
    const float rs = 1.0f / sqrtf(wave_sum(s) * (1.0f / D) + NORM_EPS);
    const f32x4* gr = (const f32x4*)gam + lane; v2u* o8 = (v2u*)orow + lane;
#pragma unroll
    for (int j = 0; j < 8; ++j) { const f32x4 g = gr[64 * j]; v2u w; w.x = pk2(v[j].x * rs * g.x, v[j].y * rs * g.y); w.y = pk2(v[j].z * rs * g.z, v[j].w * rs * g.w); o8[64 * j] = w; }
}
__device__ __forceinline__ void rms_row_f32(float* xrow, const float* gam, int lane) {
    f32x4* xr = (f32x4*)xrow + lane; f32x4 v[8]; float s = 0.f;
#pragma unroll
    for (int j = 0; j < 8; ++j) { v[j] = xr[64 * j]; s += (v[j].x * v[j].x + v[j].y * v[j].y) + (v[j].z * v[j].z + v[j].w * v[j].w); }
    const float rs = 1.0f / sqrtf(wave_sum(s) * (1.0f / D) + NORM_EPS);
    const f32x4* gr = (const f32x4*)gam + lane;
#pragma unroll
    for (int j = 0; j < 8; ++j) { const f32x4 g = gr[64 * j]; xr[64 * j] = v[j] * rs * g; }
}

__device__ __forceinline__ void phase_prep(const Ctx& C, const Args& a, int l, const float* xsrc, unsigned char* ws) {
    int base = 0;
    base = transpose_matrix(C, a.in[3] + (size_t)l * D * DIN, D, DIN, (bf16*)(ws + WS_WIN), 1, base);
    base = transpose_matrix(C, a.in[21] + (size_t)l * D * NUP, D, NUP, (bf16*)(ws + WS_WUP), 0, base);
    base = transpose_matrix(C, a.in[23] + (size_t)l * DFF * D, DFF, D, (bf16*)(ws + WS_WDOWN), 0, base);
    base = transpose_matrix(C, a.in[19] + (size_t)l * D * D, D, D, (bf16*)(ws + WS_WOUT), 0, base);
    base = transpose_matrix(C, a.in[16] + (size_t)l * 512 * D, 512, D, (bf16*)(ws + WS_PA), 0, base);
    base = transpose_matrix(C, a.in[17] + (size_t)l * 768 * D, 768, D, (bf16*)(ws + WS_PB), 0, base);
    base = transpose_matrix(C, a.in[18] + (size_t)l * 256 * D, 256, D, (bf16*)(ws + WS_PC), 0, base);
    const int gt = C.bid * NTHREADS + C.tid, ngt = C.G * NTHREADS;
    { v4u* z = (v4u*)((bf16*)(ws + WS_WIN) + (size_t)C_END * D); for (int i = gt; i < 64 * D / 8; i += ngt) z[i] = (v4u){0u, 0u, 0u, 0u}; }
    { bf16* wl = (bf16*)(ws + WS_WLORA); const float* wup = a.in[7] + (size_t)l * 96 * BW; const float* aup = a.in[9] + (size_t)l * 96 * BW; const float* gup = a.in[10] + (size_t)l * 256 * BW;
      for (int i = gt; i < NLORA * KLORA; i += ngt) { const int n = i / KLORA, k = i % KLORA; float v = 0.f;
          if (n < 768) { if (k < 96) v = wup[k * BW + n]; }
          else if (n < 1536) { if (k >= 96 && k < 192) v = aup[(k - 96) * BW + (n - 768)]; }
          else { if (k >= 192 && k < 448) v = gup[(k - 192) * BW + (n - 1536)]; }
          wl[i] = (bf16)f2bf(v); } }
    const float* g1 = a.in[2] + (size_t)l * D; bf16* H = (bf16*)(ws + WS_H);
    for (int m = C.gw; m < M; m += C.ngw) rms_row_bf16(xsrc + (size_t)m * D, g1, H + (size_t)m * D, C.lane);
}

__device__ __forceinline__ void phase_aprime(const Ctx& C, const Args& a, int l, unsigned char* ws) {
    const bf16* P1 = (const bf16*)(ws + WS_P1); bf16* AP = (bf16*)(ws + WS_AP); const float* mu = a.in[5] + (size_t)l * BCOLS;
    const int g = C.lane, c0 = 8 * g;
    float muv[8];
#pragma unroll
    for (int j = 0; j < 8; ++j) muv[j] = (g < 56) ? mu[(C_WD - C_R) + c0 + j] : 0.f;
    for (int m = C.gw; m < M; m += C.ngw) {
        v4u o = (v4u){0u, 0u, 0u, 0u};
        if (g < 56) {
            const v4u cur = *(const v4u*)(P1 + (size_t)m * NP1 + C_WD + c0);
            v4u prv = (v4u){0u, 0u, 0u, 0u}; if ((m & (SEQ - 1)) != 0) prv = *(const v4u*)(P1 + (size_t)(m - 1) * NP1 + C_WD + c0);
            float x[8], p[8];
            x[0] = bflo(cur.x); x[1] = bfhi(cur.x); x[2] = bflo(cur.y); x[3] = bfhi(cur.y); x[4] = bflo(cur.z); x[5] = bfhi(cur.z); x[6] = bflo(cur.w); x[7] = bfhi(cur.w);
            p[0] = bflo(prv.x); p[1] = bfhi(prv.x); p[2] = bflo(prv.y); p[3] = bfhi(prv.y); p[4] = bflo(prv.z); p[5] = bfhi(prv.z); p[6] = bflo(prv.w); p[7] = bfhi(prv.w);
#pragma unroll
            for (int j = 0; j < 8; ++j) { float v = x[j] + (p[j] - x[j]) * muv[j];
                if (g < 12) v = tanhf(v); else if (g >= 24) v = sigmoidf_(v);
                x[j] = v; }
            o.x = pk2(x[0], x[1]); o.y = pk2(x[2], x[3]); o.z = pk2(x[4], x[5]); o.w = pk2(x[6], x[7]);
        }
        *(v4u*)(AP + (size_t)m * KLORA + c0) = o;
    }
}

__device__ __forceinline__ void phase_scanprep(const Ctx& C, const Args& a, int l, unsigned char* ws) {
    const bf16* P1 = (const bf16*)(ws + WS_P1); const float* LO = (const float*)(ws + WS_LO);
    float* SR = (float*)(ws + WS_SR); float* SW = (float*)(ws + WS_SW); float* SK = (float*)(ws + WS_SK); float* SKK = (float*)(ws + WS_SKK); float* SB = (float*)(ws + WS_SB); float* SV = (float*)(ws + WS_SV);
    const float* mu = a.in[5] + (size_t)l * BCOLS; const float* w0 = a.in[6] + (size_t)l * BW; const float* a0 = a.in[8] + (size_t)l * BW;
    const float* kkw = a.in[11] + (size_t)l * BW; const float* kaw = a.in[12] + (size_t)l * BW;
    for (int it = C.gw; it < M * 12; it += C.ngw) {
        const int m = it / 12, h = it % 12, hc = h * 64 + C.lane; const bool first = (m & (SEQ - 1)) == 0;
        const bf16* pr = P1 + (size_t)m * NP1; const bf16* pp = pr - NP1;
        float r = bf1(pr[C_R + hc]), k = bf1(pr[C_K + hc]), v = bf1(pr[C_V + hc]);
        const float rp = first ? 0.f : bf1(pp[C_R + hc]), kp = first ? 0.f : bf1(pp[C_K + hc]), vp = first ? 0.f : bf1(pp[C_V + hc]);
        r = r + (rp - r) * mu[hc]; k = k + (kp - k) * mu[BW + hc]; v = v + (vp - v) * mu[2 * BW + hc];
        const float wpre = w0[hc] + LO[(size_t)m * NLORA + hc], apre = a0[hc] + LO[(size_t)m * NLORA + BW + hc];
        const float xx = -wpre; const float sp = fmaxf(xx, 0.f) + log1pf(expf(-fabsf(xx)));
        const float wlog = -sp - 0.5f; const float decay = expf(-expf(wlog));
        const float av = 1.0f / (1.0f + expf(-apre));
        const float kkr = k * kkw[hc]; const float nrm = sqrtf(wave_sum(kkr * kkr)); const float kk = kkr / fmaxf(nrm, 1e-12f);
        const float kt = k * (1.0f + (av - 1.0f) * kaw[hc]);
        const size_t o = (size_t)m * BW + hc;
        SR[o] = r; SW[o] = decay; SK[o] = kt; SKK[o] = kk; SB[o] = kk * av; SV[o] = v;
    }
}

__device__ __forceinline__ void scan_block(const Ctx& C, int sb, unsigned char* ws) {
    const int b = sb / 24, h = (sb % 24) >> 1, half = sb & 1;
    const float* SR = (const float*)(ws + WS_SR); const float* SW = (const float*)(ws + WS_SW); const float* SK = (const float*)(ws + WS_SK); const float* SKK = (const float*)(ws + WS_SKK);
    const float* SB = (const float*)(ws + WS_SB); const float* SV = (const float*)(ws + WS_SV); float* YR = (float*)(ws + WS_YRAW);
    constexpr int T = 64;
    LAS float* Lr = (LAS float*)(C.lds + RING_OFF); LAS float* Lw = Lr + T * 64; LAS float* Lk = Lw + T * 64; LAS float* Lkk = Lk + T * 64; LAS float* Lb = Lkk + T * 64;
    LAS float* Lv = Lb + T * 64; LAS float* Ly = Lv + T * 32;
    const int tid = C.tid, rl = tid >> 4, kq = tid & 15;
    const size_t rowbase = (size_t)b * SEQ; const int colh = h * 64;
    const int lt0 = tid >> 4, lc0 = (tid & 15) * 4, vt = tid >> 3, vc = (tid & 7) * 4;
    f32x4 pr[2], pw[2], pk[2], pkk[2], pb[2], pv;
#define SCAN_LOAD(t0) do { _Pragma("unroll") for (int i = 0; i < 2; ++i) { const size_t o = (rowbase + (t0) + lt0 + 32 * i) * BW + colh + lc0; \
        pr[i] = *(const f32x4*)(SR + o); pw[i] = *(const f32x4*)(SW + o); pk[i] = *(const f32x4*)(SK + o); pkk[i] = *(const f32x4*)(SKK + o); pb[i] = *(const f32x4*)(SB + o); } \
        pv = *(const f32x4*)(SV + (rowbase + (t0) + vt) * BW + colh + 32 * half + vc); } while (0)
    SCAN_LOAD(0);
    float S0 = 0.f, S1 = 0.f, S2 = 0.f, S3 = 0.f;
    for (int ch = 0; ch < SEQ / T; ++ch) {
        const int t0 = ch * T;
#pragma unroll
        for (int i = 0; i < 2; ++i) { const int lo = (lt0 + 32 * i) * 64 + lc0;
            *(LAS f32x4*)(Lr + lo) = pr[i]; *(LAS f32x4*)(Lw + lo) = pw[i]; *(LAS f32x4*)(Lk + lo) = pk[i]; *(LAS f32x4*)(Lkk + lo) = pkk[i]; *(LAS f32x4*)(Lb + lo) = pb[i]; }
        *(LAS f32x4*)(Lv + vt * 32 + vc) = pv;
        __syncthreads();
        if (ch + 1 < SEQ / T) SCAN_LOAD(t0 + T);
#pragma unroll 4
        for (int t = 0; t < T; ++t) {
            const f32x4 kk4 = *(const LAS f32x4*)(Lkk + t * 64 + kq * 4), w4 = *(const LAS f32x4*)(Lw + t * 64 + kq * 4), b4 = *(const LAS f32x4*)(Lb + t * 64 + kq * 4);
            const f32x4 k4 = *(const LAS f32x4*)(Lk + t * 64 + kq * 4), r4 = *(const LAS f32x4*)(Lr + t * 64 + kq * 4); const float v = Lv[t * 32 + rl];
            float d = (S0 * kk4.x + S1 * kk4.y) + (S2 * kk4.z + S3 * kk4.w); d = red16(d); const float sa = -d;
            S0 = S0 * w4.x + (sa * b4.x + v * k4.x); S1 = S1 * w4.y + (sa * b4.y + v * k4.y); S2 = S2 * w4.z + (sa * b4.z + v * k4.z); S3 = S3 * w4.w + (sa * b4.w + v * k4.w);
            float y = (S0 * r4.x + S1 * r4.y) + (S2 * r4.z + S3 * r4.w); y = red16(y);
            if (kq == 0) Ly[t * 32 + rl] = y;
        }
        __syncthreads();
        *(f32x4*)(YR + (rowbase + t0 + vt) * BW + colh + 32 * half + vc) = *(const LAS f32x4*)(Ly + vt * 32 + vc);
    }
#undef SCAN_LOAD
}

struct AttnPass { int qcol; int bias_head; int tbl; float sink; int use_sink; int maxsteps; bf16* out; int out_ld; int out_col; float* lse; };
__device__ __forceinline__ void attn_stage_kv(const Ctx& C, const bf16* P1, int b, int res, int dil, int fblk, int kcol, int vcol) {
    LAS unsigned char* Ks = C.lds + RING_OFF; LAS unsigned char* Vs = Ks + 256 * 144;
#pragma unroll
    for (int i = 0; i < 4; ++i) { const int c = C.tid + 512 * i, row = c >> 3, part = c & 7; const int fp = (fblk - 1) * 128 + row;
        v4u kv = (v4u){0u, 0u, 0u, 0u}, vv = (v4u){0u, 0u, 0u, 0u};
        if (fp >= 0) { const bf16* src = P1 + ((size_t)b * SEQ + (size_t)fp * dil + res) * NP1; kv = *(const v4u*)(src + kcol + part * 8); vv = *(const v4u*)(src + vcol + part * 8); }
        *(LAS v4u*)(Ks + row * 144 + part * 16) = kv; *(LAS v4u*)(Vs + row * 144 + part * 16) = vv; }
}
__device__ __forceinline__ void attn_pass(const Ctx& C, const bf16* P1, const float* relb, int b, int res, int dil, int fblk, const AttnPass& ap) {
    LAS unsigned char* Ks = C.lds + RING_OFF; LAS unsigned char* Vs = Ks + 256 * 144; LAS float* lut = (LAS float*)(Vs + 256 * 144);
    __syncthreads();
    if (C.tid < 132) lut[C.tid] = (C.tid <= 128) ? relb[(int)T5B[ap.tbl][C.tid] * 20 + ap.bias_head] : 0.f;
    __syncthreads();
    const int i = C.tid >> 2, dq = C.tid & 3;
    const size_t tok = (size_t)b * SEQ + (size_t)(fblk * 128 + i) * dil + res;
    float q[16];
    { const bf16* qp = P1 + tok * NP1 + ap.qcol + dq * 16; const v4u a0 = *(const v4u*)qp, a1 = *(const v4u*)(qp + 8);
      q[0] = bflo(a0.x); q[1] = bfhi(a0.x); q[2] = bflo(a0.y); q[3] = bfhi(a0.y); q[4] = bflo(a0.z); q[5] = bfhi(a0.z); q[6] = bflo(a0.w); q[7] = bfhi(a0.w);
      q[8] = bflo(a1.x); q[9] = bfhi(a1.x); q[10] = bflo(a1.y); q[11] = bfhi(a1.y); q[12] = bflo(a1.z); q[13] = bfhi(a1.z); q[14] = bflo(a1.w); q[15] = bfhi(a1.w);
#pragma unroll
      for (int j = 0; j < 16; ++j) q[j] *= 0.125f; }
    float mrun = ap.use_sink ? ap.sink : -INFINITY, lrun = ap.use_sink ? 1.0f : 0.0f;
    float o[16];
#pragma unroll
    for (int j = 0; j < 16; ++j) o[j] = 0.f;
    const int fq0 = fblk * 128 + i;
    for (int dist = 0; dist <= ap.maxsteps; ++dist) {
        const int kr = i + 128 - dist;
        const bool valid = (fq0 - dist) >= 0;
        const v4u k0 = *(const LAS v4u*)(Ks + kr * 144 + dq * 32), k1 = *(const LAS v4u*)(Ks + kr * 144 + dq * 32 + 16);
        float s = q[0] * bflo(k0.x) + q[1] * bfhi(k0.x) + q[2] * bflo(k0.y) + q[3] * bfhi(k0.y) + q[4] * bflo(k0.z) + q[5] * bfhi(k0.z) + q[6] * bflo(k0.w) + q[7] * bfhi(k0.w)
                + q[8] * bflo(k1.x) + q[9] * bfhi(k1.x) + q[10] * bflo(k1.y) + q[11] * bfhi(k1.y) + q[12] * bflo(k1.z) + q[13] * bfhi(k1.z) + q[14] * bflo(k1.w) + q[15] * bfhi(k1.w);
        s = red4(s) + lut[dist];
        if (valid) {
            if (s > mrun) { const float c = __expf(mrun - s); lrun *= c;
#pragma unroll
                for (int j = 0; j < 16; ++j) o[j] *= c;
                mrun = s; }
            const float p = __expf(s - mrun); lrun += p;
            const v4u v0 = *(const LAS v4u*)(Vs + kr * 144 + dq * 32), v1 = *(const LAS v4u*)(Vs + kr * 144 + dq * 32 + 16);
            o[0] += p * bflo(v0.x); o[1] += p * bfhi(v0.x); o[2] += p * bflo(v0.y); o[3] += p * bfhi(v0.y); o[4] += p * bflo(v0.z); o[5] += p * bfhi(v0.z); o[6] += p * bflo(v0.w); o[7] += p * bfhi(v0.w);
            o[8] += p * bflo(v1.x); o[9] += p * bfhi(v1.x); o[10] += p * bflo(v1.y); o[11] += p * bfhi(v1.y); o[12] += p * bflo(v1.z); o[13] += p * bfhi(v1.z); o[14] += p * bflo(v1.w); o[15] += p * bfhi(v1.w);
        }
    }
    const float inv = 1.0f / lrun;
    v4u w0, w1;
    w0.x = pk2(o[0] * inv, o[1] * inv); w0.y = pk2(o[2] * inv, o[3] * inv); w0.z = pk2(o[4] * inv, o[5] * inv); w0.w = pk2(o[6] * inv, o[7] * inv);
    w1.x = pk2(o[8] * inv, o[9] * inv); w1.y = pk2(o[10] * inv, o[11] * inv); w1.z = pk2(o[12] * inv, o[13] * inv); w1.w = pk2(o[14] * inv, o[15] * inv);
    bf16* op = ap.out + tok * ap.out_ld + ap.out_col + dq * 16;
    *(v4u*)op = w0; *(v4u*)(op + 8) = w1;
    if (ap.lse && dq == 0) ap.lse[tok * 4] = mrun + __logf(lrun);
}
__device__ __forceinline__ void phase_attn(const Ctx& C, const Args& a, int l, unsigned char* ws, int ab, int nab) {
    const bf16* P1 = (const bf16*)(ws + WS_P1); const float* relb = a.in[1]; const float* sinks = a.in[4] + l * 8;
    bf16* YA = (bf16*)(ws + WS_YA); bf16* OC = (bf16*)(ws + WS_OC); float* LSE = (float*)(ws + WS_LSE);
    constexpr int NA = 256, NC = 1536;
    for (int it = ab; it < NA + NC; it += nab) {
        __syncthreads();
        if (it < NA) {
            const int b = it >> 7, fblk = (it >> 1) & 63, hkv = it & 1;
            attn_stage_kv(C, P1, b, 0, 1, fblk, C_AK + hkv * 64, C_AV + hkv * 64);
            for (int g = 0; g < 4; ++g) { const int hq = hkv * 4 + g;
                AttnPass ap; ap.qcol = C_AQ + hq * 64; ap.bias_head = hq; ap.tbl = 0; ap.sink = sinks[hq]; ap.use_sink = 1; ap.maxsteps = 127; ap.out = YA; ap.out_ld = 512; ap.out_col = hq * 64; ap.lse = nullptr;
                attn_pass(C, P1, relb, b, 0, 1, fblk, ap); }
        } else {
            const int ci = it - NA; const int gi = ci / 512, j = (ci >> 7) & 3, qb = ci & 127;
            const int dil = (gi == 0) ? 1 : (gi == 1 ? 4 : 16); const int bps = 64 / dil;
            const int n = qb / bps, fblk = qb % bps, b = n / dil, res = n % dil; const int hc = gi * 4 + j;
            attn_stage_kv(C, P1, b, res, dil, fblk, C_CK + hc * 64, C_CV + hc * 64);
            AttnPass ap; ap.qcol = C_CQ + hc * 64; ap.bias_head = 8 + hc; ap.tbl = gi; ap.sink = 0.f; ap.use_sink = 0; ap.maxsteps = 128; ap.out = OC + (size_t)gi * M * 256; ap.out_ld = 256; ap.out_col = j * 64;
            ap.lse = LSE + (size_t)gi * M * 4 + j;
            attn_pass(C, P1, relb, b, res, dil, fblk, ap);
        }
    }
}

__device__ __forceinline__ void phase_post(const Ctx& C, const Args& a, int l, unsigned char* ws) {
    const float* YR = (const float*)(ws + WS_YRAW); const float* SR = (const float*)(ws + WS_SR); const float* SK = (const float*)(ws + WS_SK); const float* SV = (const float*)(ws + WS_SV);
    const float* LO = (const float*)(ws + WS_LO); bf16* YB = (bf16*)(ws + WS_YB);
    const float* rk = a.in[13] + (size_t)l * BW; const float* lg = a.in[14] + (size_t)l * BW; const float* lb = a.in[15] + (size_t)l * BW;
    for (int it = C.gw; it < M * 12; it += C.ngw) {
        const int m = it / 12, h = it % 12, hc = h * 64 + C.lane; const size_t o = (size_t)m * BW + hc;
        const float y = YR[o]; const float mean = wave_sum(y) * (1.0f / 64.0f); const float dv = y - mean; const float var = wave_sum(dv * dv) * (1.0f / 64.0f);
        float yn = dv * (1.0f / sqrtf(var + GN_EPS)) * lg[hc] + lb[hc];
        const float bonus = wave_sum(SR[o] * SK[o] * rk[hc]);
        yn += bonus * SV[o];
        yn *= LO[(size_t)m * NLORA + 2 * BW + hc];
        YB[o] = (bf16)f2bf(yn);
    }
    const bf16* OC = (const bf16*)(ws + WS_OC); const float* LSE = (const float*)(ws + WS_LSE); bf16* YC = (bf16*)(ws + WS_YC);
    for (int m = C.gw; m < M; m += C.ngw) {
        const int j = C.lane >> 4;
        const float l0 = LSE[(size_t)m * 4 + j], l1 = LSE[((size_t)M + m) * 4 + j], l2 = LSE[((size_t)2 * M + m) * 4 + j];
        const float mx = fmaxf(l0, fmaxf(l1, l2)); const float e0 = __expf(l0 - mx), e1 = __expf(l1 - mx), e2 = __expf(l2 - mx); const float inv = 1.0f / (e0 + e1 + e2);
        const v2u a0 = *(const v2u*)(OC + (size_t)m * 256 + 4 * C.lane), a1 = *(const v2u*)(OC + ((size_t)M + m) * 256 + 4 * C.lane), a2 = *(const v2u*)(OC + ((size_t)2 * M + m) * 256 + 4 * C.lane);
        const float w0 = e0 * inv, w1 = e1 * inv, w2 = e2 * inv;
        v2u o; o.x = pk2(w0 * bflo(a0.x) + w1 * bflo(a1.x) + w2 * bflo(a2.x), w0 * bfhi(a0.x) + w1 * bfhi(a1.x) + w2 * bfhi(a2.x));
        o.y = pk2(w0 * bflo(a0.y) + w1 * bflo(a1.y) + w2 * bflo(a2.y), w0 * bfhi(a0.y) + w1 * bfhi(a1.y) + w2 * bfhi(a2.y));
        *(v2u*)(YC + (size_t)m * 256 + 4 * C.lane) = o;
    }
}

__device__ __forceinline__ void phase_conv(const Ctx& C, const Args& a, int l, unsigned char* ws) {
    const bf16* U = (const bf16*)(ws + WS_U); bf16* ACT = (bf16*)(ws + WS_ACT); const float* cw = a.in[22] + (size_t)l * 3 * DFF;
    constexpr int GPR = DFF / 8;
    const int gt = C.bid * NTHREADS + C.tid, ngt = C.G * NTHREADS;
    for (int idx = gt; idx < M * GPR; idx += ngt) {
        const int m = idx / GPR, f0 = (idx % GPR) * 8, t = m & (SEQ - 1);
        const bf16* ur = U + (size_t)m * NUP + f0;
        const v4u g2 = *(const v4u*)ur; const v4u vv = *(const v4u*)(ur + DFF);
        v4u g1 = (v4u){0u, 0u, 0u, 0u}, g0 = (v4u){0u, 0u, 0u, 0u};
        if (t >= 1) g1 = *(const v4u*)(ur - NUP); if (t >= 2) g0 = *(const v4u*)(ur - 2 * NUP);
        float x2[8], x1[8], x0[8], vl[8], r[8];
        x2[0] = bflo(g2.x); x2[1] = bfhi(g2.x); x2[2] = bflo(g2.y); x2[3] = bfhi(g2.y); x2[4] = bflo(g2.z); x2[5] = bfhi(g2.z); x2[6] = bflo(g2.w); x2[7] = bfhi(g2.w);
        x1[0] = bflo(g1.x); x1[1] = bfhi(g1.x); x1[2] = bflo(g1.y); x1[3] = bfhi(g1.y); x1[4] = bflo(g1.z); x1[5] = bfhi(g1.z); x1[6] = bflo(g1.w); x1[7] = bfhi(g1.w);
        x0[0] = bflo(g0.x); x0[1] = bfhi(g0.x); x0[2] = bflo(g0.y); x0[3] = bfhi(g0.y); x0[4] = bflo(g0.z); x0[5] = bfhi(g0.z); x0[6] = bflo(g0.w); x0[7] = bfhi(g0.w);
        vl[0] = bflo(vv.x); vl[1] = bfhi(vv.x); vl[2] = bflo(vv.y); vl[3] = bfhi(vv.y); vl[4] = bflo(vv.z); vl[5] = bfhi(vv.z); vl[6] = bflo(vv.w); vl[7] = bfhi(vv.w);
#pragma unroll
        for (int j = 0; j < 8; ++j) { const float gsum = cw[f0 + j] * x0[j] + cw[DFF + f0 + j] * x1[j] + cw[2 * DFF + f0 + j] * x2[j];
            r[j] = gsum / (1.0f + __expf(-gsum)) * vl[j]; }
        v4u o; o.x = pk2(r[0], r[1]); o.y = pk2(r[2], r[3]); o.z = pk2(r[4], r[5]); o.w = pk2(r[6], r[7]);
        *(v4u*)(ACT + (size_t)m * DFF + f0) = o;
    }
}

__device__ __forceinline__ Ctx make_ctx(unsigned char* lds) {
    Ctx C;
    C.lds = (LAS unsigned char*)lds;
    int t = threadIdx.x; asm volatile("" : "+v"(t));
    C.tid = t; C.lane = C.tid & 63; C.wave = __builtin_amdgcn_readfirstlane(C.tid >> 6);
    C.G = gridDim.x; C.bid = blockIdx.x; C.gw = C.bid * NWAVES + C.wave; C.ngw = C.G * NWAVES;
    return C;
}
template <int K> __device__ __forceinline__ void run_phase(unsigned char* lds, const Args& args, int l) {
    const Ctx C = make_ctx(lds);
    unsigned char* ws = args.ws; asm volatile("" : "+s"(ws)); LAS unsigned char* ring = C.lds + RING_OFF; float* out = args.out;
    const float* xsrc = (l == 0) ? args.in[0] : out;
    if constexpr (K == 0) { phase_prep(C, args, l, xsrc, ws); }
    if constexpr (K == 1) { pg8::Gemm g{(const bf16*)(ws + WS_H), (const bf16*)(ws + WS_WIN), M, NWIN, D}; pg8::StaticOrder S; S.init(M, NWIN, C.G, C.bid);
        pg8::EpiWin E{(bf16*)(ws + WS_P1), (bf16*)(ws + WS_G)};
        pg8::gemm_phase<pg8::EpiWin, pg8::StaticOrder, true, true>(ring, g, S, E); }
    if constexpr (K == 2) { phase_aprime(C, args, l, ws); }
    if constexpr (K == 3) { pg8::Gemm g{(const bf16*)(ws + WS_AP), (const bf16*)(ws + WS_WLORA), M, NLORA, KLORA}; pg8::StaticOrder S; S.init(M, NLORA, C.G, C.bid);
        pg8::EpiF32P E{(float*)(ws + WS_LO), NLORA};
        pg8::gemm_phase<pg8::EpiF32P, pg8::StaticOrder, true, true>(ring, g, S, E); }
    if constexpr (K == 4) { phase_scanprep(C, args, l, ws); }
    if constexpr (K == 5) { if (C.bid < NSCAN) scan_block(C, C.bid, ws); else phase_attn(C, args, l, ws, C.bid - NSCAN, C.G - NSCAN); }
    if constexpr (K == 6) { phase_post(C, args, l, ws); }
    if constexpr (K == 7) {
        { pg8::Gemm g{(const bf16*)(ws + WS_YA), (const bf16*)(ws + WS_PA), M, D, 512}; pg8::StaticOrder S; S.init(M, D, C.G, C.bid);
          pg8::EpiGate<false> E{(const bf16*)(ws + WS_G), 0, (bf16*)(ws + WS_MG)};
          pg8::gemm_phase<pg8::EpiGate<false>, pg8::StaticOrder, true, true>(ring, g, S, E); }
        { pg8::Gemm g{(const bf16*)(ws + WS_YB), (const bf16*)(ws + WS_PB), M, D, 768}; pg8::StaticOrder S; S.init(M, D, C.G, C.bid);
          pg8::EpiGate<true> E{(const bf16*)(ws + WS_G), 2048, (bf16*)(ws + WS_MG)};
          pg8::gemm_phase<pg8::EpiGate<true>, pg8::StaticOrder, true, true>(ring, g, S, E); }
        { pg8::Gemm g{(const bf16*)(ws + WS_YC), (const bf16*)(ws + WS_PC), M, D, 256}; pg8::StaticOrder S; S.init(M, D, C.G, C.bid);
          pg8::EpiGate<true> E{(const bf16*)(ws + WS_G), 4096, (bf16*)(ws + WS_MG)};
          pg8::gemm_phase<pg8::EpiGate<true>, pg8::StaticOrder, true, true>(ring, g, S, E); } }
    if constexpr (K == 8) { pg8::Gemm g{(const bf16*)(ws + WS_MG), (const bf16*)(ws + WS_WOUT), M, D, D}; pg8::StaticOrder S; S.init(M, D, C.G, C.bid);
        pg8::EpiResid E{xsrc, out};
        pg8::gemm_phase<pg8::EpiResid, pg8::StaticOrder, true, true>(ring, g, S, E); }
    if constexpr (K == 9) { const float* g2 = args.in[20] + (size_t)l * D; bf16* H = (bf16*)(ws + WS_H);
        for (int m = C.gw; m < M; m += C.ngw) rms_row_bf16(out + (size_t)m * D, g2, H + (size_t)m * D, C.lane); }
    if constexpr (K == 10) { pg8::Gemm g{(const bf16*)(ws + WS_H), (const bf16*)(ws + WS_WUP), M, NUP, D}; pg8::StaticOrder S; S.init(M, NUP, C.G, C.bid);
        pg8::EpiBf16P E{(bf16*)(ws + WS_U), NUP};
        pg8::gemm_phase<pg8::EpiBf16P, pg8::StaticOrder, true, true>(ring, g, S, E); }
    if constexpr (K == 11) { phase_conv(C, args, l, ws); }
    if constexpr (K == 12) { pg8::Gemm g{(const bf16*)(ws + WS_ACT), (const bf16*)(ws + WS_WDOWN), M, D, DFF}; pg8::StaticOrder S; S.init(M, D, C.G, C.bid);
        pg8::EpiResid E{out, out};
        pg8::gemm_phase<pg8::EpiResid, pg8::StaticOrder, true, true>(ring, g, S, E); }
    if constexpr (K == 13) { const float* gf = args.in[24];
        for (int m = C.gw; m < M; m += C.ngw) rms_row_f32(out + (size_t)m * D, gf, C.lane); }
}
template <int K> __global__ void __launch_bounds__(NTHREADS, 2) fwd_phase(Args args) {
    extern __shared__ __attribute__((aligned(16))) unsigned char lds[];
    run_phase<K>(lds, args, args.li);
}
__global__ void __launch_bounds__(NTHREADS, 2) fwd_all(Args args) {
    extern __shared__ __attribute__((aligned(16))) unsigned char lds[];
    { LAS unsigned* ctlw = (LAS unsigned*)((LAS unsigned char*)lds + LDSCTL_OFF); for (int u = threadIdx.x; u < (LDS_BYTES - LDSCTL_OFF) / 4; u += NTHREADS) ctlw[u] = 0u; }
    __syncthreads();
    const XcdBarrier bar = xcd_barrier_post((unsigned*)(args.ws + WS_CTL) + CW_BAR, (volatile LAS unsigned*)((LAS unsigned char*)lds + MISC_OFF) + 8);
    for (int l = 0; l < DEPTH; ++l) {
        run_phase<0>(lds, args, l); xcd_barrier(bar);
        run_phase<1>(lds, args, l); xcd_barrier(bar);
        run_phase<2>(lds, args, l); xcd_barrier(bar);
        run_phase<3>(lds, args, l); xcd_barrier(bar);
        run_phase<4>(lds, args, l); xcd_barrier(bar);
        run_phase<5>(lds, args, l); xcd_barrier(bar);
        run_phase<6>(lds, args, l); xcd_barrier(bar);
        run_phase<7>(lds, args, l); xcd_barrier(bar);
        run_phase<8>(lds, args, l); xcd_barrier(bar);
        run_phase<9>(lds, args, l); xcd_barrier(bar);
        run_phase<10>(lds, args, l); xcd_barrier(bar);
        run_phase<11>(lds, args, l); xcd_barrier(bar);
        run_phase<12>(lds, args, l); xcd_barrier(bar);
    }
    run_phase<13>(lds, args, 0);
}

#ifndef MK_ONE_LAUNCH
#define MK_ONE_LAUNCH 1
#endif
template <int K> static void launch_phase(int grid, hipStream_t stream, Args a, int l) {
    static bool attr = false; if (!attr) { (void)hipFuncSetAttribute((const void*)fwd_phase<K>, hipFuncAttributeMaxDynamicSharedMemorySize, LDS_BYTES); attr = true; }
    a.li = l; a.ph_lo = K; a.ph_hi = K + 1;
    hipLaunchKernelGGL(fwd_phase<K>, dim3(grid), dim3(NTHREADS), LDS_BYTES, stream, a);
}
extern "C" void kernel_launch(void* const* d_in, const int* in_sizes, int n_in, void* d_out, int out_size, void* d_ws, size_t ws_size, hipStream_t stream) {
    static int grid = 0;
    if (grid == 0) {
        if (n_in != 25 || in_sizes[0] != M * D || out_size != M * D || ws_size < WS_END) { fprintf(stderr, "kernel_launch: unexpected shapes (n_in %d, in0 %d, out %d, ws %zu < %zu)\n", n_in, n_in > 0 ? in_sizes[0] : -1, out_size, ws_size, (size_t)WS_END); grid = -1; return; }
        int dev = 0, cus = 0;
        if (hipGetDevice(&dev) != hipSuccess || hipDeviceGetAttribute(&cus, hipDeviceAttributeMultiprocessorCount, dev) != hipSuccess) { grid = -1; return; }
        grid = cus;
    }
    if (grid < 0) return;
    (void)hipMemsetAsync((char*)d_ws + WS_CTL, 0, CTL_ZERO_BYTES, stream);
    Args a{};
    for (int i = 0; i < 25; ++i) a.in[i] = (const float*)d_in[i];
    a.out = (float*)d_out; a.ws = (unsigned char*)d_ws; a.pad = 0;
#if MK_ONE_LAUNCH
    { static bool attr = false; if (!attr) { (void)hipFuncSetAttribute((const void*)fwd_all, hipFuncAttributeMaxDynamicSharedMemorySize, LDS_BYTES); attr = true; }
      a.li = 0; a.ph_lo = 0; a.ph_hi = NPHASES;
      hipLaunchKernelGGL(fwd_all, dim3(grid), dim3(NTHREADS), LDS_BYTES, stream, a); }
#else
    for (int l = 0; l < DEPTH; ++l) {
        launch_phase<0>(grid, stream, a, l); launch_phase<1>(grid, stream, a, l); launch_phase<2>(grid, stream, a, l); launch_phase<3>(grid, stream, a, l);
        launch_phase<4>(grid, stream, a, l); launch_phase<5>(grid, stream, a, l); launch_phase<6>(grid, stream, a, l); launch_phase<7>(grid, stream, a, l);
        launch_phase<8>(grid, stream, a, l); launch_phase<9>(grid, stream, a, l); launch_phase<10>(grid, stream, a, l); launch_phase<11>(grid, stream, a, l);
        launch_phase<12>(grid, stream, a, l);
    }
    launch_phase<13>(grid, stream, a, 0);
#endif
}
```

```cpp
#include <hip/hip_runtime.h>
#include <cstdio>
#include <cstdint>
#include <cmath>
#define GAS __attribute__((address_space(1)))
#define LAS __attribute__((address_space(3)))
namespace pg8 {
#define PG8_LAS __attribute__((address_space(3)))
typedef unsigned short bf16_t;
typedef short bf16x8 __attribute__((ext_vector_type(8)));
typedef float f32x4 __attribute__((ext_vector_type(4)));
typedef unsigned u32x4 __attribute__((ext_vector_type(4)));
constexpr int BM = 256, BK = 64, HALF = 128, HTB = HALF * BK * 2  , STAGE_BYTES = 8 * HTB, NXCD = 8, WGM = 8;

__host__ __device__ __forceinline__ int lds_byte(int r, int c) { const int st = (r >> 4) * 2 + (c >> 5), rr = r & 15, cc = c & 31, ob = rr * 64 + cc * 2; return st * 1024 + (ob ^ (((ob >> 9) & 1) << 5)); }
__host__ __device__ __forceinline__ void stage_rc(int b, int& R, int& C) { const int st = b / 1024, sb = b % 1024, swz = sb ^ (((sb >> 9) & 1) << 5); R = (st >> 1) * 16 + swz / 64; C = (st & 1) * 32 + (swz % 64) / 2; }
__host__ __device__ __forceinline__ int perm32(int rho) { const int n = rho >> 4, i = rho & 15; return 8 * (i >> 2) + 4 * n + (i & 3); }

struct Unit { int pm, pn; };
struct Gemm { const bf16_t* A; const bf16_t* Bt; int M, N, K; };

struct StaticOrder {
    int nM, nN, nwg, G, c;
    __host__ __device__ void init(int M, int N, int G_, int c_) { nM = M / BM; nN = N / BM; nwg = nM * nN; G = G_; c = c_; }
    __host__ __device__ bool next(int i, Unit& u) const {
        const long L = (long)i * G + c; if (L >= nwg) return false;
        int wgid = (int)L; { const int q = nwg / NXCD, r = nwg % NXCD, xcd = wgid % NXCD, off = wgid / NXCD; wgid = (xcd < r ? xcd * (q + 1) : r * (q + 1) + (xcd - r) * q) + off; }
        const int nig = WGM * nN, gid = wgid / nig, fm = gid * WGM, gsz = (nM - fm) < WGM ? (nM - fm) : WGM;
        u.pm = fm + ((wgid % nig) % gsz); u.pn = (wgid % nig) / gsz; return true;
    }
    __device__ __forceinline__ void a_ready(const Unit&) const {}
    __device__ __forceinline__ void done(const Unit&) const {}
};
__device__ __forceinline__ unsigned cvt_pk_bf16(float lo, float hi) { unsigned r; asm volatile("v_cvt_pk_bf16_f32 %0, %1, %2" : "=v"(r) : "v"(lo), "v"(hi)); return r; }
template <class Epi, class Sched, bool ALIGN_EPI = false, bool SP2 = false>
__device__ __forceinline__ void gemm_phase(PG8_LAS unsigned char* lds, const Gemm g, const Sched& S, const Epi& E) {
    int tid_ = threadIdx.x; asm volatile("" : "+v"(tid_));
    const int tid = tid_, wid = __builtin_amdgcn_readfirstlane(tid >> 6), lane = tid & 63, wr = wid >> 2, wc = wid & 3, fr = lane & 15, fq = lane >> 4;
    const int K = g.K, nt = K / BK;
    unsigned voffA[2], voffB[2];
#pragma unroll
    for (int i = 0; i < 2; ++i) { int R, C; stage_rc(tid * 16 + i * 8192, R, C); const int Rb = Epi::PERM ? ((R & ~31) + perm32(R & 31)) : R;
        voffA[i] = (unsigned)(R * K + C) * 2u; voffB[i] = (unsigned)(Rb * K + C) * 2u; }
    const size_t kstep = (size_t)(BK * 2);
    const size_t hstep = (size_t)HALF * K * 2;
    const size_t tstep = 2 * hstep;
    const unsigned ldsw = (unsigned)wid * 1024u;
    const int aoff = lds_byte(wr * 64 + fr, fq * 8), boff = lds_byte(wc * 32 + fr, fq * 8);
#define PG8_SA(b, h) (((b) * 2 + (h)) * HTB)
#define PG8_SB(b, h) ((4 + (b) * 2 + (h)) * HTB)
#define PG8_STAGE(bufoff, gbase, voff) do { _Pragma("unroll") for (int _i = 0; _i < 2; ++_i) \
        __builtin_amdgcn_global_load_lds((const unsigned*)((const char*)(gbase) + (voff)[_i]), (PG8_LAS unsigned*)(lds + (bufoff) + ldsw + _i * 8192), 16, 0, 0); } while (0)
#define PG8_LDA(dst, b, h) do { _Pragma("unroll") for (int m = 0; m < 4; ++m) _Pragma("unroll") for (int k = 0; k < 2; ++k) dst[m][k] = *(const PG8_LAS bf16x8*)(lds + PG8_SA(b, h) + aoff + m * 2048 + k * 1024); } while (0)
#define PG8_LDB(dst, b, h) do { _Pragma("unroll") for (int n = 0; n < 2; ++n) _Pragma("unroll") for (int k = 0; k < 2; ++k) dst[n][k] = *(const PG8_LAS bf16x8*)(lds + PG8_SB(b, h) + boff + n * 2048 + k * 1024); } while (0)
#define PG8_MMA(ai, bj, At, Bt) do { __builtin_amdgcn_s_setprio(1); _Pragma("unroll") for (int m = 0; m < 4; ++m) _Pragma("unroll") for (int n = 0; n < 2; ++n) _Pragma("unroll") for (int k = 0; k < 2; ++k) \
        acc[ai][bj][m][n] = __builtin_amdgcn_mfma_f32_16x16x32_bf16(Bt[n][k], At[m][k], acc[ai][bj][m][n], 0, 0, 0); __builtin_amdgcn_s_setprio(0); } while (0)
#define PG8_WAIT_V(n) asm volatile("s_waitcnt vmcnt(" #n ")" ::: "memory")
#define PG8_WAIT_L(n) asm volatile("s_waitcnt lgkmcnt(" #n ")" ::: "memory")
#define PG8_BAR __builtin_amdgcn_s_barrier()
#define PG8_SCHED __builtin_amdgcn_sched_barrier(0)
    Unit cur, nxt; int ui = 0;
    if (!S.next(0, cur)) return;
    f32x4 acc[2][2][4][2];
#pragma unroll
    for (int a = 0; a < 2; ++a)
#pragma unroll
        for (int b = 0; b < 2; ++b)
#pragma unroll
            for (int m = 0; m < 4; ++m)
#pragma unroll
                for (int n = 0; n < 2; ++n) acc[a][b][m][n] = (f32x4){0.f, 0.f, 0.f, 0.f};
    bf16x8 At[4][2], B0[2][2], B1[2][2];
    const char* cA = (const char*)g.A + (size_t)cur.pm * tstep; const char* cB = (const char*)g.Bt + (size_t)cur.pn * tstep;
    S.a_ready(cur);
    if constexpr (SP2) {
        PG8_STAGE(PG8_SB(0, 0), cB, voffB); PG8_STAGE(PG8_SB(0, 1), cB + hstep, voffB); PG8_STAGE(PG8_SA(0, 0), cA, voffA); PG8_STAGE(PG8_SA(0, 1), cA + hstep, voffA);
        if (wr == 1) PG8_BAR;
        PG8_WAIT_V(2); PG8_BAR;
        PG8_STAGE(PG8_SB(1, 0), cB + kstep, voffB); PG8_STAGE(PG8_SA(1, 0), cA + kstep, voffA); PG8_STAGE(PG8_SB(1, 1), cB + hstep + kstep, voffB);
        PG8_WAIT_V(6); PG8_BAR;
    } else {
        PG8_STAGE(PG8_SB(0, 0), cB, voffB); PG8_STAGE(PG8_SA(0, 0), cA, voffA); PG8_STAGE(PG8_SB(0, 1), cB + hstep, voffB); PG8_STAGE(PG8_SA(0, 1), cA + hstep, voffA);
        if (wr == 1) PG8_BAR;
        PG8_WAIT_V(4); PG8_BAR;
        PG8_STAGE(PG8_SB(1, 0), cB + kstep, voffB); PG8_STAGE(PG8_SA(1, 0), cA + kstep, voffA); PG8_STAGE(PG8_SB(1, 1), cB + hstep + kstep, voffB);
        PG8_WAIT_V(6); PG8_BAR;
    }
    for (;;) {
        const bool has_next = S.next(ui + 1, nxt);
        const char* nA = has_next ? (const char*)g.A + (size_t)nxt.pm * tstep : cA; const char* nB = has_next ? (const char*)g.Bt + (size_t)nxt.pn * tstep : cB;
        for (int t = 0; t < nt; t += 2) {
            const bool last = (t == nt - 2);
            const char* a1 = cA + (size_t)(t + 1) * kstep;
            const char* a2 = last ? nA : cA + (size_t)(t + 2) * kstep; const char* b2 = last ? nB : cB + (size_t)(t + 2) * kstep;
            const char* a3 = a2 + kstep; const char* b3 = b2 + kstep;
            if (last && has_next) S.a_ready(nxt);
            if constexpr (SP2) {
            PG8_LDB(B0, 0, 0); PG8_LDB(B1, 0, 1); PG8_SCHED; PG8_LDA(At, 0, 0); PG8_STAGE(PG8_SA(1, 1), a1 + hstep, voffA);
            PG8_WAIT_V(8); PG8_WAIT_L(0); PG8_BAR; PG8_MMA(0, 0, At, B0); PG8_MMA(0, 1, At, B1); PG8_BAR; PG8_SCHED;
            PG8_LDA(At, 0, 1); PG8_STAGE(PG8_SB(0, 0), b2, voffB); PG8_STAGE(PG8_SB(0, 1), b2 + hstep, voffB); PG8_STAGE(PG8_SA(0, 0), a2, voffA);
            PG8_WAIT_V(8); PG8_WAIT_L(0); PG8_BAR; PG8_MMA(1, 0, At, B0); PG8_MMA(1, 1, At, B1); PG8_BAR; PG8_SCHED;
            PG8_LDB(B0, 1, 0); PG8_LDB(B1, 1, 1); PG8_SCHED; PG8_LDA(At, 1, 0); PG8_STAGE(PG8_SA(0, 1), a2 + hstep, voffA);
            PG8_WAIT_V(8); PG8_WAIT_L(0); PG8_BAR; PG8_MMA(0, 0, At, B0); PG8_MMA(0, 1, At, B1); PG8_BAR; PG8_SCHED;
            PG8_LDA(At, 1, 1); PG8_STAGE(PG8_SB(1, 0), b3, voffB); PG8_STAGE(PG8_SB(1, 1), b3 + hstep, voffB); PG8_STAGE(PG8_SA(1, 0), a3, voffA);
            PG8_WAIT_V(8); PG8_WAIT_L(0); PG8_BAR; PG8_MMA(1, 0, At, B0); PG8_MMA(1, 1, At, B1); PG8_BAR; PG8_SCHED;
            } else {
            PG8_LDB(B0, 0, 0); PG8_SCHED; PG8_LDA(At, 0, 0); PG8_STAGE(PG8_SA(1, 1), a1 + hstep, voffA);
            PG8_WAIT_L(8); PG8_BAR; PG8_WAIT_L(0); PG8_MMA(0, 0, At, B0); PG8_BAR; PG8_SCHED;
            PG8_LDB(B1, 0, 1); PG8_STAGE(PG8_SB(0, 0), b2, voffB);
            PG8_BAR; PG8_WAIT_L(0); PG8_MMA(0, 1, At, B1); PG8_BAR;
            PG8_LDA(At, 0, 1); PG8_STAGE(PG8_SA(0, 0), a2, voffA);
            PG8_BAR; PG8_WAIT_L(0); PG8_MMA(1, 0, At, B0); PG8_BAR; PG8_SCHED;
            PG8_STAGE(PG8_SB(0, 1), b2 + hstep, voffB);
            PG8_WAIT_V(6); PG8_BAR; PG8_MMA(1, 1, At, B1); PG8_BAR;
            PG8_LDB(B0, 1, 0); PG8_SCHED; PG8_LDA(At, 1, 0); PG8_STAGE(PG8_SA(0, 1), a2 + hstep, voffA);
            PG8_WAIT_L(8); PG8_BAR; PG8_WAIT_L(0); PG8_MMA(0, 0, At, B0); PG8_BAR; PG8_SCHED;
            PG8_LDB(B1, 1, 1); PG8_STAGE(PG8_SB(1, 0), b3, voffB);
            PG8_BAR; PG8_WAIT_L(0); PG8_MMA(0, 1, At, B1); PG8_BAR;
            PG8_LDA(At, 1, 1); PG8_STAGE(PG8_SA(1, 0), a3, voffA);
            PG8_BAR; PG8_WAIT_L(0); PG8_MMA(1, 0, At, B0); PG8_BAR; PG8_SCHED;
            PG8_STAGE(PG8_SB(1, 1), b3 + hstep, voffB);
            PG8_WAIT_V(6); PG8_BAR; PG8_MMA(1, 1, At, B1); PG8_BAR;
            }
        }
        if constexpr (ALIGN_EPI) { if (wr == 0) PG8_BAR; }
        if constexpr (!Epi::AFTER_DRAIN) { E(acc, cur, wr, wc, fr, fq); S.done(cur); }
        if (!has_next) break;
#pragma unroll
        for (int a = 0; a < 2; ++a)
#pragma unroll
            for (int b = 0; b < 2; ++b)
#pragma unroll
                for (int m = 0; m < 4; ++m)
#pragma unroll
                    for (int n = 0; n < 2; ++n) acc[a][b][m][n] = (f32x4){0.f, 0.f, 0.f, 0.f};
        cur = nxt; cA = nA; cB = nB; ++ui;
        if constexpr (ALIGN_EPI) { if (wr == 1) PG8_BAR; }
    }
    PG8_WAIT_V(0);
    if constexpr (!ALIGN_EPI) { if (wr == 0) PG8_BAR; }
    PG8_BAR;
    if constexpr (Epi::AFTER_DRAIN) { E.fused(acc, cur, wr, wc, fr, fq, lds, wid, lane); S.done(cur); }
#undef PG8_SA
#undef PG8_SB
#undef PG8_STAGE
#undef PG8_LDA
#undef PG8_LDB
#undef PG8_MMA
#undef PG8_WAIT_V
#undef PG8_WAIT_L
#undef PG8_BAR
#undef PG8_SCHED
}
}
#define XB_TMO      128
#define XB_XCNT(j)  (256  + 64 * (j))
#define XB_XSUB(j)  (1280 + 64 * (j))
#define XB_XGEN(j)  (2304 + 64 * (j))
#define XB_TOP      3328
#define XB_TOPGEN   3392
#define XCD_BAR_WORDS 3456
#define XB_SPIN_CAP (1u << 18)

__device__ __forceinline__ unsigned xb_ld(unsigned* p)              { return __hip_atomic_load(p, __ATOMIC_RELAXED, __HIP_MEMORY_SCOPE_AGENT); }
__device__ __forceinline__ unsigned xb_add(unsigned* p, unsigned v) { return __hip_atomic_fetch_add(p, v, __ATOMIC_RELAXED, __HIP_MEMORY_SCOPE_AGENT); }
__device__ __forceinline__ unsigned xb_xcc_id() { return (unsigned)__builtin_amdgcn_s_getreg((3 << 11) | 20) & 0xFu; }
#define XB_SPIN(cond, bar) do { unsigned _sp = 0; while (cond) { __builtin_amdgcn_s_sleep(1); \
    if ((++_sp & 255u) == 0u) { if (xb_ld(&(bar)[XB_TMO])) break; if (_sp > XB_SPIN_CAP) { atomicAdd(&(bar)[XB_TMO], 1u); break; } } } } while (0)

struct XcdBarrier {
    unsigned* bar; unsigned x;
    volatile LAS unsigned* st;
};

__device__ __forceinline__ XcdBarrier xcd_barrier_post(unsigned* bar, volatile LAS unsigned* st) {
    XcdBarrier b; b.bar = bar; b.x = xb_xcc_id(); b.st = st;
    if (threadIdx.x == 0) (void)xb_add(&bar[XB_XCNT(b.x)], 1u);
    return b;
}
__device__ __forceinline__ void xcd_barrier_complete(unsigned* bar, unsigned x, unsigned& nloc, unsigned& nx) {
    const unsigned G = gridDim.x * gridDim.y * gridDim.z;
    unsigned sum, cnt, mine, sp = 0u;
    for (;;) {
        sum = 0u; cnt = 0u; mine = 0u;
#pragma unroll
        for (unsigned j = 0; j < 16; ++j) { const unsigned c = xb_ld(&bar[XB_XCNT(j)]); sum += c; cnt += (c > 0u) ? 1u : 0u; mine = (j == x) ? c : mine; }
        if (sum == G) break;
        __builtin_amdgcn_s_sleep(1);
        if ((++sp & 255u) == 0u) { if (xb_ld(&bar[XB_TMO])) break; if (sp > XB_SPIN_CAP) { atomicAdd(&bar[XB_TMO], 1u); break; } }
    }
    nloc = mine > 0u ? mine : 1u; nx = cnt > 0u ? cnt : 1u;
}

__device__ __forceinline__ void xcd_barrier(const XcdBarrier& b) {
    asm volatile("s_waitcnt vmcnt(0)" ::: "memory");
    __syncthreads();
    if (threadIdx.x == 0) {
        unsigned* bar = b.bar;
        __builtin_amdgcn_s_waitcnt(0);
        unsigned nloc = b.st[0], nx = b.st[1];
        if (nloc == 0u) { xcd_barrier_complete(bar, b.x, nloc, nx); b.st[0] = nloc; b.st[1] = nx; }
        const unsigned old = xb_add(&bar[XB_XSUB(b.x)], 1u);
        const unsigned gen = old / nloc;
        if (old + 1u == (gen + 1u) * nloc) {
            __builtin_amdgcn_fence(__ATOMIC_RELEASE, "agent");
            asm volatile("s_waitcnt vmcnt(0)" ::: "memory");
            const unsigned og = xb_add(&bar[XB_TOP], 1u);
            const unsigned tg = og / nx;
            if (og + 1u == (tg + 1u) * nx) xb_add(&bar[XB_TOPGEN], 1u);
            else XB_SPIN(xb_ld(&bar[XB_TOPGEN]) == tg, bar);
            __builtin_amdgcn_fence(__ATOMIC_ACQUIRE, "agent");
            xb_add(&bar[XB_XGEN(b.x)], 1u);
            asm volatile("s_waitcnt vmcnt(0)" ::: "memory");
        } else {
            XB_SPIN(xb_ld(&bar[XB_XGEN(b.x)]) == gen, bar);
            __builtin_amdgcn_fence(__ATOMIC_ACQUIRE, "agent");
            asm volatile("s_waitcnt vmcnt(0)" ::: "memory");
        }
    }
    __syncthreads();
}

constexpr int BATCH = 2, SEQ = 8192, M = BATCH * SEQ, D = 2048, DEPTH = 4;
constexpr int DIN = 11968, NP1 = 5888, NG = 6144, NWIN = NP1 + NG;
constexpr int BW = 768, BCOLS = 2752;
constexpr int C_AQ = 0, C_AK = 512, C_AV = 640, C_R = 768, C_K = 1536, C_V = 2304, C_WD = 3072, C_CQ = 3520, C_CK = 4288, C_CV = 5056, C_END = 5824;
constexpr int DFF = 5504, NUP = 2 * DFF;
constexpr int NLORA = 2304, KLORA = 512;
constexpr float NORM_EPS = 1e-5f, GN_EPS = 64e-5f;
constexpr int NWAVES = 8, NTHREADS = 512;
constexpr int NPH = 13;
constexpr int NPHASES = DEPTH * NPH + 1;
#ifndef EXP_SCAN_REPS
#define EXP_SCAN_REPS 1
#endif
#ifndef EXP_ATTN_REPS
#define EXP_ATTN_REPS 1
#endif
constexpr int NSCAN = 48;

constexpr size_t MiB = 1u << 20;
constexpr size_t WS_CTL = 0, CTL_ZERO_BYTES = 1 * MiB;
constexpr size_t WS_WIN = 1 * MiB;
constexpr size_t WS_WLORA = 48 * MiB;
constexpr size_t WS_PA = 51 * MiB;
constexpr size_t WS_PB = 53 * MiB;
constexpr size_t WS_PC = 56 * MiB;
constexpr size_t WS_WOUT = 57 * MiB;
constexpr size_t WS_WUP = 65 * MiB;
constexpr size_t WS_WDOWN = 108 * MiB;
constexpr size_t WS_H = 130 * MiB;
constexpr size_t WS_P1 = 194 * MiB;
constexpr size_t WS_G = 378 * MiB;
constexpr size_t WS_U = WS_P1;
constexpr size_t WS_AP = 570 * MiB;
constexpr size_t WS_LO = 586 * MiB;
constexpr size_t WS_ACT = WS_LO;
constexpr size_t WS_SR = 730 * MiB;
constexpr size_t WS_SW = 778 * MiB, WS_SK = 826 * MiB, WS_SKK = 874 * MiB, WS_SB = 922 * MiB, WS_SV = 970 * MiB;
constexpr size_t WS_YRAW = 1018 * MiB;
constexpr size_t WS_YA = 1066 * MiB;
constexpr size_t WS_YB = 1082 * MiB;
constexpr size_t WS_YC = 1106 * MiB;
constexpr size_t WS_OC = 1114 * MiB;
constexpr size_t WS_LSE = 1138 * MiB;
constexpr size_t WS_MG = 1139 * MiB;
constexpr size_t WS_BK = 1203 * MiB;
constexpr size_t WS_VT = 1205 * MiB;
constexpr size_t WS_END = 1235 * MiB;
constexpr int CW_BAR = 4096;

constexpr int RING_OFF = 0, RING_BYTES = 131072;
constexpr int LDSCTL_OFF = RING_BYTES, MISC_OFF = LDSCTL_OFF + 320;
constexpr int LDS_BYTES = 147456;

typedef unsigned short bf16;
typedef unsigned v4u __attribute__((ext_vector_type(4)));
typedef unsigned v2u __attribute__((ext_vector_type(2)));
typedef float f32x4 __attribute__((ext_vector_type(4)));
#define LDS_WAIT() asm volatile("s_waitcnt lgkmcnt(0)" ::: "memory")

__device__ __forceinline__ unsigned f2bf(float f) { unsigned u = __builtin_bit_cast(unsigned, f); return (u + 0x7fffu + ((u >> 16) & 1u)) >> 16; }
__device__ __forceinline__ unsigned pk2(float lo, float hi) { return f2bf(lo) | (f2bf(hi) << 16); }
__device__ __forceinline__ float bflo(unsigned w) { return __builtin_bit_cast(float, w << 16); }
__device__ __forceinline__ float bfhi(unsigned w) { return __builtin_bit_cast(float, w & 0xffff0000u); }
__device__ __forceinline__ float bf1(bf16 h) { return __builtin_bit_cast(float, ((unsigned)h) << 16); }
__device__ __forceinline__ float sigmoidf_(float x) { return 1.0f / (1.0f + __expf(-x)); }
__device__ __forceinline__ float wave_sum(float v) {
#pragma unroll
    for (int o = 1; o < 64; o <<= 1) v += __shfl_xor(v, o);
    return v;
}
template <int CTRL> __device__ __forceinline__ float dppf(float x) { return __builtin_bit_cast(float, __builtin_amdgcn_update_dpp(0, __builtin_bit_cast(int, x), CTRL, 0xF, 0xF, true)); }
__device__ __forceinline__ float red4(float x) { x += dppf<0xB1>(x); x += dppf<0x4E>(x); return x; }
__device__ __forceinline__ float red16(float x) { x = red4(x); x += dppf<0x141>(x); x += dppf<0x140>(x); return x; }

__device__ const unsigned char T5B[3][132] = {
 {0,1,2,3,4,5,6,7,8,9,10,11,12,13,14,15,16,16,16,16,16,16,17,17,17,17,17,17,17,17,18,18,18,18,18,18,18,18,18,18,19,19,19,19,19,19,19,19,19,19,19,19,19,19,20,20,20,20,20,20,20,20,20,20,20,20,20,20,20,20,20,20,20,21,21,21,21,21,21,21,21,21,21,21,21,21,21,21,21,21,21,21,21,21,21,21,21,21,21,22,22,22,22,22,22,22,22,22,22,22,22,22,22,22,22,22,22,22,22,22,22,22,22,22,22,22,22,22,22,0,0,0},
 {0,4,8,12,16,16,17,17,18,18,19,19,19,19,20,20,20,20,20,21,21,21,21,21,21,22,22,22,22,22,22,22,22,22,23,23,23,23,23,23,23,23,23,23,23,23,24,24,24,24,24,24,24,24,24,24,24,24,24,24,24,24,25,25,25,25,25,25,25,25,25,25,25,25,25,25,25,25,25,25,25,25,25,26,26,26,26,26,26,26,26,26,26,26,26,26,26,26,26,26,26,26,26,26,26,26,26,26,26,26,26,26,26,27,27,27,27,27,27,27,27,27,27,27,27,27,27,27,27,0,0,0},
 {0,16,18,19,20,21,21,22,22,23,23,23,24,24,24,24,25,25,25,25,25,26,26,26,26,26,26,26,26,27,27,27,27,27,27,27,27,27,27,28,28,28,28,28,28,28,28,28,28,28,28,28,29,29,29,29,29,29,29,29,29,29,29,29,29,29,29,29,29,29,30,30,30,30,30,30,30,30,30,30,30,30,30,30,30,30,30,30,30,30,30,30,30,30,30,31,31,31,31,31,31,31,31,31,31,31,31,31,31,31,31,31,31,31,31,31,31,31,31,31,31,31,31,31,31,31,31,31,31,0,0,0}};

namespace pg8 {
struct EpiWin {
    static constexpr bool PERM = true, AFTER_DRAIN = false;
    bf16_t* P1; bf16_t* G;
    __device__ __forceinline__ void operator()(const f32x4 (&acc)[2][2][4][2], const Unit& u, int wr, int wc, int fr, int fq) const {
        const int row0 = u.pm * BM + wr * 64 + fr; const bool gate = u.pn >= 23;
        bf16_t* base = gate ? G : P1; const int ldc = gate ? 6144 : 5888; const int col0 = (gate ? (u.pn - 23) : u.pn) * BM + wc * 32 + 8 * fq;
#pragma unroll
        for (int ai = 0; ai < 2; ++ai)
#pragma unroll
            for (int m = 0; m < 4; ++m) { bf16_t* rowp = base + (size_t)(row0 + ai * HALF + m * 16) * ldc + col0;
#pragma unroll
                for (int bj = 0; bj < 2; ++bj) { f32x4 v0 = acc[ai][bj][m][0], v1 = acc[ai][bj][m][1];
                    if (gate) {
#pragma unroll
                        for (int j = 0; j < 4; ++j) { v0[j] = __builtin_amdgcn_rcpf(1.0f + __expf(-v0[j])); v1[j] = __builtin_amdgcn_rcpf(1.0f + __expf(-v1[j])); } }
                    u32x4 w; w.x = cvt_pk_bf16(v0[0], v0[1]); w.y = cvt_pk_bf16(v0[2], v0[3]); w.z = cvt_pk_bf16(v1[0], v1[1]); w.w = cvt_pk_bf16(v1[2], v1[3]);
                    *(u32x4*)(rowp + bj * HALF) = w; } }
    }
};
struct EpiBf16P {
    static constexpr bool PERM = true, AFTER_DRAIN = false;
    bf16_t* O; int ldc;
    __device__ __forceinline__ void operator()(const f32x4 (&acc)[2][2][4][2], const Unit& u, int wr, int wc, int fr, int fq) const {
        const int row0 = u.pm * BM + wr * 64 + fr; const int col0 = u.pn * BM + wc * 32 + 8 * fq;
#pragma unroll
        for (int ai = 0; ai < 2; ++ai)
#pragma unroll
            for (int m = 0; m < 4; ++m) { bf16_t* rowp = O + (size_t)(row0 + ai * HALF + m * 16) * ldc + col0;
#pragma unroll
                for (int bj = 0; bj < 2; ++bj) { const f32x4 v0 = acc[ai][bj][m][0], v1 = acc[ai][bj][m][1];
                    u32x4 w; w.x = cvt_pk_bf16(v0[0], v0[1]); w.y = cvt_pk_bf16(v0[2], v0[3]); w.z = cvt_pk_bf16(v1[0], v1[1]); w.w = cvt_pk_bf16(v1[2], v1[3]);
                    *(u32x4*)(rowp + bj * HALF) = w; } }
    }
};
struct EpiF32P {
    static constexpr bool PERM = false, AFTER_DRAIN = false;
    float* C; int ldc;
    __device__ __forceinline__ void operator()(const f32x4 (&acc)[2][2][4][2], const Unit& u, int wr, int wc, int fr, int fq) const {
        const int row0 = u.pm * BM + wr * 64 + fr, col0 = u.pn * BM + wc * 32 + 4 * fq;
#pragma unroll
        for (int ai = 0; ai < 2; ++ai)
#pragma unroll
            for (int m = 0; m < 4; ++m) { float* rowp = C + (size_t)(row0 + ai * HALF + m * 16) * ldc + col0;
#pragma unroll
                for (int bj = 0; bj < 2; ++bj)
#pragma unroll
                    for (int n = 0; n < 2; ++n) *(f32x4*)(rowp + bj * HALF + n * 16) = acc[ai][bj][m][n]; }
    }
};
struct EpiResid {
    static constexpr bool PERM = false, AFTER_DRAIN = false;
    const float* xin; float* out;
    __device__ __forceinline__ void operator()(const f32x4 (&acc)[2][2][4][2], const Unit& u, int wr, int wc, int fr, int fq) const {
        const int row0 = u.pm * BM + wr * 64 + fr, col0 = u.pn * BM + wc * 32 + 4 * fq;
#pragma unroll
        for (int ai = 0; ai < 2; ++ai)
#pragma unroll
            for (int m = 0; m < 4; ++m) { const size_t ro = (size_t)(row0 + ai * HALF + m * 16) * 2048 + col0;
#pragma unroll
                for (int bj = 0; bj < 2; ++bj)
#pragma unroll
                    for (int n = 0; n < 2; ++n) { const f32x4 xv = *(const f32x4*)(xin + ro + bj * HALF + n * 16); *(f32x4*)(out + ro + bj * HALF + n * 16) = xv + acc[ai][bj][m][n]; } }
    }
};
template <bool ACC> struct EpiGate {
    static constexpr bool PERM = true, AFTER_DRAIN = false;
    const bf16_t* G; int gofs; bf16_t* MG;
    __device__ __forceinline__ void operator()(const f32x4 (&acc)[2][2][4][2], const Unit& u, int wr, int wc, int fr, int fq) const {
        const int row0 = u.pm * BM + wr * 64 + fr; const int col0 = u.pn * BM + wc * 32 + 8 * fq;
#pragma unroll
        for (int ai = 0; ai < 2; ++ai)
#pragma unroll
            for (int m = 0; m < 4; ++m) { const int row = row0 + ai * HALF + m * 16;
#pragma unroll
                for (int bj = 0; bj < 2; ++bj) { const int col = col0 + bj * HALF;
                    const u32x4 gv = *(const u32x4*)(G + (size_t)row * 6144 + gofs + col);
                    const f32x4 a0 = acc[ai][bj][m][0], a1 = acc[ai][bj][m][1];
                    float r[8];
                    r[0] = __builtin_bit_cast(float, gv.x << 16) * a0[0]; r[1] = __builtin_bit_cast(float, gv.x & 0xffff0000u) * a0[1];
                    r[2] = __builtin_bit_cast(float, gv.y << 16) * a0[2]; r[3] = __builtin_bit_cast(float, gv.y & 0xffff0000u) * a0[3];
                    r[4] = __builtin_bit_cast(float, gv.z << 16) * a1[0]; r[5] = __builtin_bit_cast(float, gv.z & 0xffff0000u) * a1[1];
                    r[6] = __builtin_bit_cast(float, gv.w << 16) * a1[2]; r[7] = __builtin_bit_cast(float, gv.w & 0xffff0000u) * a1[3];
                    bf16_t* mp = MG + (size_t)row * 2048 + col;
                    if (ACC) { const u32x4 ov = *(const u32x4*)mp;
                        r[0] += __builtin_bit_cast(float, ov.x << 16); r[1] += __builtin_bit_cast(float, ov.x & 0xffff0000u);
                        r[2] += __builtin_bit_cast(float, ov.y << 16); r[3] += __builtin_bit_cast(float, ov.y & 0xffff0000u);
                        r[4] += __builtin_bit_cast(float, ov.z << 16); r[5] += __builtin_bit_cast(float, ov.z & 0xffff0000u);
                        r[6] += __builtin_bit_cast(float, ov.w << 16); r[7] += __builtin_bit_cast(float, ov.w & 0xffff0000u); }
                    u32x4 w; w.x = cvt_pk_bf16(r[0], r[1]); w.y = cvt_pk_bf16(r[2], r[3]); w.z = cvt_pk_bf16(r[4], r[5]); w.w = cvt_pk_bf16(r[6], r[7]);
                    *(u32x4*)mp = w; } }
    }
};
}

struct Args { const float* in[25]; float* out; unsigned char* ws; int ph_lo, ph_hi, li, pad; };

struct Ctx {
    LAS unsigned char* lds;
    int tid, lane, wave, G, bid;
    int gw, ngw;
};

__device__ __forceinline__ void transpose_item(const float* W, int K, int N, bf16* WT, int kb, int nb, int dst_row0, LAS float* scr, int lane) {
    const int k0 = 64 * kb, n0 = 32 * nb;
#pragma unroll 8
    for (int i = 0; i < 32; ++i) { const int kk = 2 * i + (lane >> 5); scr[kk * 33 + (lane & 31)] = W[(size_t)(k0 + kk) * N + n0 + (lane & 31)]; }
    LDS_WAIT(); asm volatile("" ::: "memory");
    const int c = lane & 7;
#pragma unroll
    for (int j = 0; j < 4; ++j) { const int n = (lane >> 3) + 8 * j; const LAS float* s = scr + (8 * c) * 33 + n;
        v4u o; o.x = pk2(s[0 * 33], s[1 * 33]); o.y = pk2(s[2 * 33], s[3 * 33]); o.z = pk2(s[4 * 33], s[5 * 33]); o.w = pk2(s[6 * 33], s[7 * 33]);
        *(v4u*)(WT + (size_t)(dst_row0 + n) * K + k0 + 8 * c) = o; }
    LDS_WAIT(); asm volatile("" ::: "memory");
}
__device__ __forceinline__ int transpose_matrix(const Ctx& C, const float* W, int K, int N, bf16* WT, int gate_split, int base) {
    LAS float* scr = (LAS float*)(C.lds + RING_OFF + C.wave * 16384);
    const int nblk = N / 32, items = (K / 64) * nblk;
    int first = (C.gw - base) % C.ngw; if (first < 0) first += C.ngw;
    for (int it = first; it < items; it += C.ngw) {
        const int kb = it / nblk, nb = it % nblk; int dr = 32 * nb; if (gate_split && dr >= C_END) dr += 64;
        transpose_item(W, K, N, WT, kb, nb, dr, scr, C.lane);
    }
    return base + items;
}

__device__ __forceinline__ void rms_row_bf16(const float* xrow, const float* gam, bf16* orow, int lane) {
    const f32x4* xr = (const f32x4*)xrow + lane; f32x4 v[8]; float s = 0.f;
#pragma unroll
    for (int j = 0; j < 8; ++j) { v[j] = xr[64 * j]; s += (v[j].x * v[j].x + v[j].y * v[j].y) + (v[j].z * v[j].z + v[j].w * v[j].w); }
    const float rs = 1.0f / sqrtf(wave_sum(s) * (1.0f / D) + NORM_EPS);
    const f32x4* gr = (const f32x4*)gam + lane; v2u* o8 = (v2u*)orow + lane;
#pragma unroll
    for (int j = 0; j < 8; ++j) { const f32x4 g = gr[64 * j]; v2u w; w.x = pk2(v[j].x * rs * g.x, v[j].y * rs * g.y); w.y = pk2(v[j].z * rs * g.z, v[j].w * rs * g.w); o8[64 * j] = w; }
}
__device__ __forceinline__ void rms_row_f32(float* xrow, const float* gam, int lane) {
    f32x4* xr = (f32x4*)xrow + lane; f32x4 v[8]; float s = 0.f;
#pragma unroll
    for (int j = 0; j < 8; ++j) { v[j] = xr[64 * j]; s += (v[j].x * v[j].x + v[j].y * v[j].y) + (v[j].z * v[j].z + v[j].w * v[j].w); }
    const float rs = 1.0f / sqrtf(wave_sum(s) * (1.0f / D) + NORM_EPS);
    const f32x4* gr = (const f32x4*)gam + lane;
#pragma unroll
    for (int j = 0; j < 8; ++j) { const f32x4 g = gr[64 * j]; xr[64 * j] = v[j] * rs * g; }
}

__device__ __forceinline__ void phase_prep(const Ctx& C, const Args& a, int l, const float* xsrc, unsigned char* ws) {
    int base = 0;
    base = transpose_matrix(C, a.in[3] + (size_t)l * D * DIN, D, DIN, (bf16*)(ws + WS_WIN), 1, base);
    base = transpose_matrix(C, a.in[21] + (size_t)l * D * NUP, D, NUP, (bf16*)(ws + WS_WUP), 0, base);
    base = transpose_matrix(C, a.in[23] + (size_t)l * DFF * D, DFF, D, (bf16*)(ws + WS_WDOWN), 0, base);
    base = transpose_matrix(C, a.in[19] + (size_t)l * D * D, D, D, (bf16*)(ws + WS_WOUT), 0, base);
    base = transpose_matrix(C, a.in[16] + (size_t)l * 512 * D, 512, D, (bf16*)(ws + WS_PA), 0, base);
    base = transpose_matrix(C, a.in[17] + (size_t)l * 768 * D, 768, D, (bf16*)(ws + WS_PB), 0, base);
    base = transpose_matrix(C, a.in[18] + (size_t)l * 256 * D, 256, D, (bf16*)(ws + WS_PC), 0, base);
    const int gt = C.bid * NTHREADS + C.tid, ngt = C.G * NTHREADS;
    { v4u* z = (v4u*)((bf16*)(ws + WS_WIN) + (size_t)C_END * D); for (int i = gt; i < 64 * D / 8; i += ngt) z[i] = (v4u){0u, 0u, 0u, 0u}; }
    { bf16* wl = (bf16*)(ws + WS_WLORA); const float* wup = a.in[7] + (size_t)l * 96 * BW; const float* aup = a.in[9] + (size_t)l * 96 * BW; const float* gup = a.in[10] + (size_t)l * 256 * BW;
      for (int i = gt; i < NLORA * KLORA; i += ngt) { const int n = i / KLORA, k = i % KLORA; float v = 0.f;
          if (n < 768) { if (k < 96) v = wup[k * BW + n]; }
          else if (n < 1536) { if (k >= 96 && k < 192) v = aup[(k - 96) * BW + (n - 768)]; }
          else { if (k >= 192 && k < 448) v = gup[(k - 192) * BW + (n - 1536)]; }
          wl[i] = (bf16)f2bf(v); } }
    const float* g1 = a.in[2] + (size_t)l * D; bf16* H = (bf16*)(ws + WS_H);
    for (int m = C.gw; m < M; m += C.ngw) rms_row_bf16(xsrc + (size_t)m * D, g1, H + (size_t)m * D, C.lane);
}

__device__ __forceinline__ void phase_aprime(const Ctx& C, const Args& a, int l, unsigned char* ws) {
    const bf16* P1 = (const bf16*)(ws + WS_P1); bf16* AP = (bf16*)(ws + WS_AP); const float* mu = a.in[5] + (size_t)l * BCOLS;
    const int g = C.lane, c0 = 8 * g;
    float muv[8];
#pragma unroll
    for (int j = 0; j < 8; ++j) muv[j] = (g < 56) ? mu[(C_WD - C_R) + c0 + j] : 0.f;
    for (int m = C.gw; m < M; m += C.ngw) {
        v4u o = (v4u){0u, 0u, 0u, 0u};
        if (g < 56) {
            const v4u cur = *(const v4u*)(P1 + (size_t)m * NP1 + C_WD + c0);
            v4u prv = (v4u){0u, 0u, 0u, 0u}; if ((m & (SEQ - 1)) != 0) prv = *(const v4u*)(P1 + (size_t)(m - 1) * NP1 + C_WD + c0);
            float x[8], p[8];
            x[0] = bflo(cur.x); x[1] = bfhi(cur.x); x[2] = bflo(cur.y); x[3] = bfhi(cur.y); x[4] = bflo(cur.z); x[5] = bfhi(cur.z); x[6] = bflo(cur.w); x[7] = bfhi(cur.w);
            p[0] = bflo(prv.x); p[1] = bfhi(prv.x); p[2] = bflo(prv.y); p[3] = bfhi(prv.y); p[4] = bflo(prv.z); p[5] = bfhi(prv.z); p[6] = bflo(prv.w); p[7] = bfhi(prv.w);
#pragma unroll
            for (int j = 0; j < 8; ++j) { float v = x[j] + (p[j] - x[j]) * muv[j];
                if (g < 12) v = tanhf(v); else if (g >= 24) v = sigmoidf_(v);
                x[j] = v; }
            o.x = pk2(x[0], x[1]); o.y = pk2(x[2], x[3]); o.z = pk2(x[4], x[5]); o.w = pk2(x[6], x[7]);
        }
        *(v4u*)(AP + (size_t)m * KLORA + c0) = o;
    }
}

struct PrepTok { float r, kt, v, w, kk, b; };
__device__ __forceinline__ PrepTok prep_token(const bf16* P1, const float* LO, int m, int hc, float mur, float muk, float muv, float w0, float a0, float kkw, float kaw) {
    const bool first = (m & (SEQ - 1)) == 0;
    const bf16* pr = P1 + (size_t)m * NP1; const bf16* pp = pr - NP1;
    float r = bf1(pr[C_R + hc]), k = bf1(pr[C_K + hc]), v = bf1(pr[C_V + hc]);
    const float rp = first ? 0.f : bf1(pp[C_R + hc]), kp = first ? 0.f : bf1(pp[C_K + hc]), vp = first ? 0.f : bf1(pp[C_V + hc]);
    r = r + (rp - r) * mur; k = k + (kp - k) * muk; v = v + (vp - v) * muv;
    const float wpre = w0 + LO[(size_t)m * NLORA + hc], apre = a0 + LO[(size_t)m * NLORA + BW + hc];
    const float xx = -wpre; const float sp = fmaxf(xx, 0.f) + log1pf(expf(-fabsf(xx)));
    const float wlog = -sp - 0.5f; const float decay = expf(-expf(wlog));
    const float av = 1.0f / (1.0f + expf(-apre));
    const float kkr = k * kkw; const float nrm = sqrtf(wave_sum(kkr * kkr)); const float kk = kkr / fmaxf(nrm, 1e-12f);
    PrepTok t; t.r = r; t.kt = k * (1.0f + (av - 1.0f) * kaw); t.v = v; t.w = decay; t.kk = kk; t.b = kk * av; return t;
}
__device__ __forceinline__ void phase_scanprep(const Ctx& C, const Args& a, int l, unsigned char* ws) {
    const bf16* P1 = (const bf16*)(ws + WS_P1); const float* LO = (const float*)(ws + WS_LO);
    float* SR = (float*)(ws + WS_SR); float* SW = (float*)(ws + WS_SW); float* SK = (float*)(ws + WS_SK); float* SU = (float*)(ws + WS_SKK); float* SB = (float*)(ws + WS_SB); float* SV = (float*)(ws + WS_SV);
    float* BK = (float*)(ws + WS_BK);
    const float* mu = a.in[5] + (size_t)l * BCOLS; const float* w0p = a.in[6] + (size_t)l * BW; const float* a0p = a.in[8] + (size_t)l * BW;
    const float* kkwp = a.in[11] + (size_t)l * BW; const float* kawp = a.in[12] + (size_t)l * BW;
    constexpr int TB = 32;
    for (int it = C.gw; it < (M / TB) * 12; it += C.ngw) {
        const int tb = it / 12, h = it % 12, hc = h * 64 + C.lane, m0 = tb * TB;
        const float mur = mu[hc], muk = mu[BW + hc], muv = mu[2 * BW + hc], w0 = w0p[hc], a0 = a0p[hc], kkw = kkwp[hc], kaw = kawp[hc];
        float pw = 0.f, pb = 0.f, pkt = 0.f;
        const bool seq_start = (m0 & (SEQ - 1)) == 0;
        if (!seq_start) { const PrepTok q = prep_token(P1, LO, m0 - 1, hc, mur, muk, muv, w0, a0, kkw, kaw); pw = q.w; pb = q.b; pkt = q.kt; }
        for (int i = 0; i < TB; ++i) {
            const int m = m0 + i; const PrepTok q = prep_token(P1, LO, m, hc, mur, muk, muv, w0, a0, kkw, kaw);
            const size_t o = (size_t)m * BW + hc;
            SR[o] = q.r; SW[o] = q.w; SK[o] = q.kt; SB[o] = q.b; SV[o] = q.v;
            const bool first = (m & (SEQ - 1)) == 0;
            const float beta = wave_sum(pb * q.kk), kappa = wave_sum(pkt * q.kk);
            if (!first) SU[o - BW] = pw * q.kk;
            if ((m & (SEQ - 1)) == SEQ - 1) SU[o] = 0.f;
            if (C.lane < 2) BK[((size_t)m * 12 + h) * 2 + C.lane] = first ? 0.f : (C.lane == 0 ? beta : kappa);
            pw = q.w; pb = q.b; pkt = q.kt;
        }
    }
}

__device__ __forceinline__ void scan_block(const Ctx& C, int sb, unsigned char* ws) {
    const int b = sb / 24, h = (sb % 24) >> 1, half = sb & 1;
    const float* SR = (const float*)(ws + WS_SR); const float* SW = (const float*)(ws + WS_SW); const float* SK = (const float*)(ws + WS_SK); const float* SKK = (const float*)(ws + WS_SKK);
    const float* SB = (const float*)(ws + WS_SB); const float* SV = (const float*)(ws + WS_SV); float* YR = (float*)(ws + WS_YRAW);
    constexpr int T = 64;
    LAS float* Lr = (LAS float*)(C.lds + RING_OFF); LAS float* Lw = Lr + T * 64; LAS float* Lk = Lw + T * 64; LAS float* Lkk = Lk + T * 64; LAS float* Lb = Lkk + T * 64;
    LAS float* Lv = Lb + T * 64; LAS float* Ly = Lv + T * 32;
    const int tid = C.tid, rl = tid >> 4, kq = tid & 15;
    const size_t rowbase = (size_t)b * SEQ; const int colh = h * 64;
    const int lt0 = tid >> 4, lc0 = (tid & 15) * 4, vt = tid >> 3, vc = (tid & 7) * 4;
    f32x4 pr[2], pw[2], pk[2], pkk[2], pb[2], pv;
#define SCAN_LOAD(t0) do { _Pragma("unroll") for (int i = 0; i < 2; ++i) { const size_t o = (rowbase + (t0) + lt0 + 32 * i) * BW + colh + lc0; \
        pr[i] = *(const f32x4*)(SR + o); pw[i] = *(const f32x4*)(SW + o); pk[i] = *(const f32x4*)(SK + o); pkk[i] = *(const f32x4*)(SKK + o); pb[i] = *(const f32x4*)(SB + o); } \
        pv = *(const f32x4*)(SV + (rowbase + (t0) + vt) * BW + colh + 32 * half + vc); } while (0)
    SCAN_LOAD(0);
    float S0 = 0.f, S1 = 0.f, S2 = 0.f, S3 = 0.f;
    for (int ch = 0; ch < SEQ / T; ++ch) {
        const int t0 = ch * T;
#pragma unroll
        for (int i = 0; i < 2; ++i) { const int lo = (lt0 + 32 * i) * 64 + lc0;
            *(LAS f32x4*)(Lr + lo) = pr[i]; *(LAS f32x4*)(Lw + lo) = pw[i]; *(LAS f32x4*)(Lk + lo) = pk[i]; *(LAS f32x4*)(Lkk + lo) = pkk[i]; *(LAS f32x4*)(Lb + lo) = pb[i]; }
        *(LAS f32x4*)(Lv + vt * 32 + vc) = pv;
        __syncthreads();
        if (ch + 1 < SEQ / T) SCAN_LOAD(t0 + T);
#pragma unroll 4
        for (int t = 0; t < T; ++t) {
            const f32x4 kk4 = *(const LAS f32x4*)(Lkk + t * 64 + kq * 4), w4 = *(const LAS f32x4*)(Lw + t * 64 + kq * 4), b4 = *(const LAS f32x4*)(Lb + t * 64 + kq * 4);
            const f32x4 k4 = *(const LAS f32x4*)(Lk + t * 64 + kq * 4), r4 = *(const LAS f32x4*)(Lr + t * 64 + kq * 4); const float v = Lv[t * 32 + rl];
            float d = (S0 * kk4.x + S1 * kk4.y) + (S2 * kk4.z + S3 * kk4.w); d = red16(d); const float sa = -d;
            S0 = S0 * w4.x + (sa * b4.x + v * k4.x); S1 = S1 * w4.y + (sa * b4.y + v * k4.y); S2 = S2 * w4.z + (sa * b4.z + v * k4.z); S3 = S3 * w4.w + (sa * b4.w + v * k4.w);
            float y = (S0 * r4.x + S1 * r4.y) + (S2 * r4.z + S3 * r4.w); y = red16(y);
            if (kq == 0) Ly[t * 32 + rl] = y;
        }
        __syncthreads();
        *(f32x4*)(YR + (rowbase + t0 + vt) * BW + colh + 32 * half + vc) = *(const LAS f32x4*)(Ly + vt * 32 + vc);
    }
#undef SCAN_LOAD
}

__device__ __forceinline__ void glds16(const void* gsrc, unsigned lds_dst) { unsigned keep;
    asm volatile("s_mov_b32 %0, m0\n\ts_mov_b32 m0, %2\n\ts_nop 0\n\tglobal_load_lds_dwordx4 %1, off\n\ts_mov_b32 m0, %0" : "=&s"(keep) : "v"(gsrc), "s"(lds_dst) : "memory"); }
__device__ __forceinline__ void glds4(const void* gsrc, unsigned lds_dst) { unsigned keep;
    asm volatile("s_mov_b32 %0, m0\n\ts_mov_b32 m0, %2\n\ts_nop 0\n\tglobal_load_lds_dword %1, off\n\ts_mov_b32 m0, %0" : "=&s"(keep) : "v"(gsrc), "s"(lds_dst) : "memory"); }
constexpr int SCAN_T = 8, SCAN_SLOT = 5 * SCAN_T * 256 + 512, SCAN_NSLOT = 3, SCAN_RING = SCAN_NSLOT * SCAN_SLOT;
typedef float f32x2 __attribute__((ext_vector_type(2)));
__device__ __forceinline__ void scan_wave(int lane, LAS unsigned char* ring, int hs, int r0, unsigned char* ws) {
    const int b = hs / 12, h = hs % 12;
    const float* SR = (const float*)(ws + WS_SR); const float* SW = (const float*)(ws + WS_SW); const float* SK = (const float*)(ws + WS_SK); const float* SU = (const float*)(ws + WS_SKK);
    const float* SB = (const float*)(ws + WS_SB); const float* SV = (const float*)(ws + WS_SV); const float* BK = (const float*)(ws + WS_BK); float* YR = (float*)(ws + WS_YRAW);
    const int rg = lane >> 4, kq = lane & 15;
    const size_t rowbase = (size_t)b * SEQ; const int colh = h * 64;
    const unsigned ring0 = (unsigned)(size_t)ring;
    const size_t voff = ((size_t)(lane >> 4)) * BW + colh + 4 * kq;
    const size_t vvoff = ((size_t)((lane & 31) >> 2)) * BW + colh + r0 + (lane & 3);
    const size_t bkoff = ((size_t)((lane & 15) >> 1) * 12 + h) * 2 + (lane & 1);
    constexpr int NCH = SEQ / SCAN_T;
#define SCAN_DMA(ch, slot) do { const int cc_ = (ch) < NCH ? (ch) : NCH - 1; const size_t tok_ = rowbase + (size_t)cc_ * SCAN_T; const unsigned sl_ = ring0 + (unsigned)(slot) * SCAN_SLOT; \
        _Pragma("unroll") for (int i_ = 0; i_ < 2; ++i_) { const size_t o_ = (tok_ + 4 * i_) * BW + voff; \
            glds16(SU + o_, sl_ + 0 * 2048 + i_ * 1024); glds16(SW + o_, sl_ + 1 * 2048 + i_ * 1024); glds16(SB + o_, sl_ + 2 * 2048 + i_ * 1024); glds16(SK + o_, sl_ + 3 * 2048 + i_ * 1024); glds16(SR + o_, sl_ + 4 * 2048 + i_ * 1024); } \
        glds4(SV + tok_ * BW + vvoff, sl_ + 10240); glds4(BK + tok_ * 24 + bkoff, sl_ + 10496); } while (0)
    SCAN_DMA(0, 0); SCAN_DMA(1, 1); SCAN_DMA(2, 2);
    f32x2 S01 = (f32x2){0.f, 0.f}, S23 = (f32x2){0.f, 0.f};
    float e_cur = 0.f, sa_prev = 0.f, v_prev = 0.f;
    int slot = 0;
    for (int ch = 0; ch < NCH; ++ch) {
        asm volatile("s_waitcnt vmcnt(24)" ::: "memory");
        const LAS unsigned char* sp = ring + slot * SCAN_SLOT;
        float ykeep = 0.f;
        f32x4 u4a[SCAN_T], w4a[SCAN_T], b4a[SCAN_T], k4a[SCAN_T], r4a[SCAN_T]; float va[SCAN_T]; f32x2 bka[SCAN_T];
#pragma unroll
        for (int tt = 0; tt < SCAN_T; ++tt) {
            u4a[tt] = *(const LAS f32x4*)(sp + 0 * 2048 + tt * 256 + kq * 16); bka[tt] = *(const LAS f32x2*)(sp + 10496 + tt * 8); va[tt] = *(const LAS float*)(sp + 10240 + tt * 16 + rg * 4);
            w4a[tt] = *(const LAS f32x4*)(sp + 1 * 2048 + tt * 256 + kq * 16); b4a[tt] = *(const LAS f32x4*)(sp + 2 * 2048 + tt * 256 + kq * 16);
            k4a[tt] = *(const LAS f32x4*)(sp + 3 * 2048 + tt * 256 + kq * 16); r4a[tt] = *(const LAS f32x4*)(sp + 4 * 2048 + tt * 256 + kq * 16); }
#pragma unroll
        for (int tt = 0; tt < SCAN_T; ++tt) {
            const f32x4 u4 = u4a[tt], w4 = w4a[tt], b4 = b4a[tt], k4 = k4a[tt], r4 = r4a[tt]; const float v = va[tt]; const f32x2 bk = bka[tt];
            f32x2 pe = S01 * (f32x2){u4.x, u4.y}; pe = S23 * (f32x2){u4.z, u4.w} + pe; const float e_next = red16(pe.x + pe.y);
            const float d = e_cur + sa_prev * bk.x + v_prev * bk.y; const float sa = -d;
            const f32x2 sav = (f32x2){sa, sa}, vv = (f32x2){v, v};
            S01 = S01 * (f32x2){w4.x, w4.y} + (sav * (f32x2){b4.x, b4.y} + vv * (f32x2){k4.x, k4.y});
            S23 = S23 * (f32x2){w4.z, w4.w} + (sav * (f32x2){b4.z, b4.w} + vv * (f32x2){k4.z, k4.w});
            f32x2 py = S01 * (f32x2){r4.x, r4.y}; py = S23 * (f32x2){r4.z, r4.w} + py; const float y = red16(py.x + py.y);
            ykeep = (kq == tt) ? y : ykeep;
            e_cur = e_next; sa_prev = sa; v_prev = v;
        }
        if (kq < SCAN_T) YR[(rowbase + (size_t)ch * SCAN_T + kq) * BW + colh + r0 + rg] = ykeep;
        SCAN_DMA(ch + 3, slot);
        slot = (slot == SCAN_NSLOT - 1) ? 0 : slot + 1;
    }
    asm volatile("s_waitcnt vmcnt(0)" ::: "memory");
#undef SCAN_DMA
}

struct AttnPass { int qcol; int bias_head; int tbl; float sink; int use_sink; int maxsteps; bf16* out; int out_ld; int out_col; float* lse; };
__device__ __forceinline__ void attn_stage_kv(const Ctx& C, const bf16* P1, int b, int res, int dil, int fblk, int kcol, int vcol) {
    LAS unsigned char* Ks = C.lds + RING_OFF; LAS unsigned char* Vs = Ks + 256 * 144;
#pragma unroll
    for (int i = 0; i < 4; ++i) { const int c = C.tid + 512 * i, row = c >> 3, part = c & 7; const int fp = (fblk - 1) * 128 + row;
        v4u kv = (v4u){0u, 0u, 0u, 0u}, vv = (v4u){0u, 0u, 0u, 0u};
        if (fp >= 0) { const bf16* src = P1 + ((size_t)b * SEQ + (size_t)fp * dil + res) * NP1; kv = *(const v4u*)(src + kcol + part * 8); vv = *(const v4u*)(src + vcol + part * 8); }
        *(LAS v4u*)(Ks + row * 144 + part * 16) = kv; *(LAS v4u*)(Vs + row * 144 + part * 16) = vv; }
}
__device__ __forceinline__ void attn_pass(const Ctx& C, const bf16* P1, const float* relb, int b, int res, int dil, int fblk, const AttnPass& ap) {
    LAS unsigned char* Ks = C.lds + RING_OFF; LAS unsigned char* Vs = Ks + 256 * 144; LAS float* lut = (LAS float*)(Vs + 256 * 144);
    __syncthreads();
    if (C.tid < 132) lut[C.tid] = (C.tid <= 128) ? relb[(int)T5B[ap.tbl][C.tid] * 20 + ap.bias_head] : 0.f;
    __syncthreads();
    const int i = C.tid >> 2, dq = C.tid & 3;
    const size_t tok = (size_t)b * SEQ + (size_t)(fblk * 128 + i) * dil + res;
    float q[16];
    { const bf16* qp = P1 + tok * NP1 + ap.qcol + dq * 16; const v4u a0 = *(const v4u*)qp, a1 = *(const v4u*)(qp + 8);
      q[0] = bflo(a0.x); q[1] = bfhi(a0.x); q[2] = bflo(a0.y); q[3] = bfhi(a0.y); q[4] = bflo(a0.z); q[5] = bfhi(a0.z); q[6] = bflo(a0.w); q[7] = bfhi(a0.w);
      q[8] = bflo(a1.x); q[9] = bfhi(a1.x); q[10] = bflo(a1.y); q[11] = bfhi(a1.y); q[12] = bflo(a1.z); q[13] = bfhi(a1.z); q[14] = bflo(a1.w); q[15] = bfhi(a1.w);
#pragma unroll
      for (int j = 0; j < 16; ++j) q[j] *= 0.125f; }
    float mrun = ap.use_sink ? ap.sink : -INFINITY, lrun = ap.use_sink ? 1.0f : 0.0f;
    float o[16];
#pragma unroll
    for (int j = 0; j < 16; ++j) o[j] = 0.f;
    const int fq0 = fblk * 128 + i;
    for (int dist = 0; dist <= ap.maxsteps; ++dist) {
        const int kr = i + 128 - dist;
        const bool valid = (fq0 - dist) >= 0;
        const v4u k0 = *(const LAS v4u*)(Ks + kr * 144 + dq * 32), k1 = *(const LAS v4u*)(Ks + kr * 144 + dq * 32 + 16);
        float s = q[0] * bflo(k0.x) + q[1] * bfhi(k0.x) + q[2] * bflo(k0.y) + q[3] * bfhi(k0.y) + q[4] * bflo(k0.z) + q[5] * bfhi(k0.z) + q[6] * bflo(k0.w) + q[7] * bfhi(k0.w)
                + q[8] * bflo(k1.x) + q[9] * bfhi(k1.x) + q[10] * bflo(k1.y) + q[11] * bfhi(k1.y) + q[12] * bflo(k1.z) + q[13] * bfhi(k1.z) + q[14] * bflo(k1.w) + q[15] * bfhi(k1.w);
        s = red4(s) + lut[dist];
        if (valid) {
            if (s > mrun) { const float c = __expf(mrun - s); lrun *= c;
#pragma unroll
                for (int j = 0; j < 16; ++j) o[j] *= c;
                mrun = s; }
            const float p = __expf(s - mrun); lrun += p;
            const v4u v0 = *(const LAS v4u*)(Vs + kr * 144 + dq * 32), v1 = *(const LAS v4u*)(Vs + kr * 144 + dq * 32 + 16);
            o[0] += p * bflo(v0.x); o[1] += p * bfhi(v0.x); o[2] += p * bflo(v0.y); o[3] += p * bfhi(v0.y); o[4] += p * bflo(v0.z); o[5] += p * bfhi(v0.z); o[6] += p * bflo(v0.w); o[7] += p * bfhi(v0.w);
            o[8] += p * bflo(v1.x); o[9] += p * bfhi(v1.x); o[10] += p * bflo(v1.y); o[11] += p * bfhi(v1.y); o[12] += p * bflo(v1.z); o[13] += p * bfhi(v1.z); o[14] += p * bflo(v1.w); o[15] += p * bfhi(v1.w);
        }
    }
    const float inv = 1.0f / lrun;
    v4u w0, w1;
    w0.x = pk2(o[0] * inv, o[1] * inv); w0.y = pk2(o[2] * inv, o[3] * inv); w0.z = pk2(o[4] * inv, o[5] * inv); w0.w = pk2(o[6] * inv, o[7] * inv);
    w1.x = pk2(o[8] * inv, o[9] * inv); w1.y = pk2(o[10] * inv, o[11] * inv); w1.z = pk2(o[12] * inv, o[13] * inv); w1.w = pk2(o[14] * inv, o[15] * inv);
    bf16* op = ap.out + tok * ap.out_ld + ap.out_col + dq * 16;
    *(v4u*)op = w0; *(v4u*)(op + 8) = w1;
    if (ap.lse && dq == 0) ap.lse[tok * 4] = mrun + __logf(lrun);
}
__device__ __forceinline__ void phase_attn(const Ctx& C, const Args& a, int l, unsigned char* ws, int ab, int nab) {
    const bf16* P1 = (const bf16*)(ws + WS_P1); const float* relb = a.in[1]; const float* sinks = a.in[4] + l * 8;
    bf16* YA = (bf16*)(ws + WS_YA); bf16* OC = (bf16*)(ws + WS_OC); float* LSE = (float*)(ws + WS_LSE);
    constexpr int NA = 256, NC = 1536;
    for (int it = ab; it < NA + NC; it += nab) {
        __syncthreads();
        if (it < NA) {
            const int b = it >> 7, fblk = (it >> 1) & 63, hkv = it & 1;
            attn_stage_kv(C, P1, b, 0, 1, fblk, C_AK + hkv * 64, C_AV + hkv * 64);
            for (int g = 0; g < 4; ++g) { const int hq = hkv * 4 + g;
                AttnPass ap; ap.qcol = C_AQ + hq * 64; ap.bias_head = hq; ap.tbl = 0; ap.sink = sinks[hq]; ap.use_sink = 1; ap.maxsteps = 127; ap.out = YA; ap.out_ld = 512; ap.out_col = hq * 64; ap.lse = nullptr;
                attn_pass(C, P1, relb, b, 0, 1, fblk, ap); }
        } else {
            const int ci = it - NA; const int gi = ci / 512, j = (ci >> 7) & 3, qb = ci & 127;
            const int dil = (gi == 0) ? 1 : (gi == 1 ? 4 : 16); const int bps = 64 / dil;
            const int n = qb / bps, fblk = qb % bps, b = n / dil, res = n % dil; const int hc = gi * 4 + j;
            attn_stage_kv(C, P1, b, res, dil, fblk, C_CK + hc * 64, C_CV + hc * 64);
            AttnPass ap; ap.qcol = C_CQ + hc * 64; ap.bias_head = 8 + hc; ap.tbl = gi; ap.sink = 0.f; ap.use_sink = 0; ap.maxsteps = 128; ap.out = OC + (size_t)gi * M * 256; ap.out_ld = 256; ap.out_col = j * 64;
            ap.lse = LSE + (size_t)gi * M * 4 + j;
            attn_pass(C, P1, relb, b, res, dil, fblk, ap);
        }
    }
}

__device__ __forceinline__ void phase_vt(const Ctx& C, unsigned char* ws) {
    const bf16* P1 = (const bf16*)(ws + WS_P1); bf16* VT = (bf16*)(ws + WS_VT);
    for (int it = C.gw; it < 14 * 2 * 128; it += C.ngw) {
        const int hs = it / 256, b = (it >> 7) & 1, blk = it & 127;
        const int gi = hs < 2 ? 0 : (hs - 2) >> 2; const int dil = gi == 0 ? 1 : (gi == 1 ? 4 : 16); const int Lf = SEQ / dil;
        const int vcol = hs < 2 ? C_AV + hs * 64 : C_CV + (hs - 2) * 64;
        const int ft = blk * 64 + C.lane;
        const int res = ft / Lf, tp = ft % Lf; const int tok = b * SEQ + tp * dil + res;
        const v4u* src = (const v4u*)(P1 + (size_t)tok * NP1 + vcol);
        v4u x[8];
#pragma unroll
        for (int i = 0; i < 8; ++i) x[i] = src[i];
        bf16* dst = VT + ((size_t)(hs * 2 + b) * 64) * SEQ + ft;
#pragma unroll
        for (int i = 0; i < 8; ++i) {
            dst[(size_t)(8 * i + 0) * SEQ] = (bf16)(x[i].x & 0xffffu); dst[(size_t)(8 * i + 1) * SEQ] = (bf16)(x[i].x >> 16);
            dst[(size_t)(8 * i + 2) * SEQ] = (bf16)(x[i].y & 0xffffu); dst[(size_t)(8 * i + 3) * SEQ] = (bf16)(x[i].y >> 16);
            dst[(size_t)(8 * i + 4) * SEQ] = (bf16)(x[i].z & 0xffffu); dst[(size_t)(8 * i + 5) * SEQ] = (bf16)(x[i].z >> 16);
            dst[(size_t)(8 * i + 6) * SEQ] = (bf16)(x[i].w & 0xffffu); dst[(size_t)(8 * i + 7) * SEQ] = (bf16)(x[i].w >> 16);
        }
    }
}

typedef float f32x16 __attribute__((ext_vector_type(16)));
constexpr int LUT_OFF = 65536;
__device__ __forceinline__ void attn_wave_item(int lane, const LAS float* lutall, int item, const float* sinks, unsigned char* ws) {
    const bf16* P1 = (const bf16*)(ws + WS_P1); const bf16* VT = (const bf16*)(ws + WS_VT);
    const int hh = item % 20, g32 = item / 20;
    const bool isA = hh < 8; const int hc = hh - 8; const int gi = isA ? 0 : hc >> 2, j = hc & 3;
    const int dil = gi == 0 ? 1 : (gi == 1 ? 4 : 16); const int Lf = SEQ / dil, gps = Lf / 32;
    const int b = g32 >> 8, rr = g32 & 255, res = rr / gps, qg = rr % gps, fq0 = qg * 32;
    const int qcol = isA ? C_AQ + hh * 64 : C_CQ + hc * 64, kcol = isA ? C_AK + (hh >> 2) * 64 : C_CK + hc * 64;
    const int hs = isA ? (hh >> 2) : 2 + hc; const int maxsteps = isA ? 127 : 128;
    const LAS float* lut = lutall + hh * 132;
    const int r = lane & 31, hf = lane >> 5;
    const size_t tokq = (size_t)b * SEQ + (size_t)(fq0 + r) * dil + res;
    pg8::bf16x8 qf[4];
    { const bf16* qrow = P1 + tokq * NP1 + qcol + 8 * hf;
#pragma unroll
      for (int s_ = 0; s_ < 4; ++s_) qf[s_] = *(const pg8::bf16x8*)(qrow + 16 * s_); }
    f32x16 sc[5];
#pragma unroll
    for (int kt = 0; kt < 5; ++kt) {
        int fk = fq0 - 128 + 32 * kt + r; fk = fk < 0 ? 0 : fk;
        const bf16* krow = P1 + ((size_t)b * SEQ + (size_t)fk * dil + res) * NP1 + kcol + 8 * hf;
        f32x16 acc;
#pragma unroll
        for (int q = 0; q < 16; ++q) acc[q] = 0.f;
#pragma unroll
        for (int s_ = 0; s_ < 4; ++s_) { const pg8::bf16x8 a = *(const pg8::bf16x8*)(krow + 16 * s_); acc = __builtin_amdgcn_mfma_f32_32x32x16_bf16(a, qf[s_], acc, 0, 0, 0); }
        sc[kt] = acc;
    }
    float mx = -1e30f;
#pragma unroll
    for (int kt = 0; kt < 5; ++kt)
#pragma unroll
        for (int q = 0; q < 16; ++q) {
            const int rowoff = (q & 3) + 8 * (q >> 2) + 4 * hf; const int dist = 128 + r - 32 * kt - rowoff; const int fk = fq0 + r - dist;
            const bool valid = dist >= 0 && dist <= maxsteps && fk >= 0;
            const int di = dist < 0 ? 0 : (dist > 128 ? 128 : dist);
            const float sv = valid ? sc[kt][q] * 0.125f + lut[di] : -1e30f;
            sc[kt][q] = sv; mx = fmaxf(mx, sv);
        }
    mx = fmaxf(mx, __shfl_xor(mx, 32));
    const float sink = isA ? sinks[hh] : -1e30f;
    mx = fmaxf(mx, sink);
    float lsum = 0.f;
#pragma unroll
    for (int kt = 0; kt < 5; ++kt)
#pragma unroll
        for (int q = 0; q < 16; ++q) { const float pv = __expf(sc[kt][q] - mx); sc[kt][q] = pv; lsum += pv; }
    lsum += __shfl_xor(lsum, 32);
    const float denom = isA ? lsum + __expf(sink - mx) : lsum;
    const float inv = 1.0f / denom;
    pg8::bf16x8 pf[5][2];
#pragma unroll
    for (int kt = 0; kt < 5; ++kt)
#pragma unroll
        for (int s_ = 0; s_ < 2; ++s_) { pg8::u32x4 w;
            w.x = pg8::cvt_pk_bf16(sc[kt][8 * s_ + 0], sc[kt][8 * s_ + 1]); w.y = pg8::cvt_pk_bf16(sc[kt][8 * s_ + 2], sc[kt][8 * s_ + 3]);
            w.z = pg8::cvt_pk_bf16(sc[kt][8 * s_ + 4], sc[kt][8 * s_ + 5]); w.w = pg8::cvt_pk_bf16(sc[kt][8 * s_ + 6], sc[kt][8 * s_ + 7]);
            pf[kt][s_] = __builtin_bit_cast(pg8::bf16x8, w); }
    bf16* outp; int out_ld, ocol;
    if (isA) { outp = (bf16*)(ws + WS_YA); out_ld = 512; ocol = hh * 64; } else { outp = (bf16*)(ws + WS_OC) + (size_t)gi * M * 256; out_ld = 256; ocol = j * 64; }
    const bf16* vth = VT + ((size_t)(hs * 2 + b) * 64) * SEQ + (size_t)res * Lf;
#pragma unroll
    for (int dt = 0; dt < 2; ++dt) {
        const bf16* vrow = vth + (size_t)(32 * dt + r) * SEQ;
        f32x16 acc;
#pragma unroll
        for (int q = 0; q < 16; ++q) acc[q] = 0.f;
#pragma unroll
        for (int kt = 0; kt < 5; ++kt)
#pragma unroll
            for (int s_ = 0; s_ < 2; ++s_) {
                int k0 = fq0 - 128 + 32 * kt + 16 * s_ + 4 * hf, k1 = k0 + 8; k0 = k0 < 0 ? 0 : k0; k1 = k1 < 0 ? 0 : k1;
                const v2u lo = *(const v2u*)(vrow + k0), hi = *(const v2u*)(vrow + k1);
                pg8::u32x4 w; w.x = lo.x; w.y = lo.y; w.z = hi.x; w.w = hi.y;
                acc = __builtin_amdgcn_mfma_f32_32x32x16_bf16(__builtin_bit_cast(pg8::bf16x8, w), pf[kt][s_], acc, 0, 0, 0);
            }
        bf16* op = outp + tokq * out_ld + ocol + 32 * dt + 4 * hf;
#pragma unroll
        for (int g = 0; g < 4; ++g) { v2u w; w.x = pg8::cvt_pk_bf16(acc[4 * g + 0] * inv, acc[4 * g + 1] * inv); w.y = pg8::cvt_pk_bf16(acc[4 * g + 2] * inv, acc[4 * g + 3] * inv);
            *(v2u*)(op + 8 * g) = w; }
    }
    if (!isA && hf == 0) ((float*)(ws + WS_LSE))[((size_t)gi * M + tokq) * 4 + j] = mx + __logf(lsum);
}
__device__ __forceinline__ void build_lut(const Ctx& C, const float* relb) {
    LAS float* lut = (LAS float*)(C.lds + LUT_OFF);
    for (int i = C.tid; i < 20 * 132; i += NTHREADS) { const int hh = i / 132, d = i % 132; const int tbl = hh < 8 ? 0 : (hh - 8) >> 2;
        lut[i] = (d <= 128) ? relb[(int)T5B[tbl][d] * 20 + hh] : 0.f; }
    __syncthreads();
}

__device__ __forceinline__ void phase_post(const Ctx& C, const Args& a, int l, unsigned char* ws) {
    const float* YR = (const float*)(ws + WS_YRAW); const float* SR = (const float*)(ws + WS_SR); const float* SK = (const float*)(ws + WS_SK); const float* SV = (const float*)(ws + WS_SV);
    const float* LO = (const float*)(ws + WS_LO); bf16* YB = (bf16*)(ws + WS_YB);
    const float* rk = a.in[13] + (size_t)l * BW; const float* lg = a.in[14] + (size_t)l * BW; const float* lb = a.in[15] + (size_t)l * BW;
    for (int it = C.gw; it < M * 12; it += C.ngw) {
        const int m = it / 12, h = it % 12, hc = h * 64 + C.lane; const size_t o = (size_t)m * BW + hc;
        const float y = YR[o]; const float mean = wave_sum(y) * (1.0f / 64.0f); const float dv = y - mean; const float var = wave_sum(dv * dv) * (1.0f / 64.0f);
        float yn = dv * (1.0f / sqrtf(var + GN_EPS)) * lg[hc] + lb[hc];
        const float bonus = wave_sum(SR[o] * SK[o] * rk[hc]);
        yn += bonus * SV[o];
        yn *= LO[(size_t)m * NLORA + 2 * BW + hc];
        YB[o] = (bf16)f2bf(yn);
    }
    const bf16* OC = (const bf16*)(ws + WS_OC); const float* LSE = (const float*)(ws + WS_LSE); bf16* YC = (bf16*)(ws + WS_YC);
    for (int m = C.gw; m < M; m += C.ngw) {
        const int j = C.lane >> 4;
        const float l0 = LSE[(size_t)m * 4 + j], l1 = LSE[((size_t)M + m) * 4 + j], l2 = LSE[((size_t)2 * M + m) * 4 + j];
        const float mx = fmaxf(l0, fmaxf(l1, l2)); const float e0 = __expf(l0 - mx), e1 = __expf(l1 - mx), e2 = __expf(l2 - mx); const float inv = 1.0f / (e0 + e1 + e2);
        const v2u a0 = *(const v2u*)(OC + (size_t)m * 256 + 4 * C.lane), a1 = *(const v2u*)(OC + ((size_t)M + m) * 256 + 4 * C.lane), a2 = *(const v2u*)(OC + ((size_t)2 * M + m) * 256 + 4 * C.lane);
        const float w0 = e0 * inv, w1 = e1 * inv, w2 = e2 * inv;
        v2u o; o.x = pk2(w0 * bflo(a0.x) + w1 * bflo(a1.x) + w2 * bflo(a2.x), w0 * bfhi(a0.x) + w1 * bfhi(a1.x) + w2 * bfhi(a2.x));
        o.y = pk2(w0 * bflo(a0.y) + w1 * bflo(a1.y) + w2 * bflo(a2.y), w0 * bfhi(a0.y) + w1 * bfhi(a1.y) + w2 * bfhi(a2.y));
        *(v2u*)(YC + (size_t)m * 256 + 4 * C.lane) = o;
    }
}

__device__ __forceinline__ void phase_conv(const Ctx& C, const Args& a, int l, unsigned char* ws) {
    const bf16* U = (const bf16*)(ws + WS_U); bf16* ACT = (bf16*)(ws + WS_ACT); const float* cw = a.in[22] + (size_t)l * 3 * DFF;
    constexpr int GPR = DFF / 8;
    const int gt = C.bid * NTHREADS + C.tid, ngt = C.G * NTHREADS;
    for (int idx = gt; idx < M * GPR; idx += ngt) {
        const int m = idx / GPR, f0 = (idx % GPR) * 8, t = m & (SEQ - 1);
        const bf16* ur = U + (size_t)m * NUP + f0;
        const v4u g2 = *(const v4u*)ur; const v4u vv = *(const v4u*)(ur + DFF);
        v4u g1 = (v4u){0u, 0u, 0u, 0u}, g0 = (v4u){0u, 0u, 0u, 0u};
        if (t >= 1) g1 = *(const v4u*)(ur - NUP); if (t >= 2) g0 = *(const v4u*)(ur - 2 * NUP);
        float x2[8], x1[8], x0[8], vl[8], r[8];
        x2[0] = bflo(g2.x); x2[1] = bfhi(g2.x); x2[2] = bflo(g2.y); x2[3] = bfhi(g2.y); x2[4] = bflo(g2.z); x2[5] = bfhi(g2.z); x2[6] = bflo(g2.w); x2[7] = bfhi(g2.w);
        x1[0] = bflo(g1.x); x1[1] = bfhi(g1.x); x1[2] = bflo(g1.y); x1[3] = bfhi(g1.y); x1[4] = bflo(g1.z); x1[5] = bfhi(g1.z); x1[6] = bflo(g1.w); x1[7] = bfhi(g1.w);
        x0[0] = bflo(g0.x); x0[1] = bfhi(g0.x); x0[2] = bflo(g0.y); x0[3] = bfhi(g0.y); x0[4] = bflo(g0.z); x0[5] = bfhi(g0.z); x0[6] = bflo(g0.w); x0[7] = bfhi(g0.w);
        vl[0] = bflo(vv.x); vl[1] = bfhi(vv.x); vl[2] = bflo(vv.y); vl[3] = bfhi(vv.y); vl[4] = bflo(vv.z); vl[5] = bfhi(vv.z); vl[6] = bflo(vv.w); vl[7] = bfhi(vv.w);
#pragma unroll
        for (int j = 0; j < 8; ++j) { const float gsum = cw[f0 + j] * x0[j] + cw[DFF + f0 + j] * x1[j] + cw[2 * DFF + f0 + j] * x2[j];
            r[j] = gsum / (1.0f + __expf(-gsum)) * vl[j]; }
        v4u o; o.x = pk2(r[0], r[1]); o.y = pk2(r[2], r[3]); o.z = pk2(r[4], r[5]); o.w = pk2(r[6], r[7]);
        *(v4u*)(ACT + (size_t)m * DFF + f0) = o;
    }
}

__device__ __forceinline__ Ctx make_ctx(unsigned char* lds) {
    Ctx C;
    C.lds = (LAS unsigned char*)lds;
    int t = threadIdx.x; asm volatile("" : "+v"(t));
    C.tid = t; C.lane = C.tid & 63; C.wave = __builtin_amdgcn_readfirstlane(C.tid >> 6);
    C.G = gridDim.x; C.bid = blockIdx.x; C.gw = C.bid * NWAVES + C.wave; C.ngw = C.G * NWAVES;
    return C;
}
template <int K> __device__ __forceinline__ void run_phase(unsigned char* lds, const Args& args, int l) {
    const Ctx C = make_ctx(lds);
    unsigned char* ws = args.ws; asm volatile("" : "+s"(ws)); LAS unsigned char* ring = C.lds + RING_OFF; float* out = args.out;
    const float* xsrc = (l == 0) ? args.in[0] : out;
    if constexpr (K == 0) { phase_prep(C, args, l, xsrc, ws); }
    if constexpr (K == 1) { pg8::Gemm g{(const bf16*)(ws + WS_H), (const bf16*)(ws + WS_WIN), M, NWIN, D}; pg8::StaticOrder S; S.init(M, NWIN, C.G, C.bid);
        pg8::EpiWin E{(bf16*)(ws + WS_P1), (bf16*)(ws + WS_G)};
        pg8::gemm_phase<pg8::EpiWin, pg8::StaticOrder, true, true>(ring, g, S, E); }
    if constexpr (K == 2) { phase_aprime(C, args, l, ws); phase_vt(C, ws); }
    if constexpr (K == 3) { pg8::Gemm g{(const bf16*)(ws + WS_AP), (const bf16*)(ws + WS_WLORA), M, NLORA, KLORA}; pg8::StaticOrder S; S.init(M, NLORA, C.G, C.bid);
        pg8::EpiF32P E{(float*)(ws + WS_LO), NLORA};
        pg8::gemm_phase<pg8::EpiF32P, pg8::StaticOrder, true, true>(ring, g, S, E); }
    if constexpr (K == 4) { phase_scanprep(C, args, l, ws); }
    if constexpr (K == 5) {
        build_lut(C, args.in[1]);
        const int xg = C.bid & 7, jj = C.bid >> 3; const bool scanwg = jj < 24;
        if (scanwg && C.wave < 2) { for (int rep = 0; rep < EXP_SCAN_REPS; ++rep) scan_wave(C.lane, C.lds + RING_OFF + C.wave * SCAN_RING, xg * 3 + (jj >> 3), ((jj & 7) * 2 + C.wave) * 4, ws); }
        else { const int aw = scanwg ? (jj * 8 + xg) * 6 + (C.wave - 2) : 1152 + ((jj - 24) * 8 + xg) * 8 + C.wave; const float* sinks = args.in[4] + l * 8;
            for (int rep = 0; rep < EXP_ATTN_REPS; ++rep) for (int it = aw; it < 512 * 20; it += 1664) attn_wave_item(C.lane, (const LAS float*)(C.lds + LUT_OFF), it, sinks, ws); } }
    if constexpr (K == 6) { phase_post(C, args, l, ws); }
    if constexpr (K == 7) {
        { pg8::Gemm g{(const bf16*)(ws + WS_YA), (const bf16*)(ws + WS_PA), M, D, 512}; pg8::StaticOrder S; S.init(M, D, C.G, C.bid);
          pg8::EpiGate<false> E{(const bf16*)(ws + WS_G), 0, (bf16*)(ws + WS_MG)};
          pg8::gemm_phase<pg8::EpiGate<false>, pg8::StaticOrder, true, true>(ring, g, S, E); }
        { pg8::Gemm g{(const bf16*)(ws + WS_YB), (const bf16*)(ws + WS_PB), M, D, 768}; pg8::StaticOrder S; S.init(M, D, C.G, C.bid);
          pg8::EpiGate<true> E{(const bf16*)(ws + WS_G), 2048, (bf16*)(ws + WS_MG)};
          pg8::gemm_phase<pg8::EpiGate<true>, pg8::StaticOrder, true, true>(ring, g, S, E); }
        { pg8::Gemm g{(const bf16*)(ws + WS_YC), (const bf16*)(ws + WS_PC), M, D, 256}; pg8::StaticOrder S; S.init(M, D, C.G, C.bid);
          pg8::EpiGate<true> E{(const bf16*)(ws + WS_G), 4096, (bf16*)(ws + WS_MG)};
          pg8::gemm_phase<pg8::EpiGate<true>, pg8::StaticOrder, true, true>(ring, g, S, E); } }
    if constexpr (K == 8) { pg8::Gemm g{(const bf16*)(ws + WS_MG), (const bf16*)(ws + WS_WOUT), M, D, D}; pg8::StaticOrder S; S.init(M, D, C.G, C.bid);
        pg8::EpiResid E{xsrc, out};
        pg8::gemm_phase<pg8::EpiResid, pg8::StaticOrder, true, true>(ring, g, S, E); }
    if constexpr (K == 9) { const float* g2 = args.in[20] + (size_t)l * D; bf16* H = (bf16*)(ws + WS_H);
        for (int m = C.gw; m < M; m += C.ngw) rms_row_bf16(out + (size_t)m * D, g2, H + (size_t)m * D, C.lane); }
    if constexpr (K == 10) { pg8::Gemm g{(const bf16*)(ws + WS_H), (const bf16*)(ws + WS_WUP), M, NUP, D}; pg8::StaticOrder S; S.init(M, NUP, C.G, C.bid);
        pg8::EpiBf16P E{(bf16*)(ws + WS_U), NUP};
        pg8::gemm_phase<pg8::EpiBf16P, pg8::StaticOrder, true, true>(ring, g, S, E); }
    if constexpr (K == 11) { phase_conv(C, args, l, ws); }
    if constexpr (K == 12) { pg8::Gemm g{(const bf16*)(ws + WS_ACT), (const bf16*)(ws + WS_WDOWN), M, D, DFF}; pg8::StaticOrder S; S.init(M, D, C.G, C.bid);
        pg8::EpiResid E{out, out};
        pg8::gemm_phase<pg8::EpiResid, pg8::StaticOrder, true, true>(ring, g, S, E); }
    if constexpr (K == 13) { const float* gf = args.in[24];
        for (int m = C.gw; m < M; m += C.ngw) rms_row_f32(out + (size_t)m * D, gf, C.lane); }
}
template <int K> __global__ void __launch_bounds__(NTHREADS, 2) fwd_phase(Args args) {
    extern __shared__ __attribute__((aligned(16))) unsigned char lds[];
    run_phase<K>(lds, args, args.li);
}
__global__ void __launch_bounds__(NTHREADS, 2) fwd_all(Args args) {
    extern __shared__ __attribute__((aligned(16))) unsigned char lds[];
    { LAS unsigned* ctlw = (LAS unsigned*)((LAS unsigned char*)lds + LDSCTL_OFF); for (int u = threadIdx.x; u < (LDS_BYTES - LDSCTL_OFF) / 4; u += NTHREADS) ctlw[u] = 0u; }
    __syncthreads();
    const XcdBarrier bar = xcd_barrier_post((unsigned*)(args.ws + WS_CTL) + CW_BAR, (volatile LAS unsigned*)((LAS unsigned char*)lds + MISC_OFF) + 8);
    for (int l = 0; l < DEPTH; ++l) {
        run_phase<0>(lds, args, l); xcd_barrier(bar);
        run_phase<1>(lds, args, l); xcd_barrier(bar);
        run_phase<2>(lds, args, l); xcd_barrier(bar);
        run_phase<3>(lds, args, l); xcd_barrier(bar);
        run_phase<4>(lds, args, l); xcd_barrier(bar);
        run_phase<5>(lds, args, l); xcd_barrier(bar);
        run_phase<6>(lds, args, l); xcd_barrier(bar);
        run_phase<7>(lds, args, l); xcd_barrier(bar);
        run_phase<8>(lds, args, l); xcd_barrier(bar);
        run_phase<9>(lds, args, l); xcd_barrier(bar);
        run_phase<10>(lds, args, l); xcd_barrier(bar);
        run_phase<11>(lds, args, l); xcd_barrier(bar);
        run_phase<12>(lds, args, l); xcd_barrier(bar);
    }
    run_phase<13>(lds, args, 0);
}

#ifndef MK_ONE_LAUNCH
#define MK_ONE_LAUNCH 1
#endif
template <int K> static void launch_phase(int grid, hipStream_t stream, Args a, int l) {
    static bool attr = false; if (!attr) { (void)hipFuncSetAttribute((const void*)fwd_phase<K>, hipFuncAttributeMaxDynamicSharedMemorySize, LDS_BYTES); attr = true; }
    a.li = l; a.ph_lo = K; a.ph_hi = K + 1;
    hipLaunchKernelGGL(fwd_phase<K>, dim3(grid), dim3(NTHREADS), LDS_BYTES, stream, a);
}
extern "C" void kernel_launch(void* const* d_in, const int* in_sizes, int n_in, void* d_out, int out_size, void* d_ws, size_t ws_size, hipStream_t stream) {
    static int grid = 0;
    if (grid == 0) {
        if (n_in != 25 || in_sizes[0] != M * D || out_size != M * D || ws_size < WS_END) { fprintf(stderr, "kernel_launch: unexpected shapes (n_in %d, in0 %d, out %d, ws %zu < %zu)\n", n_in, n_in > 0 ? in_sizes[0] : -1, out_size, ws_size, (size_t)WS_END); grid = -1; return; }
        int dev = 0, cus = 0;
        if (hipGetDevice(&dev) != hipSuccess || hipDeviceGetAttribute(&cus, hipDeviceAttributeMultiprocessorCount, dev) != hipSuccess) { grid = -1; return; }
        grid = cus;
    }
    if (grid < 0) return;
    (void)hipMemsetAsync((char*)d_ws + WS_CTL, 0, CTL_ZERO_BYTES, stream);
    Args a{};
    for (int i = 0; i < 25; ++i) a.in[i] = (const float*)d_in[i];
    a.out = (float*)d_out; a.ws = (unsigned char*)d_ws; a.pad = 0;
#if MK_ONE_LAUNCH
    { static bool attr = false; if (!attr) { (void)hipFuncSetAttribute((const void*)fwd_all, hipFuncAttributeMaxDynamicSharedMemorySize, LDS_BYTES); attr = true; }
      a.li = 0; a.ph_lo = 0; a.ph_hi = NPHASES;
      hipLaunchKernelGGL(fwd_all, dim3(grid), dim3(NTHREADS), LDS_BYTES, stream, a); }
#else
    for (int l = 0; l < DEPTH; ++l) {
        launch_phase<0>(grid, stream, a, l); launch_phase<1>(grid, stream, a, l); launch_phase<2>(grid, stream, a, l); launch_phase<3>(grid, stream, a, l);
        launch_phase<4>(grid, stream, a, l); launch_phase<5>(grid, stream, a, l); launch_phase<6>(grid, stream, a, l); launch_phase<7>(grid, stream, a, l);
        launch_phase<8>(grid, stream, a, l); launch_phase<9>(grid, stream, a, l); launch_phase<10>(grid, stream, a, l); launch_phase<11>(grid, stream, a, l);
        launch_phase<12>(grid, stream, a, l);
    }
    launch_phase<13>(grid, stream, a, 0);
#endif
}
```

```cpp
#include <hip/hip_runtime.h>
#include <cstdio>
#include <cstdint>
#include <cmath>
#define GAS __attribute__((address_space(1)))
#define LAS __attribute__((address_space(3)))
namespace pg8 {
#define PG8_LAS __attribute__((address_space(3)))
typedef unsigned short bf16_t;
typedef short bf16x8 __attribute__((ext_vector_type(8)));
typedef float f32x4 __attribute__((ext_vector_type(4)));
typedef unsigned u32x4 __attribute__((ext_vector_type(4)));
constexpr int BM = 256, BK = 64, HALF = 128, HTB = HALF * BK * 2  , STAGE_BYTES = 8 * HTB, NXCD = 8, WGM = 8;

__host__ __device__ __forceinline__ int lds_byte(int r, int c) { const int st = (r >> 4) * 2 + (c >> 5), rr = r & 15, cc = c & 31, ob = rr * 64 + cc * 2; return st * 1024 + (ob ^ (((ob >> 9) & 1) << 5)); }
__host__ __device__ __forceinline__ void stage_rc(int b, int& R, int& C) { const int st = b / 1024, sb = b % 1024, swz = sb ^ (((sb >> 9) & 1) << 5); R = (st >> 1) * 16 + swz / 64; C = (st & 1) * 32 + (swz % 64) / 2; }
__host__ __device__ __forceinline__ int perm32(int rho) { const int n = rho >> 4, i = rho & 15; return 8 * (i >> 2) + 4 * n + (i & 3); }

struct Unit { int pm, pn; };
struct Gemm { const bf16_t* A; const bf16_t* Bt; int M, N, K; };

struct StaticOrder {
    int nM, nN, nwg, G, c;
    __host__ __device__ void init(int M, int N, int G_, int c_) { nM = M / BM; nN = N / BM; nwg = nM * nN; G = G_; c = c_; }
    __host__ __device__ bool next(int i, Unit& u) const {
        const long L = (long)i * G + c; if (L >= nwg) return false;
        int wgid = (int)L; { const int q = nwg / NXCD, r = nwg % NXCD, xcd = wgid % NXCD, off = wgid / NXCD; wgid = (xcd < r ? xcd * (q + 1) : r * (q + 1) + (xcd - r) * q) + off; }
        const int nig = WGM * nN, gid = wgid / nig, fm = gid * WGM, gsz = (nM - fm) < WGM ? (nM - fm) : WGM;
        u.pm = fm + ((wgid % nig) % gsz); u.pn = (wgid % nig) / gsz; return true;
    }
    __device__ __forceinline__ void a_ready(const Unit&) const {}
    __device__ __forceinline__ void done(const Unit&) const {}
};
__device__ __forceinline__ unsigned cvt_pk_bf16(float lo, float hi) { unsigned r; asm volatile("v_cvt_pk_bf16_f32 %0, %1, %2" : "=v"(r) : "v"(lo), "v"(hi)); return r; }
template <class Epi, class Sched, bool ALIGN_EPI = false, bool SP2 = false>
__device__ __forceinline__ void gemm_phase(PG8_LAS unsigned char* lds, const Gemm g, const Sched& S, const Epi& E) {
    int tid_ = threadIdx.x; asm volatile("" : "+v"(tid_));
    const int tid = tid_, wid = __builtin_amdgcn_readfirstlane(tid >> 6), lane = tid & 63, wr = wid >> 2, wc = wid & 3, fr = lane & 15, fq = lane >> 4;
    const int K = g.K, nt = K / BK;
    unsigned voffA[2], voffB[2];
#pragma unroll
    for (int i = 0; i < 2; ++i) { int R, C; stage_rc(tid * 16 + i * 8192, R, C); const int Rb = Epi::PERM ? ((R & ~31) + perm32(R & 31)) : R;
        voffA[i] = (unsigned)(R * K + C) * 2u; voffB[i] = (unsigned)(Rb * K + C) * 2u; }
    const size_t kstep = (size_t)(BK * 2);
    const size_t hstep = (size_t)HALF * K * 2;
    const size_t tstep = 2 * hstep;
    const unsigned ldsw = (unsigned)wid * 1024u;
    const int aoff = lds_byte(wr * 64 + fr, fq * 8), boff = lds_byte(wc * 32 + fr, fq * 8);
#define PG8_SA(b, h) (((b) * 2 + (h)) * HTB)
#define PG8_SB(b, h) ((4 + (b) * 2 + (h)) * HTB)
#define PG8_STAGE(bufoff, gbase, voff) do { _Pragma("unroll") for (int _i = 0; _i < 2; ++_i) \
        __builtin_amdgcn_global_load_lds((const unsigned*)((const char*)(gbase) + (voff)[_i]), (PG8_LAS unsigned*)(lds + (bufoff) + ldsw + _i * 8192), 16, 0, 0); } while (0)
#define PG8_LDA(dst, b, h) do { _Pragma("unroll") for (int m = 0; m < 4; ++m) _Pragma("unroll") for (int k = 0; k < 2; ++k) dst[m][k] = *(const PG8_LAS bf16x8*)(lds + PG8_SA(b, h) + aoff + m * 2048 + k * 1024); } while (0)
#define PG8_LDB(dst, b, h) do { _Pragma("unroll") for (int n = 0; n < 2; ++n) _Pragma("unroll") for (int k = 0; k < 2; ++k) dst[n][k] = *(const PG8_LAS bf16x8*)(lds + PG8_SB(b, h) + boff + n * 2048 + k * 1024); } while (0)
#define PG8_MMA(ai, bj, At, Bt) do { __builtin_amdgcn_s_setprio(1); _Pragma("unroll") for (int m = 0; m < 4; ++m) _Pragma("unroll") for (int n = 0; n < 2; ++n) _Pragma("unroll") for (int k = 0; k < 2; ++k) \
        acc[ai][bj][m][n] = __builtin_amdgcn_mfma_f32_16x16x32_bf16(Bt[n][k], At[m][k], acc[ai][bj][m][n], 0, 0, 0); __builtin_amdgcn_s_setprio(0); } while (0)
#define PG8_WAIT_V(n) asm volatile("s_waitcnt vmcnt(" #n ")" ::: "memory")
#define PG8_WAIT_L(n) asm volatile("s_waitcnt lgkmcnt(" #n ")" ::: "memory")
#define PG8_BAR __builtin_amdgcn_s_barrier()
#define PG8_SCHED __builtin_amdgcn_sched_barrier(0)
    Unit cur, nxt; int ui = 0;
    if (!S.next(0, cur)) return;
    f32x4 acc[2][2][4][2];
#pragma unroll
    for (int a = 0; a < 2; ++a)
#pragma unroll
        for (int b = 0; b < 2; ++b)
#pragma unroll
            for (int m = 0; m < 4; ++m)
#pragma unroll
                for (int n = 0; n < 2; ++n) acc[a][b][m][n] = (f32x4){0.f, 0.f, 0.f, 0.f};
    bf16x8 At[4][2], B0[2][2], B1[2][2];
    const char* cA = (const char*)g.A + (size_t)cur.pm * tstep; const char* cB = (const char*)g.Bt + (size_t)cur.pn * tstep;
    S.a_ready(cur);
    if constexpr (SP2) {
        PG8_STAGE(PG8_SB(0, 0), cB, voffB); PG8_STAGE(PG8_SB(0, 1), cB + hstep, voffB); PG8_STAGE(PG8_SA(0, 0), cA, voffA); PG8_STAGE(PG8_SA(0, 1), cA + hstep, voffA);
        if (wr == 1) PG8_BAR;
        PG8_WAIT_V(2); PG8_BAR;
        PG8_STAGE(PG8_SB(1, 0), cB + kstep, voffB); PG8_STAGE(PG8_SA(1, 0), cA + kstep, voffA); PG8_STAGE(PG8_SB(1, 1), cB + hstep + kstep, voffB);
        PG8_WAIT_V(6); PG8_BAR;
    } else {
        PG8_STAGE(PG8_SB(0, 0), cB, voffB); PG8_STAGE(PG8_SA(0, 0), cA, voffA); PG8_STAGE(PG8_SB(0, 1), cB + hstep, voffB); PG8_STAGE(PG8_SA(0, 1), cA + hstep, voffA);
        if (wr == 1) PG8_BAR;
        PG8_WAIT_V(4); PG8_BAR;
        PG8_STAGE(PG8_SB(1, 0), cB + kstep, voffB); PG8_STAGE(PG8_SA(1, 0), cA + kstep, voffA); PG8_STAGE(PG8_SB(1, 1), cB + hstep + kstep, voffB);
        PG8_WAIT_V(6); PG8_BAR;
    }
    for (;;) {
        const bool has_next = S.next(ui + 1, nxt);
        const char* nA = has_next ? (const char*)g.A + (size_t)nxt.pm * tstep : cA; const char* nB = has_next ? (const char*)g.Bt + (size_t)nxt.pn * tstep : cB;
        for (int t = 0; t < nt; t += 2) {
            const bool last = (t == nt - 2);
            const char* a1 = cA + (size_t)(t + 1) * kstep;
            const char* a2 = last ? nA : cA + (size_t)(t + 2) * kstep; const char* b2 = last ? nB : cB + (size_t)(t + 2) * kstep;
            const char* a3 = a2 + kstep; const char* b3 = b2 + kstep;
            if (last && has_next) S.a_ready(nxt);
            if constexpr (SP2) {
            PG8_LDB(B0, 0, 0); PG8_LDB(B1, 0, 1); PG8_SCHED; PG8_LDA(At, 0, 0); PG8_STAGE(PG8_SA(1, 1), a1 + hstep, voffA);
            PG8_WAIT_V(8); PG8_WAIT_L(0); PG8_BAR; PG8_MMA(0, 0, At, B0); PG8_MMA(0, 1, At, B1); PG8_BAR; PG8_SCHED;
            PG8_LDA(At, 0, 1); PG8_STAGE(PG8_SB(0, 0), b2, voffB); PG8_STAGE(PG8_SB(0, 1), b2 + hstep, voffB); PG8_STAGE(PG8_SA(0, 0), a2, voffA);
            PG8_WAIT_V(8); PG8_WAIT_L(0); PG8_BAR; PG8_MMA(1, 0, At, B0); PG8_MMA(1, 1, At, B1); PG8_BAR; PG8_SCHED;
            PG8_LDB(B0, 1, 0); PG8_LDB(B1, 1, 1); PG8_SCHED; PG8_LDA(At, 1, 0); PG8_STAGE(PG8_SA(0, 1), a2 + hstep, voffA);
            PG8_WAIT_V(8); PG8_WAIT_L(0); PG8_BAR; PG8_MMA(0, 0, At, B0); PG8_MMA(0, 1, At, B1); PG8_BAR; PG8_SCHED;
            PG8_LDA(At, 1, 1); PG8_STAGE(PG8_SB(1, 0), b3, voffB); PG8_STAGE(PG8_SB(1, 1), b3 + hstep, voffB); PG8_STAGE(PG8_SA(1, 0), a3, voffA);
            PG8_WAIT_V(8); PG8_WAIT_L(0); PG8_BAR; PG8_MMA(1, 0, At, B0); PG8_MMA(1, 1, At, B1); PG8_BAR; PG8_SCHED;
            } else {
            PG8_LDB(B0, 0, 0); PG8_SCHED; PG8_LDA(At, 0, 0); PG8_STAGE(PG8_SA(1, 1), a1 + hstep, voffA);
            PG8_WAIT_L(8); PG8_BAR; PG8_WAIT_L(0); PG8_MMA(0, 0, At, B0); PG8_BAR; PG8_SCHED;
            PG8_LDB(B1, 0, 1); PG8_STAGE(PG8_SB(0, 0), b2, voffB);
            PG8_BAR; PG8_WAIT_L(0); PG8_MMA(0, 1, At, B1); PG8_BAR;
            PG8_LDA(At, 0, 1); PG8_STAGE(PG8_SA(0, 0), a2, voffA);
            PG8_BAR; PG8_WAIT_L(0); PG8_MMA(1, 0, At, B0); PG8_BAR; PG8_SCHED;
            PG8_STAGE(PG8_SB(0, 1), b2 + hstep, voffB);
            PG8_WAIT_V(6); PG8_BAR; PG8_MMA(1, 1, At, B1); PG8_BAR;
            PG8_LDB(B0, 1, 0); PG8_SCHED; PG8_LDA(At, 1, 0); PG8_STAGE(PG8_SA(0, 1), a2 + hstep, voffA);
            PG8_WAIT_L(8); PG8_BAR; PG8_WAIT_L(0); PG8_MMA(0, 0, At, B0); PG8_BAR; PG8_SCHED;
            PG8_LDB(B1, 1, 1); PG8_STAGE(PG8_SB(1, 0), b3, voffB);
            PG8_BAR; PG8_WAIT_L(0); PG8_MMA(0, 1, At, B1); PG8_BAR;
            PG8_LDA(At, 1, 1); PG8_STAGE(PG8_SA(1, 0), a3, voffA);
            PG8_BAR; PG8_WAIT_L(0); PG8_MMA(1, 0, At, B0); PG8_BAR; PG8_SCHED;
            PG8_STAGE(PG8_SB(1, 1), b3 + hstep, voffB);
            PG8_WAIT_V(6); PG8_BAR; PG8_MMA(1, 1, At, B1); PG8_BAR;
            }
        }
        if constexpr (ALIGN_EPI) { if (wr == 0) PG8_BAR; }
        if constexpr (!Epi::AFTER_DRAIN) { E(acc, cur, wr, wc, fr, fq); S.done(cur); }
        if (!has_next) break;
#pragma unroll
        for (int a = 0; a < 2; ++a)
#pragma unroll
            for (int b = 0; b < 2; ++b)
#pragma unroll
                for (int m = 0; m < 4; ++m)
#pragma unroll
                    for (int n = 0; n < 2; ++n) acc[a][b][m][n] = (f32x4){0.f, 0.f, 0.f, 0.f};
        cur = nxt; cA = nA; cB = nB; ++ui;
        if constexpr (ALIGN_EPI) { if (wr == 1) PG8_BAR; }
    }
    PG8_WAIT_V(0);
    if constexpr (!ALIGN_EPI) { if (wr == 0) PG8_BAR; }
    PG8_BAR;
    if constexpr (Epi::AFTER_DRAIN) { E.fused(acc, cur, wr, wc, fr, fq, lds, wid, lane); S.done(cur); }
#undef PG8_SA
#undef PG8_SB
#undef PG8_STAGE
#undef PG8_LDA
#undef PG8_LDB
#undef PG8_MMA
#undef PG8_WAIT_V
#undef PG8_WAIT_L
#undef PG8_BAR
#undef PG8_SCHED
}
}
#define XB_TMO      128
#define XB_XCNT(j)  (256  + 64 * (j))
#define XB_XSUB(j)  (1280 + 64 * (j))
#define XB_XGEN(j)  (2304 + 64 * (j))
#define XB_TOP      3328
#define XB_TOPGEN   3392
#define XCD_BAR_WORDS 3456
#define XB_SPIN_CAP (1u << 18)

__device__ __forceinline__ unsigned xb_ld(unsigned* p)              { return __hip_atomic_load(p, __ATOMIC_RELAXED, __HIP_MEMORY_SCOPE_AGENT); }
__device__ __forceinline__ unsigned xb_add(unsigned* p, unsigned v) { return __hip_atomic_fetch_add(p, v, __ATOMIC_RELAXED, __HIP_MEMORY_SCOPE_AGENT); }
__device__ __forceinline__ unsigned xb_xcc_id() { return (unsigned)__builtin_amdgcn_s_getreg((3 << 11) | 20) & 0xFu; }
#define XB_SPIN(cond, bar) do { unsigned _sp = 0; while (cond) { __builtin_amdgcn_s_sleep(1); \
    if ((++_sp & 255u) == 0u) { if (xb_ld(&(bar)[XB_TMO])) break; if (_sp > XB_SPIN_CAP) { atomicAdd(&(bar)[XB_TMO], 1u); break; } } } } while (0)

struct XcdBarrier {
    unsigned* bar; unsigned x;
    volatile LAS unsigned* st;
};

__device__ __forceinline__ XcdBarrier xcd_barrier_post(unsigned* bar, volatile LAS unsigned* st) {
    XcdBarrier b; b.bar = bar; b.x = xb_xcc_id(); b.st = st;
    if (threadIdx.x == 0) (void)xb_add(&bar[XB_XCNT(b.x)], 1u);
    return b;
}
__device__ __forceinline__ void xcd_barrier_complete(unsigned* bar, unsigned x, unsigned& nloc, unsigned& nx) {
    const unsigned G = gridDim.x * gridDim.y * gridDim.z;
    unsigned sum, cnt, mine, sp = 0u;
    for (;;) {
        sum = 0u; cnt = 0u; mine = 0u;
#pragma unroll
        for (unsigned j = 0; j < 16; ++j) { const unsigned c = xb_ld(&bar[XB_XCNT(j)]); sum += c; cnt += (c > 0u) ? 1u : 0u; mine = (j == x) ? c : mine; }
        if (sum == G) break;
        __builtin_amdgcn_s_sleep(1);
        if ((++sp & 255u) == 0u) { if (xb_ld(&bar[XB_TMO])) break; if (sp > XB_SPIN_CAP) { atomicAdd(&bar[XB_TMO], 1u); break; } }
    }
    nloc = mine > 0u ? mine : 1u; nx = cnt > 0u ? cnt : 1u;
}

__device__ __forceinline__ void xcd_barrier(const XcdBarrier& b) {
    asm volatile("s_waitcnt vmcnt(0)" ::: "memory");
    __syncthreads();
    if (threadIdx.x == 0) {
        unsigned* bar = b.bar;
        __builtin_amdgcn_s_waitcnt(0);
        unsigned nloc = b.st[0], nx = b.st[1];
        if (nloc == 0u) { xcd_barrier_complete(bar, b.x, nloc, nx); b.st[0] = nloc; b.st[1] = nx; }
        const unsigned old = xb_add(&bar[XB_XSUB(b.x)], 1u);
        const unsigned gen = old / nloc;
        if (old + 1u == (gen + 1u) * nloc) {
            __builtin_amdgcn_fence(__ATOMIC_RELEASE, "agent");
            asm volatile("s_waitcnt vmcnt(0)" ::: "memory");
            const unsigned og = xb_add(&bar[XB_TOP], 1u);
            const unsigned tg = og / nx;
            if (og + 1u == (tg + 1u) * nx) xb_add(&bar[XB_TOPGEN], 1u);
            else XB_SPIN(xb_ld(&bar[XB_TOPGEN]) == tg, bar);
            __builtin_amdgcn_fence(__ATOMIC_ACQUIRE, "agent");
            xb_add(&bar[XB_XGEN(b.x)], 1u);
            asm volatile("s_waitcnt vmcnt(0)" ::: "memory");
        } else {
            XB_SPIN(xb_ld(&bar[XB_XGEN(b.x)]) == gen, bar);
            __builtin_amdgcn_fence(__ATOMIC_ACQUIRE, "agent");
            asm volatile("s_waitcnt vmcnt(0)" ::: "memory");
        }
    }
    __syncthreads();
}

constexpr int BATCH = 2, SEQ = 8192, M = BATCH * SEQ, D = 2048, DEPTH = 4;
constexpr int DIN = 11968, NP1 = 5888, NG = 6144, NWIN = NP1 + NG;
constexpr int BW = 768, BCOLS = 2752;
constexpr int C_AQ = 0, C_AK = 512, C_AV = 640, C_R = 768, C_K = 1536, C_V = 2304, C_WD = 3072, C_CQ = 3520, C_CK = 4288, C_CV = 5056, C_END = 5824;
constexpr int DFF = 5504, NUP = 2 * DFF;
constexpr int NLORA = 2304, KLORA = 512;
constexpr float NORM_EPS = 1e-5f, GN_EPS = 64e-5f;
constexpr int NWAVES = 8, NTHREADS = 512;
constexpr int NPH = 13;
constexpr int NPHASES = DEPTH * NPH + 1;
#ifndef EXP_EW_MASK
#define EXP_EW_MASK 0
#endif
#ifndef EXP_EW_REPS
#define EXP_EW_REPS 1
#endif
#ifndef EXP_G1_REPS
#define EXP_G1_REPS 1
#endif
#ifndef EXP_SCAN_REPS
#define EXP_SCAN_REPS 1
#endif
#ifndef EXP_ATTN_REPS
#define EXP_ATTN_REPS 1
#endif
constexpr int NSCAN = 48;

constexpr size_t MiB = 1u << 20;
constexpr size_t WS_CTL = 0, CTL_ZERO_BYTES = 1 * MiB;
constexpr size_t WS_WIN = 1 * MiB;
constexpr size_t WS_WLORA = 48 * MiB;
constexpr size_t WS_PA = 51 * MiB;
constexpr size_t WS_PB = 53 * MiB;
constexpr size_t WS_PC = 56 * MiB;
constexpr size_t WS_WOUT = 57 * MiB;
constexpr size_t WS_WUP = 65 * MiB;
constexpr size_t WS_WDOWN = 108 * MiB;
constexpr size_t WS_H = 130 * MiB;
constexpr size_t WS_P1 = 194 * MiB;
constexpr size_t WS_G = 378 * MiB;
constexpr size_t WS_U = WS_P1;
constexpr size_t WS_AP = 570 * MiB;
constexpr size_t WS_LO = 586 * MiB;
constexpr size_t WS_ACT = WS_LO;
constexpr size_t WS_SR = 730 * MiB;
constexpr size_t WS_SW = 778 * MiB, WS_SK = 826 * MiB, WS_SKK = 874 * MiB, WS_SB = 922 * MiB, WS_SV = 970 * MiB;
constexpr size_t WS_YRAW = 1018 * MiB;
constexpr size_t WS_YA = 1066 * MiB;
constexpr size_t WS_YB = 1082 * MiB;
constexpr size_t WS_YC = 1106 * MiB;
constexpr size_t WS_OC = 1114 * MiB;
constexpr size_t WS_LSE = 1138 * MiB;
constexpr size_t WS_MG = 1139 * MiB;
constexpr size_t WS_BK = 1203 * MiB;
constexpr size_t WS_VT = 1205 * MiB;
constexpr size_t WS_W2 = 1235 * MiB;
constexpr size_t WSET_STRIDE = WS_W2 - WS_WIN;
constexpr size_t WS_END = 1365 * MiB;
constexpr int CW_BAR = 4096;

constexpr int RING_OFF = 0, RING_BYTES = 131072;
constexpr int LDSCTL_OFF = RING_BYTES, MISC_OFF = LDSCTL_OFF + 320;
constexpr int LDS_BYTES = 147456;

typedef unsigned short bf16;
typedef unsigned v4u __attribute__((ext_vector_type(4)));
typedef unsigned v2u __attribute__((ext_vector_type(2)));
typedef float f32x4 __attribute__((ext_vector_type(4)));
#define LDS_WAIT() asm volatile("s_waitcnt lgkmcnt(0)" ::: "memory")

__device__ __forceinline__ unsigned f2bf(float f) { unsigned u = __builtin_bit_cast(unsigned, f); return (u + 0x7fffu + ((u >> 16) & 1u)) >> 16; }
__device__ __forceinline__ unsigned pk2(float lo, float hi) { return f2bf(lo) | (f2bf(hi) << 16); }
__device__ __forceinline__ float bflo(unsigned w) { return __builtin_bit_cast(float, w << 16); }
__device__ __forceinline__ float bfhi(unsigned w) { return __builtin_bit_cast(float, w & 0xffff0000u); }
__device__ __forceinline__ float bf1(bf16 h) { return __builtin_bit_cast(float, ((unsigned)h) << 16); }
__device__ __forceinline__ float sigmoidf_(float x) { return 1.0f / (1.0f + __expf(-x)); }
__device__ __forceinline__ float wave_sum(float v) {
#pragma unroll
    for (int o = 1; o < 64; o <<= 1) v += __shfl_xor(v, o);
    return v;
}
template <int CTRL> __device__ __forceinline__ float dppf(float x) { return __builtin_bit_cast(float, __builtin_amdgcn_update_dpp(0, __builtin_bit_cast(int, x), CTRL, 0xF, 0xF, true)); }
__device__ __forceinline__ float red4(float x) { x += dppf<0xB1>(x); x += dppf<0x4E>(x); return x; }
__device__ __forceinline__ float red16(float x) { x = red4(x); x += dppf<0x141>(x); x += dppf<0x140>(x); return x; }
__device__ __forceinline__ float wsum(float x) { x = red16(x); x += __shfl_xor(x, 16); x += __shfl_xor(x, 32); return x; }

__device__ const unsigned char T5B[3][132] = {
 {0,1,2,3,4,5,6,7,8,9,10,11,12,13,14,15,16,16,16,16,16,16,17,17,17,17,17,17,17,17,18,18,18,18,18,18,18,18,18,18,19,19,19,19,19,19,19,19,19,19,19,19,19,19,20,20,20,20,20,20,20,20,20,20,20,20,20,20,20,20,20,20,20,21,21,21,21,21,21,21,21,21,21,21,21,21,21,21,21,21,21,21,21,21,21,21,21,21,21,22,22,22,22,22,22,22,22,22,22,22,22,22,22,22,22,22,22,22,22,22,22,22,22,22,22,22,22,22,22,0,0,0},
 {0,4,8,12,16,16,17,17,18,18,19,19,19,19,20,20,20,20,20,21,21,21,21,21,21,22,22,22,22,22,22,22,22,22,23,23,23,23,23,23,23,23,23,23,23,23,24,24,24,24,24,24,24,24,24,24,24,24,24,24,24,24,25,25,25,25,25,25,25,25,25,25,25,25,25,25,25,25,25,25,25,25,25,26,26,26,26,26,26,26,26,26,26,26,26,26,26,26,26,26,26,26,26,26,26,26,26,26,26,26,26,26,26,27,27,27,27,27,27,27,27,27,27,27,27,27,27,27,27,0,0,0},
 {0,16,18,19,20,21,21,22,22,23,23,23,24,24,24,24,25,25,25,25,25,26,26,26,26,26,26,26,26,27,27,27,27,27,27,27,27,27,27,28,28,28,28,28,28,28,28,28,28,28,28,28,29,29,29,29,29,29,29,29,29,29,29,29,29,29,29,29,29,29,30,30,30,30,30,30,30,30,30,30,30,30,30,30,30,30,30,30,30,30,30,30,30,30,30,31,31,31,31,31,31,31,31,31,31,31,31,31,31,31,31,31,31,31,31,31,31,31,31,31,31,31,31,31,31,31,31,31,31,0,0,0}};

namespace pg8 {
struct EpiWin {
    static constexpr bool PERM = true, AFTER_DRAIN = false;
    bf16_t* P1; bf16_t* G;
    __device__ __forceinline__ void operator()(const f32x4 (&acc)[2][2][4][2], const Unit& u, int wr, int wc, int fr, int fq) const {
        const int row0 = u.pm * BM + wr * 64 + fr; const bool gate = u.pn >= 23;
        bf16_t* base = gate ? G : P1; const int ldc = gate ? 6144 : 5888; const int col0 = (gate ? (u.pn - 23) : u.pn) * BM + wc * 32 + 8 * fq;
#pragma unroll
        for (int ai = 0; ai < 2; ++ai)
#pragma unroll
            for (int m = 0; m < 4; ++m) { bf16_t* rowp = base + (size_t)(row0 + ai * HALF + m * 16) * ldc + col0;
#pragma unroll
                for (int bj = 0; bj < 2; ++bj) { f32x4 v0 = acc[ai][bj][m][0], v1 = acc[ai][bj][m][1];
                    if (gate) {
#pragma unroll
                        for (int j = 0; j < 4; ++j) { v0[j] = __builtin_amdgcn_rcpf(1.0f + __expf(-v0[j])); v1[j] = __builtin_amdgcn_rcpf(1.0f + __expf(-v1[j])); } }
                    u32x4 w; w.x = cvt_pk_bf16(v0[0], v0[1]); w.y = cvt_pk_bf16(v0[2], v0[3]); w.z = cvt_pk_bf16(v1[0], v1[1]); w.w = cvt_pk_bf16(v1[2], v1[3]);
                    *(u32x4*)(rowp + bj * HALF) = w; } }
    }
};
struct EpiBf16P {
    static constexpr bool PERM = true, AFTER_DRAIN = false;
    bf16_t* O; int ldc;
    __device__ __forceinline__ void operator()(const f32x4 (&acc)[2][2][4][2], const Unit& u, int wr, int wc, int fr, int fq) const {
        const int row0 = u.pm * BM + wr * 64 + fr; const int col0 = u.pn * BM + wc * 32 + 8 * fq;
#pragma unroll
        for (int ai = 0; ai < 2; ++ai)
#pragma unroll
            for (int m = 0; m < 4; ++m) { bf16_t* rowp = O + (size_t)(row0 + ai * HALF + m * 16) * ldc + col0;
#pragma unroll
                for (int bj = 0; bj < 2; ++bj) { const f32x4 v0 = acc[ai][bj][m][0], v1 = acc[ai][bj][m][1];
                    u32x4 w; w.x = cvt_pk_bf16(v0[0], v0[1]); w.y = cvt_pk_bf16(v0[2], v0[3]); w.z = cvt_pk_bf16(v1[0], v1[1]); w.w = cvt_pk_bf16(v1[2], v1[3]);
                    *(u32x4*)(rowp + bj * HALF) = w; } }
    }
};
struct EpiF32P {
    static constexpr bool PERM = false, AFTER_DRAIN = false;
    float* C; int ldc;
    __device__ __forceinline__ void operator()(const f32x4 (&acc)[2][2][4][2], const Unit& u, int wr, int wc, int fr, int fq) const {
        const int row0 = u.pm * BM + wr * 64 + fr, col0 = u.pn * BM + wc * 32 + 4 * fq;
#pragma unroll
        for (int ai = 0; ai < 2; ++ai)
#pragma unroll
            for (int m = 0; m < 4; ++m) { float* rowp = C + (size_t)(row0 + ai * HALF + m * 16) * ldc + col0;
#pragma unroll
                for (int bj = 0; bj < 2; ++bj)
#pragma unroll
                    for (int n = 0; n < 2; ++n) *(f32x4*)(rowp + bj * HALF + n * 16) = acc[ai][bj][m][n]; }
    }
};
struct EpiResid {
    static constexpr bool PERM = false, AFTER_DRAIN = false;
    const float* xin; float* out;
    __device__ __forceinline__ void operator()(const f32x4 (&acc)[2][2][4][2], const Unit& u, int wr, int wc, int fr, int fq) const {
        const int row0 = u.pm * BM + wr * 64 + fr, col0 = u.pn * BM + wc * 32 + 4 * fq;
#pragma unroll
        for (int ai = 0; ai < 2; ++ai)
#pragma unroll
            for (int m = 0; m < 4; ++m) { const size_t ro = (size_t)(row0 + ai * HALF + m * 16) * 2048 + col0;
#pragma unroll
                for (int bj = 0; bj < 2; ++bj)
#pragma unroll
                    for (int n = 0; n < 2; ++n) { const f32x4 xv = *(const f32x4*)(xin + ro + bj * HALF + n * 16); *(f32x4*)(out + ro + bj * HALF + n * 16) = xv + acc[ai][bj][m][n]; } }
    }
};
template <bool ACC> struct EpiGate {
    static constexpr bool PERM = true, AFTER_DRAIN = false;
    const bf16_t* G; int gofs; bf16_t* MG;
    __device__ __forceinline__ void operator()(const f32x4 (&acc)[2][2][4][2], const Unit& u, int wr, int wc, int fr, int fq) const {
        const int row0 = u.pm * BM + wr * 64 + fr; const int col0 = u.pn * BM + wc * 32 + 8 * fq;
#pragma unroll
        for (int ai = 0; ai < 2; ++ai)
#pragma unroll
            for (int m = 0; m < 4; ++m) { const int row = row0 + ai * HALF + m * 16;
#pragma unroll
                for (int bj = 0; bj < 2; ++bj) { const int col = col0 + bj * HALF;
                    const u32x4 gv = *(const u32x4*)(G + (size_t)row * 6144 + gofs + col);
                    const f32x4 a0 = acc[ai][bj][m][0], a1 = acc[ai][bj][m][1];
                    float r[8];
                    r[0] = __builtin_bit_cast(float, gv.x << 16) * a0[0]; r[1] = __builtin_bit_cast(float, gv.x & 0xffff0000u) * a0[1];
                    r[2] = __builtin_bit_cast(float, gv.y << 16) * a0[2]; r[3] = __builtin_bit_cast(float, gv.y & 0xffff0000u) * a0[3];
                    r[4] = __builtin_bit_cast(float, gv.z << 16) * a1[0]; r[5] = __builtin_bit_cast(float, gv.z & 0xffff0000u) * a1[1];
                    r[6] = __builtin_bit_cast(float, gv.w << 16) * a1[2]; r[7] = __builtin_bit_cast(float, gv.w & 0xffff0000u) * a1[3];
                    bf16_t* mp = MG + (size_t)row * 2048 + col;
                    if (ACC) { const u32x4 ov = *(const u32x4*)mp;
                        r[0] += __builtin_bit_cast(float, ov.x << 16); r[1] += __builtin_bit_cast(float, ov.x & 0xffff0000u);
                        r[2] += __builtin_bit_cast(float, ov.y << 16); r[3] += __builtin_bit_cast(float, ov.y & 0xffff0000u);
                        r[4] += __builtin_bit_cast(float, ov.z << 16); r[5] += __builtin_bit_cast(float, ov.z & 0xffff0000u);
                        r[6] += __builtin_bit_cast(float, ov.w << 16); r[7] += __builtin_bit_cast(float, ov.w & 0xffff0000u); }
                    u32x4 w; w.x = cvt_pk_bf16(r[0], r[1]); w.y = cvt_pk_bf16(r[2], r[3]); w.z = cvt_pk_bf16(r[4], r[5]); w.w = cvt_pk_bf16(r[6], r[7]);
                    *(u32x4*)mp = w; } }
    }
};
}

struct Args { const float* in[25]; float* out; unsigned char* ws; int ph_lo, ph_hi, li, pad; };

struct Ctx {
    LAS unsigned char* lds;
    int tid, lane, wave, G, bid;
    int gw, ngw;
};

__device__ __forceinline__ void transpose_item(const float* W, int K, int N, bf16* WT, int kb, int nb, int dst_row0, LAS float* scr, int lane) {
    const int k0 = 64 * kb, n0 = 32 * nb;
#pragma unroll 8
    for (int i = 0; i < 32; ++i) { const int kk = 2 * i + (lane >> 5); scr[kk * 33 + (lane & 31)] = W[(size_t)(k0 + kk) * N + n0 + (lane & 31)]; }
    LDS_WAIT(); asm volatile("" ::: "memory");
    const int c = lane & 7;
#pragma unroll
    for (int j = 0; j < 4; ++j) { const int n = (lane >> 3) + 8 * j; const LAS float* s = scr + (8 * c) * 33 + n;
        v4u o; o.x = pk2(s[0 * 33], s[1 * 33]); o.y = pk2(s[2 * 33], s[3 * 33]); o.z = pk2(s[4 * 33], s[5 * 33]); o.w = pk2(s[6 * 33], s[7 * 33]);
        *(v4u*)(WT + (size_t)(dst_row0 + n) * K + k0 + 8 * c) = o; }
    LDS_WAIT(); asm volatile("" ::: "memory");
}
__device__ __forceinline__ int transpose_matrix(int widx, int nw, int lane, LAS float* scr, const float* W, int K, int N, bf16* WT, int gate_split, int base) {
    const int nblk = N / 32, items = (K / 64) * nblk;
    int first = (widx - base) % nw; if (first < 0) first += nw;
    for (int it = first; it < items; it += nw) {
        const int kb = it / nblk, nb = it % nblk; int dr = 32 * nb; if (gate_split && dr >= C_END) dr += 64;
        transpose_item(W, K, N, WT, kb, nb, dr, scr, lane);
    }
    return base + items;
}
__device__ __forceinline__ void convert_weights(int widx, int nw, int lane, LAS float* scr, const Args& a, int l, unsigned char* ws) {
    unsigned char* wsw = ws + (size_t)(l & 1) * WSET_STRIDE;
    int base = 0;
    base = transpose_matrix(widx, nw, lane, scr, a.in[3] + (size_t)l * D * DIN, D, DIN, (bf16*)(wsw + WS_WIN), 1, base);
    base = transpose_matrix(widx, nw, lane, scr, a.in[21] + (size_t)l * D * NUP, D, NUP, (bf16*)(wsw + WS_WUP), 0, base);
    base = transpose_matrix(widx, nw, lane, scr, a.in[23] + (size_t)l * DFF * D, DFF, D, (bf16*)(wsw + WS_WDOWN), 0, base);
    base = transpose_matrix(widx, nw, lane, scr, a.in[19] + (size_t)l * D * D, D, D, (bf16*)(wsw + WS_WOUT), 0, base);
    base = transpose_matrix(widx, nw, lane, scr, a.in[16] + (size_t)l * 512 * D, 512, D, (bf16*)(wsw + WS_PA), 0, base);
    base = transpose_matrix(widx, nw, lane, scr, a.in[17] + (size_t)l * 768 * D, 768, D, (bf16*)(wsw + WS_PB), 0, base);
    base = transpose_matrix(widx, nw, lane, scr, a.in[18] + (size_t)l * 256 * D, 256, D, (bf16*)(wsw + WS_PC), 0, base);
    const int gt = widx * 64 + lane, ngt = nw * 64;
    { v4u* z = (v4u*)((bf16*)(wsw + WS_WIN) + (size_t)C_END * D); for (int i = gt; i < 64 * D / 8; i += ngt) z[i] = (v4u){0u, 0u, 0u, 0u}; }
    { bf16* wl = (bf16*)(wsw + WS_WLORA); const float* wup = a.in[7] + (size_t)l * 96 * BW; const float* aup = a.in[9] + (size_t)l * 96 * BW; const float* gup = a.in[10] + (size_t)l * 256 * BW;
      for (int i = gt; i < NLORA * KLORA; i += ngt) { const int n = i / KLORA, k = i % KLORA; float v = 0.f;
          if (n < 768) { if (k < 96) v = wup[k * BW + n]; }
          else if (n < 1536) { if (k >= 96 && k < 192) v = aup[(k - 96) * BW + (n - 768)]; }
          else { if (k >= 192 && k < 448) v = gup[(k - 192) * BW + (n - 1536)]; }
          wl[i] = (bf16)f2bf(v); } }
}

__device__ __forceinline__ void rms_row_bf16(const float* xrow, const float* gam, bf16* orow, int lane) {
    const f32x4* xr = (const f32x4*)xrow + lane; f32x4 v[8]; float s = 0.f;
#pragma unroll
    for (int j = 0; j < 8; ++j) { v[j] = xr[64 * j]; s += (v[j].x * v[j].x + v[j].y * v[j].y) + (v[j].z * v[j].z + v[j].w * v[j].w); }
    const float rs = 1.0f / sqrtf(wave_sum(s) * (1.0f / D) + NORM_EPS);
    const f32x4* gr = (const f32x4*)gam + lane; v2u* o8 = (v2u*)orow + lane;
#pragma unroll
    for (int j = 0; j < 8; ++j) { const f32x4 g = gr[64 * j]; v2u w; w.x = pk2(v[j].x * rs * g.x, v[j].y * rs * g.y); w.y = pk2(v[j].z * rs * g.z, v[j].w * rs * g.w); o8[64 * j] = w; }
}
__device__ __forceinline__ void rms_row2_bf16(const float* xrow, const float* gam, bf16* orow, int lane) {
    const f32x4* xr = (const f32x4*)xrow + lane; f32x4 v[16]; float s0 = 0.f, s1 = 0.f;
#pragma unroll
    for (int j = 0; j < 16; ++j) v[j] = xr[64 * j];
#pragma unroll
    for (int j = 0; j < 8; ++j) { s0 += (v[j].x * v[j].x + v[j].y * v[j].y) + (v[j].z * v[j].z + v[j].w * v[j].w); s1 += (v[8 + j].x * v[8 + j].x + v[8 + j].y * v[8 + j].y) + (v[8 + j].z * v[8 + j].z + v[8 + j].w * v[8 + j].w); }
    const float rs0 = 1.0f / sqrtf(wsum(s0) * (1.0f / D) + NORM_EPS), rs1 = 1.0f / sqrtf(wsum(s1) * (1.0f / D) + NORM_EPS);
    const f32x4* gr = (const f32x4*)gam + lane; v2u* o8 = (v2u*)orow + lane;
#pragma unroll
    for (int j = 0; j < 8; ++j) { const f32x4 g = gr[64 * j]; v2u w; w.x = pk2(v[j].x * rs0 * g.x, v[j].y * rs0 * g.y); w.y = pk2(v[j].z * rs0 * g.z, v[j].w * rs0 * g.w); o8[64 * j] = w;
        v2u w1; w1.x = pk2(v[8 + j].x * rs1 * g.x, v[8 + j].y * rs1 * g.y); w1.y = pk2(v[8 + j].z * rs1 * g.z, v[8 + j].w * rs1 * g.w); o8[64 * (8 + j)] = w1; }
}
__device__ __forceinline__ void rms_row_f32(float* xrow, const float* gam, int lane) {
    f32x4* xr = (f32x4*)xrow + lane; f32x4 v[8]; float s = 0.f;
#pragma unroll
    for (int j = 0; j < 8; ++j) { v[j] = xr[64 * j]; s += (v[j].x * v[j].x + v[j].y * v[j].y) + (v[j].z * v[j].z + v[j].w * v[j].w); }
    const float rs = 1.0f / sqrtf(wave_sum(s) * (1.0f / D) + NORM_EPS);
    const f32x4* gr = (const f32x4*)gam + lane;
#pragma unroll
    for (int j = 0; j < 8; ++j) { const f32x4 g = gr[64 * j]; xr[64 * j] = v[j] * rs * g; }
}

__device__ __forceinline__ void phase_prep(const Ctx& C, const Args& a, int l, const float* xsrc, unsigned char* ws) {
    if (l == 0) convert_weights(C.gw, C.ngw, C.lane, (LAS float*)(C.lds + RING_OFF + C.wave * 16384), a, 0, ws);
    const float* g1 = a.in[2] + (size_t)l * D; bf16* H = (bf16*)(ws + WS_H);
    for (int m = 2 * C.gw; m < M; m += 2 * C.ngw) rms_row2_bf16(xsrc + (size_t)m * D, g1, H + (size_t)m * D, C.lane);
}

__device__ __forceinline__ void phase_aprime(const Ctx& C, const Args& a, int l, unsigned char* ws) {
    const bf16* P1 = (const bf16*)(ws + WS_P1); bf16* AP = (bf16*)(ws + WS_AP); const float* mu = a.in[5] + (size_t)l * BCOLS;
    const int g = C.lane, c0 = 8 * g;
    float muv[8];
#pragma unroll
    for (int j = 0; j < 8; ++j) muv[j] = (g < 56) ? mu[(C_WD - C_R) + c0 + j] : 0.f;
    for (int m = C.gw; m < M; m += C.ngw) {
        v4u o = (v4u){0u, 0u, 0u, 0u};
        if (g < 56) {
            const v4u cur = *(const v4u*)(P1 + (size_t)m * NP1 + C_WD + c0);
            v4u prv = (v4u){0u, 0u, 0u, 0u}; if ((m & (SEQ - 1)) != 0) prv = *(const v4u*)(P1 + (size_t)(m - 1) * NP1 + C_WD + c0);
            float x[8], p[8];
            x[0] = bflo(cur.x); x[1] = bfhi(cur.x); x[2] = bflo(cur.y); x[3] = bfhi(cur.y); x[4] = bflo(cur.z); x[5] = bfhi(cur.z); x[6] = bflo(cur.w); x[7] = bfhi(cur.w);
            p[0] = bflo(prv.x); p[1] = bfhi(prv.x); p[2] = bflo(prv.y); p[3] = bfhi(prv.y); p[4] = bflo(prv.z); p[5] = bfhi(prv.z); p[6] = bflo(prv.w); p[7] = bfhi(prv.w);
#pragma unroll
            for (int j = 0; j < 8; ++j) { float v = x[j] + (p[j] - x[j]) * muv[j];
                if (g < 12) v = tanhf(v); else if (g >= 24) v = sigmoidf_(v);
                x[j] = v; }
            o.x = pk2(x[0], x[1]); o.y = pk2(x[2], x[3]); o.z = pk2(x[4], x[5]); o.w = pk2(x[6], x[7]);
        }
        *(v4u*)(AP + (size_t)m * KLORA + c0) = o;
    }
}

struct PrepTok { float r, kt, v, w, kk, b; };
__device__ __forceinline__ PrepTok prep_token(const bf16* P1, const float* LO, int m, int hc, float mur, float muk, float muv, float w0, float a0, float kkw, float kaw) {
    const bool first = (m & (SEQ - 1)) == 0;
    const bf16* pr = P1 + (size_t)m * NP1; const bf16* pp = pr - NP1;
    float r = bf1(pr[C_R + hc]), k = bf1(pr[C_K + hc]), v = bf1(pr[C_V + hc]);
    const float rp = first ? 0.f : bf1(pp[C_R + hc]), kp = first ? 0.f : bf1(pp[C_K + hc]), vp = first ? 0.f : bf1(pp[C_V + hc]);
    r = r + (rp - r) * mur; k = k + (kp - k) * muk; v = v + (vp - v) * muv;
    const float wpre = w0 + LO[(size_t)m * NLORA + hc], apre = a0 + LO[(size_t)m * NLORA + BW + hc];
    const float xx = -wpre; const float sp = fmaxf(xx, 0.f) + log1pf(expf(-fabsf(xx)));
    const float wlog = -sp - 0.5f; const float decay = expf(-expf(wlog));
    const float av = 1.0f / (1.0f + expf(-apre));
    const float kkr = k * kkw; const float nrm = sqrtf(wave_sum(kkr * kkr)); const float kk = kkr / fmaxf(nrm, 1e-12f);
    PrepTok t; t.r = r; t.kt = k * (1.0f + (av - 1.0f) * kaw); t.v = v; t.w = decay; t.kk = kk; t.b = kk * av; return t;
}
__device__ __forceinline__ void phase_scanprep(const Ctx& C, const Args& a, int l, unsigned char* ws) {
    const bf16* P1 = (const bf16*)(ws + WS_P1); const float* LO = (const float*)(ws + WS_LO);
    float* SR = (float*)(ws + WS_SR); float* SW = (float*)(ws + WS_SW); float* SK = (float*)(ws + WS_SK); float* SU = (float*)(ws + WS_SKK); float* SB = (float*)(ws + WS_SB); float* SV = (float*)(ws + WS_SV);
    float* BK = (float*)(ws + WS_BK);
    const float* mu = a.in[5] + (size_t)l * BCOLS; const float* w0p = a.in[6] + (size_t)l * BW; const float* a0p = a.in[8] + (size_t)l * BW;
    const float* kkwp = a.in[11] + (size_t)l * BW; const float* kawp = a.in[12] + (size_t)l * BW;
    constexpr int TB = 16, NS = TB + 2;
    for (int it = C.gw; it < (M / TB) * 12; it += C.ngw) {
        const int tb = it / 12, h = it % 12, hc = h * 64 + C.lane, m0 = tb * TB;
        const float mur = mu[hc], muk = mu[BW + hc], muv = mu[2 * BW + hc], w0 = w0p[hc], a0 = a0p[hc], kkw = kkwp[hc], kaw = kawp[hc];
        const bool seq_start = (m0 & (SEQ - 1)) == 0;
        float rr[NS], rk[NS], rv[NS], lw[NS], la[NS];
#pragma unroll
        for (int j = 0; j < NS; ++j) {
            const bool ok = !(seq_start && j < 2); const size_t row = ok ? (size_t)(m0 - 2 + j) : (size_t)m0;
            const bf16* pr = P1 + row * NP1 + hc;
            const float x0 = bf1(pr[C_R]), x1 = bf1(pr[C_K]), x2 = bf1(pr[C_V]);
            rr[j] = ok ? x0 : 0.f; rk[j] = ok ? x1 : 0.f; rv[j] = ok ? x2 : 0.f;
            if (j >= 1) { const float y0 = LO[row * NLORA + hc], y1 = LO[row * NLORA + BW + hc]; lw[j] = ok ? y0 : 0.f; la[j] = ok ? y1 : 0.f; } else { lw[j] = 0.f; la[j] = 0.f; }
        }
        float tr[NS], tk[NS], tv[NS], tw[NS], ta[NS], tq[NS];
#pragma unroll
        for (int j = 1; j < NS; ++j) {
            tr[j] = rr[j] + (rr[j - 1] - rr[j]) * mur; tk[j] = rk[j] + (rk[j - 1] - rk[j]) * muk; tv[j] = rv[j] + (rv[j - 1] - rv[j]) * muv;
            const float xx = -(w0 + lw[j]); const float sp = fmaxf(xx, 0.f) + __logf(1.0f + __expf(-fabsf(xx)));
            tw[j] = __expf(-__expf(-sp - 0.5f));
            ta[j] = 1.0f / (1.0f + __expf(-(a0 + la[j])));
            const float kkr = tk[j] * kkw; tq[j] = kkr * kkr;
        }
#pragma unroll
        for (int j = 1; j < NS; ++j) tq[j] = wsum(tq[j]);
        float tkk[NS], tb_[NS], tkt[NS];
#pragma unroll
        for (int j = 1; j < NS; ++j) { tkk[j] = tk[j] * kkw / fmaxf(sqrtf(tq[j]), 1e-12f); tb_[j] = tkk[j] * ta[j]; tkt[j] = tk[j] * (1.0f + (ta[j] - 1.0f) * kaw); }
        float be[NS], ka[NS];
#pragma unroll
        for (int j = 2; j < NS; ++j) { be[j] = wsum(tb_[j - 1] * tkk[j]); ka[j] = wsum(tkt[j - 1] * tkk[j]); }
#pragma unroll
        for (int j = 2; j < NS; ++j) {
            const int m = m0 + j - 2; const size_t o = (size_t)m * BW + hc; const bool first = (m & (SEQ - 1)) == 0;
            SR[o] = tr[j]; SW[o] = tw[j]; SK[o] = tkt[j]; SB[o] = tb_[j]; SV[o] = tv[j];
            if (!first) SU[o - BW] = tw[j - 1] * tkk[j];
            if ((m & (SEQ - 1)) == SEQ - 1) SU[o] = 0.f;
            if (C.lane < 2) BK[((size_t)m * 12 + h) * 2 + C.lane] = first ? 0.f : (C.lane == 0 ? be[j] : ka[j]);
        }
    }
}

__device__ __forceinline__ void scan_block(const Ctx& C, int sb, unsigned char* ws) {
    const int b = sb / 24, h = (sb % 24) >> 1, half = sb & 1;
    const float* SR = (const float*)(ws + WS_SR); const float* SW = (const float*)(ws + WS_SW); const float* SK = (const float*)(ws + WS_SK); const float* SKK = (const float*)(ws + WS_SKK);
    const float* SB = (const float*)(ws + WS_SB); const float* SV = (const float*)(ws + WS_SV); float* YR = (float*)(ws + WS_YRAW);
    constexpr int T = 64;
    LAS float* Lr = (LAS float*)(C.lds + RING_OFF); LAS float* Lw = Lr + T * 64; LAS float* Lk = Lw + T * 64; LAS float* Lkk = Lk + T * 64; LAS float* Lb = Lkk + T * 64;
    LAS float* Lv = Lb + T * 64; LAS float* Ly = Lv + T * 32;
    const int tid = C.tid, rl = tid >> 4, kq = tid & 15;
    const size_t rowbase = (size_t)b * SEQ; const int colh = h * 64;
    const int lt0 = tid >> 4, lc0 = (tid & 15) * 4, vt = tid >> 3, vc = (tid & 7) * 4;
    f32x4 pr[2], pw[2], pk[2], pkk[2], pb[2], pv;
#define SCAN_LOAD(t0) do { _Pragma("unroll") for (int i = 0; i < 2; ++i) { const size_t o = (rowbase + (t0) + lt0 + 32 * i) * BW + colh + lc0; \
        pr[i] = *(const f32x4*)(SR + o); pw[i] = *(const f32x4*)(SW + o); pk[i] = *(const f32x4*)(SK + o); pkk[i] = *(const f32x4*)(SKK + o); pb[i] = *(const f32x4*)(SB + o); } \
        pv = *(const f32x4*)(SV + (rowbase + (t0) + vt) * BW + colh + 32 * half + vc); } while (0)
    SCAN_LOAD(0);
    float S0 = 0.f, S1 = 0.f, S2 = 0.f, S3 = 0.f;
    for (int ch = 0; ch < SEQ / T; ++ch) {
        const int t0 = ch * T;
#pragma unroll
        for (int i = 0; i < 2; ++i) { const int lo = (lt0 + 32 * i) * 64 + lc0;
            *(LAS f32x4*)(Lr + lo) = pr[i]; *(LAS f32x4*)(Lw + lo) = pw[i]; *(LAS f32x4*)(Lk + lo) = pk[i]; *(LAS f32x4*)(Lkk + lo) = pkk[i]; *(LAS f32x4*)(Lb + lo) = pb[i]; }
        *(LAS f32x4*)(Lv + vt * 32 + vc) = pv;
        __syncthreads();
        if (ch + 1 < SEQ / T) SCAN_LOAD(t0 + T);
#pragma unroll 4
        for (int t = 0; t < T; ++t) {
            const f32x4 kk4 = *(const LAS f32x4*)(Lkk + t * 64 + kq * 4), w4 = *(const LAS f32x4*)(Lw + t * 64 + kq * 4), b4 = *(const LAS f32x4*)(Lb + t * 64 + kq * 4);
            const f32x4 k4 = *(const LAS f32x4*)(Lk + t * 64 + kq * 4), r4 = *(const LAS f32x4*)(Lr + t * 64 + kq * 4); const float v = Lv[t * 32 + rl];
            float d = (S0 * kk4.x + S1 * kk4.y) + (S2 * kk4.z + S3 * kk4.w); d = red16(d); const float sa = -d;
            S0 = S0 * w4.x + (sa * b4.x + v * k4.x); S1 = S1 * w4.y + (sa * b4.y + v * k4.y); S2 = S2 * w4.z + (sa * b4.z + v * k4.z); S3 = S3 * w4.w + (sa * b4.w + v * k4.w);
            float y = (S0 * r4.x + S1 * r4.y) + (S2 * r4.z + S3 * r4.w); y = red16(y);
            if (kq == 0) Ly[t * 32 + rl] = y;
        }
        __syncthreads();
        *(f32x4*)(YR + (rowbase + t0 + vt) * BW + colh + 32 * half + vc) = *(const LAS f32x4*)(Ly + vt * 32 + vc);
    }
#undef SCAN_LOAD
}

__device__ __forceinline__ void glds16(const void* gsrc, unsigned lds_dst) { unsigned keep;
    asm volatile("s_mov_b32 %0, m0\n\ts_mov_b32 m0, %2\n\ts_nop 0\n\tglobal_load_lds_dwordx4 %1, off\n\ts_mov_b32 m0, %0" : "=&s"(keep) : "v"(gsrc), "s"(lds_dst) : "memory"); }
__device__ __forceinline__ void glds4(const void* gsrc, unsigned lds_dst) { unsigned keep;
    asm volatile("s_mov_b32 %0, m0\n\ts_mov_b32 m0, %2\n\ts_nop 0\n\tglobal_load_lds_dword %1, off\n\ts_mov_b32 m0, %0" : "=&s"(keep) : "v"(gsrc), "s"(lds_dst) : "memory"); }
constexpr int SCAN_T = 8, SCAN_SLOT = 5 * SCAN_T * 256 + 512, SCAN_NSLOT = 3, SCAN_RING = SCAN_NSLOT * SCAN_SLOT;
typedef float f32x2 __attribute__((ext_vector_type(2)));
__device__ __forceinline__ void scan_wave(int lane, LAS unsigned char* ring, int hs, int r0, unsigned char* ws) {
    const int b = hs / 12, h = hs % 12;
    const float* SR = (const float*)(ws + WS_SR); const float* SW = (const float*)(ws + WS_SW); const float* SK = (const float*)(ws + WS_SK); const float* SU = (const float*)(ws + WS_SKK);
    const float* SB = (const float*)(ws + WS_SB); const float* SV = (const float*)(ws + WS_SV); const float* BK = (const float*)(ws + WS_BK); float* YR = (float*)(ws + WS_YRAW);
    const int rg = lane >> 4, kq = lane & 15;
    const size_t rowbase = (size_t)b * SEQ; const int colh = h * 64;
    const unsigned ring0 = (unsigned)(size_t)ring;
    const size_t voff = ((size_t)(lane >> 4)) * BW + colh + 4 * kq;
    const size_t vvoff = ((size_t)((lane & 31) >> 2)) * BW + colh + r0 + (lane & 3);
    const size_t bkoff = ((size_t)((lane & 15) >> 1) * 12 + h) * 2 + (lane & 1);
    constexpr int NCH = SEQ / SCAN_T;
#define SCAN_DMA(ch, slot) do { const int cc_ = (ch) < NCH ? (ch) : NCH - 1; const size_t tok_ = rowbase + (size_t)cc_ * SCAN_T; const unsigned sl_ = ring0 + (unsigned)(slot) * SCAN_SLOT; \
        _Pragma("unroll") for (int i_ = 0; i_ < 2; ++i_) { const size_t o_ = (tok_ + 4 * i_) * BW + voff; \
            glds16(SU + o_, sl_ + 0 * 2048 + i_ * 1024); glds16(SW + o_, sl_ + 1 * 2048 + i_ * 1024); glds16(SB + o_, sl_ + 2 * 2048 + i_ * 1024); glds16(SK + o_, sl_ + 3 * 2048 + i_ * 1024); glds16(SR + o_, sl_ + 4 * 2048 + i_ * 1024); } \
        glds4(SV + tok_ * BW + vvoff, sl_ + 10240); glds4(BK + tok_ * 24 + bkoff, sl_ + 10496); } while (0)
    SCAN_DMA(0, 0); SCAN_DMA(1, 1); SCAN_DMA(2, 2);
    f32x2 S01 = (f32x2){0.f, 0.f}, S23 = (f32x2){0.f, 0.f};
    float e_cur = 0.f, sa_prev = 0.f, v_prev = 0.f;
    int slot = 0;
    for (int ch = 0; ch < NCH; ++ch) {
        asm volatile("s_waitcnt vmcnt(24)" ::: "memory");
        const LAS unsigned char* sp = ring + slot * SCAN_SLOT;
        float ykeep = 0.f;
        f32x4 u4a[SCAN_T], w4a[SCAN_T], b4a[SCAN_T], k4a[SCAN_T], r4a[SCAN_T]; float va[SCAN_T]; f32x2 bka[SCAN_T];
#pragma unroll
        for (int tt = 0; tt < SCAN_T; ++tt) {
            u4a[tt] = *(const LAS f32x4*)(sp + 0 * 2048 + tt * 256 + kq * 16); bka[tt] = *(const LAS f32x2*)(sp + 10496 + tt * 8); va[tt] = *(const LAS float*)(sp + 10240 + tt * 16 + rg * 4);
            w4a[tt] = *(const LAS f32x4*)(sp + 1 * 2048 + tt * 256 + kq * 16); b4a[tt] = *(const LAS f32x4*)(sp + 2 * 2048 + tt * 256 + kq * 16);
            k4a[tt] = *(const LAS f32x4*)(sp + 3 * 2048 + tt * 256 + kq * 16); r4a[tt] = *(const LAS f32x4*)(sp + 4 * 2048 + tt * 256 + kq * 16); }
#pragma unroll
        for (int tt = 0; tt < SCAN_T; ++tt) {
            const f32x4 u4 = u4a[tt], w4 = w4a[tt], b4 = b4a[tt], k4 = k4a[tt], r4 = r4a[tt]; const float v = va[tt]; const f32x2 bk = bka[tt];
            f32x2 pe = S01 * (f32x2){u4.x, u4.y}; pe = S23 * (f32x2){u4.z, u4.w} + pe; const float e_next = red16(pe.x + pe.y);
            const float d = e_cur + sa_prev * bk.x + v_prev * bk.y; const float sa = -d;
            const f32x2 sav = (f32x2){sa, sa}, vv = (f32x2){v, v};
            S01 = S01 * (f32x2){w4.x, w4.y} + (sav * (f32x2){b4.x, b4.y} + vv * (f32x2){k4.x, k4.y});
            S23 = S23 * (f32x2){w4.z, w4.w} + (sav * (f32x2){b4.z, b4.w} + vv * (f32x2){k4.z, k4.w});
            f32x2 py = S01 * (f32x2){r4.x, r4.y}; py = S23 * (f32x2){r4.z, r4.w} + py; const float y = red16(py.x + py.y);
            ykeep = (kq == tt) ? y : ykeep;
            e_cur = e_next; sa_prev = sa; v_prev = v;
        }
        if (kq < SCAN_T) YR[(rowbase + (size_t)ch * SCAN_T + kq) * BW + colh + r0 + rg] = ykeep;
        SCAN_DMA(ch + 3, slot);
        slot = (slot == SCAN_NSLOT - 1) ? 0 : slot + 1;
    }
    asm volatile("s_waitcnt vmcnt(0)" ::: "memory");
#undef SCAN_DMA
}

struct AttnPass { int qcol; int bias_head; int tbl; float sink; int use_sink; int maxsteps; bf16* out; int out_ld; int out_col; float* lse; };
__device__ __forceinline__ void attn_stage_kv(const Ctx& C, const bf16* P1, int b, int res, int dil, int fblk, int kcol, int vcol) {
    LAS unsigned char* Ks = C.lds + RING_OFF; LAS unsigned char* Vs = Ks + 256 * 144;
#pragma unroll
    for (int i = 0; i < 4; ++i) { const int c = C.tid + 512 * i, row = c >> 3, part = c & 7; const int fp = (fblk - 1) * 128 + row;
        v4u kv = (v4u){0u, 0u, 0u, 0u}, vv = (v4u){0u, 0u, 0u, 0u};
        if (fp >= 0) { const bf16* src = P1 + ((size_t)b * SEQ + (size_t)fp * dil + res) * NP1; kv = *(const v4u*)(src + kcol + part * 8); vv = *(const v4u*)(src + vcol + part * 8); }
        *(LAS v4u*)(Ks + row * 144 + part * 16) = kv; *(LAS v4u*)(Vs + row * 144 + part * 16) = vv; }
}
__device__ __forceinline__ void attn_pass(const Ctx& C, const bf16* P1, const float* relb, int b, int res, int dil, int fblk, const AttnPass& ap) {
    LAS unsigned char* Ks = C.lds + RING_OFF; LAS unsigned char* Vs = Ks + 256 * 144; LAS float* lut = (LAS float*)(Vs + 256 * 144);
    __syncthreads();
    if (C.tid < 132) lut[C.tid] = (C.tid <= 128) ? relb[(int)T5B[ap.tbl][C.tid] * 20 + ap.bias_head] : 0.f;
    __syncthreads();
    const int i = C.tid >> 2, dq = C.tid & 3;
    const size_t tok = (size_t)b * SEQ + (size_t)(fblk * 128 + i) * dil + res;
    float q[16];
    { const bf16* qp = P1 + tok * NP1 + ap.qcol + dq * 16; const v4u a0 = *(const v4u*)qp, a1 = *(const v4u*)(qp + 8);
      q[0] = bflo(a0.x); q[1] = bfhi(a0.x); q[2] = bflo(a0.y); q[3] = bfhi(a0.y); q[4] = bflo(a0.z); q[5] = bfhi(a0.z); q[6] = bflo(a0.w); q[7] = bfhi(a0.w);
      q[8] = bflo(a1.x); q[9] = bfhi(a1.x); q[10] = bflo(a1.y); q[11] = bfhi(a1.y); q[12] = bflo(a1.z); q[13] = bfhi(a1.z); q[14] = bflo(a1.w); q[15] = bfhi(a1.w);
#pragma unroll
      for (int j = 0; j < 16; ++j) q[j] *= 0.125f; }
    float mrun = ap.use_sink ? ap.sink : -INFINITY, lrun = ap.use_sink ? 1.0f : 0.0f;
    float o[16];
#pragma unroll
    for (int j = 0; j < 16; ++j) o[j] = 0.f;
    const int fq0 = fblk * 128 + i;
    for (int dist = 0; dist <= ap.maxsteps; ++dist) {
        const int kr = i + 128 - dist;
        const bool valid = (fq0 - dist) >= 0;
        const v4u k0 = *(const LAS v4u*)(Ks + kr * 144 + dq * 32), k1 = *(const LAS v4u*)(Ks + kr * 144 + dq * 32 + 16);
        float s = q[0] * bflo(k0.x) + q[1] * bfhi(k0.x) + q[2] * bflo(k0.y) + q[3] * bfhi(k0.y) + q[4] * bflo(k0.z) + q[5] * bfhi(k0.z) + q[6] * bflo(k0.w) + q[7] * bfhi(k0.w)
                + q[8] * bflo(k1.x) + q[9] * bfhi(k1.x) + q[10] * bflo(k1.y) + q[11] * bfhi(k1.y) + q[12] * bflo(k1.z) + q[13] * bfhi(k1.z) + q[14] * bflo(k1.w) + q[15] * bfhi(k1.w);
        s = red4(s) + lut[dist];
        if (valid) {
            if (s > mrun) { const float c = __expf(mrun - s); lrun *= c;
#pragma unroll
                for (int j = 0; j < 16; ++j) o[j] *= c;
                mrun = s; }
            const float p = __expf(s - mrun); lrun += p;
            const v4u v0 = *(const LAS v4u*)(Vs + kr * 144 + dq * 32), v1 = *(const LAS v4u*)(Vs + kr * 144 + dq * 32 + 16);
            o[0] += p * bflo(v0.x); o[1] += p * bfhi(v0.x); o[2] += p * bflo(v0.y); o[3] += p * bfhi(v0.y); o[4] += p * bflo(v0.z); o[5] += p * bfhi(v0.z); o[6] += p * bflo(v0.w); o[7] += p * bfhi(v0.w);
            o[8] += p * bflo(v1.x); o[9] += p * bfhi(v1.x); o[10] += p * bflo(v1.y); o[11] += p * bfhi(v1.y); o[12] += p * bflo(v1.z); o[13] += p * bfhi(v1.z); o[14] += p * bflo(v1.w); o[15] += p * bfhi(v1.w);
        }
    }
    const float inv = 1.0f / lrun;
    v4u w0, w1;
    w0.x = pk2(o[0] * inv, o[1] * inv); w0.y = pk2(o[2] * inv, o[3] * inv); w0.z = pk2(o[4] * inv, o[5] * inv); w0.w = pk2(o[6] * inv, o[7] * inv);
    w1.x = pk2(o[8] * inv, o[9] * inv); w1.y = pk2(o[10] * inv, o[11] * inv); w1.z = pk2(o[12] * inv, o[13] * inv); w1.w = pk2(o[14] * inv, o[15] * inv);
    bf16* op = ap.out + tok * ap.out_ld + ap.out_col + dq * 16;
    *(v4u*)op = w0; *(v4u*)(op + 8) = w1;
    if (ap.lse && dq == 0) ap.lse[tok * 4] = mrun + __logf(lrun);
}
__device__ __forceinline__ void phase_attn(const Ctx& C, const Args& a, int l, unsigned char* ws, int ab, int nab) {
    const bf16* P1 = (const bf16*)(ws + WS_P1); const float* relb = a.in[1]; const float* sinks = a.in[4] + l * 8;
    bf16* YA = (bf16*)(ws + WS_YA); bf16* OC = (bf16*)(ws + WS_OC); float* LSE = (float*)(ws + WS_LSE);
    constexpr int NA = 256, NC = 1536;
    for (int it = ab; it < NA + NC; it += nab) {
        __syncthreads();
        if (it < NA) {
            const int b = it >> 7, fblk = (it >> 1) & 63, hkv = it & 1;
            attn_stage_kv(C, P1, b, 0, 1, fblk, C_AK + hkv * 64, C_AV + hkv * 64);
            for (int g = 0; g < 4; ++g) { const int hq = hkv * 4 + g;
                AttnPass ap; ap.qcol = C_AQ + hq * 64; ap.bias_head = hq; ap.tbl = 0; ap.sink = sinks[hq]; ap.use_sink = 1; ap.maxsteps = 127; ap.out = YA; ap.out_ld = 512; ap.out_col = hq * 64; ap.lse = nullptr;
                attn_pass(C, P1, relb, b, 0, 1, fblk, ap); }
        } else {
            const int ci = it - NA; const int gi = ci / 512, j = (ci >> 7) & 3, qb = ci & 127;
            const int dil = (gi == 0) ? 1 : (gi == 1 ? 4 : 16); const int bps = 64 / dil;
            const int n = qb / bps, fblk = qb % bps, b = n / dil, res = n % dil; const int hc = gi * 4 + j;
            attn_stage_kv(C, P1, b, res, dil, fblk, C_CK + hc * 64, C_CV + hc * 64);
            AttnPass ap; ap.qcol = C_CQ + hc * 64; ap.bias_head = 8 + hc; ap.tbl = gi; ap.sink = 0.f; ap.use_sink = 0; ap.maxsteps = 128; ap.out = OC + (size_t)gi * M * 256; ap.out_ld = 256; ap.out_col = j * 64;
            ap.lse = LSE + (size_t)gi * M * 4 + j;
            attn_pass(C, P1, relb, b, res, dil, fblk, ap);
        }
    }
}

__device__ __forceinline__ void phase_vt(const Ctx& C, unsigned char* ws) {
    const bf16* P1 = (const bf16*)(ws + WS_P1); bf16* VT = (bf16*)(ws + WS_VT);
    for (int it = C.gw; it < 14 * 2 * 128; it += C.ngw) {
        const int hs = it / 256, b = (it >> 7) & 1, blk = it & 127;
        const int gi = hs < 2 ? 0 : (hs - 2) >> 2; const int dil = gi == 0 ? 1 : (gi == 1 ? 4 : 16); const int Lf = SEQ / dil;
        const int vcol = hs < 2 ? C_AV + hs * 64 : C_CV + (hs - 2) * 64;
        const int ft = blk * 64 + C.lane;
        const int res = ft / Lf, tp = ft % Lf; const int tok = b * SEQ + tp * dil + res;
        const v4u* src = (const v4u*)(P1 + (size_t)tok * NP1 + vcol);
        v4u x[8];
#pragma unroll
        for (int i = 0; i < 8; ++i) x[i] = src[i];
        bf16* dst = VT + ((size_t)(hs * 2 + b) * 64) * SEQ + ft;
#pragma unroll
        for (int i = 0; i < 8; ++i) {
            dst[(size_t)(8 * i + 0) * SEQ] = (bf16)(x[i].x & 0xffffu); dst[(size_t)(8 * i + 1) * SEQ] = (bf16)(x[i].x >> 16);
            dst[(size_t)(8 * i + 2) * SEQ] = (bf16)(x[i].y & 0xffffu); dst[(size_t)(8 * i + 3) * SEQ] = (bf16)(x[i].y >> 16);
            dst[(size_t)(8 * i + 4) * SEQ] = (bf16)(x[i].z & 0xffffu); dst[(size_t)(8 * i + 5) * SEQ] = (bf16)(x[i].z >> 16);
            dst[(size_t)(8 * i + 6) * SEQ] = (bf16)(x[i].w & 0xffffu); dst[(size_t)(8 * i + 7) * SEQ] = (bf16)(x[i].w >> 16);
        }
    }
}

typedef float f32x16 __attribute__((ext_vector_type(16)));
constexpr int LUT_OFF = 0, SCANRING_OFF = 12288, CONV_SCR_SCAN = 77824, CONV_SCR_OTHER = 12288;
__device__ __forceinline__ void attn_wave_item(int lane, const LAS float* lutall, int item, const float* sinks, unsigned char* ws) {
    const bf16* P1 = (const bf16*)(ws + WS_P1); const bf16* VT = (const bf16*)(ws + WS_VT);
    const int hh = item % 20, g32 = item / 20;
    const bool isA = hh < 8; const int hc = hh - 8; const int gi = isA ? 0 : hc >> 2, j = hc & 3;
    const int dil = gi == 0 ? 1 : (gi == 1 ? 4 : 16); const int Lf = SEQ / dil, gps = Lf / 32;
    const int b = g32 >> 8, rr = g32 & 255, res = rr / gps, qg = rr % gps, fq0 = qg * 32;
    const int qcol = isA ? C_AQ + hh * 64 : C_CQ + hc * 64, kcol = isA ? C_AK + (hh >> 2) * 64 : C_CK + hc * 64;
    const int hs = isA ? (hh >> 2) : 2 + hc; const int maxsteps = isA ? 127 : 128;
    const LAS float* lut = lutall + hh * 132;
    const int r = lane & 31, hf = lane >> 5;
    const size_t tokq = (size_t)b * SEQ + (size_t)(fq0 + r) * dil + res;
    pg8::bf16x8 qf[4];
    { const bf16* qrow = P1 + tokq * NP1 + qcol + 8 * hf;
#pragma unroll
      for (int s_ = 0; s_ < 4; ++s_) qf[s_] = *(const pg8::bf16x8*)(qrow + 16 * s_); }
    f32x16 sc[5];
#pragma unroll
    for (int kt = 0; kt < 5; ++kt) {
        int fk = fq0 - 128 + 32 * kt + r; fk = fk < 0 ? 0 : fk;
        const bf16* krow = P1 + ((size_t)b * SEQ + (size_t)fk * dil + res) * NP1 + kcol + 8 * hf;
        f32x16 acc;
#pragma unroll
        for (int q = 0; q < 16; ++q) acc[q] = 0.f;
#pragma unroll
        for (int s_ = 0; s_ < 4; ++s_) { const pg8::bf16x8 a = *(const pg8::bf16x8*)(krow + 16 * s_); acc = __builtin_amdgcn_mfma_f32_32x32x16_bf16(a, qf[s_], acc, 0, 0, 0); }
        sc[kt] = acc;
    }
    float mx = -1e30f;
#pragma unroll
    for (int kt = 0; kt < 5; ++kt)
#pragma unroll
        for (int q = 0; q < 16; ++q) {
            const int rowoff = (q & 3) + 8 * (q >> 2) + 4 * hf; const int dist = 128 + r - 32 * kt - rowoff; const int fk = fq0 + r - dist;
            const bool valid = dist >= 0 && dist <= maxsteps && fk >= 0;
            const int di = dist < 0 ? 0 : (dist > 128 ? 128 : dist);
            const float sv = valid ? sc[kt][q] * 0.125f + lut[di] : -1e30f;
            sc[kt][q] = sv; mx = fmaxf(mx, sv);
        }
    mx = fmaxf(mx, __shfl_xor(mx, 32));
    const float sink = isA ? sinks[hh] : -1e30f;
    mx = fmaxf(mx, sink);
    float lsum = 0.f;
#pragma unroll
    for (int kt = 0; kt < 5; ++kt)
#pragma unroll
        for (int q = 0; q < 16; ++q) { const float pv = __expf(sc[kt][q] - mx); sc[kt][q] = pv; lsum += pv; }
    lsum += __shfl_xor(lsum, 32);
    const float denom = isA ? lsum + __expf(sink - mx) : lsum;
    const float inv = 1.0f / denom;
    pg8::bf16x8 pf[5][2];
#pragma unroll
    for (int kt = 0; kt < 5; ++kt)
#pragma unroll
        for (int s_ = 0; s_ < 2; ++s_) { pg8::u32x4 w;
            w.x = pg8::cvt_pk_bf16(sc[kt][8 * s_ + 0], sc[kt][8 * s_ + 1]); w.y = pg8::cvt_pk_bf16(sc[kt][8 * s_ + 2], sc[kt][8 * s_ + 3]);
            w.z = pg8::cvt_pk_bf16(sc[kt][8 * s_ + 4], sc[kt][8 * s_ + 5]); w.w = pg8::cvt_pk_bf16(sc[kt][8 * s_ + 6], sc[kt][8 * s_ + 7]);
            pf[kt][s_] = __builtin_bit_cast(pg8::bf16x8, w); }
    bf16* outp; int out_ld, ocol;
    if (isA) { outp = (bf16*)(ws + WS_YA); out_ld = 512; ocol = hh * 64; } else { outp = (bf16*)(ws + WS_OC) + (size_t)gi * M * 256; out_ld = 256; ocol = j * 64; }
    const bf16* vth = VT + ((size_t)(hs * 2 + b) * 64) * SEQ + (size_t)res * Lf;
#pragma unroll
    for (int dt = 0; dt < 2; ++dt) {
        const bf16* vrow = vth + (size_t)(32 * dt + r) * SEQ;
        f32x16 acc;
#pragma unroll
        for (int q = 0; q < 16; ++q) acc[q] = 0.f;
#pragma unroll
        for (int kt = 0; kt < 5; ++kt)
#pragma unroll
            for (int s_ = 0; s_ < 2; ++s_) {
                int k0 = fq0 - 128 + 32 * kt + 16 * s_ + 4 * hf, k1 = k0 + 8; k0 = k0 < 0 ? 0 : k0; k1 = k1 < 0 ? 0 : k1;
                const v2u lo = *(const v2u*)(vrow + k0), hi = *(const v2u*)(vrow + k1);
                pg8::u32x4 w; w.x = lo.x; w.y = lo.y; w.z = hi.x; w.w = hi.y;
                acc = __builtin_amdgcn_mfma_f32_32x32x16_bf16(__builtin_bit_cast(pg8::bf16x8, w), pf[kt][s_], acc, 0, 0, 0);
            }
        bf16* op = outp + tokq * out_ld + ocol + 32 * dt + 4 * hf;
#pragma unroll
        for (int g = 0; g < 4; ++g) { v2u w; w.x = pg8::cvt_pk_bf16(acc[4 * g + 0] * inv, acc[4 * g + 1] * inv); w.y = pg8::cvt_pk_bf16(acc[4 * g + 2] * inv, acc[4 * g + 3] * inv);
            *(v2u*)(op + 8 * g) = w; }
    }
    if (!isA && hf == 0) ((float*)(ws + WS_LSE))[((size_t)gi * M + tokq) * 4 + j] = mx + __logf(lsum);
}
__device__ __forceinline__ void build_lut(const Ctx& C, const float* relb) {
    LAS float* lut = (LAS float*)(C.lds + LUT_OFF);
    for (int i = C.tid; i < 20 * 132; i += NTHREADS) { const int hh = i / 132, d = i % 132; const int tbl = hh < 8 ? 0 : (hh - 8) >> 2;
        lut[i] = (d <= 128) ? relb[(int)T5B[tbl][d] * 20 + hh] : 0.f; }
    __syncthreads();
}

__device__ __forceinline__ void phase_post(const Ctx& C, const Args& a, int l, unsigned char* ws) {
    const float* YR = (const float*)(ws + WS_YRAW); const float* SR = (const float*)(ws + WS_SR); const float* SK = (const float*)(ws + WS_SK); const float* SV = (const float*)(ws + WS_SV);
    const float* LO = (const float*)(ws + WS_LO); bf16* YB = (bf16*)(ws + WS_YB);
    const float* rkp = a.in[13] + (size_t)l * BW; const float* lgp = a.in[14] + (size_t)l * BW; const float* lbp = a.in[15] + (size_t)l * BW;
    constexpr int TB = 8;
    for (int it = C.gw; it < (M / TB) * 12; it += C.ngw) {
        const int tb = it / 12, h = it % 12, hc = h * 64 + C.lane, m0 = tb * TB;
        const float rk = rkp[hc], lg = lgp[hc], lb = lbp[hc];
        float y[TB], bo[TB], vv[TB], gg[TB];
#pragma unroll
        for (int i = 0; i < TB; ++i) { const size_t o = (size_t)(m0 + i) * BW + hc; y[i] = YR[o]; bo[i] = SR[o] * SK[o] * rk; vv[i] = SV[o]; gg[i] = LO[(size_t)(m0 + i) * NLORA + 2 * BW + hc]; }
        float mean[TB], var[TB];
#pragma unroll
        for (int i = 0; i < TB; ++i) { mean[i] = wsum(y[i]) * (1.0f / 64.0f); bo[i] = wsum(bo[i]); }
#pragma unroll
        for (int i = 0; i < TB; ++i) { y[i] -= mean[i]; var[i] = wsum(y[i] * y[i]) * (1.0f / 64.0f); }
#pragma unroll
        for (int i = 0; i < TB; ++i) { float yn = y[i] * (1.0f / sqrtf(var[i] + GN_EPS)) * lg + lb; yn += bo[i] * vv[i]; yn *= gg[i]; YB[(size_t)(m0 + i) * BW + hc] = (bf16)f2bf(yn); }
    }
    const bf16* OC = (const bf16*)(ws + WS_OC); const float* LSE = (const float*)(ws + WS_LSE); bf16* YC = (bf16*)(ws + WS_YC);
    for (int mb = C.gw * 4; mb < M; mb += C.ngw * 4) {
        const int j = C.lane >> 4;
        float l0[4], l1[4], l2[4]; v2u a0[4], a1[4], a2[4];
#pragma unroll
        for (int i = 0; i < 4; ++i) { const int m = mb + i; l0[i] = LSE[(size_t)m * 4 + j]; l1[i] = LSE[((size_t)M + m) * 4 + j]; l2[i] = LSE[((size_t)2 * M + m) * 4 + j];
            a0[i] = *(const v2u*)(OC + (size_t)m * 256 + 4 * C.lane); a1[i] = *(const v2u*)(OC + ((size_t)M + m) * 256 + 4 * C.lane); a2[i] = *(const v2u*)(OC + ((size_t)2 * M + m) * 256 + 4 * C.lane); }
#pragma unroll
        for (int i = 0; i < 4; ++i) { const int m = mb + i;
            const float mx = fmaxf(l0[i], fmaxf(l1[i], l2[i])); const float e0 = __expf(l0[i] - mx), e1 = __expf(l1[i] - mx), e2 = __expf(l2[i] - mx); const float inv = 1.0f / (e0 + e1 + e2);
            const float w0 = e0 * inv, w1 = e1 * inv, w2 = e2 * inv;
            v2u o; o.x = pk2(w0 * bflo(a0[i].x) + w1 * bflo(a1[i].x) + w2 * bflo(a2[i].x), w0 * bfhi(a0[i].x) + w1 * bfhi(a1[i].x) + w2 * bfhi(a2[i].x));
            o.y = pk2(w0 * bflo(a0[i].y) + w1 * bflo(a1[i].y) + w2 * bflo(a2[i].y), w0 * bfhi(a0[i].y) + w1 * bfhi(a1[i].y) + w2 * bfhi(a2[i].y));
            *(v2u*)(YC + (size_t)m * 256 + 4 * C.lane) = o; }
    }
}

__device__ __forceinline__ void unpack8(const v4u w, float (&x)[8]) { x[0] = bflo(w.x); x[1] = bfhi(w.x); x[2] = bflo(w.y); x[3] = bfhi(w.y); x[4] = bflo(w.z); x[5] = bfhi(w.z); x[6] = bflo(w.w); x[7] = bfhi(w.w); }
__device__ __forceinline__ void phase_conv(const Ctx& C, const Args& a, int l, unsigned char* ws) {
    const bf16* U = (const bf16*)(ws + WS_U); bf16* ACT = (bf16*)(ws + WS_ACT); const float* cw = a.in[22] + (size_t)l * 3 * DFF;
    constexpr int GPR = DFF / 8, RUN = 32;
    const int gt = C.bid * NTHREADS + C.tid, ngt = C.G * NTHREADS;
    for (int idx = gt; idx < (M / RUN) * GPR; idx += ngt) {
        const int run = idx / GPR, f0 = (idx % GPR) * 8, m0 = run * RUN;
        float c0[8], c1[8], c2[8];
#pragma unroll
        for (int j = 0; j < 8; ++j) { c0[j] = cw[f0 + j]; c1[j] = cw[DFF + f0 + j]; c2[j] = cw[2 * DFF + f0 + j]; }
        const bf16* ur = U + (size_t)m0 * NUP + f0;
        float x0[8], x1[8];
        { v4u g0 = (v4u){0u, 0u, 0u, 0u}, g1 = (v4u){0u, 0u, 0u, 0u};
          if ((m0 & (SEQ - 1)) != 0) { g0 = *(const v4u*)(ur - 2 * NUP); g1 = *(const v4u*)(ur - NUP); }
          unpack8(g0, x0); unpack8(g1, x1); }
#pragma unroll 1
        for (int tq = 0; tq < RUN; tq += 4) {
            v4u gq[4], vq[4];
#pragma unroll
            for (int i = 0; i < 4; ++i) { gq[i] = *(const v4u*)(ur + (size_t)(tq + i) * NUP); vq[i] = *(const v4u*)(ur + (size_t)(tq + i) * NUP + DFF); }
#pragma unroll
            for (int i = 0; i < 4; ++i) {
                float x2[8], vl[8], r[8]; unpack8(gq[i], x2); unpack8(vq[i], vl);
#pragma unroll
                for (int j = 0; j < 8; ++j) { const float gsum = c0[j] * x0[j] + c1[j] * x1[j] + c2[j] * x2[j]; r[j] = gsum / (1.0f + __expf(-gsum)) * vl[j]; x0[j] = x1[j]; x1[j] = x2[j]; }
                v4u o; o.x = pk2(r[0], r[1]); o.y = pk2(r[2], r[3]); o.z = pk2(r[4], r[5]); o.w = pk2(r[6], r[7]);
                *(v4u*)(ACT + (size_t)(m0 + tq + i) * DFF + f0) = o;
            }
        }
    }
}

__device__ __forceinline__ Ctx make_ctx(unsigned char* lds) {
    Ctx C;
    C.lds = (LAS unsigned char*)lds;
    int t = threadIdx.x; asm volatile("" : "+v"(t));
    C.tid = t; C.lane = C.tid & 63; C.wave = __builtin_amdgcn_readfirstlane(C.tid >> 6);
    C.G = gridDim.x; C.bid = blockIdx.x; C.gw = C.bid * NWAVES + C.wave; C.ngw = C.G * NWAVES;
    return C;
}
template <int K> __device__ __forceinline__ void run_phase(unsigned char* lds, const Args& args, int l) {
    const Ctx C = make_ctx(lds);
    unsigned char* ws = args.ws; asm volatile("" : "+s"(ws)); unsigned char* wsw = ws + (size_t)(l & 1) * WSET_STRIDE; LAS unsigned char* ring = C.lds + RING_OFF; float* out = args.out;
    const float* xsrc = (l == 0) ? args.in[0] : out;
    if constexpr (K == 0) { phase_prep(C, args, l, xsrc, ws); }
    if constexpr (K == 1) { pg8::Gemm g{(const bf16*)(ws + WS_H), (const bf16*)(wsw + WS_WIN), M, NWIN, D}; pg8::StaticOrder S; S.init(M, NWIN, C.G, C.bid);
        pg8::EpiWin E{(bf16*)(ws + WS_P1), (bf16*)(ws + WS_G)};
        pg8::gemm_phase<pg8::EpiWin, pg8::StaticOrder, true, true>(ring, g, S, E); }
    if constexpr (K == 2) { phase_aprime(C, args, l, ws); phase_vt(C, ws); }
    if constexpr (K == 3) { pg8::Gemm g{(const bf16*)(ws + WS_AP), (const bf16*)(wsw + WS_WLORA), M, NLORA, KLORA}; pg8::StaticOrder S; S.init(M, NLORA, C.G, C.bid);
        pg8::EpiF32P E{(float*)(ws + WS_LO), NLORA};
        pg8::gemm_phase<pg8::EpiF32P, pg8::StaticOrder, true, true>(ring, g, S, E); }
    if constexpr (K == 4) { phase_scanprep(C, args, l, ws); }
    if constexpr (K == 5) {
        build_lut(C, args.in[1]);
        const int xg = C.bid & 7, jj = C.bid >> 3; const bool scanwg = jj < 24;
        if (scanwg && C.wave < 2) { for (int rep = 0; rep < EXP_SCAN_REPS; ++rep) scan_wave(C.lane, C.lds + SCANRING_OFF + C.wave * SCAN_RING, xg * 3 + (jj >> 3), ((jj & 7) * 2 + C.wave) * 4, ws); }
        else { const int aw = scanwg ? (jj * 8 + xg) * 6 + (C.wave - 2) : 1152 + ((jj - 24) * 8 + xg) * 8 + C.wave; const float* sinks = args.in[4] + l * 8;
            for (int rep = 0; rep < EXP_ATTN_REPS; ++rep) for (int it = aw; it < 512 * 20; it += 1664) attn_wave_item(C.lane, (const LAS float*)(C.lds + LUT_OFF), it, sinks, ws);
            if (l + 1 < DEPTH) convert_weights(aw, 1664, C.lane, (LAS float*)(C.lds + (scanwg ? CONV_SCR_SCAN + (C.wave - 2) * 8448 : CONV_SCR_OTHER + C.wave * 8448)), args, l + 1, ws); } }
    if constexpr (K == 6) { phase_post(C, args, l, ws); }
    if constexpr (K == 7) {
        { pg8::Gemm g{(const bf16*)(ws + WS_YA), (const bf16*)(wsw + WS_PA), M, D, 512}; pg8::StaticOrder S; S.init(M, D, C.G, C.bid);
          pg8::EpiGate<false> E{(const bf16*)(ws + WS_G), 0, (bf16*)(ws + WS_MG)};
          pg8::gemm_phase<pg8::EpiGate<false>, pg8::StaticOrder, true, true>(ring, g, S, E); }
        { pg8::Gemm g{(const bf16*)(ws + WS_YB), (const bf16*)(wsw + WS_PB), M, D, 768}; pg8::StaticOrder S; S.init(M, D, C.G, C.bid);
          pg8::EpiGate<true> E{(const bf16*)(ws + WS_G), 2048, (bf16*)(ws + WS_MG)};
          pg8::gemm_phase<pg8::EpiGate<true>, pg8::StaticOrder, true, true>(ring, g, S, E); }
        { pg8::Gemm g{(const bf16*)(ws + WS_YC), (const bf16*)(wsw + WS_PC), M, D, 256}; pg8::StaticOrder S; S.init(M, D, C.G, C.bid);
          pg8::EpiGate<true> E{(const bf16*)(ws + WS_G), 4096, (bf16*)(ws + WS_MG)};
          pg8::gemm_phase<pg8::EpiGate<true>, pg8::StaticOrder, true, true>(ring, g, S, E); } }
    if constexpr (K == 8) { pg8::Gemm g{(const bf16*)(ws + WS_MG), (const bf16*)(wsw + WS_WOUT), M, D, D}; pg8::StaticOrder S; S.init(M, D, C.G, C.bid);
        pg8::EpiResid E{xsrc, out};
        pg8::gemm_phase<pg8::EpiResid, pg8::StaticOrder, true, true>(ring, g, S, E); }
    if constexpr (K == 9) { const float* g2 = args.in[20] + (size_t)l * D; bf16* H = (bf16*)(ws + WS_H);
        for (int m = 2 * C.gw; m < M; m += 2 * C.ngw) rms_row2_bf16(out + (size_t)m * D, g2, H + (size_t)m * D, C.lane); }
    if constexpr (K == 10) { pg8::Gemm g{(const bf16*)(ws + WS_H), (const bf16*)(wsw + WS_WUP), M, NUP, D}; pg8::StaticOrder S; S.init(M, NUP, C.G, C.bid);
        pg8::EpiBf16P E{(bf16*)(ws + WS_U), NUP};
        pg8::gemm_phase<pg8::EpiBf16P, pg8::StaticOrder, true, true>(ring, g, S, E); }
    if constexpr (K == 11) { phase_conv(C, args, l, ws); }
    if constexpr (K == 12) { pg8::Gemm g{(const bf16*)(ws + WS_ACT), (const bf16*)(wsw + WS_WDOWN), M, D, DFF}; pg8::StaticOrder S; S.init(M, D, C.G, C.bid);
        pg8::EpiResid E{out, out};
        pg8::gemm_phase<pg8::EpiResid, pg8::StaticOrder, true, true>(ring, g, S, E); }
    if constexpr (K == 13) { const float* gf = args.in[24];
        for (int m = C.gw; m < M; m += C.ngw) rms_row_f32(out + (size_t)m * D, gf, C.lane); }
}
template <int K> __global__ void __launch_bounds__(NTHREADS, 2) fwd_phase(Args args) {
    extern __shared__ __attribute__((aligned(16))) unsigned char lds[];
    run_phase<K>(lds, args, args.li);
}
#ifndef EXP_BAR_REPS
#define EXP_BAR_REPS 1
#endif
#define XBAR(b) do { for (int r_ = 0; r_ < EXP_BAR_REPS; ++r_) xcd_barrier(b); } while (0)
__global__ void __launch_bounds__(NTHREADS, 2) fwd_all(Args args) {
    extern __shared__ __attribute__((aligned(16))) unsigned char lds[];
    { LAS unsigned* ctlw = (LAS unsigned*)((LAS unsigned char*)lds + LDSCTL_OFF); for (int u = threadIdx.x; u < (LDS_BYTES - LDSCTL_OFF) / 4; u += NTHREADS) ctlw[u] = 0u; }
    __syncthreads();
    const XcdBarrier bar = xcd_barrier_post((unsigned*)(args.ws + WS_CTL) + CW_BAR, (volatile LAS unsigned*)((LAS unsigned char*)lds + MISC_OFF) + 8);
    for (int l = 0; l < DEPTH; ++l) {
        for (int rep = 0; rep < (((EXP_EW_MASK >> 0) & 1) ? 2 : 1); ++rep) { run_phase<0>(lds, args, l); XBAR(bar); }
        for (int rep = 0; rep < EXP_G1_REPS; ++rep) { run_phase<1>(lds, args, l); XBAR(bar); }
        for (int rep = 0; rep < (((EXP_EW_MASK >> 2) & 1) ? 2 : 1); ++rep) { run_phase<2>(lds, args, l); XBAR(bar); }
        run_phase<3>(lds, args, l); XBAR(bar);
        for (int rep = 0; rep < (((EXP_EW_MASK >> 4) & 1) ? 2 : 1); ++rep) { run_phase<4>(lds, args, l); XBAR(bar); }
        run_phase<5>(lds, args, l); XBAR(bar);
        for (int rep = 0; rep < (((EXP_EW_MASK >> 6) & 1) ? 2 : 1); ++rep) { run_phase<6>(lds, args, l); XBAR(bar); }
        run_phase<7>(lds, args, l); XBAR(bar);
        run_phase<8>(lds, args, l); XBAR(bar);
        for (int rep = 0; rep < (((EXP_EW_MASK >> 9) & 1) ? 2 : 1); ++rep) { run_phase<9>(lds, args, l); XBAR(bar); }
        run_phase<10>(lds, args, l); XBAR(bar);
        for (int rep = 0; rep < (((EXP_EW_MASK >> 11) & 1) ? 2 : 1); ++rep) { run_phase<11>(lds, args, l); XBAR(bar); }
        run_phase<12>(lds, args, l); XBAR(bar);
    }
    run_phase<13>(lds, args, 0);
}

#ifndef MK_ONE_LAUNCH
#define MK_ONE_LAUNCH 1
#endif
template <int K> static void launch_phase(int grid, hipStream_t stream, Args a, int l) {
    static bool attr = false; if (!attr) { (void)hipFuncSetAttribute((const void*)fwd_phase<K>, hipFuncAttributeMaxDynamicSharedMemorySize, LDS_BYTES); attr = true; }
    a.li = l; a.ph_lo = K; a.ph_hi = K + 1;
    hipLaunchKernelGGL(fwd_phase<K>, dim3(grid), dim3(NTHREADS), LDS_BYTES, stream, a);
}
extern "C" void kernel_launch(void* const* d_in, const int* in_sizes, int n_in, void* d_out, int out_size, void* d_ws, size_t ws_size, hipStream_t stream) {
    static int grid = 0;
    if (grid == 0) {
        if (n_in != 25 || in_sizes[0] != M * D || out_size != M * D || ws_size < WS_END) { fprintf(stderr, "kernel_launch: unexpected shapes (n_in %d, in0 %d, out %d, ws %zu < %zu)\n", n_in, n_in > 0 ? in_sizes[0] : -1, out_size, ws_size, (size_t)WS_END); grid = -1; return; }
        int dev = 0, cus = 0;
        if (hipGetDevice(&dev) != hipSuccess || hipDeviceGetAttribute(&cus, hipDeviceAttributeMultiprocessorCount, dev) != hipSuccess) { grid = -1; return; }
        grid = cus;
    }
    if (grid < 0) return;
    (void)hipMemsetAsync((char*)d_ws + WS_CTL, 0, CTL_ZERO_BYTES, stream);
    Args a{};
    for (int i = 0; i < 25; ++i) a.in[i] = (const float*)d_in[i];
    a.out = (float*)d_out; a.ws = (unsigned char*)d_ws; a.pad = 0;
#if MK_ONE_LAUNCH
    { static bool attr = false; if (!attr) { (void)hipFuncSetAttribute((const void*)fwd_all, hipFuncAttributeMaxDynamicSharedMemorySize, LDS_BYTES); attr = true; }
      a.li = 0; a.ph_lo = 0; a.ph_hi = NPHASES;
      hipLaunchKernelGGL(fwd_all, dim3(grid), dim3(NTHREADS), LDS_BYTES, stream, a); }
#else
    for (int l = 0; l < DEPTH; ++l) {
        launch_phase<0>(grid, stream, a, l); launch_phase<1>(grid, stream, a, l); launch_phase<2>(grid, stream, a, l); launch_phase<3>(grid, stream, a, l);
        launch_phase<4>(grid, stream, a, l); launch_phase<5>(grid, stream, a, l); launch_phase<6>(grid, stream, a, l); launch_phase<7>(grid, stream, a, l);
        launch_phase<8>(grid, stream, a, l); launch_phase<9>(grid, stream, a, l); launch_phase<10>(grid, stream, a, l); launch_phase<11>(grid, stream, a, l);
        launch_phase<12>(grid, stream, a, l);
    }
    launch_phase<13>(grid, stream, a, 0);
#endif
}
```

```cpp
#include <hip/hip_runtime.h>
#include <cstdio>
#include <cstdint>
#include <cmath>
#define GAS __attribute__((address_space(1)))
#define LAS __attribute__((address_space(3)))
namespace pg8 {
#define PG8_LAS __attribute__((address_space(3)))
typedef unsigned short bf16_t;
typedef short bf16x8 __attribute__((ext_vector_type(8)));
typedef float f32x4 __attribute__((ext_vector_type(4)));
typedef unsigned u32x4 __attribute__((ext_vector_type(4)));
constexpr int BM = 256, BK = 64, HALF = 128, HTB = HALF * BK * 2  , STAGE_BYTES = 8 * HTB, NXCD = 8, WGM = 8;

__host__ __device__ __forceinline__ int lds_byte(int r, int c) { const int st = (r >> 4) * 2 + (c >> 5), rr = r & 15, cc = c & 31, ob = rr * 64 + cc * 2; return st * 1024 + (ob ^ (((ob >> 9) & 1) << 5)); }
__host__ __device__ __forceinline__ void stage_rc(int b, int& R, int& C) { const int st = b / 1024, sb = b % 1024, swz = sb ^ (((sb >> 9) & 1) << 5); R = (st >> 1) * 16 + swz / 64; C = (st & 1) * 32 + (swz % 64) / 2; }
__host__ __device__ __forceinline__ int perm32(int rho) { const int n = rho >> 4, i = rho & 15; return 8 * (i >> 2) + 4 * n + (i & 3); }

struct Unit { int pm, pn; };
struct Gemm { const bf16_t* A; const bf16_t* Bt; int M, N, K; };

struct StaticOrder {
    int nM, nN, nwg, G, c;
    __host__ __device__ void init(int M, int N, int G_, int c_) { nM = M / BM; nN = N / BM; nwg = nM * nN; G = G_; c = c_; }
    __host__ __device__ bool next(int i, Unit& u) const {
        const long L = (long)i * G + c; if (L >= nwg) return false;
        int wgid = (int)L; { const int q = nwg / NXCD, r = nwg % NXCD, xcd = wgid % NXCD, off = wgid / NXCD; wgid = (xcd < r ? xcd * (q + 1) : r * (q + 1) + (xcd - r) * q) + off; }
        const int nig = WGM * nN, gid = wgid / nig, fm = gid * WGM, gsz = (nM - fm) < WGM ? (nM - fm) : WGM;
        u.pm = fm + ((wgid % nig) % gsz); u.pn = (wgid % nig) / gsz; return true;
    }
    __device__ __forceinline__ void a_ready(const Unit&) const {}
    __device__ __forceinline__ void done(const Unit&) const {}
};
__device__ __forceinline__ unsigned cvt_pk_bf16(float lo, float hi) { unsigned r; asm volatile("v_cvt_pk_bf16_f32 %0, %1, %2" : "=v"(r) : "v"(lo), "v"(hi)); return r; }
template <class Epi, class Sched, bool ALIGN_EPI = false, bool SP2 = false>
__device__ __forceinline__ void gemm_phase(PG8_LAS unsigned char* lds, const Gemm g, const Sched& S, const Epi& E) {
    int tid_ = threadIdx.x; asm volatile("" : "+v"(tid_));
    const int tid = tid_, wid = __builtin_amdgcn_readfirstlane(tid >> 6), lane = tid & 63, wr = wid >> 2, wc = wid & 3, fr = lane & 15, fq = lane >> 4;
    const int K = g.K, nt = K / BK;
    unsigned voffA[2], voffB[2];
#pragma unroll
    for (int i = 0; i < 2; ++i) { int R, C; stage_rc(tid * 16 + i * 8192, R, C); const int Rb = Epi::PERM ? ((R & ~31) + perm32(R & 31)) : R;
        voffA[i] = (unsigned)(R * K + C) * 2u; voffB[i] = (unsigned)(Rb * K + C) * 2u; }
    const size_t kstep = (size_t)(BK * 2);
    const size_t hstep = (size_t)HALF * K * 2;
    const size_t tstep = 2 * hstep;
    const unsigned ldsw = (unsigned)wid * 1024u;
    const int aoff = lds_byte(wr * 64 + fr, fq * 8), boff = lds_byte(wc * 32 + fr, fq * 8);
#define PG8_SA(b, h) (((b) * 2 + (h)) * HTB)
#define PG8_SB(b, h) ((4 + (b) * 2 + (h)) * HTB)
#define PG8_STAGE(bufoff, gbase, voff) do { _Pragma("unroll") for (int _i = 0; _i < 2; ++_i) \
        __builtin_amdgcn_global_load_lds((const unsigned*)((const char*)(gbase) + (voff)[_i]), (PG8_LAS unsigned*)(lds + (bufoff) + ldsw + _i * 8192), 16, 0, 0); } while (0)
#define PG8_LDA(dst, b, h) do { _Pragma("unroll") for (int m = 0; m < 4; ++m) _Pragma("unroll") for (int k = 0; k < 2; ++k) dst[m][k] = *(const PG8_LAS bf16x8*)(lds + PG8_SA(b, h) + aoff + m * 2048 + k * 1024); } while (0)
#define PG8_LDB(dst, b, h) do { _Pragma("unroll") for (int n = 0; n < 2; ++n) _Pragma("unroll") for (int k = 0; k < 2; ++k) dst[n][k] = *(const PG8_LAS bf16x8*)(lds + PG8_SB(b, h) + boff + n * 2048 + k * 1024); } while (0)
#define PG8_MMA(ai, bj, At, Bt) do { __builtin_amdgcn_s_setprio(1); _Pragma("unroll") for (int m = 0; m < 4; ++m) _Pragma("unroll") for (int n = 0; n < 2; ++n) _Pragma("unroll") for (int k = 0; k < 2; ++k) \
        acc[ai][bj][m][n] = __builtin_amdgcn_mfma_f32_16x16x32_bf16(Bt[n][k], At[m][k], acc[ai][bj][m][n], 0, 0, 0); __builtin_amdgcn_s_setprio(0); } while (0)
#define PG8_WAIT_V(n) asm volatile("s_waitcnt vmcnt(" #n ")" ::: "memory")
#define PG8_WAIT_L(n) asm volatile("s_waitcnt lgkmcnt(" #n ")" ::: "memory")
#define PG8_BAR __builtin_amdgcn_s_barrier()
#define PG8_SCHED __builtin_amdgcn_sched_barrier(0)
    Unit cur, nxt; int ui = 0;
    if (!S.next(0, cur)) return;
    f32x4 acc[2][2][4][2];
#pragma unroll
    for (int a = 0; a < 2; ++a)
#pragma unroll
        for (int b = 0; b < 2; ++b)
#pragma unroll
            for (int m = 0; m < 4; ++m)
#pragma unroll
                for (int n = 0; n < 2; ++n) acc[a][b][m][n] = (f32x4){0.f, 0.f, 0.f, 0.f};
    bf16x8 At[4][2], B0[2][2], B1[2][2];
    const char* cA = (const char*)g.A + (size_t)cur.pm * tstep; const char* cB = (const char*)g.Bt + (size_t)cur.pn * tstep;
    S.a_ready(cur);
    if constexpr (SP2) {
        PG8_STAGE(PG8_SB(0, 0), cB, voffB); PG8_STAGE(PG8_SB(0, 1), cB + hstep, voffB); PG8_STAGE(PG8_SA(0, 0), cA, voffA); PG8_STAGE(PG8_SA(0, 1), cA + hstep, voffA);
        if (wr == 1) PG8_BAR;
        PG8_WAIT_V(2); PG8_BAR;
        PG8_STAGE(PG8_SB(1, 0), cB + kstep, voffB); PG8_STAGE(PG8_SA(1, 0), cA + kstep, voffA); PG8_STAGE(PG8_SB(1, 1), cB + hstep + kstep, voffB);
        PG8_WAIT_V(6); PG8_BAR;
    } else {
        PG8_STAGE(PG8_SB(0, 0), cB, voffB); PG8_STAGE(PG8_SA(0, 0), cA, voffA); PG8_STAGE(PG8_SB(0, 1), cB + hstep, voffB); PG8_STAGE(PG8_SA(0, 1), cA + hstep, voffA);
        if (wr == 1) PG8_BAR;
        PG8_WAIT_V(4); PG8_BAR;
        PG8_STAGE(PG8_SB(1, 0), cB + kstep, voffB); PG8_STAGE(PG8_SA(1, 0), cA + kstep, voffA); PG8_STAGE(PG8_SB(1, 1), cB + hstep + kstep, voffB);
        PG8_WAIT_V(6); PG8_BAR;
    }
    for (;;) {
        const bool has_next = S.next(ui + 1, nxt);
        const char* nA = has_next ? (const char*)g.A + (size_t)nxt.pm * tstep : cA; const char* nB = has_next ? (const char*)g.Bt + (size_t)nxt.pn * tstep : cB;
        for (int t = 0; t < nt; t += 2) {
            const bool last = (t == nt - 2);
            const char* a1 = cA + (size_t)(t + 1) * kstep;
            const char* a2 = last ? nA : cA + (size_t)(t + 2) * kstep; const char* b2 = last ? nB : cB + (size_t)(t + 2) * kstep;
            const char* a3 = a2 + kstep; const char* b3 = b2 + kstep;
            if (last && has_next) S.a_ready(nxt);
            if constexpr (SP2) {
            PG8_LDB(B0, 0, 0); PG8_LDB(B1, 0, 1); PG8_SCHED; PG8_LDA(At, 0, 0); PG8_STAGE(PG8_SA(1, 1), a1 + hstep, voffA);
            PG8_WAIT_V(8); PG8_WAIT_L(0); PG8_BAR; PG8_MMA(0, 0, At, B0); PG8_MMA(0, 1, At, B1); PG8_BAR; PG8_SCHED;
            PG8_LDA(At, 0, 1); PG8_STAGE(PG8_SB(0, 0), b2, voffB); PG8_STAGE(PG8_SB(0, 1), b2 + hstep, voffB); PG8_STAGE(PG8_SA(0, 0), a2, voffA);
            PG8_WAIT_V(8); PG8_WAIT_L(0); PG8_BAR; PG8_MMA(1, 0, At, B0); PG8_MMA(1, 1, At, B1); PG8_BAR; PG8_SCHED;
            PG8_LDB(B0, 1, 0); PG8_LDB(B1, 1, 1); PG8_SCHED; PG8_LDA(At, 1, 0); PG8_STAGE(PG8_SA(0, 1), a2 + hstep, voffA);
            PG8_WAIT_V(8); PG8_WAIT_L(0); PG8_BAR; PG8_MMA(0, 0, At, B0); PG8_MMA(0, 1, At, B1); PG8_BAR; PG8_SCHED;
            PG8_LDA(At, 1, 1); PG8_STAGE(PG8_SB(1, 0), b3, voffB); PG8_STAGE(PG8_SB(1, 1), b3 + hstep, voffB); PG8_STAGE(PG8_SA(1, 0), a3, voffA);
            PG8_WAIT_V(8); PG8_WAIT_L(0); PG8_BAR; PG8_MMA(1, 0, At, B0); PG8_MMA(1, 1, At, B1); PG8_BAR; PG8_SCHED;
            } else {
            PG8_LDB(B0, 0, 0); PG8_SCHED; PG8_LDA(At, 0, 0); PG8_STAGE(PG8_SA(1, 1), a1 + hstep, voffA);
            PG8_WAIT_L(8); PG8_BAR; PG8_WAIT_L(0); PG8_MMA(0, 0, At, B0); PG8_BAR; PG8_SCHED;
            PG8_LDB(B1, 0, 1); PG8_STAGE(PG8_SB(0, 0), b2, voffB);
            PG8_BAR; PG8_WAIT_L(0); PG8_MMA(0, 1, At, B1); PG8_BAR;
            PG8_LDA(At, 0, 1); PG8_STAGE(PG8_SA(0, 0), a2, voffA);
            PG8_BAR; PG8_WAIT_L(0); PG8_MMA(1, 0, At, B0); PG8_BAR; PG8_SCHED;
            PG8_STAGE(PG8_SB(0, 1), b2 + hstep, voffB);
            PG8_WAIT_V(6); PG8_BAR; PG8_MMA(1, 1, At, B1); PG8_BAR;
            PG8_LDB(B0, 1, 0); PG8_SCHED; PG8_LDA(At, 1, 0); PG8_STAGE(PG8_SA(0, 1), a2 + hstep, voffA);
            PG8_WAIT_L(8); PG8_BAR; PG8_WAIT_L(0); PG8_MMA(0, 0, At, B0); PG8_BAR; PG8_SCHED;
            PG8_LDB(B1, 1, 1); PG8_STAGE(PG8_SB(1, 0), b3, voffB);
            PG8_BAR; PG8_WAIT_L(0); PG8_MMA(0, 1, At, B1); PG8_BAR;
            PG8_LDA(At, 1, 1); PG8_STAGE(PG8_SA(1, 0), a3, voffA);
            PG8_BAR; PG8_WAIT_L(0); PG8_MMA(1, 0, At, B0); PG8_BAR; PG8_SCHED;
            PG8_STAGE(PG8_SB(1, 1), b3 + hstep, voffB);
            PG8_WAIT_V(6); PG8_BAR; PG8_MMA(1, 1, At, B1); PG8_BAR;
            }
        }
        if constexpr (ALIGN_EPI) { if (wr == 0) PG8_BAR; }
        if constexpr (!Epi::AFTER_DRAIN) { E(acc, cur, wr, wc, fr, fq); S.done(cur); }
        if (!has_next) break;
#pragma unroll
        for (int a = 0; a < 2; ++a)
#pragma unroll
            for (int b = 0; b < 2; ++b)
#pragma unroll
                for (int m = 0; m < 4; ++m)
#pragma unroll
                    for (int n = 0; n < 2; ++n) acc[a][b][m][n] = (f32x4){0.f, 0.f, 0.f, 0.f};
        cur = nxt; cA = nA; cB = nB; ++ui;
        if constexpr (ALIGN_EPI) { if (wr == 1) PG8_BAR; }
    }
    PG8_WAIT_V(0);
    if constexpr (!ALIGN_EPI) { if (wr == 0) PG8_BAR; }
    PG8_BAR;
    if constexpr (Epi::AFTER_DRAIN) { E.fused(acc, cur, wr, wc, fr, fq, lds, wid, lane); S.done(cur); }
#undef PG8_SA
#undef PG8_SB
#undef PG8_STAGE
#undef PG8_LDA
#undef PG8_LDB
#undef PG8_MMA
#undef PG8_WAIT_V
#undef PG8_WAIT_L
#undef PG8_BAR
#undef PG8_SCHED
}
}
#define XB_TMO      128
#define XB_XCNT(j)  (256  + 64 * (j))
#define XB_XSUB(j)  (1280 + 64 * (j))
#define XB_XGEN(j)  (2304 + 64 * (j))
#define XB_TOP      3328
#define XB_TOPGEN   3392
#define XCD_BAR_WORDS 3456
#define XB_SPIN_CAP (1u << 18)

__device__ __forceinline__ unsigned xb_ld(unsigned* p)              { return __hip_atomic_load(p, __ATOMIC_RELAXED, __HIP_MEMORY_SCOPE_AGENT); }
__device__ __forceinline__ unsigned xb_add(unsigned* p, unsigned v) { return __hip_atomic_fetch_add(p, v, __ATOMIC_RELAXED, __HIP_MEMORY_SCOPE_AGENT); }
__device__ __forceinline__ unsigned xb_xcc_id() { return (unsigned)__builtin_amdgcn_s_getreg((3 << 11) | 20) & 0xFu; }
#define XB_SPIN(cond, bar) do { unsigned _sp = 0; while (cond) { __builtin_amdgcn_s_sleep(1); \
    if ((++_sp & 255u) == 0u) { if (xb_ld(&(bar)[XB_TMO])) break; if (_sp > XB_SPIN_CAP) { atomicAdd(&(bar)[XB_TMO], 1u); break; } } } } while (0)

struct XcdBarrier {
    unsigned* bar; unsigned x;
    volatile LAS unsigned* st;
};

__device__ __forceinline__ XcdBarrier xcd_barrier_post(unsigned* bar, volatile LAS unsigned* st) {
    XcdBarrier b; b.bar = bar; b.x = xb_xcc_id(); b.st = st;
    if (threadIdx.x == 0) (void)xb_add(&bar[XB_XCNT(b.x)], 1u);
    return b;
}
__device__ __forceinline__ void xcd_barrier_complete(unsigned* bar, unsigned x, unsigned& nloc, unsigned& nx) {
    const unsigned G = gridDim.x * gridDim.y * gridDim.z;
    unsigned sum, cnt, mine, sp = 0u;
    for (;;) {
        sum = 0u; cnt = 0u; mine = 0u;
#pragma unroll
        for (unsigned j = 0; j < 16; ++j) { const unsigned c = xb_ld(&bar[XB_XCNT(j)]); sum += c; cnt += (c > 0u) ? 1u : 0u; mine = (j == x) ? c : mine; }
        if (sum == G) break;
        __builtin_amdgcn_s_sleep(1);
        if ((++sp & 255u) == 0u) { if (xb_ld(&bar[XB_TMO])) break; if (sp > XB_SPIN_CAP) { atomicAdd(&bar[XB_TMO], 1u); break; } }
    }
    nloc = mine > 0u ? mine : 1u; nx = cnt > 0u ? cnt : 1u;
}

__device__ __forceinline__ void xcd_barrier(const XcdBarrier& b) {
    asm volatile("s_waitcnt vmcnt(0)" ::: "memory");
    __syncthreads();
    if (threadIdx.x == 0) {
        unsigned* bar = b.bar;
        __builtin_amdgcn_s_waitcnt(0);
        unsigned nloc = b.st[0], nx = b.st[1];
        if (nloc == 0u) { xcd_barrier_complete(bar, b.x, nloc, nx); b.st[0] = nloc; b.st[1] = nx; }
        const unsigned old = xb_add(&bar[XB_XSUB(b.x)], 1u);
        const unsigned gen = old / nloc;
        if (old + 1u == (gen + 1u) * nloc) {
            __builtin_amdgcn_fence(__ATOMIC_RELEASE, "agent");
            asm volatile("s_waitcnt vmcnt(0)" ::: "memory");
            const unsigned og = xb_add(&bar[XB_TOP], 1u);
            const unsigned tg = og / nx;
            if (og + 1u == (tg + 1u) * nx) xb_add(&bar[XB_TOPGEN], 1u);
            else XB_SPIN(xb_ld(&bar[XB_TOPGEN]) == tg, bar);
            __builtin_amdgcn_fence(__ATOMIC_ACQUIRE, "agent");
            xb_add(&bar[XB_XGEN(b.x)], 1u);
            asm volatile("s_waitcnt vmcnt(0)" ::: "memory");
        } else {
            XB_SPIN(xb_ld(&bar[XB_XGEN(b.x)]) == gen, bar);
            __builtin_amdgcn_fence(__ATOMIC_ACQUIRE, "agent");
            asm volatile("s_waitcnt vmcnt(0)" ::: "memory");
        }
    }
    __syncthreads();
}

constexpr int BATCH = 2, SEQ = 8192, M = BATCH * SEQ, D = 2048, DEPTH = 4;
constexpr int DIN = 11968, NP1 = 5888, NG = 6144, NWIN = NP1 + NG;
constexpr int BW = 768, BCOLS = 2752;
constexpr int C_AQ = 0, C_AK = 512, C_AV = 640, C_R = 768, C_K = 1536, C_V = 2304, C_WD = 3072, C_CQ = 3520, C_CK = 4288, C_CV = 5056, C_END = 5824;
constexpr int DFF = 5504, NUP = 2 * DFF;
constexpr int NLORA = 2304, KLORA = 512;
constexpr float NORM_EPS = 1e-5f, GN_EPS = 64e-5f;
constexpr int NWAVES = 8, NTHREADS = 512;
constexpr int NPH = 13;
constexpr int NPHASES = DEPTH * NPH + 1;
#ifndef EXP_EW_MASK
#define EXP_EW_MASK 0
#endif
#ifndef EXP_EW_REPS
#define EXP_EW_REPS 1
#endif
#ifndef EXP_G1_REPS
#define EXP_G1_REPS 1
#endif
#ifndef EXP_SCAN_REPS
#define EXP_SCAN_REPS 1
#endif
#ifndef EXP_ATTN_REPS
#define EXP_ATTN_REPS 1
#endif
constexpr int NSCAN = 48;

constexpr size_t MiB = 1u << 20;
constexpr size_t WS_CTL = 0, CTL_ZERO_BYTES = 1 * MiB;
constexpr size_t WS_WIN = 1 * MiB;
constexpr size_t WS_WLORA = 48 * MiB;
constexpr size_t WS_PA = 51 * MiB;
constexpr size_t WS_PB = 53 * MiB;
constexpr size_t WS_PC = 56 * MiB;
constexpr size_t WS_WOUT = 57 * MiB;
constexpr size_t WS_WUP = 65 * MiB;
constexpr size_t WS_WDOWN = 108 * MiB;
constexpr size_t WS_H = 130 * MiB;
constexpr size_t WS_P1 = 194 * MiB;
constexpr size_t WS_G = 378 * MiB;
constexpr size_t WS_U = WS_P1;
constexpr size_t WS_AP = 570 * MiB;
constexpr size_t WS_LO = 586 * MiB;
constexpr size_t WS_ACT = WS_LO;
constexpr size_t WS_SR = 730 * MiB;
constexpr size_t WS_SW = 778 * MiB, WS_SK = 826 * MiB, WS_SKK = 874 * MiB, WS_SB = 922 * MiB, WS_SV = 970 * MiB;
constexpr size_t WS_YRAW = 1018 * MiB;
constexpr size_t WS_YA = 1066 * MiB;
constexpr size_t WS_YB = 1082 * MiB;
constexpr size_t WS_YC = 1106 * MiB;
constexpr size_t WS_OC = 1114 * MiB;
constexpr size_t WS_LSE = 1138 * MiB;
constexpr size_t WS_MG = 1139 * MiB;
constexpr size_t WS_BK = 1203 * MiB;
constexpr size_t WS_VT = 1205 * MiB;
constexpr size_t WS_W2 = 1235 * MiB;
constexpr size_t WSET_STRIDE = WS_W2 - WS_WIN;
constexpr size_t WS_END = 1365 * MiB;
constexpr int CW_BAR = 4096;

constexpr int RING_OFF = 0, RING_BYTES = 131072;
constexpr int LDSCTL_OFF = 141312, MISC_OFF = LDSCTL_OFF + 320;
constexpr int LDS_BYTES = 147456;

typedef unsigned short bf16;
typedef unsigned v4u __attribute__((ext_vector_type(4)));
typedef unsigned v2u __attribute__((ext_vector_type(2)));
typedef float f32x4 __attribute__((ext_vector_type(4)));
#define LDS_WAIT() asm volatile("s_waitcnt lgkmcnt(0)" ::: "memory")

__device__ __forceinline__ unsigned f2bf(float f) { unsigned u = __builtin_bit_cast(unsigned, f); return (u + 0x7fffu + ((u >> 16) & 1u)) >> 16; }
__device__ __forceinline__ unsigned pk2(float lo, float hi) { return f2bf(lo) | (f2bf(hi) << 16); }
__device__ __forceinline__ float bflo(unsigned w) { return __builtin_bit_cast(float, w << 16); }
__device__ __forceinline__ float bfhi(unsigned w) { return __builtin_bit_cast(float, w & 0xffff0000u); }
__device__ __forceinline__ float bf1(bf16 h) { return __builtin_bit_cast(float, ((unsigned)h) << 16); }
__device__ __forceinline__ float sigmoidf_(float x) { return 1.0f / (1.0f + __expf(-x)); }
__device__ __forceinline__ float wave_sum(float v) {
#pragma unroll
    for (int o = 1; o < 64; o <<= 1) v += __shfl_xor(v, o);
    return v;
}
template <int CTRL> __device__ __forceinline__ float dppf(float x) { return __builtin_bit_cast(float, __builtin_amdgcn_update_dpp(0, __builtin_bit_cast(int, x), CTRL, 0xF, 0xF, true)); }
__device__ __forceinline__ float red4(float x) { x += dppf<0xB1>(x); x += dppf<0x4E>(x); return x; }
__device__ __forceinline__ float red16(float x) { x = red4(x); x += dppf<0x141>(x); x += dppf<0x140>(x); return x; }
__device__ __forceinline__ float wsum(float x) { x = red16(x); x += __shfl_xor(x, 16); x += __shfl_xor(x, 32); return x; }

__device__ const unsigned char T5B[3][132] = {
 {0,1,2,3,4,5,6,7,8,9,10,11,12,13,14,15,16,16,16,16,16,16,17,17,17,17,17,17,17,17,18,18,18,18,18,18,18,18,18,18,19,19,19,19,19,19,19,19,19,19,19,19,19,19,20,20,20,20,20,20,20,20,20,20,20,20,20,20,20,20,20,20,20,21,21,21,21,21,21,21,21,21,21,21,21,21,21,21,21,21,21,21,21,21,21,21,21,21,21,22,22,22,22,22,22,22,22,22,22,22,22,22,22,22,22,22,22,22,22,22,22,22,22,22,22,22,22,22,22,0,0,0},
 {0,4,8,12,16,16,17,17,18,18,19,19,19,19,20,20,20,20,20,21,21,21,21,21,21,22,22,22,22,22,22,22,22,22,23,23,23,23,23,23,23,23,23,23,23,23,24,24,24,24,24,24,24,24,24,24,24,24,24,24,24,24,25,25,25,25,25,25,25,25,25,25,25,25,25,25,25,25,25,25,25,25,25,26,26,26,26,26,26,26,26,26,26,26,26,26,26,26,26,26,26,26,26,26,26,26,26,26,26,26,26,26,26,27,27,27,27,27,27,27,27,27,27,27,27,27,27,27,27,0,0,0},
 {0,16,18,19,20,21,21,22,22,23,23,23,24,24,24,24,25,25,25,25,25,26,26,26,26,26,26,26,26,27,27,27,27,27,27,27,27,27,27,28,28,28,28,28,28,28,28,28,28,28,28,28,29,29,29,29,29,29,29,29,29,29,29,29,29,29,29,29,29,29,30,30,30,30,30,30,30,30,30,30,30,30,30,30,30,30,30,30,30,30,30,30,30,30,30,31,31,31,31,31,31,31,31,31,31,31,31,31,31,31,31,31,31,31,31,31,31,31,31,31,31,31,31,31,31,31,31,31,31,0,0,0}};

namespace pg8 {
struct EpiWin {
    static constexpr bool PERM = true, AFTER_DRAIN = false;
    bf16_t* P1; bf16_t* G; int pn0;
    __device__ __forceinline__ void operator()(const f32x4 (&acc)[2][2][4][2], const Unit& u, int wr, int wc, int fr, int fq) const {
        const int pn = u.pn + pn0; const int row0 = u.pm * BM + wr * 64 + fr; const bool gate = pn >= 23;
        bf16_t* base = gate ? G : P1; const int ldc = gate ? 6144 : 5888; const int col0 = (gate ? (pn - 23) : pn) * BM + wc * 32 + 8 * fq;
#pragma unroll
        for (int ai = 0; ai < 2; ++ai)
#pragma unroll
            for (int m = 0; m < 4; ++m) { bf16_t* rowp = base + (size_t)(row0 + ai * HALF + m * 16) * ldc + col0;
#pragma unroll
                for (int bj = 0; bj < 2; ++bj) { f32x4 v0 = acc[ai][bj][m][0], v1 = acc[ai][bj][m][1];
                    if (gate) {
#pragma unroll
                        for (int j = 0; j < 4; ++j) { v0[j] = __builtin_amdgcn_rcpf(1.0f + __expf(-v0[j])); v1[j] = __builtin_amdgcn_rcpf(1.0f + __expf(-v1[j])); } }
                    u32x4 w; w.x = cvt_pk_bf16(v0[0], v0[1]); w.y = cvt_pk_bf16(v0[2], v0[3]); w.z = cvt_pk_bf16(v1[0], v1[1]); w.w = cvt_pk_bf16(v1[2], v1[3]);
                    *(u32x4*)(rowp + bj * HALF) = w; } }
    }
};
struct EpiBf16P {
    static constexpr bool PERM = true, AFTER_DRAIN = false;
    bf16_t* O; int ldc;
    __device__ __forceinline__ void operator()(const f32x4 (&acc)[2][2][4][2], const Unit& u, int wr, int wc, int fr, int fq) const {
        const int row0 = u.pm * BM + wr * 64 + fr; const int col0 = u.pn * BM + wc * 32 + 8 * fq;
#pragma unroll
        for (int ai = 0; ai < 2; ++ai)
#pragma unroll
            for (int m = 0; m < 4; ++m) { bf16_t* rowp = O + (size_t)(row0 + ai * HALF + m * 16) * ldc + col0;
#pragma unroll
                for (int bj = 0; bj < 2; ++bj) { const f32x4 v0 = acc[ai][bj][m][0], v1 = acc[ai][bj][m][1];
                    u32x4 w; w.x = cvt_pk_bf16(v0[0], v0[1]); w.y = cvt_pk_bf16(v0[2], v0[3]); w.z = cvt_pk_bf16(v1[0], v1[1]); w.w = cvt_pk_bf16(v1[2], v1[3]);
                    *(u32x4*)(rowp + bj * HALF) = w; } }
    }
};
struct EpiF32P {
    static constexpr bool PERM = false, AFTER_DRAIN = false;
    float* C; int ldc;
    __device__ __forceinline__ void operator()(const f32x4 (&acc)[2][2][4][2], const Unit& u, int wr, int wc, int fr, int fq) const {
        const int row0 = u.pm * BM + wr * 64 + fr, col0 = u.pn * BM + wc * 32 + 4 * fq;
#pragma unroll
        for (int ai = 0; ai < 2; ++ai)
#pragma unroll
            for (int m = 0; m < 4; ++m) { float* rowp = C + (size_t)(row0 + ai * HALF + m * 16) * ldc + col0;
#pragma unroll
                for (int bj = 0; bj < 2; ++bj)
#pragma unroll
                    for (int n = 0; n < 2; ++n) *(f32x4*)(rowp + bj * HALF + n * 16) = acc[ai][bj][m][n]; }
    }
};
struct EpiResid {
    static constexpr bool PERM = false, AFTER_DRAIN = false;
    const float* xin; float* out;
    __device__ __forceinline__ void operator()(const f32x4 (&acc)[2][2][4][2], const Unit& u, int wr, int wc, int fr, int fq) const {
        const int row0 = u.pm * BM + wr * 64 + fr, col0 = u.pn * BM + wc * 32 + 4 * fq;
#pragma unroll
        for (int ai = 0; ai < 2; ++ai)
#pragma unroll
            for (int m = 0; m < 4; ++m) { const size_t ro = (size_t)(row0 + ai * HALF + m * 16) * 2048 + col0;
#pragma unroll
                for (int bj = 0; bj < 2; ++bj)
#pragma unroll
                    for (int n = 0; n < 2; ++n) { const f32x4 xv = *(const f32x4*)(xin + ro + bj * HALF + n * 16); *(f32x4*)(out + ro + bj * HALF + n * 16) = xv + acc[ai][bj][m][n]; } }
    }
};
template <bool ACC> struct EpiGate {
    static constexpr bool PERM = true, AFTER_DRAIN = false;
    const bf16_t* G; int gofs; bf16_t* MG;
    __device__ __forceinline__ void operator()(const f32x4 (&acc)[2][2][4][2], const Unit& u, int wr, int wc, int fr, int fq) const {
        const int row0 = u.pm * BM + wr * 64 + fr; const int col0 = u.pn * BM + wc * 32 + 8 * fq;
#pragma unroll
        for (int ai = 0; ai < 2; ++ai)
#pragma unroll
            for (int m = 0; m < 4; ++m) { const int row = row0 + ai * HALF + m * 16;
#pragma unroll
                for (int bj = 0; bj < 2; ++bj) { const int col = col0 + bj * HALF;
                    const u32x4 gv = *(const u32x4*)(G + (size_t)row * 6144 + gofs + col);
                    const f32x4 a0 = acc[ai][bj][m][0], a1 = acc[ai][bj][m][1];
                    float r[8];
                    r[0] = __builtin_bit_cast(float, gv.x << 16) * a0[0]; r[1] = __builtin_bit_cast(float, gv.x & 0xffff0000u) * a0[1];
                    r[2] = __builtin_bit_cast(float, gv.y << 16) * a0[2]; r[3] = __builtin_bit_cast(float, gv.y & 0xffff0000u) * a0[3];
                    r[4] = __builtin_bit_cast(float, gv.z << 16) * a1[0]; r[5] = __builtin_bit_cast(float, gv.z & 0xffff0000u) * a1[1];
                    r[6] = __builtin_bit_cast(float, gv.w << 16) * a1[2]; r[7] = __builtin_bit_cast(float, gv.w & 0xffff0000u) * a1[3];
                    bf16_t* mp = MG + (size_t)row * 2048 + col;
                    if (ACC) { const u32x4 ov = *(const u32x4*)mp;
                        r[0] += __builtin_bit_cast(float, ov.x << 16); r[1] += __builtin_bit_cast(float, ov.x & 0xffff0000u);
                        r[2] += __builtin_bit_cast(float, ov.y << 16); r[3] += __builtin_bit_cast(float, ov.y & 0xffff0000u);
                        r[4] += __builtin_bit_cast(float, ov.z << 16); r[5] += __builtin_bit_cast(float, ov.z & 0xffff0000u);
                        r[6] += __builtin_bit_cast(float, ov.w << 16); r[7] += __builtin_bit_cast(float, ov.w & 0xffff0000u); }
                    u32x4 w; w.x = cvt_pk_bf16(r[0], r[1]); w.y = cvt_pk_bf16(r[2], r[3]); w.z = cvt_pk_bf16(r[4], r[5]); w.w = cvt_pk_bf16(r[6], r[7]);
                    *(u32x4*)mp = w; } }
    }
};
}

struct Args { const float* in[25]; float* out; unsigned char* ws; int ph_lo, ph_hi, li, pad; };

struct Ctx {
    LAS unsigned char* lds;
    int tid, lane, wave, G, bid;
    int gw, ngw;
};

__device__ __forceinline__ void transpose_item(const float* W, int K, int N, bf16* WT, int kb, int nb, int dst_row0, LAS float* scr, int lane) {
    const int k0 = 64 * kb, n0 = 32 * nb;
#pragma unroll 8
    for (int i = 0; i < 32; ++i) { const int kk = 2 * i + (lane >> 5); scr[kk * 33 + (lane & 31)] = W[(size_t)(k0 + kk) * N + n0 + (lane & 31)]; }
    LDS_WAIT(); asm volatile("" ::: "memory");
    const int c = lane & 7;
#pragma unroll
    for (int j = 0; j < 4; ++j) { const int n = (lane >> 3) + 8 * j; const LAS float* s = scr + (8 * c) * 33 + n;
        v4u o; o.x = pk2(s[0 * 33], s[1 * 33]); o.y = pk2(s[2 * 33], s[3 * 33]); o.z = pk2(s[4 * 33], s[5 * 33]); o.w = pk2(s[6 * 33], s[7 * 33]);
        *(v4u*)(WT + (size_t)(dst_row0 + n) * K + k0 + 8 * c) = o; }
    LDS_WAIT(); asm volatile("" ::: "memory");
}
__device__ __forceinline__ int transpose_matrix(int widx, int nw, int lane, LAS float* scr, const float* W, int K, int N, bf16* WT, int gate_split, int base) {
    const int nblk = N / 32, items = (K / 64) * nblk;
    int first = (widx - base) % nw; if (first < 0) first += nw;
    for (int it = first; it < items; it += nw) {
        const int kb = it / nblk, nb = it % nblk; int dr = 32 * nb; if (gate_split && dr >= C_END) dr += 64;
        transpose_item(W, K, N, WT, kb, nb, dr, scr, lane);
    }
    return base + items;
}
__device__ __forceinline__ void convert_weights(int widx, int nw, int lane, LAS float* scr, const Args& a, int l, unsigned char* ws) {
    unsigned char* wsw = ws + (size_t)(l & 1) * WSET_STRIDE;
    int base = 0;
    base = transpose_matrix(widx, nw, lane, scr, a.in[3] + (size_t)l * D * DIN, D, DIN, (bf16*)(wsw + WS_WIN), 1, base);
    base = transpose_matrix(widx, nw, lane, scr, a.in[21] + (size_t)l * D * NUP, D, NUP, (bf16*)(wsw + WS_WUP), 0, base);
    base = transpose_matrix(widx, nw, lane, scr, a.in[23] + (size_t)l * DFF * D, DFF, D, (bf16*)(wsw + WS_WDOWN), 0, base);
    base = transpose_matrix(widx, nw, lane, scr, a.in[19] + (size_t)l * D * D, D, D, (bf16*)(wsw + WS_WOUT), 0, base);
    base = transpose_matrix(widx, nw, lane, scr, a.in[16] + (size_t)l * 512 * D, 512, D, (bf16*)(wsw + WS_PA), 0, base);
    base = transpose_matrix(widx, nw, lane, scr, a.in[17] + (size_t)l * 768 * D, 768, D, (bf16*)(wsw + WS_PB), 0, base);
    base = transpose_matrix(widx, nw, lane, scr, a.in[18] + (size_t)l * 256 * D, 256, D, (bf16*)(wsw + WS_PC), 0, base);
    const int gt = widx * 64 + lane, ngt = nw * 64;
    { v4u* z = (v4u*)((bf16*)(wsw + WS_WIN) + (size_t)C_END * D); for (int i = gt; i < 64 * D / 8; i += ngt) z[i] = (v4u){0u, 0u, 0u, 0u}; }
    { bf16* wl = (bf16*)(wsw + WS_WLORA); const float* wup = a.in[7] + (size_t)l * 96 * BW; const float* aup = a.in[9] + (size_t)l * 96 * BW; const float* gup = a.in[10] + (size_t)l * 256 * BW;
      for (int i = gt; i < NLORA * KLORA; i += ngt) { const int n = i / KLORA, k = i % KLORA; float v = 0.f;
          if (n < 768) { if (k < 96) v = wup[k * BW + n]; }
          else if (n < 1536) { if (k >= 96 && k < 192) v = aup[(k - 96) * BW + (n - 768)]; }
          else { if (k >= 192 && k < 448) v = gup[(k - 192) * BW + (n - 1536)]; }
          wl[i] = (bf16)f2bf(v); } }
}

__device__ __forceinline__ void rms_row_bf16(const float* xrow, const float* gam, bf16* orow, int lane) {
    const f32x4* xr = (const f32x4*)xrow + lane; f32x4 v[8]; float s = 0.f;
#pragma unroll
    for (int j = 0; j < 8; ++j) { v[j] = xr[64 * j]; s += (v[j].x * v[j].x + v[j].y * v[j].y) + (v[j].z * v[j].z + v[j].w * v[j].w); }
    const float rs = 1.0f / sqrtf(wave_sum(s) * (1.0f / D) + NORM_EPS);
    const f32x4* gr = (const f32x4*)gam + lane; v2u* o8 = (v2u*)orow + lane;
#pragma unroll
    for (int j = 0; j < 8; ++j) { const f32x4 g = gr[64 * j]; v2u w; w.x = pk2(v[j].x * rs * g.x, v[j].y * rs * g.y); w.y = pk2(v[j].z * rs * g.z, v[j].w * rs * g.w); o8[64 * j] = w; }
}
__device__ __forceinline__ void rms_row2_bf16(const float* xrow, const float* gam, bf16* orow, int lane) {
    const f32x4* xr = (const f32x4*)xrow + lane; f32x4 v[16]; float s0 = 0.f, s1 = 0.f;
#pragma unroll
    for (int j = 0; j < 16; ++j) v[j] = xr[64 * j];
#pragma unroll
    for (int j = 0; j < 8; ++j) { s0 += (v[j].x * v[j].x + v[j].y * v[j].y) + (v[j].z * v[j].z + v[j].w * v[j].w); s1 += (v[8 + j].x * v[8 + j].x + v[8 + j].y * v[8 + j].y) + (v[8 + j].z * v[8 + j].z + v[8 + j].w * v[8 + j].w); }
    const float rs0 = 1.0f / sqrtf(wsum(s0) * (1.0f / D) + NORM_EPS), rs1 = 1.0f / sqrtf(wsum(s1) * (1.0f / D) + NORM_EPS);
    const f32x4* gr = (const f32x4*)gam + lane; v2u* o8 = (v2u*)orow + lane;
#pragma unroll
    for (int j = 0; j < 8; ++j) { const f32x4 g = gr[64 * j]; v2u w; w.x = pk2(v[j].x * rs0 * g.x, v[j].y * rs0 * g.y); w.y = pk2(v[j].z * rs0 * g.z, v[j].w * rs0 * g.w); o8[64 * j] = w;
        v2u w1; w1.x = pk2(v[8 + j].x * rs1 * g.x, v[8 + j].y * rs1 * g.y); w1.y = pk2(v[8 + j].z * rs1 * g.z, v[8 + j].w * rs1 * g.w); o8[64 * (8 + j)] = w1; }
}
__device__ __forceinline__ void rms_row_f32(float* xrow, const float* gam, int lane) {
    f32x4* xr = (f32x4*)xrow + lane; f32x4 v[8]; float s = 0.f;
#pragma unroll
    for (int j = 0; j < 8; ++j) { v[j] = xr[64 * j]; s += (v[j].x * v[j].x + v[j].y * v[j].y) + (v[j].z * v[j].z + v[j].w * v[j].w); }
    const float rs = 1.0f / sqrtf(wave_sum(s) * (1.0f / D) + NORM_EPS);
    const f32x4* gr = (const f32x4*)gam + lane;
#pragma unroll
    for (int j = 0; j < 8; ++j) { const f32x4 g = gr[64 * j]; xr[64 * j] = v[j] * rs * g; }
}

__device__ __forceinline__ void phase_prep(const Ctx& C, const Args& a, int l, const float* xsrc, unsigned char* ws) {
    if (l == 0) convert_weights(C.gw, C.ngw, C.lane, (LAS float*)(C.lds + RING_OFF + C.wave * 16384), a, 0, ws);
    const float* g1 = a.in[2] + (size_t)l * D; bf16* H = (bf16*)(ws + WS_H);
    for (int m = 2 * C.gw; m < M; m += 2 * C.ngw) rms_row2_bf16(xsrc + (size_t)m * D, g1, H + (size_t)m * D, C.lane);
}

__device__ __forceinline__ void phase_aprime(const Ctx& C, const Args& a, int l, unsigned char* ws) {
    const bf16* P1 = (const bf16*)(ws + WS_P1); bf16* AP = (bf16*)(ws + WS_AP); const float* mu = a.in[5] + (size_t)l * BCOLS;
    const int g = C.lane, c0 = 8 * g;
    float muv[8];
#pragma unroll
    for (int j = 0; j < 8; ++j) muv[j] = (g < 56) ? mu[(C_WD - C_R) + c0 + j] : 0.f;
    for (int m = C.gw; m < M; m += C.ngw) {
        v4u o = (v4u){0u, 0u, 0u, 0u};
        if (g < 56) {
            const v4u cur = *(const v4u*)(P1 + (size_t)m * NP1 + C_WD + c0);
            v4u prv = (v4u){0u, 0u, 0u, 0u}; if ((m & (SEQ - 1)) != 0) prv = *(const v4u*)(P1 + (size_t)(m - 1) * NP1 + C_WD + c0);
            float x[8], p[8];
            x[0] = bflo(cur.x); x[1] = bfhi(cur.x); x[2] = bflo(cur.y); x[3] = bfhi(cur.y); x[4] = bflo(cur.z); x[5] = bfhi(cur.z); x[6] = bflo(cur.w); x[7] = bfhi(cur.w);
            p[0] = bflo(prv.x); p[1] = bfhi(prv.x); p[2] = bflo(prv.y); p[3] = bfhi(prv.y); p[4] = bflo(prv.z); p[5] = bfhi(prv.z); p[6] = bflo(prv.w); p[7] = bfhi(prv.w);
#pragma unroll
            for (int j = 0; j < 8; ++j) { float v = x[j] + (p[j] - x[j]) * muv[j];
                if (g < 12) v = tanhf(v); else if (g >= 24) v = sigmoidf_(v);
                x[j] = v; }
            o.x = pk2(x[0], x[1]); o.y = pk2(x[2], x[3]); o.z = pk2(x[4], x[5]); o.w = pk2(x[6], x[7]);
        }
        *(v4u*)(AP + (size_t)m * KLORA + c0) = o;
    }
}

struct PrepTok { float r, kt, v, w, kk, b; };
__device__ __forceinline__ PrepTok prep_token(const bf16* P1, const float* LO, int m, int hc, float mur, float muk, float muv, float w0, float a0, float kkw, float kaw) {
    const bool first = (m & (SEQ - 1)) == 0;
    const bf16* pr = P1 + (size_t)m * NP1; const bf16* pp = pr - NP1;
    float r = bf1(pr[C_R + hc]), k = bf1(pr[C_K + hc]), v = bf1(pr[C_V + hc]);
    const float rp = first ? 0.f : bf1(pp[C_R + hc]), kp = first ? 0.f : bf1(pp[C_K + hc]), vp = first ? 0.f : bf1(pp[C_V + hc]);
    r = r + (rp - r) * mur; k = k + (kp - k) * muk; v = v + (vp - v) * muv;
    const float wpre = w0 + LO[(size_t)m * NLORA + hc], apre = a0 + LO[(size_t)m * NLORA + BW + hc];
    const float xx = -wpre; const float sp = fmaxf(xx, 0.f) + log1pf(expf(-fabsf(xx)));
    const float wlog = -sp - 0.5f; const float decay = expf(-expf(wlog));
    const float av = 1.0f / (1.0f + expf(-apre));
    const float kkr = k * kkw; const float nrm = sqrtf(wave_sum(kkr * kkr)); const float kk = kkr / fmaxf(nrm, 1e-12f);
    PrepTok t; t.r = r; t.kt = k * (1.0f + (av - 1.0f) * kaw); t.v = v; t.w = decay; t.kk = kk; t.b = kk * av; return t;
}
__device__ __forceinline__ void phase_scanprep(const Ctx& C, const Args& a, int l, unsigned char* ws) {
    const bf16* P1 = (const bf16*)(ws + WS_P1); const float* LO = (const float*)(ws + WS_LO);
    float* SR = (float*)(ws + WS_SR); float* SW = (float*)(ws + WS_SW); float* SK = (float*)(ws + WS_SK); float* SU = (float*)(ws + WS_SKK); float* SB = (float*)(ws + WS_SB); float* SV = (float*)(ws + WS_SV);
    float* BK = (float*)(ws + WS_BK);
    const float* mu = a.in[5] + (size_t)l * BCOLS; const float* w0p = a.in[6] + (size_t)l * BW; const float* a0p = a.in[8] + (size_t)l * BW;
    const float* kkwp = a.in[11] + (size_t)l * BW; const float* kawp = a.in[12] + (size_t)l * BW;
    constexpr int TB = 16, NS = TB + 2;
    for (int it = C.gw; it < (M / TB) * 12; it += C.ngw) {
        const int tb = it / 12, h = it % 12, hc = h * 64 + C.lane, m0 = tb * TB;
        const float mur = mu[hc], muk = mu[BW + hc], muv = mu[2 * BW + hc], w0 = w0p[hc], a0 = a0p[hc], kkw = kkwp[hc], kaw = kawp[hc];
        const bool seq_start = (m0 & (SEQ - 1)) == 0;
        float rr[NS], rk[NS], rv[NS], lw[NS], la[NS];
#pragma unroll
        for (int j = 0; j < NS; ++j) {
            const bool ok = !(seq_start && j < 2); const size_t row = ok ? (size_t)(m0 - 2 + j) : (size_t)m0;
            const bf16* pr = P1 + row * NP1 + hc;
            const float x0 = bf1(pr[C_R]), x1 = bf1(pr[C_K]), x2 = bf1(pr[C_V]);
            rr[j] = ok ? x0 : 0.f; rk[j] = ok ? x1 : 0.f; rv[j] = ok ? x2 : 0.f;
            if (j >= 1) { const float y0 = LO[row * NLORA + hc], y1 = LO[row * NLORA + BW + hc]; lw[j] = ok ? y0 : 0.f; la[j] = ok ? y1 : 0.f; } else { lw[j] = 0.f; la[j] = 0.f; }
        }
        float tr[NS], tk[NS], tv[NS], tw[NS], ta[NS], tq[NS];
#pragma unroll
        for (int j = 1; j < NS; ++j) {
            tr[j] = rr[j] + (rr[j - 1] - rr[j]) * mur; tk[j] = rk[j] + (rk[j - 1] - rk[j]) * muk; tv[j] = rv[j] + (rv[j - 1] - rv[j]) * muv;
            const float xx = -(w0 + lw[j]); const float sp = fmaxf(xx, 0.f) + __logf(1.0f + __expf(-fabsf(xx)));
            tw[j] = __expf(-__expf(-sp - 0.5f));
            ta[j] = 1.0f / (1.0f + __expf(-(a0 + la[j])));
            const float kkr = tk[j] * kkw; tq[j] = kkr * kkr;
        }
#pragma unroll
        for (int j = 1; j < NS; ++j) tq[j] = wsum(tq[j]);
        float tkk[NS], tb_[NS], tkt[NS];
#pragma unroll
        for (int j = 1; j < NS; ++j) { tkk[j] = tk[j] * kkw / fmaxf(sqrtf(tq[j]), 1e-12f); tb_[j] = tkk[j] * ta[j]; tkt[j] = tk[j] * (1.0f + (ta[j] - 1.0f) * kaw); }
        float be[NS], ka[NS];
#pragma unroll
        for (int j = 2; j < NS; ++j) { be[j] = wsum(tb_[j - 1] * tkk[j]); ka[j] = wsum(tkt[j - 1] * tkk[j]); }
#pragma unroll
        for (int j = 2; j < NS; ++j) {
            const int m = m0 + j - 2; const size_t o = (size_t)m * BW + hc; const bool first = (m & (SEQ - 1)) == 0;
            SR[o] = tr[j]; SW[o] = tw[j]; SK[o] = tkt[j]; SB[o] = tb_[j]; SV[o] = tv[j];
            if (!first) SU[o - BW] = tw[j - 1] * tkk[j];
            if ((m & (SEQ - 1)) == SEQ - 1) SU[o] = 0.f;
            if (C.lane < 2) BK[((size_t)m * 12 + h) * 2 + C.lane] = first ? 0.f : (C.lane == 0 ? be[j] : ka[j]);
        }
    }
}

__device__ __forceinline__ void scan_block(const Ctx& C, int sb, unsigned char* ws) {
    const int b = sb / 24, h = (sb % 24) >> 1, half = sb & 1;
    const float* SR = (const float*)(ws + WS_SR); const float* SW = (const float*)(ws + WS_SW); const float* SK = (const float*)(ws + WS_SK); const float* SKK = (const float*)(ws + WS_SKK);
    const float* SB = (const float*)(ws + WS_SB); const float* SV = (const float*)(ws + WS_SV); float* YR = (float*)(ws + WS_YRAW);
    constexpr int T = 64;
    LAS float* Lr = (LAS float*)(C.lds + RING_OFF); LAS float* Lw = Lr + T * 64; LAS float* Lk = Lw + T * 64; LAS float* Lkk = Lk + T * 64; LAS float* Lb = Lkk + T * 64;
    LAS float* Lv = Lb + T * 64; LAS float* Ly = Lv + T * 32;
    const int tid = C.tid, rl = tid >> 4, kq = tid & 15;
    const size_t rowbase = (size_t)b * SEQ; const int colh = h * 64;
    const int lt0 = tid >> 4, lc0 = (tid & 15) * 4, vt = tid >> 3, vc = (tid & 7) * 4;
    f32x4 pr[2], pw[2], pk[2], pkk[2], pb[2], pv;
#define SCAN_LOAD(t0) do { _Pragma("unroll") for (int i = 0; i < 2; ++i) { const size_t o = (rowbase + (t0) + lt0 + 32 * i) * BW + colh + lc0; \
        pr[i] = *(const f32x4*)(SR + o); pw[i] = *(const f32x4*)(SW + o); pk[i] = *(const f32x4*)(SK + o); pkk[i] = *(const f32x4*)(SKK + o); pb[i] = *(const f32x4*)(SB + o); } \
        pv = *(const f32x4*)(SV + (rowbase + (t0) + vt) * BW + colh + 32 * half + vc); } while (0)
    SCAN_LOAD(0);
    float S0 = 0.f, S1 = 0.f, S2 = 0.f, S3 = 0.f;
    for (int ch = 0; ch < SEQ / T; ++ch) {
        const int t0 = ch * T;
#pragma unroll
        for (int i = 0; i < 2; ++i) { const int lo = (lt0 + 32 * i) * 64 + lc0;
            *(LAS f32x4*)(Lr + lo) = pr[i]; *(LAS f32x4*)(Lw + lo) = pw[i]; *(LAS f32x4*)(Lk + lo) = pk[i]; *(LAS f32x4*)(Lkk + lo) = pkk[i]; *(LAS f32x4*)(Lb + lo) = pb[i]; }
        *(LAS f32x4*)(Lv + vt * 32 + vc) = pv;
        __syncthreads();
        if (ch + 1 < SEQ / T) SCAN_LOAD(t0 + T);
#pragma unroll 4
        for (int t = 0; t < T; ++t) {
            const f32x4 kk4 = *(const LAS f32x4*)(Lkk + t * 64 + kq * 4), w4 = *(const LAS f32x4*)(Lw + t * 64 + kq * 4), b4 = *(const LAS f32x4*)(Lb + t * 64 + kq * 4);
            const f32x4 k4 = *(const LAS f32x4*)(Lk + t * 64 + kq * 4), r4 = *(const LAS f32x4*)(Lr + t * 64 + kq * 4); const float v = Lv[t * 32 + rl];
            float d = (S0 * kk4.x + S1 * kk4.y) + (S2 * kk4.z + S3 * kk4.w); d = red16(d); const float sa = -d;
            S0 = S0 * w4.x + (sa * b4.x + v * k4.x); S1 = S1 * w4.y + (sa * b4.y + v * k4.y); S2 = S2 * w4.z + (sa * b4.z + v * k4.z); S3 = S3 * w4.w + (sa * b4.w + v * k4.w);
            float y = (S0 * r4.x + S1 * r4.y) + (S2 * r4.z + S3 * r4.w); y = red16(y);
            if (kq == 0) Ly[t * 32 + rl] = y;
        }
        __syncthreads();
        *(f32x4*)(YR + (rowbase + t0 + vt) * BW + colh + 32 * half + vc) = *(const LAS f32x4*)(Ly + vt * 32 + vc);
    }
#undef SCAN_LOAD
}

__device__ __forceinline__ void glds16(const void* gsrc, unsigned lds_dst) { unsigned keep;
    asm volatile("s_mov_b32 %0, m0\n\ts_mov_b32 m0, %2\n\ts_nop 0\n\tglobal_load_lds_dwordx4 %1, off\n\ts_mov_b32 m0, %0" : "=&s"(keep) : "v"(gsrc), "s"(lds_dst) : "memory"); }
__device__ __forceinline__ void glds4(const void* gsrc, unsigned lds_dst) { unsigned keep;
    asm volatile("s_mov_b32 %0, m0\n\ts_mov_b32 m0, %2\n\ts_nop 0\n\tglobal_load_lds_dword %1, off\n\ts_mov_b32 m0, %0" : "=&s"(keep) : "v"(gsrc), "s"(lds_dst) : "memory"); }
constexpr int SCAN_T = 8, SCAN_SLOT = 5 * SCAN_T * 256 + 512, SCAN_NSLOT = 3, SCAN_RING = SCAN_NSLOT * SCAN_SLOT;
typedef float f32x2 __attribute__((ext_vector_type(2)));
__device__ __forceinline__ void scan_wave(int lane, LAS unsigned char* ring, int hs, int r0, unsigned char* ws) {
    const int b = hs / 12, h = hs % 12;
    const float* SR = (const float*)(ws + WS_SR); const float* SW = (const float*)(ws + WS_SW); const float* SK = (const float*)(ws + WS_SK); const float* SU = (const float*)(ws + WS_SKK);
    const float* SB = (const float*)(ws + WS_SB); const float* SV = (const float*)(ws + WS_SV); const float* BK = (const float*)(ws + WS_BK); float* YR = (float*)(ws + WS_YRAW);
    const int rg = lane >> 4, kq = lane & 15;
    const size_t rowbase = (size_t)b * SEQ; const int colh = h * 64;
    const unsigned ring0 = (unsigned)(size_t)ring;
    const size_t voff = ((size_t)(lane >> 4)) * BW + colh + 4 * kq;
    const size_t vvoff = ((size_t)((lane & 31) >> 2)) * BW + colh + r0 + (lane & 3);
    const size_t bkoff = ((size_t)((lane & 15) >> 1) * 12 + h) * 2 + (lane & 1);
    constexpr int NCH = SEQ / SCAN_T;
#define SCAN_DMA(ch, slot) do { const int cc_ = (ch) < NCH ? (ch) : NCH - 1; const size_t tok_ = rowbase + (size_t)cc_ * SCAN_T; const unsigned sl_ = ring0 + (unsigned)(slot) * SCAN_SLOT; \
        _Pragma("unroll") for (int i_ = 0; i_ < 2; ++i_) { const size_t o_ = (tok_ + 4 * i_) * BW + voff; \
            glds16(SU + o_, sl_ + 0 * 2048 + i_ * 1024); glds16(SW + o_, sl_ + 1 * 2048 + i_ * 1024); glds16(SB + o_, sl_ + 2 * 2048 + i_ * 1024); glds16(SK + o_, sl_ + 3 * 2048 + i_ * 1024); glds16(SR + o_, sl_ + 4 * 2048 + i_ * 1024); } \
        glds4(SV + tok_ * BW + vvoff, sl_ + 10240); glds4(BK + tok_ * 24 + bkoff, sl_ + 10496); } while (0)
    SCAN_DMA(0, 0); SCAN_DMA(1, 1); SCAN_DMA(2, 2);
    f32x2 S01 = (f32x2){0.f, 0.f}, S23 = (f32x2){0.f, 0.f};
    float e_cur = 0.f, sa_prev = 0.f, v_prev = 0.f;
    int slot = 0;
    for (int ch = 0; ch < NCH; ++ch) {
        asm volatile("s_waitcnt vmcnt(24)" ::: "memory");
        const LAS unsigned char* sp = ring + slot * SCAN_SLOT;
        float ykeep = 0.f;
        f32x4 u4a[SCAN_T], w4a[SCAN_T], b4a[SCAN_T], k4a[SCAN_T], r4a[SCAN_T]; float va[SCAN_T]; f32x2 bka[SCAN_T];
#pragma unroll
        for (int tt = 0; tt < SCAN_T; ++tt) {
            u4a[tt] = *(const LAS f32x4*)(sp + 0 * 2048 + tt * 256 + kq * 16); bka[tt] = *(const LAS f32x2*)(sp + 10496 + tt * 8); va[tt] = *(const LAS float*)(sp + 10240 + tt * 16 + rg * 4);
            w4a[tt] = *(const LAS f32x4*)(sp + 1 * 2048 + tt * 256 + kq * 16); b4a[tt] = *(const LAS f32x4*)(sp + 2 * 2048 + tt * 256 + kq * 16);
            k4a[tt] = *(const LAS f32x4*)(sp + 3 * 2048 + tt * 256 + kq * 16); r4a[tt] = *(const LAS f32x4*)(sp + 4 * 2048 + tt * 256 + kq * 16); }
#pragma unroll
        for (int tt = 0; tt < SCAN_T; ++tt) {
            const f32x4 u4 = u4a[tt], w4 = w4a[tt], b4 = b4a[tt], k4 = k4a[tt], r4 = r4a[tt]; const float v = va[tt]; const f32x2 bk = bka[tt];
            f32x2 pe = S01 * (f32x2){u4.x, u4.y}; pe = S23 * (f32x2){u4.z, u4.w} + pe; const float e_next = red16(pe.x + pe.y);
            const float d = e_cur + sa_prev * bk.x + v_prev * bk.y; const float sa = -d;
            const f32x2 sav = (f32x2){sa, sa}, vv = (f32x2){v, v};
            S01 = S01 * (f32x2){w4.x, w4.y} + (sav * (f32x2){b4.x, b4.y} + vv * (f32x2){k4.x, k4.y});
            S23 = S23 * (f32x2){w4.z, w4.w} + (sav * (f32x2){b4.z, b4.w} + vv * (f32x2){k4.z, k4.w});
            f32x2 py = S01 * (f32x2){r4.x, r4.y}; py = S23 * (f32x2){r4.z, r4.w} + py; const float y = red16(py.x + py.y);
            ykeep = (kq == tt) ? y : ykeep;
            e_cur = e_next; sa_prev = sa; v_prev = v;
        }
        if (kq < SCAN_T) YR[(rowbase + (size_t)ch * SCAN_T + kq) * BW + colh + r0 + rg] = ykeep;
        SCAN_DMA(ch + 3, slot);
        slot = (slot == SCAN_NSLOT - 1) ? 0 : slot + 1;
    }
    asm volatile("s_waitcnt vmcnt(0)" ::: "memory");
#undef SCAN_DMA
}

struct AttnPass { int qcol; int bias_head; int tbl; float sink; int use_sink; int maxsteps; bf16* out; int out_ld; int out_col; float* lse; };
__device__ __forceinline__ void attn_stage_kv(const Ctx& C, const bf16* P1, int b, int res, int dil, int fblk, int kcol, int vcol) {
    LAS unsigned char* Ks = C.lds + RING_OFF; LAS unsigned char* Vs = Ks + 256 * 144;
#pragma unroll
    for (int i = 0; i < 4; ++i) { const int c = C.tid + 512 * i, row = c >> 3, part = c & 7; const int fp = (fblk - 1) * 128 + row;
        v4u kv = (v4u){0u, 0u, 0u, 0u}, vv = (v4u){0u, 0u, 0u, 0u};
        if (fp >= 0) { const bf16* src = P1 + ((size_t)b * SEQ + (size_t)fp * dil + res) * NP1; kv = *(const v4u*)(src + kcol + part * 8); vv = *(const v4u*)(src + vcol + part * 8); }
        *(LAS v4u*)(Ks + row * 144 + part * 16) = kv; *(LAS v4u*)(Vs + row * 144 + part * 16) = vv; }
}
__device__ __forceinline__ void attn_pass(const Ctx& C, const bf16* P1, const float* relb, int b, int res, int dil, int fblk, const AttnPass& ap) {
    LAS unsigned char* Ks = C.lds + RING_OFF; LAS unsigned char* Vs = Ks + 256 * 144; LAS float* lut = (LAS float*)(Vs + 256 * 144);
    __syncthreads();
    if (C.tid < 132) lut[C.tid] = (C.tid <= 128) ? relb[(int)T5B[ap.tbl][C.tid] * 20 + ap.bias_head] : 0.f;
    __syncthreads();
    const int i = C.tid >> 2, dq = C.tid & 3;
    const size_t tok = (size_t)b * SEQ + (size_t)(fblk * 128 + i) * dil + res;
    float q[16];
    { const bf16* qp = P1 + tok * NP1 + ap.qcol + dq * 16; const v4u a0 = *(const v4u*)qp, a1 = *(const v4u*)(qp + 8);
      q[0] = bflo(a0.x); q[1] = bfhi(a0.x); q[2] = bflo(a0.y); q[3] = bfhi(a0.y); q[4] = bflo(a0.z); q[5] = bfhi(a0.z); q[6] = bflo(a0.w); q[7] = bfhi(a0.w);
      q[8] = bflo(a1.x); q[9] = bfhi(a1.x); q[10] = bflo(a1.y); q[11] = bfhi(a1.y); q[12] = bflo(a1.z); q[13] = bfhi(a1.z); q[14] = bflo(a1.w); q[15] = bfhi(a1.w);
#pragma unroll
      for (int j = 0; j < 16; ++j) q[j] *= 0.125f; }
    float mrun = ap.use_sink ? ap.sink : -INFINITY, lrun = ap.use_sink ? 1.0f : 0.0f;
    float o[16];
#pragma unroll
    for (int j = 0; j < 16; ++j) o[j] = 0.f;
    const int fq0 = fblk * 128 + i;
    for (int dist = 0; dist <= ap.maxsteps; ++dist) {
        const int kr = i + 128 - dist;
        const bool valid = (fq0 - dist) >= 0;
        const v4u k0 = *(const LAS v4u*)(Ks + kr * 144 + dq * 32), k1 = *(const LAS v4u*)(Ks + kr * 144 + dq * 32 + 16);
        float s = q[0] * bflo(k0.x) + q[1] * bfhi(k0.x) + q[2] * bflo(k0.y) + q[3] * bfhi(k0.y) + q[4] * bflo(k0.z) + q[5] * bfhi(k0.z) + q[6] * bflo(k0.w) + q[7] * bfhi(k0.w)
                + q[8] * bflo(k1.x) + q[9] * bfhi(k1.x) + q[10] * bflo(k1.y) + q[11] * bfhi(k1.y) + q[12] * bflo(k1.z) + q[13] * bfhi(k1.z) + q[14] * bflo(k1.w) + q[15] * bfhi(k1.w);
        s = red4(s) + lut[dist];
        if (valid) {
            if (s > mrun) { const float c = __expf(mrun - s); lrun *= c;
#pragma unroll
                for (int j = 0; j < 16; ++j) o[j] *= c;
                mrun = s; }
            const float p = __expf(s - mrun); lrun += p;
            const v4u v0 = *(const LAS v4u*)(Vs + kr * 144 + dq * 32), v1 = *(const LAS v4u*)(Vs + kr * 144 + dq * 32 + 16);
            o[0] += p * bflo(v0.x); o[1] += p * bfhi(v0.x); o[2] += p * bflo(v0.y); o[3] += p * bfhi(v0.y); o[4] += p * bflo(v0.z); o[5] += p * bfhi(v0.z); o[6] += p * bflo(v0.w); o[7] += p * bfhi(v0.w);
            o[8] += p * bflo(v1.x); o[9] += p * bfhi(v1.x); o[10] += p * bflo(v1.y); o[11] += p * bfhi(v1.y); o[12] += p * bflo(v1.z); o[13] += p * bfhi(v1.z); o[14] += p * bflo(v1.w); o[15] += p * bfhi(v1.w);
        }
    }
    const float inv = 1.0f / lrun;
    v4u w0, w1;
    w0.x = pk2(o[0] * inv, o[1] * inv); w0.y = pk2(o[2] * inv, o[3] * inv); w0.z = pk2(o[4] * inv, o[5] * inv); w0.w = pk2(o[6] * inv, o[7] * inv);
    w1.x = pk2(o[8] * inv, o[9] * inv); w1.y = pk2(o[10] * inv, o[11] * inv); w1.z = pk2(o[12] * inv, o[13] * inv); w1.w = pk2(o[14] * inv, o[15] * inv);
    bf16* op = ap.out + tok * ap.out_ld + ap.out_col + dq * 16;
    *(v4u*)op = w0; *(v4u*)(op + 8) = w1;
    if (ap.lse && dq == 0) ap.lse[tok * 4] = mrun + __logf(lrun);
}
__device__ __forceinline__ void phase_attn(const Ctx& C, const Args& a, int l, unsigned char* ws, int ab, int nab) {
    const bf16* P1 = (const bf16*)(ws + WS_P1); const float* relb = a.in[1]; const float* sinks = a.in[4] + l * 8;
    bf16* YA = (bf16*)(ws + WS_YA); bf16* OC = (bf16*)(ws + WS_OC); float* LSE = (float*)(ws + WS_LSE);
    constexpr int NA = 256, NC = 1536;
    for (int it = ab; it < NA + NC; it += nab) {
        __syncthreads();
        if (it < NA) {
            const int b = it >> 7, fblk = (it >> 1) & 63, hkv = it & 1;
            attn_stage_kv(C, P1, b, 0, 1, fblk, C_AK + hkv * 64, C_AV + hkv * 64);
            for (int g = 0; g < 4; ++g) { const int hq = hkv * 4 + g;
                AttnPass ap; ap.qcol = C_AQ + hq * 64; ap.bias_head = hq; ap.tbl = 0; ap.sink = sinks[hq]; ap.use_sink = 1; ap.maxsteps = 127; ap.out = YA; ap.out_ld = 512; ap.out_col = hq * 64; ap.lse = nullptr;
                attn_pass(C, P1, relb, b, 0, 1, fblk, ap); }
        } else {
            const int ci = it - NA; const int gi = ci / 512, j = (ci >> 7) & 3, qb = ci & 127;
            const int dil = (gi == 0) ? 1 : (gi == 1 ? 4 : 16); const int bps = 64 / dil;
            const int n = qb / bps, fblk = qb % bps, b = n / dil, res = n % dil; const int hc = gi * 4 + j;
            attn_stage_kv(C, P1, b, res, dil, fblk, C_CK + hc * 64, C_CV + hc * 64);
            AttnPass ap; ap.qcol = C_CQ + hc * 64; ap.bias_head = 8 + hc; ap.tbl = gi; ap.sink = 0.f; ap.use_sink = 0; ap.maxsteps = 128; ap.out = OC + (size_t)gi * M * 256; ap.out_ld = 256; ap.out_col = j * 64;
            ap.lse = LSE + (size_t)gi * M * 4 + j;
            attn_pass(C, P1, relb, b, res, dil, fblk, ap);
        }
    }
}

__device__ __forceinline__ void phase_vt(const Ctx& C, unsigned char* ws) {
    const bf16* P1 = (const bf16*)(ws + WS_P1); bf16* VT = (bf16*)(ws + WS_VT);
    for (int it = C.gw; it < 14 * 2 * 128; it += C.ngw) {
        const int hs = it / 256, b = (it >> 7) & 1, blk = it & 127;
        const int gi = hs < 2 ? 0 : (hs - 2) >> 2; const int dil = gi == 0 ? 1 : (gi == 1 ? 4 : 16); const int Lf = SEQ / dil;
        const int vcol = hs < 2 ? C_AV + hs * 64 : C_CV + (hs - 2) * 64;
        const int ft = blk * 64 + C.lane;
        const int res = ft / Lf, tp = ft % Lf; const int tok = b * SEQ + tp * dil + res;
        const v4u* src = (const v4u*)(P1 + (size_t)tok * NP1 + vcol);
        v4u x[8];
#pragma unroll
        for (int i = 0; i < 8; ++i) x[i] = src[i];
        bf16* dst = VT + ((size_t)(hs * 2 + b) * 64) * SEQ + ft;
#pragma unroll
        for (int i = 0; i < 8; ++i) {
            dst[(size_t)(8 * i + 0) * SEQ] = (bf16)(x[i].x & 0xffffu); dst[(size_t)(8 * i + 1) * SEQ] = (bf16)(x[i].x >> 16);
            dst[(size_t)(8 * i + 2) * SEQ] = (bf16)(x[i].y & 0xffffu); dst[(size_t)(8 * i + 3) * SEQ] = (bf16)(x[i].y >> 16);
            dst[(size_t)(8 * i + 4) * SEQ] = (bf16)(x[i].z & 0xffffu); dst[(size_t)(8 * i + 5) * SEQ] = (bf16)(x[i].z >> 16);
            dst[(size_t)(8 * i + 6) * SEQ] = (bf16)(x[i].w & 0xffffu); dst[(size_t)(8 * i + 7) * SEQ] = (bf16)(x[i].w >> 16);
        }
    }
}

typedef float f32x16 __attribute__((ext_vector_type(16)));
constexpr int LUT_OFF = 0, SCANRING_OFF = 12288, CONV_SCR_SCAN = 77824, CONV_SCR_OTHER = 12288;
__device__ __forceinline__ void attn_wave_item(int lane, const LAS float* lutall, int item, const float* sinks, unsigned char* ws) {
    const bf16* P1 = (const bf16*)(ws + WS_P1); const bf16* VT = (const bf16*)(ws + WS_VT);
    const int hh = item % 20, g32 = item / 20;
    const bool isA = hh < 8; const int hc = hh - 8; const int gi = isA ? 0 : hc >> 2, j = hc & 3;
    const int dil = gi == 0 ? 1 : (gi == 1 ? 4 : 16); const int Lf = SEQ / dil, gps = Lf / 32;
    const int b = g32 >> 8, rr = g32 & 255, res = rr / gps, qg = rr % gps, fq0 = qg * 32;
    const int qcol = isA ? C_AQ + hh * 64 : C_CQ + hc * 64, kcol = isA ? C_AK + (hh >> 2) * 64 : C_CK + hc * 64;
    const int hs = isA ? (hh >> 2) : 2 + hc; const int maxsteps = isA ? 127 : 128;
    const LAS float* lut = lutall + hh * 132;
    const int r = lane & 31, hf = lane >> 5;
    const size_t tokq = (size_t)b * SEQ + (size_t)(fq0 + r) * dil + res;
    pg8::bf16x8 qf[4];
    { const bf16* qrow = P1 + tokq * NP1 + qcol + 8 * hf;
#pragma unroll
      for (int s_ = 0; s_ < 4; ++s_) qf[s_] = *(const pg8::bf16x8*)(qrow + 16 * s_); }
    f32x16 sc[5];
#pragma unroll
    for (int kt = 0; kt < 5; ++kt) {
        int fk = fq0 - 128 + 32 * kt + r; fk = fk < 0 ? 0 : fk;
        const bf16* krow = P1 + ((size_t)b * SEQ + (size_t)fk * dil + res) * NP1 + kcol + 8 * hf;
        f32x16 acc;
#pragma unroll
        for (int q = 0; q < 16; ++q) acc[q] = 0.f;
#pragma unroll
        for (int s_ = 0; s_ < 4; ++s_) { const pg8::bf16x8 a = *(const pg8::bf16x8*)(krow + 16 * s_); acc = __builtin_amdgcn_mfma_f32_32x32x16_bf16(a, qf[s_], acc, 0, 0, 0); }
        sc[kt] = acc;
    }
    float mx = -1e30f;
#pragma unroll
    for (int kt = 0; kt < 5; ++kt)
#pragma unroll
        for (int q = 0; q < 16; ++q) {
            const int rowoff = (q & 3) + 8 * (q >> 2) + 4 * hf; const int dist = 128 + r - 32 * kt - rowoff; const int fk = fq0 + r - dist;
            const bool valid = dist >= 0 && dist <= maxsteps && fk >= 0;
            const int di = dist < 0 ? 0 : (dist > 128 ? 128 : dist);
            const float sv = valid ? sc[kt][q] * 0.125f + lut[di] : -1e30f;
            sc[kt][q] = sv; mx = fmaxf(mx, sv);
        }
    mx = fmaxf(mx, __shfl_xor(mx, 32));
    const float sink = isA ? sinks[hh] : -1e30f;
    mx = fmaxf(mx, sink);
    float lsum = 0.f;
#pragma unroll
    for (int kt = 0; kt < 5; ++kt)
#pragma unroll
        for (int q = 0; q < 16; ++q) { const float pv = __expf(sc[kt][q] - mx); sc[kt][q] = pv; lsum += pv; }
    lsum += __shfl_xor(lsum, 32);
    const float denom = isA ? lsum + __expf(sink - mx) : lsum;
    const float inv = 1.0f / denom;
    pg8::bf16x8 pf[5][2];
#pragma unroll
    for (int kt = 0; kt < 5; ++kt)
#pragma unroll
        for (int s_ = 0; s_ < 2; ++s_) { pg8::u32x4 w;
            w.x = pg8::cvt_pk_bf16(sc[kt][8 * s_ + 0], sc[kt][8 * s_ + 1]); w.y = pg8::cvt_pk_bf16(sc[kt][8 * s_ + 2], sc[kt][8 * s_ + 3]);
            w.z = pg8::cvt_pk_bf16(sc[kt][8 * s_ + 4], sc[kt][8 * s_ + 5]); w.w = pg8::cvt_pk_bf16(sc[kt][8 * s_ + 6], sc[kt][8 * s_ + 7]);
            pf[kt][s_] = __builtin_bit_cast(pg8::bf16x8, w); }
    bf16* outp; int out_ld, ocol;
    if (isA) { outp = (bf16*)(ws + WS_YA); out_ld = 512; ocol = hh * 64; } else { outp = (bf16*)(ws + WS_OC) + (size_t)gi * M * 256; out_ld = 256; ocol = j * 64; }
    const bf16* vth = VT + ((size_t)(hs * 2 + b) * 64) * SEQ + (size_t)res * Lf;
#pragma unroll
    for (int dt = 0; dt < 2; ++dt) {
        const bf16* vrow = vth + (size_t)(32 * dt + r) * SEQ;
        f32x16 acc;
#pragma unroll
        for (int q = 0; q < 16; ++q) acc[q] = 0.f;
#pragma unroll
        for (int kt = 0; kt < 5; ++kt)
#pragma unroll
            for (int s_ = 0; s_ < 2; ++s_) {
                int k0 = fq0 - 128 + 32 * kt + 16 * s_ + 4 * hf, k1 = k0 + 8; k0 = k0 < 0 ? 0 : k0; k1 = k1 < 0 ? 0 : k1;
                const v2u lo = *(const v2u*)(vrow + k0), hi = *(const v2u*)(vrow + k1);
                pg8::u32x4 w; w.x = lo.x; w.y = lo.y; w.z = hi.x; w.w = hi.y;
                acc = __builtin_amdgcn_mfma_f32_32x32x16_bf16(__builtin_bit_cast(pg8::bf16x8, w), pf[kt][s_], acc, 0, 0, 0);
            }
        bf16* op = outp + tokq * out_ld + ocol + 32 * dt + 4 * hf;
#pragma unroll
        for (int g = 0; g < 4; ++g) { v2u w; w.x = pg8::cvt_pk_bf16(acc[4 * g + 0] * inv, acc[4 * g + 1] * inv); w.y = pg8::cvt_pk_bf16(acc[4 * g + 2] * inv, acc[4 * g + 3] * inv);
            *(v2u*)(op + 8 * g) = w; }
    }
    if (!isA && hf == 0) ((float*)(ws + WS_LSE))[((size_t)gi * M + tokq) * 4 + j] = mx + __logf(lsum);
}
__device__ __forceinline__ void build_lut(const Ctx& C, const float* relb) {
    LAS float* lut = (LAS float*)(C.lds + LUT_OFF);
    for (int i = C.tid; i < 20 * 132; i += NTHREADS) { const int hh = i / 132, d = i % 132; const int tbl = hh < 8 ? 0 : (hh - 8) >> 2;
        lut[i] = (d <= 128) ? relb[(int)T5B[tbl][d] * 20 + hh] : 0.f; }
    __syncthreads();
}

__device__ __forceinline__ void phase_post(const Ctx& C, const Args& a, int l, unsigned char* ws) {
    const float* YR = (const float*)(ws + WS_YRAW); const float* SR = (const float*)(ws + WS_SR); const float* SK = (const float*)(ws + WS_SK); const float* SV = (const float*)(ws + WS_SV);
    const float* LO = (const float*)(ws + WS_LO); bf16* YB = (bf16*)(ws + WS_YB);
    const float* rkp = a.in[13] + (size_t)l * BW; const float* lgp = a.in[14] + (size_t)l * BW; const float* lbp = a.in[15] + (size_t)l * BW;
    constexpr int TB = 8;
    for (int it = C.gw; it < (M / TB) * 12; it += C.ngw) {
        const int tb = it / 12, h = it % 12, hc = h * 64 + C.lane, m0 = tb * TB;
        const float rk = rkp[hc], lg = lgp[hc], lb = lbp[hc];
        float y[TB], bo[TB], vv[TB], gg[TB];
#pragma unroll
        for (int i = 0; i < TB; ++i) { const size_t o = (size_t)(m0 + i) * BW + hc; y[i] = YR[o]; bo[i] = SR[o] * SK[o] * rk; vv[i] = SV[o]; gg[i] = LO[(size_t)(m0 + i) * NLORA + 2 * BW + hc]; }
        float mean[TB], var[TB];
#pragma unroll
        for (int i = 0; i < TB; ++i) { mean[i] = wsum(y[i]) * (1.0f / 64.0f); bo[i] = wsum(bo[i]); }
#pragma unroll
        for (int i = 0; i < TB; ++i) { y[i] -= mean[i]; var[i] = wsum(y[i] * y[i]) * (1.0f / 64.0f); }
#pragma unroll
        for (int i = 0; i < TB; ++i) { float yn = y[i] * (1.0f / sqrtf(var[i] + GN_EPS)) * lg + lb; yn += bo[i] * vv[i]; yn *= gg[i]; YB[(size_t)(m0 + i) * BW + hc] = (bf16)f2bf(yn); }
    }
    const bf16* OC = (const bf16*)(ws + WS_OC); const float* LSE = (const float*)(ws + WS_LSE); bf16* YC = (bf16*)(ws + WS_YC);
    for (int mb = C.gw * 4; mb < M; mb += C.ngw * 4) {
        const int j = C.lane >> 4;
        float l0[4], l1[4], l2[4]; v2u a0[4], a1[4], a2[4];
#pragma unroll
        for (int i = 0; i < 4; ++i) { const int m = mb + i; l0[i] = LSE[(size_t)m * 4 + j]; l1[i] = LSE[((size_t)M + m) * 4 + j]; l2[i] = LSE[((size_t)2 * M + m) * 4 + j];
            a0[i] = *(const v2u*)(OC + (size_t)m * 256 + 4 * C.lane); a1[i] = *(const v2u*)(OC + ((size_t)M + m) * 256 + 4 * C.lane); a2[i] = *(const v2u*)(OC + ((size_t)2 * M + m) * 256 + 4 * C.lane); }
#pragma unroll
        for (int i = 0; i < 4; ++i) { const int m = mb + i;
            const float mx = fmaxf(l0[i], fmaxf(l1[i], l2[i])); const float e0 = __expf(l0[i] - mx), e1 = __expf(l1[i] - mx), e2 = __expf(l2[i] - mx); const float inv = 1.0f / (e0 + e1 + e2);
            const float w0 = e0 * inv, w1 = e1 * inv, w2 = e2 * inv;
            v2u o; o.x = pk2(w0 * bflo(a0[i].x) + w1 * bflo(a1[i].x) + w2 * bflo(a2[i].x), w0 * bfhi(a0[i].x) + w1 * bfhi(a1[i].x) + w2 * bfhi(a2[i].x));
            o.y = pk2(w0 * bflo(a0[i].y) + w1 * bflo(a1[i].y) + w2 * bflo(a2[i].y), w0 * bfhi(a0[i].y) + w1 * bfhi(a1[i].y) + w2 * bfhi(a2[i].y));
            *(v2u*)(YC + (size_t)m * 256 + 4 * C.lane) = o; }
    }
}

__device__ __forceinline__ void unpack8(const v4u w, float (&x)[8]) { x[0] = bflo(w.x); x[1] = bfhi(w.x); x[2] = bflo(w.y); x[3] = bfhi(w.y); x[4] = bflo(w.z); x[5] = bfhi(w.z); x[6] = bflo(w.w); x[7] = bfhi(w.w); }
__device__ __forceinline__ void phase_conv(const Ctx& C, const Args& a, int l, unsigned char* ws) {
    const bf16* U = (const bf16*)(ws + WS_U); bf16* ACT = (bf16*)(ws + WS_ACT); const float* cw = a.in[22] + (size_t)l * 3 * DFF;
    constexpr int GPR = DFF / 8, RUN = 32;
    const int gt = C.bid * NTHREADS + C.tid, ngt = C.G * NTHREADS;
    for (int idx = gt; idx < (M / RUN) * GPR; idx += ngt) {
        const int run = idx / GPR, f0 = (idx % GPR) * 8, m0 = run * RUN;
        float c0[8], c1[8], c2[8];
#pragma unroll
        for (int j = 0; j < 8; ++j) { c0[j] = cw[f0 + j]; c1[j] = cw[DFF + f0 + j]; c2[j] = cw[2 * DFF + f0 + j]; }
        const bf16* ur = U + (size_t)m0 * NUP + f0;
        float x0[8], x1[8];
        { v4u g0 = (v4u){0u, 0u, 0u, 0u}, g1 = (v4u){0u, 0u, 0u, 0u};
          if ((m0 & (SEQ - 1)) != 0) { g0 = *(const v4u*)(ur - 2 * NUP); g1 = *(const v4u*)(ur - NUP); }
          unpack8(g0, x0); unpack8(g1, x1); }
#pragma unroll 1
        for (int tq = 0; tq < RUN; tq += 4) {
            v4u gq[4], vq[4];
#pragma unroll
            for (int i = 0; i < 4; ++i) { gq[i] = *(const v4u*)(ur + (size_t)(tq + i) * NUP); vq[i] = *(const v4u*)(ur + (size_t)(tq + i) * NUP + DFF); }
#pragma unroll
            for (int i = 0; i < 4; ++i) {
                float x2[8], vl[8], r[8]; unpack8(gq[i], x2); unpack8(vq[i], vl);
#pragma unroll
                for (int j = 0; j < 8; ++j) { const float gsum = c0[j] * x0[j] + c1[j] * x1[j] + c2[j] * x2[j]; r[j] = gsum / (1.0f + __expf(-gsum)) * vl[j]; x0[j] = x1[j]; x1[j] = x2[j]; }
                v4u o; o.x = pk2(r[0], r[1]); o.y = pk2(r[2], r[3]); o.z = pk2(r[4], r[5]); o.w = pk2(r[6], r[7]);
                *(v4u*)(ACT + (size_t)(m0 + tq + i) * DFF + f0) = o;
            }
        }
    }
}

__device__ __forceinline__ Ctx make_ctx(unsigned char* lds) {
    Ctx C;
    C.lds = (LAS unsigned char*)lds;
    int t = threadIdx.x; asm volatile("" : "+v"(t));
    C.tid = t; C.lane = C.tid & 63; C.wave = __builtin_amdgcn_readfirstlane(C.tid >> 6);
    C.G = gridDim.x; C.bid = blockIdx.x; C.gw = C.bid * NWAVES + C.wave; C.ngw = C.G * NWAVES;
    return C;
}
template <int K> __device__ __forceinline__ void run_phase(unsigned char* lds, const Args& args, int l) {
    const Ctx C = make_ctx(lds);
    unsigned char* ws = args.ws; asm volatile("" : "+s"(ws)); unsigned char* wsw = ws + (size_t)(l & 1) * WSET_STRIDE; LAS unsigned char* ring = C.lds + RING_OFF; float* out = args.out;
    const float* xsrc = (l == 0) ? args.in[0] : out;
    if constexpr (K == 0) { phase_prep(C, args, l, xsrc, ws); }
    if constexpr (K == 1) { pg8::Gemm g{(const bf16*)(ws + WS_H), (const bf16*)(wsw + WS_WIN), M, NP1, D}; pg8::StaticOrder S; S.init(M, NP1, C.G, C.bid);
        pg8::EpiWin E{(bf16*)(ws + WS_P1), (bf16*)(ws + WS_G), 0};
        pg8::gemm_phase<pg8::EpiWin, pg8::StaticOrder, true, true>(ring, g, S, E); }
    if constexpr (K == 2) { phase_aprime(C, args, l, ws); phase_vt(C, ws); }
    if constexpr (K == 3) { pg8::Gemm g{(const bf16*)(ws + WS_AP), (const bf16*)(wsw + WS_WLORA), M, NLORA, KLORA}; pg8::StaticOrder S; S.init(M, NLORA, C.G, C.bid);
        pg8::EpiF32P E{(float*)(ws + WS_LO), NLORA};
        pg8::gemm_phase<pg8::EpiF32P, pg8::StaticOrder, true, true>(ring, g, S, E); }
    if constexpr (K == 4) { phase_scanprep(C, args, l, ws); }
    if constexpr (K == 5) {
        const int xg = C.bid & 7, jj = C.bid >> 3;
        if (jj < 12) {
            if (C.wave < 4) { for (int rep = 0; rep < EXP_SCAN_REPS; ++rep) scan_wave(C.lane, C.lds + SCANRING_OFF + C.wave * SCAN_RING, xg * 3 + (jj >> 2), ((jj & 3) * 4 + C.wave) * 4, ws); }
        } else {
            const int gidx = (jj - 12) * 8 + xg;
            build_lut(C, args.in[1]);
            { const float* sinks = args.in[4] + l * 8;
              for (int rep = 0; rep < EXP_ATTN_REPS; ++rep) for (int it = gidx * 8 + C.wave; it < 512 * 20; it += 1280) attn_wave_item(C.lane, (const LAS float*)(C.lds + LUT_OFF), it, sinks, ws); }
            __syncthreads();
            { pg8::Gemm g{(const bf16*)(ws + WS_H), (const bf16*)(wsw + WS_WIN) + (size_t)NP1 * D, M, NG, D}; pg8::StaticOrder S; S.init(M, NG, 160, gidx);
              pg8::EpiWin E{(bf16*)(ws + WS_P1), (bf16*)(ws + WS_G), 23};
              pg8::gemm_phase<pg8::EpiWin, pg8::StaticOrder, true, true>(ring, g, S, E); }
            if (l + 1 < DEPTH) convert_weights(gidx * 8 + C.wave, 1280, C.lane, (LAS float*)(C.lds + RING_OFF + C.wave * 16384), args, l + 1, ws);
        } }
    if constexpr (K == 6) { phase_post(C, args, l, ws); }
    if constexpr (K == 7) {
        { pg8::Gemm g{(const bf16*)(ws + WS_YA), (const bf16*)(wsw + WS_PA), M, D, 512}; pg8::StaticOrder S; S.init(M, D, C.G, C.bid);
          pg8::EpiGate<false> E{(const bf16*)(ws + WS_G), 0, (bf16*)(ws + WS_MG)};
          pg8::gemm_phase<pg8::EpiGate<false>, pg8::StaticOrder, true, true>(ring, g, S, E); }
        { pg8::Gemm g{(const bf16*)(ws + WS_YB), (const bf16*)(wsw + WS_PB), M, D, 768}; pg8::StaticOrder S; S.init(M, D, C.G, C.bid);
          pg8::EpiGate<true> E{(const bf16*)(ws + WS_G), 2048, (bf16*)(ws + WS_MG)};
          pg8::gemm_phase<pg8::EpiGate<true>, pg8::StaticOrder, true, true>(ring, g, S, E); }
        { pg8::Gemm g{(const bf16*)(ws + WS_YC), (const bf16*)(wsw + WS_PC), M, D, 256}; pg8::StaticOrder S; S.init(M, D, C.G, C.bid);
          pg8::EpiGate<true> E{(const bf16*)(ws + WS_G), 4096, (bf16*)(ws + WS_MG)};
          pg8::gemm_phase<pg8::EpiGate<true>, pg8::StaticOrder, true, true>(ring, g, S, E); } }
    if constexpr (K == 8) { pg8::Gemm g{(const bf16*)(ws + WS_MG), (const bf16*)(wsw + WS_WOUT), M, D, D}; pg8::StaticOrder S; S.init(M, D, C.G, C.bid);
        pg8::EpiResid E{xsrc, out};
        pg8::gemm_phase<pg8::EpiResid, pg8::StaticOrder, true, true>(ring, g, S, E); }
    if constexpr (K == 9) { const float* g2 = args.in[20] + (size_t)l * D; bf16* H = (bf16*)(ws + WS_H);
        for (int m = 2 * C.gw; m < M; m += 2 * C.ngw) rms_row2_bf16(out + (size_t)m * D, g2, H + (size_t)m * D, C.lane); }
    if constexpr (K == 10) { pg8::Gemm g{(const bf16*)(ws + WS_H), (const bf16*)(wsw + WS_WUP), M, NUP, D}; pg8::StaticOrder S; S.init(M, NUP, C.G, C.bid);
        pg8::EpiBf16P E{(bf16*)(ws + WS_U), NUP};
        pg8::gemm_phase<pg8::EpiBf16P, pg8::StaticOrder, true, true>(ring, g, S, E); }
    if constexpr (K == 11) { phase_conv(C, args, l, ws); }
    if constexpr (K == 12) { pg8::Gemm g{(const bf16*)(ws + WS_ACT), (const bf16*)(wsw + WS_WDOWN), M, D, DFF}; pg8::StaticOrder S; S.init(M, D, C.G, C.bid);
        pg8::EpiResid E{out, out};
        pg8::gemm_phase<pg8::EpiResid, pg8::StaticOrder, true, true>(ring, g, S, E); }
    if constexpr (K == 13) { const float* gf = args.in[24];
        for (int m = C.gw; m < M; m += C.ngw) rms_row_f32(out + (size_t)m * D, gf, C.lane); }
}
template <int K> __global__ void __launch_bounds__(NTHREADS, 2) fwd_phase(Args args) {
    extern __shared__ __attribute__((aligned(16))) unsigned char lds[];
    run_phase<K>(lds, args, args.li);
}
#ifndef EXP_BAR_REPS
#define EXP_BAR_REPS 1
#endif
#define XBAR(b) do { for (int r_ = 0; r_ < EXP_BAR_REPS; ++r_) xcd_barrier(b); } while (0)
__global__ void __launch_bounds__(NTHREADS, 2) fwd_all(Args args) {
    extern __shared__ __attribute__((aligned(16))) unsigned char lds[];
    { LAS unsigned* ctlw = (LAS unsigned*)((LAS unsigned char*)lds + LDSCTL_OFF); for (int u = threadIdx.x; u < (LDS_BYTES - LDSCTL_OFF) / 4; u += NTHREADS) ctlw[u] = 0u; }
    __syncthreads();
    const XcdBarrier bar = xcd_barrier_post((unsigned*)(args.ws + WS_CTL) + CW_BAR, (volatile LAS unsigned*)((LAS unsigned char*)lds + MISC_OFF) + 8);
    for (int l = 0; l < DEPTH; ++l) {
        for (int rep = 0; rep < (((EXP_EW_MASK >> 0) & 1) ? 2 : 1); ++rep) { run_phase<0>(lds, args, l); XBAR(bar); }
        for (int rep = 0; rep < EXP_G1_REPS; ++rep) { run_phase<1>(lds, args, l); XBAR(bar); }
        for (int rep = 0; rep < (((EXP_EW_MASK >> 2) & 1) ? 2 : 1); ++rep) { run_phase<2>(lds, args, l); XBAR(bar); }
        run_phase<3>(lds, args, l); XBAR(bar);
        for (int rep = 0; rep < (((EXP_EW_MASK >> 4) & 1) ? 2 : 1); ++rep) { run_phase<4>(lds, args, l); XBAR(bar); }
        run_phase<5>(lds, args, l); XBAR(bar);
        for (int rep = 0; rep < (((EXP_EW_MASK >> 6) & 1) ? 2 : 1); ++rep) { run_phase<6>(lds, args, l); XBAR(bar); }
        run_phase<7>(lds, args, l); XBAR(bar);
        run_phase<8>(lds, args, l); XBAR(bar);
        for (int rep = 0; rep < (((EXP_EW_MASK >> 9) & 1) ? 2 : 1); ++rep) { run_phase<9>(lds, args, l); XBAR(bar); }
        run_phase<10>(lds, args, l); XBAR(bar);
        for (int rep = 0; rep < (((EXP_EW_MASK >> 11) & 1) ? 2 : 1); ++rep) { run_phase<11>(lds, args, l); XBAR(bar); }
        run_phase<12>(lds, args, l); XBAR(bar);
    }
    run_phase<13>(lds, args, 0);
}

#ifndef MK_ONE_LAUNCH
#define MK_ONE_LAUNCH 1
#endif
template <int K> static void launch_phase(int grid, hipStream_t stream, Args a, int l) {
    static bool attr = false; if (!attr) { (void)hipFuncSetAttribute((const void*)fwd_phase<K>, hipFuncAttributeMaxDynamicSharedMemorySize, LDS_BYTES); attr = true; }
    a.li = l; a.ph_lo = K; a.ph_hi = K + 1;
    hipLaunchKernelGGL(fwd_phase<K>, dim3(grid), dim3(NTHREADS), LDS_BYTES, stream, a);
}
extern "C" void kernel_launch(void* const* d_in, const int* in_sizes, int n_in, void* d_out, int out_size, void* d_ws, size_t ws_size, hipStream_t stream) {
    static int grid = 0;
    if (grid == 0) {
        if (n_in != 25 || in_sizes[0] != M * D || out_size != M * D || ws_size < WS_END) { fprintf(stderr, "kernel_launch: unexpected shapes (n_in %d, in0 %d, out %d, ws %zu < %zu)\n", n_in, n_in > 0 ? in_sizes[0] : -1, out_size, ws_size, (size_t)WS_END); grid = -1; return; }
        int dev = 0, cus = 0;
        if (hipGetDevice(&dev) != hipSuccess || hipDeviceGetAttribute(&cus, hipDeviceAttributeMultiprocessorCount, dev) != hipSuccess) { grid = -1; return; }
        grid = cus;
    }
    if (grid < 0) return;
    (void)hipMemsetAsync((char*)d_ws + WS_CTL, 0, CTL_ZERO_BYTES, stream);
    Args a{};
    for (int i = 0; i < 25; ++i) a.in[i] = (const float*)d_in[i];
    a.out = (float*)d_out; a.ws = (unsigned char*)d_ws; a.pad = 0;
#if MK_ONE_LAUNCH
    { static bool attr = false; if (!attr) { (void)hipFuncSetAttribute((const void*)fwd_all, hipFuncAttributeMaxDynamicSharedMemorySize, LDS_BYTES); attr = true; }
      a.li = 0; a.ph_lo = 0; a.ph_hi = NPHASES;
      hipLaunchKernelGGL(fwd_all, dim3(grid), dim3(NTHREADS), LDS_BYTES, stream, a); }
#else
    for (int l = 0; l < DEPTH; ++l) {
        launch_phase<0>(grid, stream, a, l); launch_phase<1>(grid, stream, a, l); launch_phase<2>(grid, stream, a, l); launch_phase<3>(grid, stream, a, l);
        launch_phase<4>(grid, stream, a, l); launch_phase<5>(grid, stream, a, l); launch_phase<6>(grid, stream, a, l); launch_phase<7>(grid, stream, a, l);
        launch_phase<8>(grid, stream, a, l); launch_phase<9>(grid, stream, a, l); launch_phase<10>(grid, stream, a, l); launch_phase<11>(grid, stream, a, l);
        launch_phase<12>(grid, stream, a, l);
    }
    launch_phase<13>(grid, stream, a, 0);
#endif
}
```

```cpp
#include <hip/hip_runtime.h>
#include <cstdio>
#include <cstdint>
#include <cmath>
#define GAS __attribute__((address_space(1)))
#define LAS __attribute__((address_space(3)))
namespace pg8 {
#define PG8_LAS __attribute__((address_space(3)))
typedef unsigned short bf16_t;
typedef short bf16x8 __attribute__((ext_vector_type(8)));
typedef float f32x4 __attribute__((ext_vector_type(4)));
typedef unsigned u32x4 __attribute__((ext_vector_type(4)));
constexpr int BM = 256, BK = 64, HALF = 128, HTB = HALF * BK * 2  , STAGE_BYTES = 8 * HTB, NXCD = 8, WGM = 8;

__host__ __device__ __forceinline__ int lds_byte(int r, int c) { const int st = (r >> 4) * 2 + (c >> 5), rr = r & 15, cc = c & 31, ob = rr * 64 + cc * 2; return st * 1024 + (ob ^ (((ob >> 9) & 1) << 5)); }
__host__ __device__ __forceinline__ void stage_rc(int b, int& R, int& C) { const int st = b / 1024, sb = b % 1024, swz = sb ^ (((sb >> 9) & 1) << 5); R = (st >> 1) * 16 + swz / 64; C = (st & 1) * 32 + (swz % 64) / 2; }
__host__ __device__ __forceinline__ int perm32(int rho) { const int n = rho >> 4, i = rho & 15; return 8 * (i >> 2) + 4 * n + (i & 3); }

struct Unit { int pm, pn; };
struct Gemm { const bf16_t* A; const bf16_t* Bt; int M, N, K; };

struct StaticOrder {
    int nM, nN, nwg, G, c;
    __host__ __device__ void init(int M, int N, int G_, int c_) { nM = M / BM; nN = N / BM; nwg = nM * nN; G = G_; c = c_; }
    __host__ __device__ bool next(int i, Unit& u) const {
        const long L = (long)i * G + c; if (L >= nwg) return false;
        int wgid = (int)L; { const int q = nwg / NXCD, r = nwg % NXCD, xcd = wgid % NXCD, off = wgid / NXCD; wgid = (xcd < r ? xcd * (q + 1) : r * (q + 1) + (xcd - r) * q) + off; }
        const int nig = WGM * nN, gid = wgid / nig, fm = gid * WGM, gsz = (nM - fm) < WGM ? (nM - fm) : WGM;
        u.pm = fm + ((wgid % nig) % gsz); u.pn = (wgid % nig) / gsz; return true;
    }
    __device__ __forceinline__ void a_ready(const Unit&) const {}
    __device__ __forceinline__ void done(const Unit&) const {}
};
__device__ __forceinline__ unsigned cvt_pk_bf16(float lo, float hi) { unsigned r; asm volatile("v_cvt_pk_bf16_f32 %0, %1, %2" : "=v"(r) : "v"(lo), "v"(hi)); return r; }
template <class Epi, class Sched, bool ALIGN_EPI = false, bool SP2 = false>
__device__ __forceinline__ void gemm_phase(PG8_LAS unsigned char* lds, const Gemm g, const Sched& S, const Epi& E) {
    int tid_ = threadIdx.x; asm volatile("" : "+v"(tid_));
    const int tid = tid_, wid = __builtin_amdgcn_readfirstlane(tid >> 6), lane = tid & 63, wr = wid >> 2, wc = wid & 3, fr = lane & 15, fq = lane >> 4;
    const int K = g.K, nt = K / BK;
    unsigned voffA[2], voffB[2];
#pragma unroll
    for (int i = 0; i < 2; ++i) { int R, C; stage_rc(tid * 16 + i * 8192, R, C); const int Rb = Epi::PERM ? ((R & ~31) + perm32(R & 31)) : R;
        voffA[i] = (unsigned)(R * K + C) * 2u; voffB[i] = (unsigned)(Rb * K + C) * 2u; }
    const size_t kstep = (size_t)(BK * 2);
    const size_t hstep = (size_t)HALF * K * 2;
    const size_t tstep = 2 * hstep;
    const size_t tstepA = (size_t)Epi::A_ROWS * K * 2;
    const unsigned ldsw = (unsigned)wid * 1024u;
    const int aoff = lds_byte(wr * 64 + fr, fq * 8), boff = lds_byte(wc * 32 + fr, fq * 8);
#define PG8_SA(b, h) (((b) * 2 + (h)) * HTB)
#define PG8_SB(b, h) ((4 + (b) * 2 + (h)) * HTB)
#define PG8_STAGE(bufoff, gbase, voff) do { _Pragma("unroll") for (int _i = 0; _i < 2; ++_i) \
        __builtin_amdgcn_global_load_lds((const unsigned*)((const char*)(gbase) + (voff)[_i]), (PG8_LAS unsigned*)(lds + (bufoff) + ldsw + _i * 8192), 16, 0, 0); } while (0)
#define PG8_LDA(dst, b, h) do { _Pragma("unroll") for (int m = 0; m < 4; ++m) _Pragma("unroll") for (int k = 0; k < 2; ++k) dst[m][k] = *(const PG8_LAS bf16x8*)(lds + PG8_SA(b, h) + aoff + m * 2048 + k * 1024); } while (0)
#define PG8_LDB(dst, b, h) do { _Pragma("unroll") for (int n = 0; n < 2; ++n) _Pragma("unroll") for (int k = 0; k < 2; ++k) dst[n][k] = *(const PG8_LAS bf16x8*)(lds + PG8_SB(b, h) + boff + n * 2048 + k * 1024); } while (0)
#define PG8_MMA(ai, bj, At, Bt) do { __builtin_amdgcn_s_setprio(1); _Pragma("unroll") for (int m = 0; m < 4; ++m) _Pragma("unroll") for (int n = 0; n < 2; ++n) _Pragma("unroll") for (int k = 0; k < 2; ++k) \
        acc[ai][bj][m][n] = __builtin_amdgcn_mfma_f32_16x16x32_bf16(Bt[n][k], At[m][k], acc[ai][bj][m][n], 0, 0, 0); __builtin_amdgcn_s_setprio(0); } while (0)
#define PG8_WAIT_V(n) asm volatile("s_waitcnt vmcnt(" #n ")" ::: "memory")
#define PG8_WAIT_L(n) asm volatile("s_waitcnt lgkmcnt(" #n ")" ::: "memory")
#define PG8_BAR __builtin_amdgcn_s_barrier()
#define PG8_SCHED __builtin_amdgcn_sched_barrier(0)
    Unit cur, nxt; int ui = 0;
    if (!S.next(0, cur)) return;
    f32x4 acc[2][2][4][2];
#pragma unroll
    for (int a = 0; a < 2; ++a)
#pragma unroll
        for (int b = 0; b < 2; ++b)
#pragma unroll
            for (int m = 0; m < 4; ++m)
#pragma unroll
                for (int n = 0; n < 2; ++n) acc[a][b][m][n] = (f32x4){0.f, 0.f, 0.f, 0.f};
    bf16x8 At[4][2], B0[2][2], B1[2][2];
    const char* cA = (const char*)g.A + (size_t)cur.pm * tstepA; const char* cB = (const char*)g.Bt + (size_t)cur.pn * tstep;
    S.a_ready(cur);
    if constexpr (SP2) {
        PG8_STAGE(PG8_SB(0, 0), cB, voffB); PG8_STAGE(PG8_SB(0, 1), cB + hstep, voffB); PG8_STAGE(PG8_SA(0, 0), cA, voffA); PG8_STAGE(PG8_SA(0, 1), cA + hstep, voffA);
        if (wr == 1) PG8_BAR;
        PG8_WAIT_V(2); PG8_BAR;
        PG8_STAGE(PG8_SB(1, 0), cB + kstep, voffB); PG8_STAGE(PG8_SA(1, 0), cA + kstep, voffA); PG8_STAGE(PG8_SB(1, 1), cB + hstep + kstep, voffB);
        PG8_WAIT_V(6); PG8_BAR;
    } else {
        PG8_STAGE(PG8_SB(0, 0), cB, voffB); PG8_STAGE(PG8_SA(0, 0), cA, voffA); PG8_STAGE(PG8_SB(0, 1), cB + hstep, voffB); PG8_STAGE(PG8_SA(0, 1), cA + hstep, voffA);
        if (wr == 1) PG8_BAR;
        PG8_WAIT_V(4); PG8_BAR;
        PG8_STAGE(PG8_SB(1, 0), cB + kstep, voffB); PG8_STAGE(PG8_SA(1, 0), cA + kstep, voffA); PG8_STAGE(PG8_SB(1, 1), cB + hstep + kstep, voffB);
        PG8_WAIT_V(6); PG8_BAR;
    }
    for (;;) {
        const bool has_next = S.next(ui + 1, nxt);
        const char* nA = has_next ? (const char*)g.A + (size_t)nxt.pm * tstepA : cA; const char* nB = has_next ? (const char*)g.Bt + (size_t)nxt.pn * tstep : cB;
        for (int t = 0; t < nt; t += 2) {
            const bool last = (t == nt - 2);
            const char* a1 = cA + (size_t)(t + 1) * kstep;
            const char* a2 = last ? nA : cA + (size_t)(t + 2) * kstep; const char* b2 = last ? nB : cB + (size_t)(t + 2) * kstep;
            const char* a3 = a2 + kstep; const char* b3 = b2 + kstep;
            if (last && has_next) S.a_ready(nxt);
            if constexpr (SP2) {
            PG8_LDB(B0, 0, 0); PG8_LDB(B1, 0, 1); PG8_SCHED; PG8_LDA(At, 0, 0); PG8_STAGE(PG8_SA(1, 1), a1 + hstep, voffA);
            PG8_WAIT_V(8); PG8_WAIT_L(0); PG8_BAR; PG8_MMA(0, 0, At, B0); PG8_MMA(0, 1, At, B1); PG8_BAR; PG8_SCHED;
            PG8_LDA(At, 0, 1); PG8_STAGE(PG8_SB(0, 0), b2, voffB); PG8_STAGE(PG8_SB(0, 1), b2 + hstep, voffB); PG8_STAGE(PG8_SA(0, 0), a2, voffA);
            PG8_WAIT_V(8); PG8_WAIT_L(0); PG8_BAR; PG8_MMA(1, 0, At, B0); PG8_MMA(1, 1, At, B1); PG8_BAR; PG8_SCHED;
            PG8_LDB(B0, 1, 0); PG8_LDB(B1, 1, 1); PG8_SCHED; PG8_LDA(At, 1, 0); PG8_STAGE(PG8_SA(0, 1), a2 + hstep, voffA);
            PG8_WAIT_V(8); PG8_WAIT_L(0); PG8_BAR; PG8_MMA(0, 0, At, B0); PG8_MMA(0, 1, At, B1); PG8_BAR; PG8_SCHED;
            PG8_LDA(At, 1, 1); PG8_STAGE(PG8_SB(1, 0), b3, voffB); PG8_STAGE(PG8_SB(1, 1), b3 + hstep, voffB); PG8_STAGE(PG8_SA(1, 0), a3, voffA);
            PG8_WAIT_V(8); PG8_WAIT_L(0); PG8_BAR; PG8_MMA(1, 0, At, B0); PG8_MMA(1, 1, At, B1); PG8_BAR; PG8_SCHED;
            } else {
            PG8_LDB(B0, 0, 0); PG8_SCHED; PG8_LDA(At, 0, 0); PG8_STAGE(PG8_SA(1, 1), a1 + hstep, voffA);
            PG8_WAIT_L(8); PG8_BAR; PG8_WAIT_L(0); PG8_MMA(0, 0, At, B0); PG8_BAR; PG8_SCHED;
            PG8_LDB(B1, 0, 1); PG8_STAGE(PG8_SB(0, 0), b2, voffB);
            PG8_BAR; PG8_WAIT_L(0); PG8_MMA(0, 1, At, B1); PG8_BAR;
            PG8_LDA(At, 0, 1); PG8_STAGE(PG8_SA(0, 0), a2, voffA);
            PG8_BAR; PG8_WAIT_L(0); PG8_MMA(1, 0, At, B0); PG8_BAR; PG8_SCHED;
            PG8_STAGE(PG8_SB(0, 1), b2 + hstep, voffB);
            PG8_WAIT_V(6); PG8_BAR; PG8_MMA(1, 1, At, B1); PG8_BAR;
            PG8_LDB(B0, 1, 0); PG8_SCHED; PG8_LDA(At, 1, 0); PG8_STAGE(PG8_SA(0, 1), a2 + hstep, voffA);
            PG8_WAIT_L(8); PG8_BAR; PG8_WAIT_L(0); PG8_MMA(0, 0, At, B0); PG8_BAR; PG8_SCHED;
            PG8_LDB(B1, 1, 1); PG8_STAGE(PG8_SB(1, 0), b3, voffB);
            PG8_BAR; PG8_WAIT_L(0); PG8_MMA(0, 1, At, B1); PG8_BAR;
            PG8_LDA(At, 1, 1); PG8_STAGE(PG8_SA(1, 0), a3, voffA);
            PG8_BAR; PG8_WAIT_L(0); PG8_MMA(1, 0, At, B0); PG8_BAR; PG8_SCHED;
            PG8_STAGE(PG8_SB(1, 1), b3 + hstep, voffB);
            PG8_WAIT_V(6); PG8_BAR; PG8_MMA(1, 1, At, B1); PG8_BAR;
            }
        }
        if constexpr (ALIGN_EPI) { if (wr == 0) PG8_BAR; }
        if constexpr (!Epi::AFTER_DRAIN) { E(acc, cur, wr, wc, fr, fq); S.done(cur); }
        if (!has_next) break;
#pragma unroll
        for (int a = 0; a < 2; ++a)
#pragma unroll
            for (int b = 0; b < 2; ++b)
#pragma unroll
                for (int m = 0; m < 4; ++m)
#pragma unroll
                    for (int n = 0; n < 2; ++n) acc[a][b][m][n] = (f32x4){0.f, 0.f, 0.f, 0.f};
        cur = nxt; cA = nA; cB = nB; ++ui;
        if constexpr (ALIGN_EPI) { if (wr == 1) PG8_BAR; }
    }
    PG8_WAIT_V(0);
    if constexpr (!ALIGN_EPI) { if (wr == 0) PG8_BAR; }
    PG8_BAR;
    if constexpr (Epi::AFTER_DRAIN) { E.fused(acc, cur, wr, wc, fr, fq, lds, wid, lane); S.done(cur); }
#undef PG8_SA
#undef PG8_SB
#undef PG8_STAGE
#undef PG8_LDA
#undef PG8_LDB
#undef PG8_MMA
#undef PG8_WAIT_V
#undef PG8_WAIT_L
#undef PG8_BAR
#undef PG8_SCHED
}
}
#define XB_TMO      128
#define XB_XCNT(j)  (256  + 64 * (j))
#define XB_XSUB(j)  (1280 + 64 * (j))
#define XB_XGEN(j)  (2304 + 64 * (j))
#define XB_TOP      3328
#define XB_TOPGEN   3392
#define XCD_BAR_WORDS 3456
#define XB_SPIN_CAP (1u << 18)

__device__ __forceinline__ unsigned xb_ld(unsigned* p)              { return __hip_atomic_load(p, __ATOMIC_RELAXED, __HIP_MEMORY_SCOPE_AGENT); }
__device__ __forceinline__ unsigned xb_add(unsigned* p, unsigned v) { return __hip_atomic_fetch_add(p, v, __ATOMIC_RELAXED, __HIP_MEMORY_SCOPE_AGENT); }
__device__ __forceinline__ unsigned xb_xcc_id() { return (unsigned)__builtin_amdgcn_s_getreg((3 << 11) | 20) & 0xFu; }
#define XB_SPIN(cond, bar) do { unsigned _sp = 0; while (cond) { __builtin_amdgcn_s_sleep(1); \
    if ((++_sp & 255u) == 0u) { if (xb_ld(&(bar)[XB_TMO])) break; if (_sp > XB_SPIN_CAP) { atomicAdd(&(bar)[XB_TMO], 1u); break; } } } } while (0)

struct XcdBarrier {
    unsigned* bar; unsigned x;
    volatile LAS unsigned* st;
};

__device__ __forceinline__ XcdBarrier xcd_barrier_post(unsigned* bar, volatile LAS unsigned* st) {
    XcdBarrier b; b.bar = bar; b.x = xb_xcc_id(); b.st = st;
    if (threadIdx.x == 0) (void)xb_add(&bar[XB_XCNT(b.x)], 1u);
    return b;
}
__device__ __forceinline__ void xcd_barrier_complete(unsigned* bar, unsigned x, unsigned& nloc, unsigned& nx) {
    const unsigned G = gridDim.x * gridDim.y * gridDim.z;
    unsigned sum, cnt, mine, sp = 0u;
    for (;;) {
        sum = 0u; cnt = 0u; mine = 0u;
#pragma unroll
        for (unsigned j = 0; j < 16; ++j) { const unsigned c = xb_ld(&bar[XB_XCNT(j)]); sum += c; cnt += (c > 0u) ? 1u : 0u; mine = (j == x) ? c : mine; }
        if (sum == G) break;
        __builtin_amdgcn_s_sleep(1);
        if ((++sp & 255u) == 0u) { if (xb_ld(&bar[XB_TMO])) break; if (sp > XB_SPIN_CAP) { atomicAdd(&bar[XB_TMO], 1u); break; } }
    }
    nloc = mine > 0u ? mine : 1u; nx = cnt > 0u ? cnt : 1u;
}

__device__ __forceinline__ void xcd_barrier(const XcdBarrier& b) {
    asm volatile("s_waitcnt vmcnt(0)" ::: "memory");
    __syncthreads();
    if (threadIdx.x == 0) {
        unsigned* bar = b.bar;
        __builtin_amdgcn_s_waitcnt(0);
        unsigned nloc = b.st[0], nx = b.st[1];
        if (nloc == 0u) { xcd_barrier_complete(bar, b.x, nloc, nx); b.st[0] = nloc; b.st[1] = nx; }
        const unsigned old = xb_add(&bar[XB_XSUB(b.x)], 1u);
        const unsigned gen = old / nloc;
        if (old + 1u == (gen + 1u) * nloc) {
            __builtin_amdgcn_fence(__ATOMIC_RELEASE, "agent");
            asm volatile("s_waitcnt vmcnt(0)" ::: "memory");
            const unsigned og = xb_add(&bar[XB_TOP], 1u);
            const unsigned tg = og / nx;
            if (og + 1u == (tg + 1u) * nx) xb_add(&bar[XB_TOPGEN], 1u);
            else XB_SPIN(xb_ld(&bar[XB_TOPGEN]) == tg, bar);
            __builtin_amdgcn_fence(__ATOMIC_ACQUIRE, "agent");
            xb_add(&bar[XB_XGEN(b.x)], 1u);
            asm volatile("s_waitcnt vmcnt(0)" ::: "memory");
        } else {
            XB_SPIN(xb_ld(&bar[XB_XGEN(b.x)]) == gen, bar);
            __builtin_amdgcn_fence(__ATOMIC_ACQUIRE, "agent");
            asm volatile("s_waitcnt vmcnt(0)" ::: "memory");
        }
    }
    __syncthreads();
}

constexpr int BATCH = 2, SEQ = 8192, M = BATCH * SEQ, D = 2048, DEPTH = 4;
constexpr int DIN = 11968, NP1 = 5888, NG = 6144, NWIN = NP1 + NG;
constexpr int BW = 768, BCOLS = 2752;
constexpr int C_AQ = 0, C_AK = 512, C_AV = 640, C_R = 768, C_K = 1536, C_V = 2304, C_WD = 3072, C_CQ = 3520, C_CK = 4288, C_CV = 5056, C_END = 5824;
constexpr int DFF = 5504, NUP = 2 * DFF;
constexpr int NLORA = 2304, KLORA = 512;
constexpr float NORM_EPS = 1e-5f, GN_EPS = 64e-5f;
constexpr int NWAVES = 8, NTHREADS = 512;
constexpr int NPH = 13;
constexpr int NPHASES = DEPTH * NPH + 1;
#ifndef EXP_EW_MASK
#define EXP_EW_MASK 0
#endif
#ifndef EXP_EW_REPS
#define EXP_EW_REPS 1
#endif
#ifndef EXP_G1_REPS
#define EXP_G1_REPS 1
#endif
#ifndef EXP_SCAN_REPS
#define EXP_SCAN_REPS 1
#endif
#ifndef EXP_ATTN_REPS
#define EXP_ATTN_REPS 1
#endif
constexpr int NSCAN = 48;

constexpr size_t MiB = 1u << 20;
constexpr size_t WS_CTL = 0, CTL_ZERO_BYTES = 1 * MiB;
constexpr size_t WS_WIN = 1 * MiB;
constexpr size_t WS_WLORA = 48 * MiB;
constexpr size_t WS_PA = 51 * MiB;
constexpr size_t WS_PB = 53 * MiB;
constexpr size_t WS_PC = 56 * MiB;
constexpr size_t WS_WOUT = 57 * MiB;
constexpr size_t WS_WUP = 65 * MiB;
constexpr size_t WS_WDOWN = 108 * MiB;
constexpr size_t WS_H = 130 * MiB;
constexpr size_t WS_P1 = 194 * MiB;
constexpr size_t WS_G = 378 * MiB;
constexpr size_t WS_U = WS_P1;
constexpr size_t WS_AP = 570 * MiB;
constexpr size_t WS_LO = 586 * MiB;
constexpr size_t WS_ACT = WS_LO;
constexpr size_t WS_SR = 730 * MiB;
constexpr size_t WS_SW = 778 * MiB, WS_SK = 826 * MiB, WS_SKK = 874 * MiB, WS_SB = 922 * MiB, WS_SV = 970 * MiB;
constexpr size_t WS_YRAW = 1018 * MiB;
constexpr size_t WS_YA = 1066 * MiB;
constexpr size_t WS_YB = 1082 * MiB;
constexpr size_t WS_YC = 1106 * MiB;
constexpr size_t WS_OC = 1114 * MiB;
constexpr size_t WS_LSE = 1138 * MiB;
constexpr size_t WS_MG = 1139 * MiB;
constexpr size_t WS_BK = 1203 * MiB;
constexpr size_t WS_VT = 1205 * MiB;
constexpr size_t WS_W2 = 1235 * MiB;
constexpr size_t WSET_STRIDE = WS_W2 - WS_WIN;
constexpr size_t WS_END = 1365 * MiB;
constexpr int CW_BAR = 4096;

constexpr int RING_OFF = 0, RING_BYTES = 131072;
constexpr int LDSCTL_OFF = 141312, MISC_OFF = LDSCTL_OFF + 320;
constexpr int LDS_BYTES = 147456;

typedef unsigned short bf16;
typedef unsigned v4u __attribute__((ext_vector_type(4)));
typedef unsigned v2u __attribute__((ext_vector_type(2)));
typedef float f32x4 __attribute__((ext_vector_type(4)));
#define LDS_WAIT() asm volatile("s_waitcnt lgkmcnt(0)" ::: "memory")

__device__ __forceinline__ unsigned f2bf(float f) { unsigned u = __builtin_bit_cast(unsigned, f); return (u + 0x7fffu + ((u >> 16) & 1u)) >> 16; }
__device__ __forceinline__ unsigned pk2(float lo, float hi) { return f2bf(lo) | (f2bf(hi) << 16); }
__device__ __forceinline__ float bflo(unsigned w) { return __builtin_bit_cast(float, w << 16); }
__device__ __forceinline__ float bfhi(unsigned w) { return __builtin_bit_cast(float, w & 0xffff0000u); }
__device__ __forceinline__ float bf1(bf16 h) { return __builtin_bit_cast(float, ((unsigned)h) << 16); }
__device__ __forceinline__ float sigmoidf_(float x) { return 1.0f / (1.0f + __expf(-x)); }
__device__ __forceinline__ float wave_sum(float v) {
#pragma unroll
    for (int o = 1; o < 64; o <<= 1) v += __shfl_xor(v, o);
    return v;
}
template <int CTRL> __device__ __forceinline__ float dppf(float x) { return __builtin_bit_cast(float, __builtin_amdgcn_update_dpp(0, __builtin_bit_cast(int, x), CTRL, 0xF, 0xF, true)); }
__device__ __forceinline__ float red4(float x) { x += dppf<0xB1>(x); x += dppf<0x4E>(x); return x; }
__device__ __forceinline__ float red16(float x) { x = red4(x); x += dppf<0x141>(x); x += dppf<0x140>(x); return x; }
__device__ __forceinline__ float wsum(float x) { x = red16(x); x += __shfl_xor(x, 16); x += __shfl_xor(x, 32); return x; }

__device__ const unsigned char T5B[3][132] = {
 {0,1,2,3,4,5,6,7,8,9,10,11,12,13,14,15,16,16,16,16,16,16,17,17,17,17,17,17,17,17,18,18,18,18,18,18,18,18,18,18,19,19,19,19,19,19,19,19,19,19,19,19,19,19,20,20,20,20,20,20,20,20,20,20,20,20,20,20,20,20,20,20,20,21,21,21,21,21,21,21,21,21,21,21,21,21,21,21,21,21,21,21,21,21,21,21,21,21,21,22,22,22,22,22,22,22,22,22,22,22,22,22,22,22,22,22,22,22,22,22,22,22,22,22,22,22,22,22,22,0,0,0},
 {0,4,8,12,16,16,17,17,18,18,19,19,19,19,20,20,20,20,20,21,21,21,21,21,21,22,22,22,22,22,22,22,22,22,23,23,23,23,23,23,23,23,23,23,23,23,24,24,24,24,24,24,24,24,24,24,24,24,24,24,24,24,25,25,25,25,25,25,25,25,25,25,25,25,25,25,25,25,25,25,25,25,25,26,26,26,26,26,26,26,26,26,26,26,26,26,26,26,26,26,26,26,26,26,26,26,26,26,26,26,26,26,26,27,27,27,27,27,27,27,27,27,27,27,27,27,27,27,27,0,0,0},
 {0,16,18,19,20,21,21,22,22,23,23,23,24,24,24,24,25,25,25,25,25,26,26,26,26,26,26,26,26,27,27,27,27,27,27,27,27,27,27,28,28,28,28,28,28,28,28,28,28,28,28,28,29,29,29,29,29,29,29,29,29,29,29,29,29,29,29,29,29,29,30,30,30,30,30,30,30,30,30,30,30,30,30,30,30,30,30,30,30,30,30,30,30,30,30,31,31,31,31,31,31,31,31,31,31,31,31,31,31,31,31,31,31,31,31,31,31,31,31,31,31,31,31,31,31,31,31,31,31,0,0,0}};

namespace pg8 {
struct EpiWin {
    static constexpr bool PERM = true, AFTER_DRAIN = false; static constexpr int A_ROWS = 256;
    bf16_t* P1; bf16_t* G; int pn0;
    __device__ __forceinline__ void operator()(const f32x4 (&acc)[2][2][4][2], const Unit& u, int wr, int wc, int fr, int fq) const {
        const int pn = u.pn + pn0; const int row0 = u.pm * BM + wr * 64 + fr; const bool gate = pn >= 23;
        bf16_t* base = gate ? G : P1; const int ldc = gate ? 6144 : 5888; const int col0 = (gate ? (pn - 23) : pn) * BM + wc * 32 + 8 * fq;
#pragma unroll
        for (int ai = 0; ai < 2; ++ai)
#pragma unroll
            for (int m = 0; m < 4; ++m) { bf16_t* rowp = base + (size_t)(row0 + ai * HALF + m * 16) * ldc + col0;
#pragma unroll
                for (int bj = 0; bj < 2; ++bj) { f32x4 v0 = acc[ai][bj][m][0], v1 = acc[ai][bj][m][1];
                    if (gate) {
#pragma unroll
                        for (int j = 0; j < 4; ++j) { v0[j] = __builtin_amdgcn_rcpf(1.0f + __expf(-v0[j])); v1[j] = __builtin_amdgcn_rcpf(1.0f + __expf(-v1[j])); } }
                    u32x4 w; w.x = cvt_pk_bf16(v0[0], v0[1]); w.y = cvt_pk_bf16(v0[2], v0[3]); w.z = cvt_pk_bf16(v1[0], v1[1]); w.w = cvt_pk_bf16(v1[2], v1[3]);
                    *(u32x4*)(rowp + bj * HALF) = w; } }
    }
};
struct EpiBf16P {
    static constexpr bool PERM = true, AFTER_DRAIN = false; static constexpr int A_ROWS = 256;
    bf16_t* O; int ldc;
    __device__ __forceinline__ void operator()(const f32x4 (&acc)[2][2][4][2], const Unit& u, int wr, int wc, int fr, int fq) const {
        const int row0 = u.pm * BM + wr * 64 + fr; const int col0 = u.pn * BM + wc * 32 + 8 * fq;
#pragma unroll
        for (int ai = 0; ai < 2; ++ai)
#pragma unroll
            for (int m = 0; m < 4; ++m) { bf16_t* rowp = O + (size_t)(row0 + ai * HALF + m * 16) * ldc + col0;
#pragma unroll
                for (int bj = 0; bj < 2; ++bj) { const f32x4 v0 = acc[ai][bj][m][0], v1 = acc[ai][bj][m][1];
                    u32x4 w; w.x = cvt_pk_bf16(v0[0], v0[1]); w.y = cvt_pk_bf16(v0[2], v0[3]); w.z = cvt_pk_bf16(v1[0], v1[1]); w.w = cvt_pk_bf16(v1[2], v1[3]);
                    *(u32x4*)(rowp + bj * HALF) = w; } }
    }
};
struct EpiF32P {
    static constexpr bool PERM = false, AFTER_DRAIN = false; static constexpr int A_ROWS = 256;
    float* C; int ldc;
    __device__ __forceinline__ void operator()(const f32x4 (&acc)[2][2][4][2], const Unit& u, int wr, int wc, int fr, int fq) const {
        const int row0 = u.pm * BM + wr * 64 + fr, col0 = u.pn * BM + wc * 32 + 4 * fq;
#pragma unroll
        for (int ai = 0; ai < 2; ++ai)
#pragma unroll
            for (int m = 0; m < 4; ++m) { float* rowp = C + (size_t)(row0 + ai * HALF + m * 16) * ldc + col0;
#pragma unroll
                for (int bj = 0; bj < 2; ++bj)
#pragma unroll
                    for (int n = 0; n < 2; ++n) *(f32x4*)(rowp + bj * HALF + n * 16) = acc[ai][bj][m][n]; }
    }
};
struct EpiResid {
    static constexpr bool PERM = false, AFTER_DRAIN = false; static constexpr int A_ROWS = 256;
    const float* xin; float* out;
    __device__ __forceinline__ void operator()(const f32x4 (&acc)[2][2][4][2], const Unit& u, int wr, int wc, int fr, int fq) const {
        const int row0 = u.pm * BM + wr * 64 + fr, col0 = u.pn * BM + wc * 32 + 4 * fq;
#pragma unroll
        for (int ai = 0; ai < 2; ++ai)
#pragma unroll
            for (int m = 0; m < 4; ++m) { const size_t ro = (size_t)(row0 + ai * HALF + m * 16) * 2048 + col0;
#pragma unroll
                for (int bj = 0; bj < 2; ++bj)
#pragma unroll
                    for (int n = 0; n < 2; ++n) { const f32x4 xv = *(const f32x4*)(xin + ro + bj * HALF + n * 16); *(f32x4*)(out + ro + bj * HALF + n * 16) = xv + acc[ai][bj][m][n]; } }
    }
};
template <bool ACC> struct EpiGate {
    static constexpr bool PERM = true, AFTER_DRAIN = false; static constexpr int A_ROWS = 256;
    const bf16_t* G; int gofs; bf16_t* MG;
    __device__ __forceinline__ void operator()(const f32x4 (&acc)[2][2][4][2], const Unit& u, int wr, int wc, int fr, int fq) const {
        const int row0 = u.pm * BM + wr * 64 + fr; const int col0 = u.pn * BM + wc * 32 + 8 * fq;
#pragma unroll
        for (int ai = 0; ai < 2; ++ai)
#pragma unroll
            for (int m = 0; m < 4; ++m) { const int row = row0 + ai * HALF + m * 16;
#pragma unroll
                for (int bj = 0; bj < 2; ++bj) { const int col = col0 + bj * HALF;
                    const u32x4 gv = *(const u32x4*)(G + (size_t)row * 6144 + gofs + col);
                    const f32x4 a0 = acc[ai][bj][m][0], a1 = acc[ai][bj][m][1];
                    float r[8];
                    r[0] = __builtin_bit_cast(float, gv.x << 16) * a0[0]; r[1] = __builtin_bit_cast(float, gv.x & 0xffff0000u) * a0[1];
                    r[2] = __builtin_bit_cast(float, gv.y << 16) * a0[2]; r[3] = __builtin_bit_cast(float, gv.y & 0xffff0000u) * a0[3];
                    r[4] = __builtin_bit_cast(float, gv.z << 16) * a1[0]; r[5] = __builtin_bit_cast(float, gv.z & 0xffff0000u) * a1[1];
                    r[6] = __builtin_bit_cast(float, gv.w << 16) * a1[2]; r[7] = __builtin_bit_cast(float, gv.w & 0xffff0000u) * a1[3];
                    bf16_t* mp = MG + (size_t)row * 2048 + col;
                    if (ACC) { const u32x4 ov = *(const u32x4*)mp;
                        r[0] += __builtin_bit_cast(float, ov.x << 16); r[1] += __builtin_bit_cast(float, ov.x & 0xffff0000u);
                        r[2] += __builtin_bit_cast(float, ov.y << 16); r[3] += __builtin_bit_cast(float, ov.y & 0xffff0000u);
                        r[4] += __builtin_bit_cast(float, ov.z << 16); r[5] += __builtin_bit_cast(float, ov.z & 0xffff0000u);
                        r[6] += __builtin_bit_cast(float, ov.w << 16); r[7] += __builtin_bit_cast(float, ov.w & 0xffff0000u); }
                    u32x4 w; w.x = cvt_pk_bf16(r[0], r[1]); w.y = cvt_pk_bf16(r[2], r[3]); w.z = cvt_pk_bf16(r[4], r[5]); w.w = cvt_pk_bf16(r[6], r[7]);
                    *(u32x4*)mp = w; } }
    }
};
template <int CTRL> __device__ __forceinline__ float dpp_keep(float old, float x) { return __builtin_bit_cast(float, __builtin_amdgcn_update_dpp(__builtin_bit_cast(int, old), __builtin_bit_cast(int, x), CTRL, 0xF, 0xF, false)); }
struct EpiConv {
    static constexpr bool PERM = true, AFTER_DRAIN = false; static constexpr int A_ROWS = 254;
    bf16_t* ACT; const float* cw; PG8_LAS float* xch;
    __device__ __forceinline__ void operator()(const f32x4 (&acc)[2][2][4][2], const Unit& u, int wr, int wc, int fr, int fq) const {
        const int cbase = wc * 32 + 8 * fq, f0 = u.pn * 128 + cbase;
        float c0[8], c1[8], c2[8];
#pragma unroll
        for (int j = 0; j < 8; ++j) { c0[j] = cw[f0 + j]; c1[j] = cw[5504 + f0 + j]; c2[j] = cw[2 * 5504 + f0 + j]; }
        if (fr >= 14) {
#pragma unroll
            for (int ai = 0; ai < 2; ++ai)
#pragma unroll
                for (int n = 0; n < 2; ++n) *(PG8_LAS f32x4*)(xch + ((2 * ai + wr) * 2 + (fr - 14)) * 128 + cbase + 4 * n) = acc[ai][0][3][n];
        }
        asm volatile("s_waitcnt lgkmcnt(0)" ::: "memory"); __builtin_amdgcn_s_barrier(); asm volatile("" ::: "memory");
#pragma unroll
        for (int ai = 0; ai < 2; ++ai) {
            const int sl = 2 * ai + wr;
            f32x4 e1[2], e2[2];
#pragma unroll
            for (int n = 0; n < 2; ++n) { e1[n] = (f32x4){0.f, 0.f, 0.f, 0.f}; e2[n] = e1[n];
                if (sl > 0) { e2[n] = *(const PG8_LAS f32x4*)(xch + ((sl - 1) * 2 + 0) * 128 + cbase + 4 * n); e1[n] = *(const PG8_LAS f32x4*)(xch + ((sl - 1) * 2 + 1) * 128 + cbase + 4 * n); } }
#pragma unroll
            for (int m = 0; m < 4; ++m) {
                const int lr = 128 * ai + 64 * wr + 16 * m + fr; const int grow = 254 * u.pm - 2 + lr; const int t = grow & 8191;
                float r[8];
#pragma unroll
                for (int n = 0; n < 2; ++n)
#pragma unroll
                    for (int j = 0; j < 4; ++j) {
                        const float x = acc[ai][0][m][n][j];
                        float k1, k2;
                        if (m > 0) { const float xp = acc[ai][0][m > 0 ? m - 1 : 0][n][j]; k1 = dpp_keep<0x121>(xp, xp); k2 = dpp_keep<0x122>(xp, xp); }
                        else { k1 = e1[n][j]; k2 = (fr == 0) ? e2[n][j] : e1[n][j]; }
                        float p1 = dpp_keep<0x111>(k1, x), p2 = dpp_keep<0x112>(k2, x);
                        if (t == 0) p1 = 0.f; if (t <= 1) p2 = 0.f;
                        const float gs = c0[4 * n + j] * p2 + c1[4 * n + j] * p1 + c2[4 * n + j] * x;
                        r[4 * n + j] = gs * __builtin_amdgcn_rcpf(1.0f + __expf(-gs)) * acc[ai][1][m][n][j];
                    }
                if (lr >= 2 && grow < 16384) { u32x4 w; w.x = cvt_pk_bf16(r[0], r[1]); w.y = cvt_pk_bf16(r[2], r[3]); w.z = cvt_pk_bf16(r[4], r[5]); w.w = cvt_pk_bf16(r[6], r[7]);
                    *(u32x4*)(ACT + (size_t)grow * 5504 + f0) = w; }
            }
        }
    }
};
}

struct Args { const float* in[25]; float* out; unsigned char* ws; int ph_lo, ph_hi, li, pad; };

struct Ctx {
    LAS unsigned char* lds;
    int tid, lane, wave, G, bid;
    int gw, ngw;
};

__device__ __forceinline__ void transpose_item(const float* W, int K, int N, bf16* WT, int kb, int nb, int dst_row0, LAS float* scr, int lane) {
    const int k0 = 64 * kb, n0 = 32 * nb;
#pragma unroll 8
    for (int i = 0; i < 32; ++i) { const int kk = 2 * i + (lane >> 5); scr[kk * 33 + (lane & 31)] = W[(size_t)(k0 + kk) * N + n0 + (lane & 31)]; }
    LDS_WAIT(); asm volatile("" ::: "memory");
    const int c = lane & 7;
#pragma unroll
    for (int j = 0; j < 4; ++j) { const int n = (lane >> 3) + 8 * j; const LAS float* s = scr + (8 * c) * 33 + n;
        v4u o; o.x = pk2(s[0 * 33], s[1 * 33]); o.y = pk2(s[2 * 33], s[3 * 33]); o.z = pk2(s[4 * 33], s[5 * 33]); o.w = pk2(s[6 * 33], s[7 * 33]);
        *(v4u*)(WT + (size_t)(dst_row0 + n) * K + k0 + 8 * c) = o; }
    LDS_WAIT(); asm volatile("" ::: "memory");
}
__device__ __forceinline__ int transpose_matrix(int widx, int nw, int lane, LAS float* scr, const float* W, int K, int N, bf16* WT, int gate_split, int base) {
    const int nblk = N / 32, items = (K / 64) * nblk;
    int first = (widx - base) % nw; if (first < 0) first += nw;
    for (int it = first; it < items; it += nw) {
        const int kb = it / nblk, nb = it % nblk; int dr = 32 * nb; if (gate_split == 1 && dr >= C_END) dr += 64;
        if (gate_split == 2) { const int f = dr < DFF ? dr : dr - DFF; dr = 256 * (f >> 7) + (f & 127) + (dr < DFF ? 0 : 128); }
        transpose_item(W, K, N, WT, kb, nb, dr, scr, lane);
    }
    return base + items;
}
__device__ __forceinline__ void convert_weights(int widx, int nw, int lane, LAS float* scr, const Args& a, int l, unsigned char* ws) {
    unsigned char* wsw = ws + (size_t)(l & 1) * WSET_STRIDE;
    int base = 0;
    base = transpose_matrix(widx, nw, lane, scr, a.in[3] + (size_t)l * D * DIN, D, DIN, (bf16*)(wsw + WS_WIN), 1, base);
    base = transpose_matrix(widx, nw, lane, scr, a.in[21] + (size_t)l * D * NUP, D, NUP, (bf16*)(wsw + WS_WUP), 2, base);
    base = transpose_matrix(widx, nw, lane, scr, a.in[23] + (size_t)l * DFF * D, DFF, D, (bf16*)(wsw + WS_WDOWN), 0, base);
    base = transpose_matrix(widx, nw, lane, scr, a.in[19] + (size_t)l * D * D, D, D, (bf16*)(wsw + WS_WOUT), 0, base);
    base = transpose_matrix(widx, nw, lane, scr, a.in[16] + (size_t)l * 512 * D, 512, D, (bf16*)(wsw + WS_PA), 0, base);
    base = transpose_matrix(widx, nw, lane, scr, a.in[17] + (size_t)l * 768 * D, 768, D, (bf16*)(wsw + WS_PB), 0, base);
    base = transpose_matrix(widx, nw, lane, scr, a.in[18] + (size_t)l * 256 * D, 256, D, (bf16*)(wsw + WS_PC), 0, base);
    const int gt = widx * 64 + lane, ngt = nw * 64;
    { v4u* z = (v4u*)((bf16*)(wsw + WS_WIN) + (size_t)C_END * D); for (int i = gt; i < 64 * D / 8; i += ngt) z[i] = (v4u){0u, 0u, 0u, 0u}; }
    { bf16* wl = (bf16*)(wsw + WS_WLORA); const float* wup = a.in[7] + (size_t)l * 96 * BW; const float* aup = a.in[9] + (size_t)l * 96 * BW; const float* gup = a.in[10] + (size_t)l * 256 * BW;
      for (int i = gt; i < NLORA * KLORA; i += ngt) { const int n = i / KLORA, k = i % KLORA; float v = 0.f;
          if (n < 768) { if (k < 96) v = wup[k * BW + n]; }
          else if (n < 1536) { if (k >= 96 && k < 192) v = aup[(k - 96) * BW + (n - 768)]; }
          else { if (k >= 192 && k < 448) v = gup[(k - 192) * BW + (n - 1536)]; }
          wl[i] = (bf16)f2bf(v); } }
}

__device__ __forceinline__ void rms_row_bf16(const float* xrow, const float* gam, bf16* orow, int lane) {
    const f32x4* xr = (const f32x4*)xrow + lane; f32x4 v[8]; float s = 0.f;
#pragma unroll
    for (int j = 0; j < 8; ++j) { v[j] = xr[64 * j]; s += (v[j].x * v[j].x + v[j].y * v[j].y) + (v[j].z * v[j].z + v[j].w * v[j].w); }
    const float rs = 1.0f / sqrtf(wave_sum(s) * (1.0f / D) + NORM_EPS);
    const f32x4* gr = (const f32x4*)gam + lane; v2u* o8 = (v2u*)orow + lane;
#pragma unroll
    for (int j = 0; j < 8; ++j) { const f32x4 g = gr[64 * j]; v2u w; w.x = pk2(v[j].x * rs * g.x, v[j].y * rs * g.y); w.y = pk2(v[j].z * rs * g.z, v[j].w * rs * g.w); o8[64 * j] = w; }
}
__device__ __forceinline__ void rms_row2_bf16(const float* xrow, const float* gam, bf16* orow, int lane) {
    const f32x4* xr = (const f32x4*)xrow + lane; f32x4 v[16]; float s0 = 0.f, s1 = 0.f;
#pragma unroll
    for (int j = 0; j < 16; ++j) v[j] = xr[64 * j];
#pragma unroll
    for (int j = 0; j < 8; ++j) { s0 += (v[j].x * v[j].x + v[j].y * v[j].y) + (v[j].z * v[j].z + v[j].w * v[j].w); s1 += (v[8 + j].x * v[8 + j].x + v[8 + j].y * v[8 + j].y) + (v[8 + j].z * v[8 + j].z + v[8 + j].w * v[8 + j].w); }
    const float rs0 = 1.0f / sqrtf(wsum(s0) * (1.0f / D) + NORM_EPS), rs1 = 1.0f / sqrtf(wsum(s1) * (1.0f / D) + NORM_EPS);
    const f32x4* gr = (const f32x4*)gam + lane; v2u* o8 = (v2u*)orow + lane;
#pragma unroll
    for (int j = 0; j < 8; ++j) { const f32x4 g = gr[64 * j]; v2u w; w.x = pk2(v[j].x * rs0 * g.x, v[j].y * rs0 * g.y); w.y = pk2(v[j].z * rs0 * g.z, v[j].w * rs0 * g.w); o8[64 * j] = w;
        v2u w1; w1.x = pk2(v[8 + j].x * rs1 * g.x, v[8 + j].y * rs1 * g.y); w1.y = pk2(v[8 + j].z * rs1 * g.z, v[8 + j].w * rs1 * g.w); o8[64 * (8 + j)] = w1; }
}
__device__ __forceinline__ void rms_row_f32(float* xrow, const float* gam, int lane) {
    f32x4* xr = (f32x4*)xrow + lane; f32x4 v[8]; float s = 0.f;
#pragma unroll
    for (int j = 0; j < 8; ++j) { v[j] = xr[64 * j]; s += (v[j].x * v[j].x + v[j].y * v[j].y) + (v[j].z * v[j].z + v[j].w * v[j].w); }
    const float rs = 1.0f / sqrtf(wave_sum(s) * (1.0f / D) + NORM_EPS);
    const f32x4* gr = (const f32x4*)gam + lane;
#pragma unroll
    for (int j = 0; j < 8; ++j) { const f32x4 g = gr[64 * j]; xr[64 * j] = v[j] * rs * g; }
}

__device__ __forceinline__ void phase_prep(const Ctx& C, const Args& a, int l, const float* xsrc, unsigned char* ws) {
    if (l == 0) convert_weights(C.gw, C.ngw, C.lane, (LAS float*)(C.lds + RING_OFF + C.wave * 16384), a, 0, ws);
    const float* g1 = a.in[2] + (size_t)l * D; bf16* H = (bf16*)(ws + WS_H);
    for (int m = 2 * C.gw; m < M; m += 2 * C.ngw) rms_row2_bf16(xsrc + (size_t)m * D, g1, H + (size_t)m * D, C.lane);
}

__device__ __forceinline__ void phase_aprime(const Ctx& C, const Args& a, int l, unsigned char* ws) {
    const bf16* P1 = (const bf16*)(ws + WS_P1); bf16* AP = (bf16*)(ws + WS_AP); const float* mu = a.in[5] + (size_t)l * BCOLS;
    const int g = C.lane, c0 = 8 * g;
    float muv[8];
#pragma unroll
    for (int j = 0; j < 8; ++j) muv[j] = (g < 56) ? mu[(C_WD - C_R) + c0 + j] : 0.f;
    for (int m = C.gw; m < M; m += C.ngw) {
        v4u o = (v4u){0u, 0u, 0u, 0u};
        if (g < 56) {
            const v4u cur = *(const v4u*)(P1 + (size_t)m * NP1 + C_WD + c0);
            v4u prv = (v4u){0u, 0u, 0u, 0u}; if ((m & (SEQ - 1)) != 0) prv = *(const v4u*)(P1 + (size_t)(m - 1) * NP1 + C_WD + c0);
            float x[8], p[8];
            x[0] = bflo(cur.x); x[1] = bfhi(cur.x); x[2] = bflo(cur.y); x[3] = bfhi(cur.y); x[4] = bflo(cur.z); x[5] = bfhi(cur.z); x[6] = bflo(cur.w); x[7] = bfhi(cur.w);
            p[0] = bflo(prv.x); p[1] = bfhi(prv.x); p[2] = bflo(prv.y); p[3] = bfhi(prv.y); p[4] = bflo(prv.z); p[5] = bfhi(prv.z); p[6] = bflo(prv.w); p[7] = bfhi(prv.w);
#pragma unroll
            for (int j = 0; j < 8; ++j) { float v = x[j] + (p[j] - x[j]) * muv[j];
                if (g < 12) v = tanhf(v); else if (g >= 24) v = sigmoidf_(v);
                x[j] = v; }
            o.x = pk2(x[0], x[1]); o.y = pk2(x[2], x[3]); o.z = pk2(x[4], x[5]); o.w = pk2(x[6], x[7]);
        }
        *(v4u*)(AP + (size_t)m * KLORA + c0) = o;
    }
}

struct PrepTok { float r, kt, v, w, kk, b; };
__device__ __forceinline__ PrepTok prep_token(const bf16* P1, const float* LO, int m, int hc, float mur, float muk, float muv, float w0, float a0, float kkw, float kaw) {
    const bool first = (m & (SEQ - 1)) == 0;
    const bf16* pr = P1 + (size_t)m * NP1; const bf16* pp = pr - NP1;
    float r = bf1(pr[C_R + hc]), k = bf1(pr[C_K + hc]), v = bf1(pr[C_V + hc]);
    const float rp = first ? 0.f : bf1(pp[C_R + hc]), kp = first ? 0.f : bf1(pp[C_K + hc]), vp = first ? 0.f : bf1(pp[C_V + hc]);
    r = r + (rp - r) * mur; k = k + (kp - k) * muk; v = v + (vp - v) * muv;
    const float wpre = w0 + LO[(size_t)m * NLORA + hc], apre = a0 + LO[(size_t)m * NLORA + BW + hc];
    const float xx = -wpre; const float sp = fmaxf(xx, 0.f) + log1pf(expf(-fabsf(xx)));
    const float wlog = -sp - 0.5f; const float decay = expf(-expf(wlog));
    const float av = 1.0f / (1.0f + expf(-apre));
    const float kkr = k * kkw; const float nrm = sqrtf(wave_sum(kkr * kkr)); const float kk = kkr / fmaxf(nrm, 1e-12f);
    PrepTok t; t.r = r; t.kt = k * (1.0f + (av - 1.0f) * kaw); t.v = v; t.w = decay; t.kk = kk; t.b = kk * av; return t;
}
__device__ __forceinline__ void phase_scanprep(const Ctx& C, const Args& a, int l, unsigned char* ws) {
    const bf16* P1 = (const bf16*)(ws + WS_P1); const float* LO = (const float*)(ws + WS_LO);
    float* SR = (float*)(ws + WS_SR); float* SW = (float*)(ws + WS_SW); float* SK = (float*)(ws + WS_SK); float* SU = (float*)(ws + WS_SKK); float* SB = (float*)(ws + WS_SB); float* SV = (float*)(ws + WS_SV);
    float* BK = (float*)(ws + WS_BK);
    const float* mu = a.in[5] + (size_t)l * BCOLS; const float* w0p = a.in[6] + (size_t)l * BW; const float* a0p = a.in[8] + (size_t)l * BW;
    const float* kkwp = a.in[11] + (size_t)l * BW; const float* kawp = a.in[12] + (size_t)l * BW;
    constexpr int TB = 16, NS = TB + 2;
    for (int it = C.gw; it < (M / TB) * 12; it += C.ngw) {
        const int tb = it / 12, h = it % 12, hc = h * 64 + C.lane, m0 = tb * TB;
        const float mur = mu[hc], muk = mu[BW + hc], muv = mu[2 * BW + hc], w0 = w0p[hc], a0 = a0p[hc], kkw = kkwp[hc], kaw = kawp[hc];
        const bool seq_start = (m0 & (SEQ - 1)) == 0;
        float rr[NS], rk[NS], rv[NS], lw[NS], la[NS];
#pragma unroll
        for (int j = 0; j < NS; ++j) {
            const bool ok = !(seq_start && j < 2); const size_t row = ok ? (size_t)(m0 - 2 + j) : (size_t)m0;
            const bf16* pr = P1 + row * NP1 + hc;
            const float x0 = bf1(pr[C_R]), x1 = bf1(pr[C_K]), x2 = bf1(pr[C_V]);
            rr[j] = ok ? x0 : 0.f; rk[j] = ok ? x1 : 0.f; rv[j] = ok ? x2 : 0.f;
            if (j >= 1) { const float y0 = LO[row * NLORA + hc], y1 = LO[row * NLORA + BW + hc]; lw[j] = ok ? y0 : 0.f; la[j] = ok ? y1 : 0.f; } else { lw[j] = 0.f; la[j] = 0.f; }
        }
        float tr[NS], tk[NS], tv[NS], tw[NS], ta[NS], tq[NS];
#pragma unroll
        for (int j = 1; j < NS; ++j) {
            tr[j] = rr[j] + (rr[j - 1] - rr[j]) * mur; tk[j] = rk[j] + (rk[j - 1] - rk[j]) * muk; tv[j] = rv[j] + (rv[j - 1] - rv[j]) * muv;
            const float xx = -(w0 + lw[j]); const float sp = fmaxf(xx, 0.f) + __logf(1.0f + __expf(-fabsf(xx)));
            tw[j] = __expf(-__expf(-sp - 0.5f));
            ta[j] = 1.0f / (1.0f + __expf(-(a0 + la[j])));
            const float kkr = tk[j] * kkw; tq[j] = kkr * kkr;
        }
#pragma unroll
        for (int j = 1; j < NS; ++j) tq[j] = wsum(tq[j]);
        float tkk[NS], tb_[NS], tkt[NS];
#pragma unroll
        for (int j = 1; j < NS; ++j) { tkk[j] = tk[j] * kkw / fmaxf(sqrtf(tq[j]), 1e-12f); tb_[j] = tkk[j] * ta[j]; tkt[j] = tk[j] * (1.0f + (ta[j] - 1.0f) * kaw); }
        float be[NS], ka[NS];
#pragma unroll
        for (int j = 2; j < NS; ++j) { be[j] = wsum(tb_[j - 1] * tkk[j]); ka[j] = wsum(tkt[j - 1] * tkk[j]); }
#pragma unroll
        for (int j = 2; j < NS; ++j) {
            const int m = m0 + j - 2; const size_t o = (size_t)m * BW + hc; const bool first = (m & (SEQ - 1)) == 0;
            SR[o] = tr[j]; SW[o] = tw[j]; SK[o] = tkt[j]; SB[o] = tb_[j]; SV[o] = tv[j];
            if (!first) SU[o - BW] = tw[j - 1] * tkk[j];
            if ((m & (SEQ - 1)) == SEQ - 1) SU[o] = 0.f;
            if (C.lane < 2) BK[((size_t)m * 12 + h) * 2 + C.lane] = first ? 0.f : (C.lane == 0 ? be[j] : ka[j]);
        }
    }
}

__device__ __forceinline__ void scan_block(const Ctx& C, int sb, unsigned char* ws) {
    const int b = sb / 24, h = (sb % 24) >> 1, half = sb & 1;
    const float* SR = (const float*)(ws + WS_SR); const float* SW = (const float*)(ws + WS_SW); const float* SK = (const float*)(ws + WS_SK); const float* SKK = (const float*)(ws + WS_SKK);
    const float* SB = (const float*)(ws + WS_SB); const float* SV = (const float*)(ws + WS_SV); float* YR = (float*)(ws + WS_YRAW);
    constexpr int T = 64;
    LAS float* Lr = (LAS float*)(C.lds + RING_OFF); LAS float* Lw = Lr + T * 64; LAS float* Lk = Lw + T * 64; LAS float* Lkk = Lk + T * 64; LAS float* Lb = Lkk + T * 64;
    LAS float* Lv = Lb + T * 64; LAS float* Ly = Lv + T * 32;
    const int tid = C.tid, rl = tid >> 4, kq = tid & 15;
    const size_t rowbase = (size_t)b * SEQ; const int colh = h * 64;
    const int lt0 = tid >> 4, lc0 = (tid & 15) * 4, vt = tid >> 3, vc = (tid & 7) * 4;
    f32x4 pr[2], pw[2], pk[2], pkk[2], pb[2], pv;
#define SCAN_LOAD(t0) do { _Pragma("unroll") for (int i = 0; i < 2; ++i) { const size_t o = (rowbase + (t0) + lt0 + 32 * i) * BW + colh + lc0; \
        pr[i] = *(const f32x4*)(SR + o); pw[i] = *(const f32x4*)(SW + o); pk[i] = *(const f32x4*)(SK + o); pkk[i] = *(const f32x4*)(SKK + o); pb[i] = *(const f32x4*)(SB + o); } \
        pv = *(const f32x4*)(SV + (rowbase + (t0) + vt) * BW + colh + 32 * half + vc); } while (0)
    SCAN_LOAD(0);
    float S0 = 0.f, S1 = 0.f, S2 = 0.f, S3 = 0.f;
    for (int ch = 0; ch < SEQ / T; ++ch) {
        const int t0 = ch * T;
#pragma unroll
        for (int i = 0; i < 2; ++i) { const int lo = (lt0 + 32 * i) * 64 + lc0;
            *(LAS f32x4*)(Lr + lo) = pr[i]; *(LAS f32x4*)(Lw + lo) = pw[i]; *(LAS f32x4*)(Lk + lo) = pk[i]; *(LAS f32x4*)(Lkk + lo) = pkk[i]; *(LAS f32x4*)(Lb + lo) = pb[i]; }
        *(LAS f32x4*)(Lv + vt * 32 + vc) = pv;
        __syncthreads();
        if (ch + 1 < SEQ / T) SCAN_LOAD(t0 + T);
#pragma unroll 4
        for (int t = 0; t < T; ++t) {
            const f32x4 kk4 = *(const LAS f32x4*)(Lkk + t * 64 + kq * 4), w4 = *(const LAS f32x4*)(Lw + t * 64 + kq * 4), b4 = *(const LAS f32x4*)(Lb + t * 64 + kq * 4);
            const f32x4 k4 = *(const LAS f32x4*)(Lk + t * 64 + kq * 4), r4 = *(const LAS f32x4*)(Lr + t * 64 + kq * 4); const float v = Lv[t * 32 + rl];
            float d = (S0 * kk4.x + S1 * kk4.y) + (S2 * kk4.z + S3 * kk4.w); d = red16(d); const float sa = -d;
            S0 = S0 * w4.x + (sa * b4.x + v * k4.x); S1 = S1 * w4.y + (sa * b4.y + v * k4.y); S2 = S2 * w4.z + (sa * b4.z + v * k4.z); S3 = S3 * w4.w + (sa * b4.w + v * k4.w);
            float y = (S0 * r4.x + S1 * r4.y) + (S2 * r4.z + S3 * r4.w); y = red16(y);
            if (kq == 0) Ly[t * 32 + rl] = y;
        }
        __syncthreads();
        *(f32x4*)(YR + (rowbase + t0 + vt) * BW + colh + 32 * half + vc) = *(const LAS f32x4*)(Ly + vt * 32 + vc);
    }
#undef SCAN_LOAD
}

__device__ __forceinline__ void glds16(const void* gsrc, unsigned lds_dst) { unsigned keep;
    asm volatile("s_mov_b32 %0, m0\n\ts_mov_b32 m0, %2\n\ts_nop 0\n\tglobal_load_lds_dwordx4 %1, off\n\ts_mov_b32 m0, %0" : "=&s"(keep) : "v"(gsrc), "s"(lds_dst) : "memory"); }
__device__ __forceinline__ void glds4(const void* gsrc, unsigned lds_dst) { unsigned keep;
    asm volatile("s_mov_b32 %0, m0\n\ts_mov_b32 m0, %2\n\ts_nop 0\n\tglobal_load_lds_dword %1, off\n\ts_mov_b32 m0, %0" : "=&s"(keep) : "v"(gsrc), "s"(lds_dst) : "memory"); }
constexpr int SCAN_T = 8, SCAN_SLOT = 5 * SCAN_T * 256 + 512, SCAN_NSLOT = 3, SCAN_RING = SCAN_NSLOT * SCAN_SLOT;
typedef float f32x2 __attribute__((ext_vector_type(2)));
__device__ __forceinline__ void scan_wave(int lane, LAS unsigned char* ring, int hs, int r0, unsigned char* ws) {
    const int b = hs / 12, h = hs % 12;
    const float* SR = (const float*)(ws + WS_SR); const float* SW = (const float*)(ws + WS_SW); const float* SK = (const float*)(ws + WS_SK); const float* SU = (const float*)(ws + WS_SKK);
    const float* SB = (const float*)(ws + WS_SB); const float* SV = (const float*)(ws + WS_SV); const float* BK = (const float*)(ws + WS_BK); float* YR = (float*)(ws + WS_YRAW);
    const int rg = lane >> 4, kq = lane & 15;
    const size_t rowbase = (size_t)b * SEQ; const int colh = h * 64;
    const unsigned ring0 = (unsigned)(size_t)ring;
    const size_t voff = ((size_t)(lane >> 4)) * BW + colh + 4 * kq;
    const size_t vvoff = ((size_t)((lane & 31) >> 2)) * BW + colh + r0 + (lane & 3);
    const size_t bkoff = ((size_t)((lane & 15) >> 1) * 12 + h) * 2 + (lane & 1);
    constexpr int NCH = SEQ / SCAN_T;
#define SCAN_DMA(ch, slot) do { const int cc_ = (ch) < NCH ? (ch) : NCH - 1; const size_t tok_ = rowbase + (size_t)cc_ * SCAN_T; const unsigned sl_ = ring0 + (unsigned)(slot) * SCAN_SLOT; \
        _Pragma("unroll") for (int i_ = 0; i_ < 2; ++i_) { const size_t o_ = (tok_ + 4 * i_) * BW + voff; \
            glds16(SU + o_, sl_ + 0 * 2048 + i_ * 1024); glds16(SW + o_, sl_ + 1 * 2048 + i_ * 1024); glds16(SB + o_, sl_ + 2 * 2048 + i_ * 1024); glds16(SK + o_, sl_ + 3 * 2048 + i_ * 1024); glds16(SR + o_, sl_ + 4 * 2048 + i_ * 1024); } \
        glds4(SV + tok_ * BW + vvoff, sl_ + 10240); glds4(BK + tok_ * 24 + bkoff, sl_ + 10496); } while (0)
    SCAN_DMA(0, 0); SCAN_DMA(1, 1); SCAN_DMA(2, 2);
    f32x2 S01 = (f32x2){0.f, 0.f}, S23 = (f32x2){0.f, 0.f};
    float e_cur = 0.f, sa_prev = 0.f, v_prev = 0.f;
    int slot = 0;
    for (int ch = 0; ch < NCH; ++ch) {
        asm volatile("s_waitcnt vmcnt(24)" ::: "memory");
        const LAS unsigned char* sp = ring + slot * SCAN_SLOT;
        float ykeep = 0.f;
        f32x4 u4a[SCAN_T], w4a[SCAN_T], b4a[SCAN_T], k4a[SCAN_T], r4a[SCAN_T]; float va[SCAN_T]; f32x2 bka[SCAN_T];
#pragma unroll
        for (int tt = 0; tt < SCAN_T; ++tt) {
            u4a[tt] = *(const LAS f32x4*)(sp + 0 * 2048 + tt * 256 + kq * 16); bka[tt] = *(const LAS f32x2*)(sp + 10496 + tt * 8); va[tt] = *(const LAS float*)(sp + 10240 + tt * 16 + rg * 4);
            w4a[tt] = *(const LAS f32x4*)(sp + 1 * 2048 + tt * 256 + kq * 16); b4a[tt] = *(const LAS f32x4*)(sp + 2 * 2048 + tt * 256 + kq * 16);
            k4a[tt] = *(const LAS f32x4*)(sp + 3 * 2048 + tt * 256 + kq * 16); r4a[tt] = *(const LAS f32x4*)(sp + 4 * 2048 + tt * 256 + kq * 16); }
#pragma unroll
        for (int tt = 0; tt < SCAN_T; ++tt) {
            const f32x4 u4 = u4a[tt], w4 = w4a[tt], b4 = b4a[tt], k4 = k4a[tt], r4 = r4a[tt]; const float v = va[tt]; const f32x2 bk = bka[tt];
            f32x2 pe = S01 * (f32x2){u4.x, u4.y}; pe = S23 * (f32x2){u4.z, u4.w} + pe; const float e_next = red16(pe.x + pe.y);
            const float d = e_cur + sa_prev * bk.x + v_prev * bk.y; const float sa = -d;
            const f32x2 sav = (f32x2){sa, sa}, vv = (f32x2){v, v};
            S01 = S01 * (f32x2){w4.x, w4.y} + (sav * (f32x2){b4.x, b4.y} + vv * (f32x2){k4.x, k4.y});
            S23 = S23 * (f32x2){w4.z, w4.w} + (sav * (f32x2){b4.z, b4.w} + vv * (f32x2){k4.z, k4.w});
            f32x2 py = S01 * (f32x2){r4.x, r4.y}; py = S23 * (f32x2){r4.z, r4.w} + py; const float y = red16(py.x + py.y);
            ykeep = (kq == tt) ? y : ykeep;
            e_cur = e_next; sa_prev = sa; v_prev = v;
        }
        if (kq < SCAN_T) YR[(rowbase + (size_t)ch * SCAN_T + kq) * BW + colh + r0 + rg] = ykeep;
        SCAN_DMA(ch + 3, slot);
        slot = (slot == SCAN_NSLOT - 1) ? 0 : slot + 1;
    }
    asm volatile("s_waitcnt vmcnt(0)" ::: "memory");
#undef SCAN_DMA
}

struct AttnPass { int qcol; int bias_head; int tbl; float sink; int use_sink; int maxsteps; bf16* out; int out_ld; int out_col; float* lse; };
__device__ __forceinline__ void attn_stage_kv(const Ctx& C, const bf16* P1, int b, int res, int dil, int fblk, int kcol, int vcol) {
    LAS unsigned char* Ks = C.lds + RING_OFF; LAS unsigned char* Vs = Ks + 256 * 144;
#pragma unroll
    for (int i = 0; i < 4; ++i) { const int c = C.tid + 512 * i, row = c >> 3, part = c & 7; const int fp = (fblk - 1) * 128 + row;
        v4u kv = (v4u){0u, 0u, 0u, 0u}, vv = (v4u){0u, 0u, 0u, 0u};
        if (fp >= 0) { const bf16* src = P1 + ((size_t)b * SEQ + (size_t)fp * dil + res) * NP1; kv = *(const v4u*)(src + kcol + part * 8); vv = *(const v4u*)(src + vcol + part * 8); }
        *(LAS v4u*)(Ks + row * 144 + part * 16) = kv; *(LAS v4u*)(Vs + row * 144 + part * 16) = vv; }
}
__device__ __forceinline__ void attn_pass(const Ctx& C, const bf16* P1, const float* relb, int b, int res, int dil, int fblk, const AttnPass& ap) {
    LAS unsigned char* Ks = C.lds + RING_OFF; LAS unsigned char* Vs = Ks + 256 * 144; LAS float* lut = (LAS float*)(Vs + 256 * 144);
    __syncthreads();
    if (C.tid < 132) lut[C.tid] = (C.tid <= 128) ? relb[(int)T5B[ap.tbl][C.tid] * 20 + ap.bias_head] : 0.f;
    __syncthreads();
    const int i = C.tid >> 2, dq = C.tid & 3;
    const size_t tok = (size_t)b * SEQ + (size_t)(fblk * 128 + i) * dil + res;
    float q[16];
    { const bf16* qp = P1 + tok * NP1 + ap.qcol + dq * 16; const v4u a0 = *(const v4u*)qp, a1 = *(const v4u*)(qp + 8);
      q[0] = bflo(a0.x); q[1] = bfhi(a0.x); q[2] = bflo(a0.y); q[3] = bfhi(a0.y); q[4] = bflo(a0.z); q[5] = bfhi(a0.z); q[6] = bflo(a0.w); q[7] = bfhi(a0.w);
      q[8] = bflo(a1.x); q[9] = bfhi(a1.x); q[10] = bflo(a1.y); q[11] = bfhi(a1.y); q[12] = bflo(a1.z); q[13] = bfhi(a1.z); q[14] = bflo(a1.w); q[15] = bfhi(a1.w);
#pragma unroll
      for (int j = 0; j < 16; ++j) q[j] *= 0.125f; }
    float mrun = ap.use_sink ? ap.sink : -INFINITY, lrun = ap.use_sink ? 1.0f : 0.0f;
    float o[16];
#pragma unroll
    for (int j = 0; j < 16; ++j) o[j] = 0.f;
    const int fq0 = fblk * 128 + i;
    for (int dist = 0; dist <= ap.maxsteps; ++dist) {
        const int kr = i + 128 - dist;
        const bool valid = (fq0 - dist) >= 0;
        const v4u k0 = *(const LAS v4u*)(Ks + kr * 144 + dq * 32), k1 = *(const LAS v4u*)(Ks + kr * 144 + dq * 32 + 16);
        float s = q[0] * bflo(k0.x) + q[1] * bfhi(k0.x) + q[2] * bflo(k0.y) + q[3] * bfhi(k0.y) + q[4] * bflo(k0.z) + q[5] * bfhi(k0.z) + q[6] * bflo(k0.w) + q[7] * bfhi(k0.w)
                + q[8] * bflo(k1.x) + q[9] * bfhi(k1.x) + q[10] * bflo(k1.y) + q[11] * bfhi(k1.y) + q[12] * bflo(k1.z) + q[13] * bfhi(k1.z) + q[14] * bflo(k1.w) + q[15] * bfhi(k1.w);
        s = red4(s) + lut[dist];
        if (valid) {
            if (s > mrun) { const float c = __expf(mrun - s); lrun *= c;
#pragma unroll
                for (int j = 0; j < 16; ++j) o[j] *= c;
                mrun = s; }
            const float p = __expf(s - mrun); lrun += p;
            const v4u v0 = *(const LAS v4u*)(Vs + kr * 144 + dq * 32), v1 = *(const LAS v4u*)(Vs + kr * 144 + dq * 32 + 16);
            o[0] += p * bflo(v0.x); o[1] += p * bfhi(v0.x); o[2] += p * bflo(v0.y); o[3] += p * bfhi(v0.y); o[4] += p * bflo(v0.z); o[5] += p * bfhi(v0.z); o[6] += p * bflo(v0.w); o[7] += p * bfhi(v0.w);
            o[8] += p * bflo(v1.x); o[9] += p * bfhi(v1.x); o[10] += p * bflo(v1.y); o[11] += p * bfhi(v1.y); o[12] += p * bflo(v1.z); o[13] += p * bfhi(v1.z); o[14] += p * bflo(v1.w); o[15] += p * bfhi(v1.w);
        }
    }
    const float inv = 1.0f / lrun;
    v4u w0, w1;
    w0.x = pk2(o[0] * inv, o[1] * inv); w0.y = pk2(o[2] * inv, o[3] * inv); w0.z = pk2(o[4] * inv, o[5] * inv); w0.w = pk2(o[6] * inv, o[7] * inv);
    w1.x = pk2(o[8] * inv, o[9] * inv); w1.y = pk2(o[10] * inv, o[11] * inv); w1.z = pk2(o[12] * inv, o[13] * inv); w1.w = pk2(o[14] * inv, o[15] * inv);
    bf16* op = ap.out + tok * ap.out_ld + ap.out_col + dq * 16;
    *(v4u*)op = w0; *(v4u*)(op + 8) = w1;
    if (ap.lse && dq == 0) ap.lse[tok * 4] = mrun + __logf(lrun);
}
__device__ __forceinline__ void phase_attn(const Ctx& C, const Args& a, int l, unsigned char* ws, int ab, int nab) {
    const bf16* P1 = (const bf16*)(ws + WS_P1); const float* relb = a.in[1]; const float* sinks = a.in[4] + l * 8;
    bf16* YA = (bf16*)(ws + WS_YA); bf16* OC = (bf16*)(ws + WS_OC); float* LSE = (float*)(ws + WS_LSE);
    constexpr int NA = 256, NC = 1536;
    for (int it = ab; it < NA + NC; it += nab) {
        __syncthreads();
        if (it < NA) {
            const int b = it >> 7, fblk = (it >> 1) & 63, hkv = it & 1;
            attn_stage_kv(C, P1, b, 0, 1, fblk, C_AK + hkv * 64, C_AV + hkv * 64);
            for (int g = 0; g < 4; ++g) { const int hq = hkv * 4 + g;
                AttnPass ap; ap.qcol = C_AQ + hq * 64; ap.bias_head = hq; ap.tbl = 0; ap.sink = sinks[hq]; ap.use_sink = 1; ap.maxsteps = 127; ap.out = YA; ap.out_ld = 512; ap.out_col = hq * 64; ap.lse = nullptr;
                attn_pass(C, P1, relb, b, 0, 1, fblk, ap); }
        } else {
            const int ci = it - NA; const int gi = ci / 512, j = (ci >> 7) & 3, qb = ci & 127;
            const int dil = (gi == 0) ? 1 : (gi == 1 ? 4 : 16); const int bps = 64 / dil;
            const int n = qb / bps, fblk = qb % bps, b = n / dil, res = n % dil; const int hc = gi * 4 + j;
            attn_stage_kv(C, P1, b, res, dil, fblk, C_CK + hc * 64, C_CV + hc * 64);
            AttnPass ap; ap.qcol = C_CQ + hc * 64; ap.bias_head = 8 + hc; ap.tbl = gi; ap.sink = 0.f; ap.use_sink = 0; ap.maxsteps = 128; ap.out = OC + (size_t)gi * M * 256; ap.out_ld = 256; ap.out_col = j * 64;
            ap.lse = LSE + (size_t)gi * M * 4 + j;
            attn_pass(C, P1, relb, b, res, dil, fblk, ap);
        }
    }
}

__device__ __forceinline__ void phase_vt(const Ctx& C, unsigned char* ws) {
    const bf16* P1 = (const bf16*)(ws + WS_P1); bf16* VT = (bf16*)(ws + WS_VT);
    for (int it = C.gw; it < 14 * 2 * 128; it += C.ngw) {
        const int hs = it / 256, b = (it >> 7) & 1, blk = it & 127;
        const int gi = hs < 2 ? 0 : (hs - 2) >> 2; const int dil = gi == 0 ? 1 : (gi == 1 ? 4 : 16); const int Lf = SEQ / dil;
        const int vcol = hs < 2 ? C_AV + hs * 64 : C_CV + (hs - 2) * 64;
        const int ft = blk * 64 + C.lane;
        const int res = ft / Lf, tp = ft % Lf; const int tok = b * SEQ + tp * dil + res;
        const v4u* src = (const v4u*)(P1 + (size_t)tok * NP1 + vcol);
        v4u x[8];
#pragma unroll
        for (int i = 0; i < 8; ++i) x[i] = src[i];
        bf16* dst = VT + ((size_t)(hs * 2 + b) * 64) * SEQ + ft;
#pragma unroll
        for (int i = 0; i < 8; ++i) {
            dst[(size_t)(8 * i + 0) * SEQ] = (bf16)(x[i].x & 0xffffu); dst[(size_t)(8 * i + 1) * SEQ] = (bf16)(x[i].x >> 16);
            dst[(size_t)(8 * i + 2) * SEQ] = (bf16)(x[i].y & 0xffffu); dst[(size_t)(8 * i + 3) * SEQ] = (bf16)(x[i].y >> 16);
            dst[(size_t)(8 * i + 4) * SEQ] = (bf16)(x[i].z & 0xffffu); dst[(size_t)(8 * i + 5) * SEQ] = (bf16)(x[i].z >> 16);
            dst[(size_t)(8 * i + 6) * SEQ] = (bf16)(x[i].w & 0xffffu); dst[(size_t)(8 * i + 7) * SEQ] = (bf16)(x[i].w >> 16);
        }
    }
}

typedef float f32x16 __attribute__((ext_vector_type(16)));
constexpr int LUT_OFF = 0, SCANRING_OFF = 12288, CONV_SCR_SCAN = 77824, CONV_SCR_OTHER = 12288;
__device__ __forceinline__ void attn_wave_item(int lane, const LAS float* lutall, int item, const float* sinks, unsigned char* ws) {
    const bf16* P1 = (const bf16*)(ws + WS_P1); const bf16* VT = (const bf16*)(ws + WS_VT);
    const int hh = item % 20, g32 = item / 20;
    const bool isA = hh < 8; const int hc = hh - 8; const int gi = isA ? 0 : hc >> 2, j = hc & 3;
    const int dil = gi == 0 ? 1 : (gi == 1 ? 4 : 16); const int Lf = SEQ / dil, gps = Lf / 32;
    const int b = g32 >> 8, rr = g32 & 255, res = rr / gps, qg = rr % gps, fq0 = qg * 32;
    const int qcol = isA ? C_AQ + hh * 64 : C_CQ + hc * 64, kcol = isA ? C_AK + (hh >> 2) * 64 : C_CK + hc * 64;
    const int hs = isA ? (hh >> 2) : 2 + hc; const int maxsteps = isA ? 127 : 128;
    const LAS float* lut = lutall + hh * 132;
    const int r = lane & 31, hf = lane >> 5;
    const size_t tokq = (size_t)b * SEQ + (size_t)(fq0 + r) * dil + res;
    pg8::bf16x8 qf[4];
    { const bf16* qrow = P1 + tokq * NP1 + qcol + 8 * hf;
#pragma unroll
      for (int s_ = 0; s_ < 4; ++s_) qf[s_] = *(const pg8::bf16x8*)(qrow + 16 * s_); }
    f32x16 sc[5];
#pragma unroll
    for (int kt = 0; kt < 5; ++kt) {
        int fk = fq0 - 128 + 32 * kt + r; fk = fk < 0 ? 0 : fk;
        const bf16* krow = P1 + ((size_t)b * SEQ + (size_t)fk * dil + res) * NP1 + kcol + 8 * hf;
        f32x16 acc;
#pragma unroll
        for (int q = 0; q < 16; ++q) acc[q] = 0.f;
#pragma unroll
        for (int s_ = 0; s_ < 4; ++s_) { const pg8::bf16x8 a = *(const pg8::bf16x8*)(krow + 16 * s_); acc = __builtin_amdgcn_mfma_f32_32x32x16_bf16(a, qf[s_], acc, 0, 0, 0); }
        sc[kt] = acc;
    }
    float mx = -1e30f;
#pragma unroll
    for (int kt = 0; kt < 5; ++kt)
#pragma unroll
        for (int q = 0; q < 16; ++q) {
            const int rowoff = (q & 3) + 8 * (q >> 2) + 4 * hf; const int dist = 128 + r - 32 * kt - rowoff; const int fk = fq0 + r - dist;
            const bool valid = dist >= 0 && dist <= maxsteps && fk >= 0;
            const int di = dist < 0 ? 0 : (dist > 128 ? 128 : dist);
            const float sv = valid ? sc[kt][q] * 0.125f + lut[di] : -1e30f;
            sc[kt][q] = sv; mx = fmaxf(mx, sv);
        }
    mx = fmaxf(mx, __shfl_xor(mx, 32));
    const float sink = isA ? sinks[hh] : -1e30f;
    mx = fmaxf(mx, sink);
    float lsum = 0.f;
#pragma unroll
    for (int kt = 0; kt < 5; ++kt)
#pragma unroll
        for (int q = 0; q < 16; ++q) { const float pv = __expf(sc[kt][q] - mx); sc[kt][q] = pv; lsum += pv; }
    lsum += __shfl_xor(lsum, 32);
    const float denom = isA ? lsum + __expf(sink - mx) : lsum;
    const float inv = 1.0f / denom;
    pg8::bf16x8 pf[5][2];
#pragma unroll
    for (int kt = 0; kt < 5; ++kt)
#pragma unroll
        for (int s_ = 0; s_ < 2; ++s_) { pg8::u32x4 w;
            w.x = pg8::cvt_pk_bf16(sc[kt][8 * s_ + 0], sc[kt][8 * s_ + 1]); w.y = pg8::cvt_pk_bf16(sc[kt][8 * s_ + 2], sc[kt][8 * s_ + 3]);
            w.z = pg8::cvt_pk_bf16(sc[kt][8 * s_ + 4], sc[kt][8 * s_ + 5]); w.w = pg8::cvt_pk_bf16(sc[kt][8 * s_ + 6], sc[kt][8 * s_ + 7]);
            pf[kt][s_] = __builtin_bit_cast(pg8::bf16x8, w); }
    bf16* outp; int out_ld, ocol;
    if (isA) { outp = (bf16*)(ws + WS_YA); out_ld = 512; ocol = hh * 64; } else { outp = (bf16*)(ws + WS_OC) + (size_t)gi * M * 256; out_ld = 256; ocol = j * 64; }
    const bf16* vth = VT + ((size_t)(hs * 2 + b) * 64) * SEQ + (size_t)res * Lf;
#pragma unroll
    for (int dt = 0; dt < 2; ++dt) {
        const bf16* vrow = vth + (size_t)(32 * dt + r) * SEQ;
        f32x16 acc;
#pragma unroll
        for (int q = 0; q < 16; ++q) acc[q] = 0.f;
#pragma unroll
        for (int kt = 0; kt < 5; ++kt)
#pragma unroll
            for (int s_ = 0; s_ < 2; ++s_) {
                int k0 = fq0 - 128 + 32 * kt + 16 * s_ + 4 * hf, k1 = k0 + 8; k0 = k0 < 0 ? 0 : k0; k1 = k1 < 0 ? 0 : k1;
                const v2u lo = *(const v2u*)(vrow + k0), hi = *(const v2u*)(vrow + k1);
                pg8::u32x4 w; w.x = lo.x; w.y = lo.y; w.z = hi.x; w.w = hi.y;
                acc = __builtin_amdgcn_mfma_f32_32x32x16_bf16(__builtin_bit_cast(pg8::bf16x8, w), pf[kt][s_], acc, 0, 0, 0);
            }
        bf16* op = outp + tokq * out_ld + ocol + 32 * dt + 4 * hf;
#pragma unroll
        for (int g = 0; g < 4; ++g) { v2u w; w.x = pg8::cvt_pk_bf16(acc[4 * g + 0] * inv, acc[4 * g + 1] * inv); w.y = pg8::cvt_pk_bf16(acc[4 * g + 2] * inv, acc[4 * g + 3] * inv);
            *(v2u*)(op + 8 * g) = w; }
    }
    if (!isA && hf == 0) ((float*)(ws + WS_LSE))[((size_t)gi * M + tokq) * 4 + j] = mx + __logf(lsum);
}
__device__ __forceinline__ void build_lut(const Ctx& C, const float* relb) {
    LAS float* lut = (LAS float*)(C.lds + LUT_OFF);
    for (int i = C.tid; i < 20 * 132; i += NTHREADS) { const int hh = i / 132, d = i % 132; const int tbl = hh < 8 ? 0 : (hh - 8) >> 2;
        lut[i] = (d <= 128) ? relb[(int)T5B[tbl][d] * 20 + hh] : 0.f; }
    __syncthreads();
}

__device__ __forceinline__ void phase_post(const Ctx& C, const Args& a, int l, unsigned char* ws) {
    const float* YR = (const float*)(ws + WS_YRAW); const float* SR = (const float*)(ws + WS_SR); const float* SK = (const float*)(ws + WS_SK); const float* SV = (const float*)(ws + WS_SV);
    const float* LO = (const float*)(ws + WS_LO); bf16* YB = (bf16*)(ws + WS_YB);
    const float* rkp = a.in[13] + (size_t)l * BW; const float* lgp = a.in[14] + (size_t)l * BW; const float* lbp = a.in[15] + (size_t)l * BW;
    constexpr int TB = 8;
    for (int it = C.gw; it < (M / TB) * 12; it += C.ngw) {
        const int tb = it / 12, h = it % 12, hc = h * 64 + C.lane, m0 = tb * TB;
        const float rk = rkp[hc], lg = lgp[hc], lb = lbp[hc];
        float y[TB], bo[TB], vv[TB], gg[TB];
#pragma unroll
        for (int i = 0; i < TB; ++i) { const size_t o = (size_t)(m0 + i) * BW + hc; y[i] = YR[o]; bo[i] = SR[o] * SK[o] * rk; vv[i] = SV[o]; gg[i] = LO[(size_t)(m0 + i) * NLORA + 2 * BW + hc]; }
        float mean[TB], var[TB];
#pragma unroll
        for (int i = 0; i < TB; ++i) { mean[i] = wsum(y[i]) * (1.0f / 64.0f); bo[i] = wsum(bo[i]); }
#pragma unroll
        for (int i = 0; i < TB; ++i) { y[i] -= mean[i]; var[i] = wsum(y[i] * y[i]) * (1.0f / 64.0f); }
#pragma unroll
        for (int i = 0; i < TB; ++i) { float yn = y[i] * (1.0f / sqrtf(var[i] + GN_EPS)) * lg + lb; yn += bo[i] * vv[i]; yn *= gg[i]; YB[(size_t)(m0 + i) * BW + hc] = (bf16)f2bf(yn); }
    }
    const bf16* OC = (const bf16*)(ws + WS_OC); const float* LSE = (const float*)(ws + WS_LSE); bf16* YC = (bf16*)(ws + WS_YC);
    for (int mb = C.gw * 4; mb < M; mb += C.ngw * 4) {
        const int j = C.lane >> 4;
        float l0[4], l1[4], l2[4]; v2u a0[4], a1[4], a2[4];
#pragma unroll
        for (int i = 0; i < 4; ++i) { const int m = mb + i; l0[i] = LSE[(size_t)m * 4 + j]; l1[i] = LSE[((size_t)M + m) * 4 + j]; l2[i] = LSE[((size_t)2 * M + m) * 4 + j];
            a0[i] = *(const v2u*)(OC + (size_t)m * 256 + 4 * C.lane); a1[i] = *(const v2u*)(OC + ((size_t)M + m) * 256 + 4 * C.lane); a2[i] = *(const v2u*)(OC + ((size_t)2 * M + m) * 256 + 4 * C.lane); }
#pragma unroll
        for (int i = 0; i < 4; ++i) { const int m = mb + i;
            const float mx = fmaxf(l0[i], fmaxf(l1[i], l2[i])); const float e0 = __expf(l0[i] - mx), e1 = __expf(l1[i] - mx), e2 = __expf(l2[i] - mx); const float inv = 1.0f / (e0 + e1 + e2);
            const float w0 = e0 * inv, w1 = e1 * inv, w2 = e2 * inv;
            v2u o; o.x = pk2(w0 * bflo(a0[i].x) + w1 * bflo(a1[i].x) + w2 * bflo(a2[i].x), w0 * bfhi(a0[i].x) + w1 * bfhi(a1[i].x) + w2 * bfhi(a2[i].x));
            o.y = pk2(w0 * bflo(a0[i].y) + w1 * bflo(a1[i].y) + w2 * bflo(a2[i].y), w0 * bfhi(a0[i].y) + w1 * bfhi(a1[i].y) + w2 * bfhi(a2[i].y));
            *(v2u*)(YC + (size_t)m * 256 + 4 * C.lane) = o; }
    }
}

__device__ __forceinline__ void unpack8(const v4u w, float (&x)[8]) { x[0] = bflo(w.x); x[1] = bfhi(w.x); x[2] = bflo(w.y); x[3] = bfhi(w.y); x[4] = bflo(w.z); x[5] = bfhi(w.z); x[6] = bflo(w.w); x[7] = bfhi(w.w); }
__device__ __forceinline__ void phase_conv(const Ctx& C, const Args& a, int l, unsigned char* ws) {
    const bf16* U = (const bf16*)(ws + WS_U); bf16* ACT = (bf16*)(ws + WS_ACT); const float* cw = a.in[22] + (size_t)l * 3 * DFF;
    constexpr int GPR = DFF / 8, RUN = 32;
    const int gt = C.bid * NTHREADS + C.tid, ngt = C.G * NTHREADS;
    for (int idx = gt; idx < (M / RUN) * GPR; idx += ngt) {
        const int run = idx / GPR, f0 = (idx % GPR) * 8, m0 = run * RUN;
        float c0[8], c1[8], c2[8];
#pragma unroll
        for (int j = 0; j < 8; ++j) { c0[j] = cw[f0 + j]; c1[j] = cw[DFF + f0 + j]; c2[j] = cw[2 * DFF + f0 + j]; }
        const bf16* ur = U + (size_t)m0 * NUP + f0;
        float x0[8], x1[8];
        { v4u g0 = (v4u){0u, 0u, 0u, 0u}, g1 = (v4u){0u, 0u, 0u, 0u};
          if ((m0 & (SEQ - 1)) != 0) { g0 = *(const v4u*)(ur - 2 * NUP); g1 = *(const v4u*)(ur - NUP); }
          unpack8(g0, x0); unpack8(g1, x1); }
#pragma unroll 1
        for (int tq = 0; tq < RUN; tq += 4) {
            v4u gq[4], vq[4];
#pragma unroll
            for (int i = 0; i < 4; ++i) { gq[i] = *(const v4u*)(ur + (size_t)(tq + i) * NUP); vq[i] = *(const v4u*)(ur + (size_t)(tq + i) * NUP + DFF); }
#pragma unroll
            for (int i = 0; i < 4; ++i) {
                float x2[8], vl[8], r[8]; unpack8(gq[i], x2); unpack8(vq[i], vl);
#pragma unroll
                for (int j = 0; j < 8; ++j) { const float gsum = c0[j] * x0[j] + c1[j] * x1[j] + c2[j] * x2[j]; r[j] = gsum / (1.0f + __expf(-gsum)) * vl[j]; x0[j] = x1[j]; x1[j] = x2[j]; }
                v4u o; o.x = pk2(r[0], r[1]); o.y = pk2(r[2], r[3]); o.z = pk2(r[4], r[5]); o.w = pk2(r[6], r[7]);
                *(v4u*)(ACT + (size_t)(m0 + tq + i) * DFF + f0) = o;
            }
        }
    }
}

__device__ __forceinline__ Ctx make_ctx(unsigned char* lds) {
    Ctx C;
    C.lds = (LAS unsigned char*)lds;
    int t = threadIdx.x; asm volatile("" : "+v"(t));
    C.tid = t; C.lane = C.tid & 63; C.wave = __builtin_amdgcn_readfirstlane(C.tid >> 6);
    C.G = gridDim.x; C.bid = blockIdx.x; C.gw = C.bid * NWAVES + C.wave; C.ngw = C.G * NWAVES;
    return C;
}
template <int K> __device__ __forceinline__ void run_phase(unsigned char* lds, const Args& args, int l) {
    const Ctx C = make_ctx(lds);
    unsigned char* ws = args.ws; asm volatile("" : "+s"(ws)); unsigned char* wsw = ws + (size_t)(l & 1) * WSET_STRIDE; LAS unsigned char* ring = C.lds + RING_OFF; float* out = args.out;
    const float* xsrc = (l == 0) ? args.in[0] : out;
    if constexpr (K == 0) { phase_prep(C, args, l, xsrc, ws); }
    if constexpr (K == 1) { pg8::Gemm g{(const bf16*)(ws + WS_H), (const bf16*)(wsw + WS_WIN), M, NP1, D}; pg8::StaticOrder S; S.init(M, NP1, C.G, C.bid);
        pg8::EpiWin E{(bf16*)(ws + WS_P1), (bf16*)(ws + WS_G), 0};
        pg8::gemm_phase<pg8::EpiWin, pg8::StaticOrder, true, true>(ring, g, S, E); }
    if constexpr (K == 2) { phase_aprime(C, args, l, ws); phase_vt(C, ws); }
    if constexpr (K == 3) { pg8::Gemm g{(const bf16*)(ws + WS_AP), (const bf16*)(wsw + WS_WLORA), M, NLORA, KLORA}; pg8::StaticOrder S; S.init(M, NLORA, C.G, C.bid);
        pg8::EpiF32P E{(float*)(ws + WS_LO), NLORA};
        pg8::gemm_phase<pg8::EpiF32P, pg8::StaticOrder, true, true>(ring, g, S, E); }
    if constexpr (K == 4) { phase_scanprep(C, args, l, ws); }
    if constexpr (K == 5) {
        const int xg = C.bid & 7, jj = C.bid >> 3;
        if (jj < 12) {
            if (C.wave < 4) { for (int rep = 0; rep < EXP_SCAN_REPS; ++rep) scan_wave(C.lane, C.lds + SCANRING_OFF + C.wave * SCAN_RING, xg * 3 + (jj >> 2), ((jj & 3) * 4 + C.wave) * 4, ws); }
        } else {
            const int gidx = (jj - 12) * 8 + xg;
            build_lut(C, args.in[1]);
            { const float* sinks = args.in[4] + l * 8;
              for (int rep = 0; rep < EXP_ATTN_REPS; ++rep) for (int it = gidx * 8 + C.wave; it < 512 * 20; it += 1280) attn_wave_item(C.lane, (const LAS float*)(C.lds + LUT_OFF), it, sinks, ws); }
            __syncthreads();
            { pg8::Gemm g{(const bf16*)(ws + WS_H), (const bf16*)(wsw + WS_WIN) + (size_t)NP1 * D, M, NG, D}; pg8::StaticOrder S; S.init(M, NG, 160, gidx);
              pg8::EpiWin E{(bf16*)(ws + WS_P1), (bf16*)(ws + WS_G), 23};
              pg8::gemm_phase<pg8::EpiWin, pg8::StaticOrder, true, true>(ring, g, S, E); }
            if (l + 1 < DEPTH) convert_weights(gidx * 8 + C.wave, 1280, C.lane, (LAS float*)(C.lds + RING_OFF + C.wave * 16384), args, l + 1, ws);
        } }
    if constexpr (K == 6) { phase_post(C, args, l, ws); }
    if constexpr (K == 7) {
        { pg8::Gemm g{(const bf16*)(ws + WS_YA), (const bf16*)(wsw + WS_PA), M, D, 512}; pg8::StaticOrder S; S.init(M, D, C.G, C.bid);
          pg8::EpiGate<false> E{(const bf16*)(ws + WS_G), 0, (bf16*)(ws + WS_MG)};
          pg8::gemm_phase<pg8::EpiGate<false>, pg8::StaticOrder, true, true>(ring, g, S, E); }
        { pg8::Gemm g{(const bf16*)(ws + WS_YB), (const bf16*)(wsw + WS_PB), M, D, 768}; pg8::StaticOrder S; S.init(M, D, C.G, C.bid);
          pg8::EpiGate<true> E{(const bf16*)(ws + WS_G), 2048, (bf16*)(ws + WS_MG)};
          pg8::gemm_phase<pg8::EpiGate<true>, pg8::StaticOrder, true, true>(ring, g, S, E); }
        { pg8::Gemm g{(const bf16*)(ws + WS_YC), (const bf16*)(wsw + WS_PC), M, D, 256}; pg8::StaticOrder S; S.init(M, D, C.G, C.bid);
          pg8::EpiGate<true> E{(const bf16*)(ws + WS_G), 4096, (bf16*)(ws + WS_MG)};
          pg8::gemm_phase<pg8::EpiGate<true>, pg8::StaticOrder, true, true>(ring, g, S, E); } }
    if constexpr (K == 8) { pg8::Gemm g{(const bf16*)(ws + WS_MG), (const bf16*)(wsw + WS_WOUT), M, D, D}; pg8::StaticOrder S; S.init(M, D, C.G, C.bid);
        pg8::EpiResid E{xsrc, out};
        pg8::gemm_phase<pg8::EpiResid, pg8::StaticOrder, true, true>(ring, g, S, E); }
    if constexpr (K == 9) { const float* g2 = args.in[20] + (size_t)l * D; bf16* H = (bf16*)(ws + WS_H);
        for (int m = 2 * C.gw; m < M; m += 2 * C.ngw) rms_row2_bf16(out + (size_t)m * D, g2, H + (size_t)m * D, C.lane); }
    if constexpr (K == 10) { pg8::Gemm g{(const bf16*)(ws + WS_H) - 2 * D, (const bf16*)(wsw + WS_WUP), 65 * 256, NUP, D}; pg8::StaticOrder S; S.init(65 * 256, NUP, C.G, C.bid);
        pg8::EpiConv E{(bf16*)(ws + WS_ACT), args.in[22] + (size_t)l * 3 * DFF, (PG8_LAS float*)(C.lds + 131072)};
        pg8::gemm_phase<pg8::EpiConv, pg8::StaticOrder, true, true>(ring, g, S, E); }
    if constexpr (K == 12) { pg8::Gemm g{(const bf16*)(ws + WS_ACT), (const bf16*)(wsw + WS_WDOWN), M, D, DFF}; pg8::StaticOrder S; S.init(M, D, C.G, C.bid);
        pg8::EpiResid E{out, out};
        pg8::gemm_phase<pg8::EpiResid, pg8::StaticOrder, true, true>(ring, g, S, E); }
    if constexpr (K == 13) { const float* gf = args.in[24];
        for (int m = C.gw; m < M; m += C.ngw) rms_row_f32(out + (size_t)m * D, gf, C.lane); }
}
template <int K> __global__ void __launch_bounds__(NTHREADS, 2) fwd_phase(Args args) {
    extern __shared__ __attribute__((aligned(16))) unsigned char lds[];
    run_phase<K>(lds, args, args.li);
}
#ifndef EXP_BAR_REPS
#define EXP_BAR_REPS 1
#endif
#define XBAR(b) do { for (int r_ = 0; r_ < EXP_BAR_REPS; ++r_) xcd_barrier(b); } while (0)
__global__ void __launch_bounds__(NTHREADS, 2) fwd_all(Args args) {
    extern __shared__ __attribute__((aligned(16))) unsigned char lds[];
    { LAS unsigned* ctlw = (LAS unsigned*)((LAS unsigned char*)lds + LDSCTL_OFF); for (int u = threadIdx.x; u < (LDS_BYTES - LDSCTL_OFF) / 4; u += NTHREADS) ctlw[u] = 0u; }
    __syncthreads();
    const XcdBarrier bar = xcd_barrier_post((unsigned*)(args.ws + WS_CTL) + CW_BAR, (volatile LAS unsigned*)((LAS unsigned char*)lds + MISC_OFF) + 8);
    for (int l = 0; l < DEPTH; ++l) {
        for (int rep = 0; rep < (((EXP_EW_MASK >> 0) & 1) ? 2 : 1); ++rep) { run_phase<0>(lds, args, l); XBAR(bar); }
        for (int rep = 0; rep < EXP_G1_REPS; ++rep) { run_phase<1>(lds, args, l); XBAR(bar); }
        for (int rep = 0; rep < (((EXP_EW_MASK >> 2) & 1) ? 2 : 1); ++rep) { run_phase<2>(lds, args, l); XBAR(bar); }
        run_phase<3>(lds, args, l); XBAR(bar);
        for (int rep = 0; rep < (((EXP_EW_MASK >> 4) & 1) ? 2 : 1); ++rep) { run_phase<4>(lds, args, l); XBAR(bar); }
        run_phase<5>(lds, args, l); XBAR(bar);
        for (int rep = 0; rep < (((EXP_EW_MASK >> 6) & 1) ? 2 : 1); ++rep) { run_phase<6>(lds, args, l); XBAR(bar); }
        run_phase<7>(lds, args, l); XBAR(bar);
        run_phase<8>(lds, args, l); XBAR(bar);
        for (int rep = 0; rep < (((EXP_EW_MASK >> 9) & 1) ? 2 : 1); ++rep) { run_phase<9>(lds, args, l); XBAR(bar); }
        run_phase<10>(lds, args, l); XBAR(bar);
        run_phase<12>(lds, args, l); XBAR(bar);
    }
    run_phase<13>(lds, args, 0);
}

#ifndef MK_ONE_LAUNCH
#define MK_ONE_LAUNCH 1
#endif
template <int K> static void launch_phase(int grid, hipStream_t stream, Args a, int l) {
    static bool attr = false; if (!attr) { (void)hipFuncSetAttribute((const void*)fwd_phase<K>, hipFuncAttributeMaxDynamicSharedMemorySize, LDS_BYTES); attr = true; }
    a.li = l; a.ph_lo = K; a.ph_hi = K + 1;
    hipLaunchKernelGGL(fwd_phase<K>, dim3(grid), dim3(NTHREADS), LDS_BYTES, stream, a);
}
extern "C" void kernel_launch(void* const* d_in, const int* in_sizes, int n_in, void* d_out, int out_size, void* d_ws, size_t ws_size, hipStream_t stream) {
    static int grid = 0;
    if (grid == 0) {
        if (n_in != 25 || in_sizes[0] != M * D || out_size != M * D || ws_size < WS_END) { fprintf(stderr, "kernel_launch: unexpected shapes (n_in %d, in0 %d, out %d, ws %zu < %zu)\n", n_in, n_in > 0 ? in_sizes[0] : -1, out_size, ws_size, (size_t)WS_END); grid = -1; return; }
        int dev = 0, cus = 0;
        if (hipGetDevice(&dev) != hipSuccess || hipDeviceGetAttribute(&cus, hipDeviceAttributeMultiprocessorCount, dev) != hipSuccess) { grid = -1; return; }
        grid = cus;
    }
    if (grid < 0) return;
    (void)hipMemsetAsync((char*)d_ws + WS_CTL, 0, CTL_ZERO_BYTES, stream);
    Args a{};
    for (int i = 0; i < 25; ++i) a.in[i] = (const float*)d_in[i];
    a.out = (float*)d_out; a.ws = (unsigned char*)d_ws; a.pad = 0;
#if MK_ONE_LAUNCH
    { static bool attr = false; if (!attr) { (void)hipFuncSetAttribute((const void*)fwd_all, hipFuncAttributeMaxDynamicSharedMemorySize, LDS_BYTES); attr = true; }
      a.li = 0; a.ph_lo = 0; a.ph_hi = NPHASES;
      hipLaunchKernelGGL(fwd_all, dim3(grid), dim3(NTHREADS), LDS_BYTES, stream, a); }
#else
    for (int l = 0; l < DEPTH; ++l) {
        launch_phase<0>(grid, stream, a, l); launch_phase<1>(grid, stream, a, l); launch_phase<2>(grid, stream, a, l); launch_phase<3>(grid, stream, a, l);
        launch_phase<4>(grid, stream, a, l); launch_phase<5>(grid, stream, a, l); launch_phase<6>(grid, stream, a, l); launch_phase<7>(grid, stream, a, l);
        launch_phase<8>(grid, stream, a, l); launch_phase<9>(grid, stream, a, l); launch_phase<10>(grid, stream, a, l); launch_phase<11>(grid, stream, a, l);
        launch_phase<12>(grid, stream, a, l);
    }
    launch_phase<13>(grid, stream, a, 0);
#endif
}
```

```cpp
#include <hip/hip_runtime.h>
#include <cstdio>
#include <cstdint>
#include <cmath>
#define GAS __attribute__((address_space(1)))
#define LAS __attribute__((address_space(3)))
namespace pg8 {
#define PG8_LAS __attribute__((address_space(3)))
typedef unsigned short bf16_t;
typedef short bf16x8 __attribute__((ext_vector_type(8)));
typedef float f32x4 __attribute__((ext_vector_type(4)));
typedef unsigned u32x4 __attribute__((ext_vector_type(4)));
constexpr int BM = 256, BK = 64, HALF = 128, HTB = HALF * BK * 2  , STAGE_BYTES = 8 * HTB, NXCD = 8, WGM = 8;

__host__ __device__ __forceinline__ int lds_byte(int r, int c) { const int st = (r >> 4) * 2 + (c >> 5), rr = r & 15, cc = c & 31, ob = rr * 64 + cc * 2; return st * 1024 + (ob ^ (((ob >> 9) & 1) << 5)); }
__host__ __device__ __forceinline__ void stage_rc(int b, int& R, int& C) { const int st = b / 1024, sb = b % 1024, swz = sb ^ (((sb >> 9) & 1) << 5); R = (st >> 1) * 16 + swz / 64; C = (st & 1) * 32 + (swz % 64) / 2; }
__host__ __device__ __forceinline__ int perm32(int rho) { const int n = rho >> 4, i = rho & 15; return 8 * (i >> 2) + 4 * n + (i & 3); }

struct Unit { int pm, pn; };
struct Gemm { const bf16_t* A; const bf16_t* Bt; int M, N, K; };

struct StaticOrder {
    int nM, nN, nwg, G, c;
    __host__ __device__ void init(int M, int N, int G_, int c_) { nM = M / BM; nN = N / BM; nwg = nM * nN; G = G_; c = c_; }
    __host__ __device__ bool next(int i, Unit& u) const {
        const long L = (long)i * G + c; if (L >= nwg) return false;
        int wgid = (int)L; { const int q = nwg / NXCD, r = nwg % NXCD, xcd = wgid % NXCD, off = wgid / NXCD; wgid = (xcd < r ? xcd * (q + 1) : r * (q + 1) + (xcd - r) * q) + off; }
        const int nig = WGM * nN, gid = wgid / nig, fm = gid * WGM, gsz = (nM - fm) < WGM ? (nM - fm) : WGM;
        u.pm = fm + ((wgid % nig) % gsz); u.pn = (wgid % nig) / gsz; return true;
    }
    __device__ __forceinline__ void a_ready(const Unit&) const {}
    __device__ __forceinline__ void done(const Unit&) const {}
};
__device__ __forceinline__ unsigned cvt_pk_bf16(float lo, float hi) { unsigned r; asm volatile("v_cvt_pk_bf16_f32 %0, %1, %2" : "=v"(r) : "v"(lo), "v"(hi)); return r; }
template <class Epi, class Sched, bool ALIGN_EPI = false, bool SP2 = false>
__device__ __forceinline__ void gemm_phase(PG8_LAS unsigned char* lds, const Gemm g, const Sched& S, const Epi& E) {
    int tid_ = threadIdx.x; asm volatile("" : "+v"(tid_));
    const int tid = tid_, wid = __builtin_amdgcn_readfirstlane(tid >> 6), lane = tid & 63, wr = wid >> 2, wc = wid & 3, fr = lane & 15, fq = lane >> 4;
    const int K = g.K, nt = K / BK;
    unsigned voffA[2], voffB[2];
#pragma unroll
    for (int i = 0; i < 2; ++i) { int R, C; stage_rc(tid * 16 + i * 8192, R, C); const int Rb = Epi::PERM ? ((R & ~31) + perm32(R & 31)) : R;
        voffA[i] = (unsigned)(R * K + C) * 2u; voffB[i] = (unsigned)(Rb * K + C) * 2u; }
    const size_t kstep = (size_t)(BK * 2);
    const size_t hstep = (size_t)HALF * K * 2;
    const size_t tstep = 2 * hstep;
    const size_t tstepA = (size_t)Epi::A_ROWS * K * 2;
    const unsigned ldsw = (unsigned)wid * 1024u;
    const int aoff = lds_byte(wr * 64 + fr, fq * 8), boff = lds_byte(wc * 32 + fr, fq * 8);
#define PG8_SA(b, h) (((b) * 2 + (h)) * HTB)
#define PG8_SB(b, h) ((4 + (b) * 2 + (h)) * HTB)
#define PG8_STAGE(bufoff, gbase, voff) do { _Pragma("unroll") for (int _i = 0; _i < 2; ++_i) \
        __builtin_amdgcn_global_load_lds((const unsigned*)((const char*)(gbase) + (voff)[_i]), (PG8_LAS unsigned*)(lds + (bufoff) + ldsw + _i * 8192), 16, 0, 0); } while (0)
#define PG8_LDA(dst, b, h) do { _Pragma("unroll") for (int m = 0; m < 4; ++m) _Pragma("unroll") for (int k = 0; k < 2; ++k) dst[m][k] = *(const PG8_LAS bf16x8*)(lds + PG8_SA(b, h) + aoff + m * 2048 + k * 1024); } while (0)
#define PG8_LDB(dst, b, h) do { _Pragma("unroll") for (int n = 0; n < 2; ++n) _Pragma("unroll") for (int k = 0; k < 2; ++k) dst[n][k] = *(const PG8_LAS bf16x8*)(lds + PG8_SB(b, h) + boff + n * 2048 + k * 1024); } while (0)
#define PG8_MMA(ai, bj, At, Bt) do { __builtin_amdgcn_s_setprio(1); _Pragma("unroll") for (int m = 0; m < 4; ++m) _Pragma("unroll") for (int n = 0; n < 2; ++n) _Pragma("unroll") for (int k = 0; k < 2; ++k) \
        acc[ai][bj][m][n] = __builtin_amdgcn_mfma_f32_16x16x32_bf16(Bt[n][k], At[m][k], acc[ai][bj][m][n], 0, 0, 0); __builtin_amdgcn_s_setprio(0); } while (0)
#define PG8_WAIT_V(n) asm volatile("s_waitcnt vmcnt(" #n ")" ::: "memory")
#define PG8_WAIT_L(n) asm volatile("s_waitcnt lgkmcnt(" #n ")" ::: "memory")
#define PG8_BAR __builtin_amdgcn_s_barrier()
#define PG8_SCHED __builtin_amdgcn_sched_barrier(0)
    Unit cur, nxt; int ui = 0;
    if (!S.next(0, cur)) return;
    f32x4 acc[2][2][4][2];
#pragma unroll
    for (int a = 0; a < 2; ++a)
#pragma unroll
        for (int b = 0; b < 2; ++b)
#pragma unroll
            for (int m = 0; m < 4; ++m)
#pragma unroll
                for (int n = 0; n < 2; ++n) acc[a][b][m][n] = (f32x4){0.f, 0.f, 0.f, 0.f};
    bf16x8 At[4][2], B0[2][2], B1[2][2];
    const char* cA = (const char*)g.A + (size_t)cur.pm * tstepA; const char* cB = (const char*)g.Bt + (size_t)cur.pn * tstep;
    S.a_ready(cur);
    if constexpr (SP2) {
        PG8_STAGE(PG8_SB(0, 0), cB, voffB); PG8_STAGE(PG8_SB(0, 1), cB + hstep, voffB); PG8_STAGE(PG8_SA(0, 0), cA, voffA); PG8_STAGE(PG8_SA(0, 1), cA + hstep, voffA);
        if (wr == 1) PG8_BAR;
        PG8_WAIT_V(2); PG8_BAR;
        PG8_STAGE(PG8_SB(1, 0), cB + kstep, voffB); PG8_STAGE(PG8_SA(1, 0), cA + kstep, voffA); PG8_STAGE(PG8_SB(1, 1), cB + hstep + kstep, voffB);
        PG8_WAIT_V(6); PG8_BAR;
    } else {
        PG8_STAGE(PG8_SB(0, 0), cB, voffB); PG8_STAGE(PG8_SA(0, 0), cA, voffA); PG8_STAGE(PG8_SB(0, 1), cB + hstep, voffB); PG8_STAGE(PG8_SA(0, 1), cA + hstep, voffA);
        if (wr == 1) PG8_BAR;
        PG8_WAIT_V(4); PG8_BAR;
        PG8_STAGE(PG8_SB(1, 0), cB + kstep, voffB); PG8_STAGE(PG8_SA(1, 0), cA + kstep, voffA); PG8_STAGE(PG8_SB(1, 1), cB + hstep + kstep, voffB);
        PG8_WAIT_V(6); PG8_BAR;
    }
    for (;;) {
        const bool has_next = S.next(ui + 1, nxt);
        const char* nA = has_next ? (const char*)g.A + (size_t)nxt.pm * tstepA : cA; const char* nB = has_next ? (const char*)g.Bt + (size_t)nxt.pn * tstep : cB;
        for (int t = 0; t < nt; t += 2) {
            const bool last = (t == nt - 2);
            const char* a1 = cA + (size_t)(t + 1) * kstep;
            const char* a2 = last ? nA : cA + (size_t)(t + 2) * kstep; const char* b2 = last ? nB : cB + (size_t)(t + 2) * kstep;
            const char* a3 = a2 + kstep; const char* b3 = b2 + kstep;
            if (last && has_next) S.a_ready(nxt);
            if constexpr (SP2) {
            PG8_LDB(B0, 0, 0); PG8_LDB(B1, 0, 1); PG8_SCHED; PG8_LDA(At, 0, 0); PG8_STAGE(PG8_SA(1, 1), a1 + hstep, voffA);
            PG8_WAIT_V(8); PG8_WAIT_L(0); PG8_BAR; PG8_MMA(0, 0, At, B0); PG8_MMA(0, 1, At, B1); PG8_BAR; PG8_SCHED;
            PG8_LDA(At, 0, 1); PG8_STAGE(PG8_SB(0, 0), b2, voffB); PG8_STAGE(PG8_SB(0, 1), b2 + hstep, voffB); PG8_STAGE(PG8_SA(0, 0), a2, voffA);
            PG8_WAIT_V(8); PG8_WAIT_L(0); PG8_BAR; PG8_MMA(1, 0, At, B0); PG8_MMA(1, 1, At, B1); PG8_BAR; PG8_SCHED;
            PG8_LDB(B0, 1, 0); PG8_LDB(B1, 1, 1); PG8_SCHED; PG8_LDA(At, 1, 0); PG8_STAGE(PG8_SA(0, 1), a2 + hstep, voffA);
            PG8_WAIT_V(8); PG8_WAIT_L(0); PG8_BAR; PG8_MMA(0, 0, At, B0); PG8_MMA(0, 1, At, B1); PG8_BAR; PG8_SCHED;
            PG8_LDA(At, 1, 1); PG8_STAGE(PG8_SB(1, 0), b3, voffB); PG8_STAGE(PG8_SB(1, 1), b3 + hstep, voffB); PG8_STAGE(PG8_SA(1, 0), a3, voffA);
            PG8_WAIT_V(8); PG8_WAIT_L(0); PG8_BAR; PG8_MMA(1, 0, At, B0); PG8_MMA(1, 1, At, B1); PG8_BAR; PG8_SCHED;
            } else {
            PG8_LDB(B0, 0, 0); PG8_SCHED; PG8_LDA(At, 0, 0); PG8_STAGE(PG8_SA(1, 1), a1 + hstep, voffA);
            PG8_WAIT_L(8); PG8_BAR; PG8_WAIT_L(0); PG8_MMA(0, 0, At, B0); PG8_BAR; PG8_SCHED;
            PG8_LDB(B1, 0, 1); PG8_STAGE(PG8_SB(0, 0), b2, voffB);
            PG8_BAR; PG8_WAIT_L(0); PG8_MMA(0, 1, At, B1); PG8_BAR;
            PG8_LDA(At, 0, 1); PG8_STAGE(PG8_SA(0, 0), a2, voffA);
            PG8_BAR; PG8_WAIT_L(0); PG8_MMA(1, 0, At, B0); PG8_BAR; PG8_SCHED;
            PG8_STAGE(PG8_SB(0, 1), b2 + hstep, voffB);
            PG8_WAIT_V(6); PG8_BAR; PG8_MMA(1, 1, At, B1); PG8_BAR;
            PG8_LDB(B0, 1, 0); PG8_SCHED; PG8_LDA(At, 1, 0); PG8_STAGE(PG8_SA(0, 1), a2 + hstep, voffA);
            PG8_WAIT_L(8); PG8_BAR; PG8_WAIT_L(0); PG8_MMA(0, 0, At, B0); PG8_BAR; PG8_SCHED;
            PG8_LDB(B1, 1, 1); PG8_STAGE(PG8_SB(1, 0), b3, voffB);
            PG8_BAR; PG8_WAIT_L(0); PG8_MMA(0, 1, At, B1); PG8_BAR;
            PG8_LDA(At, 1, 1); PG8_STAGE(PG8_SA(1, 0), a3, voffA);
            PG8_BAR; PG8_WAIT_L(0); PG8_MMA(1, 0, At, B0); PG8_BAR; PG8_SCHED;
            PG8_STAGE(PG8_SB(1, 1), b3 + hstep, voffB);
            PG8_WAIT_V(6); PG8_BAR; PG8_MMA(1, 1, At, B1); PG8_BAR;
            }
        }
        if constexpr (ALIGN_EPI) { if (wr == 0) PG8_BAR; }
        if constexpr (!Epi::AFTER_DRAIN) { E(acc, cur, wr, wc, fr, fq); S.done(cur); }
        if (!has_next) break;
#pragma unroll
        for (int a = 0; a < 2; ++a)
#pragma unroll
            for (int b = 0; b < 2; ++b)
#pragma unroll
                for (int m = 0; m < 4; ++m)
#pragma unroll
                    for (int n = 0; n < 2; ++n) acc[a][b][m][n] = (f32x4){0.f, 0.f, 0.f, 0.f};
        cur = nxt; cA = nA; cB = nB; ++ui;
        if constexpr (ALIGN_EPI) { if (wr == 1) PG8_BAR; }
    }
    PG8_WAIT_V(0);
    if constexpr (!ALIGN_EPI) { if (wr == 0) PG8_BAR; }
    PG8_BAR;
    if constexpr (Epi::AFTER_DRAIN) { E.fused(acc, cur, wr, wc, fr, fq, lds, wid, lane); S.done(cur); }
#undef PG8_SA
#undef PG8_SB
#undef PG8_STAGE
#undef PG8_LDA
#undef PG8_LDB
#undef PG8_MMA
#undef PG8_WAIT_V
#undef PG8_WAIT_L
#undef PG8_BAR
#undef PG8_SCHED
}
}
#define XB_TMO      128
#define XB_XCNT(j)  (256  + 64 * (j))
#define XB_XSUB(j)  (1280 + 64 * (j))
#define XB_XGEN(j)  (2304 + 64 * (j))
#define XB_TOP      3328
#define XB_TOPGEN   3392
#define XCD_BAR_WORDS 3456
#define XB_SPIN_CAP (1u << 18)

__device__ __forceinline__ unsigned xb_ld(unsigned* p)              { return __hip_atomic_load(p, __ATOMIC_RELAXED, __HIP_MEMORY_SCOPE_AGENT); }
__device__ __forceinline__ unsigned xb_add(unsigned* p, unsigned v) { return __hip_atomic_fetch_add(p, v, __ATOMIC_RELAXED, __HIP_MEMORY_SCOPE_AGENT); }
__device__ __forceinline__ unsigned xb_xcc_id() { return (unsigned)__builtin_amdgcn_s_getreg((3 << 11) | 20) & 0xFu; }
#define XB_SPIN(cond, bar) do { unsigned _sp = 0; while (cond) { __builtin_amdgcn_s_sleep(1); \
    if ((++_sp & 255u) == 0u) { if (xb_ld(&(bar)[XB_TMO])) break; if (_sp > XB_SPIN_CAP) { atomicAdd(&(bar)[XB_TMO], 1u); break; } } } } while (0)

struct XcdBarrier {
    unsigned* bar; unsigned x;
    volatile LAS unsigned* st;
};

__device__ __forceinline__ XcdBarrier xcd_barrier_post(unsigned* bar, volatile LAS unsigned* st) {
    XcdBarrier b; b.bar = bar; b.x = xb_xcc_id(); b.st = st;
    if (threadIdx.x == 0) (void)xb_add(&bar[XB_XCNT(b.x)], 1u);
    return b;
}
__device__ __forceinline__ void xcd_barrier_complete(unsigned* bar, unsigned x, unsigned& nloc, unsigned& nx) {
    const unsigned G = gridDim.x * gridDim.y * gridDim.z;
    unsigned sum, cnt, mine, sp = 0u;
    for (;;) {
        sum = 0u; cnt = 0u; mine = 0u;
#pragma unroll
        for (unsigned j = 0; j < 16; ++j) { const unsigned c = xb_ld(&bar[XB_XCNT(j)]); sum += c; cnt += (c > 0u) ? 1u : 0u; mine = (j == x) ? c : mine; }
        if (sum == G) break;
        __builtin_amdgcn_s_sleep(1);
        if ((++sp & 255u) == 0u) { if (xb_ld(&bar[XB_TMO])) break; if (sp > XB_SPIN_CAP) { atomicAdd(&bar[XB_TMO], 1u); break; } }
    }
    nloc = mine > 0u ? mine : 1u; nx = cnt > 0u ? cnt : 1u;
}

__device__ __forceinline__ void xcd_barrier(const XcdBarrier& b) {
    asm volatile("s_waitcnt vmcnt(0)" ::: "memory");
    __syncthreads();
    if (threadIdx.x == 0) {
        unsigned* bar = b.bar;
        __builtin_amdgcn_s_waitcnt(0);
        unsigned nloc = b.st[0], nx = b.st[1];
        if (nloc == 0u) { xcd_barrier_complete(bar, b.x, nloc, nx); b.st[0] = nloc; b.st[1] = nx; }
        const unsigned old = xb_add(&bar[XB_XSUB(b.x)], 1u);
        const unsigned gen = old / nloc;
        if (old + 1u == (gen + 1u) * nloc) {
            __builtin_amdgcn_fence(__ATOMIC_RELEASE, "agent");
            asm volatile("s_waitcnt vmcnt(0)" ::: "memory");
            const unsigned og = xb_add(&bar[XB_TOP], 1u);
            const unsigned tg = og / nx;
            if (og + 1u == (tg + 1u) * nx) xb_add(&bar[XB_TOPGEN], 1u);
            else XB_SPIN(xb_ld(&bar[XB_TOPGEN]) == tg, bar);
            __builtin_amdgcn_fence(__ATOMIC_ACQUIRE, "agent");
            xb_add(&bar[XB_XGEN(b.x)], 1u);
            asm volatile("s_waitcnt vmcnt(0)" ::: "memory");
        } else {
            XB_SPIN(xb_ld(&bar[XB_XGEN(b.x)]) == gen, bar);
            __builtin_amdgcn_fence(__ATOMIC_ACQUIRE, "agent");
            asm volatile("s_waitcnt vmcnt(0)" ::: "memory");
        }
    }
    __syncthreads();
}

constexpr int BATCH = 2, SEQ = 8192, M = BATCH * SEQ, D = 2048, DEPTH = 4;
constexpr int DIN = 11968, NP1 = 5888, NG = 6144, NWIN = NP1 + NG;
constexpr int BW = 768, BCOLS = 2752;
constexpr int C_AQ = 0, C_AK = 512, C_AV = 640, C_R = 768, C_K = 1536, C_V = 2304, C_WD = 3072, C_CQ = 3520, C_CK = 4288, C_CV = 5056, C_END = 5824;
constexpr int DFF = 5504, NUP = 2 * DFF;
constexpr int NLORA = 2304, KLORA = 512;
constexpr float NORM_EPS = 1e-5f, GN_EPS = 64e-5f;
constexpr int NWAVES = 8, NTHREADS = 512;
constexpr int NPH = 13;
constexpr int NPHASES = DEPTH * NPH + 1;
#ifndef EXP_EW_MASK
#define EXP_EW_MASK 0
#endif
#ifndef EXP_EW_REPS
#define EXP_EW_REPS 1
#endif
#ifndef EXP_G10_REPS
#define EXP_G10_REPS 1
#endif
#ifndef EXP_GATE_REPS
#define EXP_GATE_REPS 1
#endif
#ifndef EXP_G7_REPS
#define EXP_G7_REPS 1
#endif
#ifndef EXP_G3_REPS
#define EXP_G3_REPS 1
#endif
#ifndef EXP_G1_REPS
#define EXP_G1_REPS 1
#endif
#ifndef EXP_SCAN_REPS
#define EXP_SCAN_REPS 1
#endif
#ifndef EXP_ATTN_REPS
#define EXP_ATTN_REPS 1
#endif
constexpr int NSCAN = 48;

constexpr size_t MiB = 1u << 20;
constexpr size_t WS_CTL = 0, CTL_ZERO_BYTES = 1 * MiB;
constexpr size_t WS_WIN = 1 * MiB;
constexpr size_t WS_WLORA = 48 * MiB;
constexpr size_t WS_PA = 51 * MiB;
constexpr size_t WS_PB = 53 * MiB;
constexpr size_t WS_PC = 56 * MiB;
constexpr size_t WS_WOUT = 57 * MiB;
constexpr size_t WS_WUP = 65 * MiB;
constexpr size_t WS_WDOWN = 108 * MiB;
constexpr size_t WS_H = 130 * MiB;
constexpr size_t WS_P1 = 194 * MiB;
constexpr size_t WS_G = 378 * MiB;
constexpr size_t WS_U = WS_P1;
constexpr size_t WS_AP = 570 * MiB;
constexpr size_t WS_LO = 586 * MiB;
constexpr size_t WS_ACT = WS_LO;
constexpr size_t WS_SR = 730 * MiB;
constexpr size_t WS_SW = 778 * MiB, WS_SK = 826 * MiB, WS_SKK = 874 * MiB, WS_SB = 922 * MiB, WS_SV = 970 * MiB;
constexpr size_t WS_YRAW = 1018 * MiB;
constexpr size_t WS_YA = 1066 * MiB;
constexpr size_t WS_YB = 1082 * MiB;
constexpr size_t WS_YC = 1106 * MiB;
constexpr size_t WS_OC = 1114 * MiB;
constexpr size_t WS_LSE = 1138 * MiB;
constexpr size_t WS_MG = 1139 * MiB;
constexpr size_t WS_BK = 1203 * MiB;
constexpr size_t WS_VT = 1205 * MiB;
constexpr size_t WS_W2 = 1235 * MiB;
constexpr size_t WSET_STRIDE = WS_W2 - WS_WIN;
constexpr size_t WS_BON = 1365 * MiB;
constexpr size_t WS_END = 1366 * MiB;
constexpr int CW_BAR = 4096;

constexpr int RING_OFF = 0, RING_BYTES = 131072;
constexpr int LDSCTL_OFF = 141312, MISC_OFF = LDSCTL_OFF + 320;
constexpr int LDS_BYTES = 147456;
constexpr int LUT_OFF = 0, SCANRING_OFF = 12288, CONV_SCR_SCAN = 77824, CONV_SCR_OTHER = 12288;

typedef unsigned short bf16;
typedef unsigned v4u __attribute__((ext_vector_type(4)));
typedef unsigned v2u __attribute__((ext_vector_type(2)));
typedef float f32x4 __attribute__((ext_vector_type(4)));
#define LDS_WAIT() asm volatile("s_waitcnt lgkmcnt(0)" ::: "memory")

__device__ __forceinline__ unsigned f2bf(float f) { unsigned u = __builtin_bit_cast(unsigned, f); return (u + 0x7fffu + ((u >> 16) & 1u)) >> 16; }
__device__ __forceinline__ unsigned pk2(float lo, float hi) { return f2bf(lo) | (f2bf(hi) << 16); }
__device__ __forceinline__ float bflo(unsigned w) { return __builtin_bit_cast(float, w << 16); }
__device__ __forceinline__ float bfhi(unsigned w) { return __builtin_bit_cast(float, w & 0xffff0000u); }
__device__ __forceinline__ float bf1(bf16 h) { return __builtin_bit_cast(float, ((unsigned)h) << 16); }
__device__ __forceinline__ float sigmoidf_(float x) { return 1.0f / (1.0f + __expf(-x)); }
__device__ __forceinline__ float wave_sum(float v) {
#pragma unroll
    for (int o = 1; o < 64; o <<= 1) v += __shfl_xor(v, o);
    return v;
}
template <int CTRL> __device__ __forceinline__ float dppf(float x) { return __builtin_bit_cast(float, __builtin_amdgcn_update_dpp(0, __builtin_bit_cast(int, x), CTRL, 0xF, 0xF, true)); }
__device__ __forceinline__ float red4(float x) { x += dppf<0xB1>(x); x += dppf<0x4E>(x); return x; }
__device__ __forceinline__ float red16(float x) { x = red4(x); x += dppf<0x141>(x); x += dppf<0x140>(x); return x; }
__device__ __forceinline__ float wsum(float x) { x = red16(x); x += __shfl_xor(x, 16); x += __shfl_xor(x, 32); return x; }

__device__ const unsigned char T5B[3][132] = {
 {0,1,2,3,4,5,6,7,8,9,10,11,12,13,14,15,16,16,16,16,16,16,17,17,17,17,17,17,17,17,18,18,18,18,18,18,18,18,18,18,19,19,19,19,19,19,19,19,19,19,19,19,19,19,20,20,20,20,20,20,20,20,20,20,20,20,20,20,20,20,20,20,20,21,21,21,21,21,21,21,21,21,21,21,21,21,21,21,21,21,21,21,21,21,21,21,21,21,21,22,22,22,22,22,22,22,22,22,22,22,22,22,22,22,22,22,22,22,22,22,22,22,22,22,22,22,22,22,22,0,0,0},
 {0,4,8,12,16,16,17,17,18,18,19,19,19,19,20,20,20,20,20,21,21,21,21,21,21,22,22,22,22,22,22,22,22,22,23,23,23,23,23,23,23,23,23,23,23,23,24,24,24,24,24,24,24,24,24,24,24,24,24,24,24,24,25,25,25,25,25,25,25,25,25,25,25,25,25,25,25,25,25,25,25,25,25,26,26,26,26,26,26,26,26,26,26,26,26,26,26,26,26,26,26,26,26,26,26,26,26,26,26,26,26,26,26,27,27,27,27,27,27,27,27,27,27,27,27,27,27,27,27,0,0,0},
 {0,16,18,19,20,21,21,22,22,23,23,23,24,24,24,24,25,25,25,25,25,26,26,26,26,26,26,26,26,27,27,27,27,27,27,27,27,27,27,28,28,28,28,28,28,28,28,28,28,28,28,28,29,29,29,29,29,29,29,29,29,29,29,29,29,29,29,29,29,29,30,30,30,30,30,30,30,30,30,30,30,30,30,30,30,30,30,30,30,30,30,30,30,30,30,31,31,31,31,31,31,31,31,31,31,31,31,31,31,31,31,31,31,31,31,31,31,31,31,31,31,31,31,31,31,31,31,31,31,0,0,0}};

namespace pg8 {
struct EpiWin {
    static constexpr bool PERM = true, AFTER_DRAIN = false; static constexpr int A_ROWS = 256;
    bf16_t* P1; bf16_t* G; int pn0;
    __device__ __forceinline__ void operator()(const f32x4 (&acc)[2][2][4][2], const Unit& u, int wr, int wc, int fr, int fq) const {
        const int pn = u.pn + pn0; const int row0 = u.pm * BM + wr * 64 + fr; const bool gate = pn >= 23;
        bf16_t* base = gate ? G : P1; const int ldc = gate ? 6144 : 5888; const int col0 = (gate ? (pn - 23) : pn) * BM + wc * 32 + 8 * fq;
#pragma unroll
        for (int ai = 0; ai < 2; ++ai)
#pragma unroll
            for (int m = 0; m < 4; ++m) { bf16_t* rowp = base + (size_t)(row0 + ai * HALF + m * 16) * ldc + col0;
#pragma unroll
                for (int bj = 0; bj < 2; ++bj) { f32x4 v0 = acc[ai][bj][m][0], v1 = acc[ai][bj][m][1];
                    if (gate) {
#pragma unroll
                        for (int j = 0; j < 4; ++j) { v0[j] = __builtin_amdgcn_rcpf(1.0f + __expf(-v0[j])); v1[j] = __builtin_amdgcn_rcpf(1.0f + __expf(-v1[j])); } }
                    u32x4 w; w.x = cvt_pk_bf16(v0[0], v0[1]); w.y = cvt_pk_bf16(v0[2], v0[3]); w.z = cvt_pk_bf16(v1[0], v1[1]); w.w = cvt_pk_bf16(v1[2], v1[3]);
                    *(u32x4*)(rowp + bj * HALF) = w; } }
    }
};
struct EpiBf16P {
    static constexpr bool PERM = true, AFTER_DRAIN = false; static constexpr int A_ROWS = 256;
    bf16_t* O; int ldc;
    __device__ __forceinline__ void operator()(const f32x4 (&acc)[2][2][4][2], const Unit& u, int wr, int wc, int fr, int fq) const {
        const int row0 = u.pm * BM + wr * 64 + fr; const int col0 = u.pn * BM + wc * 32 + 8 * fq;
#pragma unroll
        for (int ai = 0; ai < 2; ++ai)
#pragma unroll
            for (int m = 0; m < 4; ++m) { bf16_t* rowp = O + (size_t)(row0 + ai * HALF + m * 16) * ldc + col0;
#pragma unroll
                for (int bj = 0; bj < 2; ++bj) { const f32x4 v0 = acc[ai][bj][m][0], v1 = acc[ai][bj][m][1];
                    u32x4 w; w.x = cvt_pk_bf16(v0[0], v0[1]); w.y = cvt_pk_bf16(v0[2], v0[3]); w.z = cvt_pk_bf16(v1[0], v1[1]); w.w = cvt_pk_bf16(v1[2], v1[3]);
                    *(u32x4*)(rowp + bj * HALF) = w; } }
    }
};
struct EpiF32P {
    static constexpr bool PERM = false, AFTER_DRAIN = false; static constexpr int A_ROWS = 256;
    float* C; int ldc;
    __device__ __forceinline__ void operator()(const f32x4 (&acc)[2][2][4][2], const Unit& u, int wr, int wc, int fr, int fq) const {
        const int row0 = u.pm * BM + wr * 64 + fr, col0 = u.pn * BM + wc * 32 + 4 * fq;
#pragma unroll
        for (int ai = 0; ai < 2; ++ai)
#pragma unroll
            for (int m = 0; m < 4; ++m) { float* rowp = C + (size_t)(row0 + ai * HALF + m * 16) * ldc + col0;
#pragma unroll
                for (int bj = 0; bj < 2; ++bj)
#pragma unroll
                    for (int n = 0; n < 2; ++n) *(f32x4*)(rowp + bj * HALF + n * 16) = acc[ai][bj][m][n]; }
    }
};
struct EpiResid {
    static constexpr bool PERM = false, AFTER_DRAIN = false; static constexpr int A_ROWS = 256;
    const float* xin; float* out;
    __device__ __forceinline__ void operator()(const f32x4 (&acc)[2][2][4][2], const Unit& u, int wr, int wc, int fr, int fq) const {
        const int row0 = u.pm * BM + wr * 64 + fr, col0 = u.pn * BM + wc * 32 + 4 * fq;
#pragma unroll
        for (int ai = 0; ai < 2; ++ai)
#pragma unroll
            for (int m = 0; m < 4; ++m) { const size_t ro = (size_t)(row0 + ai * HALF + m * 16) * 2048 + col0;
#pragma unroll
                for (int bj = 0; bj < 2; ++bj)
#pragma unroll
                    for (int n = 0; n < 2; ++n) { const f32x4 xv = *(const f32x4*)(xin + ro + bj * HALF + n * 16); *(f32x4*)(out + ro + bj * HALF + n * 16) = xv + acc[ai][bj][m][n]; } }
    }
};
template <bool ACC> struct EpiGate {
    static constexpr bool PERM = true, AFTER_DRAIN = false; static constexpr int A_ROWS = 256;
    const bf16_t* G; int gofs; bf16_t* MG;
    __device__ __forceinline__ void operator()(const f32x4 (&acc)[2][2][4][2], const Unit& u, int wr, int wc, int fr, int fq) const {
        const int row0 = u.pm * BM + wr * 64 + fr; const int col0 = u.pn * BM + wc * 32 + 8 * fq;
#pragma unroll
        for (int ai = 0; ai < 2; ++ai)
#pragma unroll
            for (int m = 0; m < 4; ++m) { const int row = row0 + ai * HALF + m * 16;
#pragma unroll
                for (int bj = 0; bj < 2; ++bj) { const int col = col0 + bj * HALF;
                    const u32x4 gv = *(const u32x4*)(G + (size_t)row * 6144 + gofs + col);
                    const f32x4 a0 = acc[ai][bj][m][0], a1 = acc[ai][bj][m][1];
                    float r[8];
                    r[0] = __builtin_bit_cast(float, gv.x << 16) * a0[0]; r[1] = __builtin_bit_cast(float, gv.x & 0xffff0000u) * a0[1];
                    r[2] = __builtin_bit_cast(float, gv.y << 16) * a0[2]; r[3] = __builtin_bit_cast(float, gv.y & 0xffff0000u) * a0[3];
                    r[4] = __builtin_bit_cast(float, gv.z << 16) * a1[0]; r[5] = __builtin_bit_cast(float, gv.z & 0xffff0000u) * a1[1];
                    r[6] = __builtin_bit_cast(float, gv.w << 16) * a1[2]; r[7] = __builtin_bit_cast(float, gv.w & 0xffff0000u) * a1[3];
                    bf16_t* mp = MG + (size_t)row * 2048 + col;
                    if (ACC) { const u32x4 ov = *(const u32x4*)mp;
                        r[0] += __builtin_bit_cast(float, ov.x << 16); r[1] += __builtin_bit_cast(float, ov.x & 0xffff0000u);
                        r[2] += __builtin_bit_cast(float, ov.y << 16); r[3] += __builtin_bit_cast(float, ov.y & 0xffff0000u);
                        r[4] += __builtin_bit_cast(float, ov.z << 16); r[5] += __builtin_bit_cast(float, ov.z & 0xffff0000u);
                        r[6] += __builtin_bit_cast(float, ov.w << 16); r[7] += __builtin_bit_cast(float, ov.w & 0xffff0000u); }
                    u32x4 w; w.x = cvt_pk_bf16(r[0], r[1]); w.y = cvt_pk_bf16(r[2], r[3]); w.z = cvt_pk_bf16(r[4], r[5]); w.w = cvt_pk_bf16(r[6], r[7]);
                    *(u32x4*)mp = w; } }
    }
};
template <int CTRL> __device__ __forceinline__ float dpp_keep(float old, float x) { return __builtin_bit_cast(float, __builtin_amdgcn_update_dpp(__builtin_bit_cast(int, old), __builtin_bit_cast(int, x), CTRL, 0xF, 0xF, false)); }
struct EpiConv {
    static constexpr bool PERM = true, AFTER_DRAIN = false; static constexpr int A_ROWS = 254;
    bf16_t* ACT; const float* cw; PG8_LAS float* xch;
    __device__ __forceinline__ void operator()(const f32x4 (&acc)[2][2][4][2], const Unit& u, int wr, int wc, int fr, int fq) const {
        const int cbase = wc * 32 + 8 * fq, f0 = u.pn * 128 + cbase;
        float c0[8], c1[8], c2[8];
#pragma unroll
        for (int j = 0; j < 8; ++j) { c0[j] = cw[f0 + j]; c1[j] = cw[5504 + f0 + j]; c2[j] = cw[2 * 5504 + f0 + j]; }
        if (fr >= 14) {
#pragma unroll
            for (int ai = 0; ai < 2; ++ai)
#pragma unroll
                for (int n = 0; n < 2; ++n) *(PG8_LAS f32x4*)(xch + ((2 * ai + wr) * 2 + (fr - 14)) * 128 + cbase + 4 * n) = acc[ai][0][3][n];
        }
        asm volatile("s_waitcnt lgkmcnt(0)" ::: "memory"); __builtin_amdgcn_s_barrier(); asm volatile("" ::: "memory");
#pragma unroll
        for (int ai = 0; ai < 2; ++ai) {
            const int sl = 2 * ai + wr;
            f32x4 e1[2], e2[2];
#pragma unroll
            for (int n = 0; n < 2; ++n) { e1[n] = (f32x4){0.f, 0.f, 0.f, 0.f}; e2[n] = e1[n];
                if (sl > 0) { e2[n] = *(const PG8_LAS f32x4*)(xch + ((sl - 1) * 2 + 0) * 128 + cbase + 4 * n); e1[n] = *(const PG8_LAS f32x4*)(xch + ((sl - 1) * 2 + 1) * 128 + cbase + 4 * n); } }
#pragma unroll
            for (int m = 0; m < 4; ++m) {
                const int lr = 128 * ai + 64 * wr + 16 * m + fr; const int grow = 254 * u.pm - 2 + lr; const int t = grow & 8191;
                float r[8];
#pragma unroll
                for (int n = 0; n < 2; ++n)
#pragma unroll
                    for (int j = 0; j < 4; ++j) {
                        const float x = acc[ai][0][m][n][j];
                        float k1, k2;
                        if (m > 0) { const float xp = acc[ai][0][m > 0 ? m - 1 : 0][n][j]; k1 = dpp_keep<0x121>(xp, xp); k2 = dpp_keep<0x122>(xp, xp); }
                        else { k1 = e1[n][j]; k2 = (fr == 0) ? e2[n][j] : e1[n][j]; }
                        float p1 = dpp_keep<0x111>(k1, x), p2 = dpp_keep<0x112>(k2, x);
                        if (t == 0) p1 = 0.f; if (t <= 1) p2 = 0.f;
                        const float gs = c0[4 * n + j] * p2 + c1[4 * n + j] * p1 + c2[4 * n + j] * x;
                        r[4 * n + j] = gs * __builtin_amdgcn_rcpf(1.0f + __expf(-gs)) * acc[ai][1][m][n][j];
                    }
                if (lr >= 2 && grow < 16384) { u32x4 w; w.x = cvt_pk_bf16(r[0], r[1]); w.y = cvt_pk_bf16(r[2], r[3]); w.z = cvt_pk_bf16(r[4], r[5]); w.w = cvt_pk_bf16(r[6], r[7]);
                    *(u32x4*)(ACT + (size_t)grow * 5504 + f0) = w; }
            }
        }
    }
};
}

struct Args { const float* in[25]; float* out; unsigned char* ws; int ph_lo, ph_hi, li, pad; };

struct Ctx {
    LAS unsigned char* lds;
    int tid, lane, wave, G, bid;
    int gw, ngw;
};

__device__ __forceinline__ void transpose_item(const float* W, int K, int N, bf16* WT, int kb, int nb, int dst_row0, LAS float* scr, int lane) {
    const int k0 = 64 * kb, n0 = 32 * nb;
#pragma unroll 8
    for (int i = 0; i < 32; ++i) { const int kk = 2 * i + (lane >> 5); scr[kk * 33 + (lane & 31)] = W[(size_t)(k0 + kk) * N + n0 + (lane & 31)]; }
    LDS_WAIT(); asm volatile("" ::: "memory");
    const int c = lane & 7;
#pragma unroll
    for (int j = 0; j < 4; ++j) { const int n = (lane >> 3) + 8 * j; const LAS float* s = scr + (8 * c) * 33 + n;
        v4u o; o.x = pk2(s[0 * 33], s[1 * 33]); o.y = pk2(s[2 * 33], s[3 * 33]); o.z = pk2(s[4 * 33], s[5 * 33]); o.w = pk2(s[6 * 33], s[7 * 33]);
        *(v4u*)(WT + (size_t)(dst_row0 + n) * K + k0 + 8 * c) = o; }
    LDS_WAIT(); asm volatile("" ::: "memory");
}
__device__ __forceinline__ int transpose_matrix(int widx, int nw, int lane, LAS float* scr, const float* W, int K, int N, bf16* WT, int gate_split, int base) {
    const int nblk = N / 32, items = (K / 64) * nblk;
    int first = (widx - base) % nw; if (first < 0) first += nw;
    for (int it = first; it < items; it += nw) {
        const int kb = it / nblk, nb = it % nblk; int dr = 32 * nb; if (gate_split == 1 && dr >= C_END) dr += 64;
        if (gate_split == 2) { const int f = dr < DFF ? dr : dr - DFF; dr = 256 * (f >> 7) + (f & 127) + (dr < DFF ? 0 : 128); }
        transpose_item(W, K, N, WT, kb, nb, dr, scr, lane);
    }
    return base + items;
}
__device__ __forceinline__ void convert_weights(int widx, int nw, int lane, LAS float* scr, const Args& a, int l, unsigned char* ws) {
    unsigned char* wsw = ws + (size_t)(l & 1) * WSET_STRIDE;
    int base = 0;
    base = transpose_matrix(widx, nw, lane, scr, a.in[3] + (size_t)l * D * DIN, D, DIN, (bf16*)(wsw + WS_WIN), 1, base);
    base = transpose_matrix(widx, nw, lane, scr, a.in[21] + (size_t)l * D * NUP, D, NUP, (bf16*)(wsw + WS_WUP), 2, base);
    base = transpose_matrix(widx, nw, lane, scr, a.in[23] + (size_t)l * DFF * D, DFF, D, (bf16*)(wsw + WS_WDOWN), 0, base);
    base = transpose_matrix(widx, nw, lane, scr, a.in[19] + (size_t)l * D * D, D, D, (bf16*)(wsw + WS_WOUT), 0, base);
    base = transpose_matrix(widx, nw, lane, scr, a.in[16] + (size_t)l * 512 * D, 512, D, (bf16*)(wsw + WS_PA), 0, base);
    base = transpose_matrix(widx, nw, lane, scr, a.in[17] + (size_t)l * 768 * D, 768, D, (bf16*)(wsw + WS_PB), 0, base);
    base = transpose_matrix(widx, nw, lane, scr, a.in[18] + (size_t)l * 256 * D, 256, D, (bf16*)(wsw + WS_PC), 0, base);
    const int gt = widx * 64 + lane, ngt = nw * 64;
    { v4u* z = (v4u*)((bf16*)(wsw + WS_WIN) + (size_t)C_END * D); for (int i = gt; i < 64 * D / 8; i += ngt) z[i] = (v4u){0u, 0u, 0u, 0u}; }
    { bf16* wl = (bf16*)(wsw + WS_WLORA); const float* wup = a.in[7] + (size_t)l * 96 * BW; const float* aup = a.in[9] + (size_t)l * 96 * BW; const float* gup = a.in[10] + (size_t)l * 256 * BW;
      for (int i = gt; i < NLORA * KLORA; i += ngt) { const int n = i / KLORA, k = i % KLORA; float v = 0.f;
          if (n < 768) { if (k < 96) v = wup[k * BW + n]; }
          else if (n < 1536) { if (k >= 96 && k < 192) v = aup[(k - 96) * BW + (n - 768)]; }
          else { if (k >= 192 && k < 448) v = gup[(k - 192) * BW + (n - 1536)]; }
          wl[i] = (bf16)f2bf(v); } }
}

__device__ __forceinline__ void rms_row_bf16(const float* xrow, const float* gam, bf16* orow, int lane) {
    const f32x4* xr = (const f32x4*)xrow + lane; f32x4 v[8]; float s = 0.f;
#pragma unroll
    for (int j = 0; j < 8; ++j) { v[j] = xr[64 * j]; s += (v[j].x * v[j].x + v[j].y * v[j].y) + (v[j].z * v[j].z + v[j].w * v[j].w); }
    const float rs = 1.0f / sqrtf(wave_sum(s) * (1.0f / D) + NORM_EPS);
    const f32x4* gr = (const f32x4*)gam + lane; v2u* o8 = (v2u*)orow + lane;
#pragma unroll
    for (int j = 0; j < 8; ++j) { const f32x4 g = gr[64 * j]; v2u w; w.x = pk2(v[j].x * rs * g.x, v[j].y * rs * g.y); w.y = pk2(v[j].z * rs * g.z, v[j].w * rs * g.w); o8[64 * j] = w; }
}
__device__ __forceinline__ void rms_row2_bf16(const float* xrow, const float* gam, bf16* orow, int lane) {
    const f32x4* xr = (const f32x4*)xrow + lane; f32x4 v[16]; float s0 = 0.f, s1 = 0.f;
#pragma unroll
    for (int j = 0; j < 16; ++j) v[j] = xr[64 * j];
#pragma unroll
    for (int j = 0; j < 8; ++j) { s0 += (v[j].x * v[j].x + v[j].y * v[j].y) + (v[j].z * v[j].z + v[j].w * v[j].w); s1 += (v[8 + j].x * v[8 + j].x + v[8 + j].y * v[8 + j].y) + (v[8 + j].z * v[8 + j].z + v[8 + j].w * v[8 + j].w); }
    const float rs0 = 1.0f / sqrtf(wsum(s0) * (1.0f / D) + NORM_EPS), rs1 = 1.0f / sqrtf(wsum(s1) * (1.0f / D) + NORM_EPS);
    const f32x4* gr = (const f32x4*)gam + lane; v2u* o8 = (v2u*)orow + lane;
#pragma unroll
    for (int j = 0; j < 8; ++j) { const f32x4 g = gr[64 * j]; v2u w; w.x = pk2(v[j].x * rs0 * g.x, v[j].y * rs0 * g.y); w.y = pk2(v[j].z * rs0 * g.z, v[j].w * rs0 * g.w); o8[64 * j] = w;
        v2u w1; w1.x = pk2(v[8 + j].x * rs1 * g.x, v[8 + j].y * rs1 * g.y); w1.y = pk2(v[8 + j].z * rs1 * g.z, v[8 + j].w * rs1 * g.w); o8[64 * (8 + j)] = w1; }
}
__device__ __forceinline__ void rms_row_f32(float* xrow, const float* gam, int lane) {
    f32x4* xr = (f32x4*)xrow + lane; f32x4 v[8]; float s = 0.f;
#pragma unroll
    for (int j = 0; j < 8; ++j) { v[j] = xr[64 * j]; s += (v[j].x * v[j].x + v[j].y * v[j].y) + (v[j].z * v[j].z + v[j].w * v[j].w); }
    const float rs = 1.0f / sqrtf(wave_sum(s) * (1.0f / D) + NORM_EPS);
    const f32x4* gr = (const f32x4*)gam + lane;
#pragma unroll
    for (int j = 0; j < 8; ++j) { const f32x4 g = gr[64 * j]; xr[64 * j] = v[j] * rs * g; }
}

__device__ __forceinline__ void phase_prep(const Ctx& C, const Args& a, int l, const float* xsrc, unsigned char* ws) {
    if (l == 0) convert_weights(C.gw, C.ngw, C.lane, (LAS float*)(C.lds + RING_OFF + C.wave * 16384), a, 0, ws);
    const float* g1 = a.in[2] + (size_t)l * D; bf16* H = (bf16*)(ws + WS_H);
    for (int m = 2 * C.gw; m < M; m += 2 * C.ngw) rms_row2_bf16(xsrc + (size_t)m * D, g1, H + (size_t)m * D, C.lane);
}

__device__ __forceinline__ void phase_aprime(const Ctx& C, const Args& a, int l, unsigned char* ws) {
    const bf16* P1 = (const bf16*)(ws + WS_P1); bf16* AP = (bf16*)(ws + WS_AP); const float* mu = a.in[5] + (size_t)l * BCOLS;
    const int g = C.lane, c0 = 8 * g;
    float muv[8];
#pragma unroll
    for (int j = 0; j < 8; ++j) muv[j] = (g < 56) ? mu[(C_WD - C_R) + c0 + j] : 0.f;
    for (int m = C.gw; m < M; m += C.ngw) {
        v4u o = (v4u){0u, 0u, 0u, 0u};
        if (g < 56) {
            const v4u cur = *(const v4u*)(P1 + (size_t)m * NP1 + C_WD + c0);
            v4u prv = (v4u){0u, 0u, 0u, 0u}; if ((m & (SEQ - 1)) != 0) prv = *(const v4u*)(P1 + (size_t)(m - 1) * NP1 + C_WD + c0);
            float x[8], p[8];
            x[0] = bflo(cur.x); x[1] = bfhi(cur.x); x[2] = bflo(cur.y); x[3] = bfhi(cur.y); x[4] = bflo(cur.z); x[5] = bfhi(cur.z); x[6] = bflo(cur.w); x[7] = bfhi(cur.w);
            p[0] = bflo(prv.x); p[1] = bfhi(prv.x); p[2] = bflo(prv.y); p[3] = bfhi(prv.y); p[4] = bflo(prv.z); p[5] = bfhi(prv.z); p[6] = bflo(prv.w); p[7] = bfhi(prv.w);
#pragma unroll
            for (int j = 0; j < 8; ++j) { float v = x[j] + (p[j] - x[j]) * muv[j];
                if (g < 12) v = tanhf(v); else if (g >= 24) v = sigmoidf_(v);
                x[j] = v; }
            o.x = pk2(x[0], x[1]); o.y = pk2(x[2], x[3]); o.z = pk2(x[4], x[5]); o.w = pk2(x[6], x[7]);
        }
        *(v4u*)(AP + (size_t)m * KLORA + c0) = o;
    }
}

struct PrepTok { float r, kt, v, w, kk, b; };
__device__ __forceinline__ PrepTok prep_token(const bf16* P1, const float* LO, int m, int hc, float mur, float muk, float muv, float w0, float a0, float kkw, float kaw) {
    const bool first = (m & (SEQ - 1)) == 0;
    const bf16* pr = P1 + (size_t)m * NP1; const bf16* pp = pr - NP1;
    float r = bf1(pr[C_R + hc]), k = bf1(pr[C_K + hc]), v = bf1(pr[C_V + hc]);
    const float rp = first ? 0.f : bf1(pp[C_R + hc]), kp = first ? 0.f : bf1(pp[C_K + hc]), vp = first ? 0.f : bf1(pp[C_V + hc]);
    r = r + (rp - r) * mur; k = k + (kp - k) * muk; v = v + (vp - v) * muv;
    const float wpre = w0 + LO[(size_t)m * NLORA + hc], apre = a0 + LO[(size_t)m * NLORA + BW + hc];
    const float xx = -wpre; const float sp = fmaxf(xx, 0.f) + log1pf(expf(-fabsf(xx)));
    const float wlog = -sp - 0.5f; const float decay = expf(-expf(wlog));
    const float av = 1.0f / (1.0f + expf(-apre));
    const float kkr = k * kkw; const float nrm = sqrtf(wave_sum(kkr * kkr)); const float kk = kkr / fmaxf(nrm, 1e-12f);
    PrepTok t; t.r = r; t.kt = k * (1.0f + (av - 1.0f) * kaw); t.v = v; t.w = decay; t.kk = kk; t.b = kk * av; return t;
}
struct PrepRaw { v2u r, k, v; f32x4 lw, la; };
__device__ __forceinline__ PrepRaw prep_load(const bf16* P1, const float* LO, int m, int c0) {
    PrepRaw x; const bf16* pr = P1 + (size_t)m * NP1 + c0;
    x.r = *(const v2u*)(pr + C_R); x.k = *(const v2u*)(pr + C_K); x.v = *(const v2u*)(pr + C_V);
    x.lw = *(const f32x4*)(LO + (size_t)m * NLORA + c0); x.la = *(const f32x4*)(LO + (size_t)m * NLORA + BW + c0); return x;
}
__device__ __forceinline__ void un4(const v2u w, float (&x)[4]) { x[0] = bflo(w.x); x[1] = bfhi(w.x); x[2] = bflo(w.y); x[3] = bfhi(w.y); }
__device__ __forceinline__ void phase_scanprep(const Ctx& C, const Args& a, int l, unsigned char* ws) {
    const bf16* P1 = (const bf16*)(ws + WS_P1); const float* LO = (const float*)(ws + WS_LO);
    float* SR = (float*)(ws + WS_SR); float* SW = (float*)(ws + WS_SW); float* SK = (float*)(ws + WS_SK); float* SU = (float*)(ws + WS_SKK); float* SB = (float*)(ws + WS_SB); float* SV = (float*)(ws + WS_SV);
    float* BK = (float*)(ws + WS_BK); float* BON = (float*)(ws + WS_BON);
    const float* mu = a.in[5] + (size_t)l * BCOLS; const float* w0p = a.in[6] + (size_t)l * BW; const float* a0p = a.in[8] + (size_t)l * BW;
    const float* kkwp = a.in[11] + (size_t)l * BW; const float* kawp = a.in[12] + (size_t)l * BW; const float* rkp = a.in[13] + (size_t)l * BW;
    constexpr int RL = 8;
    const int g = C.lane >> 4, cq = C.lane & 15;
    for (int it = C.gw; it < (M / (4 * RL)) * 12; it += C.ngw) {
        const int h = it % 12, m0 = ((it / 12) * 4 + g) * RL, c0 = h * 64 + 4 * cq;
        const f32x4 mur = *(const f32x4*)(mu + c0), muk = *(const f32x4*)(mu + BW + c0), muv = *(const f32x4*)(mu + 2 * BW + c0), w0 = *(const f32x4*)(w0p + c0), a0 = *(const f32x4*)(a0p + c0);
        const f32x4 kkw = *(const f32x4*)(kkwp + c0), kaw = *(const f32x4*)(kawp + c0), rkc = *(const f32x4*)(rkp + c0);
        const bool seq_start = (m0 & (SEQ - 1)) == 0;
        float prr[4] = {0.f, 0.f, 0.f, 0.f}, prk[4] = {0.f, 0.f, 0.f, 0.f}, prv[4] = {0.f, 0.f, 0.f, 0.f}, pw[4] = {0.f, 0.f, 0.f, 0.f}, pb[4] = {0.f, 0.f, 0.f, 0.f}, pkt[4] = {0.f, 0.f, 0.f, 0.f};
        if (!seq_start) { const bf16* pr = P1 + (size_t)(m0 - 2) * NP1 + c0; un4(*(const v2u*)(pr + C_R), prr); un4(*(const v2u*)(pr + C_K), prk); un4(*(const v2u*)(pr + C_V), prv); }
        PrepRaw nx = prep_load(P1, LO, seq_start ? m0 : m0 - 1, c0);
#pragma unroll 1
        for (int i = seq_start ? 0 : -1; i < RL; ++i) {
            const int m = m0 + i; const PrepRaw cu = nx;
            if (i + 1 < RL) nx = prep_load(P1, LO, m + 1, c0);
            float xr[4], xk[4], xv[4]; un4(cu.r, xr); un4(cu.k, xk); un4(cu.v, xv);
            float tr[4], tk[4], tv[4], tw[4], ta[4], kkr[4]; float q = 0.f;
#pragma unroll
            for (int e = 0; e < 4; ++e) {
                tr[e] = xr[e] + (prr[e] - xr[e]) * mur[e]; tk[e] = xk[e] + (prk[e] - xk[e]) * muk[e]; tv[e] = xv[e] + (prv[e] - xv[e]) * muv[e];
                const float xx = -(w0[e] + cu.lw[e]); const float sp = fmaxf(xx, 0.f) + __logf(1.0f + __expf(-fabsf(xx)));
                tw[e] = __expf(-__expf(-sp - 0.5f)); ta[e] = __builtin_amdgcn_rcpf(1.0f + __expf(-(a0[e] + cu.la[e])));
                kkr[e] = tk[e] * kkw[e]; q += kkr[e] * kkr[e];
            }
            q = red16(q); const float rn = __builtin_amdgcn_rsqf(fmaxf(q, 1e-24f));
            float tkk[4], tb[4], tkt[4]; float be = 0.f, ka = 0.f, bo = 0.f;
#pragma unroll
            for (int e = 0; e < 4; ++e) { tkk[e] = kkr[e] * rn; tb[e] = tkk[e] * ta[e]; tkt[e] = tk[e] * (1.0f + (ta[e] - 1.0f) * kaw[e]);
                be += pb[e] * tkk[e]; ka += pkt[e] * tkk[e]; bo += tr[e] * tkt[e] * rkc[e]; }
            if (i >= 0) {
                be = red16(be); ka = red16(ka); bo = red16(bo);
                const size_t o = (size_t)m * BW + c0; const bool first = (m & (SEQ - 1)) == 0;
                *(f32x4*)(SR + o) = (f32x4){tr[0], tr[1], tr[2], tr[3]}; *(f32x4*)(SW + o) = (f32x4){tw[0], tw[1], tw[2], tw[3]}; *(f32x4*)(SK + o) = (f32x4){tkt[0], tkt[1], tkt[2], tkt[3]};
                *(f32x4*)(SB + o) = (f32x4){tb[0], tb[1], tb[2], tb[3]}; *(f32x4*)(SV + o) = (f32x4){tv[0], tv[1], tv[2], tv[3]};
                if (!first) *(f32x4*)(SU + o - BW) = (f32x4){pw[0] * tkk[0], pw[1] * tkk[1], pw[2] * tkk[2], pw[3] * tkk[3]};
                if ((m & (SEQ - 1)) == SEQ - 1) *(f32x4*)(SU + o) = (f32x4){0.f, 0.f, 0.f, 0.f};
                if (cq < 2) BK[((size_t)m * 12 + h) * 2 + cq] = first ? 0.f : (cq == 0 ? be : ka);
                if (cq == 2) BON[(size_t)m * 12 + h] = bo;
            }
#pragma unroll
            for (int e = 0; e < 4; ++e) { prr[e] = xr[e]; prk[e] = xk[e]; prv[e] = xv[e]; pw[e] = tw[e]; pb[e] = tb[e]; pkt[e] = tkt[e]; }
        }
    }
}

__device__ __forceinline__ void scan_block(const Ctx& C, int sb, unsigned char* ws) {
    const int b = sb / 24, h = (sb % 24) >> 1, half = sb & 1;
    const float* SR = (const float*)(ws + WS_SR); const float* SW = (const float*)(ws + WS_SW); const float* SK = (const float*)(ws + WS_SK); const float* SKK = (const float*)(ws + WS_SKK);
    const float* SB = (const float*)(ws + WS_SB); const float* SV = (const float*)(ws + WS_SV); float* YR = (float*)(ws + WS_YRAW);
    constexpr int T = 64;
    LAS float* Lr = (LAS float*)(C.lds + RING_OFF); LAS float* Lw = Lr + T * 64; LAS float* Lk = Lw + T * 64; LAS float* Lkk = Lk + T * 64; LAS float* Lb = Lkk + T * 64;
    LAS float* Lv = Lb + T * 64; LAS float* Ly = Lv + T * 32;
    const int tid = C.tid, rl = tid >> 4, kq = tid & 15;
    const size_t rowbase = (size_t)b * SEQ; const int colh = h * 64;
    const int lt0 = tid >> 4, lc0 = (tid & 15) * 4, vt = tid >> 3, vc = (tid & 7) * 4;
    f32x4 pr[2], pw[2], pk[2], pkk[2], pb[2], pv;
#define SCAN_LOAD(t0) do { _Pragma("unroll") for (int i = 0; i < 2; ++i) { const size_t o = (rowbase + (t0) + lt0 + 32 * i) * BW + colh + lc0; \
        pr[i] = *(const f32x4*)(SR + o); pw[i] = *(const f32x4*)(SW + o); pk[i] = *(const f32x4*)(SK + o); pkk[i] = *(const f32x4*)(SKK + o); pb[i] = *(const f32x4*)(SB + o); } \
        pv = *(const f32x4*)(SV + (rowbase + (t0) + vt) * BW + colh + 32 * half + vc); } while (0)
    SCAN_LOAD(0);
    float S0 = 0.f, S1 = 0.f, S2 = 0.f, S3 = 0.f;
    for (int ch = 0; ch < SEQ / T; ++ch) {
        const int t0 = ch * T;
#pragma unroll
        for (int i = 0; i < 2; ++i) { const int lo = (lt0 + 32 * i) * 64 + lc0;
            *(LAS f32x4*)(Lr + lo) = pr[i]; *(LAS f32x4*)(Lw + lo) = pw[i]; *(LAS f32x4*)(Lk + lo) = pk[i]; *(LAS f32x4*)(Lkk + lo) = pkk[i]; *(LAS f32x4*)(Lb + lo) = pb[i]; }
        *(LAS f32x4*)(Lv + vt * 32 + vc) = pv;
        __syncthreads();
        if (ch + 1 < SEQ / T) SCAN_LOAD(t0 + T);
#pragma unroll 4
        for (int t = 0; t < T; ++t) {
            const f32x4 kk4 = *(const LAS f32x4*)(Lkk + t * 64 + kq * 4), w4 = *(const LAS f32x4*)(Lw + t * 64 + kq * 4), b4 = *(const LAS f32x4*)(Lb + t * 64 + kq * 4);
            const f32x4 k4 = *(const LAS f32x4*)(Lk + t * 64 + kq * 4), r4 = *(const LAS f32x4*)(Lr + t * 64 + kq * 4); const float v = Lv[t * 32 + rl];
            float d = (S0 * kk4.x + S1 * kk4.y) + (S2 * kk4.z + S3 * kk4.w); d = red16(d); const float sa = -d;
            S0 = S0 * w4.x + (sa * b4.x + v * k4.x); S1 = S1 * w4.y + (sa * b4.y + v * k4.y); S2 = S2 * w4.z + (sa * b4.z + v * k4.z); S3 = S3 * w4.w + (sa * b4.w + v * k4.w);
            float y = (S0 * r4.x + S1 * r4.y) + (S2 * r4.z + S3 * r4.w); y = red16(y);
            if (kq == 0) Ly[t * 32 + rl] = y;
        }
        __syncthreads();
        *(f32x4*)(YR + (rowbase + t0 + vt) * BW + colh + 32 * half + vc) = *(const LAS f32x4*)(Ly + vt * 32 + vc);
    }
#undef SCAN_LOAD
}

__device__ __forceinline__ void glds16(const void* gsrc, unsigned lds_dst) { unsigned keep;
    asm volatile("s_mov_b32 %0, m0\n\ts_mov_b32 m0, %2\n\ts_nop 0\n\tglobal_load_lds_dwordx4 %1, off\n\ts_mov_b32 m0, %0" : "=&s"(keep) : "v"(gsrc), "s"(lds_dst) : "memory"); }
__device__ __forceinline__ void glds4(const void* gsrc, unsigned lds_dst) { unsigned keep;
    asm volatile("s_mov_b32 %0, m0\n\ts_mov_b32 m0, %2\n\ts_nop 0\n\tglobal_load_lds_dword %1, off\n\ts_mov_b32 m0, %0" : "=&s"(keep) : "v"(gsrc), "s"(lds_dst) : "memory"); }
constexpr int SCAN_T = 8, SCAN_SLOT = 5 * SCAN_T * 256 + 512, SCAN_NSLOT = 3, SCAN_RING = SCAN_NSLOT * SCAN_SLOT;
typedef float f32x2 __attribute__((ext_vector_type(2)));
__device__ __forceinline__ void scan_wave(int lane, LAS unsigned char* ring, int hs, int r0, unsigned char* ws) {
    const int b = hs / 12, h = hs % 12;
    const float* SR = (const float*)(ws + WS_SR); const float* SW = (const float*)(ws + WS_SW); const float* SK = (const float*)(ws + WS_SK); const float* SU = (const float*)(ws + WS_SKK);
    const float* SB = (const float*)(ws + WS_SB); const float* SV = (const float*)(ws + WS_SV); const float* BK = (const float*)(ws + WS_BK); float* YR = (float*)(ws + WS_YRAW);
    const int rg = lane >> 4, kq = lane & 15;
    const size_t rowbase = (size_t)b * SEQ; const int colh = h * 64;
    const unsigned ring0 = (unsigned)(size_t)ring;
    const size_t voff = ((size_t)(lane >> 4)) * BW + colh + 4 * kq;
    const size_t vvoff = ((size_t)((lane & 31) >> 2)) * BW + colh + r0 + (lane & 3);
    const size_t bkoff = ((size_t)((lane & 15) >> 1) * 12 + h) * 2 + (lane & 1);
    constexpr int NCH = SEQ / SCAN_T;
#define SCAN_DMA(ch, slot) do { const int cc_ = (ch) < NCH ? (ch) : NCH - 1; const size_t tok_ = rowbase + (size_t)cc_ * SCAN_T; const unsigned sl_ = ring0 + (unsigned)(slot) * SCAN_SLOT; \
        _Pragma("unroll") for (int i_ = 0; i_ < 2; ++i_) { const size_t o_ = (tok_ + 4 * i_) * BW + voff; \
            glds16(SU + o_, sl_ + 0 * 2048 + i_ * 1024); glds16(SW + o_, sl_ + 1 * 2048 + i_ * 1024); glds16(SB + o_, sl_ + 2 * 2048 + i_ * 1024); glds16(SK + o_, sl_ + 3 * 2048 + i_ * 1024); glds16(SR + o_, sl_ + 4 * 2048 + i_ * 1024); } \
        glds4(SV + tok_ * BW + vvoff, sl_ + 10240); glds4(BK + tok_ * 24 + bkoff, sl_ + 10496); } while (0)
    SCAN_DMA(0, 0); SCAN_DMA(1, 1); SCAN_DMA(2, 2);
    f32x2 S01 = (f32x2){0.f, 0.f}, S23 = (f32x2){0.f, 0.f};
    float e_cur = 0.f, sa_prev = 0.f, v_prev = 0.f;
    int slot = 0;
    for (int ch = 0; ch < NCH; ++ch) {
        asm volatile("s_waitcnt vmcnt(24)" ::: "memory");
        const LAS unsigned char* sp = ring + slot * SCAN_SLOT;
        float ykeep = 0.f;
        f32x4 u4a[SCAN_T], w4a[SCAN_T], b4a[SCAN_T], k4a[SCAN_T], r4a[SCAN_T]; float va[SCAN_T]; f32x2 bka[SCAN_T];
#pragma unroll
        for (int tt = 0; tt < SCAN_T; ++tt) {
            u4a[tt] = *(const LAS f32x4*)(sp + 0 * 2048 + tt * 256 + kq * 16); bka[tt] = *(const LAS f32x2*)(sp + 10496 + tt * 8); va[tt] = *(const LAS float*)(sp + 10240 + tt * 16 + rg * 4);
            w4a[tt] = *(const LAS f32x4*)(sp + 1 * 2048 + tt * 256 + kq * 16); b4a[tt] = *(const LAS f32x4*)(sp + 2 * 2048 + tt * 256 + kq * 16);
            k4a[tt] = *(const LAS f32x4*)(sp + 3 * 2048 + tt * 256 + kq * 16); r4a[tt] = *(const LAS f32x4*)(sp + 4 * 2048 + tt * 256 + kq * 16); }
#pragma unroll
        for (int tt = 0; tt < SCAN_T; ++tt) {
            const f32x4 u4 = u4a[tt], w4 = w4a[tt], b4 = b4a[tt], k4 = k4a[tt], r4 = r4a[tt]; const float v = va[tt]; const f32x2 bk = bka[tt];
            f32x2 pe = S01 * (f32x2){u4.x, u4.y}; pe = S23 * (f32x2){u4.z, u4.w} + pe; const float e_next = red16(pe.x + pe.y);
            const float d = e_cur + sa_prev * bk.x + v_prev * bk.y; const float sa = -d;
            const f32x2 sav = (f32x2){sa, sa}, vv = (f32x2){v, v};
            S01 = S01 * (f32x2){w4.x, w4.y} + (sav * (f32x2){b4.x, b4.y} + vv * (f32x2){k4.x, k4.y});
            S23 = S23 * (f32x2){w4.z, w4.w} + (sav * (f32x2){b4.z, b4.w} + vv * (f32x2){k4.z, k4.w});
            f32x2 py = S01 * (f32x2){r4.x, r4.y}; py = S23 * (f32x2){r4.z, r4.w} + py; const float y = red16(py.x + py.y);
            ykeep = (kq == tt) ? y : ykeep;
            e_cur = e_next; sa_prev = sa; v_prev = v;
        }
        if (kq < SCAN_T) YR[(rowbase + (size_t)ch * SCAN_T + kq) * BW + colh + r0 + rg] = ykeep;
        SCAN_DMA(ch + 3, slot);
        slot = (slot == SCAN_NSLOT - 1) ? 0 : slot + 1;
    }
    asm volatile("s_waitcnt vmcnt(0)" ::: "memory");
#undef SCAN_DMA
}

constexpr int SH_T = 8, SH_SLOT = 10240 + 1024 + 256, SH_NSLOT = 11, SH_D = 4, SH_FLAGS = SCANRING_OFF + SH_NSLOT * SH_SLOT;
static_assert(SH_FLAGS + 64 <= LDSCTL_OFF, "scan ring + flags fit below the LDS control words");
__device__ __forceinline__ unsigned lds_ld(volatile LAS unsigned* p) { return *p; }
__device__ __forceinline__ void scan_loader(int lane, LAS unsigned char* lds, int hs, int rblk, unsigned char* ws) {
    const int b = hs / 12, h = hs % 12;
    const float* SR = (const float*)(ws + WS_SR); const float* SW = (const float*)(ws + WS_SW); const float* SK = (const float*)(ws + WS_SK); const float* SU = (const float*)(ws + WS_SKK);
    const float* SB = (const float*)(ws + WS_SB); const float* SV = (const float*)(ws + WS_SV); const float* BK = (const float*)(ws + WS_BK);
    const size_t rowbase = (size_t)b * SEQ; const int colh = h * 64;
    const unsigned ring0 = (unsigned)(size_t)(lds + SCANRING_OFF);
    volatile LAS unsigned* flags = (volatile LAS unsigned*)(lds + SH_FLAGS);
    const size_t voff = ((size_t)(lane >> 4)) * BW + colh + 4 * (lane & 15);
    const size_t vvoff = ((size_t)((lane >> 2) & 7)) * BW + colh + rblk + 4 * (lane & 3);
    const size_t bkoff = ((size_t)((lane & 15) >> 1) * 12 + h) * 2 + (lane & 1);
    constexpr int NCH = SEQ / SH_T;
    int slot = 0;
    for (int c = 0; c < NCH; ++c) {
        if (c >= SH_NSLOT) { const unsigned need = (unsigned)(c - SH_NSLOT + 1);
            while (lds_ld(flags + 1) < need || lds_ld(flags + 2) < need || lds_ld(flags + 3) < need || lds_ld(flags + 4) < need) __builtin_amdgcn_s_sleep(1); }
        const size_t tok = rowbase + (size_t)c * SH_T; const unsigned sl = ring0 + (unsigned)slot * SH_SLOT;
#pragma unroll
        for (int i = 0; i < 2; ++i) { const size_t o = (tok + 4 * i) * BW + voff;
            glds16(SU + o, sl + 0 * 2048 + i * 1024); glds16(SW + o, sl + 1 * 2048 + i * 1024); glds16(SB + o, sl + 2 * 2048 + i * 1024); glds16(SK + o, sl + 3 * 2048 + i * 1024); glds16(SR + o, sl + 4 * 2048 + i * 1024); }
        glds16(SV + tok * BW + vvoff, sl + 10240); glds4(BK + tok * 24 + bkoff, sl + 11264);
        if (c >= SH_D) { asm volatile("s_waitcnt vmcnt(48)" ::: "memory"); if (lane == 0) flags[0] = (unsigned)(c - SH_D + 1); }
        slot = (slot == SH_NSLOT - 1) ? 0 : slot + 1;
    }
    asm volatile("s_waitcnt vmcnt(0)" ::: "memory"); if (lane == 0) flags[0] = (unsigned)NCH;
}
__device__ __forceinline__ void scan_wave_sh(int lane, int w, LAS unsigned char* lds, int hs, int rblk, unsigned char* ws) {
    const int b = hs / 12, h = hs % 12; float* YR = (float*)(ws + WS_YRAW);
    const int rg = lane >> 4, kq = lane & 15, r0 = rblk + 4 * w;
    const size_t rowbase = (size_t)b * SEQ; const int colh = h * 64;
    volatile LAS unsigned* flags = (volatile LAS unsigned*)(lds + SH_FLAGS);
    constexpr int NCH = SEQ / SH_T;
    f32x2 S01 = (f32x2){0.f, 0.f}, S23 = (f32x2){0.f, 0.f};
    float e_cur = 0.f, sa_prev = 0.f, v_prev = 0.f;
    int slot = 0;
    for (int ch = 0; ch < NCH; ++ch) {
        while (lds_ld(flags) <= (unsigned)ch) __builtin_amdgcn_s_sleep(1);
        asm volatile("" ::: "memory");
        const LAS unsigned char* sp = lds + SCANRING_OFF + slot * SH_SLOT;
        float ykeep = 0.f;
        f32x4 u4a[SH_T], w4a[SH_T], b4a[SH_T], k4a[SH_T], r4a[SH_T]; float va[SH_T]; f32x2 bka[SH_T];
#pragma unroll
        for (int tt = 0; tt < SH_T; ++tt) {
            u4a[tt] = *(const LAS f32x4*)(sp + 0 * 2048 + tt * 256 + kq * 16); bka[tt] = *(const LAS f32x2*)(sp + 11264 + tt * 8); va[tt] = *(const LAS float*)(sp + 10240 + tt * 64 + (w * 4 + rg) * 4);
            w4a[tt] = *(const LAS f32x4*)(sp + 1 * 2048 + tt * 256 + kq * 16); b4a[tt] = *(const LAS f32x4*)(sp + 2 * 2048 + tt * 256 + kq * 16);
            k4a[tt] = *(const LAS f32x4*)(sp + 3 * 2048 + tt * 256 + kq * 16); r4a[tt] = *(const LAS f32x4*)(sp + 4 * 2048 + tt * 256 + kq * 16); }
#pragma unroll
        for (int tt = 0; tt < SH_T; ++tt) {
            const f32x4 u4 = u4a[tt], w4 = w4a[tt], b4 = b4a[tt], k4 = k4a[tt], r4 = r4a[tt]; const float v = va[tt]; const f32x2 bk = bka[tt];
            f32x2 pe = S01 * (f32x2){u4.x, u4.y}; pe = S23 * (f32x2){u4.z, u4.w} + pe; const float e_next = red16(pe.x + pe.y);
            const float d = e_cur + sa_prev * bk.x + v_prev * bk.y; const float sa = -d;
            const f32x2 sav = (f32x2){sa, sa}, vv = (f32x2){v, v};
            S01 = S01 * (f32x2){w4.x, w4.y} + (sav * (f32x2){b4.x, b4.y} + vv * (f32x2){k4.x, k4.y});
            S23 = S23 * (f32x2){w4.z, w4.w} + (sav * (f32x2){b4.z, b4.w} + vv * (f32x2){k4.z, k4.w});
            f32x2 py = S01 * (f32x2){r4.x, r4.y}; py = S23 * (f32x2){r4.z, r4.w} + py; const float y = red16(py.x + py.y);
            ykeep = (kq == tt) ? y : ykeep;
            e_cur = e_next; sa_prev = sa; v_prev = v;
        }
        if (kq < SH_T) YR[(rowbase + (size_t)ch * SH_T + kq) * BW + colh + r0 + rg] = ykeep;
        asm volatile("" ::: "memory");
        if (lane == 0) flags[1 + w] = (unsigned)(ch + 1);
        slot = (slot == SH_NSLOT - 1) ? 0 : slot + 1;
    }
}

struct AttnPass { int qcol; int bias_head; int tbl; float sink; int use_sink; int maxsteps; bf16* out; int out_ld; int out_col; float* lse; };
__device__ __forceinline__ void attn_stage_kv(const Ctx& C, const bf16* P1, int b, int res, int dil, int fblk, int kcol, int vcol) {
    LAS unsigned char* Ks = C.lds + RING_OFF; LAS unsigned char* Vs = Ks + 256 * 144;
#pragma unroll
    for (int i = 0; i < 4; ++i) { const int c = C.tid + 512 * i, row = c >> 3, part = c & 7; const int fp = (fblk - 1) * 128 + row;
        v4u kv = (v4u){0u, 0u, 0u, 0u}, vv = (v4u){0u, 0u, 0u, 0u};
        if (fp >= 0) { const bf16* src = P1 + ((size_t)b * SEQ + (size_t)fp * dil + res) * NP1; kv = *(const v4u*)(src + kcol + part * 8); vv = *(const v4u*)(src + vcol + part * 8); }
        *(LAS v4u*)(Ks + row * 144 + part * 16) = kv; *(LAS v4u*)(Vs + row * 144 + part * 16) = vv; }
}
__device__ __forceinline__ void attn_pass(const Ctx& C, const bf16* P1, const float* relb, int b, int res, int dil, int fblk, const AttnPass& ap) {
    LAS unsigned char* Ks = C.lds + RING_OFF; LAS unsigned char* Vs = Ks + 256 * 144; LAS float* lut = (LAS float*)(Vs + 256 * 144);
    __syncthreads();
    if (C.tid < 132) lut[C.tid] = (C.tid <= 128) ? relb[(int)T5B[ap.tbl][C.tid] * 20 + ap.bias_head] : 0.f;
    __syncthreads();
    const int i = C.tid >> 2, dq = C.tid & 3;
    const size_t tok = (size_t)b * SEQ + (size_t)(fblk * 128 + i) * dil + res;
    float q[16];
    { const bf16* qp = P1 + tok * NP1 + ap.qcol + dq * 16; const v4u a0 = *(const v4u*)qp, a1 = *(const v4u*)(qp + 8);
      q[0] = bflo(a0.x); q[1] = bfhi(a0.x); q[2] = bflo(a0.y); q[3] = bfhi(a0.y); q[4] = bflo(a0.z); q[5] = bfhi(a0.z); q[6] = bflo(a0.w); q[7] = bfhi(a0.w);
      q[8] = bflo(a1.x); q[9] = bfhi(a1.x); q[10] = bflo(a1.y); q[11] = bfhi(a1.y); q[12] = bflo(a1.z); q[13] = bfhi(a1.z); q[14] = bflo(a1.w); q[15] = bfhi(a1.w);
#pragma unroll
      for (int j = 0; j < 16; ++j) q[j] *= 0.125f; }
    float mrun = ap.use_sink ? ap.sink : -INFINITY, lrun = ap.use_sink ? 1.0f : 0.0f;
    float o[16];
#pragma unroll
    for (int j = 0; j < 16; ++j) o[j] = 0.f;
    const int fq0 = fblk * 128 + i;
    for (int dist = 0; dist <= ap.maxsteps; ++dist) {
        const int kr = i + 128 - dist;
        const bool valid = (fq0 - dist) >= 0;
        const v4u k0 = *(const LAS v4u*)(Ks + kr * 144 + dq * 32), k1 = *(const LAS v4u*)(Ks + kr * 144 + dq * 32 + 16);
        float s = q[0] * bflo(k0.x) + q[1] * bfhi(k0.x) + q[2] * bflo(k0.y) + q[3] * bfhi(k0.y) + q[4] * bflo(k0.z) + q[5] * bfhi(k0.z) + q[6] * bflo(k0.w) + q[7] * bfhi(k0.w)
                + q[8] * bflo(k1.x) + q[9] * bfhi(k1.x) + q[10] * bflo(k1.y) + q[11] * bfhi(k1.y) + q[12] * bflo(k1.z) + q[13] * bfhi(k1.z) + q[14] * bflo(k1.w) + q[15] * bfhi(k1.w);
        s = red4(s) + lut[dist];
        if (valid) {
            if (s > mrun) { const float c = __expf(mrun - s); lrun *= c;
#pragma unroll
                for (int j = 0; j < 16; ++j) o[j] *= c;
                mrun = s; }
            const float p = __expf(s - mrun); lrun += p;
            const v4u v0 = *(const LAS v4u*)(Vs + kr * 144 + dq * 32), v1 = *(const LAS v4u*)(Vs + kr * 144 + dq * 32 + 16);
            o[0] += p * bflo(v0.x); o[1] += p * bfhi(v0.x); o[2] += p * bflo(v0.y); o[3] += p * bfhi(v0.y); o[4] += p * bflo(v0.z); o[5] += p * bfhi(v0.z); o[6] += p * bflo(v0.w); o[7] += p * bfhi(v0.w);
            o[8] += p * bflo(v1.x); o[9] += p * bfhi(v1.x); o[10] += p * bflo(v1.y); o[11] += p * bfhi(v1.y); o[12] += p * bflo(v1.z); o[13] += p * bfhi(v1.z); o[14] += p * bflo(v1.w); o[15] += p * bfhi(v1.w);
        }
    }
    const float inv = 1.0f / lrun;
    v4u w0, w1;
    w0.x = pk2(o[0] * inv, o[1] * inv); w0.y = pk2(o[2] * inv, o[3] * inv); w0.z = pk2(o[4] * inv, o[5] * inv); w0.w = pk2(o[6] * inv, o[7] * inv);
    w1.x = pk2(o[8] * inv, o[9] * inv); w1.y = pk2(o[10] * inv, o[11] * inv); w1.z = pk2(o[12] * inv, o[13] * inv); w1.w = pk2(o[14] * inv, o[15] * inv);
    bf16* op = ap.out + tok * ap.out_ld + ap.out_col + dq * 16;
    *(v4u*)op = w0; *(v4u*)(op + 8) = w1;
    if (ap.lse && dq == 0) ap.lse[tok * 4] = mrun + __logf(lrun);
}
__device__ __forceinline__ void phase_attn(const Ctx& C, const Args& a, int l, unsigned char* ws, int ab, int nab) {
    const bf16* P1 = (const bf16*)(ws + WS_P1); const float* relb = a.in[1]; const float* sinks = a.in[4] + l * 8;
    bf16* YA = (bf16*)(ws + WS_YA); bf16* OC = (bf16*)(ws + WS_OC); float* LSE = (float*)(ws + WS_LSE);
    constexpr int NA = 256, NC = 1536;
    for (int it = ab; it < NA + NC; it += nab) {
        __syncthreads();
        if (it < NA) {
            const int b = it >> 7, fblk = (it >> 1) & 63, hkv = it & 1;
            attn_stage_kv(C, P1, b, 0, 1, fblk, C_AK + hkv * 64, C_AV + hkv * 64);
            for (int g = 0; g < 4; ++g) { const int hq = hkv * 4 + g;
                AttnPass ap; ap.qcol = C_AQ + hq * 64; ap.bias_head = hq; ap.tbl = 0; ap.sink = sinks[hq]; ap.use_sink = 1; ap.maxsteps = 127; ap.out = YA; ap.out_ld = 512; ap.out_col = hq * 64; ap.lse = nullptr;
                attn_pass(C, P1, relb, b, 0, 1, fblk, ap); }
        } else {
            const int ci = it - NA; const int gi = ci / 512, j = (ci >> 7) & 3, qb = ci & 127;
            const int dil = (gi == 0) ? 1 : (gi == 1 ? 4 : 16); const int bps = 64 / dil;
            const int n = qb / bps, fblk = qb % bps, b = n / dil, res = n % dil; const int hc = gi * 4 + j;
            attn_stage_kv(C, P1, b, res, dil, fblk, C_CK + hc * 64, C_CV + hc * 64);
            AttnPass ap; ap.qcol = C_CQ + hc * 64; ap.bias_head = 8 + hc; ap.tbl = gi; ap.sink = 0.f; ap.use_sink = 0; ap.maxsteps = 128; ap.out = OC + (size_t)gi * M * 256; ap.out_ld = 256; ap.out_col = j * 64;
            ap.lse = LSE + (size_t)gi * M * 4 + j;
            attn_pass(C, P1, relb, b, res, dil, fblk, ap);
        }
    }
}

__device__ __forceinline__ void phase_vt(const Ctx& C, unsigned char* ws) {
    const bf16* P1 = (const bf16*)(ws + WS_P1); bf16* VT = (bf16*)(ws + WS_VT);
    for (int it = C.gw; it < 14 * 2 * 128; it += C.ngw) {
        const int hs = it / 256, b = (it >> 7) & 1, blk = it & 127;
        const int gi = hs < 2 ? 0 : (hs - 2) >> 2; const int dil = gi == 0 ? 1 : (gi == 1 ? 4 : 16); const int Lf = SEQ / dil;
        const int vcol = hs < 2 ? C_AV + hs * 64 : C_CV + (hs - 2) * 64;
        const int ft = blk * 64 + C.lane;
        const int res = ft / Lf, tp = ft % Lf; const int tok = b * SEQ + tp * dil + res;
        const v4u* src = (const v4u*)(P1 + (size_t)tok * NP1 + vcol);
        v4u x[8];
#pragma unroll
        for (int i = 0; i < 8; ++i) x[i] = src[i];
        bf16* dst = VT + ((size_t)(hs * 2 + b) * 64) * SEQ + ft;
#pragma unroll
        for (int i = 0; i < 8; ++i) {
            dst[(size_t)(8 * i + 0) * SEQ] = (bf16)(x[i].x & 0xffffu); dst[(size_t)(8 * i + 1) * SEQ] = (bf16)(x[i].x >> 16);
            dst[(size_t)(8 * i + 2) * SEQ] = (bf16)(x[i].y & 0xffffu); dst[(size_t)(8 * i + 3) * SEQ] = (bf16)(x[i].y >> 16);
            dst[(size_t)(8 * i + 4) * SEQ] = (bf16)(x[i].z & 0xffffu); dst[(size_t)(8 * i + 5) * SEQ] = (bf16)(x[i].z >> 16);
            dst[(size_t)(8 * i + 6) * SEQ] = (bf16)(x[i].w & 0xffffu); dst[(size_t)(8 * i + 7) * SEQ] = (bf16)(x[i].w >> 16);
        }
    }
}

typedef float f32x16 __attribute__((ext_vector_type(16)));
__device__ __forceinline__ void attn_wave_item(int lane, const LAS float* lutall, int item, const float* sinks, unsigned char* ws) {
    const bf16* P1 = (const bf16*)(ws + WS_P1); const bf16* VT = (const bf16*)(ws + WS_VT);
    const int hh = item % 20, g32 = item / 20;
    const bool isA = hh < 8; const int hc = hh - 8; const int gi = isA ? 0 : hc >> 2, j = hc & 3;
    const int dil = gi == 0 ? 1 : (gi == 1 ? 4 : 16); const int Lf = SEQ / dil, gps = Lf / 32;
    const int b = g32 >> 8, rr = g32 & 255, res = rr / gps, qg = rr % gps, fq0 = qg * 32;
    const int qcol = isA ? C_AQ + hh * 64 : C_CQ + hc * 64, kcol = isA ? C_AK + (hh >> 2) * 64 : C_CK + hc * 64;
    const int hs = isA ? (hh >> 2) : 2 + hc; const int maxsteps = isA ? 127 : 128;
    const LAS float* lut = lutall + hh * 132;
    const int r = lane & 31, hf = lane >> 5;
    const size_t tokq = (size_t)b * SEQ + (size_t)(fq0 + r) * dil + res;
    pg8::bf16x8 qf[4];
    { const bf16* qrow = P1 + tokq * NP1 + qcol + 8 * hf;
#pragma unroll
      for (int s_ = 0; s_ < 4; ++s_) qf[s_] = *(const pg8::bf16x8*)(qrow + 16 * s_); }
    f32x16 sc[5];
#pragma unroll
    for (int kt = 0; kt < 5; ++kt) {
        int fk = fq0 - 128 + 32 * kt + r; fk = fk < 0 ? 0 : fk;
        const bf16* krow = P1 + ((size_t)b * SEQ + (size_t)fk * dil + res) * NP1 + kcol + 8 * hf;
        f32x16 acc;
#pragma unroll
        for (int q = 0; q < 16; ++q) acc[q] = 0.f;
#pragma unroll
        for (int s_ = 0; s_ < 4; ++s_) { const pg8::bf16x8 a = *(const pg8::bf16x8*)(krow + 16 * s_); acc = __builtin_amdgcn_mfma_f32_32x32x16_bf16(a, qf[s_], acc, 0, 0, 0); }
        sc[kt] = acc;
    }
    float mx = -1e30f;
#pragma unroll
    for (int kt = 0; kt < 5; ++kt)
#pragma unroll
        for (int q = 0; q < 16; ++q) {
            const int rowoff = (q & 3) + 8 * (q >> 2) + 4 * hf; const int dist = 128 + r - 32 * kt - rowoff; const int fk = fq0 + r - dist;
            const bool valid = dist >= 0 && dist <= maxsteps && fk >= 0;
            const int di = dist < 0 ? 0 : (dist > 128 ? 128 : dist);
            const float sv = valid ? sc[kt][q] * 0.125f + lut[di] : -1e30f;
            sc[kt][q] = sv; mx = fmaxf(mx, sv);
        }
    mx = fmaxf(mx, __shfl_xor(mx, 32));
    const float sink = isA ? sinks[hh] : -1e30f;
    mx = fmaxf(mx, sink);
    float lsum = 0.f;
#pragma unroll
    for (int kt = 0; kt < 5; ++kt)
#pragma unroll
        for (int q = 0; q < 16; ++q) { const float pv = __expf(sc[kt][q] - mx); sc[kt][q] = pv; lsum += pv; }
    lsum += __shfl_xor(lsum, 32);
    const float denom = isA ? lsum + __expf(sink - mx) : lsum;
    const float inv = 1.0f / denom;
    pg8::bf16x8 pf[5][2];
#pragma unroll
    for (int kt = 0; kt < 5; ++kt)
#pragma unroll
        for (int s_ = 0; s_ < 2; ++s_) { pg8::u32x4 w;
            w.x = pg8::cvt_pk_bf16(sc[kt][8 * s_ + 0], sc[kt][8 * s_ + 1]); w.y = pg8::cvt_pk_bf16(sc[kt][8 * s_ + 2], sc[kt][8 * s_ + 3]);
            w.z = pg8::cvt_pk_bf16(sc[kt][8 * s_ + 4], sc[kt][8 * s_ + 5]); w.w = pg8::cvt_pk_bf16(sc[kt][8 * s_ + 6], sc[kt][8 * s_ + 7]);
            pf[kt][s_] = __builtin_bit_cast(pg8::bf16x8, w); }
    bf16* outp; int out_ld, ocol;
    if (isA) { outp = (bf16*)(ws + WS_YA); out_ld = 512; ocol = hh * 64; } else { outp = (bf16*)(ws + WS_OC) + (size_t)gi * M * 256; out_ld = 256; ocol = j * 64; }
    const bf16* vth = VT + ((size_t)(hs * 2 + b) * 64) * SEQ + (size_t)res * Lf;
#pragma unroll
    for (int dt = 0; dt < 2; ++dt) {
        const bf16* vrow = vth + (size_t)(32 * dt + r) * SEQ;
        f32x16 acc;
#pragma unroll
        for (int q = 0; q < 16; ++q) acc[q] = 0.f;
#pragma unroll
        for (int kt = 0; kt < 5; ++kt)
#pragma unroll
            for (int s_ = 0; s_ < 2; ++s_) {
                int k0 = fq0 - 128 + 32 * kt + 16 * s_ + 4 * hf, k1 = k0 + 8; k0 = k0 < 0 ? 0 : k0; k1 = k1 < 0 ? 0 : k1;
                const v2u lo = *(const v2u*)(vrow + k0), hi = *(const v2u*)(vrow + k1);
                pg8::u32x4 w; w.x = lo.x; w.y = lo.y; w.z = hi.x; w.w = hi.y;
                acc = __builtin_amdgcn_mfma_f32_32x32x16_bf16(__builtin_bit_cast(pg8::bf16x8, w), pf[kt][s_], acc, 0, 0, 0);
            }
        bf16* op = outp + tokq * out_ld + ocol + 32 * dt + 4 * hf;
#pragma unroll
        for (int g = 0; g < 4; ++g) { v2u w; w.x = pg8::cvt_pk_bf16(acc[4 * g + 0] * inv, acc[4 * g + 1] * inv); w.y = pg8::cvt_pk_bf16(acc[4 * g + 2] * inv, acc[4 * g + 3] * inv);
            *(v2u*)(op + 8 * g) = w; }
    }
    if (!isA && hf == 0) ((float*)(ws + WS_LSE))[((size_t)gi * M + tokq) * 4 + j] = mx + __logf(lsum);
}
__device__ __forceinline__ void build_lut(const Ctx& C, const float* relb) {
    LAS float* lut = (LAS float*)(C.lds + LUT_OFF);
    for (int i = C.tid; i < 20 * 132; i += NTHREADS) { const int hh = i / 132, d = i % 132; const int tbl = hh < 8 ? 0 : (hh - 8) >> 2;
        lut[i] = (d <= 128) ? relb[(int)T5B[tbl][d] * 20 + hh] : 0.f; }
    __syncthreads();
}

__device__ __forceinline__ void phase_post(const Ctx& C, const Args& a, int l, unsigned char* ws) {
    const float* YR = (const float*)(ws + WS_YRAW); const float* SV = (const float*)(ws + WS_SV); const float* BON = (const float*)(ws + WS_BON);
    const float* LO = (const float*)(ws + WS_LO); bf16* YB = (bf16*)(ws + WS_YB);
    const float* lgp = a.in[14] + (size_t)l * BW; const float* lbp = a.in[15] + (size_t)l * BW;
    const int g = C.lane >> 4, cq = C.lane & 15;
    for (int it0 = C.gw * 2; it0 < (M / 4) * 12; it0 += C.ngw * 2) {
        f32x4 y[2], vv[2], gg[2]; float bo[2]; int mm[2], cc[2];
#pragma unroll
        for (int u = 0; u < 2; ++u) { const int it = it0 + u; const int h = it % 12, m = (it / 12) * 4 + g, c0 = h * 64 + 4 * cq; mm[u] = m; cc[u] = c0;
            const size_t o = (size_t)m * BW + c0; y[u] = *(const f32x4*)(YR + o); vv[u] = *(const f32x4*)(SV + o); gg[u] = *(const f32x4*)(LO + (size_t)m * NLORA + 2 * BW + c0); bo[u] = BON[(size_t)m * 12 + h]; }
#pragma unroll
        for (int u = 0; u < 2; ++u) {
            const f32x4 lg = *(const f32x4*)(lgp + cc[u]), lb = *(const f32x4*)(lbp + cc[u]);
            const float mean = red16((y[u][0] + y[u][1]) + (y[u][2] + y[u][3])) * (1.0f / 64.0f);
            const f32x4 dv = y[u] - mean; const float var = red16((dv[0] * dv[0] + dv[1] * dv[1]) + (dv[2] * dv[2] + dv[3] * dv[3])) * (1.0f / 64.0f);
            const float rsd = __builtin_amdgcn_rsqf(var + GN_EPS);
            f32x4 yn = (dv * rsd * lg + lb + vv[u] * bo[u]) * gg[u];
            v2u w; w.x = pk2(yn[0], yn[1]); w.y = pk2(yn[2], yn[3]); *(v2u*)(YB + (size_t)mm[u] * BW + cc[u]) = w;
        }
    }
    const bf16* OC = (const bf16*)(ws + WS_OC); const float* LSE = (const float*)(ws + WS_LSE); bf16* YC = (bf16*)(ws + WS_YC);
    for (int mb = C.gw * 4; mb < M; mb += C.ngw * 4) {
        const int j = C.lane >> 4;
        float l0[4], l1[4], l2[4]; v2u a0[4], a1[4], a2[4];
#pragma unroll
        for (int i = 0; i < 4; ++i) { const int m = mb + i; l0[i] = LSE[(size_t)m * 4 + j]; l1[i] = LSE[((size_t)M + m) * 4 + j]; l2[i] = LSE[((size_t)2 * M + m) * 4 + j];
            a0[i] = *(const v2u*)(OC + (size_t)m * 256 + 4 * C.lane); a1[i] = *(const v2u*)(OC + ((size_t)M + m) * 256 + 4 * C.lane); a2[i] = *(const v2u*)(OC + ((size_t)2 * M + m) * 256 + 4 * C.lane); }
#pragma unroll
        for (int i = 0; i < 4; ++i) { const int m = mb + i;
            const float mx = fmaxf(l0[i], fmaxf(l1[i], l2[i])); const float e0 = __expf(l0[i] - mx), e1 = __expf(l1[i] - mx), e2 = __expf(l2[i] - mx); const float inv = 1.0f / (e0 + e1 + e2);
            const float w0 = e0 * inv, w1 = e1 * inv, w2 = e2 * inv;
            v2u o; o.x = pk2(w0 * bflo(a0[i].x) + w1 * bflo(a1[i].x) + w2 * bflo(a2[i].x), w0 * bfhi(a0[i].x) + w1 * bfhi(a1[i].x) + w2 * bfhi(a2[i].x));
            o.y = pk2(w0 * bflo(a0[i].y) + w1 * bflo(a1[i].y) + w2 * bflo(a2[i].y), w0 * bfhi(a0[i].y) + w1 * bfhi(a1[i].y) + w2 * bfhi(a2[i].y));
            *(v2u*)(YC + (size_t)m * 256 + 4 * C.lane) = o; }
    }
}

__device__ __forceinline__ void unpack8(const v4u w, float (&x)[8]) { x[0] = bflo(w.x); x[1] = bfhi(w.x); x[2] = bflo(w.y); x[3] = bfhi(w.y); x[4] = bflo(w.z); x[5] = bfhi(w.z); x[6] = bflo(w.w); x[7] = bfhi(w.w); }
__device__ __forceinline__ void phase_conv(const Ctx& C, const Args& a, int l, unsigned char* ws) {
    const bf16* U = (const bf16*)(ws + WS_U); bf16* ACT = (bf16*)(ws + WS_ACT); const float* cw = a.in[22] + (size_t)l * 3 * DFF;
    constexpr int GPR = DFF / 8, RUN = 32;
    const int gt = C.bid * NTHREADS + C.tid, ngt = C.G * NTHREADS;
    for (int idx = gt; idx < (M / RUN) * GPR; idx += ngt) {
        const int run = idx / GPR, f0 = (idx % GPR) * 8, m0 = run * RUN;
        float c0[8], c1[8], c2[8];
#pragma unroll
        for (int j = 0; j < 8; ++j) { c0[j] = cw[f0 + j]; c1[j] = cw[DFF + f0 + j]; c2[j] = cw[2 * DFF + f0 + j]; }
        const bf16* ur = U + (size_t)m0 * NUP + f0;
        float x0[8], x1[8];
        { v4u g0 = (v4u){0u, 0u, 0u, 0u}, g1 = (v4u){0u, 0u, 0u, 0u};
          if ((m0 & (SEQ - 1)) != 0) { g0 = *(const v4u*)(ur - 2 * NUP); g1 = *(const v4u*)(ur - NUP); }
          unpack8(g0, x0); unpack8(g1, x1); }
#pragma unroll 1
        for (int tq = 0; tq < RUN; tq += 4) {
            v4u gq[4], vq[4];
#pragma unroll
            for (int i = 0; i < 4; ++i) { gq[i] = *(const v4u*)(ur + (size_t)(tq + i) * NUP); vq[i] = *(const v4u*)(ur + (size_t)(tq + i) * NUP + DFF); }
#pragma unroll
            for (int i = 0; i < 4; ++i) {
                float x2[8], vl[8], r[8]; unpack8(gq[i], x2); unpack8(vq[i], vl);
#pragma unroll
                for (int j = 0; j < 8; ++j) { const float gsum = c0[j] * x0[j] + c1[j] * x1[j] + c2[j] * x2[j]; r[j] = gsum / (1.0f + __expf(-gsum)) * vl[j]; x0[j] = x1[j]; x1[j] = x2[j]; }
                v4u o; o.x = pk2(r[0], r[1]); o.y = pk2(r[2], r[3]); o.z = pk2(r[4], r[5]); o.w = pk2(r[6], r[7]);
                *(v4u*)(ACT + (size_t)(m0 + tq + i) * DFF + f0) = o;
            }
        }
    }
}

__device__ __forceinline__ Ctx make_ctx(unsigned char* lds) {
    Ctx C;
    C.lds = (LAS unsigned char*)lds;
    int t = threadIdx.x; asm volatile("" : "+v"(t));
    C.tid = t; C.lane = C.tid & 63; C.wave = __builtin_amdgcn_readfirstlane(C.tid >> 6);
    C.G = gridDim.x; C.bid = blockIdx.x; C.gw = C.bid * NWAVES + C.wave; C.ngw = C.G * NWAVES;
    return C;
}
template <int K> __device__ __forceinline__ void run_phase(unsigned char* lds, const Args& args, int l) {
    const Ctx C = make_ctx(lds);
    unsigned char* ws = args.ws; asm volatile("" : "+s"(ws)); unsigned char* wsw = ws + (size_t)(l & 1) * WSET_STRIDE; LAS unsigned char* ring = C.lds + RING_OFF; float* out = args.out;
    const float* xsrc = (l == 0) ? args.in[0] : out;
    if constexpr (K == 0) { phase_prep(C, args, l, xsrc, ws); }
    if constexpr (K == 1) { pg8::Gemm g{(const bf16*)(ws + WS_H), (const bf16*)(wsw + WS_WIN), M, NP1, D}; pg8::StaticOrder S; S.init(M, NP1, C.G, C.bid);
        pg8::EpiWin E{(bf16*)(ws + WS_P1), (bf16*)(ws + WS_G), 0};
        pg8::gemm_phase<pg8::EpiWin, pg8::StaticOrder, true, true>(ring, g, S, E); }
    if constexpr (K == 2) { phase_aprime(C, args, l, ws); phase_vt(C, ws); }
    if constexpr (K == 3) { pg8::Gemm g{(const bf16*)(ws + WS_AP), (const bf16*)(wsw + WS_WLORA), M, NLORA, KLORA}; pg8::StaticOrder S; S.init(M, NLORA, C.G, C.bid);
        pg8::EpiF32P E{(float*)(ws + WS_LO), NLORA};
        pg8::gemm_phase<pg8::EpiF32P, pg8::StaticOrder, true, true>(ring, g, S, E); }
    if constexpr (K == 4) { phase_scanprep(C, args, l, ws); }
    if constexpr (K == 5) {
        const int xg = C.bid & 7, jj = C.bid >> 3;
        if (jj < 12) {
            if (C.tid < 16) ((LAS unsigned*)(C.lds + SH_FLAGS))[C.tid] = 0u;
            __syncthreads();
            const int hs = xg * 3 + (jj >> 2), rblk = (jj & 3) * 16;
            if (C.wave < 4) scan_wave_sh(C.lane, C.wave, C.lds, hs, rblk, ws);
            else if (C.wave == 4) scan_loader(C.lane, C.lds, hs, rblk, ws);
        } else {
            const int gidx = (jj - 12) * 8 + xg;
            build_lut(C, args.in[1]);
            { const float* sinks = args.in[4] + l * 8;
              for (int rep = 0; rep < EXP_ATTN_REPS; ++rep) for (int it = gidx * 8 + C.wave; it < 512 * 20; it += 1280) attn_wave_item(C.lane, (const LAS float*)(C.lds + LUT_OFF), it, sinks, ws); }
            __syncthreads();
            for (int rep = 0; rep < EXP_GATE_REPS; ++rep) { pg8::Gemm g{(const bf16*)(ws + WS_H), (const bf16*)(wsw + WS_WIN) + (size_t)NP1 * D, M, NG, D}; pg8::StaticOrder S; S.init(M, NG, 160, gidx);
              pg8::EpiWin E{(bf16*)(ws + WS_P1), (bf16*)(ws + WS_G), 23};
              pg8::gemm_phase<pg8::EpiWin, pg8::StaticOrder, true, true>(ring, g, S, E); }
            if (l + 1 < DEPTH) convert_weights(gidx * 8 + C.wave, 1280, C.lane, (LAS float*)(C.lds + RING_OFF + C.wave * 16384), args, l + 1, ws);
        } }
    if constexpr (K == 6) { phase_post(C, args, l, ws); }
    if constexpr (K == 7) {
        { pg8::Gemm g{(const bf16*)(ws + WS_YA), (const bf16*)(wsw + WS_PA), M, D, 512}; pg8::StaticOrder S; S.init(M, D, C.G, C.bid);
          pg8::EpiGate<false> E{(const bf16*)(ws + WS_G), 0, (bf16*)(ws + WS_MG)};
          pg8::gemm_phase<pg8::EpiGate<false>, pg8::StaticOrder, true, true>(ring, g, S, E); }
        { pg8::Gemm g{(const bf16*)(ws + WS_YB), (const bf16*)(wsw + WS_PB), M, D, 768}; pg8::StaticOrder S; S.init(M, D, C.G, C.bid);
          pg8::EpiGate<true> E{(const bf16*)(ws + WS_G), 2048, (bf16*)(ws + WS_MG)};
          pg8::gemm_phase<pg8::EpiGate<true>, pg8::StaticOrder, true, true>(ring, g, S, E); }
        { pg8::Gemm g{(const bf16*)(ws + WS_YC), (const bf16*)(wsw + WS_PC), M, D, 256}; pg8::StaticOrder S; S.init(M, D, C.G, C.bid);
          pg8::EpiGate<true> E{(const bf16*)(ws + WS_G), 4096, (bf16*)(ws + WS_MG)};
          pg8::gemm_phase<pg8::EpiGate<true>, pg8::StaticOrder, true, true>(ring, g, S, E); } }
    if constexpr (K == 8) { pg8::Gemm g{(const bf16*)(ws + WS_MG), (const bf16*)(wsw + WS_WOUT), M, D, D}; pg8::StaticOrder S; S.init(M, D, C.G, C.bid);
        pg8::EpiResid E{xsrc, out};
        pg8::gemm_phase<pg8::EpiResid, pg8::StaticOrder, true, true>(ring, g, S, E); }
    if constexpr (K == 9) { const float* g2 = args.in[20] + (size_t)l * D; bf16* H = (bf16*)(ws + WS_H);
        for (int m = 2 * C.gw; m < M; m += 2 * C.ngw) rms_row2_bf16(out + (size_t)m * D, g2, H + (size_t)m * D, C.lane); }
    if constexpr (K == 10) { pg8::Gemm g{(const bf16*)(ws + WS_H) - 2 * D, (const bf16*)(wsw + WS_WUP), 65 * 256, NUP, D}; pg8::StaticOrder S; S.init(65 * 256, NUP, C.G, C.bid);
        pg8::EpiConv E{(bf16*)(ws + WS_ACT), args.in[22] + (size_t)l * 3 * DFF, (PG8_LAS float*)(C.lds + 131072)};
        pg8::gemm_phase<pg8::EpiConv, pg8::StaticOrder, true, true>(ring, g, S, E); }
    if constexpr (K == 12) { pg8::Gemm g{(const bf16*)(ws + WS_ACT), (const bf16*)(wsw + WS_WDOWN), M, D, DFF}; pg8::StaticOrder S; S.init(M, D, C.G, C.bid);
        pg8::EpiResid E{out, out};
        pg8::gemm_phase<pg8::EpiResid, pg8::StaticOrder, true, true>(ring, g, S, E); }
    if constexpr (K == 13) { const float* gf = args.in[24];
        for (int m = C.gw; m < M; m += C.ngw) rms_row_f32(out + (size_t)m * D, gf, C.lane); }
}
template <int K> __global__ void __launch_bounds__(NTHREADS, 2) fwd_phase(Args args) {
    extern __shared__ __attribute__((aligned(16))) unsigned char lds[];
    run_phase<K>(lds, args, args.li);
}
#ifndef EXP_BAR_REPS
#define EXP_BAR_REPS 1
#endif
#define XBAR(b) do { for (int r_ = 0; r_ < EXP_BAR_REPS; ++r_) xcd_barrier(b); } while (0)
__global__ void __launch_bounds__(NTHREADS, 2) fwd_all(Args args) {
    extern __shared__ __attribute__((aligned(16))) unsigned char lds[];
    { LAS unsigned* ctlw = (LAS unsigned*)((LAS unsigned char*)lds + LDSCTL_OFF); for (int u = threadIdx.x; u < (LDS_BYTES - LDSCTL_OFF) / 4; u += NTHREADS) ctlw[u] = 0u; }
    __syncthreads();
    const XcdBarrier bar = xcd_barrier_post((unsigned*)(args.ws + WS_CTL) + CW_BAR, (volatile LAS unsigned*)((LAS unsigned char*)lds + MISC_OFF) + 8);
    for (int l = 0; l < DEPTH; ++l) {
        for (int rep = 0; rep < (((EXP_EW_MASK >> 0) & 1) ? 2 : 1); ++rep) { run_phase<0>(lds, args, l); XBAR(bar); }
        for (int rep = 0; rep < EXP_G1_REPS; ++rep) { run_phase<1>(lds, args, l); XBAR(bar); }
        for (int rep = 0; rep < (((EXP_EW_MASK >> 2) & 1) ? 2 : 1); ++rep) { run_phase<2>(lds, args, l); XBAR(bar); }
        for (int rep = 0; rep < EXP_G3_REPS; ++rep) { run_phase<3>(lds, args, l); XBAR(bar); }
        for (int rep = 0; rep < (((EXP_EW_MASK >> 4) & 1) ? 2 : 1); ++rep) { run_phase<4>(lds, args, l); XBAR(bar); }
        run_phase<5>(lds, args, l); XBAR(bar);
        for (int rep = 0; rep < (((EXP_EW_MASK >> 6) & 1) ? 2 : 1); ++rep) { run_phase<6>(lds, args, l); XBAR(bar); }
        for (int rep = 0; rep < EXP_G7_REPS; ++rep) { run_phase<7>(lds, args, l); XBAR(bar); }
        run_phase<8>(lds, args, l); XBAR(bar);
        for (int rep = 0; rep < (((EXP_EW_MASK >> 9) & 1) ? 2 : 1); ++rep) { run_phase<9>(lds, args, l); XBAR(bar); }
        for (int rep = 0; rep < EXP_G10_REPS; ++rep) { run_phase<10>(lds, args, l); XBAR(bar); }
        run_phase<12>(lds, args, l); XBAR(bar);
    }
    run_phase<13>(lds, args, 0);
}

#ifndef MK_ONE_LAUNCH
#define MK_ONE_LAUNCH 1
#endif
template <int K> static void launch_phase(int grid, hipStream_t stream, Args a, int l) {
    static bool attr = false; if (!attr) { (void)hipFuncSetAttribute((const void*)fwd_phase<K>, hipFuncAttributeMaxDynamicSharedMemorySize, LDS_BYTES); attr = true; }
    a.li = l; a.ph_lo = K; a.ph_hi = K + 1;
    hipLaunchKernelGGL(fwd_phase<K>, dim3(grid), dim3(NTHREADS), LDS_BYTES, stream, a);
}
extern "C" void kernel_launch(void* const* d_in, const int* in_sizes, int n_in, void* d_out, int out_size, void* d_ws, size_t ws_size, hipStream_t stream) {
    static int grid = 0;
    if (grid == 0) {
        if (n_in != 25 || in_sizes[0] != M * D || out_size != M * D || ws_size < WS_END) { fprintf(stderr, "kernel_launch: unexpected shapes (n_in %d, in0 %d, out %d, ws %zu < %zu)\n", n_in, n_in > 0 ? in_sizes[0] : -1, out_size, ws_size, (size_t)WS_END); grid = -1; return; }
        int dev = 0, cus = 0;
        if (hipGetDevice(&dev) != hipSuccess || hipDeviceGetAttribute(&cus, hipDeviceAttributeMultiprocessorCount, dev) != hipSuccess) { grid = -1; return; }
        grid = cus;
    }
    if (grid < 0) return;
    (void)hipMemsetAsync((char*)d_ws + WS_CTL, 0, CTL_ZERO_BYTES, stream);
    Args a{};
    for (int i = 0; i < 25; ++i) a.in[i] = (const float*)d_in[i];
    a.out = (float*)d_out; a.ws = (unsigned char*)d_ws; a.pad = 0;
#if MK_ONE_LAUNCH
    { static bool attr = false; if (!attr) { (void)hipFuncSetAttribute((const void*)fwd_all, hipFuncAttributeMaxDynamicSharedMemorySize, LDS_BYTES); attr = true; }
      a.li = 0; a.ph_lo = 0; a.ph_hi = NPHASES;
      hipLaunchKernelGGL(fwd_all, dim3(grid), dim3(NTHREADS), LDS_BYTES, stream, a); }
#else
    for (int l = 0; l < DEPTH; ++l) {
        launch_phase<0>(grid, stream, a, l); launch_phase<1>(grid, stream, a, l); launch_phase<2>(grid, stream, a, l); launch_phase<3>(grid, stream, a, l);
        launch_phase<4>(grid, stream, a, l); launch_phase<5>(grid, stream, a, l); launch_phase<6>(grid, stream, a, l); launch_phase<7>(grid, stream, a, l);
        launch_phase<8>(grid, stream, a, l); launch_phase<9>(grid, stream, a, l); launch_phase<10>(grid, stream, a, l); launch_phase<11>(grid, stream, a, l);
        launch_phase<12>(grid, stream, a, l);
    }
    launch_phase<13>(grid, stream, a, 0);
#endif
}
```

```cpp
#include <hip/hip_runtime.h>
#include <cstdio>
#include <cstdint>
#include <cmath>
#define GAS __attribute__((address_space(1)))
#define LAS __attribute__((address_space(3)))
namespace pg8 {
#define PG8_LAS __attribute__((address_space(3)))
typedef unsigned short bf16_t;
typedef short bf16x8 __attribute__((ext_vector_type(8)));
typedef float f32x4 __attribute__((ext_vector_type(4)));
typedef unsigned u32x4 __attribute__((ext_vector_type(4)));
constexpr int BM = 256, BK = 64, HALF = 128, HTB = HALF * BK * 2  , STAGE_BYTES = 8 * HTB, NXCD = 8, WGM = 8;

__host__ __device__ __forceinline__ int lds_byte(int r, int c) { const int st = (r >> 4) * 2 + (c >> 5), rr = r & 15, cc = c & 31, ob = rr * 64 + cc * 2; return st * 1024 + (ob ^ (((ob >> 9) & 1) << 5)); }
__host__ __device__ __forceinline__ void stage_rc(int b, int& R, int& C) { const int st = b / 1024, sb = b % 1024, swz = sb ^ (((sb >> 9) & 1) << 5); R = (st >> 1) * 16 + swz / 64; C = (st & 1) * 32 + (swz % 64) / 2; }
__host__ __device__ __forceinline__ int perm32(int rho) { const int n = rho >> 4, i = rho & 15; return 8 * (i >> 2) + 4 * n + (i & 3); }

struct Unit { int pm, pn; };
struct Gemm { const bf16_t* A; const bf16_t* Bt; int M, N, K; };

struct StaticOrder {
    int nM, nN, nwg, G, c;
    __host__ __device__ void init(int M, int N, int G_, int c_) { nM = M / BM; nN = N / BM; nwg = nM * nN; G = G_; c = c_; }
    __host__ __device__ bool next(int i, Unit& u) const {
        const long L = (long)i * G + c; if (L >= nwg) return false;
        int wgid = (int)L; { const int q = nwg / NXCD, r = nwg % NXCD, xcd = wgid % NXCD, off = wgid / NXCD; wgid = (xcd < r ? xcd * (q + 1) : r * (q + 1) + (xcd - r) * q) + off; }
        const int nig = WGM * nN, gid = wgid / nig, fm = gid * WGM, gsz = (nM - fm) < WGM ? (nM - fm) : WGM;
        u.pm = fm + ((wgid % nig) % gsz); u.pn = (wgid % nig) / gsz; return true;
    }
    __device__ __forceinline__ void a_ready(const Unit&) const {}
    __device__ __forceinline__ void done(const Unit&) const {}
};
__device__ __forceinline__ unsigned cvt_pk_bf16(float lo, float hi) { unsigned r; asm volatile("v_cvt_pk_bf16_f32 %0, %1, %2" : "=v"(r) : "v"(lo), "v"(hi)); return r; }
template <class Epi, class Sched, bool ALIGN_EPI = false, bool SP2 = false>
__device__ __forceinline__ void gemm_phase(PG8_LAS unsigned char* lds, const Gemm g, const Sched& S, const Epi& E) {
    int tid_ = threadIdx.x; asm volatile("" : "+v"(tid_));
    const int tid = tid_, wid = __builtin_amdgcn_readfirstlane(tid >> 6), lane = tid & 63, wr = wid >> 2, wc = wid & 3, fr = lane & 15, fq = lane >> 4;
    const int K = g.K, nt = K / BK;
    unsigned voffA[2], voffB[2];
#pragma unroll
    for (int i = 0; i < 2; ++i) { int R, C; stage_rc(tid * 16 + i * 8192, R, C); const int Rb = Epi::PERM ? ((R & ~31) + perm32(R & 31)) : R;
        voffA[i] = (unsigned)(R * K + C) * 2u; voffB[i] = (unsigned)(Rb * K + C) * 2u; }
    const size_t kstep = (size_t)(BK * 2);
    const size_t hstep = (size_t)HALF * K * 2;
    const size_t tstep = 2 * hstep;
    const size_t tstepA = (size_t)Epi::A_ROWS * K * 2;
    const unsigned ldsw = (unsigned)wid * 1024u;
    const int aoff = lds_byte(wr * 64 + fr, fq * 8), boff = lds_byte(wc * 32 + fr, fq * 8);
#define PG8_SA(b, h) (((b) * 2 + (h)) * HTB)
#define PG8_SB(b, h) ((4 + (b) * 2 + (h)) * HTB)
#define PG8_STAGE(bufoff, gbase, voff) do { _Pragma("unroll") for (int _i = 0; _i < 2; ++_i) \
        __builtin_amdgcn_global_load_lds((const unsigned*)((const char*)(gbase) + (voff)[_i]), (PG8_LAS unsigned*)(lds + (bufoff) + ldsw + _i * 8192), 16, 0, 0); } while (0)
#define PG8_LDA(dst, b, h) do { _Pragma("unroll") for (int m = 0; m < 4; ++m) _Pragma("unroll") for (int k = 0; k < 2; ++k) dst[m][k] = *(const PG8_LAS bf16x8*)(lds + PG8_SA(b, h) + aoff + m * 2048 + k * 1024); } while (0)
#define PG8_LDB(dst, b, h) do { _Pragma("unroll") for (int n = 0; n < 2; ++n) _Pragma("unroll") for (int k = 0; k < 2; ++k) dst[n][k] = *(const PG8_LAS bf16x8*)(lds + PG8_SB(b, h) + boff + n * 2048 + k * 1024); } while (0)
#define PG8_MMA(ai, bj, At, Bt) do { __builtin_amdgcn_s_setprio(1); _Pragma("unroll") for (int m = 0; m < 4; ++m) _Pragma("unroll") for (int n = 0; n < 2; ++n) _Pragma("unroll") for (int k = 0; k < 2; ++k) \
        acc[ai][bj][m][n] = __builtin_amdgcn_mfma_f32_16x16x32_bf16(Bt[n][k], At[m][k], acc[ai][bj][m][n], 0, 0, 0); __builtin_amdgcn_s_setprio(0); } while (0)
#define PG8_WAIT_V(n) asm volatile("s_waitcnt vmcnt(" #n ")" ::: "memory")
#define PG8_WAIT_L(n) asm volatile("s_waitcnt lgkmcnt(" #n ")" ::: "memory")
#define PG8_BAR __builtin_amdgcn_s_barrier()
#define PG8_SCHED __builtin_amdgcn_sched_barrier(0)
    Unit cur, nxt; int ui = 0;
    if (!S.next(0, cur)) return;
    f32x4 acc[2][2][4][2];
#pragma unroll
    for (int a = 0; a < 2; ++a)
#pragma unroll
        for (int b = 0; b < 2; ++b)
#pragma unroll
            for (int m = 0; m < 4; ++m)
#pragma unroll
                for (int n = 0; n < 2; ++n) acc[a][b][m][n] = (f32x4){0.f, 0.f, 0.f, 0.f};
    bf16x8 At[4][2], B0[2][2], B1[2][2];
    const char* cA = (const char*)g.A + (size_t)cur.pm * tstepA; const char* cB = (const char*)g.Bt + (size_t)cur.pn * tstep;
    S.a_ready(cur);
    if constexpr (SP2) {
        PG8_STAGE(PG8_SB(0, 0), cB, voffB); PG8_STAGE(PG8_SB(0, 1), cB + hstep, voffB); PG8_STAGE(PG8_SA(0, 0), cA, voffA); PG8_STAGE(PG8_SA(0, 1), cA + hstep, voffA);
        if (wr == 1) PG8_BAR;
        PG8_WAIT_V(2); PG8_BAR;
        PG8_STAGE(PG8_SB(1, 0), cB + kstep, voffB); PG8_STAGE(PG8_SA(1, 0), cA + kstep, voffA); PG8_STAGE(PG8_SB(1, 1), cB + hstep + kstep, voffB);
        PG8_WAIT_V(6); PG8_BAR;
    } else {
        PG8_STAGE(PG8_SB(0, 0), cB, voffB); PG8_STAGE(PG8_SA(0, 0), cA, voffA); PG8_STAGE(PG8_SB(0, 1), cB + hstep, voffB); PG8_STAGE(PG8_SA(0, 1), cA + hstep, voffA);
        if (wr == 1) PG8_BAR;
        PG8_WAIT_V(4); PG8_BAR;
        PG8_STAGE(PG8_SB(1, 0), cB + kstep, voffB); PG8_STAGE(PG8_SA(1, 0), cA + kstep, voffA); PG8_STAGE(PG8_SB(1, 1), cB + hstep + kstep, voffB);
        PG8_WAIT_V(6); PG8_BAR;
    }
    for (;;) {
        const bool has_next = S.next(ui + 1, nxt);
        const char* nA = has_next ? (const char*)g.A + (size_t)nxt.pm * tstepA : cA; const char* nB = has_next ? (const char*)g.Bt + (size_t)nxt.pn * tstep : cB;
        for (int t = 0; t < nt; t += 2) {
            const bool last = (t == nt - 2);
            const char* a1 = cA + (size_t)(t + 1) * kstep;
            const char* a2 = last ? nA : cA + (size_t)(t + 2) * kstep; const char* b2 = last ? nB : cB + (size_t)(t + 2) * kstep;
            const char* a3 = a2 + kstep; const char* b3 = b2 + kstep;
            if (last && has_next) S.a_ready(nxt);
            if constexpr (Epi::HAS_SEG) { if (t == E.t1 || t == E.t2) E.seg(acc, cur, t, wr, wc, fr, fq); }
            if constexpr (SP2) {
            PG8_LDB(B0, 0, 0); PG8_LDB(B1, 0, 1); PG8_SCHED; PG8_LDA(At, 0, 0); PG8_STAGE(PG8_SA(1, 1), a1 + hstep, voffA);
            PG8_WAIT_V(8); PG8_WAIT_L(0); PG8_BAR; PG8_MMA(0, 0, At, B0); PG8_MMA(0, 1, At, B1); PG8_BAR; PG8_SCHED;
            PG8_LDA(At, 0, 1); PG8_STAGE(PG8_SB(0, 0), b2, voffB); PG8_STAGE(PG8_SB(0, 1), b2 + hstep, voffB); PG8_STAGE(PG8_SA(0, 0), a2, voffA);
            PG8_WAIT_V(8); PG8_WAIT_L(0); PG8_BAR; PG8_MMA(1, 0, At, B0); PG8_MMA(1, 1, At, B1); PG8_BAR; PG8_SCHED;
            PG8_LDB(B0, 1, 0); PG8_LDB(B1, 1, 1); PG8_SCHED; PG8_LDA(At, 1, 0); PG8_STAGE(PG8_SA(0, 1), a2 + hstep, voffA);
            PG8_WAIT_V(8); PG8_WAIT_L(0); PG8_BAR; PG8_MMA(0, 0, At, B0); PG8_MMA(0, 1, At, B1); PG8_BAR; PG8_SCHED;
            PG8_LDA(At, 1, 1); PG8_STAGE(PG8_SB(1, 0), b3, voffB); PG8_STAGE(PG8_SB(1, 1), b3 + hstep, voffB); PG8_STAGE(PG8_SA(1, 0), a3, voffA);
            PG8_WAIT_V(8); PG8_WAIT_L(0); PG8_BAR; PG8_MMA(1, 0, At, B0); PG8_MMA(1, 1, At, B1); PG8_BAR; PG8_SCHED;
            } else {
            PG8_LDB(B0, 0, 0); PG8_SCHED; PG8_LDA(At, 0, 0); PG8_STAGE(PG8_SA(1, 1), a1 + hstep, voffA);
            PG8_WAIT_L(8); PG8_BAR; PG8_WAIT_L(0); PG8_MMA(0, 0, At, B0); PG8_BAR; PG8_SCHED;
            PG8_LDB(B1, 0, 1); PG8_STAGE(PG8_SB(0, 0), b2, voffB);
            PG8_BAR; PG8_WAIT_L(0); PG8_MMA(0, 1, At, B1); PG8_BAR;
            PG8_LDA(At, 0, 1); PG8_STAGE(PG8_SA(0, 0), a2, voffA);
            PG8_BAR; PG8_WAIT_L(0); PG8_MMA(1, 0, At, B0); PG8_BAR; PG8_SCHED;
            PG8_STAGE(PG8_SB(0, 1), b2 + hstep, voffB);
            PG8_WAIT_V(6); PG8_BAR; PG8_MMA(1, 1, At, B1); PG8_BAR;
            PG8_LDB(B0, 1, 0); PG8_SCHED; PG8_LDA(At, 1, 0); PG8_STAGE(PG8_SA(0, 1), a2 + hstep, voffA);
            PG8_WAIT_L(8); PG8_BAR; PG8_WAIT_L(0); PG8_MMA(0, 0, At, B0); PG8_BAR; PG8_SCHED;
            PG8_LDB(B1, 1, 1); PG8_STAGE(PG8_SB(1, 0), b3, voffB);
            PG8_BAR; PG8_WAIT_L(0); PG8_MMA(0, 1, At, B1); PG8_BAR;
            PG8_LDA(At, 1, 1); PG8_STAGE(PG8_SA(1, 0), a3, voffA);
            PG8_BAR; PG8_WAIT_L(0); PG8_MMA(1, 0, At, B0); PG8_BAR; PG8_SCHED;
            PG8_STAGE(PG8_SB(1, 1), b3 + hstep, voffB);
            PG8_WAIT_V(6); PG8_BAR; PG8_MMA(1, 1, At, B1); PG8_BAR;
            }
        }
        if constexpr (ALIGN_EPI) { if (wr == 0) PG8_BAR; }
        if constexpr (!Epi::AFTER_DRAIN) { E(acc, cur, wr, wc, fr, fq); S.done(cur); }
        if (!has_next) break;
#pragma unroll
        for (int a = 0; a < 2; ++a)
#pragma unroll
            for (int b = 0; b < 2; ++b)
#pragma unroll
                for (int m = 0; m < 4; ++m)
#pragma unroll
                    for (int n = 0; n < 2; ++n) acc[a][b][m][n] = (f32x4){0.f, 0.f, 0.f, 0.f};
        cur = nxt; cA = nA; cB = nB; ++ui;
        if constexpr (ALIGN_EPI) { if (wr == 1) PG8_BAR; }
    }
    PG8_WAIT_V(0);
    if constexpr (!ALIGN_EPI) { if (wr == 0) PG8_BAR; }
    PG8_BAR;
    if constexpr (Epi::AFTER_DRAIN) { E.fused(acc, cur, wr, wc, fr, fq, lds, wid, lane); S.done(cur); }
#undef PG8_SA
#undef PG8_SB
#undef PG8_STAGE
#undef PG8_LDA
#undef PG8_LDB
#undef PG8_MMA
#undef PG8_WAIT_V
#undef PG8_WAIT_L
#undef PG8_BAR
#undef PG8_SCHED
}
}
#define XB_TMO      128
#define XB_XCNT(j)  (256  + 64 * (j))
#define XB_XSUB(j)  (1280 + 64 * (j))
#define XB_XGEN(j)  (2304 + 64 * (j))
#define XB_TOP      3328
#define XB_TOPGEN   3392
#define XCD_BAR_WORDS 3456
#define XB_SPIN_CAP (1u << 18)

__device__ __forceinline__ unsigned xb_ld(unsigned* p)              { return __hip_atomic_load(p, __ATOMIC_RELAXED, __HIP_MEMORY_SCOPE_AGENT); }
__device__ __forceinline__ unsigned xb_add(unsigned* p, unsigned v) { return __hip_atomic_fetch_add(p, v, __ATOMIC_RELAXED, __HIP_MEMORY_SCOPE_AGENT); }
__device__ __forceinline__ unsigned xb_xcc_id() { return (unsigned)__builtin_amdgcn_s_getreg((3 << 11) | 20) & 0xFu; }
#define XB_SPIN(cond, bar) do { unsigned _sp = 0; while (cond) { __builtin_amdgcn_s_sleep(1); \
    if ((++_sp & 255u) == 0u) { if (xb_ld(&(bar)[XB_TMO])) break; if (_sp > XB_SPIN_CAP) { atomicAdd(&(bar)[XB_TMO], 1u); break; } } } } while (0)

struct XcdBarrier {
    unsigned* bar; unsigned x;
    volatile LAS unsigned* st;
};

__device__ __forceinline__ XcdBarrier xcd_barrier_post(unsigned* bar, volatile LAS unsigned* st) {
    XcdBarrier b; b.bar = bar; b.x = xb_xcc_id(); b.st = st;
    if (threadIdx.x == 0) (void)xb_add(&bar[XB_XCNT(b.x)], 1u);
    return b;
}
__device__ __forceinline__ void xcd_barrier_complete(unsigned* bar, unsigned x, unsigned& nloc, unsigned& nx) {
    const unsigned G = gridDim.x * gridDim.y * gridDim.z;
    unsigned sum, cnt, mine, sp = 0u;
    for (;;) {
        sum = 0u; cnt = 0u; mine = 0u;
#pragma unroll
        for (unsigned j = 0; j < 16; ++j) { const unsigned c = xb_ld(&bar[XB_XCNT(j)]); sum += c; cnt += (c > 0u) ? 1u : 0u; mine = (j == x) ? c : mine; }
        if (sum == G) break;
        __builtin_amdgcn_s_sleep(1);
        if ((++sp & 255u) == 0u) { if (xb_ld(&bar[XB_TMO])) break; if (sp > XB_SPIN_CAP) { atomicAdd(&bar[XB_TMO], 1u); break; } }
    }
    nloc = mine > 0u ? mine : 1u; nx = cnt > 0u ? cnt : 1u;
}

__device__ __forceinline__ void xcd_barrier(const XcdBarrier& b) {
    asm volatile("s_waitcnt vmcnt(0)" ::: "memory");
    __syncthreads();
    if (threadIdx.x == 0) {
        unsigned* bar = b.bar;
        __builtin_amdgcn_s_waitcnt(0);
        unsigned nloc = b.st[0], nx = b.st[1];
        if (nloc == 0u) { xcd_barrier_complete(bar, b.x, nloc, nx); b.st[0] = nloc; b.st[1] = nx; }
        const unsigned old = xb_add(&bar[XB_XSUB(b.x)], 1u);
        const unsigned gen = old / nloc;
        if (old + 1u == (gen + 1u) * nloc) {
            __builtin_amdgcn_fence(__ATOMIC_RELEASE, "agent");
            asm volatile("s_waitcnt vmcnt(0)" ::: "memory");
            const unsigned og = xb_add(&bar[XB_TOP], 1u);
            const unsigned tg = og / nx;
            if (og + 1u == (tg + 1u) * nx) xb_add(&bar[XB_TOPGEN], 1u);
            else XB_SPIN(xb_ld(&bar[XB_TOPGEN]) == tg, bar);
            __builtin_amdgcn_fence(__ATOMIC_ACQUIRE, "agent");
            xb_add(&bar[XB_XGEN(b.x)], 1u);
            asm volatile("s_waitcnt vmcnt(0)" ::: "memory");
        } else {
            XB_SPIN(xb_ld(&bar[XB_XGEN(b.x)]) == gen, bar);
            __builtin_amdgcn_fence(__ATOMIC_ACQUIRE, "agent");
            asm volatile("s_waitcnt vmcnt(0)" ::: "memory");
        }
    }
    __syncthreads();
}

constexpr int BATCH = 2, SEQ = 8192, M = BATCH * SEQ, D = 2048, DEPTH = 4;
constexpr int DIN = 11968, NP1 = 5888, NG = 6144, NWIN = NP1 + NG;
constexpr int BW = 768, BCOLS = 2752;
constexpr int C_AQ = 0, C_AK = 512, C_AV = 640, C_R = 768, C_K = 1536, C_V = 2304, C_WD = 3072, C_CQ = 3520, C_CK = 4288, C_CV = 5056, C_END = 5824;
constexpr int DFF = 5504, NUP = 2 * DFF;
constexpr int NLORA = 2304, KLORA = 512;
constexpr float NORM_EPS = 1e-5f, GN_EPS = 64e-5f;
constexpr int NWAVES = 8, NTHREADS = 512;
constexpr int NPH = 13;
constexpr int NPHASES = DEPTH * NPH + 1;
#ifndef EXP_EW_MASK
#define EXP_EW_MASK 0
#endif
#ifndef EXP_EW_REPS
#define EXP_EW_REPS 1
#endif
#ifndef EXP_G10_REPS
#define EXP_G10_REPS 1
#endif
#ifndef EXP_GATE_REPS
#define EXP_GATE_REPS 1
#endif
#ifndef EXP_G7_REPS
#define EXP_G7_REPS 1
#endif
#ifndef EXP_G3_REPS
#define EXP_G3_REPS 1
#endif
#ifndef EXP_G1_REPS
#define EXP_G1_REPS 1
#endif
#ifndef EXP_SCAN_REPS
#define EXP_SCAN_REPS 1
#endif
#ifndef EXP_ATTN_REPS
#define EXP_ATTN_REPS 1
#endif
constexpr int NSCAN = 48;

constexpr size_t MiB = 1u << 20;
constexpr size_t WS_CTL = 0, CTL_ZERO_BYTES = 1 * MiB;
constexpr size_t WS_WIN = 1 * MiB;
constexpr size_t WS_WLORA = 48 * MiB;
constexpr size_t WS_PA = 51 * MiB;
constexpr size_t WS_PB = 53 * MiB;
constexpr size_t WS_PC = 56 * MiB;
constexpr size_t WS_WOUT = 57 * MiB;
constexpr size_t WS_WUP = 65 * MiB;
constexpr size_t WS_WDOWN = 108 * MiB;
constexpr size_t WS_H = 130 * MiB;
constexpr size_t WS_P1 = 194 * MiB;
constexpr size_t WS_G = 378 * MiB;
constexpr size_t WS_U = WS_P1;
constexpr size_t WS_AP = 570 * MiB;
constexpr size_t WS_LO = 586 * MiB;
constexpr size_t WS_ACT = WS_LO;
constexpr size_t WS_SR = 730 * MiB;
constexpr size_t WS_SW = 778 * MiB, WS_SK = 826 * MiB, WS_SKK = 874 * MiB, WS_SB = 922 * MiB, WS_SV = 970 * MiB;
constexpr size_t WS_YRAW = 1018 * MiB;
constexpr size_t WS_YA = 1066 * MiB;
constexpr size_t WS_YB = 1082 * MiB;
constexpr size_t WS_YC = 1106 * MiB;
constexpr size_t WS_OC = 1114 * MiB;
constexpr size_t WS_LSE = 1138 * MiB;
constexpr size_t WS_MG = 1139 * MiB;
constexpr size_t WS_BK = 1203 * MiB;
constexpr size_t WS_VT = 1205 * MiB;
constexpr size_t WS_W2 = 1235 * MiB;
constexpr size_t WSET_STRIDE = WS_W2 - WS_WIN;
constexpr size_t WS_BON = 1365 * MiB;
constexpr size_t WS_END = 1366 * MiB;
constexpr size_t WS_SST_A = 1366 * MiB, WS_SST_B = WS_MG;
constexpr size_t WS_END2 = 1494 * MiB;
constexpr size_t WS_COP = WS_SR;
constexpr int COP_W1 = 0, COP_U0 = 1024, COP_BK = 1536, COP_GAM = 3584, COP_RY = 3648, COP_Y0 = 4672, COP_STRIDE = 4928;
constexpr int CW_BAR = 4096;

constexpr int RING_OFF = 0, RING_BYTES = 131072;
constexpr int LDSCTL_OFF = 141312, MISC_OFF = LDSCTL_OFF + 320;
constexpr int LDS_BYTES = 147456;
constexpr int LUT_OFF = 0, SCANRING_OFF = 12288, CONV_SCR_SCAN = 77824, CONV_SCR_OTHER = 12288;

typedef unsigned short bf16;
typedef unsigned v4u __attribute__((ext_vector_type(4)));
typedef unsigned v2u __attribute__((ext_vector_type(2)));
typedef float f32x4 __attribute__((ext_vector_type(4)));
#define LDS_WAIT() asm volatile("s_waitcnt lgkmcnt(0)" ::: "memory")

__device__ __forceinline__ unsigned f2bf(float f) { unsigned u = __builtin_bit_cast(unsigned, f); return (u + 0x7fffu + ((u >> 16) & 1u)) >> 16; }
__device__ __forceinline__ unsigned pk2(float lo, float hi) { return f2bf(lo) | (f2bf(hi) << 16); }
__device__ __forceinline__ float bflo(unsigned w) { return __builtin_bit_cast(float, w << 16); }
__device__ __forceinline__ float bfhi(unsigned w) { return __builtin_bit_cast(float, w & 0xffff0000u); }
__device__ __forceinline__ float bf1(bf16 h) { return __builtin_bit_cast(float, ((unsigned)h) << 16); }
__device__ __forceinline__ float sigmoidf_(float x) { return 1.0f / (1.0f + __expf(-x)); }
__device__ __forceinline__ float wave_sum(float v) {
#pragma unroll
    for (int o = 1; o < 64; o <<= 1) v += __shfl_xor(v, o);
    return v;
}
template <int CTRL> __device__ __forceinline__ float dppf(float x) { return __builtin_bit_cast(float, __builtin_amdgcn_update_dpp(0, __builtin_bit_cast(int, x), CTRL, 0xF, 0xF, true)); }
__device__ __forceinline__ float red4(float x) { x += dppf<0xB1>(x); x += dppf<0x4E>(x); return x; }
__device__ __forceinline__ float red16(float x) { x = red4(x); x += dppf<0x141>(x); x += dppf<0x140>(x); return x; }
__device__ __forceinline__ float wsum(float x) { x = red16(x); x += __shfl_xor(x, 16); x += __shfl_xor(x, 32); return x; }

__device__ const unsigned char T5B[3][132] = {
 {0,1,2,3,4,5,6,7,8,9,10,11,12,13,14,15,16,16,16,16,16,16,17,17,17,17,17,17,17,17,18,18,18,18,18,18,18,18,18,18,19,19,19,19,19,19,19,19,19,19,19,19,19,19,20,20,20,20,20,20,20,20,20,20,20,20,20,20,20,20,20,20,20,21,21,21,21,21,21,21,21,21,21,21,21,21,21,21,21,21,21,21,21,21,21,21,21,21,21,22,22,22,22,22,22,22,22,22,22,22,22,22,22,22,22,22,22,22,22,22,22,22,22,22,22,22,22,22,22,0,0,0},
 {0,4,8,12,16,16,17,17,18,18,19,19,19,19,20,20,20,20,20,21,21,21,21,21,21,22,22,22,22,22,22,22,22,22,23,23,23,23,23,23,23,23,23,23,23,23,24,24,24,24,24,24,24,24,24,24,24,24,24,24,24,24,25,25,25,25,25,25,25,25,25,25,25,25,25,25,25,25,25,25,25,25,25,26,26,26,26,26,26,26,26,26,26,26,26,26,26,26,26,26,26,26,26,26,26,26,26,26,26,26,26,26,26,27,27,27,27,27,27,27,27,27,27,27,27,27,27,27,27,0,0,0},
 {0,16,18,19,20,21,21,22,22,23,23,23,24,24,24,24,25,25,25,25,25,26,26,26,26,26,26,26,26,27,27,27,27,27,27,27,27,27,27,28,28,28,28,28,28,28,28,28,28,28,28,28,29,29,29,29,29,29,29,29,29,29,29,29,29,29,29,29,29,29,30,30,30,30,30,30,30,30,30,30,30,30,30,30,30,30,30,30,30,30,30,30,30,30,30,31,31,31,31,31,31,31,31,31,31,31,31,31,31,31,31,31,31,31,31,31,31,31,31,31,31,31,31,31,31,31,31,31,31,0,0,0}};

namespace pg8 {
struct EpiWin {
    static constexpr bool PERM = true, AFTER_DRAIN = false; static constexpr int A_ROWS = 256; static constexpr bool HAS_SEG = false;
    bf16_t* P1; bf16_t* G; int pn0;
    __device__ __forceinline__ void operator()(const f32x4 (&acc)[2][2][4][2], const Unit& u, int wr, int wc, int fr, int fq) const {
        const int pn = u.pn + pn0; const int row0 = u.pm * BM + wr * 64 + fr; const bool gate = pn >= 23;
        bf16_t* base = gate ? G : P1; const int ldc = gate ? 6144 : 5888; const int col0 = (gate ? (pn - 23) : pn) * BM + wc * 32 + 8 * fq;
#pragma unroll
        for (int ai = 0; ai < 2; ++ai)
#pragma unroll
            for (int m = 0; m < 4; ++m) { bf16_t* rowp = base + (size_t)(row0 + ai * HALF + m * 16) * ldc + col0;
#pragma unroll
                for (int bj = 0; bj < 2; ++bj) { f32x4 v0 = acc[ai][bj][m][0], v1 = acc[ai][bj][m][1];
                    if (gate) {
#pragma unroll
                        for (int j = 0; j < 4; ++j) { v0[j] = __builtin_amdgcn_rcpf(1.0f + __expf(-v0[j])); v1[j] = __builtin_amdgcn_rcpf(1.0f + __expf(-v1[j])); } }
                    u32x4 w; w.x = cvt_pk_bf16(v0[0], v0[1]); w.y = cvt_pk_bf16(v0[2], v0[3]); w.z = cvt_pk_bf16(v1[0], v1[1]); w.w = cvt_pk_bf16(v1[2], v1[3]);
                    *(u32x4*)(rowp + bj * HALF) = w; } }
    }
};
struct EpiBf16P {
    static constexpr bool PERM = true, AFTER_DRAIN = false; static constexpr int A_ROWS = 256; static constexpr bool HAS_SEG = false;
    bf16_t* O; int ldc;
    __device__ __forceinline__ void operator()(const f32x4 (&acc)[2][2][4][2], const Unit& u, int wr, int wc, int fr, int fq) const {
        const int row0 = u.pm * BM + wr * 64 + fr; const int col0 = u.pn * BM + wc * 32 + 8 * fq;
#pragma unroll
        for (int ai = 0; ai < 2; ++ai)
#pragma unroll
            for (int m = 0; m < 4; ++m) { bf16_t* rowp = O + (size_t)(row0 + ai * HALF + m * 16) * ldc + col0;
#pragma unroll
                for (int bj = 0; bj < 2; ++bj) { const f32x4 v0 = acc[ai][bj][m][0], v1 = acc[ai][bj][m][1];
                    u32x4 w; w.x = cvt_pk_bf16(v0[0], v0[1]); w.y = cvt_pk_bf16(v0[2], v0[3]); w.z = cvt_pk_bf16(v1[0], v1[1]); w.w = cvt_pk_bf16(v1[2], v1[3]);
                    *(u32x4*)(rowp + bj * HALF) = w; } }
    }
};
struct EpiF32P {
    static constexpr bool PERM = false, AFTER_DRAIN = false; static constexpr int A_ROWS = 256; static constexpr bool HAS_SEG = false;
    float* C; int ldc;
    __device__ __forceinline__ void operator()(const f32x4 (&acc)[2][2][4][2], const Unit& u, int wr, int wc, int fr, int fq) const {
        const int row0 = u.pm * BM + wr * 64 + fr, col0 = u.pn * BM + wc * 32 + 4 * fq;
#pragma unroll
        for (int ai = 0; ai < 2; ++ai)
#pragma unroll
            for (int m = 0; m < 4; ++m) { float* rowp = C + (size_t)(row0 + ai * HALF + m * 16) * ldc + col0;
#pragma unroll
                for (int bj = 0; bj < 2; ++bj)
#pragma unroll
                    for (int n = 0; n < 2; ++n) *(f32x4*)(rowp + bj * HALF + n * 16) = acc[ai][bj][m][n]; }
    }
};
struct EpiResid {
    static constexpr bool PERM = false, AFTER_DRAIN = false; static constexpr int A_ROWS = 256; static constexpr bool HAS_SEG = false;
    const float* xin; float* out;
    __device__ __forceinline__ void operator()(const f32x4 (&acc)[2][2][4][2], const Unit& u, int wr, int wc, int fr, int fq) const {
        const int row0 = u.pm * BM + wr * 64 + fr, col0 = u.pn * BM + wc * 32 + 4 * fq;
#pragma unroll
        for (int ai = 0; ai < 2; ++ai)
#pragma unroll
            for (int m = 0; m < 4; ++m) { const size_t ro = (size_t)(row0 + ai * HALF + m * 16) * 2048 + col0;
#pragma unroll
                for (int bj = 0; bj < 2; ++bj)
#pragma unroll
                    for (int n = 0; n < 2; ++n) { const f32x4 xv = *(const f32x4*)(xin + ro + bj * HALF + n * 16); *(f32x4*)(out + ro + bj * HALF + n * 16) = xv + acc[ai][bj][m][n]; } }
    }
};
template <bool ACC> struct EpiGate {
    static constexpr bool PERM = true, AFTER_DRAIN = false; static constexpr int A_ROWS = 256; static constexpr bool HAS_SEG = false;
    const bf16_t* G; int gofs; bf16_t* MG;
    __device__ __forceinline__ void operator()(const f32x4 (&acc)[2][2][4][2], const Unit& u, int wr, int wc, int fr, int fq) const {
        const int row0 = u.pm * BM + wr * 64 + fr; const int col0 = u.pn * BM + wc * 32 + 8 * fq;
#pragma unroll
        for (int ai = 0; ai < 2; ++ai)
#pragma unroll
            for (int m = 0; m < 4; ++m) { const int row = row0 + ai * HALF + m * 16;
#pragma unroll
                for (int bj = 0; bj < 2; ++bj) { const int col = col0 + bj * HALF;
                    const u32x4 gv = *(const u32x4*)(G + (size_t)row * 6144 + gofs + col);
                    const f32x4 a0 = acc[ai][bj][m][0], a1 = acc[ai][bj][m][1];
                    float r[8];
                    r[0] = __builtin_bit_cast(float, gv.x << 16) * a0[0]; r[1] = __builtin_bit_cast(float, gv.x & 0xffff0000u) * a0[1];
                    r[2] = __builtin_bit_cast(float, gv.y << 16) * a0[2]; r[3] = __builtin_bit_cast(float, gv.y & 0xffff0000u) * a0[3];
                    r[4] = __builtin_bit_cast(float, gv.z << 16) * a1[0]; r[5] = __builtin_bit_cast(float, gv.z & 0xffff0000u) * a1[1];
                    r[6] = __builtin_bit_cast(float, gv.w << 16) * a1[2]; r[7] = __builtin_bit_cast(float, gv.w & 0xffff0000u) * a1[3];
                    bf16_t* mp = MG + (size_t)row * 2048 + col;
                    if (ACC) { const u32x4 ov = *(const u32x4*)mp;
                        r[0] += __builtin_bit_cast(float, ov.x << 16); r[1] += __builtin_bit_cast(float, ov.x & 0xffff0000u);
                        r[2] += __builtin_bit_cast(float, ov.y << 16); r[3] += __builtin_bit_cast(float, ov.y & 0xffff0000u);
                        r[4] += __builtin_bit_cast(float, ov.z << 16); r[5] += __builtin_bit_cast(float, ov.z & 0xffff0000u);
                        r[6] += __builtin_bit_cast(float, ov.w << 16); r[7] += __builtin_bit_cast(float, ov.w & 0xffff0000u); }
                    u32x4 w; w.x = cvt_pk_bf16(r[0], r[1]); w.y = cvt_pk_bf16(r[2], r[3]); w.z = cvt_pk_bf16(r[4], r[5]); w.w = cvt_pk_bf16(r[6], r[7]);
                    *(u32x4*)mp = w; } }
    }
};
struct EpiGate3 {
    static constexpr bool PERM = true, AFTER_DRAIN = false; static constexpr int A_ROWS = 256; static constexpr bool HAS_SEG = true;
    const bf16_t* G; bf16_t* MG; int t1, t2;
    __device__ __forceinline__ void seg(f32x4 (&acc)[2][2][4][2], const Unit& u, int t, int wr, int wc, int fr, int fq) const {
        typedef unsigned u32x2 __attribute__((ext_vector_type(2)));
        const int gnum = (t == t1) ? 0 : 2048;
        const bf16_t* gp0 = G + (size_t)(u.pm * BM + wr * 64 + fr) * 6144 + gnum + u.pn * BM + wc * 32 + 8 * fq;
#pragma unroll
        for (int ai = 0; ai < 2; ++ai)
#pragma unroll
            for (int m = 0; m < 4; ++m)
#pragma unroll
                for (int bj = 0; bj < 2; ++bj)
#pragma unroll
                    for (int n = 0; n < 2; ++n) {
                        const bf16_t* gp = gp0 + (size_t)(ai * HALF + m * 16) * 6144 + bj * HALF + 4 * n;
                        const u32x2 gn = *(const u32x2*)gp, gd = *(const u32x2*)(gp + 2048);
                        f32x4 r;
                        r[0] = __builtin_bit_cast(float, gn.x << 16) * __builtin_amdgcn_rcpf(__builtin_bit_cast(float, gd.x << 16)); r[1] = __builtin_bit_cast(float, gn.x & 0xffff0000u) * __builtin_amdgcn_rcpf(__builtin_bit_cast(float, gd.x & 0xffff0000u));
                        r[2] = __builtin_bit_cast(float, gn.y << 16) * __builtin_amdgcn_rcpf(__builtin_bit_cast(float, gd.y << 16)); r[3] = __builtin_bit_cast(float, gn.y & 0xffff0000u) * __builtin_amdgcn_rcpf(__builtin_bit_cast(float, gd.y & 0xffff0000u));
                        acc[ai][bj][m][n] *= r; if (n == 1 && bj == 1) asm volatile("" ::: "memory"); }
    }
    __device__ __forceinline__ void operator()(const f32x4 (&acc)[2][2][4][2], const Unit& u, int wr, int wc, int fr, int fq) const {
        const int row0 = u.pm * BM + wr * 64 + fr; const int col0 = u.pn * BM + wc * 32 + 8 * fq;
#pragma unroll
        for (int ai = 0; ai < 2; ++ai)
#pragma unroll
            for (int m = 0; m < 4; ++m) { const int row = row0 + ai * HALF + m * 16;
#pragma unroll
                for (int bj = 0; bj < 2; ++bj) { const int col = col0 + bj * HALF; const u32x4 gv = *(const u32x4*)(G + (size_t)row * 6144 + 4096 + col);
                    const f32x4 a0 = acc[ai][bj][m][0], a1 = acc[ai][bj][m][1];
                    u32x4 w;
                    w.x = cvt_pk_bf16(__builtin_bit_cast(float, gv.x << 16) * a0[0], __builtin_bit_cast(float, gv.x & 0xffff0000u) * a0[1]);
                    w.y = cvt_pk_bf16(__builtin_bit_cast(float, gv.y << 16) * a0[2], __builtin_bit_cast(float, gv.y & 0xffff0000u) * a0[3]);
                    w.z = cvt_pk_bf16(__builtin_bit_cast(float, gv.z << 16) * a1[0], __builtin_bit_cast(float, gv.z & 0xffff0000u) * a1[1]);
                    w.w = cvt_pk_bf16(__builtin_bit_cast(float, gv.w << 16) * a1[2], __builtin_bit_cast(float, gv.w & 0xffff0000u) * a1[3]);
                    *(u32x4*)(MG + (size_t)row * 2048 + col) = w; } }
    }
};
template <int CTRL> __device__ __forceinline__ float dpp_keep(float old, float x) { return __builtin_bit_cast(float, __builtin_amdgcn_update_dpp(__builtin_bit_cast(int, old), __builtin_bit_cast(int, x), CTRL, 0xF, 0xF, false)); }
struct EpiConv {
    static constexpr bool PERM = true, AFTER_DRAIN = false; static constexpr int A_ROWS = 254; static constexpr bool HAS_SEG = false;
    bf16_t* ACT; const float* cw; PG8_LAS float* xch;
    __device__ __forceinline__ void operator()(const f32x4 (&acc)[2][2][4][2], const Unit& u, int wr, int wc, int fr, int fq) const {
        const int cbase = wc * 32 + 8 * fq, f0 = u.pn * 128 + cbase;
        float c0[8], c1[8], c2[8];
#pragma unroll
        for (int j = 0; j < 8; ++j) { c0[j] = cw[f0 + j]; c1[j] = cw[5504 + f0 + j]; c2[j] = cw[2 * 5504 + f0 + j]; }
        if (fr >= 14) {
#pragma unroll
            for (int ai = 0; ai < 2; ++ai)
#pragma unroll
                for (int n = 0; n < 2; ++n) *(PG8_LAS f32x4*)(xch + ((2 * ai + wr) * 2 + (fr - 14)) * 128 + cbase + 4 * n) = acc[ai][0][3][n];
        }
        asm volatile("s_waitcnt lgkmcnt(0)" ::: "memory"); __builtin_amdgcn_s_barrier(); asm volatile("" ::: "memory");
#pragma unroll
        for (int ai = 0; ai < 2; ++ai) {
            const int sl = 2 * ai + wr;
            f32x4 e1[2], e2[2];
#pragma unroll
            for (int n = 0; n < 2; ++n) { e1[n] = (f32x4){0.f, 0.f, 0.f, 0.f}; e2[n] = e1[n];
                if (sl > 0) { e2[n] = *(const PG8_LAS f32x4*)(xch + ((sl - 1) * 2 + 0) * 128 + cbase + 4 * n); e1[n] = *(const PG8_LAS f32x4*)(xch + ((sl - 1) * 2 + 1) * 128 + cbase + 4 * n); } }
#pragma unroll
            for (int m = 0; m < 4; ++m) {
                const int lr = 128 * ai + 64 * wr + 16 * m + fr; const int grow = 254 * u.pm - 2 + lr; const int t = grow & 8191;
                float r[8];
#pragma unroll
                for (int n = 0; n < 2; ++n)
#pragma unroll
                    for (int j = 0; j < 4; ++j) {
                        const float x = acc[ai][0][m][n][j];
                        float k1, k2;
                        if (m > 0) { const float xp = acc[ai][0][m > 0 ? m - 1 : 0][n][j]; k1 = dpp_keep<0x121>(xp, xp); k2 = dpp_keep<0x122>(xp, xp); }
                        else { k1 = e1[n][j]; k2 = (fr == 0) ? e2[n][j] : e1[n][j]; }
                        float p1 = dpp_keep<0x111>(k1, x), p2 = dpp_keep<0x112>(k2, x);
                        if (t == 0) p1 = 0.f; if (t <= 1) p2 = 0.f;
                        const float gs = c0[4 * n + j] * p2 + c1[4 * n + j] * p1 + c2[4 * n + j] * x;
                        r[4 * n + j] = gs * __builtin_amdgcn_rcpf(1.0f + __expf(-gs)) * acc[ai][1][m][n][j];
                    }
                if (lr >= 2 && grow < 16384) { u32x4 w; w.x = cvt_pk_bf16(r[0], r[1]); w.y = cvt_pk_bf16(r[2], r[3]); w.z = cvt_pk_bf16(r[4], r[5]); w.w = cvt_pk_bf16(r[6], r[7]);
                    *(u32x4*)(ACT + (size_t)grow * 5504 + f0) = w; }
            }
        }
    }
};
}

struct Args { const float* in[25]; float* out; unsigned char* ws; int ph_lo, ph_hi, li, pad; };

struct Ctx {
    LAS unsigned char* lds;
    int tid, lane, wave, G, bid;
    int gw, ngw;
};

__device__ __forceinline__ void transpose_item(const float* W, int K, int N, bf16* WT, int kb, int nb, int dst_row0, LAS float* scr, int lane, int ldk = 0, int koff = 0) {
    if (ldk == 0) ldk = K;
    const int k0 = 64 * kb, n0 = 32 * nb;
#pragma unroll 8
    for (int i = 0; i < 32; ++i) { const int kk = 2 * i + (lane >> 5); scr[kk * 33 + (lane & 31)] = W[(size_t)(k0 + kk) * N + n0 + (lane & 31)]; }
    LDS_WAIT(); asm volatile("" ::: "memory");
    const int c = lane & 7;
#pragma unroll
    for (int j = 0; j < 4; ++j) { const int n = (lane >> 3) + 8 * j; const LAS float* s = scr + (8 * c) * 33 + n;
        v4u o; o.x = pk2(s[0 * 33], s[1 * 33]); o.y = pk2(s[2 * 33], s[3 * 33]); o.z = pk2(s[4 * 33], s[5 * 33]); o.w = pk2(s[6 * 33], s[7 * 33]);
        *(v4u*)(WT + (size_t)(dst_row0 + n) * ldk + koff + k0 + 8 * c) = o; }
    LDS_WAIT(); asm volatile("" ::: "memory");
}
__device__ __forceinline__ int transpose_matrix(int widx, int nw, int lane, LAS float* scr, const float* W, int K, int N, bf16* WT, int gate_split, int base, int ldk = 0, int koff = 0) {
    const int nblk = N / 32, items = (K / 64) * nblk;
    int first = (widx - base) % nw; if (first < 0) first += nw;
    for (int it = first; it < items; it += nw) {
        const int kb = it / nblk, nb = it % nblk; int dr = 32 * nb; if (gate_split == 1 && dr >= C_END) dr += 64;
        if (gate_split == 2) { const int f = dr < DFF ? dr : dr - DFF; dr = 256 * (f >> 7) + (f & 127) + (dr < DFF ? 0 : 128); }
        transpose_item(W, K, N, WT, kb, nb, dr, scr, lane, ldk, koff);
    }
    return base + items;
}
__device__ __forceinline__ void convert_weights(int widx, int nw, int lane, LAS float* scr, const Args& a, int l, unsigned char* ws) {
    unsigned char* wsw = ws + (size_t)(l & 1) * WSET_STRIDE;
    int base = 0;
    base = transpose_matrix(widx, nw, lane, scr, a.in[3] + (size_t)l * D * DIN, D, DIN, (bf16*)(wsw + WS_WIN), 1, base);
    base = transpose_matrix(widx, nw, lane, scr, a.in[21] + (size_t)l * D * NUP, D, NUP, (bf16*)(wsw + WS_WUP), 2, base);
    base = transpose_matrix(widx, nw, lane, scr, a.in[23] + (size_t)l * DFF * D, DFF, D, (bf16*)(wsw + WS_WDOWN), 0, base);
    base = transpose_matrix(widx, nw, lane, scr, a.in[19] + (size_t)l * D * D, D, D, (bf16*)(wsw + WS_WOUT), 0, base);
    base = transpose_matrix(widx, nw, lane, scr, a.in[16] + (size_t)l * 512 * D, 512, D, (bf16*)(wsw + WS_PA), 0, base, 1536, 0);
    base = transpose_matrix(widx, nw, lane, scr, a.in[17] + (size_t)l * 768 * D, 768, D, (bf16*)(wsw + WS_PA), 0, base, 1536, 512);
    base = transpose_matrix(widx, nw, lane, scr, a.in[18] + (size_t)l * 256 * D, 256, D, (bf16*)(wsw + WS_PA), 0, base, 1536, 1280);
    const int gt = widx * 64 + lane, ngt = nw * 64;
    { v4u* z = (v4u*)((bf16*)(wsw + WS_WIN) + (size_t)C_END * D); for (int i = gt; i < 64 * D / 8; i += ngt) z[i] = (v4u){0u, 0u, 0u, 0u}; }
    { bf16* wl = (bf16*)(wsw + WS_WLORA); const float* wup = a.in[7] + (size_t)l * 96 * BW; const float* aup = a.in[9] + (size_t)l * 96 * BW; const float* gup = a.in[10] + (size_t)l * 256 * BW;
      for (int i = gt; i < NLORA * KLORA; i += ngt) { const int n = i / KLORA, k = i % KLORA; float v = 0.f;
          if (n < 768) { if (k < 96) v = wup[k * BW + n]; }
          else if (n < 1536) { if (k >= 96 && k < 192) v = aup[(k - 96) * BW + (n - 768)]; }
          else { if (k >= 192 && k < 448) v = gup[(k - 192) * BW + (n - 1536)]; }
          wl[i] = (bf16)f2bf(v); } }
}

__device__ __forceinline__ void rms_row_bf16(const float* xrow, const float* gam, bf16* orow, int lane) {
    const f32x4* xr = (const f32x4*)xrow + lane; f32x4 v[8]; float s = 0.f;
#pragma unroll
    for (int j = 0; j < 8; ++j) { v[j] = xr[64 * j]; s += (v[j].x * v[j].x + v[j].y * v[j].y) + (v[j].z * v[j].z + v[j].w * v[j].w); }
    const float rs = 1.0f / sqrtf(wave_sum(s) * (1.0f / D) + NORM_EPS);
    const f32x4* gr = (const f32x4*)gam + lane; v2u* o8 = (v2u*)orow + lane;
#pragma unroll
    for (int j = 0; j < 8; ++j) { const f32x4 g = gr[64 * j]; v2u w; w.x = pk2(v[j].x * rs * g.x, v[j].y * rs * g.y); w.y = pk2(v[j].z * rs * g.z, v[j].w * rs * g.w); o8[64 * j] = w; }
}
__device__ __forceinline__ void rms_row2_bf16(const float* xrow, const float* gam, bf16* orow, int lane) {
    const f32x4* xr = (const f32x4*)xrow + lane; f32x4 v[16]; float s0 = 0.f, s1 = 0.f;
#pragma unroll
    for (int j = 0; j < 16; ++j) v[j] = xr[64 * j];
#pragma unroll
    for (int j = 0; j < 8; ++j) { s0 += (v[j].x * v[j].x + v[j].y * v[j].y) + (v[j].z * v[j].z + v[j].w * v[j].w); s1 += (v[8 + j].x * v[8 + j].x + v[8 + j].y * v[8 + j].y) + (v[8 + j].z * v[8 + j].z + v[8 + j].w * v[8 + j].w); }
    const float rs0 = 1.0f / sqrtf(wsum(s0) * (1.0f / D) + NORM_EPS), rs1 = 1.0f / sqrtf(wsum(s1) * (1.0f / D) + NORM_EPS);
    const f32x4* gr = (const f32x4*)gam + lane; v2u* o8 = (v2u*)orow + lane;
#pragma unroll
    for (int j = 0; j < 8; ++j) { const f32x4 g = gr[64 * j]; v2u w; w.x = pk2(v[j].x * rs0 * g.x, v[j].y * rs0 * g.y); w.y = pk2(v[j].z * rs0 * g.z, v[j].w * rs0 * g.w); o8[64 * j] = w;
        v2u w1; w1.x = pk2(v[8 + j].x * rs1 * g.x, v[8 + j].y * rs1 * g.y); w1.y = pk2(v[8 + j].z * rs1 * g.z, v[8 + j].w * rs1 * g.w); o8[64 * (8 + j)] = w1; }
}
__device__ __forceinline__ void rms_row_f32(float* xrow, const float* gam, int lane) {
    f32x4* xr = (f32x4*)xrow + lane; f32x4 v[8]; float s = 0.f;
#pragma unroll
    for (int j = 0; j < 8; ++j) { v[j] = xr[64 * j]; s += (v[j].x * v[j].x + v[j].y * v[j].y) + (v[j].z * v[j].z + v[j].w * v[j].w); }
    const float rs = 1.0f / sqrtf(wave_sum(s) * (1.0f / D) + NORM_EPS);
    const f32x4* gr = (const f32x4*)gam + lane;
#pragma unroll
    for (int j = 0; j < 8; ++j) { const f32x4 g = gr[64 * j]; xr[64 * j] = v[j] * rs * g; }
}

__device__ __forceinline__ void phase_prep(const Ctx& C, const Args& a, int l, const float* xsrc, unsigned char* ws) {
    if (l == 0) convert_weights(C.gw, C.ngw, C.lane, (LAS float*)(C.lds + RING_OFF + C.wave * 16384), a, 0, ws);
    const float* g1 = a.in[2] + (size_t)l * D; bf16* H = (bf16*)(ws + WS_H);
    for (int m = 2 * C.gw; m < M; m += 2 * C.ngw) rms_row2_bf16(xsrc + (size_t)m * D, g1, H + (size_t)m * D, C.lane);
}

__device__ __forceinline__ void phase_aprime(const Ctx& C, const Args& a, int l, unsigned char* ws) {
    const bf16* P1 = (const bf16*)(ws + WS_P1); bf16* AP = (bf16*)(ws + WS_AP); const float* mu = a.in[5] + (size_t)l * BCOLS;
    const int g = C.lane, c0 = 8 * g;
    float muv[8];
#pragma unroll
    for (int j = 0; j < 8; ++j) muv[j] = (g < 56) ? mu[(C_WD - C_R) + c0 + j] : 0.f;
    for (int m = C.gw; m < M; m += C.ngw) {
        v4u o = (v4u){0u, 0u, 0u, 0u};
        if (g < 56) {
            const v4u cur = *(const v4u*)(P1 + (size_t)m * NP1 + C_WD + c0);
            v4u prv = (v4u){0u, 0u, 0u, 0u}; if ((m & (SEQ - 1)) != 0) prv = *(const v4u*)(P1 + (size_t)(m - 1) * NP1 + C_WD + c0);
            float x[8], p[8];
            x[0] = bflo(cur.x); x[1] = bfhi(cur.x); x[2] = bflo(cur.y); x[3] = bfhi(cur.y); x[4] = bflo(cur.z); x[5] = bfhi(cur.z); x[6] = bflo(cur.w); x[7] = bfhi(cur.w);
            p[0] = bflo(prv.x); p[1] = bfhi(prv.x); p[2] = bflo(prv.y); p[3] = bfhi(prv.y); p[4] = bflo(prv.z); p[5] = bfhi(prv.z); p[6] = bflo(prv.w); p[7] = bfhi(prv.w);
#pragma unroll
            for (int j = 0; j < 8; ++j) { float v = x[j] + (p[j] - x[j]) * muv[j];
                if (g < 12) v = tanhf(v); else if (g >= 24) v = sigmoidf_(v);
                x[j] = v; }
            o.x = pk2(x[0], x[1]); o.y = pk2(x[2], x[3]); o.z = pk2(x[4], x[5]); o.w = pk2(x[6], x[7]);
        }
        *(v4u*)(AP + (size_t)m * KLORA + c0) = o;
    }
}

struct PrepTok { float r, kt, v, w, kk, b; };
__device__ __forceinline__ PrepTok prep_token(const bf16* P1, const float* LO, int m, int hc, float mur, float muk, float muv, float w0, float a0, float kkw, float kaw) {
    const bool first = (m & (SEQ - 1)) == 0;
    const bf16* pr = P1 + (size_t)m * NP1; const bf16* pp = pr - NP1;
    float r = bf1(pr[C_R + hc]), k = bf1(pr[C_K + hc]), v = bf1(pr[C_V + hc]);
    const float rp = first ? 0.f : bf1(pp[C_R + hc]), kp = first ? 0.f : bf1(pp[C_K + hc]), vp = first ? 0.f : bf1(pp[C_V + hc]);
    r = r + (rp - r) * mur; k = k + (kp - k) * muk; v = v + (vp - v) * muv;
    const float wpre = w0 + LO[(size_t)m * NLORA + hc], apre = a0 + LO[(size_t)m * NLORA + BW + hc];
    const float xx = -wpre; const float sp = fmaxf(xx, 0.f) + log1pf(expf(-fabsf(xx)));
    const float wlog = -sp - 0.5f; const float decay = expf(-expf(wlog));
    const float av = 1.0f / (1.0f + expf(-apre));
    const float kkr = k * kkw; const float nrm = sqrtf(wave_sum(kkr * kkr)); const float kk = kkr / fmaxf(nrm, 1e-12f);
    PrepTok t; t.r = r; t.kt = k * (1.0f + (av - 1.0f) * kaw); t.v = v; t.w = decay; t.kk = kk; t.b = kk * av; return t;
}
struct PrepRaw { v2u r, k, v; f32x4 lw, la; };
__device__ __forceinline__ PrepRaw prep_load(const bf16* P1, const float* LO, int m, int c0) {
    PrepRaw x; const bf16* pr = P1 + (size_t)m * NP1 + c0;
    x.r = *(const v2u*)(pr + C_R); x.k = *(const v2u*)(pr + C_K); x.v = *(const v2u*)(pr + C_V);
    x.lw = *(const f32x4*)(LO + (size_t)m * NLORA + c0); x.la = *(const f32x4*)(LO + (size_t)m * NLORA + BW + c0); return x;
}
__device__ __forceinline__ void un4(const v2u w, float (&x)[4]) { x[0] = bflo(w.x); x[1] = bfhi(w.x); x[2] = bflo(w.y); x[3] = bfhi(w.y); }
__device__ __forceinline__ void phase_scanprep(const Ctx& C, const Args& a, int l, unsigned char* ws) {
    const bf16* P1 = (const bf16*)(ws + WS_P1); const float* LO = (const float*)(ws + WS_LO);
    float* SR = (float*)(ws + WS_SR); float* SW = (float*)(ws + WS_SW); float* SK = (float*)(ws + WS_SK); float* SU = (float*)(ws + WS_SKK); float* SB = (float*)(ws + WS_SB); float* SV = (float*)(ws + WS_SV);
    float* BK = (float*)(ws + WS_BK); float* BON = (float*)(ws + WS_BON);
    const float* mu = a.in[5] + (size_t)l * BCOLS; const float* w0p = a.in[6] + (size_t)l * BW; const float* a0p = a.in[8] + (size_t)l * BW;
    const float* kkwp = a.in[11] + (size_t)l * BW; const float* kawp = a.in[12] + (size_t)l * BW; const float* rkp = a.in[13] + (size_t)l * BW;
    constexpr int RL = 8;
    const int g = C.lane >> 4, cq = C.lane & 15;
    for (int it = C.gw; it < (M / (4 * RL)) * 12; it += C.ngw) {
        const int h = it % 12, m0 = ((it / 12) * 4 + g) * RL, c0 = h * 64 + 4 * cq;
        const f32x4 mur = *(const f32x4*)(mu + c0), muk = *(const f32x4*)(mu + BW + c0), muv = *(const f32x4*)(mu + 2 * BW + c0), w0 = *(const f32x4*)(w0p + c0), a0 = *(const f32x4*)(a0p + c0);
        const f32x4 kkw = *(const f32x4*)(kkwp + c0), kaw = *(const f32x4*)(kawp + c0), rkc = *(const f32x4*)(rkp + c0);
        const bool seq_start = (m0 & (SEQ - 1)) == 0;
        float prr[4] = {0.f, 0.f, 0.f, 0.f}, prk[4] = {0.f, 0.f, 0.f, 0.f}, prv[4] = {0.f, 0.f, 0.f, 0.f}, pw[4] = {0.f, 0.f, 0.f, 0.f}, pb[4] = {0.f, 0.f, 0.f, 0.f}, pkt[4] = {0.f, 0.f, 0.f, 0.f};
        if (!seq_start) { const bf16* pr = P1 + (size_t)(m0 - 2) * NP1 + c0; un4(*(const v2u*)(pr + C_R), prr); un4(*(const v2u*)(pr + C_K), prk); un4(*(const v2u*)(pr + C_V), prv); }
        PrepRaw nx = prep_load(P1, LO, seq_start ? m0 : m0 - 1, c0);
#pragma unroll 1
        for (int i = seq_start ? 0 : -1; i < RL; ++i) {
            const int m = m0 + i; const PrepRaw cu = nx;
            if (i + 1 < RL) nx = prep_load(P1, LO, m + 1, c0);
            float xr[4], xk[4], xv[4]; un4(cu.r, xr); un4(cu.k, xk); un4(cu.v, xv);
            float tr[4], tk[4], tv[4], tw[4], ta[4], kkr[4]; float q = 0.f;
#pragma unroll
            for (int e = 0; e < 4; ++e) {
                tr[e] = xr[e] + (prr[e] - xr[e]) * mur[e]; tk[e] = xk[e] + (prk[e] - xk[e]) * muk[e]; tv[e] = xv[e] + (prv[e] - xv[e]) * muv[e];
                const float xx = -(w0[e] + cu.lw[e]); const float sp = fmaxf(xx, 0.f) + __logf(1.0f + __expf(-fabsf(xx)));
                tw[e] = __expf(-__expf(-sp - 0.5f)); ta[e] = __builtin_amdgcn_rcpf(1.0f + __expf(-(a0[e] + cu.la[e])));
                kkr[e] = tk[e] * kkw[e]; q += kkr[e] * kkr[e];
            }
            q = red16(q); const float rn = __builtin_amdgcn_rsqf(fmaxf(q, 1e-24f));
            float tkk[4], tb[4], tkt[4]; float be = 0.f, ka = 0.f, bo = 0.f;
#pragma unroll
            for (int e = 0; e < 4; ++e) { tkk[e] = kkr[e] * rn; tb[e] = tkk[e] * ta[e]; tkt[e] = tk[e] * (1.0f + (ta[e] - 1.0f) * kaw[e]);
                be += pb[e] * tkk[e]; ka += pkt[e] * tkk[e]; bo += tr[e] * tkt[e] * rkc[e]; }
            if (i >= 0) {
                be = red16(be); ka = red16(ka); bo = red16(bo);
                const size_t o = (size_t)m * BW + c0; const bool first = (m & (SEQ - 1)) == 0;
                *(f32x4*)(SR + o) = (f32x4){tr[0], tr[1], tr[2], tr[3]}; *(f32x4*)(SW + o) = (f32x4){tw[0], tw[1], tw[2], tw[3]}; *(f32x4*)(SK + o) = (f32x4){tkt[0], tkt[1], tkt[2], tkt[3]};
                *(f32x4*)(SB + o) = (f32x4){tb[0], tb[1], tb[2], tb[3]}; *(f32x4*)(SV + o) = (f32x4){tv[0], tv[1], tv[2], tv[3]};
                if (!first) *(f32x4*)(SU + o - BW) = (f32x4){pw[0] * tkk[0], pw[1] * tkk[1], pw[2] * tkk[2], pw[3] * tkk[3]};
                if ((m & (SEQ - 1)) == SEQ - 1) *(f32x4*)(SU + o) = (f32x4){0.f, 0.f, 0.f, 0.f};
                if (cq < 2) BK[((size_t)m * 12 + h) * 2 + cq] = first ? 0.f : (cq == 0 ? be : ka);
                if (cq == 2) BON[(size_t)m * 12 + h] = bo;
            }
#pragma unroll
            for (int e = 0; e < 4; ++e) { prr[e] = xr[e]; prk[e] = xk[e]; prv[e] = xv[e]; pw[e] = tw[e]; pb[e] = tb[e]; pkt[e] = tkt[e]; }
        }
    }
}

typedef float f32x4c __attribute__((ext_vector_type(4)));
#define MFMA4(a, b, c) __builtin_amdgcn_mfma_f32_16x16x4f32((a), (b), (c), 0, 0, 0)
__device__ __forceinline__ void split8(const float (&x)[8], v4u& hi, v4u& lo) {
    unsigned h[4], l[4];
#pragma unroll
    for (int p = 0; p < 4; ++p) { h[p] = pg8::cvt_pk_bf16(x[2 * p], x[2 * p + 1]); l[p] = pg8::cvt_pk_bf16(x[2 * p] - bflo(h[p]), x[2 * p + 1] - bfhi(h[p])); }
    hi = (v4u){h[0], h[1], h[2], h[3]}; lo = (v4u){l[0], l[1], l[2], l[3]};
}
constexpr int CP_LD = 65, CP_ARR = 16 * CP_LD, CP_SM = 16 * 17;
constexpr int CP_WAVE_FLOATS = 4 * CP_ARR + 4 * CP_SM;
__device__ __forceinline__ void phase_chunkprep(const Ctx& C, const Args& a, int l, unsigned char* ws) {
    if (C.wave >= 6) return;
    const bf16* P1 = (const bf16*)(ws + WS_P1); const float* LO = (const float*)(ws + WS_LO);
    float* SV = (float*)(ws + WS_SV); float* BON = (float*)(ws + WS_BON); float* COP = (float*)(ws + WS_COP);
    const float* mu = a.in[5] + (size_t)l * BCOLS; const float* w0p = a.in[6] + (size_t)l * BW; const float* a0p = a.in[8] + (size_t)l * BW;
    const float* kkwp = a.in[11] + (size_t)l * BW; const float* kawp = a.in[12] + (size_t)l * BW; const float* rkp = a.in[13] + (size_t)l * BW;
    LAS float* L = (LAS float*)(C.lds + RING_OFF) + C.wave * CP_WAVE_FLOATS;
    LAS float* At = L; LAS float* Bt = L + CP_ARR; LAS float* Kt = L + 2 * CP_ARR; LAS float* Rt = L + 3 * CP_ARR;
    LAS float* Sa = L + 4 * CP_ARR; LAS float* Sb = Sa + CP_SM; LAS float* Sc = Sb + CP_SM; LAS float* Sd = Sc + CP_SM;
    const int lane = C.lane, li = lane & 15, q = lane >> 4;
    const int widx = C.bid * 6 + C.wave, nw = C.G * 6;
    for (int it = widx; it < 24 * 512; it += nw) {
        const int hs = it >> 9, c = it & 511, b = hs / 12, h = hs % 12, hc = h * 64 + lane; const int m0 = b * SEQ + c * 16;
        const float mur = mu[hc], muk = mu[BW + hc], muv = mu[2 * BW + hc], w0 = w0p[hc], a0 = a0p[hc], kkw = kkwp[hc], kaw = kawp[hc], rkc = rkp[hc];
        float rr[17], rk_[17], rv[17], lw[16], la[16];
#pragma unroll
        for (int j = 0; j < 17; ++j) { const bool ok = !((c == 0) && j == 0); const size_t row = ok ? (size_t)(m0 - 1 + j) : (size_t)m0; const bf16* pr = P1 + row * NP1 + hc;
            const float x0 = bf1(pr[C_R]), x1 = bf1(pr[C_K]), x2 = bf1(pr[C_V]); rr[j] = ok ? x0 : 0.f; rk_[j] = ok ? x1 : 0.f; rv[j] = ok ? x2 : 0.f;
            if (j >= 1) { lw[j - 1] = LO[row * NLORA + hc]; la[j - 1] = LO[row * NLORA + BW + hc]; } }
        float cum = 0.f;
#pragma unroll
        for (int i = 0; i < 16; ++i) {
            const float tr = rr[i + 1] + (rr[i] - rr[i + 1]) * mur, tk = rk_[i + 1] + (rk_[i] - rk_[i + 1]) * muk, tv = rv[i + 1] + (rv[i] - rv[i + 1]) * muv;
            const float xx = -(w0 + lw[i]); const float sp = fmaxf(xx, 0.f) + __logf(1.0f + __expf(-fabsf(xx)));
            const float lwv = -__expf(-sp - 0.5f);
            const float av = __builtin_amdgcn_rcpf(1.0f + __expf(-(a0 + la[i])));
            const float kkr = tk * kkw; const float kk = kkr * __builtin_amdgcn_rsqf(fmaxf(wsum(kkr * kkr), 1e-24f));
            const float kt = tk * (1.0f + (av - 1.0f) * kaw), bb = kk * av;
            const float bo = wsum(tr * kt * rkc);
            SV[(size_t)(m0 + i) * BW + hc] = tv; if (lane == 0) BON[(size_t)(m0 + i) * 12 + h] = bo;
            const float ex = __expf(cum); cum += lwv; const float ei = __expf(cum), eni = __expf(-cum);
            At[i * CP_LD + lane] = -kk * ex; Bt[i * CP_LD + lane] = bb * eni; Kt[i * CP_LD + lane] = kt * eni; Rt[i * CP_LD + lane] = tr * ei;
        }
        const float gam = __expf(cum);
        LDS_WAIT(); asm volatile("" ::: "memory");
        f32x4c gab = {0.f, 0.f, 0.f, 0.f}, gak = gab, grb = gab, grk = gab;
#pragma unroll
        for (int s_ = 0; s_ < 16; ++s_) { const int o = li * CP_LD + 4 * s_ + q; const float fa = At[o], fr = Rt[o], fb = Bt[o], fk = Kt[o];
            gab = MFMA4(fa, fb, gab); gak = MFMA4(fa, fk, gak); grb = MFMA4(fr, fb, grb); grk = MFMA4(fr, fk, grk); }
#pragma unroll
        for (int e = 0; e < 4; ++e) { const int i = 4 * q + e, j = li; if (!(j < i)) { gab[e] = 0.f; gak[e] = 0.f; } if (!(j <= i)) { grb[e] = 0.f; grk[e] = 0.f; }
            Sa[i * 17 + j] = gab[e]; Sb[i * 17 + j] = gak[e]; Sc[i * 17 + j] = grb[e]; }
        LDS_WAIT(); asm volatile("" ::: "memory");
        float tt[16];
#pragma unroll
        for (int i = 0; i < 16; ++i) { float acc = (i == li) ? 1.f : 0.f;
#pragma unroll
            for (int j = 0; j < i; ++j) acc += Sa[i * 17 + j] * tt[j];
            tt[i] = acc; }
        if (q == 0) {
#pragma unroll
            for (int i = 0; i < 16; ++i) Sd[i * 17 + li] = tt[i]; }
        LDS_WAIT(); asm volatile("" ::: "memory");
        float tf[4], mrbf[4];
#pragma unroll
        for (int s_ = 0; s_ < 4; ++s_) { tf[s_] = Sd[li * 17 + 4 * s_ + q]; mrbf[s_] = Sc[li * 17 + 4 * s_ + q]; }
        f32x4c w1[4], u0 = {0.f, 0.f, 0.f, 0.f};
#pragma unroll
        for (int n = 0; n < 4; ++n) { w1[n] = (f32x4c){0.f, 0.f, 0.f, 0.f};
#pragma unroll
            for (int s_ = 0; s_ < 4; ++s_) w1[n] = MFMA4(tf[s_], At[(4 * s_ + q) * CP_LD + 16 * n + li], w1[n]); }
#pragma unroll
        for (int s_ = 0; s_ < 4; ++s_) u0 = MFMA4(tf[s_], Sb[(4 * s_ + q) * 17 + li], u0);
        LDS_WAIT(); asm volatile("" ::: "memory");
#pragma unroll
        for (int n = 0; n < 4; ++n)
#pragma unroll
            for (int e = 0; e < 4; ++e) At[(4 * q + e) * CP_LD + 16 * n + li] = w1[n][e];
#pragma unroll
        for (int e = 0; e < 4; ++e) Sa[(4 * q + e) * 17 + li] = u0[e];
        LDS_WAIT(); asm volatile("" ::: "memory");
        f32x4c ry[4], y0 = grk;
#pragma unroll
        for (int n = 0; n < 4; ++n) {
#pragma unroll
            for (int e = 0; e < 4; ++e) ry[n][e] = Rt[(4 * q + e) * CP_LD + 16 * n + li];
#pragma unroll
            for (int s_ = 0; s_ < 4; ++s_) ry[n] = MFMA4(mrbf[s_], At[(4 * s_ + q) * CP_LD + 16 * n + li], ry[n]); }
#pragma unroll
        for (int s_ = 0; s_ < 4; ++s_) y0 = MFMA4(mrbf[s_], Sa[(4 * s_ + q) * 17 + li], y0);
        LDS_WAIT(); asm volatile("" ::: "memory");
#pragma unroll
        for (int n = 0; n < 4; ++n)
#pragma unroll
            for (int e = 0; e < 4; ++e) Rt[(4 * q + e) * CP_LD + 16 * n + li] = ry[n][e];
#pragma unroll
        for (int e = 0; e < 4; ++e) Sb[(4 * q + e) * 17 + li] = y0[e];
        LDS_WAIT(); asm volatile("" ::: "memory");
        float* rec = COP + ((size_t)hs * 512 + c) * COP_STRIDE; unsigned* recu = (unsigned*)rec;
#pragma unroll
        for (int kb = 0; kb < 2; ++kb) { float x[8];
#pragma unroll
            for (int jj = 0; jj < 8; ++jj) x[jj] = At[li * CP_LD + 16 * (2 * kb + (jj >> 2)) + 4 * q + (jj & 3)];
            v4u hi, lo; split8(x, hi, lo); *(v4u*)(recu + COP_W1 + lane * 16 + 8 * kb) = hi; *(v4u*)(recu + COP_W1 + lane * 16 + 8 * kb + 4) = lo; }
        { float x[8];
#pragma unroll
          for (int jj = 0; jj < 8; ++jj) x[jj] = jj < 4 ? Sa[li * 17 + 4 * q + jj] : 0.f;
          v4u hi, lo; split8(x, hi, lo); *(v4u*)(recu + COP_U0 + lane * 8) = hi; *(v4u*)(recu + COP_U0 + lane * 8 + 4) = lo; }
#pragma unroll
        for (int m = 0; m < 4; ++m) { float x[8]; const float gk = __shfl(gam, 16 * m + li);
#pragma unroll
            for (int jj = 0; jj < 8; ++jj) x[jj] = gk * (jj < 4 ? Bt[(4 * q + jj) * CP_LD + 16 * m + li] : Kt[(4 * q + jj - 4) * CP_LD + 16 * m + li]);
            v4u hi, lo; split8(x, hi, lo); *(v4u*)(recu + COP_BK + lane * 32 + 8 * m) = hi; *(v4u*)(recu + COP_BK + lane * 32 + 8 * m + 4) = lo; }
#pragma unroll
        for (int m = 0; m < 4; ++m) { f32x4 y;
#pragma unroll
            for (int j = 0; j < 4; ++j) y[j] = Rt[li * CP_LD + 16 * m + 4 * q + j];
            *(f32x4*)(rec + COP_RY + lane * 16 + 4 * m) = y; }
        { f32x4 y;
#pragma unroll
          for (int s_ = 0; s_ < 4; ++s_) y[s_] = Sb[li * 17 + 4 * q + s_];
          *(f32x4*)(rec + COP_Y0 + lane * 4) = y; }
        rec[COP_GAM + lane] = gam;
        LDS_WAIT(); asm volatile("" ::: "memory");
    }
}

__device__ __forceinline__ void scan_block(const Ctx& C, int sb, unsigned char* ws) {
    const int b = sb / 24, h = (sb % 24) >> 1, half = sb & 1;
    const float* SR = (const float*)(ws + WS_SR); const float* SW = (const float*)(ws + WS_SW); const float* SK = (const float*)(ws + WS_SK); const float* SKK = (const float*)(ws + WS_SKK);
    const float* SB = (const float*)(ws + WS_SB); const float* SV = (const float*)(ws + WS_SV); float* YR = (float*)(ws + WS_YRAW);
    constexpr int T = 64;
    LAS float* Lr = (LAS float*)(C.lds + RING_OFF); LAS float* Lw = Lr + T * 64; LAS float* Lk = Lw + T * 64; LAS float* Lkk = Lk + T * 64; LAS float* Lb = Lkk + T * 64;
    LAS float* Lv = Lb + T * 64; LAS float* Ly = Lv + T * 32;
    const int tid = C.tid, rl = tid >> 4, kq = tid & 15;
    const size_t rowbase = (size_t)b * SEQ; const int colh = h * 64;
    const int lt0 = tid >> 4, lc0 = (tid & 15) * 4, vt = tid >> 3, vc = (tid & 7) * 4;
    f32x4 pr[2], pw[2], pk[2], pkk[2], pb[2], pv;
#define SCAN_LOAD(t0) do { _Pragma("unroll") for (int i = 0; i < 2; ++i) { const size_t o = (rowbase + (t0) + lt0 + 32 * i) * BW + colh + lc0; \
        pr[i] = *(const f32x4*)(SR + o); pw[i] = *(const f32x4*)(SW + o); pk[i] = *(const f32x4*)(SK + o); pkk[i] = *(const f32x4*)(SKK + o); pb[i] = *(const f32x4*)(SB + o); } \
        pv = *(const f32x4*)(SV + (rowbase + (t0) + vt) * BW + colh + 32 * half + vc); } while (0)
    SCAN_LOAD(0);
    float S0 = 0.f, S1 = 0.f, S2 = 0.f, S3 = 0.f;
    for (int ch = 0; ch < SEQ / T; ++ch) {
        const int t0 = ch * T;
#pragma unroll
        for (int i = 0; i < 2; ++i) { const int lo = (lt0 + 32 * i) * 64 + lc0;
            *(LAS f32x4*)(Lr + lo) = pr[i]; *(LAS f32x4*)(Lw + lo) = pw[i]; *(LAS f32x4*)(Lk + lo) = pk[i]; *(LAS f32x4*)(Lkk + lo) = pkk[i]; *(LAS f32x4*)(Lb + lo) = pb[i]; }
        *(LAS f32x4*)(Lv + vt * 32 + vc) = pv;
        __syncthreads();
        if (ch + 1 < SEQ / T) SCAN_LOAD(t0 + T);
#pragma unroll 4
        for (int t = 0; t < T; ++t) {
            const f32x4 kk4 = *(const LAS f32x4*)(Lkk + t * 64 + kq * 4), w4 = *(const LAS f32x4*)(Lw + t * 64 + kq * 4), b4 = *(const LAS f32x4*)(Lb + t * 64 + kq * 4);
            const f32x4 k4 = *(const LAS f32x4*)(Lk + t * 64 + kq * 4), r4 = *(const LAS f32x4*)(Lr + t * 64 + kq * 4); const float v = Lv[t * 32 + rl];
            float d = (S0 * kk4.x + S1 * kk4.y) + (S2 * kk4.z + S3 * kk4.w); d = red16(d); const float sa = -d;
            S0 = S0 * w4.x + (sa * b4.x + v * k4.x); S1 = S1 * w4.y + (sa * b4.y + v * k4.y); S2 = S2 * w4.z + (sa * b4.z + v * k4.z); S3 = S3 * w4.w + (sa * b4.w + v * k4.w);
            float y = (S0 * r4.x + S1 * r4.y) + (S2 * r4.z + S3 * r4.w); y = red16(y);
            if (kq == 0) Ly[t * 32 + rl] = y;
        }
        __syncthreads();
        *(f32x4*)(YR + (rowbase + t0 + vt) * BW + colh + 32 * half + vc) = *(const LAS f32x4*)(Ly + vt * 32 + vc);
    }
#undef SCAN_LOAD
}

__device__ __forceinline__ void glds16(const void* gsrc, unsigned lds_dst) { unsigned keep;
    asm volatile("s_mov_b32 %0, m0\n\ts_mov_b32 m0, %2\n\ts_nop 0\n\tglobal_load_lds_dwordx4 %1, off\n\ts_mov_b32 m0, %0" : "=&s"(keep) : "v"(gsrc), "s"(lds_dst) : "memory"); }
__device__ __forceinline__ void glds4(const void* gsrc, unsigned lds_dst) { unsigned keep;
    asm volatile("s_mov_b32 %0, m0\n\ts_mov_b32 m0, %2\n\ts_nop 0\n\tglobal_load_lds_dword %1, off\n\ts_mov_b32 m0, %0" : "=&s"(keep) : "v"(gsrc), "s"(lds_dst) : "memory"); }
constexpr int SCAN_T = 8, SCAN_SLOT = 5 * SCAN_T * 256 + 512, SCAN_NSLOT = 3, SCAN_RING = SCAN_NSLOT * SCAN_SLOT;
typedef float f32x2 __attribute__((ext_vector_type(2)));
__device__ __forceinline__ void scan_wave(int lane, LAS unsigned char* ring, int hs, int r0, unsigned char* ws) {
    const int b = hs / 12, h = hs % 12;
    const float* SR = (const float*)(ws + WS_SR); const float* SW = (const float*)(ws + WS_SW); const float* SK = (const float*)(ws + WS_SK); const float* SU = (const float*)(ws + WS_SKK);
    const float* SB = (const float*)(ws + WS_SB); const float* SV = (const float*)(ws + WS_SV); const float* BK = (const float*)(ws + WS_BK); float* YR = (float*)(ws + WS_YRAW);
    const int rg = lane >> 4, kq = lane & 15;
    const size_t rowbase = (size_t)b * SEQ; const int colh = h * 64;
    const unsigned ring0 = (unsigned)(size_t)ring;
    const size_t voff = ((size_t)(lane >> 4)) * BW + colh + 4 * kq;
    const size_t vvoff = ((size_t)((lane & 31) >> 2)) * BW + colh + r0 + (lane & 3);
    const size_t bkoff = ((size_t)((lane & 15) >> 1) * 12 + h) * 2 + (lane & 1);
    constexpr int NCH = SEQ / SCAN_T;
#define SCAN_DMA(ch, slot) do { const int cc_ = (ch) < NCH ? (ch) : NCH - 1; const size_t tok_ = rowbase + (size_t)cc_ * SCAN_T; const unsigned sl_ = ring0 + (unsigned)(slot) * SCAN_SLOT; \
        _Pragma("unroll") for (int i_ = 0; i_ < 2; ++i_) { const size_t o_ = (tok_ + 4 * i_) * BW + voff; \
            glds16(SU + o_, sl_ + 0 * 2048 + i_ * 1024); glds16(SW + o_, sl_ + 1 * 2048 + i_ * 1024); glds16(SB + o_, sl_ + 2 * 2048 + i_ * 1024); glds16(SK + o_, sl_ + 3 * 2048 + i_ * 1024); glds16(SR + o_, sl_ + 4 * 2048 + i_ * 1024); } \
        glds4(SV + tok_ * BW + vvoff, sl_ + 10240); glds4(BK + tok_ * 24 + bkoff, sl_ + 10496); } while (0)
    SCAN_DMA(0, 0); SCAN_DMA(1, 1); SCAN_DMA(2, 2);
    f32x2 S01 = (f32x2){0.f, 0.f}, S23 = (f32x2){0.f, 0.f};
    float e_cur = 0.f, sa_prev = 0.f, v_prev = 0.f;
    int slot = 0;
    for (int ch = 0; ch < NCH; ++ch) {
        asm volatile("s_waitcnt vmcnt(24)" ::: "memory");
        const LAS unsigned char* sp = ring + slot * SCAN_SLOT;
        float ykeep = 0.f;
        f32x4 u4a[SCAN_T], w4a[SCAN_T], b4a[SCAN_T], k4a[SCAN_T], r4a[SCAN_T]; float va[SCAN_T]; f32x2 bka[SCAN_T];
#pragma unroll
        for (int tt = 0; tt < SCAN_T; ++tt) {
            u4a[tt] = *(const LAS f32x4*)(sp + 0 * 2048 + tt * 256 + kq * 16); bka[tt] = *(const LAS f32x2*)(sp + 10496 + tt * 8); va[tt] = *(const LAS float*)(sp + 10240 + tt * 16 + rg * 4);
            w4a[tt] = *(const LAS f32x4*)(sp + 1 * 2048 + tt * 256 + kq * 16); b4a[tt] = *(const LAS f32x4*)(sp + 2 * 2048 + tt * 256 + kq * 16);
            k4a[tt] = *(const LAS f32x4*)(sp + 3 * 2048 + tt * 256 + kq * 16); r4a[tt] = *(const LAS f32x4*)(sp + 4 * 2048 + tt * 256 + kq * 16); }
#pragma unroll
        for (int tt = 0; tt < SCAN_T; ++tt) {
            const f32x4 u4 = u4a[tt], w4 = w4a[tt], b4 = b4a[tt], k4 = k4a[tt], r4 = r4a[tt]; const float v = va[tt]; const f32x2 bk = bka[tt];
            f32x2 pe = S01 * (f32x2){u4.x, u4.y}; pe = S23 * (f32x2){u4.z, u4.w} + pe; const float e_next = red16(pe.x + pe.y);
            const float d = e_cur + sa_prev * bk.x + v_prev * bk.y; const float sa = -d;
            const f32x2 sav = (f32x2){sa, sa}, vv = (f32x2){v, v};
            S01 = S01 * (f32x2){w4.x, w4.y} + (sav * (f32x2){b4.x, b4.y} + vv * (f32x2){k4.x, k4.y});
            S23 = S23 * (f32x2){w4.z, w4.w} + (sav * (f32x2){b4.z, b4.w} + vv * (f32x2){k4.z, k4.w});
            f32x2 py = S01 * (f32x2){r4.x, r4.y}; py = S23 * (f32x2){r4.z, r4.w} + py; const float y = red16(py.x + py.y);
            ykeep = (kq == tt) ? y : ykeep;
            e_cur = e_next; sa_prev = sa; v_prev = v;
        }
        if (kq < SCAN_T) YR[(rowbase + (size_t)ch * SCAN_T + kq) * BW + colh + r0 + rg] = ykeep;
        SCAN_DMA(ch + 3, slot);
        slot = (slot == SCAN_NSLOT - 1) ? 0 : slot + 1;
    }
    asm volatile("s_waitcnt vmcnt(0)" ::: "memory");
#undef SCAN_DMA
}

constexpr int SH_T = 8, SH_SLOT = 10240 + 1024 + 256, SH_NSLOT = 11, SH_D = 4, SH_FLAGS = SCANRING_OFF + SH_NSLOT * SH_SLOT;
static_assert(SH_FLAGS + 64 <= LDSCTL_OFF, "scan ring + flags fit below the LDS control words");
__device__ __forceinline__ unsigned lds_ld(volatile LAS unsigned* p) { return *p; }
__device__ __forceinline__ void scan_loader(int lane, LAS unsigned char* lds, int hs, int rblk, unsigned char* ws) {
    const int b = hs / 12, h = hs % 12;
    const float* SR = (const float*)(ws + WS_SR); const float* SW = (const float*)(ws + WS_SW); const float* SK = (const float*)(ws + WS_SK); const float* SU = (const float*)(ws + WS_SKK);
    const float* SB = (const float*)(ws + WS_SB); const float* SV = (const float*)(ws + WS_SV); const float* BK = (const float*)(ws + WS_BK);
    const size_t rowbase = (size_t)b * SEQ; const int colh = h * 64;
    const unsigned ring0 = (unsigned)(size_t)(lds + SCANRING_OFF);
    volatile LAS unsigned* flags = (volatile LAS unsigned*)(lds + SH_FLAGS);
    const size_t voff = ((size_t)(lane >> 4)) * BW + colh + 4 * (lane & 15);
    const size_t vvoff = ((size_t)((lane >> 2) & 7)) * BW + colh + rblk + 4 * (lane & 3);
    const size_t bkoff = ((size_t)((lane & 15) >> 1) * 12 + h) * 2 + (lane & 1);
    constexpr int NCH = SEQ / SH_T;
    int slot = 0;
    for (int c = 0; c < NCH; ++c) {
        if (c >= SH_NSLOT) { const unsigned need = (unsigned)(c - SH_NSLOT + 1);
            while (lds_ld(flags + 1) < need || lds_ld(flags + 2) < need || lds_ld(flags + 3) < need || lds_ld(flags + 4) < need) __builtin_amdgcn_s_sleep(1); }
        const size_t tok = rowbase + (size_t)c * SH_T; const unsigned sl = ring0 + (unsigned)slot * SH_SLOT;
#pragma unroll
        for (int i = 0; i < 2; ++i) { const size_t o = (tok + 4 * i) * BW + voff;
            glds16(SU + o, sl + 0 * 2048 + i * 1024); glds16(SW + o, sl + 1 * 2048 + i * 1024); glds16(SB + o, sl + 2 * 2048 + i * 1024); glds16(SK + o, sl + 3 * 2048 + i * 1024); glds16(SR + o, sl + 4 * 2048 + i * 1024); }
        glds16(SV + tok * BW + vvoff, sl + 10240); glds4(BK + tok * 24 + bkoff, sl + 11264);
        if (c >= SH_D) { asm volatile("s_waitcnt vmcnt(48)" ::: "memory"); if (lane == 0) flags[0] = (unsigned)(c - SH_D + 1); }
        slot = (slot == SH_NSLOT - 1) ? 0 : slot + 1;
    }
    asm volatile("s_waitcnt vmcnt(0)" ::: "memory"); if (lane == 0) flags[0] = (unsigned)NCH;
}
__device__ __forceinline__ void scan_wave_sh(int lane, int w, LAS unsigned char* lds, int hs, int rblk, unsigned char* ws) {
    const int b = hs / 12, h = hs % 12; float* YR = (float*)(ws + WS_YRAW);
    const int rg = lane >> 4, kq = lane & 15, r0 = rblk + 4 * w;
    const size_t rowbase = (size_t)b * SEQ; const int colh = h * 64;
    volatile LAS unsigned* flags = (volatile LAS unsigned*)(lds + SH_FLAGS);
    constexpr int NCH = SEQ / SH_T;
    f32x2 S01 = (f32x2){0.f, 0.f}, S23 = (f32x2){0.f, 0.f};
    float e_cur = 0.f, sa_prev = 0.f, v_prev = 0.f;
    int slot = 0;
    for (int ch = 0; ch < NCH; ++ch) {
        while (lds_ld(flags) <= (unsigned)ch) __builtin_amdgcn_s_sleep(1);
        asm volatile("" ::: "memory");
        const LAS unsigned char* sp = lds + SCANRING_OFF + slot * SH_SLOT;
        float ykeep = 0.f;
        f32x4 u4a[SH_T], w4a[SH_T], b4a[SH_T], k4a[SH_T], r4a[SH_T]; float va[SH_T]; f32x2 bka[SH_T];
#pragma unroll
        for (int tt = 0; tt < SH_T; ++tt) {
            u4a[tt] = *(const LAS f32x4*)(sp + 0 * 2048 + tt * 256 + kq * 16); bka[tt] = *(const LAS f32x2*)(sp + 11264 + tt * 8); va[tt] = *(const LAS float*)(sp + 10240 + tt * 64 + (w * 4 + rg) * 4);
            w4a[tt] = *(const LAS f32x4*)(sp + 1 * 2048 + tt * 256 + kq * 16); b4a[tt] = *(const LAS f32x4*)(sp + 2 * 2048 + tt * 256 + kq * 16);
            k4a[tt] = *(const LAS f32x4*)(sp + 3 * 2048 + tt * 256 + kq * 16); r4a[tt] = *(const LAS f32x4*)(sp + 4 * 2048 + tt * 256 + kq * 16); }
#pragma unroll
        for (int tt = 0; tt < SH_T; ++tt) {
            const f32x4 u4 = u4a[tt], w4 = w4a[tt], b4 = b4a[tt], k4 = k4a[tt], r4 = r4a[tt]; const float v = va[tt]; const f32x2 bk = bka[tt];
            f32x2 pe = S01 * (f32x2){u4.x, u4.y}; pe = S23 * (f32x2){u4.z, u4.w} + pe; const float e_next = red16(pe.x + pe.y);
            const float d = e_cur + sa_prev * bk.x + v_prev * bk.y; const float sa = -d;
            const f32x2 sav = (f32x2){sa, sa}, vv = (f32x2){v, v};
            S01 = S01 * (f32x2){w4.x, w4.y} + (sav * (f32x2){b4.x, b4.y} + vv * (f32x2){k4.x, k4.y});
            S23 = S23 * (f32x2){w4.z, w4.w} + (sav * (f32x2){b4.z, b4.w} + vv * (f32x2){k4.z, k4.w});
            f32x2 py = S01 * (f32x2){r4.x, r4.y}; py = S23 * (f32x2){r4.z, r4.w} + py; const float y = red16(py.x + py.y);
            ykeep = (kq == tt) ? y : ykeep;
            e_cur = e_next; sa_prev = sa; v_prev = v;
        }
        if (kq < SH_T) YR[(rowbase + (size_t)ch * SH_T + kq) * BW + colh + r0 + rg] = ykeep;
        asm volatile("" ::: "memory");
        if (lane == 0) flags[1 + w] = (unsigned)(ch + 1);
        slot = (slot == SH_NSLOT - 1) ? 0 : slot + 1;
    }
}

constexpr int CH_REC = COP_RY * 4;
constexpr int CH_SLOT = CH_REC + 4096, CH_NSLOT = 6, CH_D = 4, CH_FLAGS = SCANRING_OFF + CH_NSLOT * CH_SLOT;
static_assert(CH_FLAGS + 64 <= LDSCTL_OFF, "chain ring + flags fit below the LDS control words");
__device__ __forceinline__ float* sst_base(unsigned char* ws, int hs) { return (float*)(ws + (hs < 16 ? WS_SST_A + (size_t)hs * 8 * MiB : WS_SST_B + (size_t)(hs - 16) * 8 * MiB)); }
__device__ __forceinline__ void chain_loader(int lane, int which, LAS unsigned char* lds, int hs, unsigned char* ws) {
    const int b = hs / 12, h = hs % 12;
    const float* COP = (const float*)(ws + WS_COP) + (size_t)hs * 512 * COP_STRIDE; const float* SV = (const float*)(ws + WS_SV);
    const unsigned ring0 = (unsigned)(size_t)(lds + SCANRING_OFF);
    volatile LAS unsigned* flags = (volatile LAS unsigned*)(lds + CH_FLAGS);
    const int fidx = which == 0 ? 0 : 4 + which;
    const size_t vsrc = ((size_t)b * SEQ + (lane >> 4)) * BW + h * 64 + 4 * (lane & 15);
    int slot = 0;
    for (int c = 0; c < 512; ++c) {
        if (c >= CH_NSLOT) { const unsigned need = (unsigned)(c - CH_NSLOT + 1);
            while (lds_ld(flags + 1) < need || lds_ld(flags + 2) < need || lds_ld(flags + 3) < need || lds_ld(flags + 4) < need) __builtin_amdgcn_s_sleep(1); }
        const float* rec = COP + (size_t)c * COP_STRIDE; const unsigned sl = ring0 + (unsigned)slot * CH_SLOT;
        if (which < 2) {
#pragma unroll
            for (int i = 0; i < 5; ++i) glds16(rec + (5 * which + i) * 256 + lane * 4, sl + (5 * which + i) * 1024);
            if (c >= CH_D) { asm volatile("s_waitcnt vmcnt(20)" ::: "memory"); if (lane == 0) flags[fidx] = (unsigned)(c - CH_D + 1); }
        } else if (which == 2) {
#pragma unroll
            for (int i = 10; i < 14; ++i) glds16(rec + i * 256 + lane * 4, sl + i * 1024);
            glds4(rec + COP_GAM + lane, sl + 14 * 1024);
            if (c >= CH_D) { asm volatile("s_waitcnt vmcnt(20)" ::: "memory"); if (lane == 0) flags[fidx] = (unsigned)(c - CH_D + 1); }
        } else {
#pragma unroll
            for (int i = 0; i < 4; ++i) glds16(SV + vsrc + (size_t)(c * 16 + 4 * i) * BW, sl + CH_REC + i * 1024);
            if (c >= CH_D) { asm volatile("s_waitcnt vmcnt(16)" ::: "memory"); if (lane == 0) flags[fidx] = (unsigned)(c - CH_D + 1); }
        }
        slot = (slot == CH_NSLOT - 1) ? 0 : slot + 1;
    }
    asm volatile("s_waitcnt vmcnt(0)" ::: "memory"); if (lane == 0) flags[fidx] = 512u;
}
#define MFMAB(a, b, c) __builtin_amdgcn_mfma_f32_16x16x32_bf16(__builtin_bit_cast(pg8::bf16x8, (a)), __builtin_bit_cast(pg8::bf16x8, (b)), (c), 0, 0, 0)
__device__ __forceinline__ void scan_chain(int lane, int vs, LAS unsigned char* lds, int hs, unsigned char* ws) {
    const int li = lane & 15, q = lane >> 4;
    volatile LAS unsigned* flags = (volatile LAS unsigned*)(lds + CH_FLAGS);
    f32x4c St[4];
#pragma unroll
    for (int m = 0; m < 4; ++m) St[m] = (f32x4c){0.f, 0.f, 0.f, 0.f};
    float* sst = sst_base(ws, hs) + ((size_t)vs * 64 + lane) * 16;
    int slot = 0;
    for (int c = 0; c < 512; ++c) {
        while (lds_ld(flags) <= (unsigned)c || lds_ld(flags + 5) <= (unsigned)c || lds_ld(flags + 6) <= (unsigned)c || lds_ld(flags + 7) <= (unsigned)c) __builtin_amdgcn_s_sleep(1);
        asm volatile("" ::: "memory");
        const LAS unsigned* sp = (const LAS unsigned*)(lds + SCANRING_OFF + slot * CH_SLOT);
        v4u w1h[2], w1l[2], bkh[4], bkl[4]; f32x4 gf[4]; float vc[4];
#pragma unroll
        for (int kb = 0; kb < 2; ++kb) { w1h[kb] = *(const LAS v4u*)(sp + COP_W1 + lane * 16 + 8 * kb); w1l[kb] = *(const LAS v4u*)(sp + COP_W1 + lane * 16 + 8 * kb + 4); }
        const v4u u0h = *(const LAS v4u*)(sp + COP_U0 + lane * 8), u0l = *(const LAS v4u*)(sp + COP_U0 + lane * 8 + 4);
#pragma unroll
        for (int m = 0; m < 4; ++m) { bkh[m] = *(const LAS v4u*)(sp + COP_BK + lane * 32 + 8 * m); bkl[m] = *(const LAS v4u*)(sp + COP_BK + lane * 32 + 8 * m + 4); gf[m] = *(const LAS f32x4*)((const LAS float*)sp + COP_GAM + 16 * m + 4 * q); }
#pragma unroll
        for (int s_ = 0; s_ < 4; ++s_) vc[s_] = ((const LAS float*)sp)[COP_RY + (4 * q + s_) * 64 + 16 * vs + li];
        v4u sh[2], sl_[2];
#pragma unroll
        for (int kb = 0; kb < 2; ++kb) { float x[8];
#pragma unroll
            for (int jj = 0; jj < 8; ++jj) x[jj] = St[2 * kb + (jj >> 2)][jj & 3];
            split8(x, sh[kb], sl_[kb]); }
        v4u vh, vl; { float x[8] = {vc[0], vc[1], vc[2], vc[3], 0.f, 0.f, 0.f, 0.f}; split8(x, vh, vl); }
#pragma unroll
        for (int m = 0; m < 4; ++m) *(f32x4*)(sst + (size_t)c * 4096 + 4 * m) = St[m];
        f32x4c z0 = {0.f, 0.f, 0.f, 0.f}, z1 = {0.f, 0.f, 0.f, 0.f}, z2 = {0.f, 0.f, 0.f, 0.f};
        z0 = MFMAB(w1h[0], sh[0], z0); z1 = MFMAB(w1h[0], sl_[0], z1); z2 = MFMAB(w1l[0], sh[0], z2);
        z0 = MFMAB(w1h[1], sh[1], z0); z1 = MFMAB(w1h[1], sl_[1], z1); z2 = MFMAB(w1l[1], sh[1], z2);
        z0 = MFMAB(u0h, vh, z0); z1 = MFMAB(u0h, vl, z1); z2 = MFMAB(u0l, vh, z2);
#pragma unroll
        for (int m = 0; m < 4; ++m) St[m] *= gf[m];
        const f32x4c z = z0 + (z1 + z2);
        v4u zh, zl; { float x[8] = {z[0], z[1], z[2], z[3], vc[0], vc[1], vc[2], vc[3]}; split8(x, zh, zl); }
#pragma unroll
        for (int m = 0; m < 4; ++m) St[m] = MFMAB(bkh[m], zh, St[m]);
#pragma unroll
        for (int m = 0; m < 4; ++m) St[m] = MFMAB(bkh[m], zl, St[m]);
#pragma unroll
        for (int m = 0; m < 4; ++m) St[m] = MFMAB(bkl[m], zh, St[m]);
        asm volatile("" ::: "memory");
        if (lane == 0) flags[1 + vs] = (unsigned)(c + 1);
        slot = (slot == CH_NSLOT - 1) ? 0 : slot + 1;
    }
}

struct AttnPass { int qcol; int bias_head; int tbl; float sink; int use_sink; int maxsteps; bf16* out; int out_ld; int out_col; float* lse; };
__device__ __forceinline__ void attn_stage_kv(const Ctx& C, const bf16* P1, int b, int res, int dil, int fblk, int kcol, int vcol) {
    LAS unsigned char* Ks = C.lds + RING_OFF; LAS unsigned char* Vs = Ks + 256 * 144;
#pragma unroll
    for (int i = 0; i < 4; ++i) { const int c = C.tid + 512 * i, row = c >> 3, part = c & 7; const int fp = (fblk - 1) * 128 + row;
        v4u kv = (v4u){0u, 0u, 0u, 0u}, vv = (v4u){0u, 0u, 0u, 0u};
        if (fp >= 0) { const bf16* src = P1 + ((size_t)b * SEQ + (size_t)fp * dil + res) * NP1; kv = *(const v4u*)(src + kcol + part * 8); vv = *(const v4u*)(src + vcol + part * 8); }
        *(LAS v4u*)(Ks + row * 144 + part * 16) = kv; *(LAS v4u*)(Vs + row * 144 + part * 16) = vv; }
}
__device__ __forceinline__ void attn_pass(const Ctx& C, const bf16* P1, const float* relb, int b, int res, int dil, int fblk, const AttnPass& ap) {
    LAS unsigned char* Ks = C.lds + RING_OFF; LAS unsigned char* Vs = Ks + 256 * 144; LAS float* lut = (LAS float*)(Vs + 256 * 144);
    __syncthreads();
    if (C.tid < 132) lut[C.tid] = (C.tid <= 128) ? relb[(int)T5B[ap.tbl][C.tid] * 20 + ap.bias_head] : 0.f;
    __syncthreads();
    const int i = C.tid >> 2, dq = C.tid & 3;
    const size_t tok = (size_t)b * SEQ + (size_t)(fblk * 128 + i) * dil + res;
    float q[16];
    { const bf16* qp = P1 + tok * NP1 + ap.qcol + dq * 16; const v4u a0 = *(const v4u*)qp, a1 = *(const v4u*)(qp + 8);
      q[0] = bflo(a0.x); q[1] = bfhi(a0.x); q[2] = bflo(a0.y); q[3] = bfhi(a0.y); q[4] = bflo(a0.z); q[5] = bfhi(a0.z); q[6] = bflo(a0.w); q[7] = bfhi(a0.w);
      q[8] = bflo(a1.x); q[9] = bfhi(a1.x); q[10] = bflo(a1.y); q[11] = bfhi(a1.y); q[12] = bflo(a1.z); q[13] = bfhi(a1.z); q[14] = bflo(a1.w); q[15] = bfhi(a1.w);
#pragma unroll
      for (int j = 0; j < 16; ++j) q[j] *= 0.125f; }
    float mrun = ap.use_sink ? ap.sink : -INFINITY, lrun = ap.use_sink ? 1.0f : 0.0f;
    float o[16];
#pragma unroll
    for (int j = 0; j < 16; ++j) o[j] = 0.f;
    const int fq0 = fblk * 128 + i;
    for (int dist = 0; dist <= ap.maxsteps; ++dist) {
        const int kr = i + 128 - dist;
        const bool valid = (fq0 - dist) >= 0;
        const v4u k0 = *(const LAS v4u*)(Ks + kr * 144 + dq * 32), k1 = *(const LAS v4u*)(Ks + kr * 144 + dq * 32 + 16);
        float s = q[0] * bflo(k0.x) + q[1] * bfhi(k0.x) + q[2] * bflo(k0.y) + q[3] * bfhi(k0.y) + q[4] * bflo(k0.z) + q[5] * bfhi(k0.z) + q[6] * bflo(k0.w) + q[7] * bfhi(k0.w)
                + q[8] * bflo(k1.x) + q[9] * bfhi(k1.x) + q[10] * bflo(k1.y) + q[11] * bfhi(k1.y) + q[12] * bflo(k1.z) + q[13] * bfhi(k1.z) + q[14] * bflo(k1.w) + q[15] * bfhi(k1.w);
        s = red4(s) + lut[dist];
        if (valid) {
            if (s > mrun) { const float c = __expf(mrun - s); lrun *= c;
#pragma unroll
                for (int j = 0; j < 16; ++j) o[j] *= c;
                mrun = s; }
            const float p = __expf(s - mrun); lrun += p;
            const v4u v0 = *(const LAS v4u*)(Vs + kr * 144 + dq * 32), v1 = *(const LAS v4u*)(Vs + kr * 144 + dq * 32 + 16);
            o[0] += p * bflo(v0.x); o[1] += p * bfhi(v0.x); o[2] += p * bflo(v0.y); o[3] += p * bfhi(v0.y); o[4] += p * bflo(v0.z); o[5] += p * bfhi(v0.z); o[6] += p * bflo(v0.w); o[7] += p * bfhi(v0.w);
            o[8] += p * bflo(v1.x); o[9] += p * bfhi(v1.x); o[10] += p * bflo(v1.y); o[11] += p * bfhi(v1.y); o[12] += p * bflo(v1.z); o[13] += p * bfhi(v1.z); o[14] += p * bflo(v1.w); o[15] += p * bfhi(v1.w);
        }
    }
    const float inv = 1.0f / lrun;
    v4u w0, w1;
    w0.x = pk2(o[0] * inv, o[1] * inv); w0.y = pk2(o[2] * inv, o[3] * inv); w0.z = pk2(o[4] * inv, o[5] * inv); w0.w = pk2(o[6] * inv, o[7] * inv);
    w1.x = pk2(o[8] * inv, o[9] * inv); w1.y = pk2(o[10] * inv, o[11] * inv); w1.z = pk2(o[12] * inv, o[13] * inv); w1.w = pk2(o[14] * inv, o[15] * inv);
    bf16* op = ap.out + tok * ap.out_ld + ap.out_col + dq * 16;
    *(v4u*)op = w0; *(v4u*)(op + 8) = w1;
    if (ap.lse && dq == 0) ap.lse[tok * 4] = mrun + __logf(lrun);
}
__device__ __forceinline__ void phase_attn(const Ctx& C, const Args& a, int l, unsigned char* ws, int ab, int nab) {
    const bf16* P1 = (const bf16*)(ws + WS_P1); const float* relb = a.in[1]; const float* sinks = a.in[4] + l * 8;
    bf16* YA = (bf16*)(ws + WS_YA); bf16* OC = (bf16*)(ws + WS_OC); float* LSE = (float*)(ws + WS_LSE);
    constexpr int NA = 256, NC = 1536;
    for (int it = ab; it < NA + NC; it += nab) {
        __syncthreads();
        if (it < NA) {
            const int b = it >> 7, fblk = (it >> 1) & 63, hkv = it & 1;
            attn_stage_kv(C, P1, b, 0, 1, fblk, C_AK + hkv * 64, C_AV + hkv * 64);
            for (int g = 0; g < 4; ++g) { const int hq = hkv * 4 + g;
                AttnPass ap; ap.qcol = C_AQ + hq * 64; ap.bias_head = hq; ap.tbl = 0; ap.sink = sinks[hq]; ap.use_sink = 1; ap.maxsteps = 127; ap.out = YA; ap.out_ld = 512; ap.out_col = hq * 64; ap.lse = nullptr;
                attn_pass(C, P1, relb, b, 0, 1, fblk, ap); }
        } else {
            const int ci = it - NA; const int gi = ci / 512, j = (ci >> 7) & 3, qb = ci & 127;
            const int dil = (gi == 0) ? 1 : (gi == 1 ? 4 : 16); const int bps = 64 / dil;
            const int n = qb / bps, fblk = qb % bps, b = n / dil, res = n % dil; const int hc = gi * 4 + j;
            attn_stage_kv(C, P1, b, res, dil, fblk, C_CK + hc * 64, C_CV + hc * 64);
            AttnPass ap; ap.qcol = C_CQ + hc * 64; ap.bias_head = 8 + hc; ap.tbl = gi; ap.sink = 0.f; ap.use_sink = 0; ap.maxsteps = 128; ap.out = OC + (size_t)gi * M * 256; ap.out_ld = 256; ap.out_col = j * 64;
            ap.lse = LSE + (size_t)gi * M * 4 + j;
            attn_pass(C, P1, relb, b, res, dil, fblk, ap);
        }
    }
}

__device__ __forceinline__ void phase_vt(const Ctx& C, unsigned char* ws) {
    const bf16* P1 = (const bf16*)(ws + WS_P1); bf16* VT = (bf16*)(ws + WS_VT);
    for (int it = C.gw; it < 14 * 2 * 128; it += C.ngw) {
        const int hs = it / 256, b = (it >> 7) & 1, blk = it & 127;
        const int gi = hs < 2 ? 0 : (hs - 2) >> 2; const int dil = gi == 0 ? 1 : (gi == 1 ? 4 : 16); const int Lf = SEQ / dil;
        const int vcol = hs < 2 ? C_AV + hs * 64 : C_CV + (hs - 2) * 64;
        const int ft = blk * 64 + C.lane;
        const int res = ft / Lf, tp = ft % Lf; const int tok = b * SEQ + tp * dil + res;
        const v4u* src = (const v4u*)(P1 + (size_t)tok * NP1 + vcol);
        v4u x[8];
#pragma unroll
        for (int i = 0; i < 8; ++i) x[i] = src[i];
        bf16* dst = VT + ((size_t)(hs * 2 + b) * 64) * SEQ + ft;
#pragma unroll
        for (int i = 0; i < 8; ++i) {
            dst[(size_t)(8 * i + 0) * SEQ] = (bf16)(x[i].x & 0xffffu); dst[(size_t)(8 * i + 1) * SEQ] = (bf16)(x[i].x >> 16);
            dst[(size_t)(8 * i + 2) * SEQ] = (bf16)(x[i].y & 0xffffu); dst[(size_t)(8 * i + 3) * SEQ] = (bf16)(x[i].y >> 16);
            dst[(size_t)(8 * i + 4) * SEQ] = (bf16)(x[i].z & 0xffffu); dst[(size_t)(8 * i + 5) * SEQ] = (bf16)(x[i].z >> 16);
            dst[(size_t)(8 * i + 6) * SEQ] = (bf16)(x[i].w & 0xffffu); dst[(size_t)(8 * i + 7) * SEQ] = (bf16)(x[i].w >> 16);
        }
    }
}

typedef float f32x16 __attribute__((ext_vector_type(16)));
__device__ __forceinline__ void attn_wave_item(int lane, const LAS float* lutall, int item, const float* sinks, unsigned char* ws) {
    const bf16* P1 = (const bf16*)(ws + WS_P1); const bf16* VT = (const bf16*)(ws + WS_VT);
    const int hh = item % 20, g32 = item / 20;
    const bool isA = hh < 8; const int hc = hh - 8; const int gi = isA ? 0 : hc >> 2, j = hc & 3;
    const int dil = gi == 0 ? 1 : (gi == 1 ? 4 : 16); const int Lf = SEQ / dil, gps = Lf / 32;
    const int b = g32 >> 8, rr = g32 & 255, res = rr / gps, qg = rr % gps, fq0 = qg * 32;
    const int qcol = isA ? C_AQ + hh * 64 : C_CQ + hc * 64, kcol = isA ? C_AK + (hh >> 2) * 64 : C_CK + hc * 64;
    const int hs = isA ? (hh >> 2) : 2 + hc;
    const int r = lane & 31, hf = lane >> 5;
    const LAS float* lut = lutall + hh * 192 + (31 - r + 8 * hf);
    const int pr = (r & 0x13) | ((r & 8) >> 1) | ((r & 4) << 1);
    const size_t tokq = (size_t)b * SEQ + (size_t)(fq0 + r) * dil + res;
    pg8::bf16x8 qf[4];
    { const bf16* qrow = P1 + tokq * NP1 + qcol + 8 * hf;
#pragma unroll
      for (int s_ = 0; s_ < 4; ++s_) qf[s_] = *(const pg8::bf16x8*)(qrow + 16 * s_); }
    f32x16 sc[5];
#pragma unroll
    for (int kt = 0; kt < 5; ++kt) {
        int fk = fq0 - 128 + 32 * kt + pr; fk = fk < 0 ? 0 : fk;
        const bf16* krow = P1 + ((size_t)b * SEQ + (size_t)fk * dil + res) * NP1 + kcol + 8 * hf;
        f32x16 acc;
#pragma unroll
        for (int q = 0; q < 16; ++q) acc[q] = 0.f;
#pragma unroll
        for (int s_ = 0; s_ < 4; ++s_) { const pg8::bf16x8 a = *(const pg8::bf16x8*)(krow + 16 * s_); acc = __builtin_amdgcn_mfma_f32_32x32x16_bf16(a, qf[s_], acc, 0, 0, 0); }
        sc[kt] = acc;
    }
    float mx = -1e30f;
#pragma unroll
    for (int kt = 0; kt < 5; ++kt)
#pragma unroll
        for (int q = 0; q < 16; ++q) { const int koff = (q & 3) + 4 * ((q >> 2) & 1) + 16 * (q >> 3);
            const float sv = sc[kt][q] * 0.125f + lut[32 * kt + koff]; sc[kt][q] = sv; }
    if (fq0 < 128) {
#pragma unroll
        for (int kt = 0; kt < 5; ++kt)
#pragma unroll
            for (int q = 0; q < 16; ++q) { const int koff = (q & 3) + 4 * ((q >> 2) & 1) + 16 * (q >> 3) + 8 * hf; if (fq0 - 128 + 32 * kt + koff < 0) sc[kt][q] = -1e30f; }
    }
#pragma unroll
    for (int kt = 0; kt < 5; ++kt)
#pragma unroll
        for (int q = 0; q < 16; ++q) mx = fmaxf(mx, sc[kt][q]);
    mx = fmaxf(mx, __shfl_xor(mx, 32));
    const float sink = isA ? sinks[hh] : -1e30f;
    mx = fmaxf(mx, sink);
    float lsum = 0.f;
#pragma unroll
    for (int kt = 0; kt < 5; ++kt)
#pragma unroll
        for (int q = 0; q < 16; ++q) { const float pv = __expf(sc[kt][q] - mx); sc[kt][q] = pv; lsum += pv; }
    lsum += __shfl_xor(lsum, 32);
    const float denom = isA ? lsum + __expf(sink - mx) : lsum;
    const float inv = 1.0f / denom;
    pg8::bf16x8 pf[5][2];
#pragma unroll
    for (int kt = 0; kt < 5; ++kt)
#pragma unroll
        for (int s_ = 0; s_ < 2; ++s_) { pg8::u32x4 w;
            w.x = pg8::cvt_pk_bf16(sc[kt][8 * s_ + 0], sc[kt][8 * s_ + 1]); w.y = pg8::cvt_pk_bf16(sc[kt][8 * s_ + 2], sc[kt][8 * s_ + 3]);
            w.z = pg8::cvt_pk_bf16(sc[kt][8 * s_ + 4], sc[kt][8 * s_ + 5]); w.w = pg8::cvt_pk_bf16(sc[kt][8 * s_ + 6], sc[kt][8 * s_ + 7]);
            pf[kt][s_] = __builtin_bit_cast(pg8::bf16x8, w); }
    bf16* outp; int out_ld, ocol;
    if (isA) { outp = (bf16*)(ws + WS_YA); out_ld = 1536; ocol = hh * 64; } else { outp = (bf16*)(ws + WS_OC) + (size_t)gi * M * 256; out_ld = 256; ocol = j * 64; }
    const bf16* vth = VT + ((size_t)(hs * 2 + b) * 64) * SEQ + (size_t)res * Lf;
#pragma unroll
    for (int dt = 0; dt < 2; ++dt) {
        const bf16* vrow = vth + (size_t)(32 * dt + r) * SEQ;
        f32x16 acc;
#pragma unroll
        for (int q = 0; q < 16; ++q) acc[q] = 0.f;
#pragma unroll
        for (int kt = 0; kt < 5; ++kt)
#pragma unroll
            for (int s_ = 0; s_ < 2; ++s_) {
                int k0 = fq0 - 128 + 32 * kt + 16 * s_ + 8 * hf; k0 = k0 < 0 ? 0 : k0;
                acc = __builtin_amdgcn_mfma_f32_32x32x16_bf16(*(const pg8::bf16x8*)(vrow + k0), pf[kt][s_], acc, 0, 0, 0);
            }
        bf16* op = outp + tokq * out_ld + ocol + 32 * dt + 4 * hf;
#pragma unroll
        for (int g = 0; g < 4; ++g) { v2u w; w.x = pg8::cvt_pk_bf16(acc[4 * g + 0] * inv, acc[4 * g + 1] * inv); w.y = pg8::cvt_pk_bf16(acc[4 * g + 2] * inv, acc[4 * g + 3] * inv);
            *(v2u*)(op + 8 * g) = w; }
    }
    if (!isA && hf == 0) ((float*)(ws + WS_LSE))[((size_t)gi * M + tokq) * 4 + j] = mx + __logf(lsum);
}
__device__ __forceinline__ void build_lut(const Ctx& C, const float* relb) {
    LAS float* lut = (LAS float*)(C.lds + LUT_OFF);
    for (int i = C.tid; i < 20 * 192; i += NTHREADS) { const int hh = i / 192, x = i % 192; const int tbl = hh < 8 ? 0 : (hh - 8) >> 2; const int dist = 159 - x; const int maxsteps = hh < 8 ? 127 : 128;
        lut[i] = (dist >= 0 && dist <= maxsteps) ? relb[(int)T5B[tbl][dist] * 20 + hh] : -1e30f; }
    __syncthreads();
}

__device__ __forceinline__ void phase_post(const Ctx& C, const Args& a, int l, unsigned char* ws) {
    const float* SV = (const float*)(ws + WS_SV); const float* BON = (const float*)(ws + WS_BON); const float* COP = (const float*)(ws + WS_COP);
    const float* LO = (const float*)(ws + WS_LO); bf16* YB = (bf16*)(ws + WS_YA);
    const float* lgp = a.in[14] + (size_t)l * BW; const float* lbp = a.in[15] + (size_t)l * BW;
    const int lane = C.lane, li = lane & 15, q = lane >> 4;
    for (int it = C.gw; it < 24 * 512; it += C.ngw) {
        const int hs = it >> 9, c = it & 511, b = hs / 12, h = hs % 12; const int m0 = b * SEQ + c * 16;
        const float* rec = COP + ((size_t)hs * 512 + c) * COP_STRIDE; const float* sst = sst_base(ws, hs) + (size_t)c * 4096 + (size_t)lane * 16;
        f32x4 ryf[4]; const f32x4 y0f = *(const f32x4*)(rec + COP_Y0 + lane * 4);
#pragma unroll
        for (int m = 0; m < 4; ++m) ryf[m] = *(const f32x4*)(rec + COP_RY + lane * 16 + 4 * m);
        f32x4c y[4]; float vv[4][4];
#pragma unroll
        for (int vs = 0; vs < 4; ++vs) {
            f32x4 st[4];
#pragma unroll
            for (int m = 0; m < 4; ++m) st[m] = *(const f32x4*)(sst + (size_t)vs * 1024 + 4 * m);
#pragma unroll
            for (int s_ = 0; s_ < 4; ++s_) vv[vs][s_] = SV[(size_t)(m0 + 4 * q + s_) * BW + h * 64 + 16 * vs + li];
            f32x4c acc = {0.f, 0.f, 0.f, 0.f};
#pragma unroll
            for (int m = 0; m < 4; ++m)
#pragma unroll
                for (int j = 0; j < 4; ++j) acc = MFMA4(ryf[m][j], st[m][j], acc);
#pragma unroll
            for (int s_ = 0; s_ < 4; ++s_) acc = MFMA4(y0f[s_], vv[vs][s_], acc);
            y[vs] = acc;
        }
        float lg[4], lb[4];
#pragma unroll
        for (int vs = 0; vs < 4; ++vs) { lg[vs] = lgp[h * 64 + 16 * vs + li]; lb[vs] = lbp[h * 64 + 16 * vs + li]; }
#pragma unroll
        for (int j = 0; j < 4; ++j) {
            const int m = m0 + 4 * q + j;
            const float mean = red16((y[0][j] + y[1][j]) + (y[2][j] + y[3][j])) * (1.0f / 64.0f);
            const float d0 = y[0][j] - mean, d1 = y[1][j] - mean, d2 = y[2][j] - mean, d3 = y[3][j] - mean;
            const float var = red16((d0 * d0 + d1 * d1) + (d2 * d2 + d3 * d3)) * (1.0f / 64.0f);
            const float rsd = __builtin_amdgcn_rsqf(var + GN_EPS); const float bo = BON[(size_t)m * 12 + h];
            const float* gp = LO + (size_t)m * NLORA + 2 * BW + h * 64 + li; bf16* op = YB + (size_t)m * 1536 + 512 + h * 64 + li;
            op[0] = (bf16)f2bf((d0 * rsd * lg[0] + lb[0] + vv[0][j] * bo) * gp[0]); op[16] = (bf16)f2bf((d1 * rsd * lg[1] + lb[1] + vv[1][j] * bo) * gp[16]);
            op[32] = (bf16)f2bf((d2 * rsd * lg[2] + lb[2] + vv[2][j] * bo) * gp[32]); op[48] = (bf16)f2bf((d3 * rsd * lg[3] + lb[3] + vv[3][j] * bo) * gp[48]);
        }
    }
    const bf16* OC = (const bf16*)(ws + WS_OC); const float* LSE = (const float*)(ws + WS_LSE); bf16* YC = (bf16*)(ws + WS_YA);
    for (int mb = C.gw * 4; mb < M; mb += C.ngw * 4) {
        const int j = C.lane >> 4;
        float l0[4], l1[4], l2[4]; v2u a0[4], a1[4], a2[4];
#pragma unroll
        for (int i = 0; i < 4; ++i) { const int m = mb + i; l0[i] = LSE[(size_t)m * 4 + j]; l1[i] = LSE[((size_t)M + m) * 4 + j]; l2[i] = LSE[((size_t)2 * M + m) * 4 + j];
            a0[i] = *(const v2u*)(OC + (size_t)m * 256 + 4 * C.lane); a1[i] = *(const v2u*)(OC + ((size_t)M + m) * 256 + 4 * C.lane); a2[i] = *(const v2u*)(OC + ((size_t)2 * M + m) * 256 + 4 * C.lane); }
#pragma unroll
        for (int i = 0; i < 4; ++i) { const int m = mb + i;
            const float mx = fmaxf(l0[i], fmaxf(l1[i], l2[i])); const float e0 = __expf(l0[i] - mx), e1 = __expf(l1[i] - mx), e2 = __expf(l2[i] - mx); const float inv = 1.0f / (e0 + e1 + e2);
            const float w0 = e0 * inv, w1 = e1 * inv, w2 = e2 * inv;
            v2u o; o.x = pk2(w0 * bflo(a0[i].x) + w1 * bflo(a1[i].x) + w2 * bflo(a2[i].x), w0 * bfhi(a0[i].x) + w1 * bfhi(a1[i].x) + w2 * bfhi(a2[i].x));
            o.y = pk2(w0 * bflo(a0[i].y) + w1 * bflo(a1[i].y) + w2 * bflo(a2[i].y), w0 * bfhi(a0[i].y) + w1 * bfhi(a1[i].y) + w2 * bfhi(a2[i].y));
            *(v2u*)(YC + (size_t)m * 1536 + 1280 + 4 * C.lane) = o; }
    }
}

__device__ __forceinline__ void unpack8(const v4u w, float (&x)[8]) { x[0] = bflo(w.x); x[1] = bfhi(w.x); x[2] = bflo(w.y); x[3] = bfhi(w.y); x[4] = bflo(w.z); x[5] = bfhi(w.z); x[6] = bflo(w.w); x[7] = bfhi(w.w); }
__device__ __forceinline__ void phase_conv(const Ctx& C, const Args& a, int l, unsigned char* ws) {
    const bf16* U = (const bf16*)(ws + WS_U); bf16* ACT = (bf16*)(ws + WS_ACT); const float* cw = a.in[22] + (size_t)l * 3 * DFF;
    constexpr int GPR = DFF / 8, RUN = 32;
    const int gt = C.bid * NTHREADS + C.tid, ngt = C.G * NTHREADS;
    for (int idx = gt; idx < (M / RUN) * GPR; idx += ngt) {
        const int run = idx / GPR, f0 = (idx % GPR) * 8, m0 = run * RUN;
        float c0[8], c1[8], c2[8];
#pragma unroll
        for (int j = 0; j < 8; ++j) { c0[j] = cw[f0 + j]; c1[j] = cw[DFF + f0 + j]; c2[j] = cw[2 * DFF + f0 + j]; }
        const bf16* ur = U + (size_t)m0 * NUP + f0;
        float x0[8], x1[8];
        { v4u g0 = (v4u){0u, 0u, 0u, 0u}, g1 = (v4u){0u, 0u, 0u, 0u};
          if ((m0 & (SEQ - 1)) != 0) { g0 = *(const v4u*)(ur - 2 * NUP); g1 = *(const v4u*)(ur - NUP); }
          unpack8(g0, x0); unpack8(g1, x1); }
#pragma unroll 1
        for (int tq = 0; tq < RUN; tq += 4) {
            v4u gq[4], vq[4];
#pragma unroll
            for (int i = 0; i < 4; ++i) { gq[i] = *(const v4u*)(ur + (size_t)(tq + i) * NUP); vq[i] = *(const v4u*)(ur + (size_t)(tq + i) * NUP + DFF); }
#pragma unroll
            for (int i = 0; i < 4; ++i) {
                float x2[8], vl[8], r[8]; unpack8(gq[i], x2); unpack8(vq[i], vl);
#pragma unroll
                for (int j = 0; j < 8; ++j) { const float gsum = c0[j] * x0[j] + c1[j] * x1[j] + c2[j] * x2[j]; r[j] = gsum / (1.0f + __expf(-gsum)) * vl[j]; x0[j] = x1[j]; x1[j] = x2[j]; }
                v4u o; o.x = pk2(r[0], r[1]); o.y = pk2(r[2], r[3]); o.z = pk2(r[4], r[5]); o.w = pk2(r[6], r[7]);
                *(v4u*)(ACT + (size_t)(m0 + tq + i) * DFF + f0) = o;
            }
        }
    }
}

__device__ __forceinline__ Ctx make_ctx(unsigned char* lds) {
    Ctx C;
    C.lds = (LAS unsigned char*)lds;
    int t = threadIdx.x; asm volatile("" : "+v"(t));
    C.tid = t; C.lane = C.tid & 63; C.wave = __builtin_amdgcn_readfirstlane(C.tid >> 6);
    C.G = gridDim.x; C.bid = blockIdx.x; C.gw = C.bid * NWAVES + C.wave; C.ngw = C.G * NWAVES;
    return C;
}
template <int K> __device__ __forceinline__ void run_phase(unsigned char* lds, const Args& args, int l) {
    const Ctx C = make_ctx(lds);
    unsigned char* ws = args.ws; asm volatile("" : "+s"(ws)); unsigned char* wsw = ws + (size_t)(l & 1) * WSET_STRIDE; LAS unsigned char* ring = C.lds + RING_OFF; float* out = args.out;
    const float* xsrc = (l == 0) ? args.in[0] : out;
    if constexpr (K == 0) { phase_prep(C, args, l, xsrc, ws); }
    if constexpr (K == 1) { pg8::Gemm g{(const bf16*)(ws + WS_H), (const bf16*)(wsw + WS_WIN), M, NP1, D}; pg8::StaticOrder S; S.init(M, NP1, C.G, C.bid);
        pg8::EpiWin E{(bf16*)(ws + WS_P1), (bf16*)(ws + WS_G), 0};
        pg8::gemm_phase<pg8::EpiWin, pg8::StaticOrder, true, true>(ring, g, S, E); }
    if constexpr (K == 2) { phase_aprime(C, args, l, ws); phase_vt(C, ws); }
    if constexpr (K == 3) { pg8::Gemm g{(const bf16*)(ws + WS_AP), (const bf16*)(wsw + WS_WLORA), M, NLORA, KLORA}; pg8::StaticOrder S; S.init(M, NLORA, C.G, C.bid);
        pg8::EpiF32P E{(float*)(ws + WS_LO), NLORA};
        pg8::gemm_phase<pg8::EpiF32P, pg8::StaticOrder, true, true>(ring, g, S, E); }
    if constexpr (K == 4) { phase_chunkprep(C, args, l, ws); }
    if constexpr (K == 5) {
        const int xg = C.bid & 7, jj = C.bid >> 3;
        if (jj < 3) {
            if (C.tid < 16) ((LAS unsigned*)(C.lds + CH_FLAGS))[C.tid] = 0u;
            __syncthreads();
            const int hs = xg * 3 + jj;
            if (C.wave < 4) scan_chain(C.lane, C.wave, C.lds, hs, ws);
            else chain_loader(C.lane, C.wave - 4, C.lds, hs, ws);
        } else {
            const int gidx = (jj - 3) * 8 + xg;
            build_lut(C, args.in[1]);
            { const float* sinks = args.in[4] + l * 8;
              for (int rep = 0; rep < EXP_ATTN_REPS; ++rep) for (int it = gidx * 8 + C.wave; it < 512 * 20; it += 1856) attn_wave_item(C.lane, (const LAS float*)(C.lds + LUT_OFF), it, sinks, ws); }
            __syncthreads();
            for (int rep = 0; rep < EXP_GATE_REPS; ++rep) { pg8::Gemm g{(const bf16*)(ws + WS_H), (const bf16*)(wsw + WS_WIN) + (size_t)NP1 * D, M, NG, D}; pg8::StaticOrder S; S.init(M, NG, 232, gidx);
              pg8::EpiWin E{(bf16*)(ws + WS_P1), (bf16*)(ws + WS_G), 23};
              pg8::gemm_phase<pg8::EpiWin, pg8::StaticOrder, true, true>(ring, g, S, E); }
            if (l + 1 < DEPTH) convert_weights(gidx * 8 + C.wave, 1856, C.lane, (LAS float*)(C.lds + RING_OFF + C.wave * 16384), args, l + 1, ws);
        } }
    if constexpr (K == 6) { phase_post(C, args, l, ws); }
    if constexpr (K == 7) { pg8::Gemm g{(const bf16*)(ws + WS_YA), (const bf16*)(wsw + WS_PA), M, D, 1536}; pg8::StaticOrder S; S.init(M, D, C.G, C.bid);
        pg8::EpiGate3 E{(const bf16*)(ws + WS_G), (bf16*)(ws + WS_MG), 8, 20};
        pg8::gemm_phase<pg8::EpiGate3, pg8::StaticOrder, true, true>(ring, g, S, E); }
    if constexpr (K == 8) { pg8::Gemm g{(const bf16*)(ws + WS_MG), (const bf16*)(wsw + WS_WOUT), M, D, D}; pg8::StaticOrder S; S.init(M, D, C.G, C.bid);
        pg8::EpiResid E{xsrc, out};
        pg8::gemm_phase<pg8::EpiResid, pg8::StaticOrder, true, true>(ring, g, S, E); }
    if constexpr (K == 9) { const float* g2 = args.in[20] + (size_t)l * D; bf16* H = (bf16*)(ws + WS_H);
        for (int m = 2 * C.gw; m < M; m += 2 * C.ngw) rms_row2_bf16(out + (size_t)m * D, g2, H + (size_t)m * D, C.lane); }
    if constexpr (K == 10) { pg8::Gemm g{(const bf16*)(ws + WS_H) - 2 * D, (const bf16*)(wsw + WS_WUP), 65 * 256, NUP, D}; pg8::StaticOrder S; S.init(65 * 256, NUP, C.G, C.bid);
        pg8::EpiConv E{(bf16*)(ws + WS_ACT), args.in[22] + (size_t)l * 3 * DFF, (PG8_LAS float*)(C.lds + 131072)};
        pg8::gemm_phase<pg8::EpiConv, pg8::StaticOrder, true, true>(ring, g, S, E); }
    if constexpr (K == 12) { pg8::Gemm g{(const bf16*)(ws + WS_ACT), (const bf16*)(wsw + WS_WDOWN), M, D, DFF}; pg8::StaticOrder S; S.init(M, D, C.G, C.bid);
        pg8::EpiResid E{out, out};
        pg8::gemm_phase<pg8::EpiResid, pg8::StaticOrder, true, true>(ring, g, S, E); }
    if constexpr (K == 13) { const float* gf = args.in[24];
        for (int m = C.gw; m < M; m += C.ngw) rms_row_f32(out + (size_t)m * D, gf, C.lane); }
}
template <int K> __global__ void __launch_bounds__(NTHREADS, 2) fwd_phase(Args args) {
    extern __shared__ __attribute__((aligned(16))) unsigned char lds[];
    run_phase<K>(lds, args, args.li);
}
#ifndef EXP_BAR_REPS
#define EXP_BAR_REPS 1
#endif
#define XBAR(b) do { for (int r_ = 0; r_ < EXP_BAR_REPS; ++r_) xcd_barrier(b); } while (0)
__global__ void __launch_bounds__(NTHREADS, 2) fwd_all(Args args) {
    extern __shared__ __attribute__((aligned(16))) unsigned char lds[];
    { LAS unsigned* ctlw = (LAS unsigned*)((LAS unsigned char*)lds + LDSCTL_OFF); for (int u = threadIdx.x; u < (LDS_BYTES - LDSCTL_OFF) / 4; u += NTHREADS) ctlw[u] = 0u; }
    __syncthreads();
    const XcdBarrier bar = xcd_barrier_post((unsigned*)(args.ws + WS_CTL) + CW_BAR, (volatile LAS unsigned*)((LAS unsigned char*)lds + MISC_OFF) + 8);
    for (int l = 0; l < DEPTH; ++l) {
        for (int rep = 0; rep < (((EXP_EW_MASK >> 0) & 1) ? 2 : 1); ++rep) { run_phase<0>(lds, args, l); XBAR(bar); }
        for (int rep = 0; rep < EXP_G1_REPS; ++rep) { run_phase<1>(lds, args, l); XBAR(bar); }
        for (int rep = 0; rep < (((EXP_EW_MASK >> 2) & 1) ? 2 : 1); ++rep) { run_phase<2>(lds, args, l); XBAR(bar); }
        for (int rep = 0; rep < EXP_G3_REPS; ++rep) { run_phase<3>(lds, args, l); XBAR(bar); }
        for (int rep = 0; rep < (((EXP_EW_MASK >> 4) & 1) ? 2 : 1); ++rep) { run_phase<4>(lds, args, l); XBAR(bar); }
        run_phase<5>(lds, args, l); XBAR(bar);
        for (int rep = 0; rep < (((EXP_EW_MASK >> 6) & 1) ? 2 : 1); ++rep) { run_phase<6>(lds, args, l); XBAR(bar); }
        for (int rep = 0; rep < EXP_G7_REPS; ++rep) { run_phase<7>(lds, args, l); XBAR(bar); }
        run_phase<8>(lds, args, l); XBAR(bar);
        for (int rep = 0; rep < (((EXP_EW_MASK >> 9) & 1) ? 2 : 1); ++rep) { run_phase<9>(lds, args, l); XBAR(bar); }
        for (int rep = 0; rep < EXP_G10_REPS; ++rep) { run_phase<10>(lds, args, l); XBAR(bar); }
        run_phase<12>(lds, args, l); XBAR(bar);
    }
    run_phase<13>(lds, args, 0);
}

#ifndef MK_ONE_LAUNCH
#define MK_ONE_LAUNCH 1
#endif
template <int K> static void launch_phase(int grid, hipStream_t stream, Args a, int l) {
    static bool attr = false; if (!attr) { (void)hipFuncSetAttribute((const void*)fwd_phase<K>, hipFuncAttributeMaxDynamicSharedMemorySize, LDS_BYTES); attr = true; }
    a.li = l; a.ph_lo = K; a.ph_hi = K + 1;
    hipLaunchKernelGGL(fwd_phase<K>, dim3(grid), dim3(NTHREADS), LDS_BYTES, stream, a);
}
extern "C" void kernel_launch(void* const* d_in, const int* in_sizes, int n_in, void* d_out, int out_size, void* d_ws, size_t ws_size, hipStream_t stream) {
    static int grid = 0;
    if (grid == 0) {
        if (n_in != 25 || in_sizes[0] != M * D || out_size != M * D || ws_size < WS_END2) { fprintf(stderr, "kernel_launch: unexpected shapes (n_in %d, in0 %d, out %d, ws %zu < %zu)\n", n_in, n_in > 0 ? in_sizes[0] : -1, out_size, ws_size, (size_t)WS_END); grid = -1; return; }
        int dev = 0, cus = 0;
        if (hipGetDevice(&dev) != hipSuccess || hipDeviceGetAttribute(&cus, hipDeviceAttributeMultiprocessorCount, dev) != hipSuccess) { grid = -1; return; }
        grid = cus;
    }
    if (grid < 0) return;
    (void)hipMemsetAsync((char*)d_ws + WS_CTL, 0, CTL_ZERO_BYTES, stream);
    Args a{};
    for (int i = 0; i < 25; ++i) a.in[i] = (const float*)d_in[i];
    a.out = (float*)d_out; a.ws = (unsigned char*)d_ws; a.pad = 0;
#if MK_ONE_LAUNCH
    { static bool attr = false; if (!attr) { (void)hipFuncSetAttribute((const void*)fwd_all, hipFuncAttributeMaxDynamicSharedMemorySize, LDS_BYTES); attr = true; }
      a.li = 0; a.ph_lo = 0; a.ph_hi = NPHASES;
      hipLaunchKernelGGL(fwd_all, dim3(grid), dim3(NTHREADS), LDS_BYTES, stream, a); }
#else
    for (int l = 0; l < DEPTH; ++l) {
        launch_phase<0>(grid, stream, a, l); launch_phase<1>(grid, stream, a, l); launch_phase<2>(grid, stream, a, l); launch_phase<3>(grid, stream, a, l);
        launch_phase<4>(grid, stream, a, l); launch_phase<5>(grid, stream, a, l); launch_phase<6>(grid, stream, a, l); launch_phase<7>(grid, stream, a, l);
        launch_phase<8>(grid, stream, a, l); launch_phase<9>(grid, stream, a, l); launch_phase<10>(grid, stream, a, l); launch_phase<11>(grid, stream, a, l);
        launch_phase<12>(grid, stream, a, l);
    }
    launch_phase<13>(grid, stream, a, 0);
#endif
}
```

```cpp
#include <hip/hip_runtime.h>
#include <cstdio>
#include <cstdint>
#include <cmath>
#define GAS __attribute__((address_space(1)))
#define LAS __attribute__((address_space(3)))
namespace pg8 {
#define PG8_LAS __attribute__((address_space(3)))
typedef unsigned short bf16_t;
typedef short bf16x8 __attribute__((ext_vector_type(8)));
typedef float f32x4 __attribute__((ext_vector_type(4)));
typedef unsigned u32x4 __attribute__((ext_vector_type(4)));
constexpr int BM = 256, BK = 64, HALF = 128, HTB = HALF * BK * 2  , STAGE_BYTES = 8 * HTB, NXCD = 8, WGM = 8;

__host__ __device__ __forceinline__ int lds_byte(int r, int c) { const int st = (r >> 4) * 2 + (c >> 5), rr = r & 15, cc = c & 31, ob = rr * 64 + cc * 2; return st * 1024 + (ob ^ (((ob >> 9) & 1) << 5)); }
__host__ __device__ __forceinline__ void stage_rc(int b, int& R, int& C) { const int st = b / 1024, sb = b % 1024, swz = sb ^ (((sb >> 9) & 1) << 5); R = (st >> 1) * 16 + swz / 64; C = (st & 1) * 32 + (swz % 64) / 2; }
__host__ __device__ __forceinline__ int perm32(int rho) { const int n = rho >> 4, i = rho & 15; return 8 * (i >> 2) + 4 * n + (i & 3); }

struct Unit { int pm, pn; };
struct Gemm { const bf16_t* A; const bf16_t* Bt; int M, N, K; };

struct StaticOrder {
    int nM, nN, nwg, G, c;
    __host__ __device__ void init(int M, int N, int G_, int c_) { nM = M / BM; nN = N / BM; nwg = nM * nN; G = G_; c = c_; }
    __host__ __device__ bool next(int i, Unit& u) const {
        const long L = (long)i * G + c; if (L >= nwg) return false;
        int wgid = (int)L; { const int q = nwg / NXCD, r = nwg % NXCD, xcd = wgid % NXCD, off = wgid / NXCD; wgid = (xcd < r ? xcd * (q + 1) : r * (q + 1) + (xcd - r) * q) + off; }
        const int nig = WGM * nN, gid = wgid / nig, fm = gid * WGM, gsz = (nM - fm) < WGM ? (nM - fm) : WGM;
        u.pm = fm + ((wgid % nig) % gsz); u.pn = (wgid % nig) / gsz; return true;
    }
    __device__ __forceinline__ void a_ready(const Unit&) const {}
    __device__ __forceinline__ void done(const Unit&) const {}
};
__device__ __forceinline__ unsigned cvt_pk_bf16(float lo, float hi) { unsigned r; asm volatile("v_cvt_pk_bf16_f32 %0, %1, %2" : "=v"(r) : "v"(lo), "v"(hi)); return r; }
template <class Epi, class Sched, bool ALIGN_EPI = false, bool SP2 = false>
__device__ __forceinline__ void gemm_phase(PG8_LAS unsigned char* lds, const Gemm g, const Sched& S, const Epi& E) {
    int tid_ = threadIdx.x; asm volatile("" : "+v"(tid_));
    const int tid = tid_, wid = __builtin_amdgcn_readfirstlane(tid >> 6), lane = tid & 63, wr = wid >> 2, wc = wid & 3, fr = lane & 15, fq = lane >> 4;
    const int K = g.K, nt = K / BK;
    unsigned voffA[2], voffB[2];
#pragma unroll
    for (int i = 0; i < 2; ++i) { int R, C; stage_rc(tid * 16 + i * 8192, R, C); const int Rb = Epi::PERM ? ((R & ~31) + perm32(R & 31)) : R;
        voffA[i] = (unsigned)(R * K + C) * 2u; voffB[i] = (unsigned)(Rb * K + C) * 2u; }
    const size_t kstep = (size_t)(BK * 2);
    const size_t hstep = (size_t)HALF * K * 2;
    const size_t tstep = 2 * hstep;
    const size_t tstepA = (size_t)Epi::A_ROWS * K * 2;
    const unsigned ldsw = (unsigned)wid * 1024u;
    const int aoff = lds_byte(wr * 64 + fr, fq * 8), boff = lds_byte(wc * 32 + fr, fq * 8);
#define PG8_SA(b, h) (((b) * 2 + (h)) * HTB)
#define PG8_SB(b, h) ((4 + (b) * 2 + (h)) * HTB)
#define PG8_STAGE(bufoff, gbase, voff) do { _Pragma("unroll") for (int _i = 0; _i < 2; ++_i) \
        __builtin_amdgcn_global_load_lds((const unsigned*)((const char*)(gbase) + (voff)[_i]), (PG8_LAS unsigned*)(lds + (bufoff) + ldsw + _i * 8192), 16, 0, 0); } while (0)
#define PG8_LDA(dst, b, h) do { _Pragma("unroll") for (int m = 0; m < 4; ++m) _Pragma("unroll") for (int k = 0; k < 2; ++k) dst[m][k] = *(const PG8_LAS bf16x8*)(lds + PG8_SA(b, h) + aoff + m * 2048 + k * 1024); } while (0)
#define PG8_LDB(dst, b, h) do { _Pragma("unroll") for (int n = 0; n < 2; ++n) _Pragma("unroll") for (int k = 0; k < 2; ++k) dst[n][k] = *(const PG8_LAS bf16x8*)(lds + PG8_SB(b, h) + boff + n * 2048 + k * 1024); } while (0)
#define PG8_MMA(ai, bj, At, Bt) do { __builtin_amdgcn_s_setprio(1); _Pragma("unroll") for (int m = 0; m < 4; ++m) _Pragma("unroll") for (int n = 0; n < 2; ++n) _Pragma("unroll") for (int k = 0; k < 2; ++k) \
        acc[ai][bj][m][n] = __builtin_amdgcn_mfma_f32_16x16x32_bf16(Bt[n][k], At[m][k], acc[ai][bj][m][n], 0, 0, 0); __builtin_amdgcn_s_setprio(0); } while (0)
#define PG8_WAIT_V(n) asm volatile("s_waitcnt vmcnt(" #n ")" ::: "memory")
#define PG8_WAIT_L(n) asm volatile("s_waitcnt lgkmcnt(" #n ")" ::: "memory")
#define PG8_BAR __builtin_amdgcn_s_barrier()
#define PG8_SCHED __builtin_amdgcn_sched_barrier(0)
    Unit cur, nxt; int ui = 0;
    if (!S.next(0, cur)) return;
    f32x4 acc[2][2][4][2];
#pragma unroll
    for (int a = 0; a < 2; ++a)
#pragma unroll
        for (int b = 0; b < 2; ++b)
#pragma unroll
            for (int m = 0; m < 4; ++m)
#pragma unroll
                for (int n = 0; n < 2; ++n) acc[a][b][m][n] = (f32x4){0.f, 0.f, 0.f, 0.f};
    bf16x8 At[4][2], B0[2][2], B1[2][2];
    const char* cA = (const char*)g.A + (size_t)cur.pm * tstepA; const char* cB = (const char*)g.Bt + (size_t)cur.pn * tstep;
    S.a_ready(cur);
    if constexpr (SP2) {
        PG8_STAGE(PG8_SB(0, 0), cB, voffB); PG8_STAGE(PG8_SB(0, 1), cB + hstep, voffB); PG8_STAGE(PG8_SA(0, 0), cA, voffA); PG8_STAGE(PG8_SA(0, 1), cA + hstep, voffA);
        if (wr == 1) PG8_BAR;
        PG8_WAIT_V(2); PG8_BAR;
        PG8_STAGE(PG8_SB(1, 0), cB + kstep, voffB); PG8_STAGE(PG8_SA(1, 0), cA + kstep, voffA); PG8_STAGE(PG8_SB(1, 1), cB + hstep + kstep, voffB);
        PG8_WAIT_V(6); PG8_BAR;
    } else {
        PG8_STAGE(PG8_SB(0, 0), cB, voffB); PG8_STAGE(PG8_SA(0, 0), cA, voffA); PG8_STAGE(PG8_SB(0, 1), cB + hstep, voffB); PG8_STAGE(PG8_SA(0, 1), cA + hstep, voffA);
        if (wr == 1) PG8_BAR;
        PG8_WAIT_V(4); PG8_BAR;
        PG8_STAGE(PG8_SB(1, 0), cB + kstep, voffB); PG8_STAGE(PG8_SA(1, 0), cA + kstep, voffA); PG8_STAGE(PG8_SB(1, 1), cB + hstep + kstep, voffB);
        PG8_WAIT_V(6); PG8_BAR;
    }
    for (;;) {
        const bool has_next = S.next(ui + 1, nxt);
        const char* nA = has_next ? (const char*)g.A + (size_t)nxt.pm * tstepA : cA; const char* nB = has_next ? (const char*)g.Bt + (size_t)nxt.pn * tstep : cB;
        for (int t = 0; t < nt; t += 2) {
            const bool last = (t == nt - 2);
            const char* a1 = cA + (size_t)(t + 1) * kstep;
            const char* a2 = last ? nA : cA + (size_t)(t + 2) * kstep; const char* b2 = last ? nB : cB + (size_t)(t + 2) * kstep;
            const char* a3 = a2 + kstep; const char* b3 = b2 + kstep;
            if (last && has_next) S.a_ready(nxt);
            if constexpr (Epi::HAS_SEG) { if (t == E.t1 || t == E.t2) E.seg(acc, cur, t, wr, wc, fr, fq); }
            if constexpr (SP2) {
            PG8_LDB(B0, 0, 0); PG8_LDB(B1, 0, 1); PG8_SCHED; PG8_LDA(At, 0, 0); PG8_STAGE(PG8_SA(1, 1), a1 + hstep, voffA);
            PG8_WAIT_V(8); PG8_WAIT_L(0); PG8_BAR; PG8_MMA(0, 0, At, B0); PG8_MMA(0, 1, At, B1); PG8_BAR; PG8_SCHED;
            PG8_LDA(At, 0, 1); PG8_STAGE(PG8_SB(0, 0), b2, voffB); PG8_STAGE(PG8_SB(0, 1), b2 + hstep, voffB); PG8_STAGE(PG8_SA(0, 0), a2, voffA);
            PG8_WAIT_V(8); PG8_WAIT_L(0); PG8_BAR; PG8_MMA(1, 0, At, B0); PG8_MMA(1, 1, At, B1); PG8_BAR; PG8_SCHED;
            PG8_LDB(B0, 1, 0); PG8_LDB(B1, 1, 1); PG8_SCHED; PG8_LDA(At, 1, 0); PG8_STAGE(PG8_SA(0, 1), a2 + hstep, voffA);
            PG8_WAIT_V(8); PG8_WAIT_L(0); PG8_BAR; PG8_MMA(0, 0, At, B0); PG8_MMA(0, 1, At, B1); PG8_BAR; PG8_SCHED;
            PG8_LDA(At, 1, 1); PG8_STAGE(PG8_SB(1, 0), b3, voffB); PG8_STAGE(PG8_SB(1, 1), b3 + hstep, voffB); PG8_STAGE(PG8_SA(1, 0), a3, voffA);
            PG8_WAIT_V(8); PG8_WAIT_L(0); PG8_BAR; PG8_MMA(1, 0, At, B0); PG8_MMA(1, 1, At, B1); PG8_BAR; PG8_SCHED;
            } else {
            PG8_LDB(B0, 0, 0); PG8_SCHED; PG8_LDA(At, 0, 0); PG8_STAGE(PG8_SA(1, 1), a1 + hstep, voffA);
            PG8_WAIT_L(8); PG8_BAR; PG8_WAIT_L(0); PG8_MMA(0, 0, At, B0); PG8_BAR; PG8_SCHED;
            PG8_LDB(B1, 0, 1); PG8_STAGE(PG8_SB(0, 0), b2, voffB);
            PG8_BAR; PG8_WAIT_L(0); PG8_MMA(0, 1, At, B1); PG8_BAR;
            PG8_LDA(At, 0, 1); PG8_STAGE(PG8_SA(0, 0), a2, voffA);
            PG8_BAR; PG8_WAIT_L(0); PG8_MMA(1, 0, At, B0); PG8_BAR; PG8_SCHED;
            PG8_STAGE(PG8_SB(0, 1), b2 + hstep, voffB);
            PG8_WAIT_V(6); PG8_BAR; PG8_MMA(1, 1, At, B1); PG8_BAR;
            PG8_LDB(B0, 1, 0); PG8_SCHED; PG8_LDA(At, 1, 0); PG8_STAGE(PG8_SA(0, 1), a2 + hstep, voffA);
            PG8_WAIT_L(8); PG8_BAR; PG8_WAIT_L(0); PG8_MMA(0, 0, At, B0); PG8_BAR; PG8_SCHED;
            PG8_LDB(B1, 1, 1); PG8_STAGE(PG8_SB(1, 0), b3, voffB);
            PG8_BAR; PG8_WAIT_L(0); PG8_MMA(0, 1, At, B1); PG8_BAR;
            PG8_LDA(At, 1, 1); PG8_STAGE(PG8_SA(1, 0), a3, voffA);
            PG8_BAR; PG8_WAIT_L(0); PG8_MMA(1, 0, At, B0); PG8_BAR; PG8_SCHED;
            PG8_STAGE(PG8_SB(1, 1), b3 + hstep, voffB);
            PG8_WAIT_V(6); PG8_BAR; PG8_MMA(1, 1, At, B1); PG8_BAR;
            }
        }
        if constexpr (ALIGN_EPI) { if (wr == 0) PG8_BAR; }
        if constexpr (!Epi::AFTER_DRAIN) { E(acc, cur, wr, wc, fr, fq); S.done(cur); }
        if (!has_next) break;
#pragma unroll
        for (int a = 0; a < 2; ++a)
#pragma unroll
            for (int b = 0; b < 2; ++b)
#pragma unroll
                for (int m = 0; m < 4; ++m)
#pragma unroll
                    for (int n = 0; n < 2; ++n) acc[a][b][m][n] = (f32x4){0.f, 0.f, 0.f, 0.f};
        cur = nxt; cA = nA; cB = nB; ++ui;
        if constexpr (ALIGN_EPI) { if (wr == 1) PG8_BAR; }
    }
    PG8_WAIT_V(0);
    if constexpr (!ALIGN_EPI) { if (wr == 0) PG8_BAR; }
    PG8_BAR;
    if constexpr (Epi::AFTER_DRAIN) { E.fused(acc, cur, wr, wc, fr, fq, lds, wid, lane); S.done(cur); }
#undef PG8_SA
#undef PG8_SB
#undef PG8_STAGE
#undef PG8_LDA
#undef PG8_LDB
#undef PG8_MMA
#undef PG8_WAIT_V
#undef PG8_WAIT_L
#undef PG8_BAR
#undef PG8_SCHED
}
}
#define XB_TMO      128
#define XB_XCNT(j)  (256  + 64 * (j))
#define XB_XSUB(j)  (1280 + 64 * (j))
#define XB_XGEN(j)  (2304 + 64 * (j))
#define XB_TOP      3328
#define XB_TOPGEN   3392
#define XCD_BAR_WORDS 3456
#define XB_SPIN_CAP (1u << 18)

__device__ __forceinline__ unsigned xb_ld(unsigned* p)              { return __hip_atomic_load(p, __ATOMIC_RELAXED, __HIP_MEMORY_SCOPE_AGENT); }
__device__ __forceinline__ unsigned xb_add(unsigned* p, unsigned v) { return __hip_atomic_fetch_add(p, v, __ATOMIC_RELAXED, __HIP_MEMORY_SCOPE_AGENT); }
__device__ __forceinline__ unsigned xb_xcc_id() { return (unsigned)__builtin_amdgcn_s_getreg((3 << 11) | 20) & 0xFu; }
#define XB_SPIN(cond, bar) do { unsigned _sp = 0; while (cond) { __builtin_amdgcn_s_sleep(1); \
    if ((++_sp & 255u) == 0u) { if (xb_ld(&(bar)[XB_TMO])) break; if (_sp > XB_SPIN_CAP) { atomicAdd(&(bar)[XB_TMO], 1u); break; } } } } while (0)

struct XcdBarrier {
    unsigned* bar; unsigned x;
    volatile LAS unsigned* st;
};

__device__ __forceinline__ XcdBarrier xcd_barrier_post(unsigned* bar, volatile LAS unsigned* st) {
    XcdBarrier b; b.bar = bar; b.x = xb_xcc_id(); b.st = st;
    if (threadIdx.x == 0) (void)xb_add(&bar[XB_XCNT(b.x)], 1u);
    return b;
}
__device__ __forceinline__ void xcd_barrier_complete(unsigned* bar, unsigned x, unsigned& nloc, unsigned& nx) {
    const unsigned G = gridDim.x * gridDim.y * gridDim.z;
    unsigned sum, cnt, mine, sp = 0u;
    for (;;) {
        sum = 0u; cnt = 0u; mine = 0u;
#pragma unroll
        for (unsigned j = 0; j < 16; ++j) { const unsigned c = xb_ld(&bar[XB_XCNT(j)]); sum += c; cnt += (c > 0u) ? 1u : 0u; mine = (j == x) ? c : mine; }
        if (sum == G) break;
        __builtin_amdgcn_s_sleep(1);
        if ((++sp & 255u) == 0u) { if (xb_ld(&bar[XB_TMO])) break; if (sp > XB_SPIN_CAP) { atomicAdd(&bar[XB_TMO], 1u); break; } }
    }
    nloc = mine > 0u ? mine : 1u; nx = cnt > 0u ? cnt : 1u;
}

__device__ __forceinline__ void xcd_barrier(const XcdBarrier& b) {
    asm volatile("s_waitcnt vmcnt(0)" ::: "memory");
    __syncthreads();
    if (threadIdx.x == 0) {
        unsigned* bar = b.bar;
        __builtin_amdgcn_s_waitcnt(0);
        unsigned nloc = b.st[0], nx = b.st[1];
        if (nloc == 0u) { xcd_barrier_complete(bar, b.x, nloc, nx); b.st[0] = nloc; b.st[1] = nx; }
        const unsigned old = xb_add(&bar[XB_XSUB(b.x)], 1u);
        const unsigned gen = old / nloc;
        if (old + 1u == (gen + 1u) * nloc) {
            __builtin_amdgcn_fence(__ATOMIC_RELEASE, "agent");
            asm volatile("s_waitcnt vmcnt(0)" ::: "memory");
            const unsigned og = xb_add(&bar[XB_TOP], 1u);
            const unsigned tg = og / nx;
            if (og + 1u == (tg + 1u) * nx) xb_add(&bar[XB_TOPGEN], 1u);
            else XB_SPIN(xb_ld(&bar[XB_TOPGEN]) == tg, bar);
            __builtin_amdgcn_fence(__ATOMIC_ACQUIRE, "agent");
            xb_add(&bar[XB_XGEN(b.x)], 1u);
            asm volatile("s_waitcnt vmcnt(0)" ::: "memory");
        } else {
            XB_SPIN(xb_ld(&bar[XB_XGEN(b.x)]) == gen, bar);
            __builtin_amdgcn_fence(__ATOMIC_ACQUIRE, "agent");
            asm volatile("s_waitcnt vmcnt(0)" ::: "memory");
        }
    }
    __syncthreads();
}

constexpr int BATCH = 2, SEQ = 8192, M = BATCH * SEQ, D = 2048, DEPTH = 4;
constexpr int DIN = 11968, NP1 = 5888, NG = 6144, NWIN = NP1 + NG;
constexpr int BW = 768, BCOLS = 2752;
constexpr int C_AQ = 0, C_AK = 512, C_AV = 640, C_R = 768, C_K = 1536, C_V = 2304, C_WD = 3072, C_CQ = 3520, C_CK = 4288, C_CV = 5056, C_END = 5824;
constexpr int DFF = 5504, NUP = 2 * DFF;
constexpr int NLORA = 2304, KLORA = 512;
constexpr float NORM_EPS = 1e-5f, GN_EPS = 64e-5f;
constexpr int NWAVES = 8, NTHREADS = 512;
constexpr int NPH = 13;
constexpr int NPHASES = DEPTH * NPH + 1;
#ifndef EXP_EW_MASK
#define EXP_EW_MASK 0
#endif
#ifndef EXP_EW_REPS
#define EXP_EW_REPS 1
#endif
#ifndef EXP_G10_REPS
#define EXP_G10_REPS 1
#endif
#ifndef EXP_GATE_REPS
#define EXP_GATE_REPS 1
#endif
#ifndef EXP_G7_REPS
#define EXP_G7_REPS 1
#endif
#ifndef EXP_G3_REPS
#define EXP_G3_REPS 1
#endif
#ifndef EXP_G1_REPS
#define EXP_G1_REPS 1
#endif
#ifndef EXP_SCAN_REPS
#define EXP_SCAN_REPS 1
#endif
#ifndef EXP_ATTN_REPS
#define EXP_ATTN_REPS 1
#endif
constexpr int NSCAN = 48;

constexpr size_t MiB = 1u << 20;
constexpr size_t WS_CTL = 0, CTL_ZERO_BYTES = 1 * MiB;
constexpr size_t WS_WIN = 1 * MiB;
constexpr size_t WS_WLORA = 48 * MiB;
constexpr size_t WS_PA = 51 * MiB;
constexpr size_t WS_PB = 53 * MiB;
constexpr size_t WS_PC = 56 * MiB;
constexpr size_t WS_WOUT = 57 * MiB;
constexpr size_t WS_WUP = 65 * MiB;
constexpr size_t WS_WDOWN = 108 * MiB;
constexpr size_t WS_H = 130 * MiB;
constexpr size_t WS_P1 = 194 * MiB;
constexpr size_t WS_G = 378 * MiB;
constexpr size_t WS_U = WS_P1;
constexpr size_t WS_AP = 570 * MiB;
constexpr size_t WS_LO = 586 * MiB;
constexpr size_t WS_ACT = WS_LO;
constexpr size_t WS_SR = 730 * MiB;
constexpr size_t WS_SW = 778 * MiB, WS_SK = 826 * MiB, WS_SKK = 874 * MiB, WS_SB = 922 * MiB, WS_SV = 970 * MiB;
constexpr size_t WS_YRAW = 1018 * MiB;
constexpr size_t WS_YA = 1066 * MiB;
constexpr size_t WS_YB = 1082 * MiB;
constexpr size_t WS_YC = 1106 * MiB;
constexpr size_t WS_OC = 1114 * MiB;
constexpr size_t WS_LSE = 1138 * MiB;
constexpr size_t WS_MG = 1139 * MiB;
constexpr size_t WS_BK = 1203 * MiB;
constexpr size_t WS_VT = 1205 * MiB;
constexpr size_t WS_W2 = 1235 * MiB;
constexpr size_t WSET_STRIDE = WS_W2 - WS_WIN;
constexpr size_t WS_BON = 1365 * MiB;
constexpr size_t WS_END = 1366 * MiB;
constexpr size_t WS_SST_A = 1366 * MiB, WS_SST_B = WS_MG;
constexpr size_t WS_END2 = 1494 * MiB;
constexpr size_t WS_COP = WS_SR;
constexpr int COP_W1 = 0, COP_U0 = 1024, COP_BK = 1536, COP_GAM = 3584, COP_RY = 3648, COP_Y0 = 4672, COP_STRIDE = 4928;
constexpr int CW_BAR = 4096;

constexpr int RING_OFF = 0, RING_BYTES = 131072;
constexpr int LDSCTL_OFF = 141312, MISC_OFF = LDSCTL_OFF + 320;
constexpr int LDS_BYTES = 147456;
constexpr int LUT_OFF = 0, SCANRING_OFF = 12288, CONV_SCR_SCAN = 77824, CONV_SCR_OTHER = 12288;

typedef unsigned short bf16;
typedef unsigned v4u __attribute__((ext_vector_type(4)));
typedef unsigned v2u __attribute__((ext_vector_type(2)));
typedef float f32x4 __attribute__((ext_vector_type(4)));
#define LDS_WAIT() asm volatile("s_waitcnt lgkmcnt(0)" ::: "memory")

__device__ __forceinline__ unsigned f2bf(float f) { unsigned u = __builtin_bit_cast(unsigned, f); return (u + 0x7fffu + ((u >> 16) & 1u)) >> 16; }
__device__ __forceinline__ unsigned pk2(float lo, float hi) { return f2bf(lo) | (f2bf(hi) << 16); }
__device__ __forceinline__ float bflo(unsigned w) { return __builtin_bit_cast(float, w << 16); }
__device__ __forceinline__ float bfhi(unsigned w) { return __builtin_bit_cast(float, w & 0xffff0000u); }
__device__ __forceinline__ float bf1(bf16 h) { return __builtin_bit_cast(float, ((unsigned)h) << 16); }
__device__ __forceinline__ float sigmoidf_(float x) { return 1.0f / (1.0f + __expf(-x)); }
__device__ __forceinline__ float wave_sum(float v) {
#pragma unroll
    for (int o = 1; o < 64; o <<= 1) v += __shfl_xor(v, o);
    return v;
}
template <int CTRL> __device__ __forceinline__ float dppf(float x) { return __builtin_bit_cast(float, __builtin_amdgcn_update_dpp(0, __builtin_bit_cast(int, x), CTRL, 0xF, 0xF, true)); }
__device__ __forceinline__ float red4(float x) { x += dppf<0xB1>(x); x += dppf<0x4E>(x); return x; }
__device__ __forceinline__ float red16(float x) { x = red4(x); x += dppf<0x141>(x); x += dppf<0x140>(x); return x; }
__device__ __forceinline__ float wsum(float x) { x = red16(x); x += __shfl_xor(x, 16); x += __shfl_xor(x, 32); return x; }

__device__ const unsigned char T5B[3][132] = {
 {0,1,2,3,4,5,6,7,8,9,10,11,12,13,14,15,16,16,16,16,16,16,17,17,17,17,17,17,17,17,18,18,18,18,18,18,18,18,18,18,19,19,19,19,19,19,19,19,19,19,19,19,19,19,20,20,20,20,20,20,20,20,20,20,20,20,20,20,20,20,20,20,20,21,21,21,21,21,21,21,21,21,21,21,21,21,21,21,21,21,21,21,21,21,21,21,21,21,21,22,22,22,22,22,22,22,22,22,22,22,22,22,22,22,22,22,22,22,22,22,22,22,22,22,22,22,22,22,22,0,0,0},
 {0,4,8,12,16,16,17,17,18,18,19,19,19,19,20,20,20,20,20,21,21,21,21,21,21,22,22,22,22,22,22,22,22,22,23,23,23,23,23,23,23,23,23,23,23,23,24,24,24,24,24,24,24,24,24,24,24,24,24,24,24,24,25,25,25,25,25,25,25,25,25,25,25,25,25,25,25,25,25,25,25,25,25,26,26,26,26,26,26,26,26,26,26,26,26,26,26,26,26,26,26,26,26,26,26,26,26,26,26,26,26,26,26,27,27,27,27,27,27,27,27,27,27,27,27,27,27,27,27,0,0,0},
 {0,16,18,19,20,21,21,22,22,23,23,23,24,24,24,24,25,25,25,25,25,26,26,26,26,26,26,26,26,27,27,27,27,27,27,27,27,27,27,28,28,28,28,28,28,28,28,28,28,28,28,28,29,29,29,29,29,29,29,29,29,29,29,29,29,29,29,29,29,29,30,30,30,30,30,30,30,30,30,30,30,30,30,30,30,30,30,30,30,30,30,30,30,30,30,31,31,31,31,31,31,31,31,31,31,31,31,31,31,31,31,31,31,31,31,31,31,31,31,31,31,31,31,31,31,31,31,31,31,0,0,0}};

namespace pg8 {
struct EpiWin {
    static constexpr bool PERM = true, AFTER_DRAIN = false; static constexpr int A_ROWS = 256; static constexpr bool HAS_SEG = false;
    bf16_t* P1; bf16_t* G; int pn0;
    __device__ __forceinline__ void operator()(const f32x4 (&acc)[2][2][4][2], const Unit& u, int wr, int wc, int fr, int fq) const {
        const int pn = u.pn + pn0; const int row0 = u.pm * BM + wr * 64 + fr; const bool gate = pn >= 23;
        bf16_t* base = gate ? G : P1; const int ldc = gate ? 6144 : 5888; const int col0 = (gate ? (pn - 23) : pn) * BM + wc * 32 + 8 * fq;
#pragma unroll
        for (int ai = 0; ai < 2; ++ai)
#pragma unroll
            for (int m = 0; m < 4; ++m) { bf16_t* rowp = base + (size_t)(row0 + ai * HALF + m * 16) * ldc + col0;
#pragma unroll
                for (int bj = 0; bj < 2; ++bj) { f32x4 v0 = acc[ai][bj][m][0], v1 = acc[ai][bj][m][1];
                    if (gate) {
#pragma unroll
                        for (int j = 0; j < 4; ++j) { v0[j] = __builtin_amdgcn_rcpf(1.0f + __expf(-v0[j])); v1[j] = __builtin_amdgcn_rcpf(1.0f + __expf(-v1[j])); } }
                    u32x4 w; w.x = cvt_pk_bf16(v0[0], v0[1]); w.y = cvt_pk_bf16(v0[2], v0[3]); w.z = cvt_pk_bf16(v1[0], v1[1]); w.w = cvt_pk_bf16(v1[2], v1[3]);
                    *(u32x4*)(rowp + bj * HALF) = w; } }
    }
};
struct EpiBf16P {
    static constexpr bool PERM = true, AFTER_DRAIN = false; static constexpr int A_ROWS = 256; static constexpr bool HAS_SEG = false;
    bf16_t* O; int ldc;
    __device__ __forceinline__ void operator()(const f32x4 (&acc)[2][2][4][2], const Unit& u, int wr, int wc, int fr, int fq) const {
        const int row0 = u.pm * BM + wr * 64 + fr; const int col0 = u.pn * BM + wc * 32 + 8 * fq;
#pragma unroll
        for (int ai = 0; ai < 2; ++ai)
#pragma unroll
            for (int m = 0; m < 4; ++m) { bf16_t* rowp = O + (size_t)(row0 + ai * HALF + m * 16) * ldc + col0;
#pragma unroll
                for (int bj = 0; bj < 2; ++bj) { const f32x4 v0 = acc[ai][bj][m][0], v1 = acc[ai][bj][m][1];
                    u32x4 w; w.x = cvt_pk_bf16(v0[0], v0[1]); w.y = cvt_pk_bf16(v0[2], v0[3]); w.z = cvt_pk_bf16(v1[0], v1[1]); w.w = cvt_pk_bf16(v1[2], v1[3]);
                    *(u32x4*)(rowp + bj * HALF) = w; } }
    }
};
struct EpiF32P {
    static constexpr bool PERM = false, AFTER_DRAIN = false; static constexpr int A_ROWS = 256; static constexpr bool HAS_SEG = false;
    float* C; int ldc;
    __device__ __forceinline__ void operator()(const f32x4 (&acc)[2][2][4][2], const Unit& u, int wr, int wc, int fr, int fq) const {
        const int row0 = u.pm * BM + wr * 64 + fr, col0 = u.pn * BM + wc * 32 + 4 * fq;
#pragma unroll
        for (int ai = 0; ai < 2; ++ai)
#pragma unroll
            for (int m = 0; m < 4; ++m) { float* rowp = C + (size_t)(row0 + ai * HALF + m * 16) * ldc + col0;
#pragma unroll
                for (int bj = 0; bj < 2; ++bj)
#pragma unroll
                    for (int n = 0; n < 2; ++n) *(f32x4*)(rowp + bj * HALF + n * 16) = acc[ai][bj][m][n]; }
    }
};
struct EpiResid {
    static constexpr bool PERM = false, AFTER_DRAIN = false; static constexpr int A_ROWS = 256; static constexpr bool HAS_SEG = false;
    const float* xin; float* out;
    __device__ __forceinline__ void operator()(const f32x4 (&acc)[2][2][4][2], const Unit& u, int wr, int wc, int fr, int fq) const {
        const int row0 = u.pm * BM + wr * 64 + fr, col0 = u.pn * BM + wc * 32 + 4 * fq;
#pragma unroll
        for (int ai = 0; ai < 2; ++ai)
#pragma unroll
            for (int m = 0; m < 4; ++m) { const size_t ro = (size_t)(row0 + ai * HALF + m * 16) * 2048 + col0;
#pragma unroll
                for (int bj = 0; bj < 2; ++bj)
#pragma unroll
                    for (int n = 0; n < 2; ++n) { const f32x4 xv = *(const f32x4*)(xin + ro + bj * HALF + n * 16); *(f32x4*)(out + ro + bj * HALF + n * 16) = xv + acc[ai][bj][m][n]; } }
    }
};
template <bool ACC> struct EpiGate {
    static constexpr bool PERM = true, AFTER_DRAIN = false; static constexpr int A_ROWS = 256; static constexpr bool HAS_SEG = false;
    const bf16_t* G; int gofs; bf16_t* MG;
    __device__ __forceinline__ void operator()(const f32x4 (&acc)[2][2][4][2], const Unit& u, int wr, int wc, int fr, int fq) const {
        const int row0 = u.pm * BM + wr * 64 + fr; const int col0 = u.pn * BM + wc * 32 + 8 * fq;
#pragma unroll
        for (int ai = 0; ai < 2; ++ai)
#pragma unroll
            for (int m = 0; m < 4; ++m) { const int row = row0 + ai * HALF + m * 16;
#pragma unroll
                for (int bj = 0; bj < 2; ++bj) { const int col = col0 + bj * HALF;
                    const u32x4 gv = *(const u32x4*)(G + (size_t)row * 6144 + gofs + col);
                    const f32x4 a0 = acc[ai][bj][m][0], a1 = acc[ai][bj][m][1];
                    float r[8];
                    r[0] = __builtin_bit_cast(float, gv.x << 16) * a0[0]; r[1] = __builtin_bit_cast(float, gv.x & 0xffff0000u) * a0[1];
                    r[2] = __builtin_bit_cast(float, gv.y << 16) * a0[2]; r[3] = __builtin_bit_cast(float, gv.y & 0xffff0000u) * a0[3];
                    r[4] = __builtin_bit_cast(float, gv.z << 16) * a1[0]; r[5] = __builtin_bit_cast(float, gv.z & 0xffff0000u) * a1[1];
                    r[6] = __builtin_bit_cast(float, gv.w << 16) * a1[2]; r[7] = __builtin_bit_cast(float, gv.w & 0xffff0000u) * a1[3];
                    bf16_t* mp = MG + (size_t)row * 2048 + col;
                    if (ACC) { const u32x4 ov = *(const u32x4*)mp;
                        r[0] += __builtin_bit_cast(float, ov.x << 16); r[1] += __builtin_bit_cast(float, ov.x & 0xffff0000u);
                        r[2] += __builtin_bit_cast(float, ov.y << 16); r[3] += __builtin_bit_cast(float, ov.y & 0xffff0000u);
                        r[4] += __builtin_bit_cast(float, ov.z << 16); r[5] += __builtin_bit_cast(float, ov.z & 0xffff0000u);
                        r[6] += __builtin_bit_cast(float, ov.w << 16); r[7] += __builtin_bit_cast(float, ov.w & 0xffff0000u); }
                    u32x4 w; w.x = cvt_pk_bf16(r[0], r[1]); w.y = cvt_pk_bf16(r[2], r[3]); w.z = cvt_pk_bf16(r[4], r[5]); w.w = cvt_pk_bf16(r[6], r[7]);
                    *(u32x4*)mp = w; } }
    }
};
struct EpiGate3 {
    static constexpr bool PERM = true, AFTER_DRAIN = false; static constexpr int A_ROWS = 256; static constexpr bool HAS_SEG = true;
    const bf16_t* G; bf16_t* MG; int t1, t2;
    __device__ __forceinline__ void seg(f32x4 (&acc)[2][2][4][2], const Unit& u, int t, int wr, int wc, int fr, int fq) const {
        typedef unsigned u32x2 __attribute__((ext_vector_type(2)));
        const int gnum = (t == t1) ? 0 : 2048;
        const bf16_t* gp0 = G + (size_t)(u.pm * BM + wr * 64 + fr) * 6144 + gnum + u.pn * BM + wc * 32 + 8 * fq;
#pragma unroll
        for (int ai = 0; ai < 2; ++ai)
#pragma unroll
            for (int m = 0; m < 4; ++m)
#pragma unroll
                for (int bj = 0; bj < 2; ++bj)
#pragma unroll
                    for (int n = 0; n < 2; ++n) {
                        const bf16_t* gp = gp0 + (size_t)(ai * HALF + m * 16) * 6144 + bj * HALF + 4 * n;
                        const u32x2 gn = *(const u32x2*)gp, gd = *(const u32x2*)(gp + 2048);
                        f32x4 r;
                        r[0] = __builtin_bit_cast(float, gn.x << 16) * __builtin_amdgcn_rcpf(__builtin_bit_cast(float, gd.x << 16)); r[1] = __builtin_bit_cast(float, gn.x & 0xffff0000u) * __builtin_amdgcn_rcpf(__builtin_bit_cast(float, gd.x & 0xffff0000u));
                        r[2] = __builtin_bit_cast(float, gn.y << 16) * __builtin_amdgcn_rcpf(__builtin_bit_cast(float, gd.y << 16)); r[3] = __builtin_bit_cast(float, gn.y & 0xffff0000u) * __builtin_amdgcn_rcpf(__builtin_bit_cast(float, gd.y & 0xffff0000u));
                        acc[ai][bj][m][n] *= r; if (n == 1 && bj == 1) asm volatile("" ::: "memory"); }
    }
    __device__ __forceinline__ void operator()(const f32x4 (&acc)[2][2][4][2], const Unit& u, int wr, int wc, int fr, int fq) const {
        const int row0 = u.pm * BM + wr * 64 + fr; const int col0 = u.pn * BM + wc * 32 + 8 * fq;
#pragma unroll
        for (int ai = 0; ai < 2; ++ai)
#pragma unroll
            for (int m = 0; m < 4; ++m) { const int row = row0 + ai * HALF + m * 16;
#pragma unroll
                for (int bj = 0; bj < 2; ++bj) { const int col = col0 + bj * HALF; const u32x4 gv = *(const u32x4*)(G + (size_t)row * 6144 + 4096 + col);
                    const f32x4 a0 = acc[ai][bj][m][0], a1 = acc[ai][bj][m][1];
                    u32x4 w;
                    w.x = cvt_pk_bf16(__builtin_bit_cast(float, gv.x << 16) * a0[0], __builtin_bit_cast(float, gv.x & 0xffff0000u) * a0[1]);
                    w.y = cvt_pk_bf16(__builtin_bit_cast(float, gv.y << 16) * a0[2], __builtin_bit_cast(float, gv.y & 0xffff0000u) * a0[3]);
                    w.z = cvt_pk_bf16(__builtin_bit_cast(float, gv.z << 16) * a1[0], __builtin_bit_cast(float, gv.z & 0xffff0000u) * a1[1]);
                    w.w = cvt_pk_bf16(__builtin_bit_cast(float, gv.w << 16) * a1[2], __builtin_bit_cast(float, gv.w & 0xffff0000u) * a1[3]);
                    *(u32x4*)(MG + (size_t)row * 2048 + col) = w; } }
    }
};
template <int CTRL> __device__ __forceinline__ float dpp_keep(float old, float x) { return __builtin_bit_cast(float, __builtin_amdgcn_update_dpp(__builtin_bit_cast(int, old), __builtin_bit_cast(int, x), CTRL, 0xF, 0xF, false)); }
struct EpiConv {
    static constexpr bool PERM = true, AFTER_DRAIN = false; static constexpr int A_ROWS = 254; static constexpr bool HAS_SEG = false;
    bf16_t* ACT; const float* cw; PG8_LAS float* xch;
    __device__ __forceinline__ void operator()(const f32x4 (&acc)[2][2][4][2], const Unit& u, int wr, int wc, int fr, int fq) const {
        const int cbase = wc * 32 + 8 * fq, f0 = u.pn * 128 + cbase;
        float c0[8], c1[8], c2[8];
#pragma unroll
        for (int j = 0; j < 8; ++j) { c0[j] = cw[f0 + j]; c1[j] = cw[5504 + f0 + j]; c2[j] = cw[2 * 5504 + f0 + j]; }
        if (fr >= 14) {
#pragma unroll
            for (int ai = 0; ai < 2; ++ai)
#pragma unroll
                for (int n = 0; n < 2; ++n) *(PG8_LAS f32x4*)(xch + ((2 * ai + wr) * 2 + (fr - 14)) * 128 + cbase + 4 * n) = acc[ai][0][3][n];
        }
        asm volatile("s_waitcnt lgkmcnt(0)" ::: "memory"); __builtin_amdgcn_s_barrier(); asm volatile("" ::: "memory");
#pragma unroll
        for (int ai = 0; ai < 2; ++ai) {
            const int sl = 2 * ai + wr;
            f32x4 e1[2], e2[2];
#pragma unroll
            for (int n = 0; n < 2; ++n) { e1[n] = (f32x4){0.f, 0.f, 0.f, 0.f}; e2[n] = e1[n];
                if (sl > 0) { e2[n] = *(const PG8_LAS f32x4*)(xch + ((sl - 1) * 2 + 0) * 128 + cbase + 4 * n); e1[n] = *(const PG8_LAS f32x4*)(xch + ((sl - 1) * 2 + 1) * 128 + cbase + 4 * n); } }
#pragma unroll
            for (int m = 0; m < 4; ++m) {
                const int lr = 128 * ai + 64 * wr + 16 * m + fr; const int grow = 254 * u.pm - 2 + lr; const int t = grow & 8191;
                float r[8];
#pragma unroll
                for (int n = 0; n < 2; ++n)
#pragma unroll
                    for (int j = 0; j < 4; ++j) {
                        const float x = acc[ai][0][m][n][j];
                        float k1, k2;
                        if (m > 0) { const float xp = acc[ai][0][m > 0 ? m - 1 : 0][n][j]; k1 = dpp_keep<0x121>(xp, xp); k2 = dpp_keep<0x122>(xp, xp); }
                        else { k1 = e1[n][j]; k2 = (fr == 0) ? e2[n][j] : e1[n][j]; }
                        float p1 = dpp_keep<0x111>(k1, x), p2 = dpp_keep<0x112>(k2, x);
                        if (t == 0) p1 = 0.f; if (t <= 1) p2 = 0.f;
                        const float gs = c0[4 * n + j] * p2 + c1[4 * n + j] * p1 + c2[4 * n + j] * x;
                        r[4 * n + j] = gs * __builtin_amdgcn_rcpf(1.0f + __expf(-gs)) * acc[ai][1][m][n][j];
                    }
                if (lr >= 2 && grow < 16384) { u32x4 w; w.x = cvt_pk_bf16(r[0], r[1]); w.y = cvt_pk_bf16(r[2], r[3]); w.z = cvt_pk_bf16(r[4], r[5]); w.w = cvt_pk_bf16(r[6], r[7]);
                    *(u32x4*)(ACT + (size_t)grow * 5504 + f0) = w; }
            }
        }
    }
};
}

struct Args { const float* in[25]; float* out; unsigned char* ws; int ph_lo, ph_hi, li, pad; };

struct Ctx {
    LAS unsigned char* lds;
    int tid, lane, wave, G, bid;
    int gw, ngw;
};

__device__ __forceinline__ void transpose_item(const float* W, int K, int N, bf16* WT, int kb, int nb, int dst_row0, LAS float* scr, int lane, int ldk = 0, int koff = 0) {
    if (ldk == 0) ldk = K;
    const int k0 = 64 * kb, n0 = 32 * nb;
#pragma unroll 8
    for (int i = 0; i < 32; ++i) { const int kk = 2 * i + (lane >> 5); scr[kk * 33 + (lane & 31)] = W[(size_t)(k0 + kk) * N + n0 + (lane & 31)]; }
    LDS_WAIT(); asm volatile("" ::: "memory");
    const int c = lane & 7;
#pragma unroll
    for (int j = 0; j < 4; ++j) { const int n = (lane >> 3) + 8 * j; const LAS float* s = scr + (8 * c) * 33 + n;
        v4u o; o.x = pk2(s[0 * 33], s[1 * 33]); o.y = pk2(s[2 * 33], s[3 * 33]); o.z = pk2(s[4 * 33], s[5 * 33]); o.w = pk2(s[6 * 33], s[7 * 33]);
        *(v4u*)(WT + (size_t)(dst_row0 + n) * ldk + koff + k0 + 8 * c) = o; }
    LDS_WAIT(); asm volatile("" ::: "memory");
}
__device__ __forceinline__ int transpose_matrix(int widx, int nw, int lane, LAS float* scr, const float* W, int K, int N, bf16* WT, int gate_split, int base, int ldk = 0, int koff = 0) {
    const int nblk = N / 32, items = (K / 64) * nblk;
    int first = (widx - base) % nw; if (first < 0) first += nw;
    for (int it = first; it < items; it += nw) {
        const int kb = it / nblk, nb = it % nblk; int dr = 32 * nb; if (gate_split == 1 && dr >= C_END) dr += 64;
        if (gate_split == 2) { const int f = dr < DFF ? dr : dr - DFF; dr = 256 * (f >> 7) + (f & 127) + (dr < DFF ? 0 : 128); }
        transpose_item(W, K, N, WT, kb, nb, dr, scr, lane, ldk, koff);
    }
    return base + items;
}
__device__ __forceinline__ void convert_weights(int widx, int nw, int lane, LAS float* scr, const Args& a, int l, unsigned char* ws) {
    unsigned char* wsw = ws + (size_t)(l & 1) * WSET_STRIDE;
    int base = 0;
    base = transpose_matrix(widx, nw, lane, scr, a.in[3] + (size_t)l * D * DIN, D, DIN, (bf16*)(wsw + WS_WIN), 1, base);
    base = transpose_matrix(widx, nw, lane, scr, a.in[21] + (size_t)l * D * NUP, D, NUP, (bf16*)(wsw + WS_WUP), 2, base);
    base = transpose_matrix(widx, nw, lane, scr, a.in[23] + (size_t)l * DFF * D, DFF, D, (bf16*)(wsw + WS_WDOWN), 0, base);
    base = transpose_matrix(widx, nw, lane, scr, a.in[19] + (size_t)l * D * D, D, D, (bf16*)(wsw + WS_WOUT), 0, base);
    base = transpose_matrix(widx, nw, lane, scr, a.in[16] + (size_t)l * 512 * D, 512, D, (bf16*)(wsw + WS_PA), 0, base, 1536, 0);
    base = transpose_matrix(widx, nw, lane, scr, a.in[17] + (size_t)l * 768 * D, 768, D, (bf16*)(wsw + WS_PA), 0, base, 1536, 512);
    base = transpose_matrix(widx, nw, lane, scr, a.in[18] + (size_t)l * 256 * D, 256, D, (bf16*)(wsw + WS_PA), 0, base, 1536, 1280);
    const int gt = widx * 64 + lane, ngt = nw * 64;
    { v4u* z = (v4u*)((bf16*)(wsw + WS_WIN) + (size_t)C_END * D); for (int i = gt; i < 64 * D / 8; i += ngt) z[i] = (v4u){0u, 0u, 0u, 0u}; }
    { bf16* wl = (bf16*)(wsw + WS_WLORA); const float* wup = a.in[7] + (size_t)l * 96 * BW; const float* aup = a.in[9] + (size_t)l * 96 * BW; const float* gup = a.in[10] + (size_t)l * 256 * BW;
      for (int i = gt; i < NLORA * KLORA; i += ngt) { const int n = i / KLORA, k = i % KLORA; float v = 0.f;
          if (n < 768) { if (k < 96) v = wup[k * BW + n]; }
          else if (n < 1536) { if (k >= 96 && k < 192) v = aup[(k - 96) * BW + (n - 768)]; }
          else { if (k >= 192 && k < 448) v = gup[(k - 192) * BW + (n - 1536)]; }
          wl[i] = (bf16)f2bf(v); } }
}

__device__ __forceinline__ void rms_row_bf16(const float* xrow, const float* gam, bf16* orow, int lane) {
    const f32x4* xr = (const f32x4*)xrow + lane; f32x4 v[8]; float s = 0.f;
#pragma unroll
    for (int j = 0; j < 8; ++j) { v[j] = xr[64 * j]; s += (v[j].x * v[j].x + v[j].y * v[j].y) + (v[j].z * v[j].z + v[j].w * v[j].w); }
    const float rs = 1.0f / sqrtf(wave_sum(s) * (1.0f / D) + NORM_EPS);
    const f32x4* gr = (const f32x4*)gam + lane; v2u* o8 = (v2u*)orow + lane;
#pragma unroll
    for (int j = 0; j < 8; ++j) { const f32x4 g = gr[64 * j]; v2u w; w.x = pk2(v[j].x * rs * g.x, v[j].y * rs * g.y); w.y = pk2(v[j].z * rs * g.z, v[j].w * rs * g.w); o8[64 * j] = w; }
}
__device__ __forceinline__ void rms_row2_bf16(const float* xrow, const float* gam, bf16* orow, int lane) {
    const f32x4* xr = (const f32x4*)xrow + lane; f32x4 v[16]; float s0 = 0.f, s1 = 0.f;
#pragma unroll
    for (int j = 0; j < 16; ++j) v[j] = xr[64 * j];
#pragma unroll
    for (int j = 0; j < 8; ++j) { s0 += (v[j].x * v[j].x + v[j].y * v[j].y) + (v[j].z * v[j].z + v[j].w * v[j].w); s1 += (v[8 + j].x * v[8 + j].x + v[8 + j].y * v[8 + j].y) + (v[8 + j].z * v[8 + j].z + v[8 + j].w * v[8 + j].w); }
    const float rs0 = 1.0f / sqrtf(wsum(s0) * (1.0f / D) + NORM_EPS), rs1 = 1.0f / sqrtf(wsum(s1) * (1.0f / D) + NORM_EPS);
    const f32x4* gr = (const f32x4*)gam + lane; v2u* o8 = (v2u*)orow + lane;
#pragma unroll
    for (int j = 0; j < 8; ++j) { const f32x4 g = gr[64 * j]; v2u w; w.x = pk2(v[j].x * rs0 * g.x, v[j].y * rs0 * g.y); w.y = pk2(v[j].z * rs0 * g.z, v[j].w * rs0 * g.w); o8[64 * j] = w;
        v2u w1; w1.x = pk2(v[8 + j].x * rs1 * g.x, v[8 + j].y * rs1 * g.y); w1.y = pk2(v[8 + j].z * rs1 * g.z, v[8 + j].w * rs1 * g.w); o8[64 * (8 + j)] = w1; }
}
__device__ __forceinline__ void rms_row_f32(float* xrow, const float* gam, int lane) {
    f32x4* xr = (f32x4*)xrow + lane; f32x4 v[8]; float s = 0.f;
#pragma unroll
    for (int j = 0; j < 8; ++j) { v[j] = xr[64 * j]; s += (v[j].x * v[j].x + v[j].y * v[j].y) + (v[j].z * v[j].z + v[j].w * v[j].w); }
    const float rs = 1.0f / sqrtf(wave_sum(s) * (1.0f / D) + NORM_EPS);
    const f32x4* gr = (const f32x4*)gam + lane;
#pragma unroll
    for (int j = 0; j < 8; ++j) { const f32x4 g = gr[64 * j]; xr[64 * j] = v[j] * rs * g; }
}

__device__ __forceinline__ void phase_prep(const Ctx& C, const Args& a, int l, const float* xsrc, unsigned char* ws) {
    if (l == 0) convert_weights(C.gw, C.ngw, C.lane, (LAS float*)(C.lds + RING_OFF + C.wave * 16384), a, 0, ws);
    const float* g1 = a.in[2] + (size_t)l * D; bf16* H = (bf16*)(ws + WS_H);
    for (int m = 2 * C.gw; m < M; m += 2 * C.ngw) rms_row2_bf16(xsrc + (size_t)m * D, g1, H + (size_t)m * D, C.lane);
}

__device__ __forceinline__ void phase_aprime(const Ctx& C, const Args& a, int l, unsigned char* ws) {
    const bf16* P1 = (const bf16*)(ws + WS_P1); bf16* AP = (bf16*)(ws + WS_AP); const float* mu = a.in[5] + (size_t)l * BCOLS;
    const int g = C.lane, c0 = 8 * g;
    float muv[8];
#pragma unroll
    for (int j = 0; j < 8; ++j) muv[j] = (g < 56) ? mu[(C_WD - C_R) + c0 + j] : 0.f;
    for (int m = C.gw; m < M; m += C.ngw) {
        v4u o = (v4u){0u, 0u, 0u, 0u};
        if (g < 56) {
            const v4u cur = *(const v4u*)(P1 + (size_t)m * NP1 + C_WD + c0);
            v4u prv = (v4u){0u, 0u, 0u, 0u}; if ((m & (SEQ - 1)) != 0) prv = *(const v4u*)(P1 + (size_t)(m - 1) * NP1 + C_WD + c0);
            float x[8], p[8];
            x[0] = bflo(cur.x); x[1] = bfhi(cur.x); x[2] = bflo(cur.y); x[3] = bfhi(cur.y); x[4] = bflo(cur.z); x[5] = bfhi(cur.z); x[6] = bflo(cur.w); x[7] = bfhi(cur.w);
            p[0] = bflo(prv.x); p[1] = bfhi(prv.x); p[2] = bflo(prv.y); p[3] = bfhi(prv.y); p[4] = bflo(prv.z); p[5] = bfhi(prv.z); p[6] = bflo(prv.w); p[7] = bfhi(prv.w);
#pragma unroll
            for (int j = 0; j < 8; ++j) { float v = x[j] + (p[j] - x[j]) * muv[j];
                if (g < 12) v = tanhf(v); else if (g >= 24) v = sigmoidf_(v);
                x[j] = v; }
            o.x = pk2(x[0], x[1]); o.y = pk2(x[2], x[3]); o.z = pk2(x[4], x[5]); o.w = pk2(x[6], x[7]);
        }
        *(v4u*)(AP + (size_t)m * KLORA + c0) = o;
    }
}

struct PrepTok { float r, kt, v, w, kk, b; };
__device__ __forceinline__ PrepTok prep_token(const bf16* P1, const float* LO, int m, int hc, float mur, float muk, float muv, float w0, float a0, float kkw, float kaw) {
    const bool first = (m & (SEQ - 1)) == 0;
    const bf16* pr = P1 + (size_t)m * NP1; const bf16* pp = pr - NP1;
    float r = bf1(pr[C_R + hc]), k = bf1(pr[C_K + hc]), v = bf1(pr[C_V + hc]);
    const float rp = first ? 0.f : bf1(pp[C_R + hc]), kp = first ? 0.f : bf1(pp[C_K + hc]), vp = first ? 0.f : bf1(pp[C_V + hc]);
    r = r + (rp - r) * mur; k = k + (kp - k) * muk; v = v + (vp - v) * muv;
    const float wpre = w0 + LO[(size_t)m * NLORA + hc], apre = a0 + LO[(size_t)m * NLORA + BW + hc];
    const float xx = -wpre; const float sp = fmaxf(xx, 0.f) + log1pf(expf(-fabsf(xx)));
    const float wlog = -sp - 0.5f; const float decay = expf(-expf(wlog));
    const float av = 1.0f / (1.0f + expf(-apre));
    const float kkr = k * kkw; const float nrm = sqrtf(wave_sum(kkr * kkr)); const float kk = kkr / fmaxf(nrm, 1e-12f);
    PrepTok t; t.r = r; t.kt = k * (1.0f + (av - 1.0f) * kaw); t.v = v; t.w = decay; t.kk = kk; t.b = kk * av; return t;
}
struct PrepRaw { v2u r, k, v; f32x4 lw, la; };
__device__ __forceinline__ PrepRaw prep_load(const bf16* P1, const float* LO, int m, int c0) {
    PrepRaw x; const bf16* pr = P1 + (size_t)m * NP1 + c0;
    x.r = *(const v2u*)(pr + C_R); x.k = *(const v2u*)(pr + C_K); x.v = *(const v2u*)(pr + C_V);
    x.lw = *(const f32x4*)(LO + (size_t)m * NLORA + c0); x.la = *(const f32x4*)(LO + (size_t)m * NLORA + BW + c0); return x;
}
__device__ __forceinline__ void un4(const v2u w, float (&x)[4]) { x[0] = bflo(w.x); x[1] = bfhi(w.x); x[2] = bflo(w.y); x[3] = bfhi(w.y); }
__device__ __forceinline__ void phase_scanprep(const Ctx& C, const Args& a, int l, unsigned char* ws) {
    const bf16* P1 = (const bf16*)(ws + WS_P1); const float* LO = (const float*)(ws + WS_LO);
    float* SR = (float*)(ws + WS_SR); float* SW = (float*)(ws + WS_SW); float* SK = (float*)(ws + WS_SK); float* SU = (float*)(ws + WS_SKK); float* SB = (float*)(ws + WS_SB); float* SV = (float*)(ws + WS_SV);
    float* BK = (float*)(ws + WS_BK); float* BON = (float*)(ws + WS_BON);
    const float* mu = a.in[5] + (size_t)l * BCOLS; const float* w0p = a.in[6] + (size_t)l * BW; const float* a0p = a.in[8] + (size_t)l * BW;
    const float* kkwp = a.in[11] + (size_t)l * BW; const float* kawp = a.in[12] + (size_t)l * BW; const float* rkp = a.in[13] + (size_t)l * BW;
    constexpr int RL = 8;
    const int g = C.lane >> 4, cq = C.lane & 15;
    for (int it = C.gw; it < (M / (4 * RL)) * 12; it += C.ngw) {
        const int h = it % 12, m0 = ((it / 12) * 4 + g) * RL, c0 = h * 64 + 4 * cq;
        const f32x4 mur = *(const f32x4*)(mu + c0), muk = *(const f32x4*)(mu + BW + c0), muv = *(const f32x4*)(mu + 2 * BW + c0), w0 = *(const f32x4*)(w0p + c0), a0 = *(const f32x4*)(a0p + c0);
        const f32x4 kkw = *(const f32x4*)(kkwp + c0), kaw = *(const f32x4*)(kawp + c0), rkc = *(const f32x4*)(rkp + c0);
        const bool seq_start = (m0 & (SEQ - 1)) == 0;
        float prr[4] = {0.f, 0.f, 0.f, 0.f}, prk[4] = {0.f, 0.f, 0.f, 0.f}, prv[4] = {0.f, 0.f, 0.f, 0.f}, pw[4] = {0.f, 0.f, 0.f, 0.f}, pb[4] = {0.f, 0.f, 0.f, 0.f}, pkt[4] = {0.f, 0.f, 0.f, 0.f};
        if (!seq_start) { const bf16* pr = P1 + (size_t)(m0 - 2) * NP1 + c0; un4(*(const v2u*)(pr + C_R), prr); un4(*(const v2u*)(pr + C_K), prk); un4(*(const v2u*)(pr + C_V), prv); }
        PrepRaw nx = prep_load(P1, LO, seq_start ? m0 : m0 - 1, c0);
#pragma unroll 1
        for (int i = seq_start ? 0 : -1; i < RL; ++i) {
            const int m = m0 + i; const PrepRaw cu = nx;
            if (i + 1 < RL) nx = prep_load(P1, LO, m + 1, c0);
            float xr[4], xk[4], xv[4]; un4(cu.r, xr); un4(cu.k, xk); un4(cu.v, xv);
            float tr[4], tk[4], tv[4], tw[4], ta[4], kkr[4]; float q = 0.f;
#pragma unroll
            for (int e = 0; e < 4; ++e) {
                tr[e] = xr[e] + (prr[e] - xr[e]) * mur[e]; tk[e] = xk[e] + (prk[e] - xk[e]) * muk[e]; tv[e] = xv[e] + (prv[e] - xv[e]) * muv[e];
                const float xx = -(w0[e] + cu.lw[e]); const float sp = fmaxf(xx, 0.f) + __logf(1.0f + __expf(-fabsf(xx)));
                tw[e] = __expf(-__expf(-sp - 0.5f)); ta[e] = __builtin_amdgcn_rcpf(1.0f + __expf(-(a0[e] + cu.la[e])));
                kkr[e] = tk[e] * kkw[e]; q += kkr[e] * kkr[e];
            }
            q = red16(q); const float rn = __builtin_amdgcn_rsqf(fmaxf(q, 1e-24f));
            float tkk[4], tb[4], tkt[4]; float be = 0.f, ka = 0.f, bo = 0.f;
#pragma unroll
            for (int e = 0; e < 4; ++e) { tkk[e] = kkr[e] * rn; tb[e] = tkk[e] * ta[e]; tkt[e] = tk[e] * (1.0f + (ta[e] - 1.0f) * kaw[e]);
                be += pb[e] * tkk[e]; ka += pkt[e] * tkk[e]; bo += tr[e] * tkt[e] * rkc[e]; }
            if (i >= 0) {
                be = red16(be); ka = red16(ka); bo = red16(bo);
                const size_t o = (size_t)m * BW + c0; const bool first = (m & (SEQ - 1)) == 0;
                *(f32x4*)(SR + o) = (f32x4){tr[0], tr[1], tr[2], tr[3]}; *(f32x4*)(SW + o) = (f32x4){tw[0], tw[1], tw[2], tw[3]}; *(f32x4*)(SK + o) = (f32x4){tkt[0], tkt[1], tkt[2], tkt[3]};
                *(f32x4*)(SB + o) = (f32x4){tb[0], tb[1], tb[2], tb[3]}; *(f32x4*)(SV + o) = (f32x4){tv[0], tv[1], tv[2], tv[3]};
                if (!first) *(f32x4*)(SU + o - BW) = (f32x4){pw[0] * tkk[0], pw[1] * tkk[1], pw[2] * tkk[2], pw[3] * tkk[3]};
                if ((m & (SEQ - 1)) == SEQ - 1) *(f32x4*)(SU + o) = (f32x4){0.f, 0.f, 0.f, 0.f};
                if (cq < 2) BK[((size_t)m * 12 + h) * 2 + cq] = first ? 0.f : (cq == 0 ? be : ka);
                if (cq == 2) BON[(size_t)m * 12 + h] = bo;
            }
#pragma unroll
            for (int e = 0; e < 4; ++e) { prr[e] = xr[e]; prk[e] = xk[e]; prv[e] = xv[e]; pw[e] = tw[e]; pb[e] = tb[e]; pkt[e] = tkt[e]; }
        }
    }
}

typedef float f32x4c __attribute__((ext_vector_type(4)));
#define MFMA4(a, b, c) __builtin_amdgcn_mfma_f32_16x16x4f32((a), (b), (c), 0, 0, 0)
__device__ __forceinline__ void split8(const float (&x)[8], v4u& hi, v4u& lo) {
    unsigned h[4], l[4];
#pragma unroll
    for (int p = 0; p < 4; ++p) { h[p] = pg8::cvt_pk_bf16(x[2 * p], x[2 * p + 1]); l[p] = pg8::cvt_pk_bf16(x[2 * p] - bflo(h[p]), x[2 * p + 1] - bfhi(h[p])); }
    hi = (v4u){h[0], h[1], h[2], h[3]}; lo = (v4u){l[0], l[1], l[2], l[3]};
}
constexpr int CP_LD = 65, CP_ARR = 16 * CP_LD, CP_SM = 16 * 17;
constexpr int CP_WAVE_FLOATS = 4 * CP_ARR + 4 * CP_SM;
__device__ __forceinline__ void phase_chunkprep(const Ctx& C, const Args& a, int l, unsigned char* ws) {
    if (C.wave >= 6) return;
    const bf16* P1 = (const bf16*)(ws + WS_P1); const float* LO = (const float*)(ws + WS_LO);
    float* SV = (float*)(ws + WS_SV); float* BON = (float*)(ws + WS_BON); float* COP = (float*)(ws + WS_COP);
    const float* mu = a.in[5] + (size_t)l * BCOLS; const float* w0p = a.in[6] + (size_t)l * BW; const float* a0p = a.in[8] + (size_t)l * BW;
    const float* kkwp = a.in[11] + (size_t)l * BW; const float* kawp = a.in[12] + (size_t)l * BW; const float* rkp = a.in[13] + (size_t)l * BW;
    LAS float* L = (LAS float*)(C.lds + RING_OFF) + C.wave * CP_WAVE_FLOATS;
    LAS float* At = L; LAS float* Bt = L + CP_ARR; LAS float* Kt = L + 2 * CP_ARR; LAS float* Rt = L + 3 * CP_ARR;
    LAS float* Sa = L + 4 * CP_ARR; LAS float* Sb = Sa + CP_SM; LAS float* Sc = Sb + CP_SM; LAS float* Sd = Sc + CP_SM;
    const int lane = C.lane, li = lane & 15, q = lane >> 4;
    const int widx = C.bid * 6 + C.wave, nw = C.G * 6;
    for (int it = widx; it < 24 * 512; it += nw) {
        const int hs = it >> 9, c = it & 511, b = hs / 12, h = hs % 12, hc = h * 64 + lane; const int m0 = b * SEQ + c * 16;
        const float mur = mu[hc], muk = mu[BW + hc], muv = mu[2 * BW + hc], w0 = w0p[hc], a0 = a0p[hc], kkw = kkwp[hc], kaw = kawp[hc], rkc = rkp[hc];
        float rr[17], rk_[17], rv[17], lw[16], la[16];
#pragma unroll
        for (int j = 0; j < 17; ++j) { const bool ok = !((c == 0) && j == 0); const size_t row = ok ? (size_t)(m0 - 1 + j) : (size_t)m0; const bf16* pr = P1 + row * NP1 + hc;
            const float x0 = bf1(pr[C_R]), x1 = bf1(pr[C_K]), x2 = bf1(pr[C_V]); rr[j] = ok ? x0 : 0.f; rk_[j] = ok ? x1 : 0.f; rv[j] = ok ? x2 : 0.f;
            if (j >= 1) { lw[j - 1] = LO[row * NLORA + hc]; la[j - 1] = LO[row * NLORA + BW + hc]; } }
        float cum = 0.f;
#pragma unroll
        for (int i = 0; i < 16; ++i) {
            const float tr = rr[i + 1] + (rr[i] - rr[i + 1]) * mur, tk = rk_[i + 1] + (rk_[i] - rk_[i + 1]) * muk, tv = rv[i + 1] + (rv[i] - rv[i + 1]) * muv;
            const float xx = -(w0 + lw[i]); const float sp = fmaxf(xx, 0.f) + __logf(1.0f + __expf(-fabsf(xx)));
            const float lwv = -__expf(-sp - 0.5f);
            const float av = __builtin_amdgcn_rcpf(1.0f + __expf(-(a0 + la[i])));
            const float kkr = tk * kkw; const float kk = kkr * __builtin_amdgcn_rsqf(fmaxf(wsum(kkr * kkr), 1e-24f));
            const float kt = tk * (1.0f + (av - 1.0f) * kaw), bb = kk * av;
            const float bo = wsum(tr * kt * rkc);
            SV[(size_t)(m0 + i) * BW + hc] = tv; if (lane == 0) BON[(size_t)(m0 + i) * 12 + h] = bo;
            const float ex = __expf(cum); cum += lwv; const float ei = __expf(cum), eni = __expf(-cum);
            At[i * CP_LD + lane] = -kk * ex; Bt[i * CP_LD + lane] = bb * eni; Kt[i * CP_LD + lane] = kt * eni; Rt[i * CP_LD + lane] = tr * ei;
        }
        const float gam = __expf(cum);
        LDS_WAIT(); asm volatile("" ::: "memory");
        f32x4c gab = {0.f, 0.f, 0.f, 0.f}, gak = gab, grb = gab, grk = gab;
#pragma unroll
        for (int s_ = 0; s_ < 16; ++s_) { const int o = li * CP_LD + 4 * s_ + q; const float fa = At[o], fr = Rt[o], fb = Bt[o], fk = Kt[o];
            gab = MFMA4(fa, fb, gab); gak = MFMA4(fa, fk, gak); grb = MFMA4(fr, fb, grb); grk = MFMA4(fr, fk, grk); }
#pragma unroll
        for (int e = 0; e < 4; ++e) { const int i = 4 * q + e, j = li; if (!(j < i)) { gab[e] = 0.f; gak[e] = 0.f; } if (!(j <= i)) { grb[e] = 0.f; grk[e] = 0.f; }
            Sa[i * 17 + j] = gab[e]; Sb[i * 17 + j] = gak[e]; Sc[i * 17 + j] = grb[e]; }
        LDS_WAIT(); asm volatile("" ::: "memory");
        float tt[16];
#pragma unroll
        for (int i = 0; i < 16; ++i) { float acc = (i == li) ? 1.f : 0.f;
#pragma unroll
            for (int j = 0; j < i; ++j) acc += Sa[i * 17 + j] * tt[j];
            tt[i] = acc; }
        if (q == 0) {
#pragma unroll
            for (int i = 0; i < 16; ++i) Sd[i * 17 + li] = tt[i]; }
        LDS_WAIT(); asm volatile("" ::: "memory");
        float tf[4], mrbf[4];
#pragma unroll
        for (int s_ = 0; s_ < 4; ++s_) { tf[s_] = Sd[li * 17 + 4 * s_ + q]; mrbf[s_] = Sc[li * 17 + 4 * s_ + q]; }
        f32x4c w1[4], u0 = {0.f, 0.f, 0.f, 0.f};
#pragma unroll
        for (int n = 0; n < 4; ++n) { w1[n] = (f32x4c){0.f, 0.f, 0.f, 0.f};
#pragma unroll
            for (int s_ = 0; s_ < 4; ++s_) w1[n] = MFMA4(tf[s_], At[(4 * s_ + q) * CP_LD + 16 * n + li], w1[n]); }
#pragma unroll
        for (int s_ = 0; s_ < 4; ++s_) u0 = MFMA4(tf[s_], Sb[(4 * s_ + q) * 17 + li], u0);
        LDS_WAIT(); asm volatile("" ::: "memory");
#pragma unroll
        for (int n = 0; n < 4; ++n)
#pragma unroll
            for (int e = 0; e < 4; ++e) At[(4 * q + e) * CP_LD + 16 * n + li] = w1[n][e];
#pragma unroll
        for (int e = 0; e < 4; ++e) Sa[(4 * q + e) * 17 + li] = u0[e];
        LDS_WAIT(); asm volatile("" ::: "memory");
        f32x4c ry[4], y0 = grk;
#pragma unroll
        for (int n = 0; n < 4; ++n) {
#pragma unroll
            for (int e = 0; e < 4; ++e) ry[n][e] = Rt[(4 * q + e) * CP_LD + 16 * n + li];
#pragma unroll
            for (int s_ = 0; s_ < 4; ++s_) ry[n] = MFMA4(mrbf[s_], At[(4 * s_ + q) * CP_LD + 16 * n + li], ry[n]); }
#pragma unroll
        for (int s_ = 0; s_ < 4; ++s_) y0 = MFMA4(mrbf[s_], Sa[(4 * s_ + q) * 17 + li], y0);
        LDS_WAIT(); asm volatile("" ::: "memory");
#pragma unroll
        for (int n = 0; n < 4; ++n)
#pragma unroll
            for (int e = 0; e < 4; ++e) Rt[(4 * q + e) * CP_LD + 16 * n + li] = ry[n][e];
#pragma unroll
        for (int e = 0; e < 4; ++e) Sb[(4 * q + e) * 17 + li] = y0[e];
        LDS_WAIT(); asm volatile("" ::: "memory");
        float* rec = COP + ((size_t)hs * 512 + c) * COP_STRIDE; unsigned* recu = (unsigned*)rec;
#pragma unroll
        for (int kb = 0; kb < 2; ++kb) { float x[8];
#pragma unroll
            for (int jj = 0; jj < 8; ++jj) x[jj] = At[li * CP_LD + 16 * (2 * kb + (jj >> 2)) + 4 * q + (jj & 3)];
            v4u hi, lo; split8(x, hi, lo); *(v4u*)(recu + COP_W1 + lane * 16 + 8 * kb) = hi; *(v4u*)(recu + COP_W1 + lane * 16 + 8 * kb + 4) = lo; }
        { float x[8];
#pragma unroll
          for (int jj = 0; jj < 8; ++jj) x[jj] = jj < 4 ? Sa[li * 17 + 4 * q + jj] : 0.f;
          v4u hi, lo; split8(x, hi, lo); *(v4u*)(recu + COP_U0 + lane * 8) = hi; *(v4u*)(recu + COP_U0 + lane * 8 + 4) = lo; }
#pragma unroll
        for (int m = 0; m < 4; ++m) { float x[8]; const float gk = __shfl(gam, 16 * m + li);
#pragma unroll
            for (int jj = 0; jj < 8; ++jj) x[jj] = gk * (jj < 4 ? Bt[(4 * q + jj) * CP_LD + 16 * m + li] : Kt[(4 * q + jj - 4) * CP_LD + 16 * m + li]);
            v4u hi, lo; split8(x, hi, lo); *(v4u*)(recu + COP_BK + lane * 32 + 8 * m) = hi; *(v4u*)(recu + COP_BK + lane * 32 + 8 * m + 4) = lo; }
#pragma unroll
        for (int m = 0; m < 4; ++m) { f32x4 y;
#pragma unroll
            for (int j = 0; j < 4; ++j) y[j] = Rt[li * CP_LD + 16 * m + 4 * q + j];
            *(f32x4*)(rec + COP_RY + lane * 16 + 4 * m) = y; }
        { f32x4 y;
#pragma unroll
          for (int s_ = 0; s_ < 4; ++s_) y[s_] = Sb[li * 17 + 4 * q + s_];
          *(f32x4*)(rec + COP_Y0 + lane * 4) = y; }
        rec[COP_GAM + lane] = gam;
        LDS_WAIT(); asm volatile("" ::: "memory");
    }
}

__device__ __forceinline__ void scan_block(const Ctx& C, int sb, unsigned char* ws) {
    const int b = sb / 24, h = (sb % 24) >> 1, half = sb & 1;
    const float* SR = (const float*)(ws + WS_SR); const float* SW = (const float*)(ws + WS_SW); const float* SK = (const float*)(ws + WS_SK); const float* SKK = (const float*)(ws + WS_SKK);
    const float* SB = (const float*)(ws + WS_SB); const float* SV = (const float*)(ws + WS_SV); float* YR = (float*)(ws + WS_YRAW);
    constexpr int T = 64;
    LAS float* Lr = (LAS float*)(C.lds + RING_OFF); LAS float* Lw = Lr + T * 64; LAS float* Lk = Lw + T * 64; LAS float* Lkk = Lk + T * 64; LAS float* Lb = Lkk + T * 64;
    LAS float* Lv = Lb + T * 64; LAS float* Ly = Lv + T * 32;
    const int tid = C.tid, rl = tid >> 4, kq = tid & 15;
    const size_t rowbase = (size_t)b * SEQ; const int colh = h * 64;
    const int lt0 = tid >> 4, lc0 = (tid & 15) * 4, vt = tid >> 3, vc = (tid & 7) * 4;
    f32x4 pr[2], pw[2], pk[2], pkk[2], pb[2], pv;
#define SCAN_LOAD(t0) do { _Pragma("unroll") for (int i = 0; i < 2; ++i) { const size_t o = (rowbase + (t0) + lt0 + 32 * i) * BW + colh + lc0; \
        pr[i] = *(const f32x4*)(SR + o); pw[i] = *(const f32x4*)(SW + o); pk[i] = *(const f32x4*)(SK + o); pkk[i] = *(const f32x4*)(SKK + o); pb[i] = *(const f32x4*)(SB + o); } \
        pv = *(const f32x4*)(SV + (rowbase + (t0) + vt) * BW + colh + 32 * half + vc); } while (0)
    SCAN_LOAD(0);
    float S0 = 0.f, S1 = 0.f, S2 = 0.f, S3 = 0.f;
    for (int ch = 0; ch < SEQ / T; ++ch) {
        const int t0 = ch * T;
#pragma unroll
        for (int i = 0; i < 2; ++i) { const int lo = (lt0 + 32 * i) * 64 + lc0;
            *(LAS f32x4*)(Lr + lo) = pr[i]; *(LAS f32x4*)(Lw + lo) = pw[i]; *(LAS f32x4*)(Lk + lo) = pk[i]; *(LAS f32x4*)(Lkk + lo) = pkk[i]; *(LAS f32x4*)(Lb + lo) = pb[i]; }
        *(LAS f32x4*)(Lv + vt * 32 + vc) = pv;
        __syncthreads();
        if (ch + 1 < SEQ / T) SCAN_LOAD(t0 + T);
#pragma unroll 4
        for (int t = 0; t < T; ++t) {
            const f32x4 kk4 = *(const LAS f32x4*)(Lkk + t * 64 + kq * 4), w4 = *(const LAS f32x4*)(Lw + t * 64 + kq * 4), b4 = *(const LAS f32x4*)(Lb + t * 64 + kq * 4);
            const f32x4 k4 = *(const LAS f32x4*)(Lk + t * 64 + kq * 4), r4 = *(const LAS f32x4*)(Lr + t * 64 + kq * 4); const float v = Lv[t * 32 + rl];
            float d = (S0 * kk4.x + S1 * kk4.y) + (S2 * kk4.z + S3 * kk4.w); d = red16(d); const float sa = -d;
            S0 = S0 * w4.x + (sa * b4.x + v * k4.x); S1 = S1 * w4.y + (sa * b4.y + v * k4.y); S2 = S2 * w4.z + (sa * b4.z + v * k4.z); S3 = S3 * w4.w + (sa * b4.w + v * k4.w);
            float y = (S0 * r4.x + S1 * r4.y) + (S2 * r4.z + S3 * r4.w); y = red16(y);
            if (kq == 0) Ly[t * 32 + rl] = y;
        }
        __syncthreads();
        *(f32x4*)(YR + (rowbase + t0 + vt) * BW + colh + 32 * half + vc) = *(const LAS f32x4*)(Ly + vt * 32 + vc);
    }
#undef SCAN_LOAD
}

__device__ __forceinline__ void glds16(const void* gsrc, unsigned lds_dst) { unsigned keep;
    asm volatile("s_mov_b32 %0, m0\n\ts_mov_b32 m0, %2\n\ts_nop 0\n\tglobal_load_lds_dwordx4 %1, off\n\ts_mov_b32 m0, %0" : "=&s"(keep) : "v"(gsrc), "s"(lds_dst) : "memory"); }
__device__ __forceinline__ void glds4(const void* gsrc, unsigned lds_dst) { unsigned keep;
    asm volatile("s_mov_b32 %0, m0\n\ts_mov_b32 m0, %2\n\ts_nop 0\n\tglobal_load_lds_dword %1, off\n\ts_mov_b32 m0, %0" : "=&s"(keep) : "v"(gsrc), "s"(lds_dst) : "memory"); }
constexpr int SCAN_T = 8, SCAN_SLOT = 5 * SCAN_T * 256 + 512, SCAN_NSLOT = 3, SCAN_RING = SCAN_NSLOT * SCAN_SLOT;
typedef float f32x2 __attribute__((ext_vector_type(2)));
__device__ __forceinline__ void scan_wave(int lane, LAS unsigned char* ring, int hs, int r0, unsigned char* ws) {
    const int b = hs / 12, h = hs % 12;
    const float* SR = (const float*)(ws + WS_SR); const float* SW = (const float*)(ws + WS_SW); const float* SK = (const float*)(ws + WS_SK); const float* SU = (const float*)(ws + WS_SKK);
    const float* SB = (const float*)(ws + WS_SB); const float* SV = (const float*)(ws + WS_SV); const float* BK = (const float*)(ws + WS_BK); float* YR = (float*)(ws + WS_YRAW);
    const int rg = lane >> 4, kq = lane & 15;
    const size_t rowbase = (size_t)b * SEQ; const int colh = h * 64;
    const unsigned ring0 = (unsigned)(size_t)ring;
    const size_t voff = ((size_t)(lane >> 4)) * BW + colh + 4 * kq;
    const size_t vvoff = ((size_t)((lane & 31) >> 2)) * BW + colh + r0 + (lane & 3);
    const size_t bkoff = ((size_t)((lane & 15) >> 1) * 12 + h) * 2 + (lane & 1);
    constexpr int NCH = SEQ / SCAN_T;
#define SCAN_DMA(ch, slot) do { const int cc_ = (ch) < NCH ? (ch) : NCH - 1; const size_t tok_ = rowbase + (size_t)cc_ * SCAN_T; const unsigned sl_ = ring0 + (unsigned)(slot) * SCAN_SLOT; \
        _Pragma("unroll") for (int i_ = 0; i_ < 2; ++i_) { const size_t o_ = (tok_ + 4 * i_) * BW + voff; \
            glds16(SU + o_, sl_ + 0 * 2048 + i_ * 1024); glds16(SW + o_, sl_ + 1 * 2048 + i_ * 1024); glds16(SB + o_, sl_ + 2 * 2048 + i_ * 1024); glds16(SK + o_, sl_ + 3 * 2048 + i_ * 1024); glds16(SR + o_, sl_ + 4 * 2048 + i_ * 1024); } \
        glds4(SV + tok_ * BW + vvoff, sl_ + 10240); glds4(BK + tok_ * 24 + bkoff, sl_ + 10496); } while (0)
    SCAN_DMA(0, 0); SCAN_DMA(1, 1); SCAN_DMA(2, 2);
    f32x2 S01 = (f32x2){0.f, 0.f}, S23 = (f32x2){0.f, 0.f};
    float e_cur = 0.f, sa_prev = 0.f, v_prev = 0.f;
    int slot = 0;
    for (int ch = 0; ch < NCH; ++ch) {
        asm volatile("s_waitcnt vmcnt(24)" ::: "memory");
        const LAS unsigned char* sp = ring + slot * SCAN_SLOT;
        float ykeep = 0.f;
        f32x4 u4a[SCAN_T], w4a[SCAN_T], b4a[SCAN_T], k4a[SCAN_T], r4a[SCAN_T]; float va[SCAN_T]; f32x2 bka[SCAN_T];
#pragma unroll
        for (int tt = 0; tt < SCAN_T; ++tt) {
            u4a[tt] = *(const LAS f32x4*)(sp + 0 * 2048 + tt * 256 + kq * 16); bka[tt] = *(const LAS f32x2*)(sp + 10496 + tt * 8); va[tt] = *(const LAS float*)(sp + 10240 + tt * 16 + rg * 4);
            w4a[tt] = *(const LAS f32x4*)(sp + 1 * 2048 + tt * 256 + kq * 16); b4a[tt] = *(const LAS f32x4*)(sp + 2 * 2048 + tt * 256 + kq * 16);
            k4a[tt] = *(const LAS f32x4*)(sp + 3 * 2048 + tt * 256 + kq * 16); r4a[tt] = *(const LAS f32x4*)(sp + 4 * 2048 + tt * 256 + kq * 16); }
#pragma unroll
        for (int tt = 0; tt < SCAN_T; ++tt) {
            const f32x4 u4 = u4a[tt], w4 = w4a[tt], b4 = b4a[tt], k4 = k4a[tt], r4 = r4a[tt]; const float v = va[tt]; const f32x2 bk = bka[tt];
            f32x2 pe = S01 * (f32x2){u4.x, u4.y}; pe = S23 * (f32x2){u4.z, u4.w} + pe; const float e_next = red16(pe.x + pe.y);
            const float d = e_cur + sa_prev * bk.x + v_prev * bk.y; const float sa = -d;
            const f32x2 sav = (f32x2){sa, sa}, vv = (f32x2){v, v};
            S01 = S01 * (f32x2){w4.x, w4.y} + (sav * (f32x2){b4.x, b4.y} + vv * (f32x2){k4.x, k4.y});
            S23 = S23 * (f32x2){w4.z, w4.w} + (sav * (f32x2){b4.z, b4.w} + vv * (f32x2){k4.z, k4.w});
            f32x2 py = S01 * (f32x2){r4.x, r4.y}; py = S23 * (f32x2){r4.z, r4.w} + py; const float y = red16(py.x + py.y);
            ykeep = (kq == tt) ? y : ykeep;
            e_cur = e_next; sa_prev = sa; v_prev = v;
        }
        if (kq < SCAN_T) YR[(rowbase + (size_t)ch * SCAN_T + kq) * BW + colh + r0 + rg] = ykeep;
        SCAN_DMA(ch + 3, slot);
        slot = (slot == SCAN_NSLOT - 1) ? 0 : slot + 1;
    }
    asm volatile("s_waitcnt vmcnt(0)" ::: "memory");
#undef SCAN_DMA
}

constexpr int SH_T = 8, SH_SLOT = 10240 + 1024 + 256, SH_NSLOT = 11, SH_D = 4, SH_FLAGS = SCANRING_OFF + SH_NSLOT * SH_SLOT;
static_assert(SH_FLAGS + 64 <= LDSCTL_OFF, "scan ring + flags fit below the LDS control words");
__device__ __forceinline__ unsigned lds_ld(volatile LAS unsigned* p) { return *p; }
__device__ __forceinline__ void scan_loader(int lane, LAS unsigned char* lds, int hs, int rblk, unsigned char* ws) {
    const int b = hs / 12, h = hs % 12;
    const float* SR = (const float*)(ws + WS_SR); const float* SW = (const float*)(ws + WS_SW); const float* SK = (const float*)(ws + WS_SK); const float* SU = (const float*)(ws + WS_SKK);
    const float* SB = (const float*)(ws + WS_SB); const float* SV = (const float*)(ws + WS_SV); const float* BK = (const float*)(ws + WS_BK);
    const size_t rowbase = (size_t)b * SEQ; const int colh = h * 64;
    const unsigned ring0 = (unsigned)(size_t)(lds + SCANRING_OFF);
    volatile LAS unsigned* flags = (volatile LAS unsigned*)(lds + SH_FLAGS);
    const size_t voff = ((size_t)(lane >> 4)) * BW + colh + 4 * (lane & 15);
    const size_t vvoff = ((size_t)((lane >> 2) & 7)) * BW + colh + rblk + 4 * (lane & 3);
    const size_t bkoff = ((size_t)((lane & 15) >> 1) * 12 + h) * 2 + (lane & 1);
    constexpr int NCH = SEQ / SH_T;
    int slot = 0;
    for (int c = 0; c < NCH; ++c) {
        if (c >= SH_NSLOT) { const unsigned need = (unsigned)(c - SH_NSLOT + 1);
            while (lds_ld(flags + 1) < need || lds_ld(flags + 2) < need || lds_ld(flags + 3) < need || lds_ld(flags + 4) < need) __builtin_amdgcn_s_sleep(1); }
        const size_t tok = rowbase + (size_t)c * SH_T; const unsigned sl = ring0 + (unsigned)slot * SH_SLOT;
#pragma unroll
        for (int i = 0; i < 2; ++i) { const size_t o = (tok + 4 * i) * BW + voff;
            glds16(SU + o, sl + 0 * 2048 + i * 1024); glds16(SW + o, sl + 1 * 2048 + i * 1024); glds16(SB + o, sl + 2 * 2048 + i * 1024); glds16(SK + o, sl + 3 * 2048 + i * 1024); glds16(SR + o, sl + 4 * 2048 + i * 1024); }
        glds16(SV + tok * BW + vvoff, sl + 10240); glds4(BK + tok * 24 + bkoff, sl + 11264);
        if (c >= SH_D) { asm volatile("s_waitcnt vmcnt(48)" ::: "memory"); if (lane == 0) flags[0] = (unsigned)(c - SH_D + 1); }
        slot = (slot == SH_NSLOT - 1) ? 0 : slot + 1;
    }
    asm volatile("s_waitcnt vmcnt(0)" ::: "memory"); if (lane == 0) flags[0] = (unsigned)NCH;
}
__device__ __forceinline__ void scan_wave_sh(int lane, int w, LAS unsigned char* lds, int hs, int rblk, unsigned char* ws) {
    const int b = hs / 12, h = hs % 12; float* YR = (float*)(ws + WS_YRAW);
    const int rg = lane >> 4, kq = lane & 15, r0 = rblk + 4 * w;
    const size_t rowbase = (size_t)b * SEQ; const int colh = h * 64;
    volatile LAS unsigned* flags = (volatile LAS unsigned*)(lds + SH_FLAGS);
    constexpr int NCH = SEQ / SH_T;
    f32x2 S01 = (f32x2){0.f, 0.f}, S23 = (f32x2){0.f, 0.f};
    float e_cur = 0.f, sa_prev = 0.f, v_prev = 0.f;
    int slot = 0;
    for (int ch = 0; ch < NCH; ++ch) {
        while (lds_ld(flags) <= (unsigned)ch) __builtin_amdgcn_s_sleep(1);
        asm volatile("" ::: "memory");
        const LAS unsigned char* sp = lds + SCANRING_OFF + slot * SH_SLOT;
        float ykeep = 0.f;
        f32x4 u4a[SH_T], w4a[SH_T], b4a[SH_T], k4a[SH_T], r4a[SH_T]; float va[SH_T]; f32x2 bka[SH_T];
#pragma unroll
        for (int tt = 0; tt < SH_T; ++tt) {
            u4a[tt] = *(const LAS f32x4*)(sp + 0 * 2048 + tt * 256 + kq * 16); bka[tt] = *(const LAS f32x2*)(sp + 11264 + tt * 8); va[tt] = *(const LAS float*)(sp + 10240 + tt * 64 + (w * 4 + rg) * 4);
            w4a[tt] = *(const LAS f32x4*)(sp + 1 * 2048 + tt * 256 + kq * 16); b4a[tt] = *(const LAS f32x4*)(sp + 2 * 2048 + tt * 256 + kq * 16);
            k4a[tt] = *(const LAS f32x4*)(sp + 3 * 2048 + tt * 256 + kq * 16); r4a[tt] = *(const LAS f32x4*)(sp + 4 * 2048 + tt * 256 + kq * 16); }
#pragma unroll
        for (int tt = 0; tt < SH_T; ++tt) {
            const f32x4 u4 = u4a[tt], w4 = w4a[tt], b4 = b4a[tt], k4 = k4a[tt], r4 = r4a[tt]; const float v = va[tt]; const f32x2 bk = bka[tt];
            f32x2 pe = S01 * (f32x2){u4.x, u4.y}; pe = S23 * (f32x2){u4.z, u4.w} + pe; const float e_next = red16(pe.x + pe.y);
            const float d = e_cur + sa_prev * bk.x + v_prev * bk.y; const float sa = -d;
            const f32x2 sav = (f32x2){sa, sa}, vv = (f32x2){v, v};
            S01 = S01 * (f32x2){w4.x, w4.y} + (sav * (f32x2){b4.x, b4.y} + vv * (f32x2){k4.x, k4.y});
            S23 = S23 * (f32x2){w4.z, w4.w} + (sav * (f32x2){b4.z, b4.w} + vv * (f32x2){k4.z, k4.w});
            f32x2 py = S01 * (f32x2){r4.x, r4.y}; py = S23 * (f32x2){r4.z, r4.w} + py; const float y = red16(py.x + py.y);
            ykeep = (kq == tt) ? y : ykeep;
            e_cur = e_next; sa_prev = sa; v_prev = v;
        }
        if (kq < SH_T) YR[(rowbase + (size_t)ch * SH_T + kq) * BW + colh + r0 + rg] = ykeep;
        asm volatile("" ::: "memory");
        if (lane == 0) flags[1 + w] = (unsigned)(ch + 1);
        slot = (slot == SH_NSLOT - 1) ? 0 : slot + 1;
    }
}

constexpr int CH_REC = COP_RY * 4;
constexpr int CH_SLOT = CH_REC + 4096, CH_NSLOT = 6, CH_D = 4, CH_FLAGS = SCANRING_OFF + CH_NSLOT * CH_SLOT;
static_assert(CH_FLAGS + 64 <= LDSCTL_OFF, "chain ring + flags fit below the LDS control words");
__device__ __forceinline__ float* sst_base(unsigned char* ws, int hs) { return (float*)(ws + (hs < 16 ? WS_SST_A + (size_t)hs * 8 * MiB : WS_SST_B + (size_t)(hs - 16) * 8 * MiB)); }
__device__ __forceinline__ void chain_loader(int lane, int which, LAS unsigned char* lds, int hs, unsigned char* ws) {
    const int b = hs / 12, h = hs % 12;
    const float* COP = (const float*)(ws + WS_COP) + (size_t)hs * 512 * COP_STRIDE; const float* SV = (const float*)(ws + WS_SV);
    const unsigned ring0 = (unsigned)(size_t)(lds + SCANRING_OFF);
    volatile LAS unsigned* flags = (volatile LAS unsigned*)(lds + CH_FLAGS);
    const int fidx = which == 0 ? 0 : 4 + which;
    const size_t vsrc = ((size_t)b * SEQ + (lane >> 4)) * BW + h * 64 + 4 * (lane & 15);
    int slot = 0;
    for (int c = 0; c < 512; ++c) {
        if (c >= CH_NSLOT) { const unsigned need = (unsigned)(c - CH_NSLOT + 1);
            while (lds_ld(flags + 1) < need || lds_ld(flags + 2) < need || lds_ld(flags + 3) < need || lds_ld(flags + 4) < need) __builtin_amdgcn_s_sleep(1); }
        const float* rec = COP + (size_t)c * COP_STRIDE; const unsigned sl = ring0 + (unsigned)slot * CH_SLOT;
        if (which < 2) {
#pragma unroll
            for (int i = 0; i < 5; ++i) glds16(rec + (5 * which + i) * 256 + lane * 4, sl + (5 * which + i) * 1024);
            if (c >= CH_D) { asm volatile("s_waitcnt vmcnt(20)" ::: "memory"); if (lane == 0) flags[fidx] = (unsigned)(c - CH_D + 1); }
        } else if (which == 2) {
#pragma unroll
            for (int i = 10; i < 14; ++i) glds16(rec + i * 256 + lane * 4, sl + i * 1024);
            glds4(rec + COP_GAM + lane, sl + 14 * 1024);
            if (c >= CH_D) { asm volatile("s_waitcnt vmcnt(20)" ::: "memory"); if (lane == 0) flags[fidx] = (unsigned)(c - CH_D + 1); }
        } else {
#pragma unroll
            for (int i = 0; i < 4; ++i) glds16(SV + vsrc + (size_t)(c * 16 + 4 * i) * BW, sl + CH_REC + i * 1024);
            if (c >= CH_D) { asm volatile("s_waitcnt vmcnt(16)" ::: "memory"); if (lane == 0) flags[fidx] = (unsigned)(c - CH_D + 1); }
        }
        slot = (slot == CH_NSLOT - 1) ? 0 : slot + 1;
    }
    asm volatile("s_waitcnt vmcnt(0)" ::: "memory"); if (lane == 0) flags[fidx] = 512u;
}
#define MFMAB(a, b, c) __builtin_amdgcn_mfma_f32_16x16x32_bf16(__builtin_bit_cast(pg8::bf16x8, (a)), __builtin_bit_cast(pg8::bf16x8, (b)), (c), 0, 0, 0)
__device__ __forceinline__ void scan_chain(int lane, int vs, LAS unsigned char* lds, int hs, unsigned char* ws) {
    const int li = lane & 15, q = lane >> 4;
    volatile LAS unsigned* flags = (volatile LAS unsigned*)(lds + CH_FLAGS);
    f32x4c St[4];
#pragma unroll
    for (int m = 0; m < 4; ++m) St[m] = (f32x4c){0.f, 0.f, 0.f, 0.f};
    float* sst = sst_base(ws, hs) + ((size_t)vs * 64 + lane) * 16;
    int slot = 0; unsigned favail = 0u;
    for (int c = 0; c < 512; ++c) {
        if (favail <= (unsigned)c) {
            for (;;) { const unsigned a0 = lds_ld(flags), a1 = lds_ld(flags + 5), a2 = lds_ld(flags + 6), a3 = lds_ld(flags + 7); const unsigned mn = min(min(a0, a1), min(a2, a3)); favail = mn; if (mn > (unsigned)c) break; __builtin_amdgcn_s_sleep(1); } }
        asm volatile("" ::: "memory");
        const LAS unsigned* sp = (const LAS unsigned*)(lds + SCANRING_OFF + slot * CH_SLOT);
        v4u w1h[2], w1l[2], bkh[4], bkl[4]; f32x4 gf[4]; float vc[4];
#pragma unroll
        for (int kb = 0; kb < 2; ++kb) { w1h[kb] = *(const LAS v4u*)(sp + COP_W1 + lane * 16 + 8 * kb); w1l[kb] = *(const LAS v4u*)(sp + COP_W1 + lane * 16 + 8 * kb + 4); }
        const v4u u0h = *(const LAS v4u*)(sp + COP_U0 + lane * 8), u0l = *(const LAS v4u*)(sp + COP_U0 + lane * 8 + 4);
#pragma unroll
        for (int m = 0; m < 4; ++m) { bkh[m] = *(const LAS v4u*)(sp + COP_BK + lane * 32 + 8 * m); bkl[m] = *(const LAS v4u*)(sp + COP_BK + lane * 32 + 8 * m + 4); gf[m] = *(const LAS f32x4*)((const LAS float*)sp + COP_GAM + 16 * m + 4 * q); }
#pragma unroll
        for (int s_ = 0; s_ < 4; ++s_) vc[s_] = ((const LAS float*)sp)[COP_RY + (4 * q + s_) * 64 + 16 * vs + li];
        v4u sh[2], sl_[2];
#pragma unroll
        for (int kb = 0; kb < 2; ++kb) { float x[8];
#pragma unroll
            for (int jj = 0; jj < 8; ++jj) x[jj] = St[2 * kb + (jj >> 2)][jj & 3];
            split8(x, sh[kb], sl_[kb]); }
        v4u vh, vl; { float x[8] = {vc[0], vc[1], vc[2], vc[3], 0.f, 0.f, 0.f, 0.f}; split8(x, vh, vl); }
#pragma unroll
        for (int m = 0; m < 4; ++m) *(f32x4*)(sst + (size_t)c * 4096 + 4 * m) = St[m];
        f32x4c z0 = {0.f, 0.f, 0.f, 0.f}, z1 = {0.f, 0.f, 0.f, 0.f}, z2 = {0.f, 0.f, 0.f, 0.f};
        z0 = MFMAB(w1h[0], sh[0], z0); z1 = MFMAB(w1h[0], sl_[0], z1); z2 = MFMAB(w1l[0], sh[0], z2);
        z0 = MFMAB(w1h[1], sh[1], z0); z1 = MFMAB(w1h[1], sl_[1], z1); z2 = MFMAB(w1l[1], sh[1], z2);
        z0 = MFMAB(u0h, vh, z0); z1 = MFMAB(u0h, vl, z1); z2 = MFMAB(u0l, vh, z2);
#pragma unroll
        for (int m = 0; m < 4; ++m) St[m] *= gf[m];
        const f32x4c z = z0 + (z1 + z2);
        v4u zh, zl; { float x[8] = {z[0], z[1], z[2], z[3], vc[0], vc[1], vc[2], vc[3]}; split8(x, zh, zl); }
#pragma unroll
        for (int m = 0; m < 4; ++m) St[m] = MFMAB(bkh[m], zh, St[m]);
#pragma unroll
        for (int m = 0; m < 4; ++m) St[m] = MFMAB(bkh[m], zl, St[m]);
#pragma unroll
        for (int m = 0; m < 4; ++m) St[m] = MFMAB(bkl[m], zh, St[m]);
        asm volatile("" ::: "memory");
        if (lane == 0) flags[1 + vs] = (unsigned)(c + 1);
        slot = (slot == CH_NSLOT - 1) ? 0 : slot + 1;
    }
}

struct AttnPass { int qcol; int bias_head; int tbl; float sink; int use_sink; int maxsteps; bf16* out; int out_ld; int out_col; float* lse; };
__device__ __forceinline__ void attn_stage_kv(const Ctx& C, const bf16* P1, int b, int res, int dil, int fblk, int kcol, int vcol) {
    LAS unsigned char* Ks = C.lds + RING_OFF; LAS unsigned char* Vs = Ks + 256 * 144;
#pragma unroll
    for (int i = 0; i < 4; ++i) { const int c = C.tid + 512 * i, row = c >> 3, part = c & 7; const int fp = (fblk - 1) * 128 + row;
        v4u kv = (v4u){0u, 0u, 0u, 0u}, vv = (v4u){0u, 0u, 0u, 0u};
        if (fp >= 0) { const bf16* src = P1 + ((size_t)b * SEQ + (size_t)fp * dil + res) * NP1; kv = *(const v4u*)(src + kcol + part * 8); vv = *(const v4u*)(src + vcol + part * 8); }
        *(LAS v4u*)(Ks + row * 144 + part * 16) = kv; *(LAS v4u*)(Vs + row * 144 + part * 16) = vv; }
}
__device__ __forceinline__ void attn_pass(const Ctx& C, const bf16* P1, const float* relb, int b, int res, int dil, int fblk, const AttnPass& ap) {
    LAS unsigned char* Ks = C.lds + RING_OFF; LAS unsigned char* Vs = Ks + 256 * 144; LAS float* lut = (LAS float*)(Vs + 256 * 144);
    __syncthreads();
    if (C.tid < 132) lut[C.tid] = (C.tid <= 128) ? relb[(int)T5B[ap.tbl][C.tid] * 20 + ap.bias_head] : 0.f;
    __syncthreads();
    const int i = C.tid >> 2, dq = C.tid & 3;
    const size_t tok = (size_t)b * SEQ + (size_t)(fblk * 128 + i) * dil + res;
    float q[16];
    { const bf16* qp = P1 + tok * NP1 + ap.qcol + dq * 16; const v4u a0 = *(const v4u*)qp, a1 = *(const v4u*)(qp + 8);
      q[0] = bflo(a0.x); q[1] = bfhi(a0.x); q[2] = bflo(a0.y); q[3] = bfhi(a0.y); q[4] = bflo(a0.z); q[5] = bfhi(a0.z); q[6] = bflo(a0.w); q[7] = bfhi(a0.w);
      q[8] = bflo(a1.x); q[9] = bfhi(a1.x); q[10] = bflo(a1.y); q[11] = bfhi(a1.y); q[12] = bflo(a1.z); q[13] = bfhi(a1.z); q[14] = bflo(a1.w); q[15] = bfhi(a1.w);
#pragma unroll
      for (int j = 0; j < 16; ++j) q[j] *= 0.125f; }
    float mrun = ap.use_sink ? ap.sink : -INFINITY, lrun = ap.use_sink ? 1.0f : 0.0f;
    float o[16];
#pragma unroll
    for (int j = 0; j < 16; ++j) o[j] = 0.f;
    const int fq0 = fblk * 128 + i;
    for (int dist = 0; dist <= ap.maxsteps; ++dist) {
        const int kr = i + 128 - dist;
        const bool valid = (fq0 - dist) >= 0;
        const v4u k0 = *(const LAS v4u*)(Ks + kr * 144 + dq * 32), k1 = *(const LAS v4u*)(Ks + kr * 144 + dq * 32 + 16);
        float s = q[0] * bflo(k0.x) + q[1] * bfhi(k0.x) + q[2] * bflo(k0.y) + q[3] * bfhi(k0.y) + q[4] * bflo(k0.z) + q[5] * bfhi(k0.z) + q[6] * bflo(k0.w) + q[7] * bfhi(k0.w)
                + q[8] * bflo(k1.x) + q[9] * bfhi(k1.x) + q[10] * bflo(k1.y) + q[11] * bfhi(k1.y) + q[12] * bflo(k1.z) + q[13] * bfhi(k1.z) + q[14] * bflo(k1.w) + q[15] * bfhi(k1.w);
        s = red4(s) + lut[dist];
        if (valid) {
            if (s > mrun) { const float c = __expf(mrun - s); lrun *= c;
#pragma unroll
                for (int j = 0; j < 16; ++j) o[j] *= c;
                mrun = s; }
            const float p = __expf(s - mrun); lrun += p;
            const v4u v0 = *(const LAS v4u*)(Vs + kr * 144 + dq * 32), v1 = *(const LAS v4u*)(Vs + kr * 144 + dq * 32 + 16);
            o[0] += p * bflo(v0.x); o[1] += p * bfhi(v0.x); o[2] += p * bflo(v0.y); o[3] += p * bfhi(v0.y); o[4] += p * bflo(v0.z); o[5] += p * bfhi(v0.z); o[6] += p * bflo(v0.w); o[7] += p * bfhi(v0.w);
            o[8] += p * bflo(v1.x); o[9] += p * bfhi(v1.x); o[10] += p * bflo(v1.y); o[11] += p * bfhi(v1.y); o[12] += p * bflo(v1.z); o[13] += p * bfhi(v1.z); o[14] += p * bflo(v1.w); o[15] += p * bfhi(v1.w);
        }
    }
    const float inv = 1.0f / lrun;
    v4u w0, w1;
    w0.x = pk2(o[0] * inv, o[1] * inv); w0.y = pk2(o[2] * inv, o[3] * inv); w0.z = pk2(o[4] * inv, o[5] * inv); w0.w = pk2(o[6] * inv, o[7] * inv);
    w1.x = pk2(o[8] * inv, o[9] * inv); w1.y = pk2(o[10] * inv, o[11] * inv); w1.z = pk2(o[12] * inv, o[13] * inv); w1.w = pk2(o[14] * inv, o[15] * inv);
    bf16* op = ap.out + tok * ap.out_ld + ap.out_col + dq * 16;
    *(v4u*)op = w0; *(v4u*)(op + 8) = w1;
    if (ap.lse && dq == 0) ap.lse[tok * 4] = mrun + __logf(lrun);
}
__device__ __forceinline__ void phase_attn(const Ctx& C, const Args& a, int l, unsigned char* ws, int ab, int nab) {
    const bf16* P1 = (const bf16*)(ws + WS_P1); const float* relb = a.in[1]; const float* sinks = a.in[4] + l * 8;
    bf16* YA = (bf16*)(ws + WS_YA); bf16* OC = (bf16*)(ws + WS_OC); float* LSE = (float*)(ws + WS_LSE);
    constexpr int NA = 256, NC = 1536;
    for (int it = ab; it < NA + NC; it += nab) {
        __syncthreads();
        if (it < NA) {
            const int b = it >> 7, fblk = (it >> 1) & 63, hkv = it & 1;
            attn_stage_kv(C, P1, b, 0, 1, fblk, C_AK + hkv * 64, C_AV + hkv * 64);
            for (int g = 0; g < 4; ++g) { const int hq = hkv * 4 + g;
                AttnPass ap; ap.qcol = C_AQ + hq * 64; ap.bias_head = hq; ap.tbl = 0; ap.sink = sinks[hq]; ap.use_sink = 1; ap.maxsteps = 127; ap.out = YA; ap.out_ld = 512; ap.out_col = hq * 64; ap.lse = nullptr;
                attn_pass(C, P1, relb, b, 0, 1, fblk, ap); }
        } else {
            const int ci = it - NA; const int gi = ci / 512, j = (ci >> 7) & 3, qb = ci & 127;
            const int dil = (gi == 0) ? 1 : (gi == 1 ? 4 : 16); const int bps = 64 / dil;
            const int n = qb / bps, fblk = qb % bps, b = n / dil, res = n % dil; const int hc = gi * 4 + j;
            attn_stage_kv(C, P1, b, res, dil, fblk, C_CK + hc * 64, C_CV + hc * 64);
            AttnPass ap; ap.qcol = C_CQ + hc * 64; ap.bias_head = 8 + hc; ap.tbl = gi; ap.sink = 0.f; ap.use_sink = 0; ap.maxsteps = 128; ap.out = OC + (size_t)gi * M * 256; ap.out_ld = 256; ap.out_col = j * 64;
            ap.lse = LSE + (size_t)gi * M * 4 + j;
            attn_pass(C, P1, relb, b, res, dil, fblk, ap);
        }
    }
}

__device__ __forceinline__ void phase_vt(const Ctx& C, unsigned char* ws) {
    const bf16* P1 = (const bf16*)(ws + WS_P1); bf16* VT = (bf16*)(ws + WS_VT);
    for (int it = C.gw; it < 14 * 2 * 128; it += C.ngw) {
        const int hs = it / 256, b = (it >> 7) & 1, blk = it & 127;
        const int gi = hs < 2 ? 0 : (hs - 2) >> 2; const int dil = gi == 0 ? 1 : (gi == 1 ? 4 : 16); const int Lf = SEQ / dil;
        const int vcol = hs < 2 ? C_AV + hs * 64 : C_CV + (hs - 2) * 64;
        const int ft = blk * 64 + C.lane;
        const int res = ft / Lf, tp = ft % Lf; const int tok = b * SEQ + tp * dil + res;
        const v4u* src = (const v4u*)(P1 + (size_t)tok * NP1 + vcol);
        v4u x[8];
#pragma unroll
        for (int i = 0; i < 8; ++i) x[i] = src[i];
        bf16* dst = VT + ((size_t)(hs * 2 + b) * 64) * SEQ + ft;
#pragma unroll
        for (int i = 0; i < 8; ++i) {
            dst[(size_t)(8 * i + 0) * SEQ] = (bf16)(x[i].x & 0xffffu); dst[(size_t)(8 * i + 1) * SEQ] = (bf16)(x[i].x >> 16);
            dst[(size_t)(8 * i + 2) * SEQ] = (bf16)(x[i].y & 0xffffu); dst[(size_t)(8 * i + 3) * SEQ] = (bf16)(x[i].y >> 16);
            dst[(size_t)(8 * i + 4) * SEQ] = (bf16)(x[i].z & 0xffffu); dst[(size_t)(8 * i + 5) * SEQ] = (bf16)(x[i].z >> 16);
            dst[(size_t)(8 * i + 6) * SEQ] = (bf16)(x[i].w & 0xffffu); dst[(size_t)(8 * i + 7) * SEQ] = (bf16)(x[i].w >> 16);
        }
    }
}

typedef float f32x16 __attribute__((ext_vector_type(16)));
__device__ __forceinline__ void attn_wave_item(int lane, const LAS float* lutall, int item, const float* sinks, unsigned char* ws) {
    const bf16* P1 = (const bf16*)(ws + WS_P1); const bf16* VT = (const bf16*)(ws + WS_VT);
    const int hh = item % 20, g32 = item / 20;
    const bool isA = hh < 8; const int hc = hh - 8; const int gi = isA ? 0 : hc >> 2, j = hc & 3;
    const int dil = gi == 0 ? 1 : (gi == 1 ? 4 : 16); const int Lf = SEQ / dil, gps = Lf / 32;
    const int b = g32 >> 8, rr = g32 & 255, res = rr / gps, qg = rr % gps, fq0 = qg * 32;
    const int qcol = isA ? C_AQ + hh * 64 : C_CQ + hc * 64, kcol = isA ? C_AK + (hh >> 2) * 64 : C_CK + hc * 64;
    const int hs = isA ? (hh >> 2) : 2 + hc;
    const int r = lane & 31, hf = lane >> 5;
    const LAS float* lut = lutall + hh * 192 + (31 - r + 8 * hf);
    const int pr = (r & 0x13) | ((r & 8) >> 1) | ((r & 4) << 1);
    const size_t tokq = (size_t)b * SEQ + (size_t)(fq0 + r) * dil + res;
    pg8::bf16x8 qf[4];
    { const bf16* qrow = P1 + tokq * NP1 + qcol + 8 * hf;
#pragma unroll
      for (int s_ = 0; s_ < 4; ++s_) qf[s_] = *(const pg8::bf16x8*)(qrow + 16 * s_); }
    f32x16 sc[5];
#pragma unroll
    for (int kt = 0; kt < 5; ++kt) {
        int fk = fq0 - 128 + 32 * kt + pr; fk = fk < 0 ? 0 : fk;
        const bf16* krow = P1 + ((size_t)b * SEQ + (size_t)fk * dil + res) * NP1 + kcol + 8 * hf;
        f32x16 acc;
#pragma unroll
        for (int q = 0; q < 16; ++q) acc[q] = 0.f;
#pragma unroll
        for (int s_ = 0; s_ < 4; ++s_) { const pg8::bf16x8 a = *(const pg8::bf16x8*)(krow + 16 * s_); acc = __builtin_amdgcn_mfma_f32_32x32x16_bf16(a, qf[s_], acc, 0, 0, 0); }
        sc[kt] = acc;
    }
    float mx = -1e30f;
#pragma unroll
    for (int kt = 0; kt < 5; ++kt)
#pragma unroll
        for (int q = 0; q < 16; ++q) { const int koff = (q & 3) + 4 * ((q >> 2) & 1) + 16 * (q >> 3);
            const float sv = sc[kt][q] * 0.125f + lut[32 * kt + koff]; sc[kt][q] = sv; }
    if (fq0 < 128) {
#pragma unroll
        for (int kt = 0; kt < 5; ++kt)
#pragma unroll
            for (int q = 0; q < 16; ++q) { const int koff = (q & 3) + 4 * ((q >> 2) & 1) + 16 * (q >> 3) + 8 * hf; if (fq0 - 128 + 32 * kt + koff < 0) sc[kt][q] = -1e30f; }
    }
#pragma unroll
    for (int kt = 0; kt < 5; ++kt)
#pragma unroll
        for (int q = 0; q < 16; ++q) mx = fmaxf(mx, sc[kt][q]);
    mx = fmaxf(mx, __shfl_xor(mx, 32));
    const float sink = isA ? sinks[hh] : -1e30f;
    mx = fmaxf(mx, sink);
    float lsum = 0.f;
#pragma unroll
    for (int kt = 0; kt < 5; ++kt)
#pragma unroll
        for (int q = 0; q < 16; ++q) { const float pv = __expf(sc[kt][q] - mx); sc[kt][q] = pv; lsum += pv; }
    lsum += __shfl_xor(lsum, 32);
    const float denom = isA ? lsum + __expf(sink - mx) : lsum;
    const float inv = 1.0f / denom;
    pg8::bf16x8 pf[5][2];
#pragma unroll
    for (int kt = 0; kt < 5; ++kt)
#pragma unroll
        for (int s_ = 0; s_ < 2; ++s_) { pg8::u32x4 w;
            w.x = pg8::cvt_pk_bf16(sc[kt][8 * s_ + 0], sc[kt][8 * s_ + 1]); w.y = pg8::cvt_pk_bf16(sc[kt][8 * s_ + 2], sc[kt][8 * s_ + 3]);
            w.z = pg8::cvt_pk_bf16(sc[kt][8 * s_ + 4], sc[kt][8 * s_ + 5]); w.w = pg8::cvt_pk_bf16(sc[kt][8 * s_ + 6], sc[kt][8 * s_ + 7]);
            pf[kt][s_] = __builtin_bit_cast(pg8::bf16x8, w); }
    bf16* outp; int out_ld, ocol;
    if (isA) { outp = (bf16*)(ws + WS_YA); out_ld = 1536; ocol = hh * 64; } else { outp = (bf16*)(ws + WS_OC) + (size_t)gi * M * 256; out_ld = 256; ocol = j * 64; }
    const bf16* vth = VT + ((size_t)(hs * 2 + b) * 64) * SEQ + (size_t)res * Lf;
#pragma unroll
    for (int dt = 0; dt < 2; ++dt) {
        const bf16* vrow = vth + (size_t)(32 * dt + r) * SEQ;
        f32x16 acc;
#pragma unroll
        for (int q = 0; q < 16; ++q) acc[q] = 0.f;
#pragma unroll
        for (int kt = 0; kt < 5; ++kt)
#pragma unroll
            for (int s_ = 0; s_ < 2; ++s_) {
                int k0 = fq0 - 128 + 32 * kt + 16 * s_ + 8 * hf; k0 = k0 < 0 ? 0 : k0;
                acc = __builtin_amdgcn_mfma_f32_32x32x16_bf16(*(const pg8::bf16x8*)(vrow + k0), pf[kt][s_], acc, 0, 0, 0);
            }
        bf16* op = outp + tokq * out_ld + ocol + 32 * dt + 4 * hf;
#pragma unroll
        for (int g = 0; g < 4; ++g) { v2u w; w.x = pg8::cvt_pk_bf16(acc[4 * g + 0] * inv, acc[4 * g + 1] * inv); w.y = pg8::cvt_pk_bf16(acc[4 * g + 2] * inv, acc[4 * g + 3] * inv);
            *(v2u*)(op + 8 * g) = w; }
    }
    if (!isA && hf == 0) ((float*)(ws + WS_LSE))[((size_t)gi * M + tokq) * 4 + j] = mx + __logf(lsum);
}
__device__ __forceinline__ void build_lut(const Ctx& C, const float* relb) {
    LAS float* lut = (LAS float*)(C.lds + LUT_OFF);
    for (int i = C.tid; i < 20 * 192; i += NTHREADS) { const int hh = i / 192, x = i % 192; const int tbl = hh < 8 ? 0 : (hh - 8) >> 2; const int dist = 159 - x; const int maxsteps = hh < 8 ? 127 : 128;
        lut[i] = (dist >= 0 && dist <= maxsteps) ? relb[(int)T5B[tbl][dist] * 20 + hh] : -1e30f; }
    __syncthreads();
}

__device__ __forceinline__ void phase_post(const Ctx& C, const Args& a, int l, unsigned char* ws) {
    const float* SV = (const float*)(ws + WS_SV); const float* BON = (const float*)(ws + WS_BON); const float* COP = (const float*)(ws + WS_COP);
    const float* LO = (const float*)(ws + WS_LO); bf16* YB = (bf16*)(ws + WS_YA);
    const float* lgp = a.in[14] + (size_t)l * BW; const float* lbp = a.in[15] + (size_t)l * BW;
    const int lane = C.lane, li = lane & 15, q = lane >> 4;
    for (int it = C.gw; it < 24 * 512; it += C.ngw) {
        const int hs = it >> 9, c = it & 511, b = hs / 12, h = hs % 12; const int m0 = b * SEQ + c * 16;
        const float* rec = COP + ((size_t)hs * 512 + c) * COP_STRIDE; const float* sst = sst_base(ws, hs) + (size_t)c * 4096 + (size_t)lane * 16;
        f32x4 ryf[4]; const f32x4 y0f = *(const f32x4*)(rec + COP_Y0 + lane * 4);
#pragma unroll
        for (int m = 0; m < 4; ++m) ryf[m] = *(const f32x4*)(rec + COP_RY + lane * 16 + 4 * m);
        f32x4c y[4]; float vv[4][4];
#pragma unroll
        for (int vs = 0; vs < 4; ++vs) {
            f32x4 st[4];
#pragma unroll
            for (int m = 0; m < 4; ++m) st[m] = *(const f32x4*)(sst + (size_t)vs * 1024 + 4 * m);
#pragma unroll
            for (int s_ = 0; s_ < 4; ++s_) vv[vs][s_] = SV[(size_t)(m0 + 4 * q + s_) * BW + h * 64 + 16 * vs + li];
            f32x4c acc = {0.f, 0.f, 0.f, 0.f};
#pragma unroll
            for (int m = 0; m < 4; ++m)
#pragma unroll
                for (int j = 0; j < 4; ++j) acc = MFMA4(ryf[m][j], st[m][j], acc);
#pragma unroll
            for (int s_ = 0; s_ < 4; ++s_) acc = MFMA4(y0f[s_], vv[vs][s_], acc);
            y[vs] = acc;
        }
        float lg[4], lb[4];
#pragma unroll
        for (int vs = 0; vs < 4; ++vs) { lg[vs] = lgp[h * 64 + 16 * vs + li]; lb[vs] = lbp[h * 64 + 16 * vs + li]; }
#pragma unroll
        for (int j = 0; j < 4; ++j) {
            const int m = m0 + 4 * q + j;
            const float mean = red16((y[0][j] + y[1][j]) + (y[2][j] + y[3][j])) * (1.0f / 64.0f);
            const float d0 = y[0][j] - mean, d1 = y[1][j] - mean, d2 = y[2][j] - mean, d3 = y[3][j] - mean;
            const float var = red16((d0 * d0 + d1 * d1) + (d2 * d2 + d3 * d3)) * (1.0f / 64.0f);
            const float rsd = __builtin_amdgcn_rsqf(var + GN_EPS); const float bo = BON[(size_t)m * 12 + h];
            const float* gp = LO + (size_t)m * NLORA + 2 * BW + h * 64 + li; bf16* op = YB + (size_t)m * 1536 + 512 + h * 64 + li;
            op[0] = (bf16)f2bf((d0 * rsd * lg[0] + lb[0] + vv[0][j] * bo) * gp[0]); op[16] = (bf16)f2bf((d1 * rsd * lg[1] + lb[1] + vv[1][j] * bo) * gp[16]);
            op[32] = (bf16)f2bf((d2 * rsd * lg[2] + lb[2] + vv[2][j] * bo) * gp[32]); op[48] = (bf16)f2bf((d3 * rsd * lg[3] + lb[3] + vv[3][j] * bo) * gp[48]);
        }
    }
    const bf16* OC = (const bf16*)(ws + WS_OC); const float* LSE = (const float*)(ws + WS_LSE); bf16* YC = (bf16*)(ws + WS_YA);
    for (int mb = C.gw * 4; mb < M; mb += C.ngw * 4) {
        const int j = C.lane >> 4;
        float l0[4], l1[4], l2[4]; v2u a0[4], a1[4], a2[4];
#pragma unroll
        for (int i = 0; i < 4; ++i) { const int m = mb + i; l0[i] = LSE[(size_t)m * 4 + j]; l1[i] = LSE[((size_t)M + m) * 4 + j]; l2[i] = LSE[((size_t)2 * M + m) * 4 + j];
            a0[i] = *(const v2u*)(OC + (size_t)m * 256 + 4 * C.lane); a1[i] = *(const v2u*)(OC + ((size_t)M + m) * 256 + 4 * C.lane); a2[i] = *(const v2u*)(OC + ((size_t)2 * M + m) * 256 + 4 * C.lane); }
#pragma unroll
        for (int i = 0; i < 4; ++i) { const int m = mb + i;
            const float mx = fmaxf(l0[i], fmaxf(l1[i], l2[i])); const float e0 = __expf(l0[i] - mx), e1 = __expf(l1[i] - mx), e2 = __expf(l2[i] - mx); const float inv = 1.0f / (e0 + e1 + e2);
            const float w0 = e0 * inv, w1 = e1 * inv, w2 = e2 * inv;
            v2u o; o.x = pk2(w0 * bflo(a0[i].x) + w1 * bflo(a1[i].x) + w2 * bflo(a2[i].x), w0 * bfhi(a0[i].x) + w1 * bfhi(a1[i].x) + w2 * bfhi(a2[i].x));
            o.y = pk2(w0 * bflo(a0[i].y) + w1 * bflo(a1[i].y) + w2 * bflo(a2[i].y), w0 * bfhi(a0[i].y) + w1 * bfhi(a1[i].y) + w2 * bfhi(a2[i].y));
            *(v2u*)(YC + (size_t)m * 1536 + 1280 + 4 * C.lane) = o; }
    }
}

__device__ __forceinline__ void unpack8(const v4u w, float (&x)[8]) { x[0] = bflo(w.x); x[1] = bfhi(w.x); x[2] = bflo(w.y); x[3] = bfhi(w.y); x[4] = bflo(w.z); x[5] = bfhi(w.z); x[6] = bflo(w.w); x[7] = bfhi(w.w); }
__device__ __forceinline__ void phase_conv(const Ctx& C, const Args& a, int l, unsigned char* ws) {
    const bf16* U = (const bf16*)(ws + WS_U); bf16* ACT = (bf16*)(ws + WS_ACT); const float* cw = a.in[22] + (size_t)l * 3 * DFF;
    constexpr int GPR = DFF / 8, RUN = 32;
    const int gt = C.bid * NTHREADS + C.tid, ngt = C.G * NTHREADS;
    for (int idx = gt; idx < (M / RUN) * GPR; idx += ngt) {
        const int run = idx / GPR, f0 = (idx % GPR) * 8, m0 = run * RUN;
        float c0[8], c1[8], c2[8];
#pragma unroll
        for (int j = 0; j < 8; ++j) { c0[j] = cw[f0 + j]; c1[j] = cw[DFF + f0 + j]; c2[j] = cw[2 * DFF + f0 + j]; }
        const bf16* ur = U + (size_t)m0 * NUP + f0;
        float x0[8], x1[8];
        { v4u g0 = (v4u){0u, 0u, 0u, 0u}, g1 = (v4u){0u, 0u, 0u, 0u};
          if ((m0 & (SEQ - 1)) != 0) { g0 = *(const v4u*)(ur - 2 * NUP); g1 = *(const v4u*)(ur - NUP); }
          unpack8(g0, x0); unpack8(g1, x1); }
#pragma unroll 1
        for (int tq = 0; tq < RUN; tq += 4) {
            v4u gq[4], vq[4];
#pragma unroll
            for (int i = 0; i < 4; ++i) { gq[i] = *(const v4u*)(ur + (size_t)(tq + i) * NUP); vq[i] = *(const v4u*)(ur + (size_t)(tq + i) * NUP + DFF); }
#pragma unroll
            for (int i = 0; i < 4; ++i) {
                float x2[8], vl[8], r[8]; unpack8(gq[i], x2); unpack8(vq[i], vl);
#pragma unroll
                for (int j = 0; j < 8; ++j) { const float gsum = c0[j] * x0[j] + c1[j] * x1[j] + c2[j] * x2[j]; r[j] = gsum / (1.0f + __expf(-gsum)) * vl[j]; x0[j] = x1[j]; x1[j] = x2[j]; }
                v4u o; o.x = pk2(r[0], r[1]); o.y = pk2(r[2], r[3]); o.z = pk2(r[4], r[5]); o.w = pk2(r[6], r[7]);
                *(v4u*)(ACT + (size_t)(m0 + tq + i) * DFF + f0) = o;
            }
        }
    }
}

__device__ __forceinline__ Ctx make_ctx(unsigned char* lds) {
    Ctx C;
    C.lds = (LAS unsigned char*)lds;
    int t = threadIdx.x; asm volatile("" : "+v"(t));
    C.tid = t; C.lane = C.tid & 63; C.wave = __builtin_amdgcn_readfirstlane(C.tid >> 6);
    C.G = gridDim.x; C.bid = blockIdx.x; C.gw = C.bid * NWAVES + C.wave; C.ngw = C.G * NWAVES;
    return C;
}
template <int K> __device__ __forceinline__ void run_phase(unsigned char* lds, const Args& args, int l) {
    const Ctx C = make_ctx(lds);
    unsigned char* ws = args.ws; asm volatile("" : "+s"(ws)); unsigned char* wsw = ws + (size_t)(l & 1) * WSET_STRIDE; LAS unsigned char* ring = C.lds + RING_OFF; float* out = args.out;
    const float* xsrc = (l == 0) ? args.in[0] : out;
    if constexpr (K == 0) { phase_prep(C, args, l, xsrc, ws); }
    if constexpr (K == 1) { pg8::Gemm g{(const bf16*)(ws + WS_H), (const bf16*)(wsw + WS_WIN), M, NP1, D}; pg8::StaticOrder S; S.init(M, NP1, C.G, C.bid);
        pg8::EpiWin E{(bf16*)(ws + WS_P1), (bf16*)(ws + WS_G), 0};
        pg8::gemm_phase<pg8::EpiWin, pg8::StaticOrder, true, true>(ring, g, S, E); }
    if constexpr (K == 2) { phase_aprime(C, args, l, ws); phase_vt(C, ws); }
    if constexpr (K == 3) { pg8::Gemm g{(const bf16*)(ws + WS_AP), (const bf16*)(wsw + WS_WLORA), M, NLORA, KLORA}; pg8::StaticOrder S; S.init(M, NLORA, C.G, C.bid);
        pg8::EpiF32P E{(float*)(ws + WS_LO), NLORA};
        pg8::gemm_phase<pg8::EpiF32P, pg8::StaticOrder, true, true>(ring, g, S, E); }
    if constexpr (K == 4) { phase_chunkprep(C, args, l, ws); }
    if constexpr (K == 5) {
        const int xg = C.bid & 7, jj = C.bid >> 3;
        if (jj < 3) {
            if (C.tid < 16) ((LAS unsigned*)(C.lds + CH_FLAGS))[C.tid] = 0u;
            __syncthreads();
            const int hs = xg * 3 + jj;
            if (C.wave < 4) scan_chain(C.lane, C.wave, C.lds, hs, ws);
            else chain_loader(C.lane, C.wave - 4, C.lds, hs, ws);
        } else {
            const int gidx = (jj - 3) * 8 + xg;
            build_lut(C, args.in[1]);
            { const float* sinks = args.in[4] + l * 8;
              for (int rep = 0; rep < EXP_ATTN_REPS; ++rep) for (int it = gidx * 8 + C.wave; it < 512 * 20; it += 1856) attn_wave_item(C.lane, (const LAS float*)(C.lds + LUT_OFF), it, sinks, ws); }
            __syncthreads();
            for (int rep = 0; rep < EXP_GATE_REPS; ++rep) { pg8::Gemm g{(const bf16*)(ws + WS_H), (const bf16*)(wsw + WS_WIN) + (size_t)NP1 * D, M, NG, D}; pg8::StaticOrder S; S.init(M, NG, 232, gidx);
              pg8::EpiWin E{(bf16*)(ws + WS_P1), (bf16*)(ws + WS_G), 23};
              pg8::gemm_phase<pg8::EpiWin, pg8::StaticOrder, true, true>(ring, g, S, E); }
            if (l + 1 < DEPTH) convert_weights(gidx * 8 + C.wave, 1856, C.lane, (LAS float*)(C.lds + RING_OFF + C.wave * 16384), args, l + 1, ws);
        } }
    if constexpr (K == 6) { phase_post(C, args, l, ws); }
    if constexpr (K == 7) { pg8::Gemm g{(const bf16*)(ws + WS_YA), (const bf16*)(wsw + WS_PA), M, D, 1536}; pg8::StaticOrder S; S.init(M, D, C.G, C.bid);
        pg8::EpiGate3 E{(const bf16*)(ws + WS_G), (bf16*)(ws + WS_MG), 8, 20};
        pg8::gemm_phase<pg8::EpiGate3, pg8::StaticOrder, true, true>(ring, g, S, E); }
    if constexpr (K == 8) { pg8::Gemm g{(const bf16*)(ws + WS_MG), (const bf16*)(wsw + WS_WOUT), M, D, D}; pg8::StaticOrder S; S.init(M, D, C.G, C.bid);
        pg8::EpiResid E{xsrc, out};
        pg8::gemm_phase<pg8::EpiResid, pg8::StaticOrder, true, true>(ring, g, S, E); }
    if constexpr (K == 9) { const float* g2 = args.in[20] + (size_t)l * D; bf16* H = (bf16*)(ws + WS_H);
        for (int m = 2 * C.gw; m < M; m += 2 * C.ngw) rms_row2_bf16(out + (size_t)m * D, g2, H + (size_t)m * D, C.lane); }
    if constexpr (K == 10) { pg8::Gemm g{(const bf16*)(ws + WS_H) - 2 * D, (const bf16*)(wsw + WS_WUP), 65 * 256, NUP, D}; pg8::StaticOrder S; S.init(65 * 256, NUP, C.G, C.bid);
        pg8::EpiConv E{(bf16*)(ws + WS_ACT), args.in[22] + (size_t)l * 3 * DFF, (PG8_LAS float*)(C.lds + 131072)};
        pg8::gemm_phase<pg8::EpiConv, pg8::StaticOrder, true, true>(ring, g, S, E); }
    if constexpr (K == 12) { pg8::Gemm g{(const bf16*)(ws + WS_ACT), (const bf16*)(wsw + WS_WDOWN), M, D, DFF}; pg8::StaticOrder S; S.init(M, D, C.G, C.bid);
        pg8::EpiResid E{out, out};
        pg8::gemm_phase<pg8::EpiResid, pg8::StaticOrder, true, true>(ring, g, S, E); }
    if constexpr (K == 13) { const float* gf = args.in[24];
        for (int m = C.gw; m < M; m += C.ngw) rms_row_f32(out + (size_t)m * D, gf, C.lane); }
}
template <int K> __global__ void __launch_bounds__(NTHREADS, 2) fwd_phase(Args args) {
    extern __shared__ __attribute__((aligned(16))) unsigned char lds[];
    run_phase<K>(lds, args, args.li);
}
#ifndef EXP_BAR_REPS
#define EXP_BAR_REPS 1
#endif
#define XBAR(b) do { for (int r_ = 0; r_ < EXP_BAR_REPS; ++r_) xcd_barrier(b); } while (0)
__global__ void __launch_bounds__(NTHREADS, 2) fwd_all(Args args) {
    extern __shared__ __attribute__((aligned(16))) unsigned char lds[];
    { LAS unsigned* ctlw = (LAS unsigned*)((LAS unsigned char*)lds + LDSCTL_OFF); for (int u = threadIdx.x; u < (LDS_BYTES - LDSCTL_OFF) / 4; u += NTHREADS) ctlw[u] = 0u; }
    __syncthreads();
    const XcdBarrier bar = xcd_barrier_post((unsigned*)(args.ws + WS_CTL) + CW_BAR, (volatile LAS unsigned*)((LAS unsigned char*)lds + MISC_OFF) + 8);
    for (int l = 0; l < DEPTH; ++l) {
        for (int rep = 0; rep < (((EXP_EW_MASK >> 0) & 1) ? 2 : 1); ++rep) { run_phase<0>(lds, args, l); XBAR(bar); }
        for (int rep = 0; rep < EXP_G1_REPS; ++rep) { run_phase<1>(lds, args, l); XBAR(bar); }
        for (int rep = 0; rep < (((EXP_EW_MASK >> 2) & 1) ? 2 : 1); ++rep) { run_phase<2>(lds, args, l); XBAR(bar); }
        for (int rep = 0; rep < EXP_G3_REPS; ++rep) { run_phase<3>(lds, args, l); XBAR(bar); }
        for (int rep = 0; rep < (((EXP_EW_MASK >> 4) & 1) ? 2 : 1); ++rep) { run_phase<4>(lds, args, l); XBAR(bar); }
        run_phase<5>(lds, args, l); XBAR(bar);
        for (int rep = 0; rep < (((EXP_EW_MASK >> 6) & 1) ? 2 : 1); ++rep) { run_phase<6>(lds, args, l); XBAR(bar); }
        for (int rep = 0; rep < EXP_G7_REPS; ++rep) { run_phase<7>(lds, args, l); XBAR(bar); }
        run_phase<8>(lds, args, l); XBAR(bar);
        for (int rep = 0; rep < (((EXP_EW_MASK >> 9) & 1) ? 2 : 1); ++rep) { run_phase<9>(lds, args, l); XBAR(bar); }
        for (int rep = 0; rep < EXP_G10_REPS; ++rep) { run_phase<10>(lds, args, l); XBAR(bar); }
        run_phase<12>(lds, args, l); XBAR(bar);
    }
    run_phase<13>(lds, args, 0);
}

#ifndef MK_ONE_LAUNCH
#define MK_ONE_LAUNCH 1
#endif
template <int K> static void launch_phase(int grid, hipStream_t stream, Args a, int l) {
    static bool attr = false; if (!attr) { (void)hipFuncSetAttribute((const void*)fwd_phase<K>, hipFuncAttributeMaxDynamicSharedMemorySize, LDS_BYTES); attr = true; }
    a.li = l; a.ph_lo = K; a.ph_hi = K + 1;
    hipLaunchKernelGGL(fwd_phase<K>, dim3(grid), dim3(NTHREADS), LDS_BYTES, stream, a);
}
extern "C" void kernel_launch(void* const* d_in, const int* in_sizes, int n_in, void* d_out, int out_size, void* d_ws, size_t ws_size, hipStream_t stream) {
    static int grid = 0;
    if (grid == 0) {
        if (n_in != 25 || in_sizes[0] != M * D || out_size != M * D || ws_size < WS_END2) { fprintf(stderr, "kernel_launch: unexpected shapes (n_in %d, in0 %d, out %d, ws %zu < %zu)\n", n_in, n_in > 0 ? in_sizes[0] : -1, out_size, ws_size, (size_t)WS_END); grid = -1; return; }
        int dev = 0, cus = 0;
        if (hipGetDevice(&dev) != hipSuccess || hipDeviceGetAttribute(&cus, hipDeviceAttributeMultiprocessorCount, dev) != hipSuccess) { grid = -1; return; }
        grid = cus;
    }
    if (grid < 0) return;
    (void)hipMemsetAsync((char*)d_ws + WS_CTL, 0, CTL_ZERO_BYTES, stream);
    Args a{};
    for (int i = 0; i < 25; ++i) a.in[i] = (const float*)d_in[i];
    a.out = (float*)d_out; a.ws = (unsigned char*)d_ws; a.pad = 0;
#if MK_ONE_LAUNCH
    { static bool attr = false; if (!attr) { (void)hipFuncSetAttribute((const void*)fwd_all, hipFuncAttributeMaxDynamicSharedMemorySize, LDS_BYTES); attr = true; }
      a.li = 0; a.ph_lo = 0; a.ph_hi = NPHASES;
      hipLaunchKernelGGL(fwd_all, dim3(grid), dim3(NTHREADS), LDS_BYTES, stream, a); }
#else
    for (int l = 0; l < DEPTH; ++l) {
        launch_phase<0>(grid, stream, a, l); launch_phase<1>(grid, stream, a, l); launch_phase<2>(grid, stream, a, l); launch_phase<3>(grid, stream, a, l);
        launch_phase<4>(grid, stream, a, l); launch_phase<5>(grid, stream, a, l); launch_phase<6>(grid, stream, a, l); launch_phase<7>(grid, stream, a, l);
        launch_phase<8>(grid, stream, a, l); launch_phase<9>(grid, stream, a, l); launch_phase<10>(grid, stream, a, l); launch_phase<11>(grid, stream, a, l);
        launch_phase<12>(grid, stream, a, l);
    }
    launch_phase<13>(grid, stream, a, 0);
#endif
}
```

```cpp
#include <hip/hip_runtime.h>
#include <cstdio>
#include <cstdint>
#include <cmath>
#define GAS __attribute__((address_space(1)))
#define LAS __attribute__((address_space(3)))
namespace pg8 {
#define PG8_LAS __attribute__((address_space(3)))
typedef unsigned short bf16_t;
typedef short bf16x8 __attribute__((ext_vector_type(8)));
typedef float f32x4 __attribute__((ext_vector_type(4)));
typedef unsigned u32x4 __attribute__((ext_vector_type(4)));
constexpr int BM = 256, BK = 64, HALF = 128, HTB = HALF * BK * 2  , STAGE_BYTES = 8 * HTB, NXCD = 8, WGM = 8;

__host__ __device__ __forceinline__ int lds_byte(int r, int c) { const int st = (r >> 4) * 2 + (c >> 5), rr = r & 15, cc = c & 31, ob = rr * 64 + cc * 2; return st * 1024 + (ob ^ (((ob >> 9) & 1) << 5)); }
__host__ __device__ __forceinline__ void stage_rc(int b, int& R, int& C) { const int st = b / 1024, sb = b % 1024, swz = sb ^ (((sb >> 9) & 1) << 5); R = (st >> 1) * 16 + swz / 64; C = (st & 1) * 32 + (swz % 64) / 2; }
__host__ __device__ __forceinline__ int perm32(int rho) { const int n = rho >> 4, i = rho & 15; return 8 * (i >> 2) + 4 * n + (i & 3); }

struct Unit { int pm, pn; };
struct Gemm { const bf16_t* A; const bf16_t* Bt; int M, N, K; };

struct StaticOrder {
    int nM, nN, nwg, G, c;
    __host__ __device__ void init(int M, int N, int G_, int c_) { nM = M / BM; nN = N / BM; nwg = nM * nN; G = G_; c = c_; }
    __host__ __device__ bool next(int i, Unit& u) const {
        const long L = (long)i * G + c; if (L >= nwg) return false;
        int wgid = (int)L; { const int q = nwg / NXCD, r = nwg % NXCD, xcd = wgid % NXCD, off = wgid / NXCD; wgid = (xcd < r ? xcd * (q + 1) : r * (q + 1) + (xcd - r) * q) + off; }
        const int nig = WGM * nN, gid = wgid / nig, fm = gid * WGM, gsz = (nM - fm) < WGM ? (nM - fm) : WGM;
        u.pm = fm + ((wgid % nig) % gsz); u.pn = (wgid % nig) / gsz; return true;
    }
    __device__ __forceinline__ void a_ready(const Unit&) const {}
    __device__ __forceinline__ void done(const Unit&) const {}
};
__device__ __forceinline__ unsigned cvt_pk_bf16(float lo, float hi) { unsigned r; asm volatile("v_cvt_pk_bf16_f32 %0, %1, %2" : "=v"(r) : "v"(lo), "v"(hi)); return r; }
template <class Epi, class Sched, bool ALIGN_EPI = false, bool SP2 = false>
__device__ __forceinline__ void gemm_phase(PG8_LAS unsigned char* lds, const Gemm g, const Sched& S, const Epi& E) {
    int tid_ = threadIdx.x; asm volatile("" : "+v"(tid_));
    const int tid = tid_, wid = __builtin_amdgcn_readfirstlane(tid >> 6), lane = tid & 63, wr = wid >> 2, wc = wid & 3, fr = lane & 15, fq = lane >> 4;
    const int K = g.K, nt = K / BK;
    unsigned voffA[2], voffB[2];
#pragma unroll
    for (int i = 0; i < 2; ++i) { int R, C; stage_rc(tid * 16 + i * 8192, R, C); const int Rb = Epi::PERM ? ((R & ~31) + perm32(R & 31)) : R;
        voffA[i] = (unsigned)(R * K + C) * 2u; voffB[i] = (unsigned)(Rb * K + C) * 2u; }
    const size_t kstep = (size_t)(BK * 2);
    const size_t hstep = (size_t)HALF * K * 2;
    const size_t tstep = 2 * hstep;
    const size_t tstepA = (size_t)Epi::A_ROWS * K * 2;
    const unsigned ldsw = (unsigned)wid * 1024u;
    const int aoff = lds_byte(wr * 64 + fr, fq * 8), boff = lds_byte(wc * 32 + fr, fq * 8);
#define PG8_SA(b, h) (((b) * 2 + (h)) * HTB)
#define PG8_SB(b, h) ((4 + (b) * 2 + (h)) * HTB)
#define PG8_STAGE(bufoff, gbase, voff) do { _Pragma("unroll") for (int _i = 0; _i < 2; ++_i) \
        __builtin_amdgcn_global_load_lds((const unsigned*)((const char*)(gbase) + (voff)[_i]), (PG8_LAS unsigned*)(lds + (bufoff) + ldsw + _i * 8192), 16, 0, 0); } while (0)
#define PG8_LDA(dst, b, h) do { _Pragma("unroll") for (int m = 0; m < 4; ++m) _Pragma("unroll") for (int k = 0; k < 2; ++k) dst[m][k] = *(const PG8_LAS bf16x8*)(lds + PG8_SA(b, h) + aoff + m * 2048 + k * 1024); } while (0)
#define PG8_LDB(dst, b, h) do { _Pragma("unroll") for (int n = 0; n < 2; ++n) _Pragma("unroll") for (int k = 0; k < 2; ++k) dst[n][k] = *(const PG8_LAS bf16x8*)(lds + PG8_SB(b, h) + boff + n * 2048 + k * 1024); } while (0)
#define PG8_MMA(ai, bj, At, Bt) do { __builtin_amdgcn_s_setprio(1); _Pragma("unroll") for (int m = 0; m < 4; ++m) _Pragma("unroll") for (int n = 0; n < 2; ++n) _Pragma("unroll") for (int k = 0; k < 2; ++k) \
        acc[ai][bj][m][n] = __builtin_amdgcn_mfma_f32_16x16x32_bf16(Bt[n][k], At[m][k], acc[ai][bj][m][n], 0, 0, 0); __builtin_amdgcn_s_setprio(0); } while (0)
#define PG8_WAIT_V(n) asm volatile("s_waitcnt vmcnt(" #n ")" ::: "memory")
#define PG8_WAIT_L(n) asm volatile("s_waitcnt lgkmcnt(" #n ")" ::: "memory")
#define PG8_BAR __builtin_amdgcn_s_barrier()
#define PG8_SCHED __builtin_amdgcn_sched_barrier(0)
    Unit cur, nxt; int ui = 0;
    if (!S.next(0, cur)) return;
    f32x4 acc[2][2][4][2];
#pragma unroll
    for (int a = 0; a < 2; ++a)
#pragma unroll
        for (int b = 0; b < 2; ++b)
#pragma unroll
            for (int m = 0; m < 4; ++m)
#pragma unroll
                for (int n = 0; n < 2; ++n) acc[a][b][m][n] = (f32x4){0.f, 0.f, 0.f, 0.f};
    bf16x8 At[4][2], B0[2][2], B1[2][2];
    const char* cA = (const char*)g.A + (size_t)cur.pm * tstepA; const char* cB = (const char*)g.Bt + (size_t)cur.pn * tstep;
    S.a_ready(cur);
    if constexpr (SP2) {
        PG8_STAGE(PG8_SB(0, 0), cB, voffB); PG8_STAGE(PG8_SB(0, 1), cB + hstep, voffB); PG8_STAGE(PG8_SA(0, 0), cA, voffA); PG8_STAGE(PG8_SA(0, 1), cA + hstep, voffA);
        if (wr == 1) PG8_BAR;
        PG8_WAIT_V(2); PG8_BAR;
        PG8_STAGE(PG8_SB(1, 0), cB + kstep, voffB); PG8_STAGE(PG8_SA(1, 0), cA + kstep, voffA); PG8_STAGE(PG8_SB(1, 1), cB + hstep + kstep, voffB);
        PG8_WAIT_V(6); PG8_BAR;
    } else {
        PG8_STAGE(PG8_SB(0, 0), cB, voffB); PG8_STAGE(PG8_SA(0, 0), cA, voffA); PG8_STAGE(PG8_SB(0, 1), cB + hstep, voffB); PG8_STAGE(PG8_SA(0, 1), cA + hstep, voffA);
        if (wr == 1) PG8_BAR;
        PG8_WAIT_V(4); PG8_BAR;
        PG8_STAGE(PG8_SB(1, 0), cB + kstep, voffB); PG8_STAGE(PG8_SA(1, 0), cA + kstep, voffA); PG8_STAGE(PG8_SB(1, 1), cB + hstep + kstep, voffB);
        PG8_WAIT_V(6); PG8_BAR;
    }
    for (;;) {
        const bool has_next = S.next(ui + 1, nxt);
        const char* nA = has_next ? (const char*)g.A + (size_t)nxt.pm * tstepA : cA; const char* nB = has_next ? (const char*)g.Bt + (size_t)nxt.pn * tstep : cB;
        for (int t = 0; t < nt; t += 2) {
            const bool last = (t == nt - 2);
            const char* a1 = cA + (size_t)(t + 1) * kstep;
            const char* a2 = last ? nA : cA + (size_t)(t + 2) * kstep; const char* b2 = last ? nB : cB + (size_t)(t + 2) * kstep;
            const char* a3 = a2 + kstep; const char* b3 = b2 + kstep;
            if (last && has_next) S.a_ready(nxt);
            if constexpr (Epi::HAS_SEG) { if (t == E.t1 || t == E.t2) E.seg(acc, cur, t, wr, wc, fr, fq); }
            if constexpr (SP2) {
            PG8_LDB(B0, 0, 0); PG8_LDB(B1, 0, 1); PG8_SCHED; PG8_LDA(At, 0, 0); PG8_STAGE(PG8_SA(1, 1), a1 + hstep, voffA);
            PG8_WAIT_V(8); PG8_WAIT_L(0); PG8_BAR; PG8_MMA(0, 0, At, B0); PG8_MMA(0, 1, At, B1); PG8_BAR; PG8_SCHED;
            PG8_LDA(At, 0, 1); PG8_STAGE(PG8_SB(0, 0), b2, voffB); PG8_STAGE(PG8_SB(0, 1), b2 + hstep, voffB); PG8_STAGE(PG8_SA(0, 0), a2, voffA);
            PG8_WAIT_V(8); PG8_WAIT_L(0); PG8_BAR; PG8_MMA(1, 0, At, B0); PG8_MMA(1, 1, At, B1); PG8_BAR; PG8_SCHED;
            PG8_LDB(B0, 1, 0); PG8_LDB(B1, 1, 1); PG8_SCHED; PG8_LDA(At, 1, 0); PG8_STAGE(PG8_SA(0, 1), a2 + hstep, voffA);
            PG8_WAIT_V(8); PG8_WAIT_L(0); PG8_BAR; PG8_MMA(0, 0, At, B0); PG8_MMA(0, 1, At, B1); PG8_BAR; PG8_SCHED;
            PG8_LDA(At, 1, 1); PG8_STAGE(PG8_SB(1, 0), b3, voffB); PG8_STAGE(PG8_SB(1, 1), b3 + hstep, voffB); PG8_STAGE(PG8_SA(1, 0), a3, voffA);
            PG8_WAIT_V(8); PG8_WAIT_L(0); PG8_BAR; PG8_MMA(1, 0, At, B0); PG8_MMA(1, 1, At, B1); PG8_BAR; PG8_SCHED;
            } else {
            PG8_LDB(B0, 0, 0); PG8_SCHED; PG8_LDA(At, 0, 0); PG8_STAGE(PG8_SA(1, 1), a1 + hstep, voffA);
            PG8_WAIT_L(8); PG8_BAR; PG8_WAIT_L(0); PG8_MMA(0, 0, At, B0); PG8_BAR; PG8_SCHED;
            PG8_LDB(B1, 0, 1); PG8_STAGE(PG8_SB(0, 0), b2, voffB);
            PG8_BAR; PG8_WAIT_L(0); PG8_MMA(0, 1, At, B1); PG8_BAR;
            PG8_LDA(At, 0, 1); PG8_STAGE(PG8_SA(0, 0), a2, voffA);
            PG8_BAR; PG8_WAIT_L(0); PG8_MMA(1, 0, At, B0); PG8_BAR; PG8_SCHED;
            PG8_STAGE(PG8_SB(0, 1), b2 + hstep, voffB);
            PG8_WAIT_V(6); PG8_BAR; PG8_MMA(1, 1, At, B1); PG8_BAR;
            PG8_LDB(B0, 1, 0); PG8_SCHED; PG8_LDA(At, 1, 0); PG8_STAGE(PG8_SA(0, 1), a2 + hstep, voffA);
            PG8_WAIT_L(8); PG8_BAR; PG8_WAIT_L(0); PG8_MMA(0, 0, At, B0); PG8_BAR; PG8_SCHED;
            PG8_LDB(B1, 1, 1); PG8_STAGE(PG8_SB(1, 0), b3, voffB);
            PG8_BAR; PG8_WAIT_L(0); PG8_MMA(0, 1, At, B1); PG8_BAR;
            PG8_LDA(At, 1, 1); PG8_STAGE(PG8_SA(1, 0), a3, voffA);
            PG8_BAR; PG8_WAIT_L(0); PG8_MMA(1, 0, At, B0); PG8_BAR; PG8_SCHED;
            PG8_STAGE(PG8_SB(1, 1), b3 + hstep, voffB);
            PG8_WAIT_V(6); PG8_BAR; PG8_MMA(1, 1, At, B1); PG8_BAR;
            }
        }
        if constexpr (ALIGN_EPI) { if (wr == 0) PG8_BAR; }
        if constexpr (!Epi::AFTER_DRAIN) { E(acc, cur, wr, wc, fr, fq); S.done(cur); }
        if (!has_next) break;
#pragma unroll
        for (int a = 0; a < 2; ++a)
#pragma unroll
            for (int b = 0; b < 2; ++b)
#pragma unroll
                for (int m = 0; m < 4; ++m)
#pragma unroll
                    for (int n = 0; n < 2; ++n) acc[a][b][m][n] = (f32x4){0.f, 0.f, 0.f, 0.f};
        cur = nxt; cA = nA; cB = nB; ++ui;
        if constexpr (ALIGN_EPI) { if (wr == 1) PG8_BAR; }
    }
    PG8_WAIT_V(0);
    if constexpr (!ALIGN_EPI) { if (wr == 0) PG8_BAR; }
    PG8_BAR;
    if constexpr (Epi::AFTER_DRAIN) { E.fused(acc, cur, wr, wc, fr, fq, lds, wid, lane); S.done(cur); }
#undef PG8_SA
#undef PG8_SB
#undef PG8_STAGE
#undef PG8_LDA
#undef PG8_LDB
#undef PG8_MMA
#undef PG8_WAIT_V
#undef PG8_WAIT_L
#undef PG8_BAR
#undef PG8_SCHED
}
}
#define XB_TMO      128
#define XB_XCNT(j)  (256  + 64 * (j))
#define XB_XSUB(j)  (1280 + 64 * (j))
#define XB_XGEN(j)  (2304 + 64 * (j))
#define XB_TOP      3328
#define XB_TOPGEN   3392
#define XCD_BAR_WORDS 3456
#define XB_SPIN_CAP (1u << 18)

__device__ __forceinline__ unsigned xb_ld(unsigned* p)              { return __hip_atomic_load(p, __ATOMIC_RELAXED, __HIP_MEMORY_SCOPE_AGENT); }
__device__ __forceinline__ unsigned xb_add(unsigned* p, unsigned v) { return __hip_atomic_fetch_add(p, v, __ATOMIC_RELAXED, __HIP_MEMORY_SCOPE_AGENT); }
__device__ __forceinline__ unsigned xb_xcc_id() { return (unsigned)__builtin_amdgcn_s_getreg((3 << 11) | 20) & 0xFu; }
#define XB_SPIN(cond, bar) do { unsigned _sp = 0; while (cond) { __builtin_amdgcn_s_sleep(1); \
    if ((++_sp & 255u) == 0u) { if (xb_ld(&(bar)[XB_TMO])) break; if (_sp > XB_SPIN_CAP) { atomicAdd(&(bar)[XB_TMO], 1u); break; } } } } while (0)

struct XcdBarrier {
    unsigned* bar; unsigned x;
    volatile LAS unsigned* st;
};

__device__ __forceinline__ XcdBarrier xcd_barrier_post(unsigned* bar, volatile LAS unsigned* st) {
    XcdBarrier b; b.bar = bar; b.x = xb_xcc_id(); b.st = st;
    if (threadIdx.x == 0) (void)xb_add(&bar[XB_XCNT(b.x)], 1u);
    return b;
}
__device__ __forceinline__ void xcd_barrier_complete(unsigned* bar, unsigned x, unsigned& nloc, unsigned& nx) {
    const unsigned G = gridDim.x * gridDim.y * gridDim.z;
    unsigned sum, cnt, mine, sp = 0u;
    for (;;) {
        sum = 0u; cnt = 0u; mine = 0u;
#pragma unroll
        for (unsigned j = 0; j < 16; ++j) { const unsigned c = xb_ld(&bar[XB_XCNT(j)]); sum += c; cnt += (c > 0u) ? 1u : 0u; mine = (j == x) ? c : mine; }
        if (sum == G) break;
        __builtin_amdgcn_s_sleep(1);
        if ((++sp & 255u) == 0u) { if (xb_ld(&bar[XB_TMO])) break; if (sp > XB_SPIN_CAP) { atomicAdd(&bar[XB_TMO], 1u); break; } }
    }
    nloc = mine > 0u ? mine : 1u; nx = cnt > 0u ? cnt : 1u;
}

__device__ __forceinline__ void xcd_barrier(const XcdBarrier& b) {
    asm volatile("s_waitcnt vmcnt(0)" ::: "memory");
    __syncthreads();
    if (threadIdx.x == 0) {
        unsigned* bar = b.bar;
        __builtin_amdgcn_s_waitcnt(0);
        unsigned nloc = b.st[0], nx = b.st[1];
        if (nloc == 0u) { xcd_barrier_complete(bar, b.x, nloc, nx); b.st[0] = nloc; b.st[1] = nx; }
        const unsigned old = xb_add(&bar[XB_XSUB(b.x)], 1u);
        const unsigned gen = old / nloc;
        if (old + 1u == (gen + 1u) * nloc) {
            __builtin_amdgcn_fence(__ATOMIC_RELEASE, "agent");
            asm volatile("s_waitcnt vmcnt(0)" ::: "memory");
            const unsigned og = xb_add(&bar[XB_TOP], 1u);
            const unsigned tg = og / nx;
            if (og + 1u == (tg + 1u) * nx) xb_add(&bar[XB_TOPGEN], 1u);
            else XB_SPIN(xb_ld(&bar[XB_TOPGEN]) == tg, bar);
            __builtin_amdgcn_fence(__ATOMIC_ACQUIRE, "agent");
            xb_add(&bar[XB_XGEN(b.x)], 1u);
            asm volatile("s_waitcnt vmcnt(0)" ::: "memory");
        } else {
            XB_SPIN(xb_ld(&bar[XB_XGEN(b.x)]) == gen, bar);
            __builtin_amdgcn_fence(__ATOMIC_ACQUIRE, "agent");
            asm volatile("s_waitcnt vmcnt(0)" ::: "memory");
        }
    }
    __syncthreads();
}

constexpr int BATCH = 2, SEQ = 8192, M = BATCH * SEQ, D = 2048, DEPTH = 4;
constexpr int DIN = 11968, NP1 = 5888, NG = 6144, NWIN = NP1 + NG;
constexpr int BW = 768, BCOLS = 2752;
constexpr int C_AQ = 0, C_AK = 512, C_AV = 640, C_R = 768, C_K = 1536, C_V = 2304, C_WD = 3072, C_CQ = 3520, C_CK = 4288, C_CV = 5056, C_END = 5824;
constexpr int DFF = 5504, NUP = 2 * DFF;
constexpr int NLORA = 2304, KLORA = 512;
constexpr float NORM_EPS = 1e-5f, GN_EPS = 64e-5f;
constexpr int NWAVES = 8, NTHREADS = 512;
constexpr int NPH = 13;
constexpr int NPHASES = DEPTH * NPH + 1;
#ifndef EXP_EW_MASK
#define EXP_EW_MASK 0
#endif
#ifndef EXP_EW_REPS
#define EXP_EW_REPS 1
#endif
#ifndef EXP_G10_REPS
#define EXP_G10_REPS 1
#endif
#ifndef EXP_GATE_REPS
#define EXP_GATE_REPS 1
#endif
#ifndef EXP_G7_REPS
#define EXP_G7_REPS 1
#endif
#ifndef EXP_G3_REPS
#define EXP_G3_REPS 1
#endif
#ifndef EXP_G1_REPS
#define EXP_G1_REPS 1
#endif
#ifndef EXP_SCAN_REPS
#define EXP_SCAN_REPS 1
#endif
#ifndef EXP_ATTN_REPS
#define EXP_ATTN_REPS 1
#endif
constexpr int NSCAN = 48;

constexpr size_t MiB = 1u << 20;
constexpr size_t WS_CTL = 0, CTL_ZERO_BYTES = 1 * MiB;
constexpr size_t WS_WIN = 1 * MiB;
constexpr size_t WS_WLORA = 48 * MiB;
constexpr size_t WS_PA = 51 * MiB;
constexpr size_t WS_PB = 53 * MiB;
constexpr size_t WS_PC = 56 * MiB;
constexpr size_t WS_WOUT = 57 * MiB;
constexpr size_t WS_WUP = 65 * MiB;
constexpr size_t WS_WDOWN = 108 * MiB;
constexpr size_t WS_H = 130 * MiB;
constexpr size_t WS_P1 = 194 * MiB;
constexpr size_t WS_G = 378 * MiB;
constexpr size_t WS_U = WS_P1;
constexpr size_t WS_AP = 570 * MiB;
constexpr size_t WS_LO = 586 * MiB;
constexpr size_t WS_ACT = WS_LO;
constexpr size_t WS_SR = 730 * MiB;
constexpr size_t WS_SW = 778 * MiB, WS_SK = 826 * MiB, WS_SKK = 874 * MiB, WS_SB = 922 * MiB, WS_SV = 970 * MiB;
constexpr size_t WS_YRAW = 1018 * MiB;
constexpr size_t WS_YA = 1066 * MiB;
constexpr size_t WS_YB = 1082 * MiB;
constexpr size_t WS_YC = 1106 * MiB;
constexpr size_t WS_OC = 1114 * MiB;
constexpr size_t WS_LSE = 1138 * MiB;
constexpr size_t WS_MG = 1139 * MiB;
constexpr size_t WS_BK = 1203 * MiB;
constexpr size_t WS_VT = 1205 * MiB;
constexpr size_t WS_W2 = 1235 * MiB;
constexpr size_t WSET_STRIDE = WS_W2 - WS_WIN;
constexpr size_t WS_BON = 1365 * MiB;
constexpr size_t WS_END = 1366 * MiB;
constexpr size_t WS_SST_A = 1366 * MiB, WS_SST_B = WS_MG;
constexpr size_t WS_END2 = 1494 * MiB;
constexpr size_t WS_COP = WS_SR;
constexpr int COP_W1 = 0, COP_BT = 1024, COP_KT = 2048, COP_U0 = 3072, COP_GAM = 3328, COP_RY = 3392, COP_Y0 = 4416, COP_STRIDE = 4672;
constexpr int CW_BAR = 4096;

constexpr int RING_OFF = 0, RING_BYTES = 131072;
constexpr int LDSCTL_OFF = 141312, MISC_OFF = LDSCTL_OFF + 320;
constexpr int LDS_BYTES = 147456;
constexpr int LUT_OFF = 0, SCANRING_OFF = 12288, CONV_SCR_SCAN = 77824, CONV_SCR_OTHER = 12288;

typedef unsigned short bf16;
typedef unsigned v4u __attribute__((ext_vector_type(4)));
typedef unsigned v2u __attribute__((ext_vector_type(2)));
typedef float f32x4 __attribute__((ext_vector_type(4)));
#define LDS_WAIT() asm volatile("s_waitcnt lgkmcnt(0)" ::: "memory")

__device__ __forceinline__ unsigned f2bf(float f) { unsigned u = __builtin_bit_cast(unsigned, f); return (u + 0x7fffu + ((u >> 16) & 1u)) >> 16; }
__device__ __forceinline__ unsigned pk2(float lo, float hi) { return f2bf(lo) | (f2bf(hi) << 16); }
__device__ __forceinline__ float bflo(unsigned w) { return __builtin_bit_cast(float, w << 16); }
__device__ __forceinline__ float bfhi(unsigned w) { return __builtin_bit_cast(float, w & 0xffff0000u); }
__device__ __forceinline__ float bf1(bf16 h) { return __builtin_bit_cast(float, ((unsigned)h) << 16); }
__device__ __forceinline__ float sigmoidf_(float x) { return 1.0f / (1.0f + __expf(-x)); }
__device__ __forceinline__ float shx(float x, int mask, int lane) { return __builtin_bit_cast(float, __builtin_amdgcn_ds_bpermute((lane ^ mask) << 2, __builtin_bit_cast(int, x))); }
__device__ __forceinline__ float wave_sum(float v, int lane) {
#pragma unroll
    for (int o = 1; o < 64; o <<= 1) v += shx(v, o, lane);
    return v;
}
template <int CTRL> __device__ __forceinline__ float dppf(float x) { return __builtin_bit_cast(float, __builtin_amdgcn_update_dpp(0, __builtin_bit_cast(int, x), CTRL, 0xF, 0xF, true)); }
__device__ __forceinline__ float red4(float x) { x += dppf<0xB1>(x); x += dppf<0x4E>(x); return x; }
__device__ __forceinline__ float red16(float x) { x = red4(x); x += dppf<0x141>(x); x += dppf<0x140>(x); return x; }
__device__ __forceinline__ float wsum(float x, int lane) { x = red16(x); x += shx(x, 16, lane); x += shx(x, 32, lane); return x; }

__device__ const unsigned char T5B[3][132] = {
 {0,1,2,3,4,5,6,7,8,9,10,11,12,13,14,15,16,16,16,16,16,16,17,17,17,17,17,17,17,17,18,18,18,18,18,18,18,18,18,18,19,19,19,19,19,19,19,19,19,19,19,19,19,19,20,20,20,20,20,20,20,20,20,20,20,20,20,20,20,20,20,20,20,21,21,21,21,21,21,21,21,21,21,21,21,21,21,21,21,21,21,21,21,21,21,21,21,21,21,22,22,22,22,22,22,22,22,22,22,22,22,22,22,22,22,22,22,22,22,22,22,22,22,22,22,22,22,22,22,0,0,0},
 {0,4,8,12,16,16,17,17,18,18,19,19,19,19,20,20,20,20,20,21,21,21,21,21,21,22,22,22,22,22,22,22,22,22,23,23,23,23,23,23,23,23,23,23,23,23,24,24,24,24,24,24,24,24,24,24,24,24,24,24,24,24,25,25,25,25,25,25,25,25,25,25,25,25,25,25,25,25,25,25,25,25,25,26,26,26,26,26,26,26,26,26,26,26,26,26,26,26,26,26,26,26,26,26,26,26,26,26,26,26,26,26,26,27,27,27,27,27,27,27,27,27,27,27,27,27,27,27,27,0,0,0},
 {0,16,18,19,20,21,21,22,22,23,23,23,24,24,24,24,25,25,25,25,25,26,26,26,26,26,26,26,26,27,27,27,27,27,27,27,27,27,27,28,28,28,28,28,28,28,28,28,28,28,28,28,29,29,29,29,29,29,29,29,29,29,29,29,29,29,29,29,29,29,30,30,30,30,30,30,30,30,30,30,30,30,30,30,30,30,30,30,30,30,30,30,30,30,30,31,31,31,31,31,31,31,31,31,31,31,31,31,31,31,31,31,31,31,31,31,31,31,31,31,31,31,31,31,31,31,31,31,31,0,0,0}};

namespace pg8 {
struct EpiWin {
    static constexpr bool PERM = true, AFTER_DRAIN = false; static constexpr int A_ROWS = 256; static constexpr bool HAS_SEG = false;
    bf16_t* P1; bf16_t* G; int pn0;
    __device__ __forceinline__ void operator()(const f32x4 (&acc)[2][2][4][2], const Unit& u, int wr, int wc, int fr, int fq) const {
        const int pn = u.pn + pn0; const int row0 = u.pm * BM + wr * 64 + fr; const bool gate = pn >= 23;
        bf16_t* base = gate ? G : P1; const int ldc = gate ? 6144 : 5888; const int col0 = (gate ? (pn - 23) : pn) * BM + wc * 32 + 8 * fq;
#pragma unroll
        for (int ai = 0; ai < 2; ++ai)
#pragma unroll
            for (int m = 0; m < 4; ++m) { bf16_t* rowp = base + (size_t)(row0 + ai * HALF + m * 16) * ldc + col0;
#pragma unroll
                for (int bj = 0; bj < 2; ++bj) { f32x4 v0 = acc[ai][bj][m][0], v1 = acc[ai][bj][m][1];
                    if (gate) {
#pragma unroll
                        for (int j = 0; j < 4; ++j) { v0[j] = __builtin_amdgcn_rcpf(1.0f + __expf(-v0[j])); v1[j] = __builtin_amdgcn_rcpf(1.0f + __expf(-v1[j])); } }
                    u32x4 w; w.x = cvt_pk_bf16(v0[0], v0[1]); w.y = cvt_pk_bf16(v0[2], v0[3]); w.z = cvt_pk_bf16(v1[0], v1[1]); w.w = cvt_pk_bf16(v1[2], v1[3]);
                    *(u32x4*)(rowp + bj * HALF) = w; } }
    }
};
struct EpiBf16P {
    static constexpr bool PERM = true, AFTER_DRAIN = false; static constexpr int A_ROWS = 256; static constexpr bool HAS_SEG = false;
    bf16_t* O; int ldc;
    __device__ __forceinline__ void operator()(const f32x4 (&acc)[2][2][4][2], const Unit& u, int wr, int wc, int fr, int fq) const {
        const int row0 = u.pm * BM + wr * 64 + fr; const int col0 = u.pn * BM + wc * 32 + 8 * fq;
#pragma unroll
        for (int ai = 0; ai < 2; ++ai)
#pragma unroll
            for (int m = 0; m < 4; ++m) { bf16_t* rowp = O + (size_t)(row0 + ai * HALF + m * 16) * ldc + col0;
#pragma unroll
                for (int bj = 0; bj < 2; ++bj) { const f32x4 v0 = acc[ai][bj][m][0], v1 = acc[ai][bj][m][1];
                    u32x4 w; w.x = cvt_pk_bf16(v0[0], v0[1]); w.y = cvt_pk_bf16(v0[2], v0[3]); w.z = cvt_pk_bf16(v1[0], v1[1]); w.w = cvt_pk_bf16(v1[2], v1[3]);
                    *(u32x4*)(rowp + bj * HALF) = w; } }
    }
};
struct EpiF32P {
    static constexpr bool PERM = false, AFTER_DRAIN = false; static constexpr int A_ROWS = 256; static constexpr bool HAS_SEG = false;
    float* C; int ldc;
    __device__ __forceinline__ void operator()(const f32x4 (&acc)[2][2][4][2], const Unit& u, int wr, int wc, int fr, int fq) const {
        const int row0 = u.pm * BM + wr * 64 + fr, col0 = u.pn * BM + wc * 32 + 4 * fq;
#pragma unroll
        for (int ai = 0; ai < 2; ++ai)
#pragma unroll
            for (int m = 0; m < 4; ++m) { float* rowp = C + (size_t)(row0 + ai * HALF + m * 16) * ldc + col0;
#pragma unroll
                for (int bj = 0; bj < 2; ++bj)
#pragma unroll
                    for (int n = 0; n < 2; ++n) *(f32x4*)(rowp + bj * HALF + n * 16) = acc[ai][bj][m][n]; }
    }
};
struct EpiResid {
    static constexpr bool PERM = false, AFTER_DRAIN = false; static constexpr int A_ROWS = 256; static constexpr bool HAS_SEG = false;
    const float* xin; float* out;
    __device__ __forceinline__ void operator()(const f32x4 (&acc)[2][2][4][2], const Unit& u, int wr, int wc, int fr, int fq) const {
        const int row0 = u.pm * BM + wr * 64 + fr, col0 = u.pn * BM + wc * 32 + 4 * fq;
#pragma unroll
        for (int ai = 0; ai < 2; ++ai)
#pragma unroll
            for (int m = 0; m < 4; ++m) { const size_t ro = (size_t)(row0 + ai * HALF + m * 16) * 2048 + col0;
#pragma unroll
                for (int bj = 0; bj < 2; ++bj)
#pragma unroll
                    for (int n = 0; n < 2; ++n) { const f32x4 xv = *(const f32x4*)(xin + ro + bj * HALF + n * 16); *(f32x4*)(out + ro + bj * HALF + n * 16) = xv + acc[ai][bj][m][n]; } }
    }
};
template <bool ACC> struct EpiGate {
    static constexpr bool PERM = true, AFTER_DRAIN = false; static constexpr int A_ROWS = 256; static constexpr bool HAS_SEG = false;
    const bf16_t* G; int gofs; bf16_t* MG;
    __device__ __forceinline__ void operator()(const f32x4 (&acc)[2][2][4][2], const Unit& u, int wr, int wc, int fr, int fq) const {
        const int row0 = u.pm * BM + wr * 64 + fr; const int col0 = u.pn * BM + wc * 32 + 8 * fq;
#pragma unroll
        for (int ai = 0; ai < 2; ++ai)
#pragma unroll
            for (int m = 0; m < 4; ++m) { const int row = row0 + ai * HALF + m * 16;
#pragma unroll
                for (int bj = 0; bj < 2; ++bj) { const int col = col0 + bj * HALF;
                    const u32x4 gv = *(const u32x4*)(G + (size_t)row * 6144 + gofs + col);
                    const f32x4 a0 = acc[ai][bj][m][0], a1 = acc[ai][bj][m][1];
                    float r[8];
                    r[0] = __builtin_bit_cast(float, gv.x << 16) * a0[0]; r[1] = __builtin_bit_cast(float, gv.x & 0xffff0000u) * a0[1];
                    r[2] = __builtin_bit_cast(float, gv.y << 16) * a0[2]; r[3] = __builtin_bit_cast(float, gv.y & 0xffff0000u) * a0[3];
                    r[4] = __builtin_bit_cast(float, gv.z << 16) * a1[0]; r[5] = __builtin_bit_cast(float, gv.z & 0xffff0000u) * a1[1];
                    r[6] = __builtin_bit_cast(float, gv.w << 16) * a1[2]; r[7] = __builtin_bit_cast(float, gv.w & 0xffff0000u) * a1[3];
                    bf16_t* mp = MG + (size_t)row * 2048 + col;
                    if (ACC) { const u32x4 ov = *(const u32x4*)mp;
                        r[0] += __builtin_bit_cast(float, ov.x << 16); r[1] += __builtin_bit_cast(float, ov.x & 0xffff0000u);
                        r[2] += __builtin_bit_cast(float, ov.y << 16); r[3] += __builtin_bit_cast(float, ov.y & 0xffff0000u);
                        r[4] += __builtin_bit_cast(float, ov.z << 16); r[5] += __builtin_bit_cast(float, ov.z & 0xffff0000u);
                        r[6] += __builtin_bit_cast(float, ov.w << 16); r[7] += __builtin_bit_cast(float, ov.w & 0xffff0000u); }
                    u32x4 w; w.x = cvt_pk_bf16(r[0], r[1]); w.y = cvt_pk_bf16(r[2], r[3]); w.z = cvt_pk_bf16(r[4], r[5]); w.w = cvt_pk_bf16(r[6], r[7]);
                    *(u32x4*)mp = w; } }
    }
};
struct EpiGate3 {
    static constexpr bool PERM = true, AFTER_DRAIN = false; static constexpr int A_ROWS = 256; static constexpr bool HAS_SEG = true;
    const bf16_t* G; bf16_t* MG; int t1, t2;
    __device__ __forceinline__ void seg(f32x4 (&acc)[2][2][4][2], const Unit& u, int t, int wr, int wc, int fr, int fq) const {
        typedef unsigned u32x2 __attribute__((ext_vector_type(2)));
        const int gnum = (t == t1) ? 0 : 2048;
        const bf16_t* gp0 = G + (size_t)(u.pm * BM + wr * 64 + fr) * 6144 + gnum + u.pn * BM + wc * 32 + 8 * fq;
#pragma unroll
        for (int ai = 0; ai < 2; ++ai)
#pragma unroll
            for (int m = 0; m < 4; ++m)
#pragma unroll
                for (int bj = 0; bj < 2; ++bj)
#pragma unroll
                    for (int n = 0; n < 2; ++n) {
                        const bf16_t* gp = gp0 + (size_t)(ai * HALF + m * 16) * 6144 + bj * HALF + 4 * n;
                        const u32x2 gn = *(const u32x2*)gp, gd = *(const u32x2*)(gp + 2048);
                        f32x4 r;
                        r[0] = __builtin_bit_cast(float, gn.x << 16) * __builtin_amdgcn_rcpf(__builtin_bit_cast(float, gd.x << 16)); r[1] = __builtin_bit_cast(float, gn.x & 0xffff0000u) * __builtin_amdgcn_rcpf(__builtin_bit_cast(float, gd.x & 0xffff0000u));
                        r[2] = __builtin_bit_cast(float, gn.y << 16) * __builtin_amdgcn_rcpf(__builtin_bit_cast(float, gd.y << 16)); r[3] = __builtin_bit_cast(float, gn.y & 0xffff0000u) * __builtin_amdgcn_rcpf(__builtin_bit_cast(float, gd.y & 0xffff0000u));
                        acc[ai][bj][m][n] *= r; if (n == 1 && bj == 1) asm volatile("" ::: "memory"); }
    }
    __device__ __forceinline__ void operator()(const f32x4 (&acc)[2][2][4][2], const Unit& u, int wr, int wc, int fr, int fq) const {
        const int row0 = u.pm * BM + wr * 64 + fr; const int col0 = u.pn * BM + wc * 32 + 8 * fq;
#pragma unroll
        for (int ai = 0; ai < 2; ++ai)
#pragma unroll
            for (int m = 0; m < 4; ++m) { const int row = row0 + ai * HALF + m * 16;
#pragma unroll
                for (int bj = 0; bj < 2; ++bj) { const int col = col0 + bj * HALF; const u32x4 gv = *(const u32x4*)(G + (size_t)row * 6144 + 4096 + col);
                    const f32x4 a0 = acc[ai][bj][m][0], a1 = acc[ai][bj][m][1];
                    u32x4 w;
                    w.x = cvt_pk_bf16(__builtin_bit_cast(float, gv.x << 16) * a0[0], __builtin_bit_cast(float, gv.x & 0xffff0000u) * a0[1]);
                    w.y = cvt_pk_bf16(__builtin_bit_cast(float, gv.y << 16) * a0[2], __builtin_bit_cast(float, gv.y & 0xffff0000u) * a0[3]);
                    w.z = cvt_pk_bf16(__builtin_bit_cast(float, gv.z << 16) * a1[0], __builtin_bit_cast(float, gv.z & 0xffff0000u) * a1[1]);
                    w.w = cvt_pk_bf16(__builtin_bit_cast(float, gv.w << 16) * a1[2], __builtin_bit_cast(float, gv.w & 0xffff0000u) * a1[3]);
                    *(u32x4*)(MG + (size_t)row * 2048 + col) = w; } }
    }
};
template <int CTRL> __device__ __forceinline__ float dpp_keep(float old, float x) { return __builtin_bit_cast(float, __builtin_amdgcn_update_dpp(__builtin_bit_cast(int, old), __builtin_bit_cast(int, x), CTRL, 0xF, 0xF, false)); }
struct EpiConv {
    static constexpr bool PERM = true, AFTER_DRAIN = false; static constexpr int A_ROWS = 254; static constexpr bool HAS_SEG = false;
    bf16_t* ACT; const float* cw; PG8_LAS float* xch;
    __device__ __forceinline__ void operator()(const f32x4 (&acc)[2][2][4][2], const Unit& u, int wr, int wc, int fr, int fq) const {
        const int cbase = wc * 32 + 8 * fq, f0 = u.pn * 128 + cbase;
        float c0[8], c1[8], c2[8];
#pragma unroll
        for (int j = 0; j < 8; ++j) { c0[j] = cw[f0 + j]; c1[j] = cw[5504 + f0 + j]; c2[j] = cw[2 * 5504 + f0 + j]; }
        if (fr >= 14) {
#pragma unroll
            for (int ai = 0; ai < 2; ++ai)
#pragma unroll
                for (int n = 0; n < 2; ++n) *(PG8_LAS f32x4*)(xch + ((2 * ai + wr) * 2 + (fr - 14)) * 128 + cbase + 4 * n) = acc[ai][0][3][n];
        }
        asm volatile("s_waitcnt lgkmcnt(0)" ::: "memory"); __builtin_amdgcn_s_barrier(); asm volatile("" ::: "memory");
#pragma unroll
        for (int ai = 0; ai < 2; ++ai) {
            const int sl = 2 * ai + wr;
            f32x4 e1[2], e2[2];
#pragma unroll
            for (int n = 0; n < 2; ++n) { e1[n] = (f32x4){0.f, 0.f, 0.f, 0.f}; e2[n] = e1[n];
                if (sl > 0) { e2[n] = *(const PG8_LAS f32x4*)(xch + ((sl - 1) * 2 + 0) * 128 + cbase + 4 * n); e1[n] = *(const PG8_LAS f32x4*)(xch + ((sl - 1) * 2 + 1) * 128 + cbase + 4 * n); } }
#pragma unroll
            for (int m = 0; m < 4; ++m) {
                const int lr = 128 * ai + 64 * wr + 16 * m + fr; const int grow = 254 * u.pm - 2 + lr; const int t = grow & 8191;
                float r[8];
#pragma unroll
                for (int n = 0; n < 2; ++n)
#pragma unroll
                    for (int j = 0; j < 4; ++j) {
                        const float x = acc[ai][0][m][n][j];
                        float k1, k2;
                        if (m > 0) { const float xp = acc[ai][0][m > 0 ? m - 1 : 0][n][j]; k1 = dpp_keep<0x121>(xp, xp); k2 = dpp_keep<0x122>(xp, xp); }
                        else { k1 = e1[n][j]; k2 = (fr == 0) ? e2[n][j] : e1[n][j]; }
                        float p1 = dpp_keep<0x111>(k1, x), p2 = dpp_keep<0x112>(k2, x);
                        if (t == 0) p1 = 0.f; if (t <= 1) p2 = 0.f;
                        const float gs = c0[4 * n + j] * p2 + c1[4 * n + j] * p1 + c2[4 * n + j] * x;
                        r[4 * n + j] = gs * __builtin_amdgcn_rcpf(1.0f + __expf(-gs)) * acc[ai][1][m][n][j];
                    }
                if (lr >= 2 && grow < 16384) { u32x4 w; w.x = cvt_pk_bf16(r[0], r[1]); w.y = cvt_pk_bf16(r[2], r[3]); w.z = cvt_pk_bf16(r[4], r[5]); w.w = cvt_pk_bf16(r[6], r[7]);
                    *(u32x4*)(ACT + (size_t)grow * 5504 + f0) = w; }
            }
        }
    }
};
}

struct Args { const float* in[25]; float* out; unsigned char* ws; int ph_lo, ph_hi, li, pad; };

struct Ctx {
    LAS unsigned char* lds;
    int tid, lane, wave, G, bid;
    int gw, ngw;
};

__device__ __forceinline__ void transpose_item(const float* W, int K, int N, bf16* WT, int kb, int nb, int dst_row0, LAS float* scr, int lane, int ldk = 0, int koff = 0) {
    if (ldk == 0) ldk = K;
    const int k0 = 64 * kb, n0 = 32 * nb;
#pragma unroll
    for (int hh = 0; hh < 2; ++hh) { f32x4 t[4];
#pragma unroll
      for (int i = 0; i < 4; ++i) t[i] = *(const f32x4*)(W + (size_t)(k0 + 8 * (4 * hh + i) + (lane >> 3)) * N + n0 + 4 * (lane & 7));
#pragma unroll
      for (int i = 0; i < 4; ++i) { LAS float* d = scr + (8 * (4 * hh + i) + (lane >> 3)) * 33 + 4 * (lane & 7); d[0] = t[i][0]; d[1] = t[i][1]; d[2] = t[i][2]; d[3] = t[i][3]; } }
    LDS_WAIT(); asm volatile("" ::: "memory");
    const int c = lane & 7;
#pragma unroll
    for (int j = 0; j < 4; ++j) { const int n = (lane >> 3) + 8 * j; const LAS float* s = scr + (8 * c) * 33 + n;
        v4u o; o.x = pk2(s[0 * 33], s[1 * 33]); o.y = pk2(s[2 * 33], s[3 * 33]); o.z = pk2(s[4 * 33], s[5 * 33]); o.w = pk2(s[6 * 33], s[7 * 33]);
        *(v4u*)(WT + (size_t)(dst_row0 + n) * ldk + koff + k0 + 8 * c) = o; }
    LDS_WAIT(); asm volatile("" ::: "memory");
}
__device__ __forceinline__ int transpose_matrix(int widx, int nw, int lane, LAS float* scr, const float* W, int K, int N, bf16* WT, int gate_split, int base, int ldk = 0, int koff = 0) {
    const int nblk = N / 32, items = (K / 64) * nblk;
    int first = (widx - base) % nw; if (first < 0) first += nw;
    for (int it = first; it < items; it += nw) {
        const int kb = it / nblk, nb = it % nblk; int dr = 32 * nb; if (gate_split == 1 && dr >= C_END) dr += 64;
        if (gate_split == 2) { const int f = dr < DFF ? dr : dr - DFF; dr = 256 * (f >> 7) + (f & 127) + (dr < DFF ? 0 : 128); }
        transpose_item(W, K, N, WT, kb, nb, dr, scr, lane, ldk, koff);
    }
    return base + items;
}
__device__ __forceinline__ void convert_weights(int widx, int nw, int lane, LAS float* scr, const Args& a, int l, unsigned char* ws) {
    unsigned char* wsw = ws + (size_t)(l & 1) * WSET_STRIDE;
    int base = 0;
    base = transpose_matrix(widx, nw, lane, scr, a.in[3] + (size_t)l * D * DIN, D, DIN, (bf16*)(wsw + WS_WIN), 1, base);
    base = transpose_matrix(widx, nw, lane, scr, a.in[21] + (size_t)l * D * NUP, D, NUP, (bf16*)(wsw + WS_WUP), 2, base);
    base = transpose_matrix(widx, nw, lane, scr, a.in[23] + (size_t)l * DFF * D, DFF, D, (bf16*)(wsw + WS_WDOWN), 0, base);
    base = transpose_matrix(widx, nw, lane, scr, a.in[19] + (size_t)l * D * D, D, D, (bf16*)(wsw + WS_WOUT), 0, base);
    base = transpose_matrix(widx, nw, lane, scr, a.in[16] + (size_t)l * 512 * D, 512, D, (bf16*)(wsw + WS_PA), 0, base, 1536, 0);
    base = transpose_matrix(widx, nw, lane, scr, a.in[17] + (size_t)l * 768 * D, 768, D, (bf16*)(wsw + WS_PA), 0, base, 1536, 512);
    base = transpose_matrix(widx, nw, lane, scr, a.in[18] + (size_t)l * 256 * D, 256, D, (bf16*)(wsw + WS_PA), 0, base, 1536, 1280);
    const int gt = widx * 64 + lane, ngt = nw * 64;
    { v4u* z = (v4u*)((bf16*)(wsw + WS_WIN) + (size_t)C_END * D); for (int i = gt; i < 64 * D / 8; i += ngt) z[i] = (v4u){0u, 0u, 0u, 0u}; }
    { bf16* wl = (bf16*)(wsw + WS_WLORA); const float* wup = a.in[7] + (size_t)l * 96 * BW; const float* aup = a.in[9] + (size_t)l * 96 * BW; const float* gup = a.in[10] + (size_t)l * 256 * BW;
      for (int i = gt; i < NLORA * KLORA; i += ngt) { const int n = i / KLORA, k = i % KLORA; float v = 0.f;
          if (n < 768) { if (k < 96) v = wup[k * BW + n]; }
          else if (n < 1536) { if (k >= 96 && k < 192) v = aup[(k - 96) * BW + (n - 768)]; }
          else { if (k >= 192 && k < 448) v = gup[(k - 192) * BW + (n - 1536)]; }
          wl[i] = (bf16)f2bf(v); } }
}

__device__ __forceinline__ void rms_row_bf16(const float* xrow, const float* gam, bf16* orow, int lane) {
    const f32x4* xr = (const f32x4*)xrow + lane; f32x4 v[8]; float s = 0.f;
#pragma unroll
    for (int j = 0; j < 8; ++j) { v[j] = xr[64 * j]; s += (v[j].x * v[j].x + v[j].y * v[j].y) + (v[j].z * v[j].z + v[j].w * v[j].w); }
    const float rs = 1.0f / sqrtf(wave_sum(s, lane) * (1.0f / D) + NORM_EPS);
    const f32x4* gr = (const f32x4*)gam + lane; v2u* o8 = (v2u*)orow + lane;
#pragma unroll
    for (int j = 0; j < 8; ++j) { const f32x4 g = gr[64 * j]; v2u w; w.x = pk2(v[j].x * rs * g.x, v[j].y * rs * g.y); w.y = pk2(v[j].z * rs * g.z, v[j].w * rs * g.w); o8[64 * j] = w; }
}
__device__ __forceinline__ void rms_row2_bf16(const float* xrow, const float* gam, bf16* orow, int lane) {
    const f32x4* xr = (const f32x4*)xrow + lane; f32x4 v[16]; float s0 = 0.f, s1 = 0.f;
#pragma unroll
    for (int j = 0; j < 16; ++j) v[j] = xr[64 * j];
#pragma unroll
    for (int j = 0; j < 8; ++j) { s0 += (v[j].x * v[j].x + v[j].y * v[j].y) + (v[j].z * v[j].z + v[j].w * v[j].w); s1 += (v[8 + j].x * v[8 + j].x + v[8 + j].y * v[8 + j].y) + (v[8 + j].z * v[8 + j].z + v[8 + j].w * v[8 + j].w); }
    const float rs0 = 1.0f / sqrtf(wsum(s0, lane) * (1.0f / D) + NORM_EPS), rs1 = 1.0f / sqrtf(wsum(s1, lane) * (1.0f / D) + NORM_EPS);
    const f32x4* gr = (const f32x4*)gam + lane; v2u* o8 = (v2u*)orow + lane;
#pragma unroll
    for (int j = 0; j < 8; ++j) { const f32x4 g = gr[64 * j]; v2u w; w.x = pk2(v[j].x * rs0 * g.x, v[j].y * rs0 * g.y); w.y = pk2(v[j].z * rs0 * g.z, v[j].w * rs0 * g.w); o8[64 * j] = w;
        v2u w1; w1.x = pk2(v[8 + j].x * rs1 * g.x, v[8 + j].y * rs1 * g.y); w1.y = pk2(v[8 + j].z * rs1 * g.z, v[8 + j].w * rs1 * g.w); o8[64 * (8 + j)] = w1; }
}
__device__ __forceinline__ void rms_row_f32(float* xrow, const float* gam, int lane) {
    f32x4* xr = (f32x4*)xrow + lane; f32x4 v[8]; float s = 0.f;
#pragma unroll
    for (int j = 0; j < 8; ++j) { v[j] = xr[64 * j]; s += (v[j].x * v[j].x + v[j].y * v[j].y) + (v[j].z * v[j].z + v[j].w * v[j].w); }
    const float rs = 1.0f / sqrtf(wave_sum(s, lane) * (1.0f / D) + NORM_EPS);
    const f32x4* gr = (const f32x4*)gam + lane;
#pragma unroll
    for (int j = 0; j < 8; ++j) { const f32x4 g = gr[64 * j]; xr[64 * j] = v[j] * rs * g; }
}

__device__ __forceinline__ void phase_prep(const Ctx& C, const Args& a, int l, const float* xsrc, unsigned char* ws) {
    if (l == 0) convert_weights(C.gw, C.ngw, C.lane, (LAS float*)(C.lds + RING_OFF + C.wave * 16384), a, 0, ws);
    const float* g1 = a.in[2] + (size_t)l * D; bf16* H = (bf16*)(ws + WS_H);
    for (int m = 2 * C.gw; m < M; m += 2 * C.ngw) rms_row2_bf16(xsrc + (size_t)m * D, g1, H + (size_t)m * D, C.lane);
}

__device__ __forceinline__ void phase_aprime(const Ctx& C, const Args& a, int l, unsigned char* ws) {
    const bf16* P1 = (const bf16*)(ws + WS_P1); bf16* AP = (bf16*)(ws + WS_AP); const float* mu = a.in[5] + (size_t)l * BCOLS;
    const int g = C.lane, c0 = 8 * g;
    float muv[8];
#pragma unroll
    for (int j = 0; j < 8; ++j) muv[j] = (g < 56) ? mu[(C_WD - C_R) + c0 + j] : 0.f;
    for (int m = C.gw; m < M; m += C.ngw) {
        v4u o = (v4u){0u, 0u, 0u, 0u};
        if (g < 56) {
            const v4u cur = *(const v4u*)(P1 + (size_t)m * NP1 + C_WD + c0);
            v4u prv = (v4u){0u, 0u, 0u, 0u}; if ((m & (SEQ - 1)) != 0) prv = *(const v4u*)(P1 + (size_t)(m - 1) * NP1 + C_WD + c0);
            float x[8], p[8];
            x[0] = bflo(cur.x); x[1] = bfhi(cur.x); x[2] = bflo(cur.y); x[3] = bfhi(cur.y); x[4] = bflo(cur.z); x[5] = bfhi(cur.z); x[6] = bflo(cur.w); x[7] = bfhi(cur.w);
            p[0] = bflo(prv.x); p[1] = bfhi(prv.x); p[2] = bflo(prv.y); p[3] = bfhi(prv.y); p[4] = bflo(prv.z); p[5] = bfhi(prv.z); p[6] = bflo(prv.w); p[7] = bfhi(prv.w);
#pragma unroll
            for (int j = 0; j < 8; ++j) { float v = x[j] + (p[j] - x[j]) * muv[j];
                if (g < 12) v = tanhf(v); else if (g >= 24) v = sigmoidf_(v);
                x[j] = v; }
            o.x = pk2(x[0], x[1]); o.y = pk2(x[2], x[3]); o.z = pk2(x[4], x[5]); o.w = pk2(x[6], x[7]);
        }
        *(v4u*)(AP + (size_t)m * KLORA + c0) = o;
    }
}

struct PrepTok { float r, kt, v, w, kk, b; };
__device__ __forceinline__ PrepTok prep_token(const bf16* P1, const float* LO, int m, int hc, float mur, float muk, float muv, float w0, float a0, float kkw, float kaw) {
    const bool first = (m & (SEQ - 1)) == 0;
    const bf16* pr = P1 + (size_t)m * NP1; const bf16* pp = pr - NP1;
    float r = bf1(pr[C_R + hc]), k = bf1(pr[C_K + hc]), v = bf1(pr[C_V + hc]);
    const float rp = first ? 0.f : bf1(pp[C_R + hc]), kp = first ? 0.f : bf1(pp[C_K + hc]), vp = first ? 0.f : bf1(pp[C_V + hc]);
    r = r + (rp - r) * mur; k = k + (kp - k) * muk; v = v + (vp - v) * muv;
    const float wpre = w0 + LO[(size_t)m * NLORA + hc], apre = a0 + LO[(size_t)m * NLORA + BW + hc];
    const float xx = -wpre; const float sp = fmaxf(xx, 0.f) + log1pf(expf(-fabsf(xx)));
    const float wlog = -sp - 0.5f; const float decay = expf(-expf(wlog));
    const float av = 1.0f / (1.0f + expf(-apre));
    const float kkr = k * kkw; const float nrm = sqrtf(wave_sum(kkr * kkr, 0)); const float kk = kkr / fmaxf(nrm, 1e-12f);
    PrepTok t; t.r = r; t.kt = k * (1.0f + (av - 1.0f) * kaw); t.v = v; t.w = decay; t.kk = kk; t.b = kk * av; return t;
}
struct PrepRaw { v2u r, k, v; f32x4 lw, la; };
__device__ __forceinline__ PrepRaw prep_load(const bf16* P1, const float* LO, int m, int c0) {
    PrepRaw x; const bf16* pr = P1 + (size_t)m * NP1 + c0;
    x.r = *(const v2u*)(pr + C_R); x.k = *(const v2u*)(pr + C_K); x.v = *(const v2u*)(pr + C_V);
    x.lw = *(const f32x4*)(LO + (size_t)m * NLORA + c0); x.la = *(const f32x4*)(LO + (size_t)m * NLORA + BW + c0); return x;
}
__device__ __forceinline__ void un4(const v2u w, float (&x)[4]) { x[0] = bflo(w.x); x[1] = bfhi(w.x); x[2] = bflo(w.y); x[3] = bfhi(w.y); }
__device__ __forceinline__ void phase_scanprep(const Ctx& C, const Args& a, int l, unsigned char* ws) {
    const bf16* P1 = (const bf16*)(ws + WS_P1); const float* LO = (const float*)(ws + WS_LO);
    float* SR = (float*)(ws + WS_SR); float* SW = (float*)(ws + WS_SW); float* SK = (float*)(ws + WS_SK); float* SU = (float*)(ws + WS_SKK); float* SB = (float*)(ws + WS_SB); float* SV = (float*)(ws + WS_SV);
    float* BK = (float*)(ws + WS_BK); float* BON = (float*)(ws + WS_BON);
    const float* mu = a.in[5] + (size_t)l * BCOLS; const float* w0p = a.in[6] + (size_t)l * BW; const float* a0p = a.in[8] + (size_t)l * BW;
    const float* kkwp = a.in[11] + (size_t)l * BW; const float* kawp = a.in[12] + (size_t)l * BW; const float* rkp = a.in[13] + (size_t)l * BW;
    constexpr int RL = 8;
    const int g = C.lane >> 4, cq = C.lane & 15;
    for (int it = C.gw; it < (M / (4 * RL)) * 12; it += C.ngw) {
        const int h = it % 12, m0 = ((it / 12) * 4 + g) * RL, c0 = h * 64 + 4 * cq;
        const f32x4 mur = *(const f32x4*)(mu + c0), muk = *(const f32x4*)(mu + BW + c0), muv = *(const f32x4*)(mu + 2 * BW + c0), w0 = *(const f32x4*)(w0p + c0), a0 = *(const f32x4*)(a0p + c0);
        const f32x4 kkw = *(const f32x4*)(kkwp + c0), kaw = *(const f32x4*)(kawp + c0), rkc = *(const f32x4*)(rkp + c0);
        const bool seq_start = (m0 & (SEQ - 1)) == 0;
        float prr[4] = {0.f, 0.f, 0.f, 0.f}, prk[4] = {0.f, 0.f, 0.f, 0.f}, prv[4] = {0.f, 0.f, 0.f, 0.f}, pw[4] = {0.f, 0.f, 0.f, 0.f}, pb[4] = {0.f, 0.f, 0.f, 0.f}, pkt[4] = {0.f, 0.f, 0.f, 0.f};
        if (!seq_start) { const bf16* pr = P1 + (size_t)(m0 - 2) * NP1 + c0; un4(*(const v2u*)(pr + C_R), prr); un4(*(const v2u*)(pr + C_K), prk); un4(*(const v2u*)(pr + C_V), prv); }
        PrepRaw nx = prep_load(P1, LO, seq_start ? m0 : m0 - 1, c0);
#pragma unroll 1
        for (int i = seq_start ? 0 : -1; i < RL; ++i) {
            const int m = m0 + i; const PrepRaw cu = nx;
            if (i + 1 < RL) nx = prep_load(P1, LO, m + 1, c0);
            float xr[4], xk[4], xv[4]; un4(cu.r, xr); un4(cu.k, xk); un4(cu.v, xv);
            float tr[4], tk[4], tv[4], tw[4], ta[4], kkr[4]; float q = 0.f;
#pragma unroll
            for (int e = 0; e < 4; ++e) {
                tr[e] = xr[e] + (prr[e] - xr[e]) * mur[e]; tk[e] = xk[e] + (prk[e] - xk[e]) * muk[e]; tv[e] = xv[e] + (prv[e] - xv[e]) * muv[e];
                const float xx = -(w0[e] + cu.lw[e]); const float sp = fmaxf(xx, 0.f) + __logf(1.0f + __expf(-fabsf(xx)));
                tw[e] = __expf(-__expf(-sp - 0.5f)); ta[e] = __builtin_amdgcn_rcpf(1.0f + __expf(-(a0[e] + cu.la[e])));
                kkr[e] = tk[e] * kkw[e]; q += kkr[e] * kkr[e];
            }
            q = red16(q); const float rn = __builtin_amdgcn_rsqf(fmaxf(q, 1e-24f));
            float tkk[4], tb[4], tkt[4]; float be = 0.f, ka = 0.f, bo = 0.f;
#pragma unroll
            for (int e = 0; e < 4; ++e) { tkk[e] = kkr[e] * rn; tb[e] = tkk[e] * ta[e]; tkt[e] = tk[e] * (1.0f + (ta[e] - 1.0f) * kaw[e]);
                be += pb[e] * tkk[e]; ka += pkt[e] * tkk[e]; bo += tr[e] * tkt[e] * rkc[e]; }
            if (i >= 0) {
                be = red16(be); ka = red16(ka); bo = red16(bo);
                const size_t o = (size_t)m * BW + c0; const bool first = (m & (SEQ - 1)) == 0;
                *(f32x4*)(SR + o) = (f32x4){tr[0], tr[1], tr[2], tr[3]}; *(f32x4*)(SW + o) = (f32x4){tw[0], tw[1], tw[2], tw[3]}; *(f32x4*)(SK + o) = (f32x4){tkt[0], tkt[1], tkt[2], tkt[3]};
                *(f32x4*)(SB + o) = (f32x4){tb[0], tb[1], tb[2], tb[3]}; *(f32x4*)(SV + o) = (f32x4){tv[0], tv[1], tv[2], tv[3]};
                if (!first) *(f32x4*)(SU + o - BW) = (f32x4){pw[0] * tkk[0], pw[1] * tkk[1], pw[2] * tkk[2], pw[3] * tkk[3]};
                if ((m & (SEQ - 1)) == SEQ - 1) *(f32x4*)(SU + o) = (f32x4){0.f, 0.f, 0.f, 0.f};
                if (cq < 2) BK[((size_t)m * 12 + h) * 2 + cq] = first ? 0.f : (cq == 0 ? be : ka);
                if (cq == 2) BON[(size_t)m * 12 + h] = bo;
            }
#pragma unroll
            for (int e = 0; e < 4; ++e) { prr[e] = xr[e]; prk[e] = xk[e]; prv[e] = xv[e]; pw[e] = tw[e]; pb[e] = tb[e]; pkt[e] = tkt[e]; }
        }
    }
}

typedef float f32x4c __attribute__((ext_vector_type(4)));
#define MFMA4(a, b, c) __builtin_amdgcn_mfma_f32_16x16x4f32((a), (b), (c), 0, 0, 0)
constexpr int CP_LD = 65, CP_ARR = 16 * CP_LD, CP_SM = 16 * 17;
constexpr int CP_WAVE_FLOATS = 4 * CP_ARR + 4 * CP_SM;
__device__ __forceinline__ void phase_chunkprep(const Ctx& C, const Args& a, int l, unsigned char* ws) {
    if (C.wave >= 6) return;
    const bf16* P1 = (const bf16*)(ws + WS_P1); const float* LO = (const float*)(ws + WS_LO);
    float* SV = (float*)(ws + WS_SV); float* BON = (float*)(ws + WS_BON); float* COP = (float*)(ws + WS_COP);
    const float* mu = a.in[5] + (size_t)l * BCOLS; const float* w0p = a.in[6] + (size_t)l * BW; const float* a0p = a.in[8] + (size_t)l * BW;
    const float* kkwp = a.in[11] + (size_t)l * BW; const float* kawp = a.in[12] + (size_t)l * BW; const float* rkp = a.in[13] + (size_t)l * BW;
    LAS float* L = (LAS float*)(C.lds + RING_OFF) + C.wave * CP_WAVE_FLOATS;
    LAS float* At = L; LAS float* Bt = L + CP_ARR; LAS float* Kt = L + 2 * CP_ARR; LAS float* Rt = L + 3 * CP_ARR;
    LAS float* Sa = L + 4 * CP_ARR; LAS float* Sb = Sa + CP_SM; LAS float* Sc = Sb + CP_SM; LAS float* Sd = Sc + CP_SM;
    const int lane = C.lane, li = lane & 15, q = lane >> 4;
    const int widx = C.bid * 6 + C.wave, nw = C.G * 6;
    for (int it = widx; it < 24 * 512; it += nw) {
        const int hs = it >> 9, c = it & 511, b = hs / 12, h = hs % 12, hc = h * 64 + lane; const int m0 = b * SEQ + c * 16;
        const float mur = mu[hc], muk = mu[BW + hc], muv = mu[2 * BW + hc], w0 = w0p[hc], a0 = a0p[hc], kkw = kkwp[hc], kaw = kawp[hc], rkc = rkp[hc];
        float rr[17], rk_[17], rv[17], lw[16], la[16];
#pragma unroll
        for (int j = 0; j < 17; ++j) { const bool ok = !((c == 0) && j == 0); const size_t row = ok ? (size_t)(m0 - 1 + j) : (size_t)m0; const bf16* pr = P1 + row * NP1 + hc;
            const float x0 = bf1(pr[C_R]), x1 = bf1(pr[C_K]), x2 = bf1(pr[C_V]); rr[j] = ok ? x0 : 0.f; rk_[j] = ok ? x1 : 0.f; rv[j] = ok ? x2 : 0.f;
            if (j >= 1) { lw[j - 1] = LO[row * NLORA + hc]; la[j - 1] = LO[row * NLORA + BW + hc]; } }
        float cum = 0.f;
#pragma unroll
        for (int i = 0; i < 16; ++i) {
            const float tr = rr[i + 1] + (rr[i] - rr[i + 1]) * mur, tk = rk_[i + 1] + (rk_[i] - rk_[i + 1]) * muk, tv = rv[i + 1] + (rv[i] - rv[i + 1]) * muv;
            const float xx = -(w0 + lw[i]); const float sp = fmaxf(xx, 0.f) + __logf(1.0f + __expf(-fabsf(xx)));
            const float lwv = -__expf(-sp - 0.5f);
            const float av = __builtin_amdgcn_rcpf(1.0f + __expf(-(a0 + la[i])));
            const float kkr = tk * kkw; const float kk = kkr * __builtin_amdgcn_rsqf(fmaxf(wsum(kkr * kkr, lane), 1e-24f));
            const float kt = tk * (1.0f + (av - 1.0f) * kaw), bb = kk * av;
            const float bo = wsum(tr * kt * rkc, lane);
            SV[(size_t)(m0 + i) * BW + hc] = tv; if (lane == 0) BON[(size_t)(m0 + i) * 12 + h] = bo;
            const float ex = __expf(cum); cum += lwv; const float ei = __expf(cum), eni = __expf(-cum);
            At[i * CP_LD + lane] = -kk * ex; Bt[i * CP_LD + lane] = bb * eni; Kt[i * CP_LD + lane] = kt * eni; Rt[i * CP_LD + lane] = tr * ei;
        }
        const float gam = __expf(cum);
        LDS_WAIT(); asm volatile("" ::: "memory");
        f32x4c gab = {0.f, 0.f, 0.f, 0.f}, gak = gab, grb = gab, grk = gab;
#pragma unroll
        for (int s_ = 0; s_ < 16; ++s_) { const int o = li * CP_LD + 4 * s_ + q; const float fa = At[o], fr = Rt[o], fb = Bt[o], fk = Kt[o];
            gab = MFMA4(fa, fb, gab); gak = MFMA4(fa, fk, gak); grb = MFMA4(fr, fb, grb); grk = MFMA4(fr, fk, grk); }
#pragma unroll
        for (int e = 0; e < 4; ++e) { const int i = 4 * q + e, j = li; if (!(j < i)) { gab[e] = 0.f; gak[e] = 0.f; } if (!(j <= i)) { grb[e] = 0.f; grk[e] = 0.f; }
            Sa[i * 17 + j] = gab[e]; Sb[i * 17 + j] = gak[e]; Sc[i * 17 + j] = grb[e]; }
        LDS_WAIT(); asm volatile("" ::: "memory");
        float tt[16];
#pragma unroll
        for (int i = 0; i < 16; ++i) { float acc = (i == li) ? 1.f : 0.f;
#pragma unroll
            for (int j = 0; j < i; ++j) acc += Sa[i * 17 + j] * tt[j];
            tt[i] = acc; }
        if (q == 0) {
#pragma unroll
            for (int i = 0; i < 16; ++i) Sd[i * 17 + li] = tt[i]; }
        LDS_WAIT(); asm volatile("" ::: "memory");
        float tf[4], mrbf[4];
#pragma unroll
        for (int s_ = 0; s_ < 4; ++s_) { tf[s_] = Sd[li * 17 + 4 * s_ + q]; mrbf[s_] = Sc[li * 17 + 4 * s_ + q]; }
        f32x4c w1[4], u0 = {0.f, 0.f, 0.f, 0.f};
#pragma unroll
        for (int n = 0; n < 4; ++n) { w1[n] = (f32x4c){0.f, 0.f, 0.f, 0.f};
#pragma unroll
            for (int s_ = 0; s_ < 4; ++s_) w1[n] = MFMA4(tf[s_], At[(4 * s_ + q) * CP_LD + 16 * n + li], w1[n]); }
#pragma unroll
        for (int s_ = 0; s_ < 4; ++s_) u0 = MFMA4(tf[s_], Sb[(4 * s_ + q) * 17 + li], u0);
        LDS_WAIT(); asm volatile("" ::: "memory");
#pragma unroll
        for (int n = 0; n < 4; ++n)
#pragma unroll
            for (int e = 0; e < 4; ++e) At[(4 * q + e) * CP_LD + 16 * n + li] = w1[n][e];
#pragma unroll
        for (int e = 0; e < 4; ++e) Sa[(4 * q + e) * 17 + li] = u0[e];
        LDS_WAIT(); asm volatile("" ::: "memory");
        f32x4c ry[4], y0 = grk;
#pragma unroll
        for (int n = 0; n < 4; ++n) {
#pragma unroll
            for (int e = 0; e < 4; ++e) ry[n][e] = Rt[(4 * q + e) * CP_LD + 16 * n + li];
#pragma unroll
            for (int s_ = 0; s_ < 4; ++s_) ry[n] = MFMA4(mrbf[s_], At[(4 * s_ + q) * CP_LD + 16 * n + li], ry[n]); }
#pragma unroll
        for (int s_ = 0; s_ < 4; ++s_) y0 = MFMA4(mrbf[s_], Sa[(4 * s_ + q) * 17 + li], y0);
        LDS_WAIT(); asm volatile("" ::: "memory");
#pragma unroll
        for (int n = 0; n < 4; ++n)
#pragma unroll
            for (int e = 0; e < 4; ++e) Rt[(4 * q + e) * CP_LD + 16 * n + li] = ry[n][e];
#pragma unroll
        for (int e = 0; e < 4; ++e) Sb[(4 * q + e) * 17 + li] = y0[e];
        LDS_WAIT(); asm volatile("" ::: "memory");
        float* rec = COP + ((size_t)hs * 512 + c) * COP_STRIDE;
#pragma unroll
        for (int m = 0; m < 4; ++m) { f32x4 x, y;
#pragma unroll
            for (int j = 0; j < 4; ++j) { x[j] = At[li * CP_LD + 16 * m + 4 * q + j]; y[j] = Rt[li * CP_LD + 16 * m + 4 * q + j]; }
            *(f32x4*)(rec + COP_W1 + lane * 16 + 4 * m) = x; *(f32x4*)(rec + COP_RY + lane * 16 + 4 * m) = y; }
#pragma unroll
        for (int m = 0; m < 4; ++m) { f32x4 x, y;
#pragma unroll
            for (int s_ = 0; s_ < 4; ++s_) { x[s_] = Bt[(4 * q + s_) * CP_LD + 16 * m + li]; y[s_] = Kt[(4 * q + s_) * CP_LD + 16 * m + li]; }
            const float gk = __builtin_bit_cast(float, __builtin_amdgcn_ds_bpermute((16 * m + li) << 2, __builtin_bit_cast(int, gam)));
            *(f32x4*)(rec + COP_BT + lane * 16 + 4 * m) = x * gk; *(f32x4*)(rec + COP_KT + lane * 16 + 4 * m) = y * gk; }
        { f32x4 x, y;
#pragma unroll
          for (int s_ = 0; s_ < 4; ++s_) { x[s_] = Sa[li * 17 + 4 * q + s_]; y[s_] = Sb[li * 17 + 4 * q + s_]; }
          *(f32x4*)(rec + COP_U0 + lane * 4) = x; *(f32x4*)(rec + COP_Y0 + lane * 4) = y; }
        rec[COP_GAM + lane] = gam;
        LDS_WAIT(); asm volatile("" ::: "memory");
    }
}

__device__ __forceinline__ void scan_block(const Ctx& C, int sb, unsigned char* ws) {
    const int b = sb / 24, h = (sb % 24) >> 1, half = sb & 1;
    const float* SR = (const float*)(ws + WS_SR); const float* SW = (const float*)(ws + WS_SW); const float* SK = (const float*)(ws + WS_SK); const float* SKK = (const float*)(ws + WS_SKK);
    const float* SB = (const float*)(ws + WS_SB); const float* SV = (const float*)(ws + WS_SV); float* YR = (float*)(ws + WS_YRAW);
    constexpr int T = 64;
    LAS float* Lr = (LAS float*)(C.lds + RING_OFF); LAS float* Lw = Lr + T * 64; LAS float* Lk = Lw + T * 64; LAS float* Lkk = Lk + T * 64; LAS float* Lb = Lkk + T * 64;
    LAS float* Lv = Lb + T * 64; LAS float* Ly = Lv + T * 32;
    const int tid = C.tid, rl = tid >> 4, kq = tid & 15;
    const size_t rowbase = (size_t)b * SEQ; const int colh = h * 64;
    const int lt0 = tid >> 4, lc0 = (tid & 15) * 4, vt = tid >> 3, vc = (tid & 7) * 4;
    f32x4 pr[2], pw[2], pk[2], pkk[2], pb[2], pv;
#define SCAN_LOAD(t0) do { _Pragma("unroll") for (int i = 0; i < 2; ++i) { const size_t o = (rowbase + (t0) + lt0 + 32 * i) * BW + colh + lc0; \
        pr[i] = *(const f32x4*)(SR + o); pw[i] = *(const f32x4*)(SW + o); pk[i] = *(const f32x4*)(SK + o); pkk[i] = *(const f32x4*)(SKK + o); pb[i] = *(const f32x4*)(SB + o); } \
        pv = *(const f32x4*)(SV + (rowbase + (t0) + vt) * BW + colh + 32 * half + vc); } while (0)
    SCAN_LOAD(0);
    float S0 = 0.f, S1 = 0.f, S2 = 0.f, S3 = 0.f;
    for (int ch = 0; ch < SEQ / T; ++ch) {
        const int t0 = ch * T;
#pragma unroll
        for (int i = 0; i < 2; ++i) { const int lo = (lt0 + 32 * i) * 64 + lc0;
            *(LAS f32x4*)(Lr + lo) = pr[i]; *(LAS f32x4*)(Lw + lo) = pw[i]; *(LAS f32x4*)(Lk + lo) = pk[i]; *(LAS f32x4*)(Lkk + lo) = pkk[i]; *(LAS f32x4*)(Lb + lo) = pb[i]; }
        *(LAS f32x4*)(Lv + vt * 32 + vc) = pv;
        __syncthreads();
        if (ch + 1 < SEQ / T) SCAN_LOAD(t0 + T);
#pragma unroll 4
        for (int t = 0; t < T; ++t) {
            const f32x4 kk4 = *(const LAS f32x4*)(Lkk + t * 64 + kq * 4), w4 = *(const LAS f32x4*)(Lw + t * 64 + kq * 4), b4 = *(const LAS f32x4*)(Lb + t * 64 + kq * 4);
            const f32x4 k4 = *(const LAS f32x4*)(Lk + t * 64 + kq * 4), r4 = *(const LAS f32x4*)(Lr + t * 64 + kq * 4); const float v = Lv[t * 32 + rl];
            float d = (S0 * kk4.x + S1 * kk4.y) + (S2 * kk4.z + S3 * kk4.w); d = red16(d); const float sa = -d;
            S0 = S0 * w4.x + (sa * b4.x + v * k4.x); S1 = S1 * w4.y + (sa * b4.y + v * k4.y); S2 = S2 * w4.z + (sa * b4.z + v * k4.z); S3 = S3 * w4.w + (sa * b4.w + v * k4.w);
            float y = (S0 * r4.x + S1 * r4.y) + (S2 * r4.z + S3 * r4.w); y = red16(y);
            if (kq == 0) Ly[t * 32 + rl] = y;
        }
        __syncthreads();
        *(f32x4*)(YR + (rowbase + t0 + vt) * BW + colh + 32 * half + vc) = *(const LAS f32x4*)(Ly + vt * 32 + vc);
    }
#undef SCAN_LOAD
}

__device__ __forceinline__ void glds16(const void* gsrc, unsigned lds_dst) { unsigned keep;
    asm volatile("s_mov_b32 %0, m0\n\ts_mov_b32 m0, %2\n\ts_nop 0\n\tglobal_load_lds_dwordx4 %1, off\n\ts_mov_b32 m0, %0" : "=&s"(keep) : "v"(gsrc), "s"(lds_dst) : "memory"); }
__device__ __forceinline__ void glds4(const void* gsrc, unsigned lds_dst) { unsigned keep;
    asm volatile("s_mov_b32 %0, m0\n\ts_mov_b32 m0, %2\n\ts_nop 0\n\tglobal_load_lds_dword %1, off\n\ts_mov_b32 m0, %0" : "=&s"(keep) : "v"(gsrc), "s"(lds_dst) : "memory"); }
constexpr int SCAN_T = 8, SCAN_SLOT = 5 * SCAN_T * 256 + 512, SCAN_NSLOT = 3, SCAN_RING = SCAN_NSLOT * SCAN_SLOT;
typedef float f32x2 __attribute__((ext_vector_type(2)));
__device__ __forceinline__ void scan_wave(int lane, LAS unsigned char* ring, int hs, int r0, unsigned char* ws) {
    const int b = hs / 12, h = hs % 12;
    const float* SR = (const float*)(ws + WS_SR); const float* SW = (const float*)(ws + WS_SW); const float* SK = (const float*)(ws + WS_SK); const float* SU = (const float*)(ws + WS_SKK);
    const float* SB = (const float*)(ws + WS_SB); const float* SV = (const float*)(ws + WS_SV); const float* BK = (const float*)(ws + WS_BK); float* YR = (float*)(ws + WS_YRAW);
    const int rg = lane >> 4, kq = lane & 15;
    const size_t rowbase = (size_t)b * SEQ; const int colh = h * 64;
    const unsigned ring0 = (unsigned)(size_t)ring;
    const size_t voff = ((size_t)(lane >> 4)) * BW + colh + 4 * kq;
    const size_t vvoff = ((size_t)((lane & 31) >> 2)) * BW + colh + r0 + (lane & 3);
    const size_t bkoff = ((size_t)((lane & 15) >> 1) * 12 + h) * 2 + (lane & 1);
    constexpr int NCH = SEQ / SCAN_T;
#define SCAN_DMA(ch, slot) do { const int cc_ = (ch) < NCH ? (ch) : NCH - 1; const size_t tok_ = rowbase + (size_t)cc_ * SCAN_T; const unsigned sl_ = ring0 + (unsigned)(slot) * SCAN_SLOT; \
        _Pragma("unroll") for (int i_ = 0; i_ < 2; ++i_) { const size_t o_ = (tok_ + 4 * i_) * BW + voff; \
            glds16(SU + o_, sl_ + 0 * 2048 + i_ * 1024); glds16(SW + o_, sl_ + 1 * 2048 + i_ * 1024); glds16(SB + o_, sl_ + 2 * 2048 + i_ * 1024); glds16(SK + o_, sl_ + 3 * 2048 + i_ * 1024); glds16(SR + o_, sl_ + 4 * 2048 + i_ * 1024); } \
        glds4(SV + tok_ * BW + vvoff, sl_ + 10240); glds4(BK + tok_ * 24 + bkoff, sl_ + 10496); } while (0)
    SCAN_DMA(0, 0); SCAN_DMA(1, 1); SCAN_DMA(2, 2);
    f32x2 S01 = (f32x2){0.f, 0.f}, S23 = (f32x2){0.f, 0.f};
    float e_cur = 0.f, sa_prev = 0.f, v_prev = 0.f;
    int slot = 0;
    for (int ch = 0; ch < NCH; ++ch) {
        asm volatile("s_waitcnt vmcnt(24)" ::: "memory");
        const LAS unsigned char* sp = ring + slot * SCAN_SLOT;
        float ykeep = 0.f;
        f32x4 u4a[SCAN_T], w4a[SCAN_T], b4a[SCAN_T], k4a[SCAN_T], r4a[SCAN_T]; float va[SCAN_T]; f32x2 bka[SCAN_T];
#pragma unroll
        for (int tt = 0; tt < SCAN_T; ++tt) {
            u4a[tt] = *(const LAS f32x4*)(sp + 0 * 2048 + tt * 256 + kq * 16); bka[tt] = *(const LAS f32x2*)(sp + 10496 + tt * 8); va[tt] = *(const LAS float*)(sp + 10240 + tt * 16 + rg * 4);
            w4a[tt] = *(const LAS f32x4*)(sp + 1 * 2048 + tt * 256 + kq * 16); b4a[tt] = *(const LAS f32x4*)(sp + 2 * 2048 + tt * 256 + kq * 16);
            k4a[tt] = *(const LAS f32x4*)(sp + 3 * 2048 + tt * 256 + kq * 16); r4a[tt] = *(const LAS f32x4*)(sp + 4 * 2048 + tt * 256 + kq * 16); }
#pragma unroll
        for (int tt = 0; tt < SCAN_T; ++tt) {
            const f32x4 u4 = u4a[tt], w4 = w4a[tt], b4 = b4a[tt], k4 = k4a[tt], r4 = r4a[tt]; const float v = va[tt]; const f32x2 bk = bka[tt];
            f32x2 pe = S01 * (f32x2){u4.x, u4.y}; pe = S23 * (f32x2){u4.z, u4.w} + pe; const float e_next = red16(pe.x + pe.y);
            const float d = e_cur + sa_prev * bk.x + v_prev * bk.y; const float sa = -d;
            const f32x2 sav = (f32x2){sa, sa}, vv = (f32x2){v, v};
            S01 = S01 * (f32x2){w4.x, w4.y} + (sav * (f32x2){b4.x, b4.y} + vv * (f32x2){k4.x, k4.y});
            S23 = S23 * (f32x2){w4.z, w4.w} + (sav * (f32x2){b4.z, b4.w} + vv * (f32x2){k4.z, k4.w});
            f32x2 py = S01 * (f32x2){r4.x, r4.y}; py = S23 * (f32x2){r4.z, r4.w} + py; const float y = red16(py.x + py.y);
            ykeep = (kq == tt) ? y : ykeep;
            e_cur = e_next; sa_prev = sa; v_prev = v;
        }
        if (kq < SCAN_T) YR[(rowbase + (size_t)ch * SCAN_T + kq) * BW + colh + r0 + rg] = ykeep;
        SCAN_DMA(ch + 3, slot);
        slot = (slot == SCAN_NSLOT - 1) ? 0 : slot + 1;
    }
    asm volatile("s_waitcnt vmcnt(0)" ::: "memory");
#undef SCAN_DMA
}

constexpr int SH_T = 8, SH_SLOT = 10240 + 1024 + 256, SH_NSLOT = 11, SH_D = 4, SH_FLAGS = SCANRING_OFF + SH_NSLOT * SH_SLOT;
static_assert(SH_FLAGS + 64 <= LDSCTL_OFF, "scan ring + flags fit below the LDS control words");
__device__ __forceinline__ unsigned lds_ld(volatile LAS unsigned* p) { return *p; }
__device__ __forceinline__ void scan_loader(int lane, LAS unsigned char* lds, int hs, int rblk, unsigned char* ws) {
    const int b = hs / 12, h = hs % 12;
    const float* SR = (const float*)(ws + WS_SR); const float* SW = (const float*)(ws + WS_SW); const float* SK = (const float*)(ws + WS_SK); const float* SU = (const float*)(ws + WS_SKK);
    const float* SB = (const float*)(ws + WS_SB); const float* SV = (const float*)(ws + WS_SV); const float* BK = (const float*)(ws + WS_BK);
    const size_t rowbase = (size_t)b * SEQ; const int colh = h * 64;
    const unsigned ring0 = (unsigned)(size_t)(lds + SCANRING_OFF);
    volatile LAS unsigned* flags = (volatile LAS unsigned*)(lds + SH_FLAGS);
    const size_t voff = ((size_t)(lane >> 4)) * BW + colh + 4 * (lane & 15);
    const size_t vvoff = ((size_t)((lane >> 2) & 7)) * BW + colh + rblk + 4 * (lane & 3);
    const size_t bkoff = ((size_t)((lane & 15) >> 1) * 12 + h) * 2 + (lane & 1);
    constexpr int NCH = SEQ / SH_T;
    int slot = 0;
    for (int c = 0; c < NCH; ++c) {
        if (c >= SH_NSLOT) { const unsigned need = (unsigned)(c - SH_NSLOT + 1);
            while (lds_ld(flags + 1) < need || lds_ld(flags + 2) < need || lds_ld(flags + 3) < need || lds_ld(flags + 4) < need) __builtin_amdgcn_s_sleep(1); }
        const size_t tok = rowbase + (size_t)c * SH_T; const unsigned sl = ring0 + (unsigned)slot * SH_SLOT;
#pragma unroll
        for (int i = 0; i < 2; ++i) { const size_t o = (tok + 4 * i) * BW + voff;
            glds16(SU + o, sl + 0 * 2048 + i * 1024); glds16(SW + o, sl + 1 * 2048 + i * 1024); glds16(SB + o, sl + 2 * 2048 + i * 1024); glds16(SK + o, sl + 3 * 2048 + i * 1024); glds16(SR + o, sl + 4 * 2048 + i * 1024); }
        glds16(SV + tok * BW + vvoff, sl + 10240); glds4(BK + tok * 24 + bkoff, sl + 11264);
        if (c >= SH_D) { asm volatile("s_waitcnt vmcnt(48)" ::: "memory"); if (lane == 0) flags[0] = (unsigned)(c - SH_D + 1); }
        slot = (slot == SH_NSLOT - 1) ? 0 : slot + 1;
    }
    asm volatile("s_waitcnt vmcnt(0)" ::: "memory"); if (lane == 0) flags[0] = (unsigned)NCH;
}
__device__ __forceinline__ void scan_wave_sh(int lane, int w, LAS unsigned char* lds, int hs, int rblk, unsigned char* ws) {
    const int b = hs / 12, h = hs % 12; float* YR = (float*)(ws + WS_YRAW);
    const int rg = lane >> 4, kq = lane & 15, r0 = rblk + 4 * w;
    const size_t rowbase = (size_t)b * SEQ; const int colh = h * 64;
    volatile LAS unsigned* flags = (volatile LAS unsigned*)(lds + SH_FLAGS);
    constexpr int NCH = SEQ / SH_T;
    f32x2 S01 = (f32x2){0.f, 0.f}, S23 = (f32x2){0.f, 0.f};
    float e_cur = 0.f, sa_prev = 0.f, v_prev = 0.f;
    int slot = 0;
    for (int ch = 0; ch < NCH; ++ch) {
        while (lds_ld(flags) <= (unsigned)ch) __builtin_amdgcn_s_sleep(1);
        asm volatile("" ::: "memory");
        const LAS unsigned char* sp = lds + SCANRING_OFF + slot * SH_SLOT;
        float ykeep = 0.f;
        f32x4 u4a[SH_T], w4a[SH_T], b4a[SH_T], k4a[SH_T], r4a[SH_T]; float va[SH_T]; f32x2 bka[SH_T];
#pragma unroll
        for (int tt = 0; tt < SH_T; ++tt) {
            u4a[tt] = *(const LAS f32x4*)(sp + 0 * 2048 + tt * 256 + kq * 16); bka[tt] = *(const LAS f32x2*)(sp + 11264 + tt * 8); va[tt] = *(const LAS float*)(sp + 10240 + tt * 64 + (w * 4 + rg) * 4);
            w4a[tt] = *(const LAS f32x4*)(sp + 1 * 2048 + tt * 256 + kq * 16); b4a[tt] = *(const LAS f32x4*)(sp + 2 * 2048 + tt * 256 + kq * 16);
            k4a[tt] = *(const LAS f32x4*)(sp + 3 * 2048 + tt * 256 + kq * 16); r4a[tt] = *(const LAS f32x4*)(sp + 4 * 2048 + tt * 256 + kq * 16); }
#pragma unroll
        for (int tt = 0; tt < SH_T; ++tt) {
            const f32x4 u4 = u4a[tt], w4 = w4a[tt], b4 = b4a[tt], k4 = k4a[tt], r4 = r4a[tt]; const float v = va[tt]; const f32x2 bk = bka[tt];
            f32x2 pe = S01 * (f32x2){u4.x, u4.y}; pe = S23 * (f32x2){u4.z, u4.w} + pe; const float e_next = red16(pe.x + pe.y);
            const float d = e_cur + sa_prev * bk.x + v_prev * bk.y; const float sa = -d;
            const f32x2 sav = (f32x2){sa, sa}, vv = (f32x2){v, v};
            S01 = S01 * (f32x2){w4.x, w4.y} + (sav * (f32x2){b4.x, b4.y} + vv * (f32x2){k4.x, k4.y});
            S23 = S23 * (f32x2){w4.z, w4.w} + (sav * (f32x2){b4.z, b4.w} + vv * (f32x2){k4.z, k4.w});
            f32x2 py = S01 * (f32x2){r4.x, r4.y}; py = S23 * (f32x2){r4.z, r4.w} + py; const float y = red16(py.x + py.y);
            ykeep = (kq == tt) ? y : ykeep;
            e_cur = e_next; sa_prev = sa; v_prev = v;
        }
        if (kq < SH_T) YR[(rowbase + (size_t)ch * SH_T + kq) * BW + colh + r0 + rg] = ykeep;
        asm volatile("" ::: "memory");
        if (lane == 0) flags[1 + w] = (unsigned)(ch + 1);
        slot = (slot == SH_NSLOT - 1) ? 0 : slot + 1;
    }
}

constexpr int CH_REC = COP_RY * 4;
constexpr int CH_SLOT = CH_REC + 4096, CH_NSLOT = 7, CH_D = 2, CH_FLAGS = SCANRING_OFF + CH_NSLOT * CH_SLOT;
static_assert(CH_FLAGS + 64 <= LDSCTL_OFF, "chain ring + flags fit below the LDS control words");
__device__ __forceinline__ float* sst_base(unsigned char* ws, int hs) { return (float*)(ws + (hs < 16 ? WS_SST_A + (size_t)hs * 8 * MiB : WS_SST_B + (size_t)(hs - 16) * 8 * MiB)); }
__device__ __forceinline__ void chain_loader(int lane, int which, LAS unsigned char* lds, int hs, unsigned char* ws) {
    const int b = hs / 12, h = hs % 12;
    const float* COP = (const float*)(ws + WS_COP) + (size_t)hs * 512 * COP_STRIDE; const float* SV = (const float*)(ws + WS_SV);
    const unsigned ring0 = (unsigned)(size_t)(lds + SCANRING_OFF);
    volatile LAS unsigned* flags = (volatile LAS unsigned*)(lds + CH_FLAGS);
    const size_t vsrc = ((size_t)b * SEQ + (lane >> 4)) * BW + h * 64 + 4 * (lane & 15);
    int slot = 0;
    for (int c = 0; c < 512; ++c) {
        if (c >= CH_NSLOT) { const unsigned need = (unsigned)(c - CH_NSLOT + 1);
            while (lds_ld(flags + 1) < need || lds_ld(flags + 2) < need || lds_ld(flags + 3) < need || lds_ld(flags + 4) < need) __builtin_amdgcn_s_sleep(1); }
        const float* rec = COP + (size_t)c * COP_STRIDE; const unsigned sl = ring0 + (unsigned)slot * CH_SLOT;
        if (which == 0) {
#pragma unroll
            for (int i = 0; i < 9; ++i) glds16(rec + i * 256 + lane * 4, sl + i * 1024);
        } else {
#pragma unroll
            for (int i = 9; i < 13; ++i) glds16(rec + i * 256 + lane * 4, sl + i * 1024);
            glds4(rec + COP_GAM + lane, sl + 13 * 1024);
#pragma unroll
            for (int i = 0; i < 4; ++i) glds16(SV + vsrc + (size_t)(c * 16 + 4 * i) * BW, sl + CH_REC + i * 1024);
        }
        if (c >= CH_D) { asm volatile("s_waitcnt vmcnt(18)" ::: "memory"); if (lane == 0) flags[which ? 5 : 0] = (unsigned)(c - CH_D + 1); }
        slot = (slot == CH_NSLOT - 1) ? 0 : slot + 1;
    }
    asm volatile("s_waitcnt vmcnt(0)" ::: "memory"); if (lane == 0) flags[which ? 5 : 0] = 512u;
}
__device__ __forceinline__ void scan_chain(int lane, int vs, LAS unsigned char* lds, int hs, unsigned char* ws) {
    const int li = lane & 15, q = lane >> 4;
    volatile LAS unsigned* flags = (volatile LAS unsigned*)(lds + CH_FLAGS);
    f32x4c St[4];
#pragma unroll
    for (int m = 0; m < 4; ++m) St[m] = (f32x4c){0.f, 0.f, 0.f, 0.f};
    float* sst = sst_base(ws, hs) + ((size_t)vs * 64 + lane) * 16;
    int slot = 0;
    for (int c = 0; c < 512; ++c) {
        while (lds_ld(flags) <= (unsigned)c || lds_ld(flags + 5) <= (unsigned)c) __builtin_amdgcn_s_sleep(1);
        asm volatile("" ::: "memory");
        const LAS float* sp = (const LAS float*)(lds + SCANRING_OFF + slot * CH_SLOT);
        f32x4 w1f[4], btf[4], ktf[4], gf[4]; float vc[4];
#pragma unroll
        for (int m = 0; m < 4; ++m) { w1f[m] = *(const LAS f32x4*)(sp + COP_W1 + lane * 16 + 4 * m);
            btf[m] = *(const LAS f32x4*)(sp + COP_BT + lane * 16 + 4 * m); ktf[m] = *(const LAS f32x4*)(sp + COP_KT + lane * 16 + 4 * m); gf[m] = *(const LAS f32x4*)(sp + COP_GAM + 16 * m + 4 * q); }
        const f32x4 u0f = *(const LAS f32x4*)(sp + COP_U0 + lane * 4);
#pragma unroll
        for (int s_ = 0; s_ < 4; ++s_) vc[s_] = sp[COP_RY + (4 * q + s_) * 64 + 16 * vs + li];
        f32x4c z0 = {0.f, 0.f, 0.f, 0.f}, z1 = {0.f, 0.f, 0.f, 0.f};
#pragma unroll
        for (int m = 0; m < 4; ++m) { z0 = MFMA4(w1f[m][0], St[m][0], z0); z1 = MFMA4(w1f[m][1], St[m][1], z1); z0 = MFMA4(w1f[m][2], St[m][2], z0); z1 = MFMA4(w1f[m][3], St[m][3], z1); }
        z0 = MFMA4(u0f[0], vc[0], z0); z1 = MFMA4(u0f[1], vc[1], z1); z0 = MFMA4(u0f[2], vc[2], z0); z1 = MFMA4(u0f[3], vc[3], z1);
#pragma unroll
        for (int m = 0; m < 4; ++m) *(f32x4*)(sst + (size_t)c * 4096 + 4 * m) = St[m];
#pragma unroll
        for (int m = 0; m < 4; ++m) St[m] *= gf[m];
        const f32x4c z = z0 + z1;
#pragma unroll
        for (int s_ = 0; s_ < 4; ++s_)
#pragma unroll
            for (int m = 0; m < 4; ++m) St[m] = MFMA4(btf[m][s_], z[s_], St[m]);
#pragma unroll
        for (int s_ = 0; s_ < 4; ++s_)
#pragma unroll
            for (int m = 0; m < 4; ++m) St[m] = MFMA4(ktf[m][s_], vc[s_], St[m]);
        asm volatile("" ::: "memory");
        if (lane == 0) flags[1 + vs] = (unsigned)(c + 1);
        slot = (slot == CH_NSLOT - 1) ? 0 : slot + 1;
    }
}

struct AttnPass { int qcol; int bias_head; int tbl; float sink; int use_sink; int maxsteps; bf16* out; int out_ld; int out_col; float* lse; };
__device__ __forceinline__ void attn_stage_kv(const Ctx& C, const bf16* P1, int b, int res, int dil, int fblk, int kcol, int vcol) {
    LAS unsigned char* Ks = C.lds + RING_OFF; LAS unsigned char* Vs = Ks + 256 * 144;
#pragma unroll
    for (int i = 0; i < 4; ++i) { const int c = C.tid + 512 * i, row = c >> 3, part = c & 7; const int fp = (fblk - 1) * 128 + row;
        v4u kv = (v4u){0u, 0u, 0u, 0u}, vv = (v4u){0u, 0u, 0u, 0u};
        if (fp >= 0) { const bf16* src = P1 + ((size_t)b * SEQ + (size_t)fp * dil + res) * NP1; kv = *(const v4u*)(src + kcol + part * 8); vv = *(const v4u*)(src + vcol + part * 8); }
        *(LAS v4u*)(Ks + row * 144 + part * 16) = kv; *(LAS v4u*)(Vs + row * 144 + part * 16) = vv; }
}
__device__ __forceinline__ void attn_pass(const Ctx& C, const bf16* P1, const float* relb, int b, int res, int dil, int fblk, const AttnPass& ap) {
    LAS unsigned char* Ks = C.lds + RING_OFF; LAS unsigned char* Vs = Ks + 256 * 144; LAS float* lut = (LAS float*)(Vs + 256 * 144);
    __syncthreads();
    if (C.tid < 132) lut[C.tid] = (C.tid <= 128) ? relb[(int)T5B[ap.tbl][C.tid] * 20 + ap.bias_head] : 0.f;
    __syncthreads();
    const int i = C.tid >> 2, dq = C.tid & 3;
    const size_t tok = (size_t)b * SEQ + (size_t)(fblk * 128 + i) * dil + res;
    float q[16];
    { const bf16* qp = P1 + tok * NP1 + ap.qcol + dq * 16; const v4u a0 = *(const v4u*)qp, a1 = *(const v4u*)(qp + 8);
      q[0] = bflo(a0.x); q[1] = bfhi(a0.x); q[2] = bflo(a0.y); q[3] = bfhi(a0.y); q[4] = bflo(a0.z); q[5] = bfhi(a0.z); q[6] = bflo(a0.w); q[7] = bfhi(a0.w);
      q[8] = bflo(a1.x); q[9] = bfhi(a1.x); q[10] = bflo(a1.y); q[11] = bfhi(a1.y); q[12] = bflo(a1.z); q[13] = bfhi(a1.z); q[14] = bflo(a1.w); q[15] = bfhi(a1.w);
#pragma unroll
      for (int j = 0; j < 16; ++j) q[j] *= 0.125f; }
    float mrun = ap.use_sink ? ap.sink : -INFINITY, lrun = ap.use_sink ? 1.0f : 0.0f;
    float o[16];
#pragma unroll
    for (int j = 0; j < 16; ++j) o[j] = 0.f;
    const int fq0 = fblk * 128 + i;
    for (int dist = 0; dist <= ap.maxsteps; ++dist) {
        const int kr = i + 128 - dist;
        const bool valid = (fq0 - dist) >= 0;
        const v4u k0 = *(const LAS v4u*)(Ks + kr * 144 + dq * 32), k1 = *(const LAS v4u*)(Ks + kr * 144 + dq * 32 + 16);
        float s = q[0] * bflo(k0.x) + q[1] * bfhi(k0.x) + q[2] * bflo(k0.y) + q[3] * bfhi(k0.y) + q[4] * bflo(k0.z) + q[5] * bfhi(k0.z) + q[6] * bflo(k0.w) + q[7] * bfhi(k0.w)
                + q[8] * bflo(k1.x) + q[9] * bfhi(k1.x) + q[10] * bflo(k1.y) + q[11] * bfhi(k1.y) + q[12] * bflo(k1.z) + q[13] * bfhi(k1.z) + q[14] * bflo(k1.w) + q[15] * bfhi(k1.w);
        s = red4(s) + lut[dist];
        if (valid) {
            if (s > mrun) { const float c = __expf(mrun - s); lrun *= c;
#pragma unroll
                for (int j = 0; j < 16; ++j) o[j] *= c;
                mrun = s; }
            const float p = __expf(s - mrun); lrun += p;
            const v4u v0 = *(const LAS v4u*)(Vs + kr * 144 + dq * 32), v1 = *(const LAS v4u*)(Vs + kr * 144 + dq * 32 + 16);
            o[0] += p * bflo(v0.x); o[1] += p * bfhi(v0.x); o[2] += p * bflo(v0.y); o[3] += p * bfhi(v0.y); o[4] += p * bflo(v0.z); o[5] += p * bfhi(v0.z); o[6] += p * bflo(v0.w); o[7] += p * bfhi(v0.w);
            o[8] += p * bflo(v1.x); o[9] += p * bfhi(v1.x); o[10] += p * bflo(v1.y); o[11] += p * bfhi(v1.y); o[12] += p * bflo(v1.z); o[13] += p * bfhi(v1.z); o[14] += p * bflo(v1.w); o[15] += p * bfhi(v1.w);
        }
    }
    const float inv = 1.0f / lrun;
    v4u w0, w1;
    w0.x = pk2(o[0] * inv, o[1] * inv); w0.y = pk2(o[2] * inv, o[3] * inv); w0.z = pk2(o[4] * inv, o[5] * inv); w0.w = pk2(o[6] * inv, o[7] * inv);
    w1.x = pk2(o[8] * inv, o[9] * inv); w1.y = pk2(o[10] * inv, o[11] * inv); w1.z = pk2(o[12] * inv, o[13] * inv); w1.w = pk2(o[14] * inv, o[15] * inv);
    bf16* op = ap.out + tok * ap.out_ld + ap.out_col + dq * 16;
    *(v4u*)op = w0; *(v4u*)(op + 8) = w1;
    if (ap.lse && dq == 0) ap.lse[tok * 4] = mrun + __logf(lrun);
}
__device__ __forceinline__ void phase_attn(const Ctx& C, const Args& a, int l, unsigned char* ws, int ab, int nab) {
    const bf16* P1 = (const bf16*)(ws + WS_P1); const float* relb = a.in[1]; const float* sinks = a.in[4] + l * 8;
    bf16* YA = (bf16*)(ws + WS_YA); bf16* OC = (bf16*)(ws + WS_OC); float* LSE = (float*)(ws + WS_LSE);
    constexpr int NA = 256, NC = 1536;
    for (int it = ab; it < NA + NC; it += nab) {
        __syncthreads();
        if (it < NA) {
            const int b = it >> 7, fblk = (it >> 1) & 63, hkv = it & 1;
            attn_stage_kv(C, P1, b, 0, 1, fblk, C_AK + hkv * 64, C_AV + hkv * 64);
            for (int g = 0; g < 4; ++g) { const int hq = hkv * 4 + g;
                AttnPass ap; ap.qcol = C_AQ + hq * 64; ap.bias_head = hq; ap.tbl = 0; ap.sink = sinks[hq]; ap.use_sink = 1; ap.maxsteps = 127; ap.out = YA; ap.out_ld = 512; ap.out_col = hq * 64; ap.lse = nullptr;
                attn_pass(C, P1, relb, b, 0, 1, fblk, ap); }
        } else {
            const int ci = it - NA; const int gi = ci / 512, j = (ci >> 7) & 3, qb = ci & 127;
            const int dil = (gi == 0) ? 1 : (gi == 1 ? 4 : 16); const int bps = 64 / dil;
            const int n = qb / bps, fblk = qb % bps, b = n / dil, res = n % dil; const int hc = gi * 4 + j;
            attn_stage_kv(C, P1, b, res, dil, fblk, C_CK + hc * 64, C_CV + hc * 64);
            AttnPass ap; ap.qcol = C_CQ + hc * 64; ap.bias_head = 8 + hc; ap.tbl = gi; ap.sink = 0.f; ap.use_sink = 0; ap.maxsteps = 128; ap.out = OC + (size_t)gi * M * 256; ap.out_ld = 256; ap.out_col = j * 64;
            ap.lse = LSE + (size_t)gi * M * 4 + j;
            attn_pass(C, P1, relb, b, res, dil, fblk, ap);
        }
    }
}

__device__ __forceinline__ void phase_vt(const Ctx& C, unsigned char* ws) {
    const bf16* P1 = (const bf16*)(ws + WS_P1); bf16* VT = (bf16*)(ws + WS_VT);
    for (int it = C.gw; it < 14 * 2 * 128; it += C.ngw) {
        const int hs = it / 256, b = (it >> 7) & 1, blk = it & 127;
        const int gi = hs < 2 ? 0 : (hs - 2) >> 2; const int dil = gi == 0 ? 1 : (gi == 1 ? 4 : 16); const int Lf = SEQ / dil;
        const int vcol = hs < 2 ? C_AV + hs * 64 : C_CV + (hs - 2) * 64;
        const int ft = blk * 64 + C.lane;
        const int res = ft / Lf, tp = ft % Lf; const int tok = b * SEQ + tp * dil + res;
        const v4u* src = (const v4u*)(P1 + (size_t)tok * NP1 + vcol);
        v4u x[8];
#pragma unroll
        for (int i = 0; i < 8; ++i) x[i] = src[i];
        bf16* dst = VT + ((size_t)(hs * 2 + b) * 64) * SEQ + ft;
#pragma unroll
        for (int i = 0; i < 8; ++i) {
            dst[(size_t)(8 * i + 0) * SEQ] = (bf16)(x[i].x & 0xffffu); dst[(size_t)(8 * i + 1) * SEQ] = (bf16)(x[i].x >> 16);
            dst[(size_t)(8 * i + 2) * SEQ] = (bf16)(x[i].y & 0xffffu); dst[(size_t)(8 * i + 3) * SEQ] = (bf16)(x[i].y >> 16);
            dst[(size_t)(8 * i + 4) * SEQ] = (bf16)(x[i].z & 0xffffu); dst[(size_t)(8 * i + 5) * SEQ] = (bf16)(x[i].z >> 16);
            dst[(size_t)(8 * i + 6) * SEQ] = (bf16)(x[i].w & 0xffffu); dst[(size_t)(8 * i + 7) * SEQ] = (bf16)(x[i].w >> 16);
        }
    }
}

typedef float f32x16 __attribute__((ext_vector_type(16)));
__device__ __forceinline__ void attn_wave_item(int lane, const LAS float* lutall, int item, const float* sinks, unsigned char* ws) {
    const bf16* P1 = (const bf16*)(ws + WS_P1); const bf16* VT = (const bf16*)(ws + WS_VT);
    const int hh = item % 20, g32 = item / 20;
    const bool isA = hh < 8; const int hc = hh - 8; const int gi = isA ? 0 : hc >> 2, j = hc & 3;
    const int dil = gi == 0 ? 1 : (gi == 1 ? 4 : 16); const int Lf = SEQ / dil, gps = Lf / 32;
    const int b = g32 >> 8, rr = g32 & 255, res = rr / gps, qg = rr % gps, fq0 = qg * 32;
    const int qcol = isA ? C_AQ + hh * 64 : C_CQ + hc * 64, kcol = isA ? C_AK + (hh >> 2) * 64 : C_CK + hc * 64;
    const int hs = isA ? (hh >> 2) : 2 + hc;
    const int r = lane & 31, hf = lane >> 5;
    const LAS float* lut = lutall + hh * 192 + (31 - r + 8 * hf);
    const int pr = (r & 0x13) | ((r & 8) >> 1) | ((r & 4) << 1);
    const size_t tokq = (size_t)b * SEQ + (size_t)(fq0 + r) * dil + res;
    pg8::bf16x8 qf[4];
    { const bf16* qrow = P1 + tokq * NP1 + qcol + 8 * hf;
#pragma unroll
      for (int s_ = 0; s_ < 4; ++s_) qf[s_] = *(const pg8::bf16x8*)(qrow + 16 * s_); }
    f32x16 sc[5];
#pragma unroll
    for (int kt = 0; kt < 5; ++kt) {
        int fk = fq0 - 128 + 32 * kt + pr; fk = fk < 0 ? 0 : fk;
        const bf16* krow = P1 + ((size_t)b * SEQ + (size_t)fk * dil + res) * NP1 + kcol + 8 * hf;
        f32x16 acc;
#pragma unroll
        for (int q = 0; q < 16; ++q) acc[q] = 0.f;
#pragma unroll
        for (int s_ = 0; s_ < 4; ++s_) { const pg8::bf16x8 a = *(const pg8::bf16x8*)(krow + 16 * s_); acc = __builtin_amdgcn_mfma_f32_32x32x16_bf16(a, qf[s_], acc, 0, 0, 0); }
        sc[kt] = acc;
    }
    float mx = -1e30f;
#pragma unroll
    for (int kt = 0; kt < 5; ++kt)
#pragma unroll
        for (int q = 0; q < 16; ++q) { const int koff = (q & 3) + 4 * ((q >> 2) & 1) + 16 * (q >> 3);
            const float sv = sc[kt][q] * 0.125f + lut[32 * kt + koff]; sc[kt][q] = sv; }
    if (fq0 < 128) {
#pragma unroll
        for (int kt = 0; kt < 5; ++kt)
#pragma unroll
            for (int q = 0; q < 16; ++q) { const int koff = (q & 3) + 4 * ((q >> 2) & 1) + 16 * (q >> 3) + 8 * hf; if (fq0 - 128 + 32 * kt + koff < 0) sc[kt][q] = -1e30f; }
    }
#pragma unroll
    for (int kt = 0; kt < 5; ++kt)
#pragma unroll
        for (int q = 0; q < 16; ++q) mx = fmaxf(mx, sc[kt][q]);
    mx = fmaxf(mx, shx(mx, 32, lane));
    const float sink = isA ? sinks[hh] : -1e30f;
    mx = fmaxf(mx, sink);
    float lsum = 0.f;
#pragma unroll
    for (int kt = 0; kt < 5; ++kt)
#pragma unroll
        for (int q = 0; q < 16; ++q) { const float pv = __expf(sc[kt][q] - mx); sc[kt][q] = pv; lsum += pv; }
    lsum += shx(lsum, 32, lane);
    const float denom = isA ? lsum + __expf(sink - mx) : lsum;
    const float inv = 1.0f / denom;
    pg8::bf16x8 pf[5][2];
#pragma unroll
    for (int kt = 0; kt < 5; ++kt)
#pragma unroll
        for (int s_ = 0; s_ < 2; ++s_) { pg8::u32x4 w;
            w.x = pg8::cvt_pk_bf16(sc[kt][8 * s_ + 0], sc[kt][8 * s_ + 1]); w.y = pg8::cvt_pk_bf16(sc[kt][8 * s_ + 2], sc[kt][8 * s_ + 3]);
            w.z = pg8::cvt_pk_bf16(sc[kt][8 * s_ + 4], sc[kt][8 * s_ + 5]); w.w = pg8::cvt_pk_bf16(sc[kt][8 * s_ + 6], sc[kt][8 * s_ + 7]);
            pf[kt][s_] = __builtin_bit_cast(pg8::bf16x8, w); }
    bf16* outp; int out_ld, ocol;
    if (isA) { outp = (bf16*)(ws + WS_YA); out_ld = 1536; ocol = hh * 64; } else { outp = (bf16*)(ws + WS_OC) + (size_t)gi * M * 256; out_ld = 256; ocol = j * 64; }
    const bf16* vth = VT + ((size_t)(hs * 2 + b) * 64) * SEQ + (size_t)res * Lf;
#pragma unroll
    for (int dt = 0; dt < 2; ++dt) {
        const bf16* vrow = vth + (size_t)(32 * dt + r) * SEQ;
        f32x16 acc;
#pragma unroll
        for (int q = 0; q < 16; ++q) acc[q] = 0.f;
#pragma unroll
        for (int kt = 0; kt < 5; ++kt)
#pragma unroll
            for (int s_ = 0; s_ < 2; ++s_) {
                int k0 = fq0 - 128 + 32 * kt + 16 * s_ + 8 * hf; k0 = k0 < 0 ? 0 : k0;
                acc = __builtin_amdgcn_mfma_f32_32x32x16_bf16(*(const pg8::bf16x8*)(vrow + k0), pf[kt][s_], acc, 0, 0, 0);
            }
        bf16* op = outp + tokq * out_ld + ocol + 32 * dt + 4 * hf;
#pragma unroll
        for (int g = 0; g < 4; ++g) { v2u w; w.x = pg8::cvt_pk_bf16(acc[4 * g + 0] * inv, acc[4 * g + 1] * inv); w.y = pg8::cvt_pk_bf16(acc[4 * g + 2] * inv, acc[4 * g + 3] * inv);
            *(v2u*)(op + 8 * g) = w; }
    }
    if (!isA && hf == 0) ((float*)(ws + WS_LSE))[((size_t)gi * M + tokq) * 4 + j] = mx + __logf(lsum);
}
__device__ __forceinline__ void build_lut(const Ctx& C, const float* relb) {
    LAS float* lut = (LAS float*)(C.lds + LUT_OFF);
    for (int i = C.tid; i < 20 * 192; i += NTHREADS) { const int hh = i / 192, x = i % 192; const int tbl = hh < 8 ? 0 : (hh - 8) >> 2; const int dist = 159 - x; const int maxsteps = hh < 8 ? 127 : 128;
        lut[i] = (dist >= 0 && dist <= maxsteps) ? relb[(int)T5B[tbl][dist] * 20 + hh] : -1e30f; }
    __syncthreads();
}

__device__ __forceinline__ void phase_post(const Ctx& C, const Args& a, int l, unsigned char* ws) {
    const float* SV = (const float*)(ws + WS_SV); const float* BON = (const float*)(ws + WS_BON); const float* COP = (const float*)(ws + WS_COP);
    const float* LO = (const float*)(ws + WS_LO); bf16* YB = (bf16*)(ws + WS_YA);
    const float* lgp = a.in[14] + (size_t)l * BW; const float* lbp = a.in[15] + (size_t)l * BW;
    const int lane = C.lane, li = lane & 15, q = lane >> 4;
    for (int it = C.gw; it < 24 * 512; it += C.ngw) {
        const int hs = it >> 9, c = it & 511, b = hs / 12, h = hs % 12; const int m0 = b * SEQ + c * 16;
        const float* rec = COP + ((size_t)hs * 512 + c) * COP_STRIDE; const float* sst = sst_base(ws, hs) + (size_t)c * 4096 + (size_t)lane * 16;
        f32x4 ryf[4]; const f32x4 y0f = *(const f32x4*)(rec + COP_Y0 + lane * 4);
#pragma unroll
        for (int m = 0; m < 4; ++m) ryf[m] = *(const f32x4*)(rec + COP_RY + lane * 16 + 4 * m);
        f32x4c y[4]; float vv[4][4];
#pragma unroll
        for (int vs = 0; vs < 4; ++vs) {
            f32x4 st[4];
#pragma unroll
            for (int m = 0; m < 4; ++m) st[m] = *(const f32x4*)(sst + (size_t)vs * 1024 + 4 * m);
#pragma unroll
            for (int s_ = 0; s_ < 4; ++s_) vv[vs][s_] = SV[(size_t)(m0 + 4 * q + s_) * BW + h * 64 + 16 * vs + li];
            f32x4c acc = {0.f, 0.f, 0.f, 0.f};
#pragma unroll
            for (int m = 0; m < 4; ++m)
#pragma unroll
                for (int j = 0; j < 4; ++j) acc = MFMA4(ryf[m][j], st[m][j], acc);
#pragma unroll
            for (int s_ = 0; s_ < 4; ++s_) acc = MFMA4(y0f[s_], vv[vs][s_], acc);
            y[vs] = acc;
        }
        float lg[4], lb[4];
#pragma unroll
        for (int vs = 0; vs < 4; ++vs) { lg[vs] = lgp[h * 64 + 16 * vs + li]; lb[vs] = lbp[h * 64 + 16 * vs + li]; }
#pragma unroll
        for (int j = 0; j < 4; ++j) {
            const int m = m0 + 4 * q + j;
            const float mean = red16((y[0][j] + y[1][j]) + (y[2][j] + y[3][j])) * (1.0f / 64.0f);
            const float d0 = y[0][j] - mean, d1 = y[1][j] - mean, d2 = y[2][j] - mean, d3 = y[3][j] - mean;
            const float var = red16((d0 * d0 + d1 * d1) + (d2 * d2 + d3 * d3)) * (1.0f / 64.0f);
            const float rsd = __builtin_amdgcn_rsqf(var + GN_EPS); const float bo = BON[(size_t)m * 12 + h];
            const float* gp = LO + (size_t)m * NLORA + 2 * BW + h * 64 + li; bf16* op = YB + (size_t)m * 1536 + 512 + h * 64 + li;
            op[0] = (bf16)f2bf((d0 * rsd * lg[0] + lb[0] + vv[0][j] * bo) * gp[0]); op[16] = (bf16)f2bf((d1 * rsd * lg[1] + lb[1] + vv[1][j] * bo) * gp[16]);
            op[32] = (bf16)f2bf((d2 * rsd * lg[2] + lb[2] + vv[2][j] * bo) * gp[32]); op[48] = (bf16)f2bf((d3 * rsd * lg[3] + lb[3] + vv[3][j] * bo) * gp[48]);
        }
    }
    const bf16* OC = (const bf16*)(ws + WS_OC); const float* LSE = (const float*)(ws + WS_LSE); bf16* YC = (bf16*)(ws + WS_YA);
    for (int mb = C.gw * 4; mb < M; mb += C.ngw * 4) {
        const int j = C.lane >> 4;
        float l0[4], l1[4], l2[4]; v2u a0[4], a1[4], a2[4];
#pragma unroll
        for (int i = 0; i < 4; ++i) { const int m = mb + i; l0[i] = LSE[(size_t)m * 4 + j]; l1[i] = LSE[((size_t)M + m) * 4 + j]; l2[i] = LSE[((size_t)2 * M + m) * 4 + j];
            a0[i] = *(const v2u*)(OC + (size_t)m * 256 + 4 * C.lane); a1[i] = *(const v2u*)(OC + ((size_t)M + m) * 256 + 4 * C.lane); a2[i] = *(const v2u*)(OC + ((size_t)2 * M + m) * 256 + 4 * C.lane); }
#pragma unroll
        for (int i = 0; i < 4; ++i) { const int m = mb + i;
            const float mx = fmaxf(l0[i], fmaxf(l1[i], l2[i])); const float e0 = __expf(l0[i] - mx), e1 = __expf(l1[i] - mx), e2 = __expf(l2[i] - mx); const float inv = 1.0f / (e0 + e1 + e2);
            const float w0 = e0 * inv, w1 = e1 * inv, w2 = e2 * inv;
            v2u o; o.x = pk2(w0 * bflo(a0[i].x) + w1 * bflo(a1[i].x) + w2 * bflo(a2[i].x), w0 * bfhi(a0[i].x) + w1 * bfhi(a1[i].x) + w2 * bfhi(a2[i].x));
            o.y = pk2(w0 * bflo(a0[i].y) + w1 * bflo(a1[i].y) + w2 * bflo(a2[i].y), w0 * bfhi(a0[i].y) + w1 * bfhi(a1[i].y) + w2 * bfhi(a2[i].y));
            *(v2u*)(YC + (size_t)m * 1536 + 1280 + 4 * C.lane) = o; }
    }
}

__device__ __forceinline__ void unpack8(const v4u w, float (&x)[8]) { x[0] = bflo(w.x); x[1] = bfhi(w.x); x[2] = bflo(w.y); x[3] = bfhi(w.y); x[4] = bflo(w.z); x[5] = bfhi(w.z); x[6] = bflo(w.w); x[7] = bfhi(w.w); }
__device__ __forceinline__ void phase_conv(const Ctx& C, const Args& a, int l, unsigned char* ws) {
    const bf16* U = (const bf16*)(ws + WS_U); bf16* ACT = (bf16*)(ws + WS_ACT); const float* cw = a.in[22] + (size_t)l * 3 * DFF;
    constexpr int GPR = DFF / 8, RUN = 32;
    const int gt = C.bid * NTHREADS + C.tid, ngt = C.G * NTHREADS;
    for (int idx = gt; idx < (M / RUN) * GPR; idx += ngt) {
        const int run = idx / GPR, f0 = (idx % GPR) * 8, m0 = run * RUN;
        float c0[8], c1[8], c2[8];
#pragma unroll
        for (int j = 0; j < 8; ++j) { c0[j] = cw[f0 + j]; c1[j] = cw[DFF + f0 + j]; c2[j] = cw[2 * DFF + f0 + j]; }
        const bf16* ur = U + (size_t)m0 * NUP + f0;
        float x0[8], x1[8];
        { v4u g0 = (v4u){0u, 0u, 0u, 0u}, g1 = (v4u){0u, 0u, 0u, 0u};
          if ((m0 & (SEQ - 1)) != 0) { g0 = *(const v4u*)(ur - 2 * NUP); g1 = *(const v4u*)(ur - NUP); }
          unpack8(g0, x0); unpack8(g1, x1); }
#pragma unroll 1
        for (int tq = 0; tq < RUN; tq += 4) {
            v4u gq[4], vq[4];
#pragma unroll
            for (int i = 0; i < 4; ++i) { gq[i] = *(const v4u*)(ur + (size_t)(tq + i) * NUP); vq[i] = *(const v4u*)(ur + (size_t)(tq + i) * NUP + DFF); }
#pragma unroll
            for (int i = 0; i < 4; ++i) {
                float x2[8], vl[8], r[8]; unpack8(gq[i], x2); unpack8(vq[i], vl);
#pragma unroll
                for (int j = 0; j < 8; ++j) { const float gsum = c0[j] * x0[j] + c1[j] * x1[j] + c2[j] * x2[j]; r[j] = gsum / (1.0f + __expf(-gsum)) * vl[j]; x0[j] = x1[j]; x1[j] = x2[j]; }
                v4u o; o.x = pk2(r[0], r[1]); o.y = pk2(r[2], r[3]); o.z = pk2(r[4], r[5]); o.w = pk2(r[6], r[7]);
                *(v4u*)(ACT + (size_t)(m0 + tq + i) * DFF + f0) = o;
            }
        }
    }
}

__device__ __forceinline__ Ctx make_ctx(unsigned char* lds) {
    Ctx C;
    C.lds = (LAS unsigned char*)lds;
    int t = threadIdx.x; asm volatile("" : "+v"(t));
    C.tid = t; C.lane = C.tid & 63; C.wave = __builtin_amdgcn_readfirstlane(C.tid >> 6);
    C.G = gridDim.x; C.bid = blockIdx.x; C.gw = C.bid * NWAVES + C.wave; C.ngw = C.G * NWAVES;
    return C;
}
template <int K> __device__ __forceinline__ void run_phase(unsigned char* lds, const Args& args, int l) {
    const Ctx C = make_ctx(lds);
    unsigned char* ws = args.ws; asm volatile("" : "+s"(ws)); unsigned char* wsw = ws + (size_t)(l & 1) * WSET_STRIDE; LAS unsigned char* ring = C.lds + RING_OFF; float* out = args.out;
    const float* xsrc = (l == 0) ? args.in[0] : out;
    if constexpr (K == 0) { phase_prep(C, args, l, xsrc, ws); }
    if constexpr (K == 1) { pg8::Gemm g{(const bf16*)(ws + WS_H), (const bf16*)(wsw + WS_WIN), M, NP1, D}; pg8::StaticOrder S; S.init(M, NP1, C.G, C.bid);
        pg8::EpiWin E{(bf16*)(ws + WS_P1), (bf16*)(ws + WS_G), 0};
        pg8::gemm_phase<pg8::EpiWin, pg8::StaticOrder, true, true>(ring, g, S, E); }
    if constexpr (K == 2) { phase_aprime(C, args, l, ws); phase_vt(C, ws); }
    if constexpr (K == 3) { pg8::Gemm g{(const bf16*)(ws + WS_AP), (const bf16*)(wsw + WS_WLORA), M, NLORA, KLORA}; pg8::StaticOrder S; S.init(M, NLORA, C.G, C.bid);
        pg8::EpiF32P E{(float*)(ws + WS_LO), NLORA};
        pg8::gemm_phase<pg8::EpiF32P, pg8::StaticOrder, true, true>(ring, g, S, E); }
    if constexpr (K == 4) { phase_chunkprep(C, args, l, ws); }
    if constexpr (K == 5) {
        const int xg = C.bid & 7, jj = C.bid >> 3;
        if (jj < 3) {
            if (C.tid < 16) ((LAS unsigned*)(C.lds + CH_FLAGS))[C.tid] = 0u;
            __syncthreads();
            const int hs = xg * 3 + jj;
            if (C.wave < 4) scan_chain(C.lane, C.wave, C.lds, hs, ws);
            else if (C.wave < 6) chain_loader(C.lane, C.wave - 4, C.lds, hs, ws);
        } else {
            const int gidx = (jj - 3) * 8 + xg;
            build_lut(C, args.in[1]);
            { const float* sinks = args.in[4] + l * 8;
              for (int rep = 0; rep < EXP_ATTN_REPS; ++rep) for (int it = gidx * 8 + C.wave; it < 512 * 20; it += 1856) attn_wave_item(C.lane, (const LAS float*)(C.lds + LUT_OFF), it, sinks, ws); }
            __syncthreads();
            for (int rep = 0; rep < EXP_GATE_REPS; ++rep) { pg8::Gemm g{(const bf16*)(ws + WS_H), (const bf16*)(wsw + WS_WIN) + (size_t)NP1 * D, M, NG, D}; pg8::StaticOrder S; S.init(M, NG, 232, gidx);
              pg8::EpiWin E{(bf16*)(ws + WS_P1), (bf16*)(ws + WS_G), 23};
              pg8::gemm_phase<pg8::EpiWin, pg8::StaticOrder, true, true>(ring, g, S, E); }
            if (l + 1 < DEPTH) convert_weights(gidx * 8 + C.wave, 1856, C.lane, (LAS float*)(C.lds + RING_OFF + C.wave * 16384), args, l + 1, ws);
        } }
    if constexpr (K == 6) { phase_post(C, args, l, ws); }
    if constexpr (K == 7) { pg8::Gemm g{(const bf16*)(ws + WS_YA), (const bf16*)(wsw + WS_PA), M, D, 1536}; pg8::StaticOrder S; S.init(M, D, C.G, C.bid);
        pg8::EpiGate3 E{(const bf16*)(ws + WS_G), (bf16*)(ws + WS_MG), 8, 20};
        pg8::gemm_phase<pg8::EpiGate3, pg8::StaticOrder, true, true>(ring, g, S, E); }
    if constexpr (K == 8) { pg8::Gemm g{(const bf16*)(ws + WS_MG), (const bf16*)(wsw + WS_WOUT), M, D, D}; pg8::StaticOrder S; S.init(M, D, C.G, C.bid);
        pg8::EpiResid E{xsrc, out};
        pg8::gemm_phase<pg8::EpiResid, pg8::StaticOrder, true, true>(ring, g, S, E); }
    if constexpr (K == 9) { const float* g2 = args.in[20] + (size_t)l * D; bf16* H = (bf16*)(ws + WS_H);
        for (int m = 2 * C.gw; m < M; m += 2 * C.ngw) rms_row2_bf16(out + (size_t)m * D, g2, H + (size_t)m * D, C.lane); }
    if constexpr (K == 10) { pg8::Gemm g{(const bf16*)(ws + WS_H) - 2 * D, (const bf16*)(wsw + WS_WUP), 65 * 256, NUP, D}; pg8::StaticOrder S; S.init(65 * 256, NUP, C.G, C.bid);
        pg8::EpiConv E{(bf16*)(ws + WS_ACT), args.in[22] + (size_t)l * 3 * DFF, (PG8_LAS float*)(C.lds + 131072)};
        pg8::gemm_phase<pg8::EpiConv, pg8::StaticOrder, true, true>(ring, g, S, E); }
    if constexpr (K == 12) { pg8::Gemm g{(const bf16*)(ws + WS_ACT), (const bf16*)(wsw + WS_WDOWN), M, D, DFF}; pg8::StaticOrder S; S.init(M, D, C.G, C.bid);
        pg8::EpiResid E{out, out};
        pg8::gemm_phase<pg8::EpiResid, pg8::StaticOrder, true, true>(ring, g, S, E); }
    if constexpr (K == 13) { const float* gf = args.in[24];
        for (int m = C.gw; m < M; m += C.ngw) rms_row_f32(out + (size_t)m * D, gf, C.lane); }
}
template <int K> __global__ void __launch_bounds__(NTHREADS, 2) fwd_phase(Args args) {
    extern __shared__ __attribute__((aligned(16))) unsigned char lds[];
    run_phase<K>(lds, args, args.li);
}
#ifndef EXP_BAR_REPS
#define EXP_BAR_REPS 1
#endif
#define XBAR(b) do { for (int r_ = 0; r_ < EXP_BAR_REPS; ++r_) xcd_barrier(b); } while (0)
__global__ void __launch_bounds__(NTHREADS, 2) fwd_all(Args args) {
    extern __shared__ __attribute__((aligned(16))) unsigned char lds[];
    { LAS unsigned* ctlw = (LAS unsigned*)((LAS unsigned char*)lds + LDSCTL_OFF); for (int u = threadIdx.x; u < (LDS_BYTES - LDSCTL_OFF) / 4; u += NTHREADS) ctlw[u] = 0u; }
    __syncthreads();
    const XcdBarrier bar = xcd_barrier_post((unsigned*)(args.ws + WS_CTL) + CW_BAR, (volatile LAS unsigned*)((LAS unsigned char*)lds + MISC_OFF) + 8);
    for (int l = 0; l < DEPTH; ++l) {
        for (int rep = 0; rep < (((EXP_EW_MASK >> 0) & 1) ? 2 : 1); ++rep) { run_phase<0>(lds, args, l); XBAR(bar); }
        for (int rep = 0; rep < EXP_G1_REPS; ++rep) { run_phase<1>(lds, args, l); XBAR(bar); }
        for (int rep = 0; rep < (((EXP_EW_MASK >> 2) & 1) ? 2 : 1); ++rep) { run_phase<2>(lds, args, l); XBAR(bar); }
        for (int rep = 0; rep < EXP_G3_REPS; ++rep) { run_phase<3>(lds, args, l); XBAR(bar); }
        for (int rep = 0; rep < (((EXP_EW_MASK >> 4) & 1) ? 2 : 1); ++rep) { run_phase<4>(lds, args, l); XBAR(bar); }
        run_phase<5>(lds, args, l); XBAR(bar);
        for (int rep = 0; rep < (((EXP_EW_MASK >> 6) & 1) ? 2 : 1); ++rep) { run_phase<6>(lds, args, l); XBAR(bar); }
        for (int rep = 0; rep < EXP_G7_REPS; ++rep) { run_phase<7>(lds, args, l); XBAR(bar); }
        run_phase<8>(lds, args, l); XBAR(bar);
        for (int rep = 0; rep < (((EXP_EW_MASK >> 9) & 1) ? 2 : 1); ++rep) { run_phase<9>(lds, args, l); XBAR(bar); }
        for (int rep = 0; rep < EXP_G10_REPS; ++rep) { run_phase<10>(lds, args, l); XBAR(bar); }
        run_phase<12>(lds, args, l); XBAR(bar);
    }
    run_phase<13>(lds, args, 0);
}

#ifndef MK_ONE_LAUNCH
#define MK_ONE_LAUNCH 1
#endif
template <int K> static void launch_phase(int grid, hipStream_t stream, Args a, int l) {
    static bool attr = false; if (!attr) { (void)hipFuncSetAttribute((const void*)fwd_phase<K>, hipFuncAttributeMaxDynamicSharedMemorySize, LDS_BYTES); attr = true; }
    a.li = l; a.ph_lo = K; a.ph_hi = K + 1;
    hipLaunchKernelGGL(fwd_phase<K>, dim3(grid), dim3(NTHREADS), LDS_BYTES, stream, a);
}
extern "C" void kernel_launch(void* const* d_in, const int* in_sizes, int n_in, void* d_out, int out_size, void* d_ws, size_t ws_size, hipStream_t stream) {
    static int grid = 0;
    if (grid == 0) {
        if (n_in != 25 || in_sizes[0] != M * D || out_size != M * D || ws_size < WS_END2) { fprintf(stderr, "kernel_launch: unexpected shapes (n_in %d, in0 %d, out %d, ws %zu < %zu)\n", n_in, n_in > 0 ? in_sizes[0] : -1, out_size, ws_size, (size_t)WS_END); grid = -1; return; }
        int dev = 0, cus = 0;
        if (hipGetDevice(&dev) != hipSuccess || hipDeviceGetAttribute(&cus, hipDeviceAttributeMultiprocessorCount, dev) != hipSuccess) { grid = -1; return; }
        grid = cus;
    }
    if (grid < 0) return;
    (void)hipMemsetAsync((char*)d_ws + WS_CTL, 0, CTL_ZERO_BYTES, stream);
    Args a{};
    for (int i = 0; i < 25; ++i) a.in[i] = (const float*)d_in[i];
    a.out = (float*)d_out; a.ws = (unsigned char*)d_ws; a.pad = 0;
#if MK_ONE_LAUNCH
    { static bool attr = false; if (!attr) { (void)hipFuncSetAttribute((const void*)fwd_all, hipFuncAttributeMaxDynamicSharedMemorySize, LDS_BYTES); attr = true; }
      a.li = 0; a.ph_lo = 0; a.ph_hi = NPHASES;
      hipLaunchKernelGGL(fwd_all, dim3(grid), dim3(NTHREADS), LDS_BYTES, stream, a); }
#else
    for (int l = 0; l < DEPTH; ++l) {
        launch_phase<0>(grid, stream, a, l); launch_phase<1>(grid, stream, a, l); launch_phase<2>(grid, stream, a, l); launch_phase<3>(grid, stream, a, l);
        launch_phase<4>(grid, stream, a, l); launch_phase<5>(grid, stream, a, l); launch_phase<6>(grid, stream, a, l); launch_phase<7>(grid, stream, a, l);
        launch_phase<8>(grid, stream, a, l); launch_phase<9>(grid, stream, a, l); launch_phase<10>(grid, stream, a, l); launch_phase<11>(grid, stream, a, l);
        launch_phase<12>(grid, stream, a, l);
    }
    launch_phase<13>(grid, stream, a, 0);
#endif
}
```

```cpp
#include <hip/hip_runtime.h>
#include <cstdio>
#include <cstdint>
#include <cmath>
#define GAS __attribute__((address_space(1)))
#define LAS __attribute__((address_space(3)))
namespace pg8 {
#define PG8_LAS __attribute__((address_space(3)))
typedef unsigned short bf16_t;
typedef short bf16x8 __attribute__((ext_vector_type(8)));
typedef float f32x4 __attribute__((ext_vector_type(4)));
typedef unsigned u32x4 __attribute__((ext_vector_type(4)));
constexpr int BM = 256, BK = 64, HALF = 128, HTB = HALF * BK * 2  , STAGE_BYTES = 8 * HTB, NXCD = 8, WGM = 8;

__host__ __device__ __forceinline__ int lds_byte(int r, int c) { const int st = (r >> 4) * 2 + (c >> 5), rr = r & 15, cc = c & 31, ob = rr * 64 + cc * 2; return st * 1024 + (ob ^ (((ob >> 9) & 1) << 5)); }
__host__ __device__ __forceinline__ void stage_rc(int b, int& R, int& C) { const int st = b / 1024, sb = b % 1024, swz = sb ^ (((sb >> 9) & 1) << 5); R = (st >> 1) * 16 + swz / 64; C = (st & 1) * 32 + (swz % 64) / 2; }
__host__ __device__ __forceinline__ int perm32(int rho) { const int n = rho >> 4, i = rho & 15; return 8 * (i >> 2) + 4 * n + (i & 3); }

struct Unit { int pm, pn; };
struct Gemm { const bf16_t* A; const bf16_t* Bt; int M, N, K; };

struct StaticOrder {
    int nM, nN, nwg, G, c;
    __host__ __device__ void init(int M, int N, int G_, int c_) { nM = M / BM; nN = N / BM; nwg = nM * nN; G = G_; c = c_; }
    __host__ __device__ bool next(int i, Unit& u) const {
        const long L = (long)i * G + c; if (L >= nwg) return false;
        int wgid = (int)L; { const int q = nwg / NXCD, r = nwg % NXCD, xcd = wgid % NXCD, off = wgid / NXCD; wgid = (xcd < r ? xcd * (q + 1) : r * (q + 1) + (xcd - r) * q) + off; }
        const int nig = WGM * nN, gid = wgid / nig, fm = gid * WGM, gsz = (nM - fm) < WGM ? (nM - fm) : WGM;
        u.pm = fm + ((wgid % nig) % gsz); u.pn = (wgid % nig) / gsz; return true;
    }
    __device__ __forceinline__ void a_ready(const Unit&) const {}
    __device__ __forceinline__ void done(const Unit&) const {}
};
__device__ __forceinline__ unsigned cvt_pk_bf16(float lo, float hi) { unsigned r; asm volatile("v_cvt_pk_bf16_f32 %0, %1, %2" : "=v"(r) : "v"(lo), "v"(hi)); return r; }
template <class Epi, class Sched, bool ALIGN_EPI = false, bool SP2 = false>
__device__ __forceinline__ void gemm_phase(PG8_LAS unsigned char* lds, const Gemm g, const Sched& S, const Epi& E) {
    int tid_ = threadIdx.x; asm volatile("" : "+v"(tid_));
    const int tid = tid_, wid = __builtin_amdgcn_readfirstlane(tid >> 6), lane = tid & 63, wr = wid >> 2, wc = wid & 3, fr = lane & 15, fq = lane >> 4;
    const int K = g.K, nt = K / BK;
    unsigned voffA[2], voffB[2];
#pragma unroll
    for (int i = 0; i < 2; ++i) { int R, C; stage_rc(tid * 16 + i * 8192, R, C); const int Rb = Epi::PERM ? ((R & ~31) + perm32(R & 31)) : R;
        voffA[i] = (unsigned)(R * K + C) * 2u; voffB[i] = (unsigned)(Rb * K + C) * 2u; }
    const size_t kstep = (size_t)(BK * 2);
    const size_t hstep = (size_t)HALF * K * 2;
    const size_t tstep = 2 * hstep;
    const size_t tstepA = (size_t)Epi::A_ROWS * K * 2;
    const unsigned ldsw = (unsigned)wid * 1024u;
    const int aoff = lds_byte(wr * 64 + fr, fq * 8), boff = lds_byte(wc * 32 + fr, fq * 8);
#define PG8_SA(b, h) (((b) * 2 + (h)) * HTB)
#define PG8_SB(b, h) ((4 + (b) * 2 + (h)) * HTB)
#define PG8_STAGE(bufoff, gbase, voff) do { _Pragma("unroll") for (int _i = 0; _i < 2; ++_i) \
        __builtin_amdgcn_global_load_lds((const unsigned*)((const char*)(gbase) + (voff)[_i]), (PG8_LAS unsigned*)(lds + (bufoff) + ldsw + _i * 8192), 16, 0, 0); } while (0)
#define PG8_LDA(dst, b, h) do { _Pragma("unroll") for (int m = 0; m < 4; ++m) _Pragma("unroll") for (int k = 0; k < 2; ++k) dst[m][k] = *(const PG8_LAS bf16x8*)(lds + PG8_SA(b, h) + aoff + m * 2048 + k * 1024); } while (0)
#define PG8_LDB(dst, b, h) do { _Pragma("unroll") for (int n = 0; n < 2; ++n) _Pragma("unroll") for (int k = 0; k < 2; ++k) dst[n][k] = *(const PG8_LAS bf16x8*)(lds + PG8_SB(b, h) + boff + n * 2048 + k * 1024); } while (0)
#define PG8_MMA(ai, bj, At, Bt) do { __builtin_amdgcn_s_setprio(1); _Pragma("unroll") for (int m = 0; m < 4; ++m) _Pragma("unroll") for (int n = 0; n < 2; ++n) _Pragma("unroll") for (int k = 0; k < 2; ++k) \
        acc[ai][bj][m][n] = __builtin_amdgcn_mfma_f32_16x16x32_bf16(Bt[n][k], At[m][k], acc[ai][bj][m][n], 0, 0, 0); __builtin_amdgcn_s_setprio(0); } while (0)
#define PG8_WAIT_V(n) asm volatile("s_waitcnt vmcnt(" #n ")" ::: "memory")
#define PG8_WAIT_L(n) asm volatile("s_waitcnt lgkmcnt(" #n ")" ::: "memory")
#define PG8_BAR __builtin_amdgcn_s_barrier()
#define PG8_SCHED __builtin_amdgcn_sched_barrier(0)
    Unit cur, nxt; int ui = 0;
    if (!S.next(0, cur)) return;
    f32x4 acc[2][2][4][2];
#pragma unroll
    for (int a = 0; a < 2; ++a)
#pragma unroll
        for (int b = 0; b < 2; ++b)
#pragma unroll
            for (int m = 0; m < 4; ++m)
#pragma unroll
                for (int n = 0; n < 2; ++n) acc[a][b][m][n] = (f32x4){0.f, 0.f, 0.f, 0.f};
    bf16x8 At[4][2], B0[2][2], B1[2][2];
    const char* cA = (const char*)g.A + (size_t)cur.pm * tstepA; const char* cB = (const char*)g.Bt + (size_t)cur.pn * tstep;
    S.a_ready(cur);
    if constexpr (SP2) {
        PG8_STAGE(PG8_SB(0, 0), cB, voffB); PG8_STAGE(PG8_SB(0, 1), cB + hstep, voffB); PG8_STAGE(PG8_SA(0, 0), cA, voffA); PG8_STAGE(PG8_SA(0, 1), cA + hstep, voffA);
        if (wr == 1) PG8_BAR;
        PG8_WAIT_V(2); PG8_BAR;
        PG8_STAGE(PG8_SB(1, 0), cB + kstep, voffB); PG8_STAGE(PG8_SA(1, 0), cA + kstep, voffA); PG8_STAGE(PG8_SB(1, 1), cB + hstep + kstep, voffB);
        PG8_WAIT_V(6); PG8_BAR;
    } else {
        PG8_STAGE(PG8_SB(0, 0), cB, voffB); PG8_STAGE(PG8_SA(0, 0), cA, voffA); PG8_STAGE(PG8_SB(0, 1), cB + hstep, voffB); PG8_STAGE(PG8_SA(0, 1), cA + hstep, voffA);
        if (wr == 1) PG8_BAR;
        PG8_WAIT_V(4); PG8_BAR;
        PG8_STAGE(PG8_SB(1, 0), cB + kstep, voffB); PG8_STAGE(PG8_SA(1, 0), cA + kstep, voffA); PG8_STAGE(PG8_SB(1, 1), cB + hstep + kstep, voffB);
        PG8_WAIT_V(6); PG8_BAR;
    }
    for (;;) {
        const bool has_next = S.next(ui + 1, nxt);
        const char* nA = has_next ? (const char*)g.A + (size_t)nxt.pm * tstepA : cA; const char* nB = has_next ? (const char*)g.Bt + (size_t)nxt.pn * tstep : cB;
        for (int t = 0; t < nt; t += 2) {
            const bool last = (t == nt - 2);
            const char* a1 = cA + (size_t)(t + 1) * kstep;
            const char* a2 = last ? nA : cA + (size_t)(t + 2) * kstep; const char* b2 = last ? nB : cB + (size_t)(t + 2) * kstep;
            const char* a3 = a2 + kstep; const char* b3 = b2 + kstep;
            if (last && has_next) S.a_ready(nxt);
            if constexpr (Epi::HAS_SEG) { if (t == E.t1 || t == E.t2) E.seg(acc, cur, t, wr, wc, fr, fq); }
            if constexpr (SP2) {
            PG8_LDB(B0, 0, 0); PG8_LDB(B1, 0, 1); PG8_SCHED; PG8_LDA(At, 0, 0); PG8_STAGE(PG8_SA(1, 1), a1 + hstep, voffA);
            PG8_WAIT_V(8); PG8_WAIT_L(0); PG8_BAR; PG8_MMA(0, 0, At, B0); PG8_MMA(0, 1, At, B1); PG8_BAR; PG8_SCHED;
            PG8_LDA(At, 0, 1); PG8_STAGE(PG8_SB(0, 0), b2, voffB); PG8_STAGE(PG8_SB(0, 1), b2 + hstep, voffB); PG8_STAGE(PG8_SA(0, 0), a2, voffA);
            PG8_WAIT_V(8); PG8_WAIT_L(0); PG8_BAR; PG8_MMA(1, 0, At, B0); PG8_MMA(1, 1, At, B1); PG8_BAR; PG8_SCHED;
            PG8_LDB(B0, 1, 0); PG8_LDB(B1, 1, 1); PG8_SCHED; PG8_LDA(At, 1, 0); PG8_STAGE(PG8_SA(0, 1), a2 + hstep, voffA);
            PG8_WAIT_V(8); PG8_WAIT_L(0); PG8_BAR; PG8_MMA(0, 0, At, B0); PG8_MMA(0, 1, At, B1); PG8_BAR; PG8_SCHED;
            PG8_LDA(At, 1, 1); PG8_STAGE(PG8_SB(1, 0), b3, voffB); PG8_STAGE(PG8_SB(1, 1), b3 + hstep, voffB); PG8_STAGE(PG8_SA(1, 0), a3, voffA);
            PG8_WAIT_V(8); PG8_WAIT_L(0); PG8_BAR; PG8_MMA(1, 0, At, B0); PG8_MMA(1, 1, At, B1); PG8_BAR; PG8_SCHED;
            } else {
            PG8_LDB(B0, 0, 0); PG8_SCHED; PG8_LDA(At, 0, 0); PG8_STAGE(PG8_SA(1, 1), a1 + hstep, voffA);
            PG8_WAIT_L(8); PG8_BAR; PG8_WAIT_L(0); PG8_MMA(0, 0, At, B0); PG8_BAR; PG8_SCHED;
            PG8_LDB(B1, 0, 1); PG8_STAGE(PG8_SB(0, 0), b2, voffB);
            PG8_BAR; PG8_WAIT_L(0); PG8_MMA(0, 1, At, B1); PG8_BAR;
            PG8_LDA(At, 0, 1); PG8_STAGE(PG8_SA(0, 0), a2, voffA);
            PG8_BAR; PG8_WAIT_L(0); PG8_MMA(1, 0, At, B0); PG8_BAR; PG8_SCHED;
            PG8_STAGE(PG8_SB(0, 1), b2 + hstep, voffB);
            PG8_WAIT_V(6); PG8_BAR; PG8_MMA(1, 1, At, B1); PG8_BAR;
            PG8_LDB(B0, 1, 0); PG8_SCHED; PG8_LDA(At, 1, 0); PG8_STAGE(PG8_SA(0, 1), a2 + hstep, voffA);
            PG8_WAIT_L(8); PG8_BAR; PG8_WAIT_L(0); PG8_MMA(0, 0, At, B0); PG8_BAR; PG8_SCHED;
            PG8_LDB(B1, 1, 1); PG8_STAGE(PG8_SB(1, 0), b3, voffB);
            PG8_BAR; PG8_WAIT_L(0); PG8_MMA(0, 1, At, B1); PG8_BAR;
            PG8_LDA(At, 1, 1); PG8_STAGE(PG8_SA(1, 0), a3, voffA);
            PG8_BAR; PG8_WAIT_L(0); PG8_MMA(1, 0, At, B0); PG8_BAR; PG8_SCHED;
            PG8_STAGE(PG8_SB(1, 1), b3 + hstep, voffB);
            PG8_WAIT_V(6); PG8_BAR; PG8_MMA(1, 1, At, B1); PG8_BAR;
            }
        }
        if constexpr (ALIGN_EPI) { if (wr == 0) PG8_BAR; }
        if constexpr (!Epi::AFTER_DRAIN) { E(acc, cur, wr, wc, fr, fq); S.done(cur); }
        if (!has_next) break;
#pragma unroll
        for (int a = 0; a < 2; ++a)
#pragma unroll
            for (int b = 0; b < 2; ++b)
#pragma unroll
                for (int m = 0; m < 4; ++m)
#pragma unroll
                    for (int n = 0; n < 2; ++n) acc[a][b][m][n] = (f32x4){0.f, 0.f, 0.f, 0.f};
        cur = nxt; cA = nA; cB = nB; ++ui;
        if constexpr (ALIGN_EPI) { if (wr == 1) PG8_BAR; }
    }
    PG8_WAIT_V(0);
    if constexpr (!ALIGN_EPI) { if (wr == 0) PG8_BAR; }
    PG8_BAR;
    if constexpr (Epi::AFTER_DRAIN) { E.fused(acc, cur, wr, wc, fr, fq, lds, wid, lane); S.done(cur); }
#undef PG8_SA
#undef PG8_SB
#undef PG8_STAGE
#undef PG8_LDA
#undef PG8_LDB
#undef PG8_MMA
#undef PG8_WAIT_V
#undef PG8_WAIT_L
#undef PG8_BAR
#undef PG8_SCHED
}
}
#define XB_TMO      128
#define XB_XCNT(j)  (256  + 64 * (j))
#define XB_XSUB(j)  (1280 + 64 * (j))
#define XB_XGEN(j)  (2304 + 64 * (j))
#define XB_TOP      3328
#define XB_TOPGEN   3392
#define XCD_BAR_WORDS 3456
#define XB_SPIN_CAP (1u << 18)

__device__ __forceinline__ unsigned xb_ld(unsigned* p)              { return __hip_atomic_load(p, __ATOMIC_RELAXED, __HIP_MEMORY_SCOPE_AGENT); }
__device__ __forceinline__ unsigned xb_add(unsigned* p, unsigned v) { return __hip_atomic_fetch_add(p, v, __ATOMIC_RELAXED, __HIP_MEMORY_SCOPE_AGENT); }
__device__ __forceinline__ unsigned xb_xcc_id() { return (unsigned)__builtin_amdgcn_s_getreg((3 << 11) | 20) & 0xFu; }
#define XB_SPIN(cond, bar) do { unsigned _sp = 0; while (cond) { __builtin_amdgcn_s_sleep(1); \
    if ((++_sp & 255u) == 0u) { if (xb_ld(&(bar)[XB_TMO])) break; if (_sp > XB_SPIN_CAP) { atomicAdd(&(bar)[XB_TMO], 1u); break; } } } } while (0)

struct XcdBarrier {
    unsigned* bar; unsigned x;
    volatile LAS unsigned* st;
};

__device__ __forceinline__ XcdBarrier xcd_barrier_post(unsigned* bar, volatile LAS unsigned* st) {
    XcdBarrier b; b.bar = bar; b.x = xb_xcc_id(); b.st = st;
    if (threadIdx.x == 0) (void)xb_add(&bar[XB_XCNT(b.x)], 1u);
    return b;
}
__device__ __forceinline__ void xcd_barrier_complete(unsigned* bar, unsigned x, unsigned& nloc, unsigned& nx) {
    const unsigned G = gridDim.x * gridDim.y * gridDim.z;
    unsigned sum, cnt, mine, sp = 0u;
    for (;;) {
        sum = 0u; cnt = 0u; mine = 0u;
#pragma unroll
        for (unsigned j = 0; j < 16; ++j) { const unsigned c = xb_ld(&bar[XB_XCNT(j)]); sum += c; cnt += (c > 0u) ? 1u : 0u; mine = (j == x) ? c : mine; }
        if (sum == G) break;
        __builtin_amdgcn_s_sleep(1);
        if ((++sp & 255u) == 0u) { if (xb_ld(&bar[XB_TMO])) break; if (sp > XB_SPIN_CAP) { atomicAdd(&bar[XB_TMO], 1u); break; } }
    }
    nloc = mine > 0u ? mine : 1u; nx = cnt > 0u ? cnt : 1u;
}

__device__ __forceinline__ void xcd_barrier(const XcdBarrier& b) {
    asm volatile("s_waitcnt vmcnt(0)" ::: "memory");
    __syncthreads();
    if (threadIdx.x == 0) {
        unsigned* bar = b.bar;
        __builtin_amdgcn_s_waitcnt(0);
        unsigned nloc = b.st[0], nx = b.st[1];
        if (nloc == 0u) { xcd_barrier_complete(bar, b.x, nloc, nx); b.st[0] = nloc; b.st[1] = nx; }
        const unsigned old = xb_add(&bar[XB_XSUB(b.x)], 1u);
        const unsigned gen = old / nloc;
        if (old + 1u == (gen + 1u) * nloc) {
            __builtin_amdgcn_fence(__ATOMIC_RELEASE, "agent");
            asm volatile("s_waitcnt vmcnt(0)" ::: "memory");
            const unsigned og = xb_add(&bar[XB_TOP], 1u);
            const unsigned tg = og / nx;
            if (og + 1u == (tg + 1u) * nx) xb_add(&bar[XB_TOPGEN], 1u);
            else XB_SPIN(xb_ld(&bar[XB_TOPGEN]) == tg, bar);
            __builtin_amdgcn_fence(__ATOMIC_ACQUIRE, "agent");
            xb_add(&bar[XB_XGEN(b.x)], 1u);
            asm volatile("s_waitcnt vmcnt(0)" ::: "memory");
        } else {
            XB_SPIN(xb_ld(&bar[XB_XGEN(b.x)]) == gen, bar);
            __builtin_amdgcn_fence(__ATOMIC_ACQUIRE, "agent");
            asm volatile("s_waitcnt vmcnt(0)" ::: "memory");
        }
    }
    __syncthreads();
}

constexpr int BATCH = 2, SEQ = 8192, M = BATCH * SEQ, D = 2048, DEPTH = 4;
constexpr int DIN = 11968, NP1 = 5888, NG = 6144, NWIN = NP1 + NG;
constexpr int BW = 768, BCOLS = 2752;
constexpr int C_AQ = 0, C_AK = 512, C_AV = 640, C_R = 768, C_K = 1536, C_V = 2304, C_WD = 3072, C_CQ = 3520, C_CK = 4288, C_CV = 5056, C_END = 5824;
constexpr int DFF = 5504, NUP = 2 * DFF;
constexpr int NLORA = 2304, KLORA = 512;
constexpr float NORM_EPS = 1e-5f, GN_EPS = 64e-5f;
constexpr int NWAVES = 8, NTHREADS = 512;
constexpr int NPH = 13;
constexpr int NPHASES = DEPTH * NPH + 1;
#ifndef EXP_EW_MASK
#define EXP_EW_MASK 0
#endif
#ifndef EXP_EW_REPS
#define EXP_EW_REPS 1
#endif
#ifndef EXP_G10_REPS
#define EXP_G10_REPS 1
#endif
#ifndef EXP_GATE_REPS
#define EXP_GATE_REPS 1
#endif
#ifndef EXP_G7_REPS
#define EXP_G7_REPS 1
#endif
#ifndef EXP_G3_REPS
#define EXP_G3_REPS 1
#endif
#ifndef EXP_G1_REPS
#define EXP_G1_REPS 1
#endif
#ifndef EXP_SCAN_REPS
#define EXP_SCAN_REPS 1
#endif
#ifndef EXP_ATTN_REPS
#define EXP_ATTN_REPS 1
#endif
constexpr int NSCAN = 48;

constexpr size_t MiB = 1u << 20;
constexpr size_t WS_CTL = 0, CTL_ZERO_BYTES = 1 * MiB;
constexpr size_t WS_WIN = 1 * MiB;
constexpr size_t WS_WLORA = 48 * MiB;
constexpr size_t WS_PA = 51 * MiB;
constexpr size_t WS_PB = 53 * MiB;
constexpr size_t WS_PC = 56 * MiB;
constexpr size_t WS_WOUT = 57 * MiB;
constexpr size_t WS_WUP = 65 * MiB;
constexpr size_t WS_WDOWN = 108 * MiB;
constexpr size_t WS_H = 130 * MiB;
constexpr size_t WS_P1 = 194 * MiB;
constexpr size_t WS_G = 378 * MiB;
constexpr size_t WS_U = WS_P1;
constexpr size_t WS_AP = 570 * MiB;
constexpr size_t WS_LO = 586 * MiB;
constexpr size_t WS_ACT = WS_LO;
constexpr size_t WS_SR = 730 * MiB;
constexpr size_t WS_SW = 778 * MiB, WS_SK = 826 * MiB, WS_SKK = 874 * MiB, WS_SB = 922 * MiB, WS_SV = 970 * MiB;
constexpr size_t WS_YRAW = 1018 * MiB;
constexpr size_t WS_YA = 1066 * MiB;
constexpr size_t WS_YB = 1082 * MiB;
constexpr size_t WS_YC = 1106 * MiB;
constexpr size_t WS_OC = 1114 * MiB;
constexpr size_t WS_LSE = 1138 * MiB;
constexpr size_t WS_MG = 1139 * MiB;
constexpr size_t WS_BK = 1203 * MiB;
constexpr size_t WS_VT = 1205 * MiB;
constexpr size_t WS_W2 = 1235 * MiB;
constexpr size_t WSET_STRIDE = WS_W2 - WS_WIN;
constexpr size_t WS_BON = 1365 * MiB;
constexpr size_t WS_END = 1366 * MiB;
constexpr size_t WS_SST_A = 1366 * MiB, WS_SST_B = WS_MG;
constexpr size_t WS_END2 = 1494 * MiB;
constexpr size_t WS_COP = WS_SR;
constexpr int COP_W1 = 0, COP_U0 = 1024, COP_BK = 1536, COP_GAM = 3584, COP_RY = 3648, COP_Y0 = 4672, COP_STRIDE = 4928;
constexpr int CW_BAR = 4096;

constexpr int RING_OFF = 0, RING_BYTES = 131072;
constexpr int LDSCTL_OFF = 141312, MISC_OFF = LDSCTL_OFF + 320;
constexpr int LDS_BYTES = 147456;
constexpr int LUT_OFF = 0, SCANRING_OFF = 12288, CONV_SCR_SCAN = 77824, CONV_SCR_OTHER = 12288;

typedef unsigned short bf16;
typedef unsigned v4u __attribute__((ext_vector_type(4)));
typedef unsigned v2u __attribute__((ext_vector_type(2)));
typedef float f32x4 __attribute__((ext_vector_type(4)));
#define LDS_WAIT() asm volatile("s_waitcnt lgkmcnt(0)" ::: "memory")

__device__ __forceinline__ unsigned f2bf(float f) { unsigned u = __builtin_bit_cast(unsigned, f); return (u + 0x7fffu + ((u >> 16) & 1u)) >> 16; }
__device__ __forceinline__ unsigned pk2(float lo, float hi) { return f2bf(lo) | (f2bf(hi) << 16); }
__device__ __forceinline__ float bflo(unsigned w) { return __builtin_bit_cast(float, w << 16); }
__device__ __forceinline__ float bfhi(unsigned w) { return __builtin_bit_cast(float, w & 0xffff0000u); }
__device__ __forceinline__ float bf1(bf16 h) { return __builtin_bit_cast(float, ((unsigned)h) << 16); }
__device__ __forceinline__ float sigmoidf_(float x) { return 1.0f / (1.0f + __expf(-x)); }
__device__ __forceinline__ float wave_sum(float v) {
#pragma unroll
    for (int o = 1; o < 64; o <<= 1) v += __shfl_xor(v, o);
    return v;
}
template <int CTRL> __device__ __forceinline__ float dppf(float x) { return __builtin_bit_cast(float, __builtin_amdgcn_update_dpp(0, __builtin_bit_cast(int, x), CTRL, 0xF, 0xF, true)); }
__device__ __forceinline__ float red4(float x) { x += dppf<0xB1>(x); x += dppf<0x4E>(x); return x; }
__device__ __forceinline__ float red16(float x) { x = red4(x); x += dppf<0x141>(x); x += dppf<0x140>(x); return x; }
__device__ __forceinline__ float wsum(float x) { x = red16(x); x += __shfl_xor(x, 16); x += __shfl_xor(x, 32); return x; }

__device__ const unsigned char T5B[3][132] = {
 {0,1,2,3,4,5,6,7,8,9,10,11,12,13,14,15,16,16,16,16,16,16,17,17,17,17,17,17,17,17,18,18,18,18,18,18,18,18,18,18,19,19,19,19,19,19,19,19,19,19,19,19,19,19,20,20,20,20,20,20,20,20,20,20,20,20,20,20,20,20,20,20,20,21,21,21,21,21,21,21,21,21,21,21,21,21,21,21,21,21,21,21,21,21,21,21,21,21,21,22,22,22,22,22,22,22,22,22,22,22,22,22,22,22,22,22,22,22,22,22,22,22,22,22,22,22,22,22,22,0,0,0},
 {0,4,8,12,16,16,17,17,18,18,19,19,19,19,20,20,20,20,20,21,21,21,21,21,21,22,22,22,22,22,22,22,22,22,23,23,23,23,23,23,23,23,23,23,23,23,24,24,24,24,24,24,24,24,24,24,24,24,24,24,24,24,25,25,25,25,25,25,25,25,25,25,25,25,25,25,25,25,25,25,25,25,25,26,26,26,26,26,26,26,26,26,26,26,26,26,26,26,26,26,26,26,26,26,26,26,26,26,26,26,26,26,26,27,27,27,27,27,27,27,27,27,27,27,27,27,27,27,27,0,0,0},
 {0,16,18,19,20,21,21,22,22,23,23,23,24,24,24,24,25,25,25,25,25,26,26,26,26,26,26,26,26,27,27,27,27,27,27,27,27,27,27,28,28,28,28,28,28,28,28,28,28,28,28,28,29,29,29,29,29,29,29,29,29,29,29,29,29,29,29,29,29,29,30,30,30,30,30,30,30,30,30,30,30,30,30,30,30,30,30,30,30,30,30,30,30,30,30,31,31,31,31,31,31,31,31,31,31,31,31,31,31,31,31,31,31,31,31,31,31,31,31,31,31,31,31,31,31,31,31,31,31,0,0,0}};

namespace pg8 {
struct EpiWin {
    static constexpr bool PERM = true, AFTER_DRAIN = false; static constexpr int A_ROWS = 256; static constexpr bool HAS_SEG = false;
    bf16_t* P1; bf16_t* G; int pn0;
    __device__ __forceinline__ void operator()(const f32x4 (&acc)[2][2][4][2], const Unit& u, int wr, int wc, int fr, int fq) const {
        const int pn = u.pn + pn0; const int row0 = u.pm * BM + wr * 64 + fr; const bool gate = pn >= 23;
        bf16_t* base = gate ? G : P1; const int ldc = gate ? 6144 : 5888; const int col0 = (gate ? (pn - 23) : pn) * BM + wc * 32 + 8 * fq;
#pragma unroll
        for (int ai = 0; ai < 2; ++ai)
#pragma unroll
            for (int m = 0; m < 4; ++m) { bf16_t* rowp = base + (size_t)(row0 + ai * HALF + m * 16) * ldc + col0;
#pragma unroll
                for (int bj = 0; bj < 2; ++bj) { f32x4 v0 = acc[ai][bj][m][0], v1 = acc[ai][bj][m][1];
                    if (gate) {
#pragma unroll
                        for (int j = 0; j < 4; ++j) { v0[j] = __builtin_amdgcn_rcpf(1.0f + __expf(-v0[j])); v1[j] = __builtin_amdgcn_rcpf(1.0f + __expf(-v1[j])); } }
                    u32x4 w; w.x = cvt_pk_bf16(v0[0], v0[1]); w.y = cvt_pk_bf16(v0[2], v0[3]); w.z = cvt_pk_bf16(v1[0], v1[1]); w.w = cvt_pk_bf16(v1[2], v1[3]);
                    *(u32x4*)(rowp + bj * HALF) = w; } }
    }
};
struct EpiBf16P {
    static constexpr bool PERM = true, AFTER_DRAIN = false; static constexpr int A_ROWS = 256; static constexpr bool HAS_SEG = false;
    bf16_t* O; int ldc;
    __device__ __forceinline__ void operator()(const f32x4 (&acc)[2][2][4][2], const Unit& u, int wr, int wc, int fr, int fq) const {
        const int row0 = u.pm * BM + wr * 64 + fr; const int col0 = u.pn * BM + wc * 32 + 8 * fq;
#pragma unroll
        for (int ai = 0; ai < 2; ++ai)
#pragma unroll
            for (int m = 0; m < 4; ++m) { bf16_t* rowp = O + (size_t)(row0 + ai * HALF + m * 16) * ldc + col0;
#pragma unroll
                for (int bj = 0; bj < 2; ++bj) { const f32x4 v0 = acc[ai][bj][m][0], v1 = acc[ai][bj][m][1];
                    u32x4 w; w.x = cvt_pk_bf16(v0[0], v0[1]); w.y = cvt_pk_bf16(v0[2], v0[3]); w.z = cvt_pk_bf16(v1[0], v1[1]); w.w = cvt_pk_bf16(v1[2], v1[3]);
                    *(u32x4*)(rowp + bj * HALF) = w; } }
    }
};
struct EpiF32P {
    static constexpr bool PERM = false, AFTER_DRAIN = false; static constexpr int A_ROWS = 256; static constexpr bool HAS_SEG = false;
    float* C; int ldc;
    __device__ __forceinline__ void operator()(const f32x4 (&acc)[2][2][4][2], const Unit& u, int wr, int wc, int fr, int fq) const {
        const int row0 = u.pm * BM + wr * 64 + fr, col0 = u.pn * BM + wc * 32 + 4 * fq;
#pragma unroll
        for (int ai = 0; ai < 2; ++ai)
#pragma unroll
            for (int m = 0; m < 4; ++m) { float* rowp = C + (size_t)(row0 + ai * HALF + m * 16) * ldc + col0;
#pragma unroll
                for (int bj = 0; bj < 2; ++bj)
#pragma unroll
                    for (int n = 0; n < 2; ++n) *(f32x4*)(rowp + bj * HALF + n * 16) = acc[ai][bj][m][n]; }
    }
};
struct EpiResid {
    static constexpr bool PERM = false, AFTER_DRAIN = false; static constexpr int A_ROWS = 256; static constexpr bool HAS_SEG = false;
    const float* xin; float* out;
    __device__ __forceinline__ void operator()(const f32x4 (&acc)[2][2][4][2], const Unit& u, int wr, int wc, int fr, int fq) const {
        const int row0 = u.pm * BM + wr * 64 + fr, col0 = u.pn * BM + wc * 32 + 4 * fq;
#pragma unroll
        for (int ai = 0; ai < 2; ++ai)
#pragma unroll
            for (int m = 0; m < 4; ++m) { const size_t ro = (size_t)(row0 + ai * HALF + m * 16) * 2048 + col0;
#pragma unroll
                for (int bj = 0; bj < 2; ++bj)
#pragma unroll
                    for (int n = 0; n < 2; ++n) { const f32x4 xv = *(const f32x4*)(xin + ro + bj * HALF + n * 16); *(f32x4*)(out + ro + bj * HALF + n * 16) = xv + acc[ai][bj][m][n]; } }
    }
};
template <bool ACC> struct EpiGate {
    static constexpr bool PERM = true, AFTER_DRAIN = false; static constexpr int A_ROWS = 256; static constexpr bool HAS_SEG = false;
    const bf16_t* G; int gofs; bf16_t* MG;
    __device__ __forceinline__ void operator()(const f32x4 (&acc)[2][2][4][2], const Unit& u, int wr, int wc, int fr, int fq) const {
        const int row0 = u.pm * BM + wr * 64 + fr; const int col0 = u.pn * BM + wc * 32 + 8 * fq;
#pragma unroll
        for (int ai = 0; ai < 2; ++ai)
#pragma unroll
            for (int m = 0; m < 4; ++m) { const int row = row0 + ai * HALF + m * 16;
#pragma unroll
                for (int bj = 0; bj < 2; ++bj) { const int col = col0 + bj * HALF;
                    const u32x4 gv = *(const u32x4*)(G + (size_t)row * 6144 + gofs + col);
                    const f32x4 a0 = acc[ai][bj][m][0], a1 = acc[ai][bj][m][1];
                    float r[8];
                    r[0] = __builtin_bit_cast(float, gv.x << 16) * a0[0]; r[1] = __builtin_bit_cast(float, gv.x & 0xffff0000u) * a0[1];
                    r[2] = __builtin_bit_cast(float, gv.y << 16) * a0[2]; r[3] = __builtin_bit_cast(float, gv.y & 0xffff0000u) * a0[3];
                    r[4] = __builtin_bit_cast(float, gv.z << 16) * a1[0]; r[5] = __builtin_bit_cast(float, gv.z & 0xffff0000u) * a1[1];
                    r[6] = __builtin_bit_cast(float, gv.w << 16) * a1[2]; r[7] = __builtin_bit_cast(float, gv.w & 0xffff0000u) * a1[3];
                    bf16_t* mp = MG + (size_t)row * 2048 + col;
                    if (ACC) { const u32x4 ov = *(const u32x4*)mp;
                        r[0] += __builtin_bit_cast(float, ov.x << 16); r[1] += __builtin_bit_cast(float, ov.x & 0xffff0000u);
                        r[2] += __builtin_bit_cast(float, ov.y << 16); r[3] += __builtin_bit_cast(float, ov.y & 0xffff0000u);
                        r[4] += __builtin_bit_cast(float, ov.z << 16); r[5] += __builtin_bit_cast(float, ov.z & 0xffff0000u);
                        r[6] += __builtin_bit_cast(float, ov.w << 16); r[7] += __builtin_bit_cast(float, ov.w & 0xffff0000u); }
                    u32x4 w; w.x = cvt_pk_bf16(r[0], r[1]); w.y = cvt_pk_bf16(r[2], r[3]); w.z = cvt_pk_bf16(r[4], r[5]); w.w = cvt_pk_bf16(r[6], r[7]);
                    *(u32x4*)mp = w; } }
    }
};
struct EpiGate3 {
    static constexpr bool PERM = true, AFTER_DRAIN = false; static constexpr int A_ROWS = 256; static constexpr bool HAS_SEG = true;
    const bf16_t* G; bf16_t* MG; int t1, t2;
    __device__ __forceinline__ void seg(f32x4 (&acc)[2][2][4][2], const Unit& u, int t, int wr, int wc, int fr, int fq) const {
        typedef unsigned u32x2 __attribute__((ext_vector_type(2)));
        const int gnum = (t == t1) ? 0 : 2048;
        const bf16_t* gp0 = G + (size_t)(u.pm * BM + wr * 64 + fr) * 6144 + gnum + u.pn * BM + wc * 32 + 8 * fq;
#pragma unroll
        for (int ai = 0; ai < 2; ++ai)
#pragma unroll
            for (int m = 0; m < 4; ++m)
#pragma unroll
                for (int bj = 0; bj < 2; ++bj)
#pragma unroll
                    for (int n = 0; n < 2; ++n) {
                        const bf16_t* gp = gp0 + (size_t)(ai * HALF + m * 16) * 6144 + bj * HALF + 4 * n;
                        const u32x2 gn = *(const u32x2*)gp, gd = *(const u32x2*)(gp + 2048);
                        f32x4 r;
                        r[0] = __builtin_bit_cast(float, gn.x << 16) * __builtin_amdgcn_rcpf(__builtin_bit_cast(float, gd.x << 16)); r[1] = __builtin_bit_cast(float, gn.x & 0xffff0000u) * __builtin_amdgcn_rcpf(__builtin_bit_cast(float, gd.x & 0xffff0000u));
                        r[2] = __builtin_bit_cast(float, gn.y << 16) * __builtin_amdgcn_rcpf(__builtin_bit_cast(float, gd.y << 16)); r[3] = __builtin_bit_cast(float, gn.y & 0xffff0000u) * __builtin_amdgcn_rcpf(__builtin_bit_cast(float, gd.y & 0xffff0000u));
                        acc[ai][bj][m][n] *= r; if (n == 1 && bj == 1) asm volatile("" ::: "memory"); }
    }
    __device__ __forceinline__ void operator()(const f32x4 (&acc)[2][2][4][2], const Unit& u, int wr, int wc, int fr, int fq) const {
        const int row0 = u.pm * BM + wr * 64 + fr; const int col0 = u.pn * BM + wc * 32 + 8 * fq;
#pragma unroll
        for (int ai = 0; ai < 2; ++ai)
#pragma unroll
            for (int m = 0; m < 4; ++m) { const int row = row0 + ai * HALF + m * 16;
#pragma unroll
                for (int bj = 0; bj < 2; ++bj) { const int col = col0 + bj * HALF; const u32x4 gv = *(const u32x4*)(G + (size_t)row * 6144 + 4096 + col);
                    const f32x4 a0 = acc[ai][bj][m][0], a1 = acc[ai][bj][m][1];
                    u32x4 w;
                    w.x = cvt_pk_bf16(__builtin_bit_cast(float, gv.x << 16) * a0[0], __builtin_bit_cast(float, gv.x & 0xffff0000u) * a0[1]);
                    w.y = cvt_pk_bf16(__builtin_bit_cast(float, gv.y << 16) * a0[2], __builtin_bit_cast(float, gv.y & 0xffff0000u) * a0[3]);
                    w.z = cvt_pk_bf16(__builtin_bit_cast(float, gv.z << 16) * a1[0], __builtin_bit_cast(float, gv.z & 0xffff0000u) * a1[1]);
                    w.w = cvt_pk_bf16(__builtin_bit_cast(float, gv.w << 16) * a1[2], __builtin_bit_cast(float, gv.w & 0xffff0000u) * a1[3]);
                    *(u32x4*)(MG + (size_t)row * 2048 + col) = w; } }
    }
};
template <int CTRL> __device__ __forceinline__ float dpp_keep(float old, float x) { return __builtin_bit_cast(float, __builtin_amdgcn_update_dpp(__builtin_bit_cast(int, old), __builtin_bit_cast(int, x), CTRL, 0xF, 0xF, false)); }
struct EpiConv {
    static constexpr bool PERM = true, AFTER_DRAIN = false; static constexpr int A_ROWS = 254; static constexpr bool HAS_SEG = false;
    bf16_t* ACT; const float* cw; PG8_LAS float* xch;
    __device__ __forceinline__ void operator()(const f32x4 (&acc)[2][2][4][2], const Unit& u, int wr, int wc, int fr, int fq) const {
        const int cbase = wc * 32 + 8 * fq, f0 = u.pn * 128 + cbase;
        float c0[8], c1[8], c2[8];
#pragma unroll
        for (int j = 0; j < 8; ++j) { c0[j] = cw[f0 + j]; c1[j] = cw[5504 + f0 + j]; c2[j] = cw[2 * 5504 + f0 + j]; }
        if (fr >= 14) {
#pragma unroll
            for (int ai = 0; ai < 2; ++ai)
#pragma unroll
                for (int n = 0; n < 2; ++n) *(PG8_LAS f32x4*)(xch + ((2 * ai + wr) * 2 + (fr - 14)) * 128 + cbase + 4 * n) = acc[ai][0][3][n];
        }
        asm volatile("s_waitcnt lgkmcnt(0)" ::: "memory"); __builtin_amdgcn_s_barrier(); asm volatile("" ::: "memory");
#pragma unroll
        for (int ai = 0; ai < 2; ++ai) {
            const int sl = 2 * ai + wr;
            f32x4 e1[2], e2[2];
#pragma unroll
            for (int n = 0; n < 2; ++n) { e1[n] = (f32x4){0.f, 0.f, 0.f, 0.f}; e2[n] = e1[n];
                if (sl > 0) { e2[n] = *(const PG8_LAS f32x4*)(xch + ((sl - 1) * 2 + 0) * 128 + cbase + 4 * n); e1[n] = *(const PG8_LAS f32x4*)(xch + ((sl - 1) * 2 + 1) * 128 + cbase + 4 * n); } }
#pragma unroll
            for (int m = 0; m < 4; ++m) {
                const int lr = 128 * ai + 64 * wr + 16 * m + fr; const int grow = 254 * u.pm - 2 + lr; const int t = grow & 8191;
                float r[8];
#pragma unroll
                for (int n = 0; n < 2; ++n)
#pragma unroll
                    for (int j = 0; j < 4; ++j) {
                        const float x = acc[ai][0][m][n][j];
                        float k1, k2;
                        if (m > 0) { const float xp = acc[ai][0][m > 0 ? m - 1 : 0][n][j]; k1 = dpp_keep<0x121>(xp, xp); k2 = dpp_keep<0x122>(xp, xp); }
                        else { k1 = e1[n][j]; k2 = (fr == 0) ? e2[n][j] : e1[n][j]; }
                        float p1 = dpp_keep<0x111>(k1, x), p2 = dpp_keep<0x112>(k2, x);
                        if (t == 0) p1 = 0.f; if (t <= 1) p2 = 0.f;
                        const float gs = c0[4 * n + j] * p2 + c1[4 * n + j] * p1 + c2[4 * n + j] * x;
                        r[4 * n + j] = gs * __builtin_amdgcn_rcpf(1.0f + __expf(-gs)) * acc[ai][1][m][n][j];
                    }
                if (lr >= 2 && grow < 16384) { u32x4 w; w.x = cvt_pk_bf16(r[0], r[1]); w.y = cvt_pk_bf16(r[2], r[3]); w.z = cvt_pk_bf16(r[4], r[5]); w.w = cvt_pk_bf16(r[6], r[7]);
                    *(u32x4*)(ACT + (size_t)grow * 5504 + f0) = w; }
            }
        }
    }
};
}

struct Args { const float* in[25]; float* out; unsigned char* ws; int ph_lo, ph_hi, li, pad; };

struct Ctx {
    LAS unsigned char* lds;
    int tid, lane, wave, G, bid;
    int gw, ngw;
};

__device__ __forceinline__ void transpose_item(const float* W, int K, int N, bf16* WT, int kb, int nb, int dst_row0, LAS float* scr, int lane, int ldk = 0, int koff = 0) {
    if (ldk == 0) ldk = K;
    const int k0 = 64 * kb, n0 = 32 * nb;
#pragma unroll 8
    for (int i = 0; i < 32; ++i) { const int kk = 2 * i + (lane >> 5); scr[kk * 33 + (lane & 31)] = W[(size_t)(k0 + kk) * N + n0 + (lane & 31)]; }
    LDS_WAIT(); asm volatile("" ::: "memory");
    const int c = lane & 7;
#pragma unroll
    for (int j = 0; j < 4; ++j) { const int n = (lane >> 3) + 8 * j; const LAS float* s = scr + (8 * c) * 33 + n;
        v4u o; o.x = pk2(s[0 * 33], s[1 * 33]); o.y = pk2(s[2 * 33], s[3 * 33]); o.z = pk2(s[4 * 33], s[5 * 33]); o.w = pk2(s[6 * 33], s[7 * 33]);
        *(v4u*)(WT + (size_t)(dst_row0 + n) * ldk + koff + k0 + 8 * c) = o; }
    LDS_WAIT(); asm volatile("" ::: "memory");
}
__device__ __forceinline__ int transpose_matrix(int widx, int nw, int lane, LAS float* scr, const float* W, int K, int N, bf16* WT, int gate_split, int base, int ldk = 0, int koff = 0) {
    const int nblk = N / 32, items = (K / 64) * nblk;
    int first = (widx - base) % nw; if (first < 0) first += nw;
    for (int it = first; it < items; it += nw) {
        const int kb = it / nblk, nb = it % nblk; int dr = 32 * nb; if (gate_split == 1 && dr >= C_END) dr += 64;
        if (gate_split == 2) { const int f = dr < DFF ? dr : dr - DFF; dr = 256 * (f >> 7) + (f & 127) + (dr < DFF ? 0 : 128); }
        transpose_item(W, K, N, WT, kb, nb, dr, scr, lane, ldk, koff);
    }
    return base + items;
}
__device__ __forceinline__ void convert_weights(int widx, int nw, int lane, LAS float* scr, const Args& a, int l, unsigned char* ws) {
    unsigned char* wsw = ws + (size_t)(l & 1) * WSET_STRIDE;
    int base = 0;
    base = transpose_matrix(widx, nw, lane, scr, a.in[3] + (size_t)l * D * DIN, D, DIN, (bf16*)(wsw + WS_WIN), 1, base);
    base = transpose_matrix(widx, nw, lane, scr, a.in[21] + (size_t)l * D * NUP, D, NUP, (bf16*)(wsw + WS_WUP), 2, base);
    base = transpose_matrix(widx, nw, lane, scr, a.in[23] + (size_t)l * DFF * D, DFF, D, (bf16*)(wsw + WS_WDOWN), 0, base);
    base = transpose_matrix(widx, nw, lane, scr, a.in[19] + (size_t)l * D * D, D, D, (bf16*)(wsw + WS_WOUT), 0, base);
    base = transpose_matrix(widx, nw, lane, scr, a.in[16] + (size_t)l * 512 * D, 512, D, (bf16*)(wsw + WS_PA), 0, base, 1536, 0);
    base = transpose_matrix(widx, nw, lane, scr, a.in[17] + (size_t)l * 768 * D, 768, D, (bf16*)(wsw + WS_PA), 0, base, 1536, 512);
    base = transpose_matrix(widx, nw, lane, scr, a.in[18] + (size_t)l * 256 * D, 256, D, (bf16*)(wsw + WS_PA), 0, base, 1536, 1280);
    const int gt = widx * 64 + lane, ngt = nw * 64;
    { v4u* z = (v4u*)((bf16*)(wsw + WS_WIN) + (size_t)C_END * D); for (int i = gt; i < 64 * D / 8; i += ngt) z[i] = (v4u){0u, 0u, 0u, 0u}; }
    { bf16* wl = (bf16*)(wsw + WS_WLORA); const float* wup = a.in[7] + (size_t)l * 96 * BW; const float* aup = a.in[9] + (size_t)l * 96 * BW; const float* gup = a.in[10] + (size_t)l * 256 * BW;
      for (int i = gt; i < NLORA * KLORA; i += ngt) { const int n = i / KLORA, k = i % KLORA; float v = 0.f;
          if (n < 768) { if (k < 96) v = wup[k * BW + n]; }
          else if (n < 1536) { if (k >= 96 && k < 192) v = aup[(k - 96) * BW + (n - 768)]; }
          else { if (k >= 192 && k < 448) v = gup[(k - 192) * BW + (n - 1536)]; }
          wl[i] = (bf16)f2bf(v); } }
}

__device__ __forceinline__ void rms_row_bf16(const float* xrow, const float* gam, bf16* orow, int lane) {
    const f32x4* xr = (const f32x4*)xrow + lane; f32x4 v[8]; float s = 0.f;
#pragma unroll
    for (int j = 0; j < 8; ++j) { v[j] = xr[64 * j]; s += (v[j].x * v[j].x + v[j].y * v[j].y) + (v[j].z * v[j].z + v[j].w * v[j].w); }
    const float rs = 1.0f / sqrtf(wave_sum(s) * (1.0f / D) + NORM_EPS);
    const f32x4* gr = (const f32x4*)gam + lane; v2u* o8 = (v2u*)orow + lane;
#pragma unroll
    for (int j = 0; j < 8; ++j) { const f32x4 g = gr[64 * j]; v2u w; w.x = pk2(v[j].x * rs * g.x, v[j].y * rs * g.y); w.y = pk2(v[j].z * rs * g.z, v[j].w * rs * g.w); o8[64 * j] = w; }
}
__device__ __forceinline__ void rms_row2_bf16(const float* xrow, const float* gam, bf16* orow, int lane) {
    const f32x4* xr = (const f32x4*)xrow + lane; f32x4 v[16]; float s0 = 0.f, s1 = 0.f;
#pragma unroll
    for (int j = 0; j < 16; ++j) v[j] = xr[64 * j];
#pragma unroll
    for (int j = 0; j < 8; ++j) { s0 += (v[j].x * v[j].x + v[j].y * v[j].y) + (v[j].z * v[j].z + v[j].w * v[j].w); s1 += (v[8 + j].x * v[8 + j].x + v[8 + j].y * v[8 + j].y) + (v[8 + j].z * v[8 + j].z + v[8 + j].w * v[8 + j].w); }
    const float rs0 = 1.0f / sqrtf(wsum(s0) * (1.0f / D) + NORM_EPS), rs1 = 1.0f / sqrtf(wsum(s1) * (1.0f / D) + NORM_EPS);
    const f32x4* gr = (const f32x4*)gam + lane; v2u* o8 = (v2u*)orow + lane;
#pragma unroll
    for (int j = 0; j < 8; ++j) { const f32x4 g = gr[64 * j]; v2u w; w.x = pk2(v[j].x * rs0 * g.x, v[j].y * rs0 * g.y); w.y = pk2(v[j].z * rs0 * g.z, v[j].w * rs0 * g.w); o8[64 * j] = w;
        v2u w1; w1.x = pk2(v[8 + j].x * rs1 * g.x, v[8 + j].y * rs1 * g.y); w1.y = pk2(v[8 + j].z * rs1 * g.z, v[8 + j].w * rs1 * g.w); o8[64 * (8 + j)] = w1; }
}
__device__ __forceinline__ void rms_row_f32(float* xrow, const float* gam, int lane) {
    f32x4* xr = (f32x4*)xrow + lane; f32x4 v[8]; float s = 0.f;
#pragma unroll
    for (int j = 0; j < 8; ++j) { v[j] = xr[64 * j]; s += (v[j].x * v[j].x + v[j].y * v[j].y) + (v[j].z * v[j].z + v[j].w * v[j].w); }
    const float rs = 1.0f / sqrtf(wave_sum(s) * (1.0f / D) + NORM_EPS);
    const f32x4* gr = (const f32x4*)gam + lane;
#pragma unroll
    for (int j = 0; j < 8; ++j) { const f32x4 g = gr[64 * j]; xr[64 * j] = v[j] * rs * g; }
}

__device__ __forceinline__ void phase_prep(const Ctx& C, const Args& a, int l, const float* xsrc, unsigned char* ws) {
    if (l == 0) convert_weights(C.gw, C.ngw, C.lane, (LAS float*)(C.lds + RING_OFF + C.wave * 16384), a, 0, ws);
    const float* g1 = a.in[2] + (size_t)l * D; bf16* H = (bf16*)(ws + WS_H);
    for (int m = 2 * C.gw; m < M; m += 2 * C.ngw) rms_row2_bf16(xsrc + (size_t)m * D, g1, H + (size_t)m * D, C.lane);
}

__device__ __forceinline__ void phase_aprime(const Ctx& C, const Args& a, int l, unsigned char* ws) {
    const bf16* P1 = (const bf16*)(ws + WS_P1); bf16* AP = (bf16*)(ws + WS_AP); const float* mu = a.in[5] + (size_t)l * BCOLS;
    const int g = C.lane, c0 = 8 * g;
    float muv[8];
#pragma unroll
    for (int j = 0; j < 8; ++j) muv[j] = (g < 56) ? mu[(C_WD - C_R) + c0 + j] : 0.f;
    for (int m = C.gw; m < M; m += C.ngw) {
        v4u o = (v4u){0u, 0u, 0u, 0u};
        if (g < 56) {
            const v4u cur = *(const v4u*)(P1 + (size_t)m * NP1 + C_WD + c0);
            v4u prv = (v4u){0u, 0u, 0u, 0u}; if ((m & (SEQ - 1)) != 0) prv = *(const v4u*)(P1 + (size_t)(m - 1) * NP1 + C_WD + c0);
            float x[8], p[8];
            x[0] = bflo(cur.x); x[1] = bfhi(cur.x); x[2] = bflo(cur.y); x[3] = bfhi(cur.y); x[4] = bflo(cur.z); x[5] = bfhi(cur.z); x[6] = bflo(cur.w); x[7] = bfhi(cur.w);
            p[0] = bflo(prv.x); p[1] = bfhi(prv.x); p[2] = bflo(prv.y); p[3] = bfhi(prv.y); p[4] = bflo(prv.z); p[5] = bfhi(prv.z); p[6] = bflo(prv.w); p[7] = bfhi(prv.w);
#pragma unroll
            for (int j = 0; j < 8; ++j) { float v = x[j] + (p[j] - x[j]) * muv[j];
                if (g < 12) v = tanhf(v); else if (g >= 24) v = sigmoidf_(v);
                x[j] = v; }
            o.x = pk2(x[0], x[1]); o.y = pk2(x[2], x[3]); o.z = pk2(x[4], x[5]); o.w = pk2(x[6], x[7]);
        }
        *(v4u*)(AP + (size_t)m * KLORA + c0) = o;
    }
}

struct PrepTok { float r, kt, v, w, kk, b; };
__device__ __forceinline__ PrepTok prep_token(const bf16* P1, const float* LO, int m, int hc, float mur, float muk, float muv, float w0, float a0, float kkw, float kaw) {
    const bool first = (m & (SEQ - 1)) == 0;
    const bf16* pr = P1 + (size_t)m * NP1; const bf16* pp = pr - NP1;
    float r = bf1(pr[C_R + hc]), k = bf1(pr[C_K + hc]), v = bf1(pr[C_V + hc]);
    const float rp = first ? 0.f : bf1(pp[C_R + hc]), kp = first ? 0.f : bf1(pp[C_K + hc]), vp = first ? 0.f : bf1(pp[C_V + hc]);
    r = r + (rp - r) * mur; k = k + (kp - k) * muk; v = v + (vp - v) * muv;
    const float wpre = w0 + LO[(size_t)m * NLORA + hc], apre = a0 + LO[(size_t)m * NLORA + BW + hc];
    const float xx = -wpre; const float sp = fmaxf(xx, 0.f) + log1pf(expf(-fabsf(xx)));
    const float wlog = -sp - 0.5f; const float decay = expf(-expf(wlog));
    const float av = 1.0f / (1.0f + expf(-apre));
    const float kkr = k * kkw; const float nrm = sqrtf(wave_sum(kkr * kkr)); const float kk = kkr / fmaxf(nrm, 1e-12f);
    PrepTok t; t.r = r; t.kt = k * (1.0f + (av - 1.0f) * kaw); t.v = v; t.w = decay; t.kk = kk; t.b = kk * av; return t;
}
struct PrepRaw { v2u r, k, v; f32x4 lw, la; };
__device__ __forceinline__ PrepRaw prep_load(const bf16* P1, const float* LO, int m, int c0) {
    PrepRaw x; const bf16* pr = P1 + (size_t)m * NP1 + c0;
    x.r = *(const v2u*)(pr + C_R); x.k = *(const v2u*)(pr + C_K); x.v = *(const v2u*)(pr + C_V);
    x.lw = *(const f32x4*)(LO + (size_t)m * NLORA + c0); x.la = *(const f32x4*)(LO + (size_t)m * NLORA + BW + c0); return x;
}
__device__ __forceinline__ void un4(const v2u w, float (&x)[4]) { x[0] = bflo(w.x); x[1] = bfhi(w.x); x[2] = bflo(w.y); x[3] = bfhi(w.y); }
__device__ __forceinline__ void phase_scanprep(const Ctx& C, const Args& a, int l, unsigned char* ws) {
    const bf16* P1 = (const bf16*)(ws + WS_P1); const float* LO = (const float*)(ws + WS_LO);
    float* SR = (float*)(ws + WS_SR); float* SW = (float*)(ws + WS_SW); float* SK = (float*)(ws + WS_SK); float* SU = (float*)(ws + WS_SKK); float* SB = (float*)(ws + WS_SB); float* SV = (float*)(ws + WS_SV);
    float* BK = (float*)(ws + WS_BK); float* BON = (float*)(ws + WS_BON);
    const float* mu = a.in[5] + (size_t)l * BCOLS; const float* w0p = a.in[6] + (size_t)l * BW; const float* a0p = a.in[8] + (size_t)l * BW;
    const float* kkwp = a.in[11] + (size_t)l * BW; const float* kawp = a.in[12] + (size_t)l * BW; const float* rkp = a.in[13] + (size_t)l * BW;
    constexpr int RL = 8;
    const int g = C.lane >> 4, cq = C.lane & 15;
    for (int it = C.gw; it < (M / (4 * RL)) * 12; it += C.ngw) {
        const int h = it % 12, m0 = ((it / 12) * 4 + g) * RL, c0 = h * 64 + 4 * cq;
        const f32x4 mur = *(const f32x4*)(mu + c0), muk = *(const f32x4*)(mu + BW + c0), muv = *(const f32x4*)(mu + 2 * BW + c0), w0 = *(const f32x4*)(w0p + c0), a0 = *(const f32x4*)(a0p + c0);
        const f32x4 kkw = *(const f32x4*)(kkwp + c0), kaw = *(const f32x4*)(kawp + c0), rkc = *(const f32x4*)(rkp + c0);
        const bool seq_start = (m0 & (SEQ - 1)) == 0;
        float prr[4] = {0.f, 0.f, 0.f, 0.f}, prk[4] = {0.f, 0.f, 0.f, 0.f}, prv[4] = {0.f, 0.f, 0.f, 0.f}, pw[4] = {0.f, 0.f, 0.f, 0.f}, pb[4] = {0.f, 0.f, 0.f, 0.f}, pkt[4] = {0.f, 0.f, 0.f, 0.f};
        if (!seq_start) { const bf16* pr = P1 + (size_t)(m0 - 2) * NP1 + c0; un4(*(const v2u*)(pr + C_R), prr); un4(*(const v2u*)(pr + C_K), prk); un4(*(const v2u*)(pr + C_V), prv); }
        PrepRaw nx = prep_load(P1, LO, seq_start ? m0 : m0 - 1, c0);
#pragma unroll 1
        for (int i = seq_start ? 0 : -1; i < RL; ++i) {
            const int m = m0 + i; const PrepRaw cu = nx;
            if (i + 1 < RL) nx = prep_load(P1, LO, m + 1, c0);
            float xr[4], xk[4], xv[4]; un4(cu.r, xr); un4(cu.k, xk); un4(cu.v, xv);
            float tr[4], tk[4], tv[4], tw[4], ta[4], kkr[4]; float q = 0.f;
#pragma unroll
            for (int e = 0; e < 4; ++e) {
                tr[e] = xr[e] + (prr[e] - xr[e]) * mur[e]; tk[e] = xk[e] + (prk[e] - xk[e]) * muk[e]; tv[e] = xv[e] + (prv[e] - xv[e]) * muv[e];
                const float xx = -(w0[e] + cu.lw[e]); const float sp = fmaxf(xx, 0.f) + __logf(1.0f + __expf(-fabsf(xx)));
                tw[e] = __expf(-__expf(-sp - 0.5f)); ta[e] = __builtin_amdgcn_rcpf(1.0f + __expf(-(a0[e] + cu.la[e])));
                kkr[e] = tk[e] * kkw[e]; q += kkr[e] * kkr[e];
            }
            q = red16(q); const float rn = __builtin_amdgcn_rsqf(fmaxf(q, 1e-24f));
            float tkk[4], tb[4], tkt[4]; float be = 0.f, ka = 0.f, bo = 0.f;
#pragma unroll
            for (int e = 0; e < 4; ++e) { tkk[e] = kkr[e] * rn; tb[e] = tkk[e] * ta[e]; tkt[e] = tk[e] * (1.0f + (ta[e] - 1.0f) * kaw[e]);
                be += pb[e] * tkk[e]; ka += pkt[e] * tkk[e]; bo += tr[e] * tkt[e] * rkc[e]; }
            if (i >= 0) {
                be = red16(be); ka = red16(ka); bo = red16(bo);
                const size_t o = (size_t)m * BW + c0; const bool first = (m & (SEQ - 1)) == 0;
                *(f32x4*)(SR + o) = (f32x4){tr[0], tr[1], tr[2], tr[3]}; *(f32x4*)(SW + o) = (f32x4){tw[0], tw[1], tw[2], tw[3]}; *(f32x4*)(SK + o) = (f32x4){tkt[0], tkt[1], tkt[2], tkt[3]};
                *(f32x4*)(SB + o) = (f32x4){tb[0], tb[1], tb[2], tb[3]}; *(f32x4*)(SV + o) = (f32x4){tv[0], tv[1], tv[2], tv[3]};
                if (!first) *(f32x4*)(SU + o - BW) = (f32x4){pw[0] * tkk[0], pw[1] * tkk[1], pw[2] * tkk[2], pw[3] * tkk[3]};
                if ((m & (SEQ - 1)) == SEQ - 1) *(f32x4*)(SU + o) = (f32x4){0.f, 0.f, 0.f, 0.f};
                if (cq < 2) BK[((size_t)m * 12 + h) * 2 + cq] = first ? 0.f : (cq == 0 ? be : ka);
                if (cq == 2) BON[(size_t)m * 12 + h] = bo;
            }
#pragma unroll
            for (int e = 0; e < 4; ++e) { prr[e] = xr[e]; prk[e] = xk[e]; prv[e] = xv[e]; pw[e] = tw[e]; pb[e] = tb[e]; pkt[e] = tkt[e]; }
        }
    }
}

typedef float f32x4c __attribute__((ext_vector_type(4)));
#define MFMA4(a, b, c) __builtin_amdgcn_mfma_f32_16x16x4f32((a), (b), (c), 0, 0, 0)
__device__ __forceinline__ void split8(const float (&x)[8], v4u& hi, v4u& lo) {
    unsigned h[4], l[4];
#pragma unroll
    for (int p = 0; p < 4; ++p) { h[p] = pg8::cvt_pk_bf16(x[2 * p], x[2 * p + 1]); l[p] = pg8::cvt_pk_bf16(x[2 * p] - bflo(h[p]), x[2 * p + 1] - bfhi(h[p])); }
    hi = (v4u){h[0], h[1], h[2], h[3]}; lo = (v4u){l[0], l[1], l[2], l[3]};
}
constexpr int CP_LD = 65, CP_ARR = 16 * CP_LD, CP_SM = 16 * 17;
constexpr int CP_WAVE_FLOATS = 4 * CP_ARR + 4 * CP_SM;
__device__ __forceinline__ void phase_chunkprep(const Ctx& C, const Args& a, int l, unsigned char* ws) {
    if (C.wave >= 6) return;
    const bf16* P1 = (const bf16*)(ws + WS_P1); const float* LO = (const float*)(ws + WS_LO);
    float* SV = (float*)(ws + WS_SV); float* BON = (float*)(ws + WS_BON); float* COP = (float*)(ws + WS_COP);
    const float* mu = a.in[5] + (size_t)l * BCOLS; const float* w0p = a.in[6] + (size_t)l * BW; const float* a0p = a.in[8] + (size_t)l * BW;
    const float* kkwp = a.in[11] + (size_t)l * BW; const float* kawp = a.in[12] + (size_t)l * BW; const float* rkp = a.in[13] + (size_t)l * BW;
    LAS float* L = (LAS float*)(C.lds + RING_OFF) + C.wave * CP_WAVE_FLOATS;
    LAS float* At = L; LAS float* Bt = L + CP_ARR; LAS float* Kt = L + 2 * CP_ARR; LAS float* Rt = L + 3 * CP_ARR;
    LAS float* Sa = L + 4 * CP_ARR; LAS float* Sb = Sa + CP_SM; LAS float* Sc = Sb + CP_SM; LAS float* Sd = Sc + CP_SM;
    const int lane = C.lane, li = lane & 15, q = lane >> 4;
    const int widx = C.bid * 6 + C.wave, nw = C.G * 6;
    for (int it = widx; it < 24 * 512; it += nw) {
        const int hs = it >> 9, c = it & 511, b = hs / 12, h = hs % 12, hc = h * 64 + lane; const int m0 = b * SEQ + c * 16;
        const float mur = mu[hc], muk = mu[BW + hc], muv = mu[2 * BW + hc], w0 = w0p[hc], a0 = a0p[hc], kkw = kkwp[hc], kaw = kawp[hc], rkc = rkp[hc];
        float rr[17], rk_[17], rv[17], lw[16], la[16];
#pragma unroll
        for (int j = 0; j < 17; ++j) { const bool ok = !((c == 0) && j == 0); const size_t row = ok ? (size_t)(m0 - 1 + j) : (size_t)m0; const bf16* pr = P1 + row * NP1 + hc;
            const float x0 = bf1(pr[C_R]), x1 = bf1(pr[C_K]), x2 = bf1(pr[C_V]); rr[j] = ok ? x0 : 0.f; rk_[j] = ok ? x1 : 0.f; rv[j] = ok ? x2 : 0.f;
            if (j >= 1) { lw[j - 1] = LO[row * NLORA + hc]; la[j - 1] = LO[row * NLORA + BW + hc]; } }
        float cum = 0.f;
#pragma unroll
        for (int i = 0; i < 16; ++i) {
            const float tr = rr[i + 1] + (rr[i] - rr[i + 1]) * mur, tk = rk_[i + 1] + (rk_[i] - rk_[i + 1]) * muk, tv = rv[i + 1] + (rv[i] - rv[i + 1]) * muv;
            const float xx = -(w0 + lw[i]); const float sp = fmaxf(xx, 0.f) + __logf(1.0f + __expf(-fabsf(xx)));
            const float lwv = -__expf(-sp - 0.5f);
            const float av = __builtin_amdgcn_rcpf(1.0f + __expf(-(a0 + la[i])));
            const float kkr = tk * kkw; const float kk = kkr * __builtin_amdgcn_rsqf(fmaxf(wsum(kkr * kkr), 1e-24f));
            const float kt = tk * (1.0f + (av - 1.0f) * kaw), bb = kk * av;
            const float bo = wsum(tr * kt * rkc);
            SV[(size_t)(m0 + i) * BW + hc] = tv; if (lane == 0) BON[(size_t)(m0 + i) * 12 + h] = bo;
            const float ex = __expf(cum); cum += lwv; const float ei = __expf(cum), eni = __expf(-cum);
            At[i * CP_LD + lane] = -kk * ex; Bt[i * CP_LD + lane] = bb * eni; Kt[i * CP_LD + lane] = kt * eni; Rt[i * CP_LD + lane] = tr * ei;
        }
        const float gam = __expf(cum);
        LDS_WAIT(); asm volatile("" ::: "memory");
        f32x4c gab = {0.f, 0.f, 0.f, 0.f}, gak = gab, grb = gab, grk = gab;
#pragma unroll
        for (int s_ = 0; s_ < 16; ++s_) { const int o = li * CP_LD + 4 * s_ + q; const float fa = At[o], fr = Rt[o], fb = Bt[o], fk = Kt[o];
            gab = MFMA4(fa, fb, gab); gak = MFMA4(fa, fk, gak); grb = MFMA4(fr, fb, grb); grk = MFMA4(fr, fk, grk); }
#pragma unroll
        for (int e = 0; e < 4; ++e) { const int i = 4 * q + e, j = li; if (!(j < i)) { gab[e] = 0.f; gak[e] = 0.f; } if (!(j <= i)) { grb[e] = 0.f; grk[e] = 0.f; }
            Sa[i * 17 + j] = gab[e]; Sb[i * 17 + j] = gak[e]; Sc[i * 17 + j] = grb[e]; }
        LDS_WAIT(); asm volatile("" ::: "memory");
        float tt[16];
#pragma unroll
        for (int i = 0; i < 16; ++i) { float acc = (i == li) ? 1.f : 0.f;
#pragma unroll
            for (int j = 0; j < i; ++j) acc += Sa[i * 17 + j] * tt[j];
            tt[i] = acc; }
        if (q == 0) {
#pragma unroll
            for (int i = 0; i < 16; ++i) Sd[i * 17 + li] = tt[i]; }
        LDS_WAIT(); asm volatile("" ::: "memory");
        float tf[4], mrbf[4];
#pragma unroll
        for (int s_ = 0; s_ < 4; ++s_) { tf[s_] = Sd[li * 17 + 4 * s_ + q]; mrbf[s_] = Sc[li * 17 + 4 * s_ + q]; }
        f32x4c w1[4], u0 = {0.f, 0.f, 0.f, 0.f};
#pragma unroll
        for (int n = 0; n < 4; ++n) { w1[n] = (f32x4c){0.f, 0.f, 0.f, 0.f};
#pragma unroll
            for (int s_ = 0; s_ < 4; ++s_) w1[n] = MFMA4(tf[s_], At[(4 * s_ + q) * CP_LD + 16 * n + li], w1[n]); }
#pragma unroll
        for (int s_ = 0; s_ < 4; ++s_) u0 = MFMA4(tf[s_], Sb[(4 * s_ + q) * 17 + li], u0);
        LDS_WAIT(); asm volatile("" ::: "memory");
#pragma unroll
        for (int n = 0; n < 4; ++n)
#pragma unroll
            for (int e = 0; e < 4; ++e) At[(4 * q + e) * CP_LD + 16 * n + li] = w1[n][e];
#pragma unroll
        for (int e = 0; e < 4; ++e) Sa[(4 * q + e) * 17 + li] = u0[e];
        LDS_WAIT(); asm volatile("" ::: "memory");
        f32x4c ry[4], y0 = grk;
#pragma unroll
        for (int n = 0; n < 4; ++n) {
#pragma unroll
            for (int e = 0; e < 4; ++e) ry[n][e] = Rt[(4 * q + e) * CP_LD + 16 * n + li];
#pragma unroll
            for (int s_ = 0; s_ < 4; ++s_) ry[n] = MFMA4(mrbf[s_], At[(4 * s_ + q) * CP_LD + 16 * n + li], ry[n]); }
#pragma unroll
        for (int s_ = 0; s_ < 4; ++s_) y0 = MFMA4(mrbf[s_], Sa[(4 * s_ + q) * 17 + li], y0);
        LDS_WAIT(); asm volatile("" ::: "memory");
#pragma unroll
        for (int n = 0; n < 4; ++n)
#pragma unroll
            for (int e = 0; e < 4; ++e) Rt[(4 * q + e) * CP_LD + 16 * n + li] = ry[n][e];
#pragma unroll
        for (int e = 0; e < 4; ++e) Sb[(4 * q + e) * 17 + li] = y0[e];
        LDS_WAIT(); asm volatile("" ::: "memory");
        float* rec = COP + ((size_t)hs * 512 + c) * COP_STRIDE; unsigned* recu = (unsigned*)rec;
#pragma unroll
        for (int kb = 0; kb < 2; ++kb) { float x[8];
#pragma unroll
            for (int jj = 0; jj < 8; ++jj) x[jj] = At[li * CP_LD + 16 * (2 * kb + (jj >> 2)) + 4 * q + (jj & 3)];
            v4u hi, lo; split8(x, hi, lo); *(v4u*)(recu + COP_W1 + lane * 16 + 8 * kb) = hi; *(v4u*)(recu + COP_W1 + lane * 16 + 8 * kb + 4) = lo; }
        { float x[8];
#pragma unroll
          for (int jj = 0; jj < 8; ++jj) x[jj] = jj < 4 ? Sa[li * 17 + 4 * q + jj] : 0.f;
          v4u hi, lo; split8(x, hi, lo); *(v4u*)(recu + COP_U0 + lane * 8) = hi; *(v4u*)(recu + COP_U0 + lane * 8 + 4) = lo; }
#pragma unroll
        for (int m = 0; m < 4; ++m) { float x[8]; const float gk = __shfl(gam, 16 * m + li);
#pragma unroll
            for (int jj = 0; jj < 8; ++jj) x[jj] = gk * (jj < 4 ? Bt[(4 * q + jj) * CP_LD + 16 * m + li] : Kt[(4 * q + jj - 4) * CP_LD + 16 * m + li]);
            v4u hi, lo; split8(x, hi, lo); *(v4u*)(recu + COP_BK + lane * 32 + 8 * m) = hi; *(v4u*)(recu + COP_BK + lane * 32 + 8 * m + 4) = lo; }
#pragma unroll
        for (int m = 0; m < 4; ++m) { f32x4 y;
#pragma unroll
            for (int j = 0; j < 4; ++j) y[j] = Rt[li * CP_LD + 16 * m + 4 * q + j];
            *(f32x4*)(rec + COP_RY + lane * 16 + 4 * m) = y; }
        { f32x4 y;
#pragma unroll
          for (int s_ = 0; s_ < 4; ++s_) y[s_] = Sb[li * 17 + 4 * q + s_];
          *(f32x4*)(rec + COP_Y0 + lane * 4) = y; }
        rec[COP_GAM + lane] = gam;
        LDS_WAIT(); asm volatile("" ::: "memory");
    }
}

__device__ __forceinline__ void scan_block(const Ctx& C, int sb, unsigned char* ws) {
    const int b = sb / 24, h = (sb % 24) >> 1, half = sb & 1;
    const float* SR = (const float*)(ws + WS_SR); const float* SW = (const float*)(ws + WS_SW); const float* SK = (const float*)(ws + WS_SK); const float* SKK = (const float*)(ws + WS_SKK);
    const float* SB = (const float*)(ws + WS_SB); const float* SV = (const float*)(ws + WS_SV); float* YR = (float*)(ws + WS_YRAW);
    constexpr int T = 64;
    LAS float* Lr = (LAS float*)(C.lds + RING_OFF); LAS float* Lw = Lr + T * 64; LAS float* Lk = Lw + T * 64; LAS float* Lkk = Lk + T * 64; LAS float* Lb = Lkk + T * 64;
    LAS float* Lv = Lb + T * 64; LAS float* Ly = Lv + T * 32;
    const int tid = C.tid, rl = tid >> 4, kq = tid & 15;
    const size_t rowbase = (size_t)b * SEQ; const int colh = h * 64;
    const int lt0 = tid >> 4, lc0 = (tid & 15) * 4, vt = tid >> 3, vc = (tid & 7) * 4;
    f32x4 pr[2], pw[2], pk[2], pkk[2], pb[2], pv;
#define SCAN_LOAD(t0) do { _Pragma("unroll") for (int i = 0; i < 2; ++i) { const size_t o = (rowbase + (t0) + lt0 + 32 * i) * BW + colh + lc0; \
        pr[i] = *(const f32x4*)(SR + o); pw[i] = *(const f32x4*)(SW + o); pk[i] = *(const f32x4*)(SK + o); pkk[i] = *(const f32x4*)(SKK + o); pb[i] = *(const f32x4*)(SB + o); } \
        pv = *(const f32x4*)(SV + (rowbase + (t0) + vt) * BW + colh + 32 * half + vc); } while (0)
    SCAN_LOAD(0);
    float S0 = 0.f, S1 = 0.f, S2 = 0.f, S3 = 0.f;
    for (int ch = 0; ch < SEQ / T; ++ch) {
        const int t0 = ch * T;
#pragma unroll
        for (int i = 0; i < 2; ++i) { const int lo = (lt0 + 32 * i) * 64 + lc0;
            *(LAS f32x4*)(Lr + lo) = pr[i]; *(LAS f32x4*)(Lw + lo) = pw[i]; *(LAS f32x4*)(Lk + lo) = pk[i]; *(LAS f32x4*)(Lkk + lo) = pkk[i]; *(LAS f32x4*)(Lb + lo) = pb[i]; }
        *(LAS f32x4*)(Lv + vt * 32 + vc) = pv;
        __syncthreads();
        if (ch + 1 < SEQ / T) SCAN_LOAD(t0 + T);
#pragma unroll 4
        for (int t = 0; t < T; ++t) {
            const f32x4 kk4 = *(const LAS f32x4*)(Lkk + t * 64 + kq * 4), w4 = *(const LAS f32x4*)(Lw + t * 64 + kq * 4), b4 = *(const LAS f32x4*)(Lb + t * 64 + kq * 4);
            const f32x4 k4 = *(const LAS f32x4*)(Lk + t * 64 + kq * 4), r4 = *(const LAS f32x4*)(Lr + t * 64 + kq * 4); const float v = Lv[t * 32 + rl];
            float d = (S0 * kk4.x + S1 * kk4.y) + (S2 * kk4.z + S3 * kk4.w); d = red16(d); const float sa = -d;
            S0 = S0 * w4.x + (sa * b4.x + v * k4.x); S1 = S1 * w4.y + (sa * b4.y + v * k4.y); S2 = S2 * w4.z + (sa * b4.z + v * k4.z); S3 = S3 * w4.w + (sa * b4.w + v * k4.w);
            float y = (S0 * r4.x + S1 * r4.y) + (S2 * r4.z + S3 * r4.w); y = red16(y);
            if (kq == 0) Ly[t * 32 + rl] = y;
        }
        __syncthreads();
        *(f32x4*)(YR + (rowbase + t0 + vt) * BW + colh + 32 * half + vc) = *(const LAS f32x4*)(Ly + vt * 32 + vc);
    }
#undef SCAN_LOAD
}

__device__ __forceinline__ void glds16(const void* gsrc, unsigned lds_dst) { unsigned keep;
    asm volatile("s_mov_b32 %0, m0\n\ts_mov_b32 m0, %2\n\ts_nop 0\n\tglobal_load_lds_dwordx4 %1, off\n\ts_mov_b32 m0, %0" : "=&s"(keep) : "v"(gsrc), "s"(lds_dst) : "memory"); }
__device__ __forceinline__ void glds4(const void* gsrc, unsigned lds_dst) { unsigned keep;
    asm volatile("s_mov_b32 %0, m0\n\ts_mov_b32 m0, %2\n\ts_nop 0\n\tglobal_load_lds_dword %1, off\n\ts_mov_b32 m0, %0" : "=&s"(keep) : "v"(gsrc), "s"(lds_dst) : "memory"); }
constexpr int SCAN_T = 8, SCAN_SLOT = 5 * SCAN_T * 256 + 512, SCAN_NSLOT = 3, SCAN_RING = SCAN_NSLOT * SCAN_SLOT;
typedef float f32x2 __attribute__((ext_vector_type(2)));
__device__ __forceinline__ void scan_wave(int lane, LAS unsigned char* ring, int hs, int r0, unsigned char* ws) {
    const int b = hs / 12, h = hs % 12;
    const float* SR = (const float*)(ws + WS_SR); const float* SW = (const float*)(ws + WS_SW); const float* SK = (const float*)(ws + WS_SK); const float* SU = (const float*)(ws + WS_SKK);
    const float* SB = (const float*)(ws + WS_SB); const float* SV = (const float*)(ws + WS_SV); const float* BK = (const float*)(ws + WS_BK); float* YR = (float*)(ws + WS_YRAW);
    const int rg = lane >> 4, kq = lane & 15;
    const size_t rowbase = (size_t)b * SEQ; const int colh = h * 64;
    const unsigned ring0 = (unsigned)(size_t)ring;
    const size_t voff = ((size_t)(lane >> 4)) * BW + colh + 4 * kq;
    const size_t vvoff = ((size_t)((lane & 31) >> 2)) * BW + colh + r0 + (lane & 3);
    const size_t bkoff = ((size_t)((lane & 15) >> 1) * 12 + h) * 2 + (lane & 1);
    constexpr int NCH = SEQ / SCAN_T;
#define SCAN_DMA(ch, slot) do { const int cc_ = (ch) < NCH ? (ch) : NCH - 1; const size_t tok_ = rowbase + (size_t)cc_ * SCAN_T; const unsigned sl_ = ring0 + (unsigned)(slot) * SCAN_SLOT; \
        _Pragma("unroll") for (int i_ = 0; i_ < 2; ++i_) { const size_t o_ = (tok_ + 4 * i_) * BW + voff; \
            glds16(SU + o_, sl_ + 0 * 2048 + i_ * 1024); glds16(SW + o_, sl_ + 1 * 2048 + i_ * 1024); glds16(SB + o_, sl_ + 2 * 2048 + i_ * 1024); glds16(SK + o_, sl_ + 3 * 2048 + i_ * 1024); glds16(SR + o_, sl_ + 4 * 2048 + i_ * 1024); } \
        glds4(SV + tok_ * BW + vvoff, sl_ + 10240); glds4(BK + tok_ * 24 + bkoff, sl_ + 10496); } while (0)
    SCAN_DMA(0, 0); SCAN_DMA(1, 1); SCAN_DMA(2, 2);
    f32x2 S01 = (f32x2){0.f, 0.f}, S23 = (f32x2){0.f, 0.f};
    float e_cur = 0.f, sa_prev = 0.f, v_prev = 0.f;
    int slot = 0;
    for (int ch = 0; ch < NCH; ++ch) {
        asm volatile("s_waitcnt vmcnt(24)" ::: "memory");
        const LAS unsigned char* sp = ring + slot * SCAN_SLOT;
        float ykeep = 0.f;
        f32x4 u4a[SCAN_T], w4a[SCAN_T], b4a[SCAN_T], k4a[SCAN_T], r4a[SCAN_T]; float va[SCAN_T]; f32x2 bka[SCAN_T];
#pragma unroll
        for (int tt = 0; tt < SCAN_T; ++tt) {
            u4a[tt] = *(const LAS f32x4*)(sp + 0 * 2048 + tt * 256 + kq * 16); bka[tt] = *(const LAS f32x2*)(sp + 10496 + tt * 8); va[tt] = *(const LAS float*)(sp + 10240 + tt * 16 + rg * 4);
            w4a[tt] = *(const LAS f32x4*)(sp + 1 * 2048 + tt * 256 + kq * 16); b4a[tt] = *(const LAS f32x4*)(sp + 2 * 2048 + tt * 256 + kq * 16);
            k4a[tt] = *(const LAS f32x4*)(sp + 3 * 2048 + tt * 256 + kq * 16); r4a[tt] = *(const LAS f32x4*)(sp + 4 * 2048 + tt * 256 + kq * 16); }
#pragma unroll
        for (int tt = 0; tt < SCAN_T; ++tt) {
            const f32x4 u4 = u4a[tt], w4 = w4a[tt], b4 = b4a[tt], k4 = k4a[tt], r4 = r4a[tt]; const float v = va[tt]; const f32x2 bk = bka[tt];
            f32x2 pe = S01 * (f32x2){u4.x, u4.y}; pe = S23 * (f32x2){u4.z, u4.w} + pe; const float e_next = red16(pe.x + pe.y);
            const float d = e_cur + sa_prev * bk.x + v_prev * bk.y; const float sa = -d;
            const f32x2 sav = (f32x2){sa, sa}, vv = (f32x2){v, v};
            S01 = S01 * (f32x2){w4.x, w4.y} + (sav * (f32x2){b4.x, b4.y} + vv * (f32x2){k4.x, k4.y});
            S23 = S23 * (f32x2){w4.z, w4.w} + (sav * (f32x2){b4.z, b4.w} + vv * (f32x2){k4.z, k4.w});
            f32x2 py = S01 * (f32x2){r4.x, r4.y}; py = S23 * (f32x2){r4.z, r4.w} + py; const float y = red16(py.x + py.y);
            ykeep = (kq == tt) ? y : ykeep;
            e_cur = e_next; sa_prev = sa; v_prev = v;
        }
        if (kq < SCAN_T) YR[(rowbase + (size_t)ch * SCAN_T + kq) * BW + colh + r0 + rg] = ykeep;
        SCAN_DMA(ch + 3, slot);
        slot = (slot == SCAN_NSLOT - 1) ? 0 : slot + 1;
    }
    asm volatile("s_waitcnt vmcnt(0)" ::: "memory");
#undef SCAN_DMA
}

constexpr int SH_T = 8, SH_SLOT = 10240 + 1024 + 256, SH_NSLOT = 11, SH_D = 4, SH_FLAGS = SCANRING_OFF + SH_NSLOT * SH_SLOT;
static_assert(SH_FLAGS + 64 <= LDSCTL_OFF, "scan ring + flags fit below the LDS control words");
__device__ __forceinline__ unsigned lds_ld(volatile LAS unsigned* p) { return *p; }
__device__ __forceinline__ void scan_loader(int lane, LAS unsigned char* lds, int hs, int rblk, unsigned char* ws) {
    const int b = hs / 12, h = hs % 12;
    const float* SR = (const float*)(ws + WS_SR); const float* SW = (const float*)(ws + WS_SW); const float* SK = (const float*)(ws + WS_SK); const float* SU = (const float*)(ws + WS_SKK);
    const float* SB = (const float*)(ws + WS_SB); const float* SV = (const float*)(ws + WS_SV); const float* BK = (const float*)(ws + WS_BK);
    const size_t rowbase = (size_t)b * SEQ; const int colh = h * 64;
    const unsigned ring0 = (unsigned)(size_t)(lds + SCANRING_OFF);
    volatile LAS unsigned* flags = (volatile LAS unsigned*)(lds + SH_FLAGS);
    const size_t voff = ((size_t)(lane >> 4)) * BW + colh + 4 * (lane & 15);
    const size_t vvoff = ((size_t)((lane >> 2) & 7)) * BW + colh + rblk + 4 * (lane & 3);
    const size_t bkoff = ((size_t)((lane & 15) >> 1) * 12 + h) * 2 + (lane & 1);
    constexpr int NCH = SEQ / SH_T;
    int slot = 0;
    for (int c = 0; c < NCH; ++c) {
        if (c >= SH_NSLOT) { const unsigned need = (unsigned)(c - SH_NSLOT + 1);
            while (lds_ld(flags + 1) < need || lds_ld(flags + 2) < need || lds_ld(flags + 3) < need || lds_ld(flags + 4) < need) __builtin_amdgcn_s_sleep(1); }
        const size_t tok = rowbase + (size_t)c * SH_T; const unsigned sl = ring0 + (unsigned)slot * SH_SLOT;
#pragma unroll
        for (int i = 0; i < 2; ++i) { const size_t o = (tok + 4 * i) * BW + voff;
            glds16(SU + o, sl + 0 * 2048 + i * 1024); glds16(SW + o, sl + 1 * 2048 + i * 1024); glds16(SB + o, sl + 2 * 2048 + i * 1024); glds16(SK + o, sl + 3 * 2048 + i * 1024); glds16(SR + o, sl + 4 * 2048 + i * 1024); }
        glds16(SV + tok * BW + vvoff, sl + 10240); glds4(BK + tok * 24 + bkoff, sl + 11264);
        if (c >= SH_D) { asm volatile("s_waitcnt vmcnt(48)" ::: "memory"); if (lane == 0) flags[0] = (unsigned)(c - SH_D + 1); }
        slot = (slot == SH_NSLOT - 1) ? 0 : slot + 1;
    }
    asm volatile("s_waitcnt vmcnt(0)" ::: "memory"); if (lane == 0) flags[0] = (unsigned)NCH;
}
__device__ __forceinline__ void scan_wave_sh(int lane, int w, LAS unsigned char* lds, int hs, int rblk, unsigned char* ws) {
    const int b = hs / 12, h = hs % 12; float* YR = (float*)(ws + WS_YRAW);
    const int rg = lane >> 4, kq = lane & 15, r0 = rblk + 4 * w;
    const size_t rowbase = (size_t)b * SEQ; const int colh = h * 64;
    volatile LAS unsigned* flags = (volatile LAS unsigned*)(lds + SH_FLAGS);
    constexpr int NCH = SEQ / SH_T;
    f32x2 S01 = (f32x2){0.f, 0.f}, S23 = (f32x2){0.f, 0.f};
    float e_cur = 0.f, sa_prev = 0.f, v_prev = 0.f;
    int slot = 0;
    for (int ch = 0; ch < NCH; ++ch) {
        while (lds_ld(flags) <= (unsigned)ch) __builtin_amdgcn_s_sleep(1);
        asm volatile("" ::: "memory");
        const LAS unsigned char* sp = lds + SCANRING_OFF + slot * SH_SLOT;
        float ykeep = 0.f;
        f32x4 u4a[SH_T], w4a[SH_T], b4a[SH_T], k4a[SH_T], r4a[SH_T]; float va[SH_T]; f32x2 bka[SH_T];
#pragma unroll
        for (int tt = 0; tt < SH_T; ++tt) {
            u4a[tt] = *(const LAS f32x4*)(sp + 0 * 2048 + tt * 256 + kq * 16); bka[tt] = *(const LAS f32x2*)(sp + 11264 + tt * 8); va[tt] = *(const LAS float*)(sp + 10240 + tt * 64 + (w * 4 + rg) * 4);
            w4a[tt] = *(const LAS f32x4*)(sp + 1 * 2048 + tt * 256 + kq * 16); b4a[tt] = *(const LAS f32x4*)(sp + 2 * 2048 + tt * 256 + kq * 16);
            k4a[tt] = *(const LAS f32x4*)(sp + 3 * 2048 + tt * 256 + kq * 16); r4a[tt] = *(const LAS f32x4*)(sp + 4 * 2048 + tt * 256 + kq * 16); }
#pragma unroll
        for (int tt = 0; tt < SH_T; ++tt) {
            const f32x4 u4 = u4a[tt], w4 = w4a[tt], b4 = b4a[tt], k4 = k4a[tt], r4 = r4a[tt]; const float v = va[tt]; const f32x2 bk = bka[tt];
            f32x2 pe = S01 * (f32x2){u4.x, u4.y}; pe = S23 * (f32x2){u4.z, u4.w} + pe; const float e_next = red16(pe.x + pe.y);
            const float d = e_cur + sa_prev * bk.x + v_prev * bk.y; const float sa = -d;
            const f32x2 sav = (f32x2){sa, sa}, vv = (f32x2){v, v};
            S01 = S01 * (f32x2){w4.x, w4.y} + (sav * (f32x2){b4.x, b4.y} + vv * (f32x2){k4.x, k4.y});
            S23 = S23 * (f32x2){w4.z, w4.w} + (sav * (f32x2){b4.z, b4.w} + vv * (f32x2){k4.z, k4.w});
            f32x2 py = S01 * (f32x2){r4.x, r4.y}; py = S23 * (f32x2){r4.z, r4.w} + py; const float y = red16(py.x + py.y);
            ykeep = (kq == tt) ? y : ykeep;
            e_cur = e_next; sa_prev = sa; v_prev = v;
        }
        if (kq < SH_T) YR[(rowbase + (size_t)ch * SH_T + kq) * BW + colh + r0 + rg] = ykeep;
        asm volatile("" ::: "memory");
        if (lane == 0) flags[1 + w] = (unsigned)(ch + 1);
        slot = (slot == SH_NSLOT - 1) ? 0 : slot + 1;
    }
}

constexpr int CH_REC = COP_RY * 4;
constexpr int CH_SLOT = CH_REC + 4096, CH_NSLOT = 6, CH_D = 4, CH_FLAGS = SCANRING_OFF + CH_NSLOT * CH_SLOT;
static_assert(CH_FLAGS + 64 <= LDSCTL_OFF, "chain ring + flags fit below the LDS control words");
__device__ __forceinline__ float* sst_base(unsigned char* ws, int hs) { return (float*)(ws + (hs < 16 ? WS_SST_A + (size_t)hs * 8 * MiB : WS_SST_B + (size_t)(hs - 16) * 8 * MiB)); }
__device__ __forceinline__ void chain_loader(int lane, int which, LAS unsigned char* lds, int hs, unsigned char* ws) {
    const int b = hs / 12, h = hs % 12;
    const float* COP = (const float*)(ws + WS_COP) + (size_t)hs * 512 * COP_STRIDE; const float* SV = (const float*)(ws + WS_SV);
    const unsigned ring0 = (unsigned)(size_t)(lds + SCANRING_OFF);
    volatile LAS unsigned* flags = (volatile LAS unsigned*)(lds + CH_FLAGS);
    const int fidx = which == 0 ? 0 : 4 + which;
    const size_t vsrc = ((size_t)b * SEQ + (lane >> 4)) * BW + h * 64 + 4 * (lane & 15);
    int slot = 0; unsigned dmin = 0u, pub = 0u;
    for (int c = 0; c < 512; ++c) {
        if (c >= CH_NSLOT) { const unsigned need = (unsigned)(c - CH_NSLOT + 1);
            if (dmin < need) {
                asm volatile("s_waitcnt vmcnt(0)" ::: "memory"); if (pub < (unsigned)c) { pub = (unsigned)c; if (lane == 0) flags[fidx] = pub; }
                for (;;) { const unsigned d1 = lds_ld(flags + 1), d2 = lds_ld(flags + 2), d3 = lds_ld(flags + 3), d4 = lds_ld(flags + 4); dmin = min(min(d1, d2), min(d3, d4)); if (dmin >= need) break; __builtin_amdgcn_s_sleep(1); } } }
        const float* rec = COP + (size_t)c * COP_STRIDE; const unsigned sl = ring0 + (unsigned)slot * CH_SLOT;
        if (which < 2) {
#pragma unroll
            for (int i = 0; i < 5; ++i) glds16(rec + (5 * which + i) * 256 + lane * 4, sl + (5 * which + i) * 1024);
            if (c >= CH_D) asm volatile("s_waitcnt vmcnt(20)" ::: "memory");
        } else if (which == 2) {
#pragma unroll
            for (int i = 10; i < 14; ++i) glds16(rec + i * 256 + lane * 4, sl + i * 1024);
            glds4(rec + COP_GAM + lane, sl + 14 * 1024);
            if (c >= CH_D) asm volatile("s_waitcnt vmcnt(20)" ::: "memory");
        } else {
#pragma unroll
            for (int i = 0; i < 4; ++i) glds16(SV + vsrc + (size_t)(c * 16 + 4 * i) * BW, sl + CH_REC + i * 1024);
            if (c >= CH_D) asm volatile("s_waitcnt vmcnt(16)" ::: "memory");
        }
        if (c >= CH_D && pub < (unsigned)(c - CH_D + 1)) { pub = (unsigned)(c - CH_D + 1); if (lane == 0) flags[fidx] = pub; }
        slot = (slot == CH_NSLOT - 1) ? 0 : slot + 1;
    }
    asm volatile("s_waitcnt vmcnt(0)" ::: "memory"); if (lane == 0) flags[fidx] = 512u;
}
#define MFMAB(a, b, c) __builtin_amdgcn_mfma_f32_16x16x32_bf16(__builtin_bit_cast(pg8::bf16x8, (a)), __builtin_bit_cast(pg8::bf16x8, (b)), (c), 0, 0, 0)
__device__ __forceinline__ void scan_chain(int lane, int vs, LAS unsigned char* lds, int hs, unsigned char* ws) {
    const int li = lane & 15, q = lane >> 4;
    volatile LAS unsigned* flags = (volatile LAS unsigned*)(lds + CH_FLAGS);
    f32x4c St[4];
#pragma unroll
    for (int m = 0; m < 4; ++m) St[m] = (f32x4c){0.f, 0.f, 0.f, 0.f};
    float* sst = sst_base(ws, hs) + ((size_t)vs * 64 + lane) * 16;
    int slot = 0; unsigned favail = 0u;
    for (int c = 0; c < 512; ++c) {
        if (favail <= (unsigned)c) {
            for (;;) { const unsigned a0 = lds_ld(flags), a1 = lds_ld(flags + 5), a2 = lds_ld(flags + 6), a3 = lds_ld(flags + 7); const unsigned mn = min(min(a0, a1), min(a2, a3)); favail = mn; if (mn > (unsigned)c) break; __builtin_amdgcn_s_sleep(1); } }
        asm volatile("" ::: "memory");
        const LAS unsigned* sp = (const LAS unsigned*)(lds + SCANRING_OFF + slot * CH_SLOT);
        v4u w1h[2], w1l[2], bkh[4], bkl[4]; f32x4 gf[4]; float vc[4];
#pragma unroll
        for (int kb = 0; kb < 2; ++kb) { w1h[kb] = *(const LAS v4u*)(sp + COP_W1 + lane * 16 + 8 * kb); w1l[kb] = *(const LAS v4u*)(sp + COP_W1 + lane * 16 + 8 * kb + 4); }
        const v4u u0h = *(const LAS v4u*)(sp + COP_U0 + lane * 8), u0l = *(const LAS v4u*)(sp + COP_U0 + lane * 8 + 4);
#pragma unroll
        for (int m = 0; m < 4; ++m) { bkh[m] = *(const LAS v4u*)(sp + COP_BK + lane * 32 + 8 * m); bkl[m] = *(const LAS v4u*)(sp + COP_BK + lane * 32 + 8 * m + 4); gf[m] = *(const LAS f32x4*)((const LAS float*)sp + COP_GAM + 16 * m + 4 * q); }
#pragma unroll
        for (int s_ = 0; s_ < 4; ++s_) vc[s_] = ((const LAS float*)sp)[COP_RY + (4 * q + s_) * 64 + 16 * vs + li];
        v4u sh[2], sl_[2];
#pragma unroll
        for (int kb = 0; kb < 2; ++kb) { float x[8];
#pragma unroll
            for (int jj = 0; jj < 8; ++jj) x[jj] = St[2 * kb + (jj >> 2)][jj & 3];
            split8(x, sh[kb], sl_[kb]); }
        v4u vh, vl; { float x[8] = {vc[0], vc[1], vc[2], vc[3], 0.f, 0.f, 0.f, 0.f}; split8(x, vh, vl); }
#pragma unroll
        for (int m = 0; m < 4; ++m) *(f32x4*)(sst + (size_t)c * 4096 + 4 * m) = St[m];
        f32x4c z0 = {0.f, 0.f, 0.f, 0.f}, z1 = {0.f, 0.f, 0.f, 0.f}, z2 = {0.f, 0.f, 0.f, 0.f};
        z0 = MFMAB(w1h[0], sh[0], z0); z1 = MFMAB(w1h[0], sl_[0], z1); z2 = MFMAB(w1l[0], sh[0], z2);
        z0 = MFMAB(w1h[1], sh[1], z0); z1 = MFMAB(w1h[1], sl_[1], z1); z2 = MFMAB(w1l[1], sh[1], z2);
        z0 = MFMAB(u0h, vh, z0); z1 = MFMAB(u0h, vl, z1); z2 = MFMAB(u0l, vh, z2);
#pragma unroll
        for (int m = 0; m < 4; ++m) St[m] *= gf[m];
        const f32x4c z = z0 + (z1 + z2);
        v4u zh, zl; { float x[8] = {z[0], z[1], z[2], z[3], vc[0], vc[1], vc[2], vc[3]}; split8(x, zh, zl); }
#pragma unroll
        for (int m = 0; m < 4; ++m) St[m] = MFMAB(bkh[m], zh, St[m]);
#pragma unroll
        for (int m = 0; m < 4; ++m) St[m] = MFMAB(bkh[m], zl, St[m]);
#pragma unroll
        for (int m = 0; m < 4; ++m) St[m] = MFMAB(bkl[m], zh, St[m]);
        asm volatile("" ::: "memory");
        if (lane == 0) flags[1 + vs] = (unsigned)(c + 1);
        slot = (slot == CH_NSLOT - 1) ? 0 : slot + 1;
    }
}

struct AttnPass { int qcol; int bias_head; int tbl; float sink; int use_sink; int maxsteps; bf16* out; int out_ld; int out_col; float* lse; };
__device__ __forceinline__ void attn_stage_kv(const Ctx& C, const bf16* P1, int b, int res, int dil, int fblk, int kcol, int vcol) {
    LAS unsigned char* Ks = C.lds + RING_OFF; LAS unsigned char* Vs = Ks + 256 * 144;
#pragma unroll
    for (int i = 0; i < 4; ++i) { const int c = C.tid + 512 * i, row = c >> 3, part = c & 7; const int fp = (fblk - 1) * 128 + row;
        v4u kv = (v4u){0u, 0u, 0u, 0u}, vv = (v4u){0u, 0u, 0u, 0u};
        if (fp >= 0) { const bf16* src = P1 + ((size_t)b * SEQ + (size_t)fp * dil + res) * NP1; kv = *(const v4u*)(src + kcol + part * 8); vv = *(const v4u*)(src + vcol + part * 8); }
        *(LAS v4u*)(Ks + row * 144 + part * 16) = kv; *(LAS v4u*)(Vs + row * 144 + part * 16) = vv; }
}
__device__ __forceinline__ void attn_pass(const Ctx& C, const bf16* P1, const float* relb, int b, int res, int dil, int fblk, const AttnPass& ap) {
    LAS unsigned char* Ks = C.lds + RING_OFF; LAS unsigned char* Vs = Ks + 256 * 144; LAS float* lut = (LAS float*)(Vs + 256 * 144);
    __syncthreads();
    if (C.tid < 132) lut[C.tid] = (C.tid <= 128) ? relb[(int)T5B[ap.tbl][C.tid] * 20 + ap.bias_head] : 0.f;
    __syncthreads();
    const int i = C.tid >> 2, dq = C.tid & 3;
    const size_t tok = (size_t)b * SEQ + (size_t)(fblk * 128 + i) * dil + res;
    float q[16];
    { const bf16* qp = P1 + tok * NP1 + ap.qcol + dq * 16; const v4u a0 = *(const v4u*)qp, a1 = *(const v4u*)(qp + 8);
      q[0] = bflo(a0.x); q[1] = bfhi(a0.x); q[2] = bflo(a0.y); q[3] = bfhi(a0.y); q[4] = bflo(a0.z); q[5] = bfhi(a0.z); q[6] = bflo(a0.w); q[7] = bfhi(a0.w);
      q[8] = bflo(a1.x); q[9] = bfhi(a1.x); q[10] = bflo(a1.y); q[11] = bfhi(a1.y); q[12] = bflo(a1.z); q[13] = bfhi(a1.z); q[14] = bflo(a1.w); q[15] = bfhi(a1.w);
#pragma unroll
      for (int j = 0; j < 16; ++j) q[j] *= 0.125f; }
    float mrun = ap.use_sink ? ap.sink : -INFINITY, lrun = ap.use_sink ? 1.0f : 0.0f;
    float o[16];
#pragma unroll
    for (int j = 0; j < 16; ++j) o[j] = 0.f;
    const int fq0 = fblk * 128 + i;
    for (int dist = 0; dist <= ap.maxsteps; ++dist) {
        const int kr = i + 128 - dist;
        const bool valid = (fq0 - dist) >= 0;
        const v4u k0 = *(const LAS v4u*)(Ks + kr * 144 + dq * 32), k1 = *(const LAS v4u*)(Ks + kr * 144 + dq * 32 + 16);
        float s = q[0] * bflo(k0.x) + q[1] * bfhi(k0.x) + q[2] * bflo(k0.y) + q[3] * bfhi(k0.y) + q[4] * bflo(k0.z) + q[5] * bfhi(k0.z) + q[6] * bflo(k0.w) + q[7] * bfhi(k0.w)
                + q[8] * bflo(k1.x) + q[9] * bfhi(k1.x) + q[10] * bflo(k1.y) + q[11] * bfhi(k1.y) + q[12] * bflo(k1.z) + q[13] * bfhi(k1.z) + q[14] * bflo(k1.w) + q[15] * bfhi(k1.w);
        s = red4(s) + lut[dist];
        if (valid) {
            if (s > mrun) { const float c = __expf(mrun - s); lrun *= c;
#pragma unroll
                for (int j = 0; j < 16; ++j) o[j] *= c;
                mrun = s; }
            const float p = __expf(s - mrun); lrun += p;
            const v4u v0 = *(const LAS v4u*)(Vs + kr * 144 + dq * 32), v1 = *(const LAS v4u*)(Vs + kr * 144 + dq * 32 + 16);
            o[0] += p * bflo(v0.x); o[1] += p * bfhi(v0.x); o[2] += p * bflo(v0.y); o[3] += p * bfhi(v0.y); o[4] += p * bflo(v0.z); o[5] += p * bfhi(v0.z); o[6] += p * bflo(v0.w); o[7] += p * bfhi(v0.w);
            o[8] += p * bflo(v1.x); o[9] += p * bfhi(v1.x); o[10] += p * bflo(v1.y); o[11] += p * bfhi(v1.y); o[12] += p * bflo(v1.z); o[13] += p * bfhi(v1.z); o[14] += p * bflo(v1.w); o[15] += p * bfhi(v1.w);
        }
    }
    const float inv = 1.0f / lrun;
    v4u w0, w1;
    w0.x = pk2(o[0] * inv, o[1] * inv); w0.y = pk2(o[2] * inv, o[3] * inv); w0.z = pk2(o[4] * inv, o[5] * inv); w0.w = pk2(o[6] * inv, o[7] * inv);
    w1.x = pk2(o[8] * inv, o[9] * inv); w1.y = pk2(o[10] * inv, o[11] * inv); w1.z = pk2(o[12] * inv, o[13] * inv); w1.w = pk2(o[14] * inv, o[15] * inv);
    bf16* op = ap.out + tok * ap.out_ld + ap.out_col + dq * 16;
    *(v4u*)op = w0; *(v4u*)(op + 8) = w1;
    if (ap.lse && dq == 0) ap.lse[tok * 4] = mrun + __logf(lrun);
}
__device__ __forceinline__ void phase_attn(const Ctx& C, const Args& a, int l, unsigned char* ws, int ab, int nab) {
    const bf16* P1 = (const bf16*)(ws + WS_P1); const float* relb = a.in[1]; const float* sinks = a.in[4] + l * 8;
    bf16* YA = (bf16*)(ws + WS_YA); bf16* OC = (bf16*)(ws + WS_OC); float* LSE = (float*)(ws + WS_LSE);
    constexpr int NA = 256, NC = 1536;
    for (int it = ab; it < NA + NC; it += nab) {
        __syncthreads();
        if (it < NA) {
            const int b = it >> 7, fblk = (it >> 1) & 63, hkv = it & 1;
            attn_stage_kv(C, P1, b, 0, 1, fblk, C_AK + hkv * 64, C_AV + hkv * 64);
            for (int g = 0; g < 4; ++g) { const int hq = hkv * 4 + g;
                AttnPass ap; ap.qcol = C_AQ + hq * 64; ap.bias_head = hq; ap.tbl = 0; ap.sink = sinks[hq]; ap.use_sink = 1; ap.maxsteps = 127; ap.out = YA; ap.out_ld = 512; ap.out_col = hq * 64; ap.lse = nullptr;
                attn_pass(C, P1, relb, b, 0, 1, fblk, ap); }
        } else {
            const int ci = it - NA; const int gi = ci / 512, j = (ci >> 7) & 3, qb = ci & 127;
            const int dil = (gi == 0) ? 1 : (gi == 1 ? 4 : 16); const int bps = 64 / dil;
            const int n = qb / bps, fblk = qb % bps, b = n / dil, res = n % dil; const int hc = gi * 4 + j;
            attn_stage_kv(C, P1, b, res, dil, fblk, C_CK + hc * 64, C_CV + hc * 64);
            AttnPass ap; ap.qcol = C_CQ + hc * 64; ap.bias_head = 8 + hc; ap.tbl = gi; ap.sink = 0.f; ap.use_sink = 0; ap.maxsteps = 128; ap.out = OC + (size_t)gi * M * 256; ap.out_ld = 256; ap.out_col = j * 64;
            ap.lse = LSE + (size_t)gi * M * 4 + j;
            attn_pass(C, P1, relb, b, res, dil, fblk, ap);
        }
    }
}

__device__ __forceinline__ void phase_vt(const Ctx& C, unsigned char* ws) {
    const bf16* P1 = (const bf16*)(ws + WS_P1); bf16* VT = (bf16*)(ws + WS_VT);
    for (int it = C.gw; it < 14 * 2 * 128; it += C.ngw) {
        const int hs = it / 256, b = (it >> 7) & 1, blk = it & 127;
        const int gi = hs < 2 ? 0 : (hs - 2) >> 2; const int dil = gi == 0 ? 1 : (gi == 1 ? 4 : 16); const int Lf = SEQ / dil;
        const int vcol = hs < 2 ? C_AV + hs * 64 : C_CV + (hs - 2) * 64;
        const int ft = blk * 64 + C.lane;
        const int res = ft / Lf, tp = ft % Lf; const int tok = b * SEQ + tp * dil + res;
        const v4u* src = (const v4u*)(P1 + (size_t)tok * NP1 + vcol);
        v4u x[8];
#pragma unroll
        for (int i = 0; i < 8; ++i) x[i] = src[i];
        bf16* dst = VT + ((size_t)(hs * 2 + b) * 64) * SEQ + ft;
#pragma unroll
        for (int i = 0; i < 8; ++i) {
            dst[(size_t)(8 * i + 0) * SEQ] = (bf16)(x[i].x & 0xffffu); dst[(size_t)(8 * i + 1) * SEQ] = (bf16)(x[i].x >> 16);
            dst[(size_t)(8 * i + 2) * SEQ] = (bf16)(x[i].y & 0xffffu); dst[(size_t)(8 * i + 3) * SEQ] = (bf16)(x[i].y >> 16);
            dst[(size_t)(8 * i + 4) * SEQ] = (bf16)(x[i].z & 0xffffu); dst[(size_t)(8 * i + 5) * SEQ] = (bf16)(x[i].z >> 16);
            dst[(size_t)(8 * i + 6) * SEQ] = (bf16)(x[i].w & 0xffffu); dst[(size_t)(8 * i + 7) * SEQ] = (bf16)(x[i].w >> 16);
        }
    }
}

typedef float f32x16 __attribute__((ext_vector_type(16)));
__device__ __forceinline__ void attn_wave_item(int lane, const LAS float* lutall, int item, const float* sinks, unsigned char* ws) {
    const bf16* P1 = (const bf16*)(ws + WS_P1); const bf16* VT = (const bf16*)(ws + WS_VT);
    const int hh = item % 20, g32 = item / 20;
    const bool isA = hh < 8; const int hc = hh - 8; const int gi = isA ? 0 : hc >> 2, j = hc & 3;
    const int dil = gi == 0 ? 1 : (gi == 1 ? 4 : 16); const int Lf = SEQ / dil, gps = Lf / 32;
    const int b = g32 >> 8, rr = g32 & 255, res = rr / gps, qg = rr % gps, fq0 = qg * 32;
    const int qcol = isA ? C_AQ + hh * 64 : C_CQ + hc * 64, kcol = isA ? C_AK + (hh >> 2) * 64 : C_CK + hc * 64;
    const int hs = isA ? (hh >> 2) : 2 + hc;
    const int r = lane & 31, hf = lane >> 5;
    const LAS float* lut = lutall + hh * 192 + (31 - r + 8 * hf);
    const int pr = (r & 0x13) | ((r & 8) >> 1) | ((r & 4) << 1);
    const size_t tokq = (size_t)b * SEQ + (size_t)(fq0 + r) * dil + res;
    pg8::bf16x8 qf[4];
    { const bf16* qrow = P1 + tokq * NP1 + qcol + 8 * hf;
#pragma unroll
      for (int s_ = 0; s_ < 4; ++s_) qf[s_] = *(const pg8::bf16x8*)(qrow + 16 * s_); }
    f32x16 sc[5];
#pragma unroll
    for (int kt = 0; kt < 5; ++kt) {
        int fk = fq0 - 128 + 32 * kt + pr; fk = fk < 0 ? 0 : fk;
        const bf16* krow = P1 + ((size_t)b * SEQ + (size_t)fk * dil + res) * NP1 + kcol + 8 * hf;
        f32x16 acc;
#pragma unroll
        for (int q = 0; q < 16; ++q) acc[q] = 0.f;
#pragma unroll
        for (int s_ = 0; s_ < 4; ++s_) { const pg8::bf16x8 a = *(const pg8::bf16x8*)(krow + 16 * s_); acc = __builtin_amdgcn_mfma_f32_32x32x16_bf16(a, qf[s_], acc, 0, 0, 0); }
        sc[kt] = acc;
    }
    float mx = -1e30f;
#pragma unroll
    for (int kt = 0; kt < 5; ++kt)
#pragma unroll
        for (int q = 0; q < 16; ++q) { const int koff = (q & 3) + 4 * ((q >> 2) & 1) + 16 * (q >> 3);
            const float sv = sc[kt][q] * 0.125f + lut[32 * kt + koff]; sc[kt][q] = sv; }
    if (fq0 < 128) {
#pragma unroll
        for (int kt = 0; kt < 5; ++kt)
#pragma unroll
            for (int q = 0; q < 16; ++q) { const int koff = (q & 3) + 4 * ((q >> 2) & 1) + 16 * (q >> 3) + 8 * hf; if (fq0 - 128 + 32 * kt + koff < 0) sc[kt][q] = -1e30f; }
    }
#pragma unroll
    for (int kt = 0; kt < 5; ++kt)
#pragma unroll
        for (int q = 0; q < 16; ++q) mx = fmaxf(mx, sc[kt][q]);
    mx = fmaxf(mx, __shfl_xor(mx, 32));
    const float sink = isA ? sinks[hh] : -1e30f;
    mx = fmaxf(mx, sink);
    float lsum = 0.f;
#pragma unroll
    for (int kt = 0; kt < 5; ++kt)
#pragma unroll
        for (int q = 0; q < 16; ++q) { const float pv = __expf(sc[kt][q] - mx); sc[kt][q] = pv; lsum += pv; }
    lsum += __shfl_xor(lsum, 32);
    const float denom = isA ? lsum + __expf(sink - mx) : lsum;
    const float inv = 1.0f / denom;
    pg8::bf16x8 pf[5][2];
#pragma unroll
    for (int kt = 0; kt < 5; ++kt)
#pragma unroll
        for (int s_ = 0; s_ < 2; ++s_) { pg8::u32x4 w;
            w.x = pg8::cvt_pk_bf16(sc[kt][8 * s_ + 0], sc[kt][8 * s_ + 1]); w.y = pg8::cvt_pk_bf16(sc[kt][8 * s_ + 2], sc[kt][8 * s_ + 3]);
            w.z = pg8::cvt_pk_bf16(sc[kt][8 * s_ + 4], sc[kt][8 * s_ + 5]); w.w = pg8::cvt_pk_bf16(sc[kt][8 * s_ + 6], sc[kt][8 * s_ + 7]);
            pf[kt][s_] = __builtin_bit_cast(pg8::bf16x8, w); }
    bf16* outp; int out_ld, ocol;
    if (isA) { outp = (bf16*)(ws + WS_YA); out_ld = 1536; ocol = hh * 64; } else { outp = (bf16*)(ws + WS_OC) + (size_t)gi * M * 256; out_ld = 256; ocol = j * 64; }
    const bf16* vth = VT + ((size_t)(hs * 2 + b) * 64) * SEQ + (size_t)res * Lf;
#pragma unroll
    for (int dt = 0; dt < 2; ++dt) {
        const bf16* vrow = vth + (size_t)(32 * dt + r) * SEQ;
        f32x16 acc;
#pragma unroll
        for (int q = 0; q < 16; ++q) acc[q] = 0.f;
#pragma unroll
        for (int kt = 0; kt < 5; ++kt)
#pragma unroll
            for (int s_ = 0; s_ < 2; ++s_) {
                int k0 = fq0 - 128 + 32 * kt + 16 * s_ + 8 * hf; k0 = k0 < 0 ? 0 : k0;
                acc = __builtin_amdgcn_mfma_f32_32x32x16_bf16(*(const pg8::bf16x8*)(vrow + k0), pf[kt][s_], acc, 0, 0, 0);
            }
        bf16* op = outp + tokq * out_ld + ocol + 32 * dt + 4 * hf;
#pragma unroll
        for (int g = 0; g < 4; ++g) { v2u w; w.x = pg8::cvt_pk_bf16(acc[4 * g + 0] * inv, acc[4 * g + 1] * inv); w.y = pg8::cvt_pk_bf16(acc[4 * g + 2] * inv, acc[4 * g + 3] * inv);
            *(v2u*)(op + 8 * g) = w; }
    }
    if (!isA && hf == 0) ((float*)(ws + WS_LSE))[((size_t)gi * M + tokq) * 4 + j] = mx + __logf(lsum);
}
__device__ __forceinline__ void build_lut(const Ctx& C, const float* relb) {
    LAS float* lut = (LAS float*)(C.lds + LUT_OFF);
    for (int i = C.tid; i < 20 * 192; i += NTHREADS) { const int hh = i / 192, x = i % 192; const int tbl = hh < 8 ? 0 : (hh - 8) >> 2; const int dist = 159 - x; const int maxsteps = hh < 8 ? 127 : 128;
        lut[i] = (dist >= 0 && dist <= maxsteps) ? relb[(int)T5B[tbl][dist] * 20 + hh] : -1e30f; }
    __syncthreads();
}

__device__ __forceinline__ void phase_post(const Ctx& C, const Args& a, int l, unsigned char* ws) {
    const float* SV = (const float*)(ws + WS_SV); const float* BON = (const float*)(ws + WS_BON); const float* COP = (const float*)(ws + WS_COP);
    const float* LO = (const float*)(ws + WS_LO); bf16* YB = (bf16*)(ws + WS_YA);
    const float* lgp = a.in[14] + (size_t)l * BW; const float* lbp = a.in[15] + (size_t)l * BW;
    const int lane = C.lane, li = lane & 15, q = lane >> 4;
    for (int it = C.gw; it < 24 * 512; it += C.ngw) {
        const int hs = it >> 9, c = it & 511, b = hs / 12, h = hs % 12; const int m0 = b * SEQ + c * 16;
        const float* rec = COP + ((size_t)hs * 512 + c) * COP_STRIDE; const float* sst = sst_base(ws, hs) + (size_t)c * 4096 + (size_t)lane * 16;
        f32x4 ryf[4]; const f32x4 y0f = *(const f32x4*)(rec + COP_Y0 + lane * 4);
#pragma unroll
        for (int m = 0; m < 4; ++m) ryf[m] = *(const f32x4*)(rec + COP_RY + lane * 16 + 4 * m);
        f32x4c y[4]; float vv[4][4];
#pragma unroll
        for (int vs = 0; vs < 4; ++vs) {
            f32x4 st[4];
#pragma unroll
            for (int m = 0; m < 4; ++m) st[m] = *(const f32x4*)(sst + (size_t)vs * 1024 + 4 * m);
#pragma unroll
            for (int s_ = 0; s_ < 4; ++s_) vv[vs][s_] = SV[(size_t)(m0 + 4 * q + s_) * BW + h * 64 + 16 * vs + li];
            f32x4c acc = {0.f, 0.f, 0.f, 0.f};
#pragma unroll
            for (int m = 0; m < 4; ++m)
#pragma unroll
                for (int j = 0; j < 4; ++j) acc = MFMA4(ryf[m][j], st[m][j], acc);
#pragma unroll
            for (int s_ = 0; s_ < 4; ++s_) acc = MFMA4(y0f[s_], vv[vs][s_], acc);
            y[vs] = acc;
        }
        float lg[4], lb[4];
#pragma unroll
        for (int vs = 0; vs < 4; ++vs) { lg[vs] = lgp[h * 64 + 16 * vs + li]; lb[vs] = lbp[h * 64 + 16 * vs + li]; }
#pragma unroll
        for (int j = 0; j < 4; ++j) {
            const int m = m0 + 4 * q + j;
            const float mean = red16((y[0][j] + y[1][j]) + (y[2][j] + y[3][j])) * (1.0f / 64.0f);
            const float d0 = y[0][j] - mean, d1 = y[1][j] - mean, d2 = y[2][j] - mean, d3 = y[3][j] - mean;
            const float var = red16((d0 * d0 + d1 * d1) + (d2 * d2 + d3 * d3)) * (1.0f / 64.0f);
            const float rsd = __builtin_amdgcn_rsqf(var + GN_EPS); const float bo = BON[(size_t)m * 12 + h];
            const float* gp = LO + (size_t)m * NLORA + 2 * BW + h * 64 + li; bf16* op = YB + (size_t)m * 1536 + 512 + h * 64 + li;
            op[0] = (bf16)f2bf((d0 * rsd * lg[0] + lb[0] + vv[0][j] * bo) * gp[0]); op[16] = (bf16)f2bf((d1 * rsd * lg[1] + lb[1] + vv[1][j] * bo) * gp[16]);
            op[32] = (bf16)f2bf((d2 * rsd * lg[2] + lb[2] + vv[2][j] * bo) * gp[32]); op[48] = (bf16)f2bf((d3 * rsd * lg[3] + lb[3] + vv[3][j] * bo) * gp[48]);
        }
    }
    const bf16* OC = (const bf16*)(ws + WS_OC); const float* LSE = (const float*)(ws + WS_LSE); bf16* YC = (bf16*)(ws + WS_YA);
    for (int mb = C.gw * 4; mb < M; mb += C.ngw * 4) {
        const int j = C.lane >> 4;
        float l0[4], l1[4], l2[4]; v2u a0[4], a1[4], a2[4];
#pragma unroll
        for (int i = 0; i < 4; ++i) { const int m = mb + i; l0[i] = LSE[(size_t)m * 4 + j]; l1[i] = LSE[((size_t)M + m) * 4 + j]; l2[i] = LSE[((size_t)2 * M + m) * 4 + j];
            a0[i] = *(const v2u*)(OC + (size_t)m * 256 + 4 * C.lane); a1[i] = *(const v2u*)(OC + ((size_t)M + m) * 256 + 4 * C.lane); a2[i] = *(const v2u*)(OC + ((size_t)2 * M + m) * 256 + 4 * C.lane); }
#pragma unroll
        for (int i = 0; i < 4; ++i) { const int m = mb + i;
            const float mx = fmaxf(l0[i], fmaxf(l1[i], l2[i])); const float e0 = __expf(l0[i] - mx), e1 = __expf(l1[i] - mx), e2 = __expf(l2[i] - mx); const float inv = 1.0f / (e0 + e1 + e2);
            const float w0 = e0 * inv, w1 = e1 * inv, w2 = e2 * inv;
            v2u o; o.x = pk2(w0 * bflo(a0[i].x) + w1 * bflo(a1[i].x) + w2 * bflo(a2[i].x), w0 * bfhi(a0[i].x) + w1 * bfhi(a1[i].x) + w2 * bfhi(a2[i].x));
            o.y = pk2(w0 * bflo(a0[i].y) + w1 * bflo(a1[i].y) + w2 * bflo(a2[i].y), w0 * bfhi(a0[i].y) + w1 * bfhi(a1[i].y) + w2 * bfhi(a2[i].y));
            *(v2u*)(YC + (size_t)m * 1536 + 1280 + 4 * C.lane) = o; }
    }
}

__device__ __forceinline__ void unpack8(const v4u w, float (&x)[8]) { x[0] = bflo(w.x); x[1] = bfhi(w.x); x[2] = bflo(w.y); x[3] = bfhi(w.y); x[4] = bflo(w.z); x[5] = bfhi(w.z); x[6] = bflo(w.w); x[7] = bfhi(w.w); }
__device__ __forceinline__ void phase_conv(const Ctx& C, const Args& a, int l, unsigned char* ws) {
    const bf16* U = (const bf16*)(ws + WS_U); bf16* ACT = (bf16*)(ws + WS_ACT); const float* cw = a.in[22] + (size_t)l * 3 * DFF;
    constexpr int GPR = DFF / 8, RUN = 32;
    const int gt = C.bid * NTHREADS + C.tid, ngt = C.G * NTHREADS;
    for (int idx = gt; idx < (M / RUN) * GPR; idx += ngt) {
        const int run = idx / GPR, f0 = (idx % GPR) * 8, m0 = run * RUN;
        float c0[8], c1[8], c2[8];
#pragma unroll
        for (int j = 0; j < 8; ++j) { c0[j] = cw[f0 + j]; c1[j] = cw[DFF + f0 + j]; c2[j] = cw[2 * DFF + f0 + j]; }
        const bf16* ur = U + (size_t)m0 * NUP + f0;
        float x0[8], x1[8];
        { v4u g0 = (v4u){0u, 0u, 0u, 0u}, g1 = (v4u){0u, 0u, 0u, 0u};
          if ((m0 & (SEQ - 1)) != 0) { g0 = *(const v4u*)(ur - 2 * NUP); g1 = *(const v4u*)(ur - NUP); }
          unpack8(g0, x0); unpack8(g1, x1); }
#pragma unroll 1
        for (int tq = 0; tq < RUN; tq += 4) {
            v4u gq[4], vq[4];
#pragma unroll
            for (int i = 0; i < 4; ++i) { gq[i] = *(const v4u*)(ur + (size_t)(tq + i) * NUP); vq[i] = *(const v4u*)(ur + (size_t)(tq + i) * NUP + DFF); }
#pragma unroll
            for (int i = 0; i < 4; ++i) {
                float x2[8], vl[8], r[8]; unpack8(gq[i], x2); unpack8(vq[i], vl);
#pragma unroll
                for (int j = 0; j < 8; ++j) { const float gsum = c0[j] * x0[j] + c1[j] * x1[j] + c2[j] * x2[j]; r[j] = gsum / (1.0f + __expf(-gsum)) * vl[j]; x0[j] = x1[j]; x1[j] = x2[j]; }
                v4u o; o.x = pk2(r[0], r[1]); o.y = pk2(r[2], r[3]); o.z = pk2(r[4], r[5]); o.w = pk2(r[6], r[7]);
                *(v4u*)(ACT + (size_t)(m0 + tq + i) * DFF + f0) = o;
            }
        }
    }
}

__device__ __forceinline__ Ctx make_ctx(unsigned char* lds) {
    Ctx C;
    C.lds = (LAS unsigned char*)lds;
    int t = threadIdx.x; asm volatile("" : "+v"(t));
    C.tid = t; C.lane = C.tid & 63; C.wave = __builtin_amdgcn_readfirstlane(C.tid >> 6);
    C.G = gridDim.x; C.bid = blockIdx.x; C.gw = C.bid * NWAVES + C.wave; C.ngw = C.G * NWAVES;
    return C;
}
template <int K> __device__ __forceinline__ void run_phase(unsigned char* lds, const Args& args, int l) {
    const Ctx C = make_ctx(lds);
    size_t wsz_ = 0; asm volatile("" : "+s"(wsz_)); unsigned char* ws = args.ws + wsz_;
    unsigned char* wsw = ws + (size_t)(l & 1) * WSET_STRIDE; LAS unsigned char* ring = C.lds + RING_OFF; float* out = args.out;
    const float* xsrc = (l == 0) ? args.in[0] : out;
    if constexpr (K == 0) { phase_prep(C, args, l, xsrc, ws); }
    if constexpr (K == 1) { pg8::Gemm g{(const bf16*)(ws + WS_H), (const bf16*)(wsw + WS_WIN), M, NP1, D}; pg8::StaticOrder S; S.init(M, NP1, C.G, C.bid);
        pg8::EpiWin E{(bf16*)(ws + WS_P1), (bf16*)(ws + WS_G), 0};
        pg8::gemm_phase<pg8::EpiWin, pg8::StaticOrder, true, true>(ring, g, S, E); }
    if constexpr (K == 2) { phase_aprime(C, args, l, ws); phase_vt(C, ws); }
    if constexpr (K == 3) { pg8::Gemm g{(const bf16*)(ws + WS_AP), (const bf16*)(wsw + WS_WLORA), M, NLORA, KLORA}; pg8::StaticOrder S; S.init(M, NLORA, C.G, C.bid);
        pg8::EpiF32P E{(float*)(ws + WS_LO), NLORA};
        pg8::gemm_phase<pg8::EpiF32P, pg8::StaticOrder, true, true>(ring, g, S, E); }
    if constexpr (K == 4) { phase_chunkprep(C, args, l, ws); }
    if constexpr (K == 5) {
        const int xg = C.bid & 7, jj = C.bid >> 3;
        if (jj < 3) {
            if (C.tid < 16) ((LAS unsigned*)(C.lds + CH_FLAGS))[C.tid] = 0u;
            __syncthreads();
            const int hs = xg * 3 + jj;
            if (C.wave < 4) scan_chain(C.lane, C.wave, C.lds, hs, ws);
            else chain_loader(C.lane, C.wave - 4, C.lds, hs, ws);
        } else {
            const int gidx = (jj - 3) * 8 + xg;
            build_lut(C, args.in[1]);
            { const float* sinks = args.in[4] + l * 8;
              for (int rep = 0; rep < EXP_ATTN_REPS; ++rep) for (int it = gidx * 8 + C.wave; it < 512 * 20; it += 1856) attn_wave_item(C.lane, (const LAS float*)(C.lds + LUT_OFF), it, sinks, ws); }
            __syncthreads();
            for (int rep = 0; rep < EXP_GATE_REPS; ++rep) { pg8::Gemm g{(const bf16*)(ws + WS_H), (const bf16*)(wsw + WS_WIN) + (size_t)NP1 * D, M, NG, D}; pg8::StaticOrder S; S.init(M, NG, 232, gidx);
              pg8::EpiWin E{(bf16*)(ws + WS_P1), (bf16*)(ws + WS_G), 23};
              pg8::gemm_phase<pg8::EpiWin, pg8::StaticOrder, true, true>(ring, g, S, E); }
            if (l + 1 < DEPTH) convert_weights(gidx * 8 + C.wave, 1856, C.lane, (LAS float*)(C.lds + RING_OFF + C.wave * 16384), args, l + 1, ws);
        } }
    if constexpr (K == 6) { phase_post(C, args, l, ws); }
    if constexpr (K == 7) { pg8::Gemm g{(const bf16*)(ws + WS_YA), (const bf16*)(wsw + WS_PA), M, D, 1536}; pg8::StaticOrder S; S.init(M, D, C.G, C.bid);
        pg8::EpiGate3 E{(const bf16*)(ws + WS_G), (bf16*)(ws + WS_MG), 8, 20};
        pg8::gemm_phase<pg8::EpiGate3, pg8::StaticOrder, true, true>(ring, g, S, E); }
    if constexpr (K == 8) { pg8::Gemm g{(const bf16*)(ws + WS_MG), (const bf16*)(wsw + WS_WOUT), M, D, D}; pg8::StaticOrder S; S.init(M, D, C.G, C.bid);
        pg8::EpiResid E{xsrc, out};
        pg8::gemm_phase<pg8::EpiResid, pg8::StaticOrder, true, true>(ring, g, S, E); }
    if constexpr (K == 9) { const float* g2 = args.in[20] + (size_t)l * D; bf16* H = (bf16*)(ws + WS_H);
        for (int m = 2 * C.gw; m < M; m += 2 * C.ngw) rms_row2_bf16(out + (size_t)m * D, g2, H + (size_t)m * D, C.lane); }
    if constexpr (K == 10) { pg8::Gemm g{(const bf16*)(ws + WS_H) - 2 * D, (const bf16*)(wsw + WS_WUP), 65 * 256, NUP, D}; pg8::StaticOrder S; S.init(65 * 256, NUP, C.G, C.bid);
        pg8::EpiConv E{(bf16*)(ws + WS_ACT), args.in[22] + (size_t)l * 3 * DFF, (PG8_LAS float*)(C.lds + 131072)};
        pg8::gemm_phase<pg8::EpiConv, pg8::StaticOrder, true, true>(ring, g, S, E); }
    if constexpr (K == 12) { pg8::Gemm g{(const bf16*)(ws + WS_ACT), (const bf16*)(wsw + WS_WDOWN), M, D, DFF}; pg8::StaticOrder S; S.init(M, D, C.G, C.bid);
        pg8::EpiResid E{out, out};
        pg8::gemm_phase<pg8::EpiResid, pg8::StaticOrder, true, true>(ring, g, S, E); }
    if constexpr (K == 13) { const float* gf = args.in[24];
        for (int m = C.gw; m < M; m += C.ngw) rms_row_f32(out + (size_t)m * D, gf, C.lane); }
}
template <int K> __global__ void __launch_bounds__(NTHREADS, 2) fwd_phase(Args args) {
    extern __shared__ __attribute__((aligned(16))) unsigned char lds[];
    run_phase<K>(lds, args, args.li);
}
#ifndef EXP_BAR_REPS
#define EXP_BAR_REPS 1
#endif
#define XBAR(b) do { for (int r_ = 0; r_ < EXP_BAR_REPS; ++r_) xcd_barrier(b); } while (0)
__global__ void __launch_bounds__(NTHREADS, 2) fwd_all(Args args) {
    extern __shared__ __attribute__((aligned(16))) unsigned char lds[];
    { LAS unsigned* ctlw = (LAS unsigned*)((LAS unsigned char*)lds + LDSCTL_OFF); for (int u = threadIdx.x; u < (LDS_BYTES - LDSCTL_OFF) / 4; u += NTHREADS) ctlw[u] = 0u; }
    __syncthreads();
    const XcdBarrier bar = xcd_barrier_post((unsigned*)(args.ws + WS_CTL) + CW_BAR, (volatile LAS unsigned*)((LAS unsigned char*)lds + MISC_OFF) + 8);
    for (int l = 0; l < DEPTH; ++l) {
        for (int rep = 0; rep < (((EXP_EW_MASK >> 0) & 1) ? 2 : 1); ++rep) { run_phase<0>(lds, args, l); XBAR(bar); }
        for (int rep = 0; rep < EXP_G1_REPS; ++rep) { run_phase<1>(lds, args, l); XBAR(bar); }
        for (int rep = 0; rep < (((EXP_EW_MASK >> 2) & 1) ? 2 : 1); ++rep) { run_phase<2>(lds, args, l); XBAR(bar); }
        for (int rep = 0; rep < EXP_G3_REPS; ++rep) { run_phase<3>(lds, args, l); XBAR(bar); }
        for (int rep = 0; rep < (((EXP_EW_MASK >> 4) & 1) ? 2 : 1); ++rep) { run_phase<4>(lds, args, l); XBAR(bar); }
        run_phase<5>(lds, args, l); XBAR(bar);
        for (int rep = 0; rep < (((EXP_EW_MASK >> 6) & 1) ? 2 : 1); ++rep) { run_phase<6>(lds, args, l); XBAR(bar); }
        for (int rep = 0; rep < EXP_G7_REPS; ++rep) { run_phase<7>(lds, args, l); XBAR(bar); }
        run_phase<8>(lds, args, l); XBAR(bar);
        for (int rep = 0; rep < (((EXP_EW_MASK >> 9) & 1) ? 2 : 1); ++rep) { run_phase<9>(lds, args, l); XBAR(bar); }
        for (int rep = 0; rep < EXP_G10_REPS; ++rep) { run_phase<10>(lds, args, l); XBAR(bar); }
        run_phase<12>(lds, args, l); XBAR(bar);
    }
    run_phase<13>(lds, args, 0);
}

#ifndef MK_ONE_LAUNCH
#define MK_ONE_LAUNCH 1
#endif
template <int K> static void launch_phase(int grid, hipStream_t stream, Args a, int l) {
    static bool attr = false; if (!attr) { (void)hipFuncSetAttribute((const void*)fwd_phase<K>, hipFuncAttributeMaxDynamicSharedMemorySize, LDS_BYTES); attr = true; }
    a.li = l; a.ph_lo = K; a.ph_hi = K + 1;
    hipLaunchKernelGGL(fwd_phase<K>, dim3(grid), dim3(NTHREADS), LDS_BYTES, stream, a);
}
extern "C" void kernel_launch(void* const* d_in, const int* in_sizes, int n_in, void* d_out, int out_size, void* d_ws, size_t ws_size, hipStream_t stream) {
    static int grid = 0;
    if (grid == 0) {
        if (n_in != 25 || in_sizes[0] != M * D || out_size != M * D || ws_size < WS_END2) { fprintf(stderr, "kernel_launch: unexpected shapes (n_in %d, in0 %d, out %d, ws %zu < %zu)\n", n_in, n_in > 0 ? in_sizes[0] : -1, out_size, ws_size, (size_t)WS_END); grid = -1; return; }
        int dev = 0, cus = 0;
        if (hipGetDevice(&dev) != hipSuccess || hipDeviceGetAttribute(&cus, hipDeviceAttributeMultiprocessorCount, dev) != hipSuccess) { grid = -1; return; }
        grid = cus;
    }
    if (grid < 0) return;
    (void)hipMemsetAsync((char*)d_ws + WS_CTL, 0, CTL_ZERO_BYTES, stream);
    Args a{};
    for (int i = 0; i < 25; ++i) a.in[i] = (const float*)d_in[i];
    a.out = (float*)d_out; a.ws = (unsigned char*)d_ws; a.pad = 0;
#if MK_ONE_LAUNCH
    { static bool attr = false; if (!attr) { (void)hipFuncSetAttribute((const void*)fwd_all, hipFuncAttributeMaxDynamicSharedMemorySize, LDS_BYTES); attr = true; }
      a.li = 0; a.ph_lo = 0; a.ph_hi = NPHASES;
      hipLaunchKernelGGL(fwd_all, dim3(grid), dim3(NTHREADS), LDS_BYTES, stream, a); }
#else
    for (int l = 0; l < DEPTH; ++l) {
        launch_phase<0>(grid, stream, a, l); launch_phase<1>(grid, stream, a, l); launch_phase<2>(grid, stream, a, l); launch_phase<3>(grid, stream, a, l);
        launch_phase<4>(grid, stream, a, l); launch_phase<5>(grid, stream, a, l); launch_phase<6>(grid, stream, a, l); launch_phase<7>(grid, stream, a, l);
        launch_phase<8>(grid, stream, a, l); launch_phase<9>(grid, stream, a, l); launch_phase<10>(grid, stream, a, l); launch_phase<11>(grid, stream, a, l);
        launch_phase<12>(grid, stream, a, l);
    }
    launch_phase<13>(grid, stream, a, 0);
#endif
}
```

```cpp
#include <hip/hip_runtime.h>
#include <cstdio>
#include <cstdint>
#include <cmath>
#define GAS __attribute__((address_space(1)))
#define LAS __attribute__((address_space(3)))
namespace pg8 {
#define PG8_LAS __attribute__((address_space(3)))
typedef unsigned short bf16_t;
typedef short bf16x8 __attribute__((ext_vector_type(8)));
typedef float f32x4 __attribute__((ext_vector_type(4)));
typedef unsigned u32x4 __attribute__((ext_vector_type(4)));
constexpr int BM = 256, BK = 64, HALF = 128, HTB = HALF * BK * 2  , STAGE_BYTES = 8 * HTB, NXCD = 8, WGM = 8;

__host__ __device__ __forceinline__ int lds_byte(int r, int c) { const int st = (r >> 4) * 2 + (c >> 5), rr = r & 15, cc = c & 31, ob = rr * 64 + cc * 2; return st * 1024 + (ob ^ (((ob >> 9) & 1) << 5)); }
__host__ __device__ __forceinline__ void stage_rc(int b, int& R, int& C) { const int st = b / 1024, sb = b % 1024, swz = sb ^ (((sb >> 9) & 1) << 5); R = (st >> 1) * 16 + swz / 64; C = (st & 1) * 32 + (swz % 64) / 2; }
__host__ __device__ __forceinline__ int perm32(int rho) { const int n = rho >> 4, i = rho & 15; return 8 * (i >> 2) + 4 * n + (i & 3); }

struct Unit { int pm, pn; };
struct Gemm { const bf16_t* A; const bf16_t* Bt; int M, N, K; };

struct StaticOrder {
    int nM, nN, nwg, G, c;
    __host__ __device__ void init(int M, int N, int G_, int c_) { nM = M / BM; nN = N / BM; nwg = nM * nN; G = G_; c = c_; }
    __host__ __device__ bool next(int i, Unit& u) const {
        const long L = (long)i * G + c; if (L >= nwg) return false;
        int wgid = (int)L; { const int q = nwg / NXCD, r = nwg % NXCD, xcd = wgid % NXCD, off = wgid / NXCD; wgid = (xcd < r ? xcd * (q + 1) : r * (q + 1) + (xcd - r) * q) + off; }
        const int nig = WGM * nN, gid = wgid / nig, fm = gid * WGM, gsz = (nM - fm) < WGM ? (nM - fm) : WGM;
        u.pm = fm + ((wgid % nig) % gsz); u.pn = (wgid % nig) / gsz; return true;
    }
    __device__ __forceinline__ void a_ready(const Unit&) const {}
    __device__ __forceinline__ void done(const Unit&) const {}
};
__device__ __forceinline__ unsigned cvt_pk_bf16(float lo, float hi) { unsigned r; asm volatile("v_cvt_pk_bf16_f32 %0, %1, %2" : "=v"(r) : "v"(lo), "v"(hi)); return r; }
template <class Epi, class Sched, bool ALIGN_EPI = false, bool SP2 = false>
__device__ __forceinline__ void gemm_phase(PG8_LAS unsigned char* lds, const Gemm g, const Sched& S, const Epi& E) {
    int tid_ = threadIdx.x; asm volatile("" : "+v"(tid_));
    const int tid = tid_, wid = __builtin_amdgcn_readfirstlane(tid >> 6), lane = tid & 63, wr = wid >> 2, wc = wid & 3, fr = lane & 15, fq = lane >> 4;
    const int K = g.K, nt = K / BK;
    unsigned voffA[2], voffB[2];
#pragma unroll
    for (int i = 0; i < 2; ++i) { int R, C; stage_rc(tid * 16 + i * 8192, R, C); const int Rb = Epi::PERM ? ((R & ~31) + perm32(R & 31)) : R;
        voffA[i] = (unsigned)(R * K + C) * 2u; voffB[i] = (unsigned)(Rb * K + C) * 2u; }
    const size_t kstep = (size_t)(BK * 2);
    const size_t hstep = (size_t)HALF * K * 2;
    const size_t tstep = 2 * hstep;
    const size_t tstepA = (size_t)Epi::A_ROWS * K * 2;
    const unsigned ldsw = (unsigned)wid * 1024u;
    const int aoff = lds_byte(wr * 64 + fr, fq * 8), boff = lds_byte(wc * 32 + fr, fq * 8);
#define PG8_SA(b, h) (((b) * 2 + (h)) * HTB)
#define PG8_SB(b, h) ((4 + (b) * 2 + (h)) * HTB)
#define PG8_STAGE(bufoff, gbase, voff) do { _Pragma("unroll") for (int _i = 0; _i < 2; ++_i) \
        __builtin_amdgcn_global_load_lds((const unsigned*)((const char*)(gbase) + (voff)[_i]), (PG8_LAS unsigned*)(lds + (bufoff) + ldsw + _i * 8192), 16, 0, 0); } while (0)
#define PG8_LDA(dst, b, h) do { _Pragma("unroll") for (int m = 0; m < 4; ++m) _Pragma("unroll") for (int k = 0; k < 2; ++k) dst[m][k] = *(const PG8_LAS bf16x8*)(lds + PG8_SA(b, h) + aoff + m * 2048 + k * 1024); } while (0)
#define PG8_LDB(dst, b, h) do { _Pragma("unroll") for (int n = 0; n < 2; ++n) _Pragma("unroll") for (int k = 0; k < 2; ++k) dst[n][k] = *(const PG8_LAS bf16x8*)(lds + PG8_SB(b, h) + boff + n * 2048 + k * 1024); } while (0)
#define PG8_MMA(ai, bj, At, Bt) do { __builtin_amdgcn_s_setprio(1); _Pragma("unroll") for (int m = 0; m < 4; ++m) _Pragma("unroll") for (int n = 0; n < 2; ++n) _Pragma("unroll") for (int k = 0; k < 2; ++k) \
        acc[ai][bj][m][n] = __builtin_amdgcn_mfma_f32_16x16x32_bf16(Bt[n][k], At[m][k], acc[ai][bj][m][n], 0, 0, 0); __builtin_amdgcn_s_setprio(0); } while (0)
#define PG8_WAIT_V(n) asm volatile("s_waitcnt vmcnt(" #n ")" ::: "memory")
#define PG8_WAIT_L(n) asm volatile("s_waitcnt lgkmcnt(" #n ")" ::: "memory")
#define PG8_BAR __builtin_amdgcn_s_barrier()
#define PG8_SCHED __builtin_amdgcn_sched_barrier(0)
    Unit cur, nxt; int ui = 0;
    if (!S.next(0, cur)) return;
    f32x4 acc[2][2][4][2];
#pragma unroll
    for (int a = 0; a < 2; ++a)
#pragma unroll
        for (int b = 0; b < 2; ++b)
#pragma unroll
            for (int m = 0; m < 4; ++m)
#pragma unroll
                for (int n = 0; n < 2; ++n) acc[a][b][m][n] = (f32x4){0.f, 0.f, 0.f, 0.f};
    bf16x8 At[4][2], B0[2][2], B1[2][2];
    const char* cA = (const char*)g.A + (size_t)cur.pm * tstepA; const char* cB = (const char*)g.Bt + (size_t)cur.pn * tstep;
    S.a_ready(cur);
    if constexpr (SP2) {
        PG8_STAGE(PG8_SB(0, 0), cB, voffB); PG8_STAGE(PG8_SB(0, 1), cB + hstep, voffB); PG8_STAGE(PG8_SA(0, 0), cA, voffA); PG8_STAGE(PG8_SA(0, 1), cA + hstep, voffA);
        if (wr == 1) PG8_BAR;
        PG8_WAIT_V(2); PG8_BAR;
        PG8_STAGE(PG8_SB(1, 0), cB + kstep, voffB); PG8_STAGE(PG8_SA(1, 0), cA + kstep, voffA); PG8_STAGE(PG8_SB(1, 1), cB + hstep + kstep, voffB);
        PG8_WAIT_V(6); PG8_BAR;
    } else {
        PG8_STAGE(PG8_SB(0, 0), cB, voffB); PG8_STAGE(PG8_SA(0, 0), cA, voffA); PG8_STAGE(PG8_SB(0, 1), cB + hstep, voffB); PG8_STAGE(PG8_SA(0, 1), cA + hstep, voffA);
        if (wr == 1) PG8_BAR;
        PG8_WAIT_V(4); PG8_BAR;
        PG8_STAGE(PG8_SB(1, 0), cB + kstep, voffB); PG8_STAGE(PG8_SA(1, 0), cA + kstep, voffA); PG8_STAGE(PG8_SB(1, 1), cB + hstep + kstep, voffB);
        PG8_WAIT_V(6); PG8_BAR;
    }
    for (;;) {
        const bool has_next = S.next(ui + 1, nxt);
        const char* nA = has_next ? (const char*)g.A + (size_t)nxt.pm * tstepA : cA; const char* nB = has_next ? (const char*)g.Bt + (size_t)nxt.pn * tstep : cB;
        for (int t = 0; t < nt; t += 2) {
            const bool last = (t == nt - 2);
            const char* a1 = cA + (size_t)(t + 1) * kstep;
            const char* a2 = last ? nA : cA + (size_t)(t + 2) * kstep; const char* b2 = last ? nB : cB + (size_t)(t + 2) * kstep;
            const char* a3 = a2 + kstep; const char* b3 = b2 + kstep;
            if (last && has_next) S.a_ready(nxt);
            if constexpr (Epi::HAS_SEG) { if (t == E.t1 || t == E.t2) E.seg(acc, cur, t, wr, wc, fr, fq); }
            if constexpr (SP2) {
            PG8_LDB(B0, 0, 0); PG8_LDB(B1, 0, 1); PG8_SCHED; PG8_LDA(At, 0, 0); PG8_STAGE(PG8_SA(1, 1), a1 + hstep, voffA);
            PG8_WAIT_V(8); PG8_WAIT_L(0); PG8_BAR; PG8_MMA(0, 0, At, B0); PG8_MMA(0, 1, At, B1); PG8_BAR; PG8_SCHED;
            PG8_LDA(At, 0, 1); PG8_STAGE(PG8_SB(0, 0), b2, voffB); PG8_STAGE(PG8_SB(0, 1), b2 + hstep, voffB); PG8_STAGE(PG8_SA(0, 0), a2, voffA);
            PG8_WAIT_V(8); PG8_WAIT_L(0); PG8_BAR; PG8_MMA(1, 0, At, B0); PG8_MMA(1, 1, At, B1); PG8_BAR; PG8_SCHED;
            PG8_LDB(B0, 1, 0); PG8_LDB(B1, 1, 1); PG8_SCHED; PG8_LDA(At, 1, 0); PG8_STAGE(PG8_SA(0, 1), a2 + hstep, voffA);
            PG8_WAIT_V(8); PG8_WAIT_L(0); PG8_BAR; PG8_MMA(0, 0, At, B0); PG8_MMA(0, 1, At, B1); PG8_BAR; PG8_SCHED;
            PG8_LDA(At, 1, 1); PG8_STAGE(PG8_SB(1, 0), b3, voffB); PG8_STAGE(PG8_SB(1, 1), b3 + hstep, voffB); PG8_STAGE(PG8_SA(1, 0), a3, voffA);
            PG8_WAIT_V(8); PG8_WAIT_L(0); PG8_BAR; PG8_MMA(1, 0, At, B0); PG8_MMA(1, 1, At, B1); PG8_BAR; PG8_SCHED;
            } else {
            PG8_LDB(B0, 0, 0); PG8_SCHED; PG8_LDA(At, 0, 0); PG8_STAGE(PG8_SA(1, 1), a1 + hstep, voffA);
            PG8_WAIT_L(8); PG8_BAR; PG8_WAIT_L(0); PG8_MMA(0, 0, At, B0); PG8_BAR; PG8_SCHED;
            PG8_LDB(B1, 0, 1); PG8_STAGE(PG8_SB(0, 0), b2, voffB);
            PG8_BAR; PG8_WAIT_L(0); PG8_MMA(0, 1, At, B1); PG8_BAR;
            PG8_LDA(At, 0, 1); PG8_STAGE(PG8_SA(0, 0), a2, voffA);
            PG8_BAR; PG8_WAIT_L(0); PG8_MMA(1, 0, At, B0); PG8_BAR; PG8_SCHED;
            PG8_STAGE(PG8_SB(0, 1), b2 + hstep, voffB);
            PG8_WAIT_V(6); PG8_BAR; PG8_MMA(1, 1, At, B1); PG8_BAR;
            PG8_LDB(B0, 1, 0); PG8_SCHED; PG8_LDA(At, 1, 0); PG8_STAGE(PG8_SA(0, 1), a2 + hstep, voffA);
            PG8_WAIT_L(8); PG8_BAR; PG8_WAIT_L(0); PG8_MMA(0, 0, At, B0); PG8_BAR; PG8_SCHED;
            PG8_LDB(B1, 1, 1); PG8_STAGE(PG8_SB(1, 0), b3, voffB);
            PG8_BAR; PG8_WAIT_L(0); PG8_MMA(0, 1, At, B1); PG8_BAR;
            PG8_LDA(At, 1, 1); PG8_STAGE(PG8_SA(1, 0), a3, voffA);
            PG8_BAR; PG8_WAIT_L(0); PG8_MMA(1, 0, At, B0); PG8_BAR; PG8_SCHED;
            PG8_STAGE(PG8_SB(1, 1), b3 + hstep, voffB);
            PG8_WAIT_V(6); PG8_BAR; PG8_MMA(1, 1, At, B1); PG8_BAR;
            }
        }
        if constexpr (ALIGN_EPI) { if (wr == 0) PG8_BAR; }
        if constexpr (!Epi::AFTER_DRAIN) { E(acc, cur, wr, wc, fr, fq); S.done(cur); }
        if (!has_next) break;
#pragma unroll
        for (int a = 0; a < 2; ++a)
#pragma unroll
            for (int b = 0; b < 2; ++b)
#pragma unroll
                for (int m = 0; m < 4; ++m)
#pragma unroll
                    for (int n = 0; n < 2; ++n) acc[a][b][m][n] = (f32x4){0.f, 0.f, 0.f, 0.f};
        cur = nxt; cA = nA; cB = nB; ++ui;
        if constexpr (ALIGN_EPI) { if (wr == 1) PG8_BAR; }
    }
    PG8_WAIT_V(0);
    if constexpr (!ALIGN_EPI) { if (wr == 0) PG8_BAR; }
    PG8_BAR;
    if constexpr (Epi::AFTER_DRAIN) { E.fused(acc, cur, wr, wc, fr, fq, lds, wid, lane); S.done(cur); }
#undef PG8_SA
#undef PG8_SB
#undef PG8_STAGE
#undef PG8_LDA
#undef PG8_LDB
#undef PG8_MMA
#undef PG8_WAIT_V
#undef PG8_WAIT_L
#undef PG8_BAR
#undef PG8_SCHED
}
}
#define XB_TMO      128
#define XB_XCNT(j)  (256  + 64 * (j))
#define XB_XSUB(j)  (1280 + 64 * (j))
#define XB_XGEN(j)  (2304 + 64 * (j))
#define XB_TOP      3328
#define XB_TOPGEN   3392
#define XCD_BAR_WORDS 3456
#define XB_SPIN_CAP (1u << 18)

__device__ __forceinline__ unsigned xb_ld(unsigned* p)              { return __hip_atomic_load(p, __ATOMIC_RELAXED, __HIP_MEMORY_SCOPE_AGENT); }
__device__ __forceinline__ unsigned xb_add(unsigned* p, unsigned v) { return __hip_atomic_fetch_add(p, v, __ATOMIC_RELAXED, __HIP_MEMORY_SCOPE_AGENT); }
__device__ __forceinline__ unsigned xb_xcc_id() { return (unsigned)__builtin_amdgcn_s_getreg((3 << 11) | 20) & 0xFu; }
#define XB_SPIN(cond, bar) do { unsigned _sp = 0; while (cond) { __builtin_amdgcn_s_sleep(1); \
    if ((++_sp & 255u) == 0u) { if (xb_ld(&(bar)[XB_TMO])) break; if (_sp > XB_SPIN_CAP) { atomicAdd(&(bar)[XB_TMO], 1u); break; } } } } while (0)

struct XcdBarrier {
    unsigned* bar; unsigned x;
    volatile LAS unsigned* st;
};

__device__ __forceinline__ XcdBarrier xcd_barrier_post(unsigned* bar, volatile LAS unsigned* st) {
    XcdBarrier b; b.bar = bar; b.x = xb_xcc_id(); b.st = st;
    if (threadIdx.x == 0) (void)xb_add(&bar[XB_XCNT(b.x)], 1u);
    return b;
}
__device__ __forceinline__ void xcd_barrier_complete(unsigned* bar, unsigned x, unsigned& nloc, unsigned& nx) {
    const unsigned G = gridDim.x * gridDim.y * gridDim.z;
    unsigned sum, cnt, mine, sp = 0u;
    for (;;) {
        sum = 0u; cnt = 0u; mine = 0u;
#pragma unroll
        for (unsigned j = 0; j < 16; ++j) { const unsigned c = xb_ld(&bar[XB_XCNT(j)]); sum += c; cnt += (c > 0u) ? 1u : 0u; mine = (j == x) ? c : mine; }
        if (sum == G) break;
        __builtin_amdgcn_s_sleep(1);
        if ((++sp & 255u) == 0u) { if (xb_ld(&bar[XB_TMO])) break; if (sp > XB_SPIN_CAP) { atomicAdd(&bar[XB_TMO], 1u); break; } }
    }
    nloc = mine > 0u ? mine : 1u; nx = cnt > 0u ? cnt : 1u;
}

__device__ __forceinline__ void xcd_barrier(const XcdBarrier& b) {
    asm volatile("s_waitcnt vmcnt(0)" ::: "memory");
    __syncthreads();
    if (threadIdx.x == 0) {
        unsigned* bar = b.bar;
        __builtin_amdgcn_s_waitcnt(0);
        unsigned nloc = b.st[0], nx = b.st[1];
        if (nloc == 0u) { xcd_barrier_complete(bar, b.x, nloc, nx); b.st[0] = nloc; b.st[1] = nx; }
        const unsigned old = xb_add(&bar[XB_XSUB(b.x)], 1u);
        const unsigned gen = old / nloc;
        if (old + 1u == (gen + 1u) * nloc) {
            __builtin_amdgcn_fence(__ATOMIC_RELEASE, "agent");
            asm volatile("s_waitcnt vmcnt(0)" ::: "memory");
            const unsigned og = xb_add(&bar[XB_TOP], 1u);
            const unsigned tg = og / nx;
            if (og + 1u == (tg + 1u) * nx) xb_add(&bar[XB_TOPGEN], 1u);
            else XB_SPIN(xb_ld(&bar[XB_TOPGEN]) == tg, bar);
            __builtin_amdgcn_fence(__ATOMIC_ACQUIRE, "agent");
            xb_add(&bar[XB_XGEN(b.x)], 1u);
            asm volatile("s_waitcnt vmcnt(0)" ::: "memory");
        } else {
            XB_SPIN(xb_ld(&bar[XB_XGEN(b.x)]) == gen, bar);
            __builtin_amdgcn_fence(__ATOMIC_ACQUIRE, "agent");
            asm volatile("s_waitcnt vmcnt(0)" ::: "memory");
        }
    }
    __syncthreads();
}

constexpr int BATCH = 2, SEQ = 8192, M = BATCH * SEQ, D = 2048, DEPTH = 4;
constexpr int DIN = 11968, NP1 = 5888, NG = 6144, NWIN = NP1 + NG;
constexpr int BW = 768, BCOLS = 2752;
constexpr int C_AQ = 0, C_AK = 512, C_AV = 640, C_R = 768, C_K = 1536, C_V = 2304, C_WD = 3072, C_CQ = 3520, C_CK = 4288, C_CV = 5056, C_END = 5824;
constexpr int DFF = 5504, NUP = 2 * DFF;
constexpr int NLORA = 2304, KLORA = 512;
constexpr float NORM_EPS = 1e-5f, GN_EPS = 64e-5f;
constexpr int NWAVES = 8, NTHREADS = 512;
constexpr int NPH = 13;
constexpr int NPHASES = DEPTH * NPH + 1;
#ifndef EXP_EW_MASK
#define EXP_EW_MASK 0
#endif
#ifndef EXP_EW_REPS
#define EXP_EW_REPS 1
#endif
#ifndef EXP_G10_REPS
#define EXP_G10_REPS 1
#endif
#ifndef EXP_GATE_REPS
#define EXP_GATE_REPS 1
#endif
#ifndef EXP_G7_REPS
#define EXP_G7_REPS 1
#endif
#ifndef EXP_G3_REPS
#define EXP_G3_REPS 1
#endif
#ifndef EXP_G1_REPS
#define EXP_G1_REPS 1
#endif
#ifndef EXP_SCAN_REPS
#define EXP_SCAN_REPS 1
#endif
#ifndef EXP_ATTN_REPS
#define EXP_ATTN_REPS 1
#endif
constexpr int NSCAN = 48;

constexpr size_t MiB = 1u << 20;
constexpr size_t WS_CTL = 0, CTL_ZERO_BYTES = 1 * MiB;
constexpr size_t WS_WIN = 1 * MiB;
constexpr size_t WS_WLORA = 48 * MiB;
constexpr size_t WS_PA = 51 * MiB;
constexpr size_t WS_PB = 53 * MiB;
constexpr size_t WS_PC = 56 * MiB;
constexpr size_t WS_WOUT = 57 * MiB;
constexpr size_t WS_WUP = 65 * MiB;
constexpr size_t WS_WDOWN = 108 * MiB;
constexpr size_t WS_H = 130 * MiB;
constexpr size_t WS_P1 = 194 * MiB;
constexpr size_t WS_G = 378 * MiB;
constexpr size_t WS_U = WS_P1;
constexpr size_t WS_AP = 570 * MiB;
constexpr size_t WS_LO = 586 * MiB;
constexpr size_t WS_ACT = WS_LO;
constexpr size_t WS_SR = 730 * MiB;
constexpr size_t WS_SW = 778 * MiB, WS_SK = 826 * MiB, WS_SKK = 874 * MiB, WS_SB = 922 * MiB, WS_SV = 970 * MiB;
constexpr size_t WS_YRAW = 1018 * MiB;
constexpr size_t WS_YA = 1066 * MiB;
constexpr size_t WS_YB = 1082 * MiB;
constexpr size_t WS_YC = 1106 * MiB;
constexpr size_t WS_OC = 1114 * MiB;
constexpr size_t WS_LSE = 1138 * MiB;
constexpr size_t WS_MG = 1139 * MiB;
constexpr size_t WS_BK = 1203 * MiB;
constexpr size_t WS_VT = 1205 * MiB;
constexpr size_t WS_W2 = 1235 * MiB;
constexpr size_t WSET_STRIDE = WS_W2 - WS_WIN;
constexpr size_t WS_BON = 1365 * MiB;
constexpr size_t WS_END = 1366 * MiB;
constexpr size_t WS_SST_A = 1366 * MiB, WS_SST_B = WS_MG;
constexpr size_t WS_END2 = 1494 * MiB;
constexpr size_t WS_COP = WS_SR;
constexpr int COP_W1 = 0, COP_U0 = 1024, COP_BK = 1536, COP_GAM = 3584, COP_RY = 3648, COP_Y0 = 4672, COP_STRIDE = 4928;
constexpr int CW_BAR = 4096;

constexpr int RING_OFF = 0, RING_BYTES = 131072;
constexpr int LDSCTL_OFF = 141312, MISC_OFF = LDSCTL_OFF + 320;
constexpr int LDS_BYTES = 147456;
constexpr int LUT_OFF = 0, SCANRING_OFF = 12288, CONV_SCR_SCAN = 77824, CONV_SCR_OTHER = 12288;

typedef unsigned short bf16;
typedef unsigned v4u __attribute__((ext_vector_type(4)));
typedef unsigned v2u __attribute__((ext_vector_type(2)));
typedef float f32x4 __attribute__((ext_vector_type(4)));
#define LDS_WAIT() asm volatile("s_waitcnt lgkmcnt(0)" ::: "memory")

__device__ __forceinline__ unsigned f2bf(float f) { unsigned u = __builtin_bit_cast(unsigned, f); return (u + 0x7fffu + ((u >> 16) & 1u)) >> 16; }
__device__ __forceinline__ unsigned pk2(float lo, float hi) { return f2bf(lo) | (f2bf(hi) << 16); }
__device__ __forceinline__ float bflo(unsigned w) { return __builtin_bit_cast(float, w << 16); }
__device__ __forceinline__ float bfhi(unsigned w) { return __builtin_bit_cast(float, w & 0xffff0000u); }
__device__ __forceinline__ float bf1(bf16 h) { return __builtin_bit_cast(float, ((unsigned)h) << 16); }
__device__ __forceinline__ float sigmoidf_(float x) { return 1.0f / (1.0f + __expf(-x)); }
__device__ __forceinline__ float shx(float x, int mask, int lane) { return __builtin_bit_cast(float, __builtin_amdgcn_ds_bpermute((lane ^ mask) << 2, __builtin_bit_cast(int, x))); }
__device__ __forceinline__ float wave_sum(float v, int lane) {
#pragma unroll
    for (int o = 1; o < 64; o <<= 1) v += shx(v, o, lane);
    return v;
}
template <int CTRL> __device__ __forceinline__ float dppf(float x) { return __builtin_bit_cast(float, __builtin_amdgcn_update_dpp(0, __builtin_bit_cast(int, x), CTRL, 0xF, 0xF, true)); }
__device__ __forceinline__ float red4(float x) { x += dppf<0xB1>(x); x += dppf<0x4E>(x); return x; }
__device__ __forceinline__ float red16(float x) { x = red4(x); x += dppf<0x141>(x); x += dppf<0x140>(x); return x; }
__device__ __forceinline__ float wsum(float x, int lane) { x = red16(x); x += shx(x, 16, lane); x += shx(x, 32, lane); return x; }

__device__ const unsigned char T5B[3][132] = {
 {0,1,2,3,4,5,6,7,8,9,10,11,12,13,14,15,16,16,16,16,16,16,17,17,17,17,17,17,17,17,18,18,18,18,18,18,18,18,18,18,19,19,19,19,19,19,19,19,19,19,19,19,19,19,20,20,20,20,20,20,20,20,20,20,20,20,20,20,20,20,20,20,20,21,21,21,21,21,21,21,21,21,21,21,21,21,21,21,21,21,21,21,21,21,21,21,21,21,21,22,22,22,22,22,22,22,22,22,22,22,22,22,22,22,22,22,22,22,22,22,22,22,22,22,22,22,22,22,22,0,0,0},
 {0,4,8,12,16,16,17,17,18,18,19,19,19,19,20,20,20,20,20,21,21,21,21,21,21,22,22,22,22,22,22,22,22,22,23,23,23,23,23,23,23,23,23,23,23,23,24,24,24,24,24,24,24,24,24,24,24,24,24,24,24,24,25,25,25,25,25,25,25,25,25,25,25,25,25,25,25,25,25,25,25,25,25,26,26,26,26,26,26,26,26,26,26,26,26,26,26,26,26,26,26,26,26,26,26,26,26,26,26,26,26,26,26,27,27,27,27,27,27,27,27,27,27,27,27,27,27,27,27,0,0,0},
 {0,16,18,19,20,21,21,22,22,23,23,23,24,24,24,24,25,25,25,25,25,26,26,26,26,26,26,26,26,27,27,27,27,27,27,27,27,27,27,28,28,28,28,28,28,28,28,28,28,28,28,28,29,29,29,29,29,29,29,29,29,29,29,29,29,29,29,29,29,29,30,30,30,30,30,30,30,30,30,30,30,30,30,30,30,30,30,30,30,30,30,30,30,30,30,31,31,31,31,31,31,31,31,31,31,31,31,31,31,31,31,31,31,31,31,31,31,31,31,31,31,31,31,31,31,31,31,31,31,0,0,0}};

namespace pg8 {
struct EpiWin {
    static constexpr bool PERM = true, AFTER_DRAIN = false; static constexpr int A_ROWS = 256; static constexpr bool HAS_SEG = false;
    bf16_t* P1; bf16_t* G; int pn0;
    __device__ __forceinline__ void operator()(const f32x4 (&acc)[2][2][4][2], const Unit& u, int wr, int wc, int fr, int fq) const {
        const int pn = u.pn + pn0; const int row0 = u.pm * BM + wr * 64 + fr; const bool gate = pn >= 23;
        bf16_t* base = gate ? G : P1; const int ldc = gate ? 6144 : 5888; const int col0 = (gate ? (pn - 23) : pn) * BM + wc * 32 + 8 * fq;
#pragma unroll
        for (int ai = 0; ai < 2; ++ai)
#pragma unroll
            for (int m = 0; m < 4; ++m) { bf16_t* rowp = base + (size_t)(row0 + ai * HALF + m * 16) * ldc + col0;
#pragma unroll
                for (int bj = 0; bj < 2; ++bj) { f32x4 v0 = acc[ai][bj][m][0], v1 = acc[ai][bj][m][1];
                    if (gate) {
#pragma unroll
                        for (int j = 0; j < 4; ++j) { v0[j] = __builtin_amdgcn_rcpf(1.0f + __expf(-v0[j])); v1[j] = __builtin_amdgcn_rcpf(1.0f + __expf(-v1[j])); } }
                    u32x4 w; w.x = cvt_pk_bf16(v0[0], v0[1]); w.y = cvt_pk_bf16(v0[2], v0[3]); w.z = cvt_pk_bf16(v1[0], v1[1]); w.w = cvt_pk_bf16(v1[2], v1[3]);
                    *(u32x4*)(rowp + bj * HALF) = w; } }
    }
};
struct EpiBf16P {
    static constexpr bool PERM = true, AFTER_DRAIN = false; static constexpr int A_ROWS = 256; static constexpr bool HAS_SEG = false;
    bf16_t* O; int ldc;
    __device__ __forceinline__ void operator()(const f32x4 (&acc)[2][2][4][2], const Unit& u, int wr, int wc, int fr, int fq) const {
        const int row0 = u.pm * BM + wr * 64 + fr; const int col0 = u.pn * BM + wc * 32 + 8 * fq;
#pragma unroll
        for (int ai = 0; ai < 2; ++ai)
#pragma unroll
            for (int m = 0; m < 4; ++m) { bf16_t* rowp = O + (size_t)(row0 + ai * HALF + m * 16) * ldc + col0;
#pragma unroll
                for (int bj = 0; bj < 2; ++bj) { const f32x4 v0 = acc[ai][bj][m][0], v1 = acc[ai][bj][m][1];
                    u32x4 w; w.x = cvt_pk_bf16(v0[0], v0[1]); w.y = cvt_pk_bf16(v0[2], v0[3]); w.z = cvt_pk_bf16(v1[0], v1[1]); w.w = cvt_pk_bf16(v1[2], v1[3]);
                    *(u32x4*)(rowp + bj * HALF) = w; } }
    }
};
struct EpiF32P {
    static constexpr bool PERM = false, AFTER_DRAIN = false; static constexpr int A_ROWS = 256; static constexpr bool HAS_SEG = false;
    float* C; int ldc;
    __device__ __forceinline__ void operator()(const f32x4 (&acc)[2][2][4][2], const Unit& u, int wr, int wc, int fr, int fq) const {
        const int row0 = u.pm * BM + wr * 64 + fr, col0 = u.pn * BM + wc * 32 + 4 * fq;
#pragma unroll
        for (int ai = 0; ai < 2; ++ai)
#pragma unroll
            for (int m = 0; m < 4; ++m) { float* rowp = C + (size_t)(row0 + ai * HALF + m * 16) * ldc + col0;
#pragma unroll
                for (int bj = 0; bj < 2; ++bj)
#pragma unroll
                    for (int n = 0; n < 2; ++n) *(f32x4*)(rowp + bj * HALF + n * 16) = acc[ai][bj][m][n]; }
    }
};
struct EpiResid {
    static constexpr bool PERM = false, AFTER_DRAIN = false; static constexpr int A_ROWS = 256; static constexpr bool HAS_SEG = false;
    const float* xin; float* out;
    __device__ __forceinline__ void operator()(const f32x4 (&acc)[2][2][4][2], const Unit& u, int wr, int wc, int fr, int fq) const {
        const int row0 = u.pm * BM + wr * 64 + fr, col0 = u.pn * BM + wc * 32 + 4 * fq;
#pragma unroll
        for (int ai = 0; ai < 2; ++ai)
#pragma unroll
            for (int m = 0; m < 4; ++m) { const size_t ro = (size_t)(row0 + ai * HALF + m * 16) * 2048 + col0;
#pragma unroll
                for (int bj = 0; bj < 2; ++bj)
#pragma unroll
                    for (int n = 0; n < 2; ++n) { const f32x4 xv = *(const f32x4*)(xin + ro + bj * HALF + n * 16); *(f32x4*)(out + ro + bj * HALF + n * 16) = xv + acc[ai][bj][m][n]; } }
    }
};
template <bool ACC> struct EpiGate {
    static constexpr bool PERM = true, AFTER_DRAIN = false; static constexpr int A_ROWS = 256; static constexpr bool HAS_SEG = false;
    const bf16_t* G; int gofs; bf16_t* MG;
    __device__ __forceinline__ void operator()(const f32x4 (&acc)[2][2][4][2], const Unit& u, int wr, int wc, int fr, int fq) const {
        const int row0 = u.pm * BM + wr * 64 + fr; const int col0 = u.pn * BM + wc * 32 + 8 * fq;
#pragma unroll
        for (int ai = 0; ai < 2; ++ai)
#pragma unroll
            for (int m = 0; m < 4; ++m) { const int row = row0 + ai * HALF + m * 16;
#pragma unroll
                for (int bj = 0; bj < 2; ++bj) { const int col = col0 + bj * HALF;
                    const u32x4 gv = *(const u32x4*)(G + (size_t)row * 6144 + gofs + col);
                    const f32x4 a0 = acc[ai][bj][m][0], a1 = acc[ai][bj][m][1];
                    float r[8];
                    r[0] = __builtin_bit_cast(float, gv.x << 16) * a0[0]; r[1] = __builtin_bit_cast(float, gv.x & 0xffff0000u) * a0[1];
                    r[2] = __builtin_bit_cast(float, gv.y << 16) * a0[2]; r[3] = __builtin_bit_cast(float, gv.y & 0xffff0000u) * a0[3];
                    r[4] = __builtin_bit_cast(float, gv.z << 16) * a1[0]; r[5] = __builtin_bit_cast(float, gv.z & 0xffff0000u) * a1[1];
                    r[6] = __builtin_bit_cast(float, gv.w << 16) * a1[2]; r[7] = __builtin_bit_cast(float, gv.w & 0xffff0000u) * a1[3];
                    bf16_t* mp = MG + (size_t)row * 2048 + col;
                    if (ACC) { const u32x4 ov = *(const u32x4*)mp;
                        r[0] += __builtin_bit_cast(float, ov.x << 16); r[1] += __builtin_bit_cast(float, ov.x & 0xffff0000u);
                        r[2] += __builtin_bit_cast(float, ov.y << 16); r[3] += __builtin_bit_cast(float, ov.y & 0xffff0000u);
                        r[4] += __builtin_bit_cast(float, ov.z << 16); r[5] += __builtin_bit_cast(float, ov.z & 0xffff0000u);
                        r[6] += __builtin_bit_cast(float, ov.w << 16); r[7] += __builtin_bit_cast(float, ov.w & 0xffff0000u); }
                    u32x4 w; w.x = cvt_pk_bf16(r[0], r[1]); w.y = cvt_pk_bf16(r[2], r[3]); w.z = cvt_pk_bf16(r[4], r[5]); w.w = cvt_pk_bf16(r[6], r[7]);
                    *(u32x4*)mp = w; } }
    }
};
struct EpiGate3 {
    static constexpr bool PERM = true, AFTER_DRAIN = false; static constexpr int A_ROWS = 256; static constexpr bool HAS_SEG = true;
    const bf16_t* G; bf16_t* MG; int t1, t2;
    __device__ __forceinline__ void seg(f32x4 (&acc)[2][2][4][2], const Unit& u, int t, int wr, int wc, int fr, int fq) const {
        typedef unsigned u32x2 __attribute__((ext_vector_type(2)));
        const int gnum = (t == t1) ? 0 : 2048;
        const bf16_t* gp0 = G + (size_t)(u.pm * BM + wr * 64 + fr) * 6144 + gnum + u.pn * BM + wc * 32 + 8 * fq;
#pragma unroll
        for (int ai = 0; ai < 2; ++ai)
#pragma unroll
            for (int m = 0; m < 4; ++m)
#pragma unroll
                for (int bj = 0; bj < 2; ++bj)
#pragma unroll
                    for (int n = 0; n < 2; ++n) {
                        const bf16_t* gp = gp0 + (size_t)(ai * HALF + m * 16) * 6144 + bj * HALF + 4 * n;
                        const u32x2 gn = *(const u32x2*)gp, gd = *(const u32x2*)(gp + 2048);
                        f32x4 r;
                        r[0] = __builtin_bit_cast(float, gn.x << 16) * __builtin_amdgcn_rcpf(__builtin_bit_cast(float, gd.x << 16)); r[1] = __builtin_bit_cast(float, gn.x & 0xffff0000u) * __builtin_amdgcn_rcpf(__builtin_bit_cast(float, gd.x & 0xffff0000u));
                        r[2] = __builtin_bit_cast(float, gn.y << 16) * __builtin_amdgcn_rcpf(__builtin_bit_cast(float, gd.y << 16)); r[3] = __builtin_bit_cast(float, gn.y & 0xffff0000u) * __builtin_amdgcn_rcpf(__builtin_bit_cast(float, gd.y & 0xffff0000u));
                        acc[ai][bj][m][n] *= r; if (n == 1 && bj == 1) asm volatile("" ::: "memory"); }
    }
    __device__ __forceinline__ void operator()(const f32x4 (&acc)[2][2][4][2], const Unit& u, int wr, int wc, int fr, int fq) const {
        const int row0 = u.pm * BM + wr * 64 + fr; const int col0 = u.pn * BM + wc * 32 + 8 * fq;
#pragma unroll
        for (int ai = 0; ai < 2; ++ai)
#pragma unroll
            for (int m = 0; m < 4; ++m) { const int row = row0 + ai * HALF + m * 16;
#pragma unroll
                for (int bj = 0; bj < 2; ++bj) { const int col = col0 + bj * HALF; const u32x4 gv = *(const u32x4*)(G + (size_t)row * 6144 + 4096 + col);
                    const f32x4 a0 = acc[ai][bj][m][0], a1 = acc[ai][bj][m][1];
                    u32x4 w;
                    w.x = cvt_pk_bf16(__builtin_bit_cast(float, gv.x << 16) * a0[0], __builtin_bit_cast(float, gv.x & 0xffff0000u) * a0[1]);
                    w.y = cvt_pk_bf16(__builtin_bit_cast(float, gv.y << 16) * a0[2], __builtin_bit_cast(float, gv.y & 0xffff0000u) * a0[3]);
                    w.z = cvt_pk_bf16(__builtin_bit_cast(float, gv.z << 16) * a1[0], __builtin_bit_cast(float, gv.z & 0xffff0000u) * a1[1]);
                    w.w = cvt_pk_bf16(__builtin_bit_cast(float, gv.w << 16) * a1[2], __builtin_bit_cast(float, gv.w & 0xffff0000u) * a1[3]);
                    *(u32x4*)(MG + (size_t)row * 2048 + col) = w; } }
    }
};
template <int CTRL> __device__ __forceinline__ float dpp_keep(float old, float x) { return __builtin_bit_cast(float, __builtin_amdgcn_update_dpp(__builtin_bit_cast(int, old), __builtin_bit_cast(int, x), CTRL, 0xF, 0xF, false)); }
struct EpiConv {
    static constexpr bool PERM = true, AFTER_DRAIN = false; static constexpr int A_ROWS = 254; static constexpr bool HAS_SEG = false;
    bf16_t* ACT; const float* cw; PG8_LAS float* xch;
    __device__ __forceinline__ void operator()(const f32x4 (&acc)[2][2][4][2], const Unit& u, int wr, int wc, int fr, int fq) const {
        const int cbase = wc * 32 + 8 * fq, f0 = u.pn * 128 + cbase;
        float c0[8], c1[8], c2[8];
#pragma unroll
        for (int j = 0; j < 8; ++j) { c0[j] = cw[f0 + j]; c1[j] = cw[5504 + f0 + j]; c2[j] = cw[2 * 5504 + f0 + j]; }
        if (fr >= 14) {
#pragma unroll
            for (int ai = 0; ai < 2; ++ai)
#pragma unroll
                for (int n = 0; n < 2; ++n) *(PG8_LAS f32x4*)(xch + ((2 * ai + wr) * 2 + (fr - 14)) * 128 + cbase + 4 * n) = acc[ai][0][3][n];
        }
        asm volatile("s_waitcnt lgkmcnt(0)" ::: "memory"); __builtin_amdgcn_s_barrier(); asm volatile("" ::: "memory");
#pragma unroll
        for (int ai = 0; ai < 2; ++ai) {
            const int sl = 2 * ai + wr;
            f32x4 e1[2], e2[2];
#pragma unroll
            for (int n = 0; n < 2; ++n) { e1[n] = (f32x4){0.f, 0.f, 0.f, 0.f}; e2[n] = e1[n];
                if (sl > 0) { e2[n] = *(const PG8_LAS f32x4*)(xch + ((sl - 1) * 2 + 0) * 128 + cbase + 4 * n); e1[n] = *(const PG8_LAS f32x4*)(xch + ((sl - 1) * 2 + 1) * 128 + cbase + 4 * n); } }
#pragma unroll
            for (int m = 0; m < 4; ++m) {
                const int lr = 128 * ai + 64 * wr + 16 * m + fr; const int grow = 254 * u.pm - 2 + lr; const int t = grow & 8191;
                float r[8];
#pragma unroll
                for (int n = 0; n < 2; ++n)
#pragma unroll
                    for (int j = 0; j < 4; ++j) {
                        const float x = acc[ai][0][m][n][j];
                        float k1, k2;
                        if (m > 0) { const float xp = acc[ai][0][m > 0 ? m - 1 : 0][n][j]; k1 = dpp_keep<0x121>(xp, xp); k2 = dpp_keep<0x122>(xp, xp); }
                        else { k1 = e1[n][j]; k2 = (fr == 0) ? e2[n][j] : e1[n][j]; }
                        float p1 = dpp_keep<0x111>(k1, x), p2 = dpp_keep<0x112>(k2, x);
                        if (t == 0) p1 = 0.f; if (t <= 1) p2 = 0.f;
                        const float gs = c0[4 * n + j] * p2 + c1[4 * n + j] * p1 + c2[4 * n + j] * x;
                        r[4 * n + j] = gs * __builtin_amdgcn_rcpf(1.0f + __expf(-gs)) * acc[ai][1][m][n][j];
                    }
                if (lr >= 2 && grow < 16384) { u32x4 w; w.x = cvt_pk_bf16(r[0], r[1]); w.y = cvt_pk_bf16(r[2], r[3]); w.z = cvt_pk_bf16(r[4], r[5]); w.w = cvt_pk_bf16(r[6], r[7]);
                    *(u32x4*)(ACT + (size_t)grow * 5504 + f0) = w; }
            }
        }
    }
};
}

struct Args { const float* in[25]; float* out; unsigned char* ws; int ph_lo, ph_hi, li, pad; };

struct Ctx {
    LAS unsigned char* lds;
    int tid, lane, wave, G, bid;
    int gw, ngw;
};

__device__ __forceinline__ void transpose_item(const float* W, int K, int N, bf16* WT, int kb, int nb, int dst_row0, LAS float* scr, int lane, int ldk = 0, int koff = 0) {
    if (ldk == 0) ldk = K;
    const int k0 = 64 * kb, n0 = 32 * nb;
#pragma unroll 8
    for (int i = 0; i < 32; ++i) { const int kk = 2 * i + (lane >> 5); scr[kk * 33 + (lane & 31)] = W[(size_t)(k0 + kk) * N + n0 + (lane & 31)]; }
    LDS_WAIT(); asm volatile("" ::: "memory");
    const int c = lane & 7;
#pragma unroll
    for (int j = 0; j < 4; ++j) { const int n = (lane >> 3) + 8 * j; const LAS float* s = scr + (8 * c) * 33 + n;
        v4u o; o.x = pk2(s[0 * 33], s[1 * 33]); o.y = pk2(s[2 * 33], s[3 * 33]); o.z = pk2(s[4 * 33], s[5 * 33]); o.w = pk2(s[6 * 33], s[7 * 33]);
        *(v4u*)(WT + (size_t)(dst_row0 + n) * ldk + koff + k0 + 8 * c) = o; }
    LDS_WAIT(); asm volatile("" ::: "memory");
}
__device__ __forceinline__ int transpose_matrix(int widx, int nw, int lane, LAS float* scr, const float* W, int K, int N, bf16* WT, int gate_split, int base, int ldk = 0, int koff = 0) {
    const int nblk = N / 32, items = (K / 64) * nblk;
    int first = (widx - base) % nw; if (first < 0) first += nw;
    for (int it = first; it < items; it += nw) {
        const int kb = it / nblk, nb = it % nblk; int dr = 32 * nb; if (gate_split == 1 && dr >= C_END) dr += 64;
        if (gate_split == 2) { const int f = dr < DFF ? dr : dr - DFF; dr = 256 * (f >> 7) + (f & 127) + (dr < DFF ? 0 : 128); }
        transpose_item(W, K, N, WT, kb, nb, dr, scr, lane, ldk, koff);
    }
    return base + items;
}
__device__ __forceinline__ void convert_weights(int widx, int nw, int lane, LAS float* scr, const Args& a, int l, unsigned char* ws) {
    unsigned char* wsw = ws + (size_t)(l & 1) * WSET_STRIDE;
    int base = 0;
    base = transpose_matrix(widx, nw, lane, scr, a.in[3] + (size_t)l * D * DIN, D, DIN, (bf16*)(wsw + WS_WIN), 1, base);
    base = transpose_matrix(widx, nw, lane, scr, a.in[21] + (size_t)l * D * NUP, D, NUP, (bf16*)(wsw + WS_WUP), 2, base);
    base = transpose_matrix(widx, nw, lane, scr, a.in[23] + (size_t)l * DFF * D, DFF, D, (bf16*)(wsw + WS_WDOWN), 0, base);
    base = transpose_matrix(widx, nw, lane, scr, a.in[19] + (size_t)l * D * D, D, D, (bf16*)(wsw + WS_WOUT), 0, base);
    base = transpose_matrix(widx, nw, lane, scr, a.in[16] + (size_t)l * 512 * D, 512, D, (bf16*)(wsw + WS_PA), 0, base, 1536, 0);
    base = transpose_matrix(widx, nw, lane, scr, a.in[17] + (size_t)l * 768 * D, 768, D, (bf16*)(wsw + WS_PA), 0, base, 1536, 512);
    base = transpose_matrix(widx, nw, lane, scr, a.in[18] + (size_t)l * 256 * D, 256, D, (bf16*)(wsw + WS_PA), 0, base, 1536, 1280);
    const int gt = widx * 64 + lane, ngt = nw * 64;
    { v4u* z = (v4u*)((bf16*)(wsw + WS_WIN) + (size_t)C_END * D); for (int i = gt; i < 64 * D / 8; i += ngt) z[i] = (v4u){0u, 0u, 0u, 0u}; }
    { bf16* wl = (bf16*)(wsw + WS_WLORA); const float* wup = a.in[7] + (size_t)l * 96 * BW; const float* aup = a.in[9] + (size_t)l * 96 * BW; const float* gup = a.in[10] + (size_t)l * 256 * BW;
      for (int i = gt; i < NLORA * KLORA; i += ngt) { const int n = i / KLORA, k = i % KLORA; float v = 0.f;
          if (n < 768) { if (k < 96) v = wup[k * BW + n]; }
          else if (n < 1536) { if (k >= 96 && k < 192) v = aup[(k - 96) * BW + (n - 768)]; }
          else { if (k >= 192 && k < 448) v = gup[(k - 192) * BW + (n - 1536)]; }
          wl[i] = (bf16)f2bf(v); } }
}

__device__ __forceinline__ void rms_row_bf16(const float* xrow, const float* gam, bf16* orow, int lane) {
    const f32x4* xr = (const f32x4*)xrow + lane; f32x4 v[8]; float s = 0.f;
#pragma unroll
    for (int j = 0; j < 8; ++j) { v[j] = xr[64 * j]; s += (v[j].x * v[j].x + v[j].y * v[j].y) + (v[j].z * v[j].z + v[j].w * v[j].w); }
    const float rs = 1.0f / sqrtf(wave_sum(s, lane) * (1.0f / D) + NORM_EPS);
    const f32x4* gr = (const f32x4*)gam + lane; v2u* o8 = (v2u*)orow + lane;
#pragma unroll
    for (int j = 0; j < 8; ++j) { const f32x4 g = gr[64 * j]; v2u w; w.x = pk2(v[j].x * rs * g.x, v[j].y * rs * g.y); w.y = pk2(v[j].z * rs * g.z, v[j].w * rs * g.w); o8[64 * j] = w; }
}
__device__ __forceinline__ void rms_row2_bf16(const float* xrow, const float* gam, bf16* orow, int lane) {
    const f32x4* xr = (const f32x4*)xrow + lane; f32x4 v[16]; float s0 = 0.f, s1 = 0.f;
#pragma unroll
    for (int j = 0; j < 16; ++j) v[j] = xr[64 * j];
#pragma unroll
    for (int j = 0; j < 8; ++j) { s0 += (v[j].x * v[j].x + v[j].y * v[j].y) + (v[j].z * v[j].z + v[j].w * v[j].w); s1 += (v[8 + j].x * v[8 + j].x + v[8 + j].y * v[8 + j].y) + (v[8 + j].z * v[8 + j].z + v[8 + j].w * v[8 + j].w); }
    const float rs0 = 1.0f / sqrtf(wsum(s0, lane) * (1.0f / D) + NORM_EPS), rs1 = 1.0f / sqrtf(wsum(s1, lane) * (1.0f / D) + NORM_EPS);
    const f32x4* gr = (const f32x4*)gam + lane; v2u* o8 = (v2u*)orow + lane;
#pragma unroll
    for (int j = 0; j < 8; ++j) { const f32x4 g = gr[64 * j]; v2u w; w.x = pk2(v[j].x * rs0 * g.x, v[j].y * rs0 * g.y); w.y = pk2(v[j].z * rs0 * g.z, v[j].w * rs0 * g.w); o8[64 * j] = w;
        v2u w1; w1.x = pk2(v[8 + j].x * rs1 * g.x, v[8 + j].y * rs1 * g.y); w1.y = pk2(v[8 + j].z * rs1 * g.z, v[8 + j].w * rs1 * g.w); o8[64 * (8 + j)] = w1; }
}
__device__ __forceinline__ void rms_row_f32(float* xrow, const float* gam, int lane) {
    f32x4* xr = (f32x4*)xrow + lane; f32x4 v[8]; float s = 0.f;
#pragma unroll
    for (int j = 0; j < 8; ++j) { v[j] = xr[64 * j]; s += (v[j].x * v[j].x + v[j].y * v[j].y) + (v[j].z * v[j].z + v[j].w * v[j].w); }
    const float rs = 1.0f / sqrtf(wave_sum(s, lane) * (1.0f / D) + NORM_EPS);
    const f32x4* gr = (const f32x4*)gam + lane;
#pragma unroll
    for (int j = 0; j < 8; ++j) { const f32x4 g = gr[64 * j]; xr[64 * j] = v[j] * rs * g; }
}

__device__ __forceinline__ void phase_prep(const Ctx& C, const Args& a, int l, const float* xsrc, unsigned char* ws) {
    if (l == 0) convert_weights(C.gw, C.ngw, C.lane, (LAS float*)(C.lds + RING_OFF + C.wave * 16384), a, 0, ws);
    const float* g1 = a.in[2] + (size_t)l * D; bf16* H = (bf16*)(ws + WS_H);
    for (int m = 2 * C.gw; m < M; m += 2 * C.ngw) rms_row2_bf16(xsrc + (size_t)m * D, g1, H + (size_t)m * D, C.lane);
}

__device__ __forceinline__ void phase_aprime(const Ctx& C, const Args& a, int l, unsigned char* ws) {
    const bf16* P1 = (const bf16*)(ws + WS_P1); bf16* AP = (bf16*)(ws + WS_AP); const float* mu = a.in[5] + (size_t)l * BCOLS;
    const int g = C.lane, c0 = 8 * g;
    float muv[8];
#pragma unroll
    for (int j = 0; j < 8; ++j) muv[j] = (g < 56) ? mu[(C_WD - C_R) + c0 + j] : 0.f;
    for (int m = C.gw; m < M; m += C.ngw) {
        v4u o = (v4u){0u, 0u, 0u, 0u};
        if (g < 56) {
            const v4u cur = *(const v4u*)(P1 + (size_t)m * NP1 + C_WD + c0);
            v4u prv = (v4u){0u, 0u, 0u, 0u}; if ((m & (SEQ - 1)) != 0) prv = *(const v4u*)(P1 + (size_t)(m - 1) * NP1 + C_WD + c0);
            float x[8], p[8];
            x[0] = bflo(cur.x); x[1] = bfhi(cur.x); x[2] = bflo(cur.y); x[3] = bfhi(cur.y); x[4] = bflo(cur.z); x[5] = bfhi(cur.z); x[6] = bflo(cur.w); x[7] = bfhi(cur.w);
            p[0] = bflo(prv.x); p[1] = bfhi(prv.x); p[2] = bflo(prv.y); p[3] = bfhi(prv.y); p[4] = bflo(prv.z); p[5] = bfhi(prv.z); p[6] = bflo(prv.w); p[7] = bfhi(prv.w);
#pragma unroll
            for (int j = 0; j < 8; ++j) { float v = x[j] + (p[j] - x[j]) * muv[j];
                if (g < 12) v = tanhf(v); else if (g >= 24) v = sigmoidf_(v);
                x[j] = v; }
            o.x = pk2(x[0], x[1]); o.y = pk2(x[2], x[3]); o.z = pk2(x[4], x[5]); o.w = pk2(x[6], x[7]);
        }
        *(v4u*)(AP + (size_t)m * KLORA + c0) = o;
    }
}

struct PrepTok { float r, kt, v, w, kk, b; };
__device__ __forceinline__ PrepTok prep_token(const bf16* P1, const float* LO, int m, int hc, float mur, float muk, float muv, float w0, float a0, float kkw, float kaw) {
    const bool first = (m & (SEQ - 1)) == 0;
    const bf16* pr = P1 + (size_t)m * NP1; const bf16* pp = pr - NP1;
    float r = bf1(pr[C_R + hc]), k = bf1(pr[C_K + hc]), v = bf1(pr[C_V + hc]);
    const float rp = first ? 0.f : bf1(pp[C_R + hc]), kp = first ? 0.f : bf1(pp[C_K + hc]), vp = first ? 0.f : bf1(pp[C_V + hc]);
    r = r + (rp - r) * mur; k = k + (kp - k) * muk; v = v + (vp - v) * muv;
    const float wpre = w0 + LO[(size_t)m * NLORA + hc], apre = a0 + LO[(size_t)m * NLORA + BW + hc];
    const float xx = -wpre; const float sp = fmaxf(xx, 0.f) + log1pf(expf(-fabsf(xx)));
    const float wlog = -sp - 0.5f; const float decay = expf(-expf(wlog));
    const float av = 1.0f / (1.0f + expf(-apre));
    const float kkr = k * kkw; const float nrm = sqrtf(wave_sum(kkr * kkr, 0)); const float kk = kkr / fmaxf(nrm, 1e-12f);
    PrepTok t; t.r = r; t.kt = k * (1.0f + (av - 1.0f) * kaw); t.v = v; t.w = decay; t.kk = kk; t.b = kk * av; return t;
}
struct PrepRaw { v2u r, k, v; f32x4 lw, la; };
__device__ __forceinline__ PrepRaw prep_load(const bf16* P1, const float* LO, int m, int c0) {
    PrepRaw x; const bf16* pr = P1 + (size_t)m * NP1 + c0;
    x.r = *(const v2u*)(pr + C_R); x.k = *(const v2u*)(pr + C_K); x.v = *(const v2u*)(pr + C_V);
    x.lw = *(const f32x4*)(LO + (size_t)m * NLORA + c0); x.la = *(const f32x4*)(LO + (size_t)m * NLORA + BW + c0); return x;
}
__device__ __forceinline__ void un4(const v2u w, float (&x)[4]) { x[0] = bflo(w.x); x[1] = bfhi(w.x); x[2] = bflo(w.y); x[3] = bfhi(w.y); }
__device__ __forceinline__ void phase_scanprep(const Ctx& C, const Args& a, int l, unsigned char* ws) {
    const bf16* P1 = (const bf16*)(ws + WS_P1); const float* LO = (const float*)(ws + WS_LO);
    float* SR = (float*)(ws + WS_SR); float* SW = (float*)(ws + WS_SW); float* SK = (float*)(ws + WS_SK); float* SU = (float*)(ws + WS_SKK); float* SB = (float*)(ws + WS_SB); float* SV = (float*)(ws + WS_SV);
    float* BK = (float*)(ws + WS_BK); float* BON = (float*)(ws + WS_BON);
    const float* mu = a.in[5] + (size_t)l * BCOLS; const float* w0p = a.in[6] + (size_t)l * BW; const float* a0p = a.in[8] + (size_t)l * BW;
    const float* kkwp = a.in[11] + (size_t)l * BW; const float* kawp = a.in[12] + (size_t)l * BW; const float* rkp = a.in[13] + (size_t)l * BW;
    constexpr int RL = 8;
    const int g = C.lane >> 4, cq = C.lane & 15;
    for (int it = C.gw; it < (M / (4 * RL)) * 12; it += C.ngw) {
        const int h = it % 12, m0 = ((it / 12) * 4 + g) * RL, c0 = h * 64 + 4 * cq;
        const f32x4 mur = *(const f32x4*)(mu + c0), muk = *(const f32x4*)(mu + BW + c0), muv = *(const f32x4*)(mu + 2 * BW + c0), w0 = *(const f32x4*)(w0p + c0), a0 = *(const f32x4*)(a0p + c0);
        const f32x4 kkw = *(const f32x4*)(kkwp + c0), kaw = *(const f32x4*)(kawp + c0), rkc = *(const f32x4*)(rkp + c0);
        const bool seq_start = (m0 & (SEQ - 1)) == 0;
        float prr[4] = {0.f, 0.f, 0.f, 0.f}, prk[4] = {0.f, 0.f, 0.f, 0.f}, prv[4] = {0.f, 0.f, 0.f, 0.f}, pw[4] = {0.f, 0.f, 0.f, 0.f}, pb[4] = {0.f, 0.f, 0.f, 0.f}, pkt[4] = {0.f, 0.f, 0.f, 0.f};
        if (!seq_start) { const bf16* pr = P1 + (size_t)(m0 - 2) * NP1 + c0; un4(*(const v2u*)(pr + C_R), prr); un4(*(const v2u*)(pr + C_K), prk); un4(*(const v2u*)(pr + C_V), prv); }
        PrepRaw nx = prep_load(P1, LO, seq_start ? m0 : m0 - 1, c0);
#pragma unroll 1
        for (int i = seq_start ? 0 : -1; i < RL; ++i) {
            const int m = m0 + i; const PrepRaw cu = nx;
            if (i + 1 < RL) nx = prep_load(P1, LO, m + 1, c0);
            float xr[4], xk[4], xv[4]; un4(cu.r, xr); un4(cu.k, xk); un4(cu.v, xv);
            float tr[4], tk[4], tv[4], tw[4], ta[4], kkr[4]; float q = 0.f;
#pragma unroll
            for (int e = 0; e < 4; ++e) {
                tr[e] = xr[e] + (prr[e] - xr[e]) * mur[e]; tk[e] = xk[e] + (prk[e] - xk[e]) * muk[e]; tv[e] = xv[e] + (prv[e] - xv[e]) * muv[e];
                const float xx = -(w0[e] + cu.lw[e]); const float sp = fmaxf(xx, 0.f) + __logf(1.0f + __expf(-fabsf(xx)));
                tw[e] = __expf(-__expf(-sp - 0.5f)); ta[e] = __builtin_amdgcn_rcpf(1.0f + __expf(-(a0[e] + cu.la[e])));
                kkr[e] = tk[e] * kkw[e]; q += kkr[e] * kkr[e];
            }
            q = red16(q); const float rn = __builtin_amdgcn_rsqf(fmaxf(q, 1e-24f));
            float tkk[4], tb[4], tkt[4]; float be = 0.f, ka = 0.f, bo = 0.f;
#pragma unroll
            for (int e = 0; e < 4; ++e) { tkk[e] = kkr[e] * rn; tb[e] = tkk[e] * ta[e]; tkt[e] = tk[e] * (1.0f + (ta[e] - 1.0f) * kaw[e]);
                be += pb[e] * tkk[e]; ka += pkt[e] * tkk[e]; bo += tr[e] * tkt[e] * rkc[e]; }
            if (i >= 0) {
                be = red16(be); ka = red16(ka); bo = red16(bo);
                const size_t o = (size_t)m * BW + c0; const bool first = (m & (SEQ - 1)) == 0;
                *(f32x4*)(SR + o) = (f32x4){tr[0], tr[1], tr[2], tr[3]}; *(f32x4*)(SW + o) = (f32x4){tw[0], tw[1], tw[2], tw[3]}; *(f32x4*)(SK + o) = (f32x4){tkt[0], tkt[1], tkt[2], tkt[3]};
                *(f32x4*)(SB + o) = (f32x4){tb[0], tb[1], tb[2], tb[3]}; *(f32x4*)(SV + o) = (f32x4){tv[0], tv[1], tv[2], tv[3]};
                if (!first) *(f32x4*)(SU + o - BW) = (f32x4){pw[0] * tkk[0], pw[1] * tkk[1], pw[2] * tkk[2], pw[3] * tkk[3]};
                if ((m & (SEQ - 1)) == SEQ - 1) *(f32x4*)(SU + o) = (f32x4){0.f, 0.f, 0.f, 0.f};
                if (cq < 2) BK[((size_t)m * 12 + h) * 2 + cq] = first ? 0.f : (cq == 0 ? be : ka);
                if (cq == 2) BON[(size_t)m * 12 + h] = bo;
            }
#pragma unroll
            for (int e = 0; e < 4; ++e) { prr[e] = xr[e]; prk[e] = xk[e]; prv[e] = xv[e]; pw[e] = tw[e]; pb[e] = tb[e]; pkt[e] = tkt[e]; }
        }
    }
}

typedef float f32x4c __attribute__((ext_vector_type(4)));
#define MFMA4(a, b, c) __builtin_amdgcn_mfma_f32_16x16x4f32((a), (b), (c), 0, 0, 0)
__device__ __forceinline__ void split8(const float (&x)[8], v4u& hi, v4u& lo) {
    unsigned h[4], l[4];
#pragma unroll
    for (int p = 0; p < 4; ++p) { h[p] = pg8::cvt_pk_bf16(x[2 * p], x[2 * p + 1]); l[p] = pg8::cvt_pk_bf16(x[2 * p] - bflo(h[p]), x[2 * p + 1] - bfhi(h[p])); }
    hi = (v4u){h[0], h[1], h[2], h[3]}; lo = (v4u){l[0], l[1], l[2], l[3]};
}
constexpr int CP_LD = 65, CP_ARR = 16 * CP_LD, CP_SM = 16 * 17;
constexpr int CP_WAVE_FLOATS = 4 * CP_ARR + 4 * CP_SM;
__device__ __forceinline__ void phase_chunkprep(const Ctx& C, const Args& a, int l, unsigned char* ws) {
    if (C.wave >= 6) return;
    const bf16* P1 = (const bf16*)(ws + WS_P1); const float* LO = (const float*)(ws + WS_LO);
    float* SV = (float*)(ws + WS_SV); float* BON = (float*)(ws + WS_BON); float* COP = (float*)(ws + WS_COP);
    const float* mu = a.in[5] + (size_t)l * BCOLS; const float* w0p = a.in[6] + (size_t)l * BW; const float* a0p = a.in[8] + (size_t)l * BW;
    const float* kkwp = a.in[11] + (size_t)l * BW; const float* kawp = a.in[12] + (size_t)l * BW; const float* rkp = a.in[13] + (size_t)l * BW;
    LAS float* L = (LAS float*)(C.lds + RING_OFF) + C.wave * CP_WAVE_FLOATS;
    LAS float* At = L; LAS float* Bt = L + CP_ARR; LAS float* Kt = L + 2 * CP_ARR; LAS float* Rt = L + 3 * CP_ARR;
    LAS float* Sa = L + 4 * CP_ARR; LAS float* Sb = Sa + CP_SM; LAS float* Sc = Sb + CP_SM; LAS float* Sd = Sc + CP_SM;
    const int lane = C.lane, li = lane & 15, q = lane >> 4;
    const int widx = C.bid * 6 + C.wave, nw = C.G * 6;
    for (int it = widx; it < 24 * 512; it += nw) {
        const int hs = it >> 9, c = it & 511, b = hs / 12, h = hs % 12, hc = h * 64 + lane; const int m0 = b * SEQ + c * 16;
        const float mur = mu[hc], muk = mu[BW + hc], muv = mu[2 * BW + hc], w0 = w0p[hc], a0 = a0p[hc], kkw = kkwp[hc], kaw = kawp[hc], rkc = rkp[hc];
        float rr[17], rk_[17], rv[17], lw[16], la[16];
#pragma unroll
        for (int j = 0; j < 17; ++j) { const bool ok = !((c == 0) && j == 0); const size_t row = ok ? (size_t)(m0 - 1 + j) : (size_t)m0; const bf16* pr = P1 + row * NP1 + hc;
            const float x0 = bf1(pr[C_R]), x1 = bf1(pr[C_K]), x2 = bf1(pr[C_V]); rr[j] = ok ? x0 : 0.f; rk_[j] = ok ? x1 : 0.f; rv[j] = ok ? x2 : 0.f;
            if (j >= 1) { lw[j - 1] = LO[row * NLORA + hc]; la[j - 1] = LO[row * NLORA + BW + hc]; } }
        float cum = 0.f;
#pragma unroll
        for (int i = 0; i < 16; ++i) {
            const float tr = rr[i + 1] + (rr[i] - rr[i + 1]) * mur, tk = rk_[i + 1] + (rk_[i] - rk_[i + 1]) * muk, tv = rv[i + 1] + (rv[i] - rv[i + 1]) * muv;
            const float xx = -(w0 + lw[i]); const float sp = fmaxf(xx, 0.f) + __logf(1.0f + __expf(-fabsf(xx)));
            const float lwv = -__expf(-sp - 0.5f);
            const float av = __builtin_amdgcn_rcpf(1.0f + __expf(-(a0 + la[i])));
            const float kkr = tk * kkw; const float kk = kkr * __builtin_amdgcn_rsqf(fmaxf(wsum(kkr * kkr, lane), 1e-24f));
            const float kt = tk * (1.0f + (av - 1.0f) * kaw), bb = kk * av;
            const float bo = wsum(tr * kt * rkc, lane);
            SV[(size_t)(m0 + i) * BW + hc] = tv; if (lane == 0) BON[(size_t)(m0 + i) * 12 + h] = bo;
            const float ex = __expf(cum); cum += lwv; const float ei = __expf(cum), eni = __expf(-cum);
            At[i * CP_LD + lane] = -kk * ex; Bt[i * CP_LD + lane] = bb * eni; Kt[i * CP_LD + lane] = kt * eni; Rt[i * CP_LD + lane] = tr * ei;
        }
        const float gam = __expf(cum);
        LDS_WAIT(); asm volatile("" ::: "memory");
        f32x4c gab = {0.f, 0.f, 0.f, 0.f}, gak = gab, grb = gab, grk = gab;
#pragma unroll
        for (int s_ = 0; s_ < 16; ++s_) { const int o = li * CP_LD + 4 * s_ + q; const float fa = At[o], fr = Rt[o], fb = Bt[o], fk = Kt[o];
            gab = MFMA4(fa, fb, gab); gak = MFMA4(fa, fk, gak); grb = MFMA4(fr, fb, grb); grk = MFMA4(fr, fk, grk); }
#pragma unroll
        for (int e = 0; e < 4; ++e) { const int i = 4 * q + e, j = li; if (!(j < i)) { gab[e] = 0.f; gak[e] = 0.f; } if (!(j <= i)) { grb[e] = 0.f; grk[e] = 0.f; }
            Sa[i * 17 + j] = gab[e]; Sb[i * 17 + j] = gak[e]; Sc[i * 17 + j] = grb[e]; }
        LDS_WAIT(); asm volatile("" ::: "memory");
        float tt[16];
#pragma unroll
        for (int i = 0; i < 16; ++i) { float acc = (i == li) ? 1.f : 0.f;
#pragma unroll
            for (int j = 0; j < i; ++j) acc += Sa[i * 17 + j] * tt[j];
            tt[i] = acc; }
        if (q == 0) {
#pragma unroll
            for (int i = 0; i < 16; ++i) Sd[i * 17 + li] = tt[i]; }
        LDS_WAIT(); asm volatile("" ::: "memory");
        float tf[4], mrbf[4];
#pragma unroll
        for (int s_ = 0; s_ < 4; ++s_) { tf[s_] = Sd[li * 17 + 4 * s_ + q]; mrbf[s_] = Sc[li * 17 + 4 * s_ + q]; }
        f32x4c w1[4], u0 = {0.f, 0.f, 0.f, 0.f};
#pragma unroll
        for (int n = 0; n < 4; ++n) { w1[n] = (f32x4c){0.f, 0.f, 0.f, 0.f};
#pragma unroll
            for (int s_ = 0; s_ < 4; ++s_) w1[n] = MFMA4(tf[s_], At[(4 * s_ + q) * CP_LD + 16 * n + li], w1[n]); }
#pragma unroll
        for (int s_ = 0; s_ < 4; ++s_) u0 = MFMA4(tf[s_], Sb[(4 * s_ + q) * 17 + li], u0);
        LDS_WAIT(); asm volatile("" ::: "memory");
#pragma unroll
        for (int n = 0; n < 4; ++n)
#pragma unroll
            for (int e = 0; e < 4; ++e) At[(4 * q + e) * CP_LD + 16 * n + li] = w1[n][e];
#pragma unroll
        for (int e = 0; e < 4; ++e) Sa[(4 * q + e) * 17 + li] = u0[e];
        LDS_WAIT(); asm volatile("" ::: "memory");
        f32x4c ry[4], y0 = grk;
#pragma unroll
        for (int n = 0; n < 4; ++n) {
#pragma unroll
            for (int e = 0; e < 4; ++e) ry[n][e] = Rt[(4 * q + e) * CP_LD + 16 * n + li];
#pragma unroll
            for (int s_ = 0; s_ < 4; ++s_) ry[n] = MFMA4(mrbf[s_], At[(4 * s_ + q) * CP_LD + 16 * n + li], ry[n]); }
#pragma unroll
        for (int s_ = 0; s_ < 4; ++s_) y0 = MFMA4(mrbf[s_], Sa[(4 * s_ + q) * 17 + li], y0);
        LDS_WAIT(); asm volatile("" ::: "memory");
#pragma unroll
        for (int n = 0; n < 4; ++n)
#pragma unroll
            for (int e = 0; e < 4; ++e) Rt[(4 * q + e) * CP_LD + 16 * n + li] = ry[n][e];
#pragma unroll
        for (int e = 0; e < 4; ++e) Sb[(4 * q + e) * 17 + li] = y0[e];
        LDS_WAIT(); asm volatile("" ::: "memory");
        float* rec = COP + ((size_t)hs * 512 + c) * COP_STRIDE; unsigned* recu = (unsigned*)rec;
#pragma unroll
        for (int kb = 0; kb < 2; ++kb) { float x[8];
#pragma unroll
            for (int jj = 0; jj < 8; ++jj) x[jj] = At[li * CP_LD + 16 * (2 * kb + (jj >> 2)) + 4 * q + (jj & 3)];
            v4u hi, lo; split8(x, hi, lo); *(v4u*)(recu + COP_W1 + lane * 16 + 8 * kb) = hi; *(v4u*)(recu + COP_W1 + lane * 16 + 8 * kb + 4) = lo; }
        { float x[8];
#pragma unroll
          for (int jj = 0; jj < 8; ++jj) x[jj] = jj < 4 ? Sa[li * 17 + 4 * q + jj] : 0.f;
          v4u hi, lo; split8(x, hi, lo); *(v4u*)(recu + COP_U0 + lane * 8) = hi; *(v4u*)(recu + COP_U0 + lane * 8 + 4) = lo; }
#pragma unroll
        for (int m = 0; m < 4; ++m) { float x[8]; const float gk = __builtin_bit_cast(float, __builtin_amdgcn_ds_bpermute((16 * m + li) << 2, __builtin_bit_cast(int, gam)));
#pragma unroll
            for (int jj = 0; jj < 8; ++jj) x[jj] = gk * (jj < 4 ? Bt[(4 * q + jj) * CP_LD + 16 * m + li] : Kt[(4 * q + jj - 4) * CP_LD + 16 * m + li]);
            v4u hi, lo; split8(x, hi, lo); *(v4u*)(recu + COP_BK + lane * 32 + 8 * m) = hi; *(v4u*)(recu + COP_BK + lane * 32 + 8 * m + 4) = lo; }
#pragma unroll
        for (int m = 0; m < 4; ++m) { f32x4 y;
#pragma unroll
            for (int j = 0; j < 4; ++j) y[j] = Rt[li * CP_LD + 16 * m + 4 * q + j];
            *(f32x4*)(rec + COP_RY + lane * 16 + 4 * m) = y; }
        { f32x4 y;
#pragma unroll
          for (int s_ = 0; s_ < 4; ++s_) y[s_] = Sb[li * 17 + 4 * q + s_];
          *(f32x4*)(rec + COP_Y0 + lane * 4) = y; }
        rec[COP_GAM + lane] = gam;
        LDS_WAIT(); asm volatile("" ::: "memory");
    }
}

__device__ __forceinline__ void scan_block(const Ctx& C, int sb, unsigned char* ws) {
    const int b = sb / 24, h = (sb % 24) >> 1, half = sb & 1;
    const float* SR = (const float*)(ws + WS_SR); const float* SW = (const float*)(ws + WS_SW); const float* SK = (const float*)(ws + WS_SK); const float* SKK = (const float*)(ws + WS_SKK);
    const float* SB = (const float*)(ws + WS_SB); const float* SV = (const float*)(ws + WS_SV); float* YR = (float*)(ws + WS_YRAW);
    constexpr int T = 64;
    LAS float* Lr = (LAS float*)(C.lds + RING_OFF); LAS float* Lw = Lr + T * 64; LAS float* Lk = Lw + T * 64; LAS float* Lkk = Lk + T * 64; LAS float* Lb = Lkk + T * 64;
    LAS float* Lv = Lb + T * 64; LAS float* Ly = Lv + T * 32;
    const int tid = C.tid, rl = tid >> 4, kq = tid & 15;
    const size_t rowbase = (size_t)b * SEQ; const int colh = h * 64;
    const int lt0 = tid >> 4, lc0 = (tid & 15) * 4, vt = tid >> 3, vc = (tid & 7) * 4;
    f32x4 pr[2], pw[2], pk[2], pkk[2], pb[2], pv;
#define SCAN_LOAD(t0) do { _Pragma("unroll") for (int i = 0; i < 2; ++i) { const size_t o = (rowbase + (t0) + lt0 + 32 * i) * BW + colh + lc0; \
        pr[i] = *(const f32x4*)(SR + o); pw[i] = *(const f32x4*)(SW + o); pk[i] = *(const f32x4*)(SK + o); pkk[i] = *(const f32x4*)(SKK + o); pb[i] = *(const f32x4*)(SB + o); } \
        pv = *(const f32x4*)(SV + (rowbase + (t0) + vt) * BW + colh + 32 * half + vc); } while (0)
    SCAN_LOAD(0);
    float S0 = 0.f, S1 = 0.f, S2 = 0.f, S3 = 0.f;
    for (int ch = 0; ch < SEQ / T; ++ch) {
        const int t0 = ch * T;
#pragma unroll
        for (int i = 0; i < 2; ++i) { const int lo = (lt0 + 32 * i) * 64 + lc0;
            *(LAS f32x4*)(Lr + lo) = pr[i]; *(LAS f32x4*)(Lw + lo) = pw[i]; *(LAS f32x4*)(Lk + lo) = pk[i]; *(LAS f32x4*)(Lkk + lo) = pkk[i]; *(LAS f32x4*)(Lb + lo) = pb[i]; }
        *(LAS f32x4*)(Lv + vt * 32 + vc) = pv;
        __syncthreads();
        if (ch + 1 < SEQ / T) SCAN_LOAD(t0 + T);
#pragma unroll 4
        for (int t = 0; t < T; ++t) {
            const f32x4 kk4 = *(const LAS f32x4*)(Lkk + t * 64 + kq * 4), w4 = *(const LAS f32x4*)(Lw + t * 64 + kq * 4), b4 = *(const LAS f32x4*)(Lb + t * 64 + kq * 4);
            const f32x4 k4 = *(const LAS f32x4*)(Lk + t * 64 + kq * 4), r4 = *(const LAS f32x4*)(Lr + t * 64 + kq * 4); const float v = Lv[t * 32 + rl];
            float d = (S0 * kk4.x + S1 * kk4.y) + (S2 * kk4.z + S3 * kk4.w); d = red16(d); const float sa = -d;
            S0 = S0 * w4.x + (sa * b4.x + v * k4.x); S1 = S1 * w4.y + (sa * b4.y + v * k4.y); S2 = S2 * w4.z + (sa * b4.z + v * k4.z); S3 = S3 * w4.w + (sa * b4.w + v * k4.w);
            float y = (S0 * r4.x + S1 * r4.y) + (S2 * r4.z + S3 * r4.w); y = red16(y);
            if (kq == 0) Ly[t * 32 + rl] = y;
        }
        __syncthreads();
        *(f32x4*)(YR + (rowbase + t0 + vt) * BW + colh + 32 * half + vc) = *(const LAS f32x4*)(Ly + vt * 32 + vc);
    }
#undef SCAN_LOAD
}

__device__ __forceinline__ void glds16(const void* gsrc, unsigned lds_dst) { unsigned keep;
    asm volatile("s_mov_b32 %0, m0\n\ts_mov_b32 m0, %2\n\ts_nop 0\n\tglobal_load_lds_dwordx4 %1, off\n\ts_mov_b32 m0, %0" : "=&s"(keep) : "v"(gsrc), "s"(lds_dst) : "memory"); }
__device__ __forceinline__ void glds4(const void* gsrc, unsigned lds_dst) { unsigned keep;
    asm volatile("s_mov_b32 %0, m0\n\ts_mov_b32 m0, %2\n\ts_nop 0\n\tglobal_load_lds_dword %1, off\n\ts_mov_b32 m0, %0" : "=&s"(keep) : "v"(gsrc), "s"(lds_dst) : "memory"); }
constexpr int SCAN_T = 8, SCAN_SLOT = 5 * SCAN_T * 256 + 512, SCAN_NSLOT = 3, SCAN_RING = SCAN_NSLOT * SCAN_SLOT;
typedef float f32x2 __attribute__((ext_vector_type(2)));
__device__ __forceinline__ void scan_wave(int lane, LAS unsigned char* ring, int hs, int r0, unsigned char* ws) {
    const int b = hs / 12, h = hs % 12;
    const float* SR = (const float*)(ws + WS_SR); const float* SW = (const float*)(ws + WS_SW); const float* SK = (const float*)(ws + WS_SK); const float* SU = (const float*)(ws + WS_SKK);
    const float* SB = (const float*)(ws + WS_SB); const float* SV = (const float*)(ws + WS_SV); const float* BK = (const float*)(ws + WS_BK); float* YR = (float*)(ws + WS_YRAW);
    const int rg = lane >> 4, kq = lane & 15;
    const size_t rowbase = (size_t)b * SEQ; const int colh = h * 64;
    const unsigned ring0 = (unsigned)(size_t)ring;
    const size_t voff = ((size_t)(lane >> 4)) * BW + colh + 4 * kq;
    const size_t vvoff = ((size_t)((lane & 31) >> 2)) * BW + colh + r0 + (lane & 3);
    const size_t bkoff = ((size_t)((lane & 15) >> 1) * 12 + h) * 2 + (lane & 1);
    constexpr int NCH = SEQ / SCAN_T;
#define SCAN_DMA(ch, slot) do { const int cc_ = (ch) < NCH ? (ch) : NCH - 1; const size_t tok_ = rowbase + (size_t)cc_ * SCAN_T; const unsigned sl_ = ring0 + (unsigned)(slot) * SCAN_SLOT; \
        _Pragma("unroll") for (int i_ = 0; i_ < 2; ++i_) { const size_t o_ = (tok_ + 4 * i_) * BW + voff; \
            glds16(SU + o_, sl_ + 0 * 2048 + i_ * 1024); glds16(SW + o_, sl_ + 1 * 2048 + i_ * 1024); glds16(SB + o_, sl_ + 2 * 2048 + i_ * 1024); glds16(SK + o_, sl_ + 3 * 2048 + i_ * 1024); glds16(SR + o_, sl_ + 4 * 2048 + i_ * 1024); } \
        glds4(SV + tok_ * BW + vvoff, sl_ + 10240); glds4(BK + tok_ * 24 + bkoff, sl_ + 10496); } while (0)
    SCAN_DMA(0, 0); SCAN_DMA(1, 1); SCAN_DMA(2, 2);
    f32x2 S01 = (f32x2){0.f, 0.f}, S23 = (f32x2){0.f, 0.f};
    float e_cur = 0.f, sa_prev = 0.f, v_prev = 0.f;
    int slot = 0;
    for (int ch = 0; ch < NCH; ++ch) {
        asm volatile("s_waitcnt vmcnt(24)" ::: "memory");
        const LAS unsigned char* sp = ring + slot * SCAN_SLOT;
        float ykeep = 0.f;
        f32x4 u4a[SCAN_T], w4a[SCAN_T], b4a[SCAN_T], k4a[SCAN_T], r4a[SCAN_T]; float va[SCAN_T]; f32x2 bka[SCAN_T];
#pragma unroll
        for (int tt = 0; tt < SCAN_T; ++tt) {
            u4a[tt] = *(const LAS f32x4*)(sp + 0 * 2048 + tt * 256 + kq * 16); bka[tt] = *(const LAS f32x2*)(sp + 10496 + tt * 8); va[tt] = *(const LAS float*)(sp + 10240 + tt * 16 + rg * 4);
            w4a[tt] = *(const LAS f32x4*)(sp + 1 * 2048 + tt * 256 + kq * 16); b4a[tt] = *(const LAS f32x4*)(sp + 2 * 2048 + tt * 256 + kq * 16);
            k4a[tt] = *(const LAS f32x4*)(sp + 3 * 2048 + tt * 256 + kq * 16); r4a[tt] = *(const LAS f32x4*)(sp + 4 * 2048 + tt * 256 + kq * 16); }
#pragma unroll
        for (int tt = 0; tt < SCAN_T; ++tt) {
            const f32x4 u4 = u4a[tt], w4 = w4a[tt], b4 = b4a[tt], k4 = k4a[tt], r4 = r4a[tt]; const float v = va[tt]; const f32x2 bk = bka[tt];
            f32x2 pe = S01 * (f32x2){u4.x, u4.y}; pe = S23 * (f32x2){u4.z, u4.w} + pe; const float e_next = red16(pe.x + pe.y);
            const float d = e_cur + sa_prev * bk.x + v_prev * bk.y; const float sa = -d;
            const f32x2 sav = (f32x2){sa, sa}, vv = (f32x2){v, v};
            S01 = S01 * (f32x2){w4.x, w4.y} + (sav * (f32x2){b4.x, b4.y} + vv * (f32x2){k4.x, k4.y});
            S23 = S23 * (f32x2){w4.z, w4.w} + (sav * (f32x2){b4.z, b4.w} + vv * (f32x2){k4.z, k4.w});
            f32x2 py = S01 * (f32x2){r4.x, r4.y}; py = S23 * (f32x2){r4.z, r4.w} + py; const float y = red16(py.x + py.y);
            ykeep = (kq == tt) ? y : ykeep;
            e_cur = e_next; sa_prev = sa; v_prev = v;
        }
        if (kq < SCAN_T) YR[(rowbase + (size_t)ch * SCAN_T + kq) * BW + colh + r0 + rg] = ykeep;
        SCAN_DMA(ch + 3, slot);
        slot = (slot == SCAN_NSLOT - 1) ? 0 : slot + 1;
    }
    asm volatile("s_waitcnt vmcnt(0)" ::: "memory");
#undef SCAN_DMA
}

constexpr int SH_T = 8, SH_SLOT = 10240 + 1024 + 256, SH_NSLOT = 11, SH_D = 4, SH_FLAGS = SCANRING_OFF + SH_NSLOT * SH_SLOT;
static_assert(SH_FLAGS + 64 <= LDSCTL_OFF, "scan ring + flags fit below the LDS control words");
__device__ __forceinline__ unsigned lds_ld(volatile LAS unsigned* p) { return *p; }
__device__ __forceinline__ void scan_loader(int lane, LAS unsigned char* lds, int hs, int rblk, unsigned char* ws) {
    const int b = hs / 12, h = hs % 12;
    const float* SR = (const float*)(ws + WS_SR); const float* SW = (const float*)(ws + WS_SW); const float* SK = (const float*)(ws + WS_SK); const float* SU = (const float*)(ws + WS_SKK);
    const float* SB = (const float*)(ws + WS_SB); const float* SV = (const float*)(ws + WS_SV); const float* BK = (const float*)(ws + WS_BK);
    const size_t rowbase = (size_t)b * SEQ; const int colh = h * 64;
    const unsigned ring0 = (unsigned)(size_t)(lds + SCANRING_OFF);
    volatile LAS unsigned* flags = (volatile LAS unsigned*)(lds + SH_FLAGS);
    const size_t voff = ((size_t)(lane >> 4)) * BW + colh + 4 * (lane & 15);
    const size_t vvoff = ((size_t)((lane >> 2) & 7)) * BW + colh + rblk + 4 * (lane & 3);
    const size_t bkoff = ((size_t)((lane & 15) >> 1) * 12 + h) * 2 + (lane & 1);
    constexpr int NCH = SEQ / SH_T;
    int slot = 0;
    for (int c = 0; c < NCH; ++c) {
        if (c >= SH_NSLOT) { const unsigned need = (unsigned)(c - SH_NSLOT + 1);
            while (lds_ld(flags + 1) < need || lds_ld(flags + 2) < need || lds_ld(flags + 3) < need || lds_ld(flags + 4) < need) __builtin_amdgcn_s_sleep(1); }
        const size_t tok = rowbase + (size_t)c * SH_T; const unsigned sl = ring0 + (unsigned)slot * SH_SLOT;
#pragma unroll
        for (int i = 0; i < 2; ++i) { const size_t o = (tok + 4 * i) * BW + voff;
            glds16(SU + o, sl + 0 * 2048 + i * 1024); glds16(SW + o, sl + 1 * 2048 + i * 1024); glds16(SB + o, sl + 2 * 2048 + i * 1024); glds16(SK + o, sl + 3 * 2048 + i * 1024); glds16(SR + o, sl + 4 * 2048 + i * 1024); }
        glds16(SV + tok * BW + vvoff, sl + 10240); glds4(BK + tok * 24 + bkoff, sl + 11264);
        if (c >= SH_D) { asm volatile("s_waitcnt vmcnt(48)" ::: "memory"); if (lane == 0) flags[0] = (unsigned)(c - SH_D + 1); }
        slot = (slot == SH_NSLOT - 1) ? 0 : slot + 1;
    }
    asm volatile("s_waitcnt vmcnt(0)" ::: "memory"); if (lane == 0) flags[0] = (unsigned)NCH;
}
__device__ __forceinline__ void scan_wave_sh(int lane, int w, LAS unsigned char* lds, int hs, int rblk, unsigned char* ws) {
    const int b = hs / 12, h = hs % 12; float* YR = (float*)(ws + WS_YRAW);
    const int rg = lane >> 4, kq = lane & 15, r0 = rblk + 4 * w;
    const size_t rowbase = (size_t)b * SEQ; const int colh = h * 64;
    volatile LAS unsigned* flags = (volatile LAS unsigned*)(lds + SH_FLAGS);
    constexpr int NCH = SEQ / SH_T;
    f32x2 S01 = (f32x2){0.f, 0.f}, S23 = (f32x2){0.f, 0.f};
    float e_cur = 0.f, sa_prev = 0.f, v_prev = 0.f;
    int slot = 0;
    for (int ch = 0; ch < NCH; ++ch) {
        while (lds_ld(flags) <= (unsigned)ch) __builtin_amdgcn_s_sleep(1);
        asm volatile("" ::: "memory");
        const LAS unsigned char* sp = lds + SCANRING_OFF + slot * SH_SLOT;
        float ykeep = 0.f;
        f32x4 u4a[SH_T], w4a[SH_T], b4a[SH_T], k4a[SH_T], r4a[SH_T]; float va[SH_T]; f32x2 bka[SH_T];
#pragma unroll
        for (int tt = 0; tt < SH_T; ++tt) {
            u4a[tt] = *(const LAS f32x4*)(sp + 0 * 2048 + tt * 256 + kq * 16); bka[tt] = *(const LAS f32x2*)(sp + 11264 + tt * 8); va[tt] = *(const LAS float*)(sp + 10240 + tt * 64 + (w * 4 + rg) * 4);
            w4a[tt] = *(const LAS f32x4*)(sp + 1 * 2048 + tt * 256 + kq * 16); b4a[tt] = *(const LAS f32x4*)(sp + 2 * 2048 + tt * 256 + kq * 16);
            k4a[tt] = *(const LAS f32x4*)(sp + 3 * 2048 + tt * 256 + kq * 16); r4a[tt] = *(const LAS f32x4*)(sp + 4 * 2048 + tt * 256 + kq * 16); }
#pragma unroll
        for (int tt = 0; tt < SH_T; ++tt) {
            const f32x4 u4 = u4a[tt], w4 = w4a[tt], b4 = b4a[tt], k4 = k4a[tt], r4 = r4a[tt]; const float v = va[tt]; const f32x2 bk = bka[tt];
            f32x2 pe = S01 * (f32x2){u4.x, u4.y}; pe = S23 * (f32x2){u4.z, u4.w} + pe; const float e_next = red16(pe.x + pe.y);
            const float d = e_cur + sa_prev * bk.x + v_prev * bk.y; const float sa = -d;
            const f32x2 sav = (f32x2){sa, sa}, vv = (f32x2){v, v};
            S01 = S01 * (f32x2){w4.x, w4.y} + (sav * (f32x2){b4.x, b4.y} + vv * (f32x2){k4.x, k4.y});
            S23 = S23 * (f32x2){w4.z, w4.w} + (sav * (f32x2){b4.z, b4.w} + vv * (f32x2){k4.z, k4.w});
            f32x2 py = S01 * (f32x2){r4.x, r4.y}; py = S23 * (f32x2){r4.z, r4.w} + py; const float y = red16(py.x + py.y);
            ykeep = (kq == tt) ? y : ykeep;
            e_cur = e_next; sa_prev = sa; v_prev = v;
        }
        if (kq < SH_T) YR[(rowbase + (size_t)ch * SH_T + kq) * BW + colh + r0 + rg] = ykeep;
        asm volatile("" ::: "memory");
        if (lane == 0) flags[1 + w] = (unsigned)(ch + 1);
        slot = (slot == SH_NSLOT - 1) ? 0 : slot + 1;
    }
}

constexpr int CH_REC = COP_RY * 4;
constexpr int CH_SLOT = CH_REC + 4096, CH_NSLOT = 6, CH_D = 4, CH_FLAGS = SCANRING_OFF + CH_NSLOT * CH_SLOT;
static_assert(CH_FLAGS + 64 <= LDSCTL_OFF, "chain ring + flags fit below the LDS control words");
__device__ __forceinline__ float* sst_base(unsigned char* ws, int hs) { return (float*)(ws + (hs < 16 ? WS_SST_A + (size_t)hs * 8 * MiB : WS_SST_B + (size_t)(hs - 16) * 8 * MiB)); }
__device__ __forceinline__ void chain_loader(int lane, int which, LAS unsigned char* lds, int hs, unsigned char* ws) {
    const int b = hs / 12, h = hs % 12;
    const float* COP = (const float*)(ws + WS_COP) + (size_t)hs * 512 * COP_STRIDE; const float* SV = (const float*)(ws + WS_SV);
    const unsigned ring0 = (unsigned)(size_t)(lds + SCANRING_OFF);
    volatile LAS unsigned* flags = (volatile LAS unsigned*)(lds + CH_FLAGS);
    const int fidx = which == 0 ? 0 : 4 + which;
    const size_t vsrc = ((size_t)b * SEQ + (lane >> 4)) * BW + h * 64 + 4 * (lane & 15);
    int slot = 0; unsigned dmin = 0u, pub = 0u;
    for (int c = 0; c < 512; ++c) {
        if (c >= CH_NSLOT) { const unsigned need = (unsigned)(c - CH_NSLOT + 1);
            if (dmin < need) {
                asm volatile("s_waitcnt vmcnt(0)" ::: "memory"); if (pub < (unsigned)c) { pub = (unsigned)c; if (lane == 0) flags[fidx] = pub; }
                for (;;) { const unsigned d1 = lds_ld(flags + 1), d2 = lds_ld(flags + 2), d3 = lds_ld(flags + 3), d4 = lds_ld(flags + 4); dmin = min(min(d1, d2), min(d3, d4)); if (dmin >= need) break; __builtin_amdgcn_s_sleep(1); } } }
        const float* rec = COP + (size_t)c * COP_STRIDE; const unsigned sl = ring0 + (unsigned)slot * CH_SLOT;
        if (which < 2) {
#pragma unroll
            for (int i = 0; i < 5; ++i) glds16(rec + (5 * which + i) * 256 + lane * 4, sl + (5 * which + i) * 1024);
            if (c >= CH_D) asm volatile("s_waitcnt vmcnt(20)" ::: "memory");
        } else if (which == 2) {
#pragma unroll
            for (int i = 10; i < 14; ++i) glds16(rec + i * 256 + lane * 4, sl + i * 1024);
            glds4(rec + COP_GAM + lane, sl + 14 * 1024);
            if (c >= CH_D) asm volatile("s_waitcnt vmcnt(20)" ::: "memory");
        } else {
#pragma unroll
            for (int i = 0; i < 4; ++i) glds16(SV + vsrc + (size_t)(c * 16 + 4 * i) * BW, sl + CH_REC + i * 1024);
            if (c >= CH_D) asm volatile("s_waitcnt vmcnt(16)" ::: "memory");
        }
        if (c >= CH_D && pub < (unsigned)(c - CH_D + 1)) { pub = (unsigned)(c - CH_D + 1); if (lane == 0) flags[fidx] = pub; }
        slot = (slot == CH_NSLOT - 1) ? 0 : slot + 1;
    }
    asm volatile("s_waitcnt vmcnt(0)" ::: "memory"); if (lane == 0) flags[fidx] = 512u;
}
#define MFMAB(a, b, c) __builtin_amdgcn_mfma_f32_16x16x32_bf16(__builtin_bit_cast(pg8::bf16x8, (a)), __builtin_bit_cast(pg8::bf16x8, (b)), (c), 0, 0, 0)
__device__ __forceinline__ void scan_chain(int lane, int vs, LAS unsigned char* lds, int hs, unsigned char* ws) {
    const int li = lane & 15, q = lane >> 4;
    volatile LAS unsigned* flags = (volatile LAS unsigned*)(lds + CH_FLAGS);
    f32x4c St[4];
#pragma unroll
    for (int m = 0; m < 4; ++m) St[m] = (f32x4c){0.f, 0.f, 0.f, 0.f};
    float* sst = sst_base(ws, hs) + ((size_t)vs * 64 + lane) * 16;
    int slot = 0; unsigned favail = 0u;
    for (int c = 0; c < 512; ++c) {
        if (favail <= (unsigned)c) {
            for (;;) { const unsigned a0 = lds_ld(flags), a1 = lds_ld(flags + 5), a2 = lds_ld(flags + 6), a3 = lds_ld(flags + 7); const unsigned mn = min(min(a0, a1), min(a2, a3)); favail = mn; if (mn > (unsigned)c) break; __builtin_amdgcn_s_sleep(1); } }
        asm volatile("" ::: "memory");
        const LAS unsigned* sp = (const LAS unsigned*)(lds + SCANRING_OFF + slot * CH_SLOT);
        v4u w1h[2], w1l[2], bkh[4], bkl[4]; f32x4 gf[4]; float vc[4];
#pragma unroll
        for (int kb = 0; kb < 2; ++kb) { w1h[kb] = *(const LAS v4u*)(sp + COP_W1 + lane * 16 + 8 * kb); w1l[kb] = *(const LAS v4u*)(sp + COP_W1 + lane * 16 + 8 * kb + 4); }
        const v4u u0h = *(const LAS v4u*)(sp + COP_U0 + lane * 8), u0l = *(const LAS v4u*)(sp + COP_U0 + lane * 8 + 4);
#pragma unroll
        for (int m = 0; m < 4; ++m) { bkh[m] = *(const LAS v4u*)(sp + COP_BK + lane * 32 + 8 * m); bkl[m] = *(const LAS v4u*)(sp + COP_BK + lane * 32 + 8 * m + 4); gf[m] = *(const LAS f32x4*)((const LAS float*)sp + COP_GAM + 16 * m + 4 * q); }
#pragma unroll
        for (int s_ = 0; s_ < 4; ++s_) vc[s_] = ((const LAS float*)sp)[COP_RY + (4 * q + s_) * 64 + 16 * vs + li];
        v4u sh[2], sl_[2];
#pragma unroll
        for (int kb = 0; kb < 2; ++kb) { float x[8];
#pragma unroll
            for (int jj = 0; jj < 8; ++jj) x[jj] = St[2 * kb + (jj >> 2)][jj & 3];
            split8(x, sh[kb], sl_[kb]); }
        v4u vh, vl; { float x[8] = {vc[0], vc[1], vc[2], vc[3], 0.f, 0.f, 0.f, 0.f}; split8(x, vh, vl); }
#pragma unroll
        for (int m = 0; m < 4; ++m) *(f32x4*)(sst + (size_t)c * 4096 + 4 * m) = St[m];
        f32x4c z0 = {0.f, 0.f, 0.f, 0.f}, z1 = {0.f, 0.f, 0.f, 0.f}, z2 = {0.f, 0.f, 0.f, 0.f};
        z0 = MFMAB(w1h[0], sh[0], z0); z1 = MFMAB(w1h[0], sl_[0], z1); z2 = MFMAB(w1l[0], sh[0], z2);
        z0 = MFMAB(w1h[1], sh[1], z0); z1 = MFMAB(w1h[1], sl_[1], z1); z2 = MFMAB(w1l[1], sh[1], z2);
        z0 = MFMAB(u0h, vh, z0); z1 = MFMAB(u0h, vl, z1); z2 = MFMAB(u0l, vh, z2);
#pragma unroll
        for (int m = 0; m < 4; ++m) St[m] *= gf[m];
        const f32x4c z = z0 + (z1 + z2);
        v4u zh, zl; { float x[8] = {z[0], z[1], z[2], z[3], vc[0], vc[1], vc[2], vc[3]}; split8(x, zh, zl); }
#pragma unroll
        for (int m = 0; m < 4; ++m) St[m] = MFMAB(bkh[m], zh, St[m]);
#pragma unroll
        for (int m = 0; m < 4; ++m) St[m] = MFMAB(bkh[m], zl, St[m]);
#pragma unroll
        for (int m = 0; m < 4; ++m) St[m] = MFMAB(bkl[m], zh, St[m]);
        asm volatile("" ::: "memory");
        if (lane == 0) flags[1 + vs] = (unsigned)(c + 1);
        slot = (slot == CH_NSLOT - 1) ? 0 : slot + 1;
    }
}

struct AttnPass { int qcol; int bias_head; int tbl; float sink; int use_sink; int maxsteps; bf16* out; int out_ld; int out_col; float* lse; };
__device__ __forceinline__ void attn_stage_kv(const Ctx& C, const bf16* P1, int b, int res, int dil, int fblk, int kcol, int vcol) {
    LAS unsigned char* Ks = C.lds + RING_OFF; LAS unsigned char* Vs = Ks + 256 * 144;
#pragma unroll
    for (int i = 0; i < 4; ++i) { const int c = C.tid + 512 * i, row = c >> 3, part = c & 7; const int fp = (fblk - 1) * 128 + row;
        v4u kv = (v4u){0u, 0u, 0u, 0u}, vv = (v4u){0u, 0u, 0u, 0u};
        if (fp >= 0) { const bf16* src = P1 + ((size_t)b * SEQ + (size_t)fp * dil + res) * NP1; kv = *(const v4u*)(src + kcol + part * 8); vv = *(const v4u*)(src + vcol + part * 8); }
        *(LAS v4u*)(Ks + row * 144 + part * 16) = kv; *(LAS v4u*)(Vs + row * 144 + part * 16) = vv; }
}
__device__ __forceinline__ void attn_pass(const Ctx& C, const bf16* P1, const float* relb, int b, int res, int dil, int fblk, const AttnPass& ap) {
    LAS unsigned char* Ks = C.lds + RING_OFF; LAS unsigned char* Vs = Ks + 256 * 144; LAS float* lut = (LAS float*)(Vs + 256 * 144);
    __syncthreads();
    if (C.tid < 132) lut[C.tid] = (C.tid <= 128) ? relb[(int)T5B[ap.tbl][C.tid] * 20 + ap.bias_head] : 0.f;
    __syncthreads();
    const int i = C.tid >> 2, dq = C.tid & 3;
    const size_t tok = (size_t)b * SEQ + (size_t)(fblk * 128 + i) * dil + res;
    float q[16];
    { const bf16* qp = P1 + tok * NP1 + ap.qcol + dq * 16; const v4u a0 = *(const v4u*)qp, a1 = *(const v4u*)(qp + 8);
      q[0] = bflo(a0.x); q[1] = bfhi(a0.x); q[2] = bflo(a0.y); q[3] = bfhi(a0.y); q[4] = bflo(a0.z); q[5] = bfhi(a0.z); q[6] = bflo(a0.w); q[7] = bfhi(a0.w);
      q[8] = bflo(a1.x); q[9] = bfhi(a1.x); q[10] = bflo(a1.y); q[11] = bfhi(a1.y); q[12] = bflo(a1.z); q[13] = bfhi(a1.z); q[14] = bflo(a1.w); q[15] = bfhi(a1.w);
#pragma unroll
      for (int j = 0; j < 16; ++j) q[j] *= 0.125f; }
    float mrun = ap.use_sink ? ap.sink : -INFINITY, lrun = ap.use_sink ? 1.0f : 0.0f;
    float o[16];
#pragma unroll
    for (int j = 0; j < 16; ++j) o[j] = 0.f;
    const int fq0 = fblk * 128 + i;
    for (int dist = 0; dist <= ap.maxsteps; ++dist) {
        const int kr = i + 128 - dist;
        const bool valid = (fq0 - dist) >= 0;
        const v4u k0 = *(const LAS v4u*)(Ks + kr * 144 + dq * 32), k1 = *(const LAS v4u*)(Ks + kr * 144 + dq * 32 + 16);
        float s = q[0] * bflo(k0.x) + q[1] * bfhi(k0.x) + q[2] * bflo(k0.y) + q[3] * bfhi(k0.y) + q[4] * bflo(k0.z) + q[5] * bfhi(k0.z) + q[6] * bflo(k0.w) + q[7] * bfhi(k0.w)
                + q[8] * bflo(k1.x) + q[9] * bfhi(k1.x) + q[10] * bflo(k1.y) + q[11] * bfhi(k1.y) + q[12] * bflo(k1.z) + q[13] * bfhi(k1.z) + q[14] * bflo(k1.w) + q[15] * bfhi(k1.w);
        s = red4(s) + lut[dist];
        if (valid) {
            if (s > mrun) { const float c = __expf(mrun - s); lrun *= c;
#pragma unroll
                for (int j = 0; j < 16; ++j) o[j] *= c;
                mrun = s; }
            const float p = __expf(s - mrun); lrun += p;
            const v4u v0 = *(const LAS v4u*)(Vs + kr * 144 + dq * 32), v1 = *(const LAS v4u*)(Vs + kr * 144 + dq * 32 + 16);
            o[0] += p * bflo(v0.x); o[1] += p * bfhi(v0.x); o[2] += p * bflo(v0.y); o[3] += p * bfhi(v0.y); o[4] += p * bflo(v0.z); o[5] += p * bfhi(v0.z); o[6] += p * bflo(v0.w); o[7] += p * bfhi(v0.w);
            o[8] += p * bflo(v1.x); o[9] += p * bfhi(v1.x); o[10] += p * bflo(v1.y); o[11] += p * bfhi(v1.y); o[12] += p * bflo(v1.z); o[13] += p * bfhi(v1.z); o[14] += p * bflo(v1.w); o[15] += p * bfhi(v1.w);
        }
    }
    const float inv = 1.0f / lrun;
    v4u w0, w1;
    w0.x = pk2(o[0] * inv, o[1] * inv); w0.y = pk2(o[2] * inv, o[3] * inv); w0.z = pk2(o[4] * inv, o[5] * inv); w0.w = pk2(o[6] * inv, o[7] * inv);
    w1.x = pk2(o[8] * inv, o[9] * inv); w1.y = pk2(o[10] * inv, o[11] * inv); w1.z = pk2(o[12] * inv, o[13] * inv); w1.w = pk2(o[14] * inv, o[15] * inv);
    bf16* op = ap.out + tok * ap.out_ld + ap.out_col + dq * 16;
    *(v4u*)op = w0; *(v4u*)(op + 8) = w1;
    if (ap.lse && dq == 0) ap.lse[tok * 4] = mrun + __logf(lrun);
}
__device__ __forceinline__ void phase_attn(const Ctx& C, const Args& a, int l, unsigned char* ws, int ab, int nab) {
    const bf16* P1 = (const bf16*)(ws + WS_P1); const float* relb = a.in[1]; const float* sinks = a.in[4] + l * 8;
    bf16* YA = (bf16*)(ws + WS_YA); bf16* OC = (bf16*)(ws + WS_OC); float* LSE = (float*)(ws + WS_LSE);
    constexpr int NA = 256, NC = 1536;
    for (int it = ab; it < NA + NC; it += nab) {
        __syncthreads();
        if (it < NA) {
            const int b = it >> 7, fblk = (it >> 1) & 63, hkv = it & 1;
            attn_stage_kv(C, P1, b, 0, 1, fblk, C_AK + hkv * 64, C_AV + hkv * 64);
            for (int g = 0; g < 4; ++g) { const int hq = hkv * 4 + g;
                AttnPass ap; ap.qcol = C_AQ + hq * 64; ap.bias_head = hq; ap.tbl = 0; ap.sink = sinks[hq]; ap.use_sink = 1; ap.maxsteps = 127; ap.out = YA; ap.out_ld = 512; ap.out_col = hq * 64; ap.lse = nullptr;
                attn_pass(C, P1, relb, b, 0, 1, fblk, ap); }
        } else {
            const int ci = it - NA; const int gi = ci / 512, j = (ci >> 7) & 3, qb = ci & 127;
            const int dil = (gi == 0) ? 1 : (gi == 1 ? 4 : 16); const int bps = 64 / dil;
            const int n = qb / bps, fblk = qb % bps, b = n / dil, res = n % dil; const int hc = gi * 4 + j;
            attn_stage_kv(C, P1, b, res, dil, fblk, C_CK + hc * 64, C_CV + hc * 64);
            AttnPass ap; ap.qcol = C_CQ + hc * 64; ap.bias_head = 8 + hc; ap.tbl = gi; ap.sink = 0.f; ap.use_sink = 0; ap.maxsteps = 128; ap.out = OC + (size_t)gi * M * 256; ap.out_ld = 256; ap.out_col = j * 64;
            ap.lse = LSE + (size_t)gi * M * 4 + j;
            attn_pass(C, P1, relb, b, res, dil, fblk, ap);
        }
    }
}

__device__ __forceinline__ void phase_vt(const Ctx& C, unsigned char* ws) {
    const bf16* P1 = (const bf16*)(ws + WS_P1); bf16* VT = (bf16*)(ws + WS_VT);
    for (int it = C.gw; it < 14 * 2 * 128; it += C.ngw) {
        const int hs = it / 256, b = (it >> 7) & 1, blk = it & 127;
        const int gi = hs < 2 ? 0 : (hs - 2) >> 2; const int dil = gi == 0 ? 1 : (gi == 1 ? 4 : 16); const int Lf = SEQ / dil;
        const int vcol = hs < 2 ? C_AV + hs * 64 : C_CV + (hs - 2) * 64;
        const int ft = blk * 64 + C.lane;
        const int res = ft / Lf, tp = ft % Lf; const int tok = b * SEQ + tp * dil + res;
        const v4u* src = (const v4u*)(P1 + (size_t)tok * NP1 + vcol);
        v4u x[8];
#pragma unroll
        for (int i = 0; i < 8; ++i) x[i] = src[i];
        bf16* dst = VT + ((size_t)(hs * 2 + b) * 64) * SEQ + ft;
#pragma unroll
        for (int i = 0; i < 8; ++i) {
            dst[(size_t)(8 * i + 0) * SEQ] = (bf16)(x[i].x & 0xffffu); dst[(size_t)(8 * i + 1) * SEQ] = (bf16)(x[i].x >> 16);
            dst[(size_t)(8 * i + 2) * SEQ] = (bf16)(x[i].y & 0xffffu); dst[(size_t)(8 * i + 3) * SEQ] = (bf16)(x[i].y >> 16);
            dst[(size_t)(8 * i + 4) * SEQ] = (bf16)(x[i].z & 0xffffu); dst[(size_t)(8 * i + 5) * SEQ] = (bf16)(x[i].z >> 16);
            dst[(size_t)(8 * i + 6) * SEQ] = (bf16)(x[i].w & 0xffffu); dst[(size_t)(8 * i + 7) * SEQ] = (bf16)(x[i].w >> 16);
        }
    }
}

typedef float f32x16 __attribute__((ext_vector_type(16)));
__device__ __forceinline__ void attn_wave_item(int lane, const LAS float* lutall, int item, const float* sinks, unsigned char* ws) {
    const bf16* P1 = (const bf16*)(ws + WS_P1); const bf16* VT = (const bf16*)(ws + WS_VT);
    const int hh = item % 20, g32 = item / 20;
    const bool isA = hh < 8; const int hc = hh - 8; const int gi = isA ? 0 : hc >> 2, j = hc & 3;
    const int dil = gi == 0 ? 1 : (gi == 1 ? 4 : 16); const int Lf = SEQ / dil, gps = Lf / 32;
    const int b = g32 >> 8, rr = g32 & 255, res = rr / gps, qg = rr % gps, fq0 = qg * 32;
    const int qcol = isA ? C_AQ + hh * 64 : C_CQ + hc * 64, kcol = isA ? C_AK + (hh >> 2) * 64 : C_CK + hc * 64;
    const int hs = isA ? (hh >> 2) : 2 + hc;
    const int r = lane & 31, hf = lane >> 5;
    const LAS float* lut = lutall + hh * 192 + (31 - r + 8 * hf);
    const int pr = (r & 0x13) | ((r & 8) >> 1) | ((r & 4) << 1);
    const size_t tokq = (size_t)b * SEQ + (size_t)(fq0 + r) * dil + res;
    pg8::bf16x8 qf[4];
    { const bf16* qrow = P1 + tokq * NP1 + qcol + 8 * hf;
#pragma unroll
      for (int s_ = 0; s_ < 4; ++s_) qf[s_] = *(const pg8::bf16x8*)(qrow + 16 * s_); }
    f32x16 sc[5];
#pragma unroll
    for (int kt = 0; kt < 5; ++kt) {
        int fk = fq0 - 128 + 32 * kt + pr; fk = fk < 0 ? 0 : fk;
        const bf16* krow = P1 + ((size_t)b * SEQ + (size_t)fk * dil + res) * NP1 + kcol + 8 * hf;
        f32x16 acc;
#pragma unroll
        for (int q = 0; q < 16; ++q) acc[q] = 0.f;
#pragma unroll
        for (int s_ = 0; s_ < 4; ++s_) { const pg8::bf16x8 a = *(const pg8::bf16x8*)(krow + 16 * s_); acc = __builtin_amdgcn_mfma_f32_32x32x16_bf16(a, qf[s_], acc, 0, 0, 0); }
        sc[kt] = acc;
    }
    float mx = -1e30f;
#pragma unroll
    for (int kt = 0; kt < 5; ++kt)
#pragma unroll
        for (int q = 0; q < 16; ++q) { const int koff = (q & 3) + 4 * ((q >> 2) & 1) + 16 * (q >> 3);
            const float sv = sc[kt][q] * 0.125f + lut[32 * kt + koff]; sc[kt][q] = sv; }
    if (fq0 < 128) {
#pragma unroll
        for (int kt = 0; kt < 5; ++kt)
#pragma unroll
            for (int q = 0; q < 16; ++q) { const int koff = (q & 3) + 4 * ((q >> 2) & 1) + 16 * (q >> 3) + 8 * hf; if (fq0 - 128 + 32 * kt + koff < 0) sc[kt][q] = -1e30f; }
    }
#pragma unroll
    for (int kt = 0; kt < 5; ++kt)
#pragma unroll
        for (int q = 0; q < 16; ++q) mx = fmaxf(mx, sc[kt][q]);
    mx = fmaxf(mx, shx(mx, 32, lane));
    const float sink = isA ? sinks[hh] : -1e30f;
    mx = fmaxf(mx, sink);
    float lsum = 0.f;
#pragma unroll
    for (int kt = 0; kt < 5; ++kt)
#pragma unroll
        for (int q = 0; q < 16; ++q) { const float pv = __expf(sc[kt][q] - mx); sc[kt][q] = pv; lsum += pv; }
    lsum += shx(lsum, 32, lane);
    const float denom = isA ? lsum + __expf(sink - mx) : lsum;
    const float inv = 1.0f / denom;
    pg8::bf16x8 pf[5][2];
#pragma unroll
    for (int kt = 0; kt < 5; ++kt)
#pragma unroll
        for (int s_ = 0; s_ < 2; ++s_) { pg8::u32x4 w;
            w.x = pg8::cvt_pk_bf16(sc[kt][8 * s_ + 0], sc[kt][8 * s_ + 1]); w.y = pg8::cvt_pk_bf16(sc[kt][8 * s_ + 2], sc[kt][8 * s_ + 3]);
            w.z = pg8::cvt_pk_bf16(sc[kt][8 * s_ + 4], sc[kt][8 * s_ + 5]); w.w = pg8::cvt_pk_bf16(sc[kt][8 * s_ + 6], sc[kt][8 * s_ + 7]);
            pf[kt][s_] = __builtin_bit_cast(pg8::bf16x8, w); }
    bf16* outp; int out_ld, ocol;
    if (isA) { outp = (bf16*)(ws + WS_YA); out_ld = 1536; ocol = hh * 64; } else { outp = (bf16*)(ws + WS_OC) + (size_t)gi * M * 256; out_ld = 256; ocol = j * 64; }
    const bf16* vth = VT + ((size_t)(hs * 2 + b) * 64) * SEQ + (size_t)res * Lf;
#pragma unroll
    for (int dt = 0; dt < 2; ++dt) {
        const bf16* vrow = vth + (size_t)(32 * dt + r) * SEQ;
        f32x16 acc;
#pragma unroll
        for (int q = 0; q < 16; ++q) acc[q] = 0.f;
#pragma unroll
        for (int kt = 0; kt < 5; ++kt)
#pragma unroll
            for (int s_ = 0; s_ < 2; ++s_) {
                int k0 = fq0 - 128 + 32 * kt + 16 * s_ + 8 * hf; k0 = k0 < 0 ? 0 : k0;
                acc = __builtin_amdgcn_mfma_f32_32x32x16_bf16(*(const pg8::bf16x8*)(vrow + k0), pf[kt][s_], acc, 0, 0, 0);
            }
        bf16* op = outp + tokq * out_ld + ocol + 32 * dt + 4 * hf;
#pragma unroll
        for (int g = 0; g < 4; ++g) { v2u w; w.x = pg8::cvt_pk_bf16(acc[4 * g + 0] * inv, acc[4 * g + 1] * inv); w.y = pg8::cvt_pk_bf16(acc[4 * g + 2] * inv, acc[4 * g + 3] * inv);
            *(v2u*)(op + 8 * g) = w; }
    }
    if (!isA && hf == 0) ((float*)(ws + WS_LSE))[((size_t)gi * M + tokq) * 4 + j] = mx + __logf(lsum);
}
__device__ __forceinline__ void build_lut(const Ctx& C, const float* relb) {
    LAS float* lut = (LAS float*)(C.lds + LUT_OFF);
    for (int i = C.tid; i < 20 * 192; i += NTHREADS) { const int hh = i / 192, x = i % 192; const int tbl = hh < 8 ? 0 : (hh - 8) >> 2; const int dist = 159 - x; const int maxsteps = hh < 8 ? 127 : 128;
        lut[i] = (dist >= 0 && dist <= maxsteps) ? relb[(int)T5B[tbl][dist] * 20 + hh] : -1e30f; }
    __syncthreads();
}

__device__ __forceinline__ void phase_post(const Ctx& C, const Args& a, int l, unsigned char* ws) {
    const float* SV = (const float*)(ws + WS_SV); const float* BON = (const float*)(ws + WS_BON); const float* COP = (const float*)(ws + WS_COP);
    const float* LO = (const float*)(ws + WS_LO); bf16* YB = (bf16*)(ws + WS_YA);
    const float* lgp = a.in[14] + (size_t)l * BW; const float* lbp = a.in[15] + (size_t)l * BW;
    const int lane = C.lane, li = lane & 15, q = lane >> 4;
    LAS float* Vt = (LAS float*)(C.lds + RING_OFF) + C.wave * 2048; LAS float* Yt = Vt + 1024;
    const int tk = lane >> 2, pt = lane & 3;
    for (int it = C.gw; it < 24 * 512; it += C.ngw) {
        const int hs = it >> 9, c = it & 511, b = hs / 12, h = hs % 12; const int m0 = b * SEQ + c * 16;
        const float* rec = COP + ((size_t)hs * 512 + c) * COP_STRIDE; const float* sst = sst_base(ws, hs) + (size_t)c * 4096 + (size_t)lane * 16;
#pragma unroll
        for (int i = 0; i < 4; ++i) *(LAS f32x4*)(Vt + (4 * i + q) * 64 + 4 * li) = *(const f32x4*)(SV + (size_t)(m0 + 4 * i + q) * BW + h * 64 + 4 * li);
        f32x4 ryf[4]; const f32x4 y0f = *(const f32x4*)(rec + COP_Y0 + lane * 4);
#pragma unroll
        for (int m = 0; m < 4; ++m) ryf[m] = *(const f32x4*)(rec + COP_RY + lane * 16 + 4 * m);
        const int mt = m0 + tk; f32x4 gt[4], lgv[4], lbv[4];
#pragma unroll
        for (int e = 0; e < 4; ++e) { gt[e] = *(const f32x4*)(LO + (size_t)mt * NLORA + 2 * BW + h * 64 + 16 * pt + 4 * e); lgv[e] = *(const f32x4*)(lgp + h * 64 + 16 * pt + 4 * e); lbv[e] = *(const f32x4*)(lbp + h * 64 + 16 * pt + 4 * e); }
        const float bo = BON[(size_t)mt * 12 + h];
        LDS_WAIT(); asm volatile("" ::: "memory");
#pragma unroll
        for (int vs = 0; vs < 4; ++vs) {
            f32x4 st[4]; float vv[4];
#pragma unroll
            for (int m = 0; m < 4; ++m) st[m] = *(const f32x4*)(sst + (size_t)vs * 1024 + 4 * m);
#pragma unroll
            for (int s_ = 0; s_ < 4; ++s_) vv[s_] = Vt[(4 * q + s_) * 64 + 16 * vs + li];
            f32x4c acc = {0.f, 0.f, 0.f, 0.f};
#pragma unroll
            for (int m = 0; m < 4; ++m)
#pragma unroll
                for (int j = 0; j < 4; ++j) acc = MFMA4(ryf[m][j], st[m][j], acc);
#pragma unroll
            for (int s_ = 0; s_ < 4; ++s_) acc = MFMA4(y0f[s_], vv[s_], acc);
#pragma unroll
            for (int j = 0; j < 4; ++j) Yt[(4 * q + j) * 64 + 16 * vs + li] = acc[j];
        }
        LDS_WAIT(); asm volatile("" ::: "memory");
        f32x4 yv[4], vr[4]; float sm = 0.f;
#pragma unroll
        for (int e = 0; e < 4; ++e) { yv[e] = *(const LAS f32x4*)(Yt + tk * 64 + 16 * pt + 4 * e); vr[e] = *(const LAS f32x4*)(Vt + tk * 64 + 16 * pt + 4 * e); sm += (yv[e][0] + yv[e][1]) + (yv[e][2] + yv[e][3]); }
        const float mean = red4(sm) * (1.0f / 64.0f); float sq = 0.f;
#pragma unroll
        for (int e = 0; e < 4; ++e) { yv[e] = yv[e] - mean; sq += (yv[e][0] * yv[e][0] + yv[e][1] * yv[e][1]) + (yv[e][2] * yv[e][2] + yv[e][3] * yv[e][3]); }
        const float rsd = __builtin_amdgcn_rsqf(red4(sq) * (1.0f / 64.0f) + GN_EPS);
        v4u o0, o1; f32x4 r0 = (yv[0] * rsd * lgv[0] + lbv[0] + vr[0] * bo) * gt[0], r1 = (yv[1] * rsd * lgv[1] + lbv[1] + vr[1] * bo) * gt[1];
        f32x4 r2 = (yv[2] * rsd * lgv[2] + lbv[2] + vr[2] * bo) * gt[2], r3 = (yv[3] * rsd * lgv[3] + lbv[3] + vr[3] * bo) * gt[3];
        o0.x = pk2(r0[0], r0[1]); o0.y = pk2(r0[2], r0[3]); o0.z = pk2(r1[0], r1[1]); o0.w = pk2(r1[2], r1[3]);
        o1.x = pk2(r2[0], r2[1]); o1.y = pk2(r2[2], r2[3]); o1.z = pk2(r3[0], r3[1]); o1.w = pk2(r3[2], r3[3]);
        bf16* op = YB + (size_t)mt * 1536 + 512 + h * 64 + 16 * pt;
        *(v4u*)op = o0; *(v4u*)(op + 8) = o1;
        LDS_WAIT(); asm volatile("" ::: "memory");
    }
    const bf16* OC = (const bf16*)(ws + WS_OC); const float* LSE = (const float*)(ws + WS_LSE); bf16* YC = (bf16*)(ws + WS_YA);
    for (int mb = C.gw * 4; mb < M; mb += C.ngw * 4) {
        const int j = C.lane >> 4;
        float l0[4], l1[4], l2[4]; v2u a0[4], a1[4], a2[4];
#pragma unroll
        for (int i = 0; i < 4; ++i) { const int m = mb + i; l0[i] = LSE[(size_t)m * 4 + j]; l1[i] = LSE[((size_t)M + m) * 4 + j]; l2[i] = LSE[((size_t)2 * M + m) * 4 + j];
            a0[i] = *(const v2u*)(OC + (size_t)m * 256 + 4 * C.lane); a1[i] = *(const v2u*)(OC + ((size_t)M + m) * 256 + 4 * C.lane); a2[i] = *(const v2u*)(OC + ((size_t)2 * M + m) * 256 + 4 * C.lane); }
#pragma unroll
        for (int i = 0; i < 4; ++i) { const int m = mb + i;
            const float mx = fmaxf(l0[i], fmaxf(l1[i], l2[i])); const float e0 = __expf(l0[i] - mx), e1 = __expf(l1[i] - mx), e2 = __expf(l2[i] - mx); const float inv = 1.0f / (e0 + e1 + e2);
            const float w0 = e0 * inv, w1 = e1 * inv, w2 = e2 * inv;
            v2u o; o.x = pk2(w0 * bflo(a0[i].x) + w1 * bflo(a1[i].x) + w2 * bflo(a2[i].x), w0 * bfhi(a0[i].x) + w1 * bfhi(a1[i].x) + w2 * bfhi(a2[i].x));
            o.y = pk2(w0 * bflo(a0[i].y) + w1 * bflo(a1[i].y) + w2 * bflo(a2[i].y), w0 * bfhi(a0[i].y) + w1 * bfhi(a1[i].y) + w2 * bfhi(a2[i].y));
            *(v2u*)(YC + (size_t)m * 1536 + 1280 + 4 * C.lane) = o; }
    }
}

__device__ __forceinline__ void unpack8(const v4u w, float (&x)[8]) { x[0] = bflo(w.x); x[1] = bfhi(w.x); x[2] = bflo(w.y); x[3] = bfhi(w.y); x[4] = bflo(w.z); x[5] = bfhi(w.z); x[6] = bflo(w.w); x[7] = bfhi(w.w); }
__device__ __forceinline__ void phase_conv(const Ctx& C, const Args& a, int l, unsigned char* ws) {
    const bf16* U = (const bf16*)(ws + WS_U); bf16* ACT = (bf16*)(ws + WS_ACT); const float* cw = a.in[22] + (size_t)l * 3 * DFF;
    constexpr int GPR = DFF / 8, RUN = 32;
    const int gt = C.bid * NTHREADS + C.tid, ngt = C.G * NTHREADS;
    for (int idx = gt; idx < (M / RUN) * GPR; idx += ngt) {
        const int run = idx / GPR, f0 = (idx % GPR) * 8, m0 = run * RUN;
        float c0[8], c1[8], c2[8];
#pragma unroll
        for (int j = 0; j < 8; ++j) { c0[j] = cw[f0 + j]; c1[j] = cw[DFF + f0 + j]; c2[j] = cw[2 * DFF + f0 + j]; }
        const bf16* ur = U + (size_t)m0 * NUP + f0;
        float x0[8], x1[8];
        { v4u g0 = (v4u){0u, 0u, 0u, 0u}, g1 = (v4u){0u, 0u, 0u, 0u};
          if ((m0 & (SEQ - 1)) != 0) { g0 = *(const v4u*)(ur - 2 * NUP); g1 = *(const v4u*)(ur - NUP); }
          unpack8(g0, x0); unpack8(g1, x1); }
#pragma unroll 1
        for (int tq = 0; tq < RUN; tq += 4) {
            v4u gq[4], vq[4];
#pragma unroll
            for (int i = 0; i < 4; ++i) { gq[i] = *(const v4u*)(ur + (size_t)(tq + i) * NUP); vq[i] = *(const v4u*)(ur + (size_t)(tq + i) * NUP + DFF); }
#pragma unroll
            for (int i = 0; i < 4; ++i) {
                float x2[8], vl[8], r[8]; unpack8(gq[i], x2); unpack8(vq[i], vl);
#pragma unroll
                for (int j = 0; j < 8; ++j) { const float gsum = c0[j] * x0[j] + c1[j] * x1[j] + c2[j] * x2[j]; r[j] = gsum / (1.0f + __expf(-gsum)) * vl[j]; x0[j] = x1[j]; x1[j] = x2[j]; }
                v4u o; o.x = pk2(r[0], r[1]); o.y = pk2(r[2], r[3]); o.z = pk2(r[4], r[5]); o.w = pk2(r[6], r[7]);
                *(v4u*)(ACT + (size_t)(m0 + tq + i) * DFF + f0) = o;
            }
        }
    }
}

__device__ __forceinline__ Ctx make_ctx(unsigned char* lds) {
    Ctx C;
    C.lds = (LAS unsigned char*)lds;
    int t = threadIdx.x; asm volatile("" : "+v"(t));
    C.tid = t; C.lane = C.tid & 63; C.wave = __builtin_amdgcn_readfirstlane(C.tid >> 6);
    C.G = gridDim.x; C.bid = blockIdx.x; C.gw = C.bid * NWAVES + C.wave; C.ngw = C.G * NWAVES;
    return C;
}
template <int K> __device__ __forceinline__ void run_phase(unsigned char* lds, const Args& args, int l) {
    const Ctx C = make_ctx(lds);
    size_t wsz_ = 0; asm volatile("" : "+s"(wsz_)); unsigned char* ws = args.ws + wsz_;
    unsigned char* wsw = ws + (size_t)(l & 1) * WSET_STRIDE; LAS unsigned char* ring = C.lds + RING_OFF; float* out = args.out;
    const float* xsrc = (l == 0) ? args.in[0] : out;
    if constexpr (K == 0) { phase_prep(C, args, l, xsrc, ws); }
    if constexpr (K == 1) { pg8::Gemm g{(const bf16*)(ws + WS_H), (const bf16*)(wsw + WS_WIN), M, NP1, D}; pg8::StaticOrder S; S.init(M, NP1, C.G, C.bid);
        pg8::EpiWin E{(bf16*)(ws + WS_P1), (bf16*)(ws + WS_G), 0};
        pg8::gemm_phase<pg8::EpiWin, pg8::StaticOrder, true, true>(ring, g, S, E); }
    if constexpr (K == 2) { phase_aprime(C, args, l, ws); phase_vt(C, ws); }
    if constexpr (K == 3) { pg8::Gemm g{(const bf16*)(ws + WS_AP), (const bf16*)(wsw + WS_WLORA), M, NLORA, KLORA}; pg8::StaticOrder S; S.init(M, NLORA, C.G, C.bid);
        pg8::EpiF32P E{(float*)(ws + WS_LO), NLORA};
        pg8::gemm_phase<pg8::EpiF32P, pg8::StaticOrder, true, true>(ring, g, S, E); }
    if constexpr (K == 4) { phase_chunkprep(C, args, l, ws); }
    if constexpr (K == 5) {
        const int xg = C.bid & 7, jj = C.bid >> 3;
        if (jj < 3) {
            if (C.tid < 16) ((LAS unsigned*)(C.lds + CH_FLAGS))[C.tid] = 0u;
            __syncthreads();
            const int hs = xg * 3 + jj;
            if (C.wave < 4) scan_chain(C.lane, C.wave, C.lds, hs, ws);
            else chain_loader(C.lane, C.wave - 4, C.lds, hs, ws);
        } else {
            const int gidx = (jj - 3) * 8 + xg;
            build_lut(C, args.in[1]);
            { const float* sinks = args.in[4] + l * 8;
              for (int rep = 0; rep < EXP_ATTN_REPS; ++rep) for (int it = gidx * 8 + C.wave; it < 512 * 20; it += 1856) attn_wave_item(C.lane, (const LAS float*)(C.lds + LUT_OFF), it, sinks, ws); }
            __syncthreads();
            for (int rep = 0; rep < EXP_GATE_REPS; ++rep) { pg8::Gemm g{(const bf16*)(ws + WS_H), (const bf16*)(wsw + WS_WIN) + (size_t)NP1 * D, M, NG, D}; pg8::StaticOrder S; S.init(M, NG, 232, gidx);
              pg8::EpiWin E{(bf16*)(ws + WS_P1), (bf16*)(ws + WS_G), 23};
              pg8::gemm_phase<pg8::EpiWin, pg8::StaticOrder, true, true>(ring, g, S, E); }
            if (l + 1 < DEPTH) convert_weights(gidx * 8 + C.wave, 1856, C.lane, (LAS float*)(C.lds + RING_OFF + C.wave * 16384), args, l + 1, ws);
        } }
    if constexpr (K == 6) { phase_post(C, args, l, ws); }
    if constexpr (K == 7) { pg8::Gemm g{(const bf16*)(ws + WS_YA), (const bf16*)(wsw + WS_PA), M, D, 1536}; pg8::StaticOrder S; S.init(M, D, C.G, C.bid);
        pg8::EpiGate3 E{(const bf16*)(ws + WS_G), (bf16*)(ws + WS_MG), 8, 20};
        pg8::gemm_phase<pg8::EpiGate3, pg8::StaticOrder, true, true>(ring, g, S, E); }
    if constexpr (K == 8) { pg8::Gemm g{(const bf16*)(ws + WS_MG), (const bf16*)(wsw + WS_WOUT), M, D, D}; pg8::StaticOrder S; S.init(M, D, C.G, C.bid);
        pg8::EpiResid E{xsrc, out};
        pg8::gemm_phase<pg8::EpiResid, pg8::StaticOrder, true, true>(ring, g, S, E); }
    if constexpr (K == 9) { const float* g2 = args.in[20] + (size_t)l * D; bf16* H = (bf16*)(ws + WS_H);
        for (int m = 2 * C.gw; m < M; m += 2 * C.ngw) rms_row2_bf16(out + (size_t)m * D, g2, H + (size_t)m * D, C.lane); }
    if constexpr (K == 10) { pg8::Gemm g{(const bf16*)(ws + WS_H) - 2 * D, (const bf16*)(wsw + WS_WUP), 65 * 256, NUP, D}; pg8::StaticOrder S; S.init(65 * 256, NUP, C.G, C.bid);
        pg8::EpiConv E{(bf16*)(ws + WS_ACT), args.in[22] + (size_t)l * 3 * DFF, (PG8_LAS float*)(C.lds + 131072)};
        pg8::gemm_phase<pg8::EpiConv, pg8::StaticOrder, true, true>(ring, g, S, E); }
    if constexpr (K == 12) { pg8::Gemm g{(const bf16*)(ws + WS_ACT), (const bf16*)(wsw + WS_WDOWN), M, D, DFF}; pg8::StaticOrder S; S.init(M, D, C.G, C.bid);
        pg8::EpiResid E{out, out};
        pg8::gemm_phase<pg8::EpiResid, pg8::StaticOrder, true, true>(ring, g, S, E); }
    if constexpr (K == 13) { const float* gf = args.in[24];
        for (int m = C.gw; m < M; m += C.ngw) rms_row_f32(out + (size_t)m * D, gf, C.lane); }
}
template <int K> __global__ void __launch_bounds__(NTHREADS, 2) fwd_phase(Args args) {
    extern __shared__ __attribute__((aligned(16))) unsigned char lds[];
    run_phase<K>(lds, args, args.li);
}
#ifndef EXP_BAR_REPS
#define EXP_BAR_REPS 1
#endif
#define XBAR(b) do { for (int r_ = 0; r_ < EXP_BAR_REPS; ++r_) xcd_barrier(b); } while (0)
__global__ void __launch_bounds__(NTHREADS, 2) fwd_all(Args args) {
    extern __shared__ __attribute__((aligned(16))) unsigned char lds[];
    { LAS unsigned* ctlw = (LAS unsigned*)((LAS unsigned char*)lds + LDSCTL_OFF); for (int u = threadIdx.x; u < (LDS_BYTES - LDSCTL_OFF) / 4; u += NTHREADS) ctlw[u] = 0u; }
    __syncthreads();
    const XcdBarrier bar = xcd_barrier_post((unsigned*)(args.ws + WS_CTL) + CW_BAR, (volatile LAS unsigned*)((LAS unsigned char*)lds + MISC_OFF) + 8);
    for (int l = 0; l < DEPTH; ++l) {
        for (int rep = 0; rep < (((EXP_EW_MASK >> 0) & 1) ? 2 : 1); ++rep) { run_phase<0>(lds, args, l); XBAR(bar); }
        for (int rep = 0; rep < EXP_G1_REPS; ++rep) { run_phase<1>(lds, args, l); XBAR(bar); }
        for (int rep = 0; rep < (((EXP_EW_MASK >> 2) & 1) ? 2 : 1); ++rep) { run_phase<2>(lds, args, l); XBAR(bar); }
        for (int rep = 0; rep < EXP_G3_REPS; ++rep) { run_phase<3>(lds, args, l); XBAR(bar); }
        for (int rep = 0; rep < (((EXP_EW_MASK >> 4) & 1) ? 2 : 1); ++rep) { run_phase<4>(lds, args, l); XBAR(bar); }
        run_phase<5>(lds, args, l); XBAR(bar);
        for (int rep = 0; rep < (((EXP_EW_MASK >> 6) & 1) ? 2 : 1); ++rep) { run_phase<6>(lds, args, l); XBAR(bar); }
        for (int rep = 0; rep < EXP_G7_REPS; ++rep) { run_phase<7>(lds, args, l); XBAR(bar); }
        run_phase<8>(lds, args, l); XBAR(bar);
        for (int rep = 0; rep < (((EXP_EW_MASK >> 9) & 1) ? 2 : 1); ++rep) { run_phase<9>(lds, args, l); XBAR(bar); }
        for (int rep = 0; rep < EXP_G10_REPS; ++rep) { run_phase<10>(lds, args, l); XBAR(bar); }
        run_phase<12>(lds, args, l); XBAR(bar);
    }
    run_phase<13>(lds, args, 0);
}

#ifndef MK_ONE_LAUNCH
#define MK_ONE_LAUNCH 1
#endif
template <int K> static void launch_phase(int grid, hipStream_t stream, Args a, int l) {
    static bool attr = false; if (!attr) { (void)hipFuncSetAttribute((const void*)fwd_phase<K>, hipFuncAttributeMaxDynamicSharedMemorySize, LDS_BYTES); attr = true; }
    a.li = l; a.ph_lo = K; a.ph_hi = K + 1;
    hipLaunchKernelGGL(fwd_phase<K>, dim3(grid), dim3(NTHREADS), LDS_BYTES, stream, a);
}
extern "C" void kernel_launch(void* const* d_in, const int* in_sizes, int n_in, void* d_out, int out_size, void* d_ws, size_t ws_size, hipStream_t stream) {
    static int grid = 0;
    if (grid == 0) {
        if (n_in != 25 || in_sizes[0] != M * D || out_size != M * D || ws_size < WS_END2) { fprintf(stderr, "kernel_launch: unexpected shapes (n_in %d, in0 %d, out %d, ws %zu < %zu)\n", n_in, n_in > 0 ? in_sizes[0] : -1, out_size, ws_size, (size_t)WS_END); grid = -1; return; }
        int dev = 0, cus = 0;
        if (hipGetDevice(&dev) != hipSuccess || hipDeviceGetAttribute(&cus, hipDeviceAttributeMultiprocessorCount, dev) != hipSuccess) { grid = -1; return; }
        grid = cus;
    }
    if (grid < 0) return;
    (void)hipMemsetAsync((char*)d_ws + WS_CTL, 0, CTL_ZERO_BYTES, stream);
    Args a{};
    for (int i = 0; i < 25; ++i) a.in[i] = (const float*)d_in[i];
    a.out = (float*)d_out; a.ws = (unsigned char*)d_ws; a.pad = 0;
#if MK_ONE_LAUNCH
    { static bool attr = false; if (!attr) { (void)hipFuncSetAttribute((const void*)fwd_all, hipFuncAttributeMaxDynamicSharedMemorySize, LDS_BYTES); attr = true; }
      a.li = 0; a.ph_lo = 0; a.ph_hi = NPHASES;
      hipLaunchKernelGGL(fwd_all, dim3(grid), dim3(NTHREADS), LDS_BYTES, stream, a); }
#else
    for (int l = 0; l < DEPTH; ++l) {
        launch_phase<0>(grid, stream, a, l); launch_phase<1>(grid, stream, a, l); launch_phase<2>(grid, stream, a, l); launch_phase<3>(grid, stream, a, l);
        launch_phase<4>(grid, stream, a, l); launch_phase<5>(grid, stream, a, l); launch_phase<6>(grid, stream, a, l); launch_phase<7>(grid, stream, a, l);
        launch_phase<8>(grid, stream, a, l); launch_phase<9>(grid, stream, a, l); launch_phase<10>(grid, stream, a, l); launch_phase<11>(grid, stream, a, l);
        launch_phase<12>(grid, stream, a, l);
    }
    launch_phase<13>(grid, stream, a, 0);
#endif
}
```
